# Optimizing an MI355X kernel written in HIP

```python
import math
import jax, jax.numpy as jnp
from jax import lax
import numpy as np

D_MODEL = 1024
BATCH = 8
SEQ = 2048
DEPTH = 4

N_MIXERS = 2
N_POOL_LAYERS = (DEPTH + 1) // 2
N_ATTN_LAYERS = DEPTH // 2

POOL_WINDOWS = (2, 4, 8, 16)
POOL_GROUPS = len(POOL_WINDOWS)
POOL_CH = D_MODEL // POOL_GROUPS

ATTN_PATTERNS = ((128, 1), (512, 4), (2048, 16))
N_ATTN_GROUPS = len(ATTN_PATTERNS)
HEAD_DIM = 64
N_HEADS = D_MODEL // HEAD_DIM
Q_BLOCK = 128

N_EXPERTS = 64
TOP_K = 8
N_EXPERT_GROUPS = 8
TOPK_GROUPS = 4
D_EXPERT = 256
D_SHARED = 256
ROUTED_SCALE = 2.5
EXPERT_ROWS = 256

ALPHA = (2 * DEPTH) ** 0.25
BETA = (8 * DEPTH) ** -0.25
LN_EPS = 1e-5

kernel_name = "hybrid_pool_dilated_attn_moe_deepnorm"

F32 = jnp.float32


def layer_norm(x, g, b):
    xf = x.astype(F32)
    mu = jnp.mean(xf, axis=-1, keepdims=True)
    var = jnp.mean(jnp.square(xf - mu), axis=-1, keepdims=True)
    return ((xf - mu) * lax.rsqrt(var + LN_EPS) * g.astype(F32) + b.astype(F32)).astype(x.dtype)


def alibi_slopes(n):
    return 2.0 ** (-8.0 * jnp.arange(1, n + 1, dtype=F32) / n)


def multiscale_pool_mixer(h, w_in, w_grp, ch_scale, w_out):
    b, s, _ = h.shape
    u = (h @ w_in).reshape(b, s, POOL_GROUPS, POOL_CH)
    csum = jnp.cumsum(u.astype(F32), axis=1)
    csum = jnp.pad(csum, ((0, 0), (1, 0), (0, 0), (0, 0)))
    t = jnp.arange(s)
    parts = []
    for g, w in enumerate(POOL_WINDOWS):
        lo = jnp.maximum(t + 1 - w, 0)
        win_sum = csum[:, 1:, g] - csum[:, lo, g]
        cnt = jnp.minimum(t + 1, w).astype(F32)[None, :, None]
        parts.append(win_sum / cnt - u[:, :, g].astype(F32))
    z = jnp.stack(parts, axis=2).astype(h.dtype)
    y = jnp.einsum('bsgc,gcf->bsgf', z, w_grp).reshape(b, s, D_MODEL) * ch_scale
    return y @ w_out


def dilated_group_attention(q, k, v, dilation, steps, slopes):
    b, s, h, dh = q.shape
    L = s // dilation
    bq = min(Q_BLOCK, L)
    nb = L // bq
    qs = q.reshape(b, nb, bq, dilation, h, dh)
    pad = ((0, 0), (steps, 0), (0, 0), (0, 0), (0, 0))
    kp = jnp.pad(k.reshape(b, L, dilation, h, dh), pad)
    vp = jnp.pad(v.reshape(b, L, dilation, h, dh), pad)
    key_idx = jnp.arange(nb)[:, None] * bq + jnp.arange(bq + steps)[None, :]
    kb = kp[:, key_idx]
    vb = vp[:, key_idx]
    sc = jnp.einsum('bnidhe,bnjdhe->bdhnij', qs, kb, preferred_element_type=F32) * (dh ** -0.5)
    qpos = jnp.arange(nb)[:, None] * bq + jnp.arange(bq)[None, :]
    kpos = key_idx - steps
    dist = qpos[:, :, None] - kpos[:, None, :]
    valid = (dist >= 0) & (dist <= steps) & (kpos[:, None, :] >= 0)
    bias = -slopes[:, None, None, None] * (dist * dilation).astype(F32)
    sc = jnp.where(valid, sc + bias, -jnp.inf)
    m = jnp.max(sc, axis=-1, keepdims=True)
    p = jnp.exp(sc - m)
    den = jnp.sum(p, axis=-1, keepdims=True)
    o = jnp.einsum('bdhnij,bnjdhe->bdhnie', p, vb, preferred_element_type=F32) / den
    lse = (m + jnp.log(den))[..., 0]
    o = o.transpose(0, 3, 4, 1, 2, 5).reshape(b, s, h, dh)
    lse = lse.transpose(0, 3, 4, 1, 2).reshape(b, s, h)
    return o, lse


def dilated_attention_mixer(h, w_in, w_out):
    b, s, _ = h.shape
    qkv = (h @ w_in).reshape(b, s, N_ATTN_GROUPS, 3, N_HEADS, HEAD_DIM)
    slopes = alibi_slopes(N_ATTN_GROUPS * N_HEADS).reshape(N_ATTN_GROUPS, N_HEADS)
    outs, lses = [], []
    for g, (window, dil) in enumerate(ATTN_PATTERNS):
        o, l = dilated_group_attention(qkv[:, :, g, 0], qkv[:, :, g, 1], qkv[:, :, g, 2],
                                       dil, window // dil, slopes[g])
        outs.append(o)
        lses.append(l)
    wts = jax.nn.softmax(jnp.stack(lses, axis=0), axis=0)
    mixed = jnp.sum(wts[..., None] * jnp.stack(outs, axis=0), axis=0)
    return mixed.astype(h.dtype).reshape(b, s, D_MODEL) @ w_out


def moe_ffn(h, w_router, router_b, w_exp_gu, w_exp_down, w_sh_gu, w_sh_down):
    b, s, d = h.shape
    hf = h.reshape(-1, d)
    T = hf.shape[0]
    scores = jax.nn.sigmoid(jnp.dot(hf, w_router, preferred_element_type=F32))
    sel = scores + router_b.astype(F32)
    grp_score = lax.top_k(sel.reshape(T, N_EXPERT_GROUPS, -1), 2)[0].sum(-1)
    _, grp_idx = lax.top_k(grp_score, TOPK_GROUPS)
    grp_mask = jax.nn.one_hot(grp_idx, N_EXPERT_GROUPS, dtype=F32).sum(1)
    exp_mask = jnp.repeat(grp_mask, N_EXPERTS // N_EXPERT_GROUPS, axis=1) > 0
    _, top_idx = lax.top_k(jnp.where(exp_mask, sel, -jnp.inf), TOP_K)
    top_w = jnp.take_along_axis(scores, top_idx, axis=1)
    top_w = top_w / jnp.sum(top_w, axis=-1, keepdims=True) * ROUTED_SCALE
    C = EXPERT_ROWS
    TK = T * TOP_K
    P = ((TK + N_EXPERTS * (C - 1) + C - 1) // C) * C
    NB = P // C
    flat_e = top_idx.reshape(-1)
    order = jnp.argsort(flat_e)
    sorted_e = flat_e[order]
    tok_sorted = (order // TOP_K).astype(jnp.int32)
    counts = jnp.bincount(flat_e, length=N_EXPERTS).astype(jnp.int32)
    padded = ((counts + C - 1) // C) * C
    starts = jnp.cumsum(counts) - counts
    padded_ends = jnp.cumsum(padded)
    padded_starts = padded_ends - padded
    dest = padded_starts[sorted_e] + (jnp.arange(TK, dtype=jnp.int32) - starts[sorted_e])
    buf_tok = jnp.full((P,), T, jnp.int32).at[dest].set(tok_sorted)
    buf_w = jnp.zeros((P,), F32).at[dest].set(top_w.reshape(-1)[order])
    group_e = jnp.clip(jnp.searchsorted(padded_ends, jnp.arange(NB) * C, side='right'),
                       0, N_EXPERTS - 1)
    hf_pad = jnp.concatenate([hf, jnp.zeros((1, d), hf.dtype)], axis=0)
    xg = hf_pad[buf_tok].reshape(NB, C, d)

    def expert_rows(args):
        xr, e = args
        gu = xr @ w_exp_gu[e]
        return (jax.nn.silu(gu[:, :D_EXPERT]) * gu[:, D_EXPERT:]) @ w_exp_down[e]

    yg = lax.map(expert_rows, (xg, group_e)).reshape(P, d)
    yg = yg * buf_w[:, None].astype(yg.dtype)
    routed = jnp.zeros((T + 1, d), hf.dtype).at[buf_tok].add(yg)[:T]
    sh = hf @ w_sh_gu
    shared = (jax.nn.silu(sh[:, :D_SHARED]) * sh[:, D_SHARED:]) @ w_sh_down
    return (routed + shared).reshape(b, s, d)


def setup_inputs(seed: int = 0) -> dict:
    key = jax.random.key(seed)
    ks = jax.random.split(key, 22)
    D = D_MODEL

    def nrm(k, shape, std):
        return jax.random.normal(k, shape, F32) * std

    return {
        "x": nrm(ks[0], (BATCH, SEQ, D), 1.0),
        "c": nrm(ks[1], (BATCH, D), 1.0),
        "ada_w": nrm(ks[2], (DEPTH, D, 6 * D), 0.2 * D ** -0.5),
        "ada_b": nrm(ks[3], (DEPTH, 6 * D), 0.02),
        "pool_w_in": nrm(ks[4], (N_POOL_LAYERS, D, D), D ** -0.5),
        "pool_w_grp": nrm(ks[5], (N_POOL_LAYERS, POOL_GROUPS, POOL_CH, POOL_CH), POOL_CH ** -0.5),
        "pool_scale": 1.0 + nrm(ks[6], (N_POOL_LAYERS, D), 0.1),
        "pool_w_out": nrm(ks[7], (N_POOL_LAYERS, D, D), BETA * D ** -0.5),
        "attn_w_in": nrm(ks[8], (N_ATTN_LAYERS, D, N_ATTN_GROUPS * 3 * D), D ** -0.5),
        "attn_w_out": nrm(ks[9], (N_ATTN_LAYERS, D, D), BETA * D ** -0.5),
        "ln1_g": 1.0 + nrm(ks[10], (DEPTH, D), 0.05),
        "ln1_b": nrm(ks[11], (DEPTH, D), 0.02),
        "router_w": nrm(ks[12], (DEPTH, D, N_EXPERTS), D ** -0.5),
        "router_b": nrm(ks[13], (DEPTH, N_EXPERTS), 0.01),
        "exp_w_gu": nrm(ks[14], (DEPTH, N_EXPERTS, D, 2 * D_EXPERT), D ** -0.5),
        "exp_w_down": nrm(ks[15], (DEPTH, N_EXPERTS, D_EXPERT, D), BETA * D_EXPERT ** -0.5),
        "sh_w_gu": nrm(ks[16], (DEPTH, D, 2 * D_SHARED), D ** -0.5),
        "sh_w_down": nrm(ks[17], (DEPTH, D_SHARED, D), BETA * D_SHARED ** -0.5),
        "ln2_g": 1.0 + nrm(ks[18], (DEPTH, D), 0.05),
        "ln2_b": nrm(ks[19], (DEPTH, D), 0.02),
    }


def reference(x, c, ada_w, ada_b, pool_w_in, pool_w_grp, pool_scale, pool_w_out,
              attn_w_in, attn_w_out, ln1_g, ln1_b, router_w, router_b, exp_w_gu,
              exp_w_down, sh_w_gu, sh_w_down, ln2_g, ln2_b):
    cs = jax.nn.silu(c)
    for i in range(DEPTH):
        mod = (cs @ ada_w[i] + ada_b[i])[:, None, :]
        sh1, sc1, g1, sh2, sc2, g2 = jnp.split(mod, 6, axis=-1)
        hm = x * (1.0 + sc1) + sh1
        j = i // N_MIXERS
        if i % N_MIXERS == 0:
            y = multiscale_pool_mixer(hm, pool_w_in[j], pool_w_grp[j], pool_scale[j], pool_w_out[j])
        else:
            y = dilated_attention_mixer(hm, attn_w_in[j], attn_w_out[j])
        x = layer_norm(ALPHA * x + (1.0 + g1) * y, ln1_g[i], ln1_b[i])
        hf = x * (1.0 + sc2) + sh2
        y = moe_ffn(hf, router_w[i], router_b[i], exp_w_gu[i], exp_w_down[i], sh_w_gu[i], sh_w_down[i])
        x = layer_norm(ALPHA * x + (1.0 + g2) * y, ln2_g[i], ln2_b[i])
    return x
```

```cpp
#include <hip/hip_runtime.h>
#include <cstdio>
#include <cstdint>

#ifndef MK_PER_PHASE
#define MK_PER_PHASE 1
#endif
#define ORACLE_SEL 1
#define ATTN_GMASK 7
#define ORACLE_W 1
#define ORACLE_LAYER 1
#ifndef PHSEL
#define PHSEL 0xFFFF
#endif
#define PHON(n) (((PHSEL) >> (n)) & 1)

#define GAS __attribute__((address_space(1)))
#define LAS __attribute__((address_space(3)))
typedef unsigned short bf16;
typedef short bf16x8 __attribute__((ext_vector_type(8)));
typedef short s16x4 __attribute__((ext_vector_type(4)));
typedef float f32x2 __attribute__((ext_vector_type(2)));
typedef float f32x4 __attribute__((ext_vector_type(4)));
typedef float f32x16 __attribute__((ext_vector_type(16)));
typedef unsigned u32x2 __attribute__((ext_vector_type(2)));
typedef unsigned u32x4 __attribute__((ext_vector_type(4)));

constexpr int BATCH = 8, SEQ = 2048, D = 1024, T = BATCH * SEQ, DEPTH = 4;
constexpr int NQKV = 9216, NE = 64, TOPK = 8, DEXP = 256;
constexpr int CAP = 16384;
constexpr int PSLOT = 147456 + T;
constexpr float ALPHA = 1.6817928305074290f;
constexpr float LN_EPS = 1e-5f;
constexpr float LOG2E = 1.4426950408889634f;
constexpr float QSCALE = 0.125f * LOG2E;
constexpr float ROUTED_SCALE = 2.5f;

constexpr size_t MiB = 1u << 20;
constexpr size_t WS_CTL = 0, CTL_ZERO_BYTES = 1 * MiB;
constexpr size_t WS_MOD = 1 * MiB;
constexpr size_t WS_WRHI = 2 * MiB;
constexpr size_t WS_WRLO = WS_WRHI + 512 * 1024;
constexpr size_t WS_WPIN = 3 * MiB;
constexpr size_t WS_WPGRP = 7 * MiB;
constexpr size_t WS_WPOUT = 8 * MiB;
constexpr size_t WS_WAIN = 12 * MiB;
constexpr size_t WS_WAOUT = 48 * MiB;
constexpr size_t WS_WSHGU = 52 * MiB;
constexpr size_t WS_WSHDN = 56 * MiB;
constexpr size_t WS_WEGU = 58 * MiB;
constexpr size_t WS_WEDN = 314 * MiB;
constexpr size_t WS_X = 442 * MiB;
constexpr size_t WS_H = 506 * MiB;
constexpr size_t WS_Y = 538 * MiB;
constexpr size_t WS_U = 570 * MiB;
constexpr size_t WS_Z = 602 * MiB;
constexpr size_t WS_Y2 = 634 * MiB;
constexpr size_t WS_YS = 666 * MiB;
constexpr size_t WS_ACT = 986 * MiB;
constexpr size_t WS_TOKL = 1066 * MiB;
constexpr size_t WS_WL = 1070 * MiB;
constexpr size_t WS_TSLOT = 1074 * MiB;
constexpr size_t WS_END = 1075 * MiB;
static_assert(WS_YS + (size_t)PSLOT * 2048 <= WS_ACT && WS_ACT + (size_t)PSLOT * 512 <= WS_TOKL, "ws map");
constexpr int CW_BAR = 4096;
constexpr int CW_CNT = 8192;

constexpr int RING_BYTES = 135168;
constexpr int LDSCTL_OFF = RING_BYTES;
constexpr int LDS_BYTES = 147456;
constexpr int LC_MISC = 0;
constexpr int LC_TS = 128;
constexpr int LC_CNT = 128 + 272;
constexpr int LC_LCNT = 128 + 272 + 256;
constexpr int LC_GB = 128 + 272 + 512;

#define RLX_AGENT __ATOMIC_RELAXED, __HIP_MEMORY_SCOPE_AGENT
#define LDS_WAIT() asm volatile("s_waitcnt lgkmcnt(0)" ::: "memory")
#define VM_WAIT() asm volatile("s_waitcnt vmcnt(0)" ::: "memory")

typedef _Float16 h16x2 __attribute__((ext_vector_type(2)));
typedef _Float16 h16x8 __attribute__((ext_vector_type(8)));
__device__ __forceinline__ unsigned f2bf(float f) { return (unsigned)__builtin_bit_cast(unsigned short, (_Float16)f); }
__device__ __forceinline__ unsigned pk2(float lo, float hi) { const f32x2 v = {lo, hi}; return __builtin_bit_cast(unsigned, __builtin_convertvector(v, h16x2)); }
__device__ __forceinline__ float bf2f(unsigned h) { return (float)__builtin_bit_cast(_Float16, (unsigned short)h); }
__device__ __forceinline__ unsigned cvt_pk_bf16(float lo, float hi) { return pk2(lo, hi); }
#define MFMA16(a, b, c) __builtin_amdgcn_mfma_f32_16x16x32_f16(__builtin_bit_cast(h16x8, a), __builtin_bit_cast(h16x8, b), c, 0, 0, 0)
#define MFMA32(a, b, c) __builtin_amdgcn_mfma_f32_32x32x16_f16(__builtin_bit_cast(h16x8, a), __builtin_bit_cast(h16x8, b), c, 0, 0, 0)
__device__ __forceinline__ float wave_sum(float v) {
#pragma unroll
    for (int o = 1; o < 64; o <<= 1) v += __shfl_xor(v, o);
    return v;
}

namespace pg8 {
constexpr int BM = 256, BK = 64, HALF = 128, HTB = HALF * BK * 2, STAGE_BYTES = 8 * HTB, NXCD = 8;
__host__ __device__ __forceinline__ int lds_byte(int r, int c) { const int st = (r >> 4) * 2 + (c >> 5), rr = r & 15, cc = c & 31, ob = rr * 64 + cc * 2; return st * 1024 + (ob ^ (((ob >> 9) & 1) << 5)); }
__host__ __device__ __forceinline__ void stage_rc(int b, int& R, int& C) { const int st = b / 1024, sb = b % 1024, swz = sb ^ (((sb >> 9) & 1) << 5); R = (st >> 1) * 16 + swz / 64; C = (st & 1) * 32 + (swz % 64) / 2; }
__host__ __device__ __forceinline__ int perm32(int rho) { const int n = rho >> 4, i = rho & 15; return 8 * (i >> 2) + 4 * n + (i & 3); }

struct Unit {
    int pm, pn;
    const char* bptr;
    int roff;
    int nvalid;
};

__device__ __forceinline__ int xcd_chunk(int L, int nwg) { const int q = nwg / NXCD, r = nwg % NXCD, xcd = L % NXCD, off = L / NXCD; return (xcd < r ? xcd * (q + 1) : r * (q + 1) + (xcd - r) * q) + off; }

template <class Epi, class Sched>
__device__ __forceinline__ void gemm_phase(const int tid, LAS unsigned char* lds, const char* Abase, const int lda, const int ldb, const int K, const Sched& S, const Epi& E) {
    constexpr bool GATHER = Sched::GATHER;
    const int wid = __builtin_amdgcn_readfirstlane(tid >> 6), lane = tid & 63, wr = wid >> 2, wc = wid & 3, fr = lane & 15, fq = lane >> 4;
    const int nt = K / BK;
    int Rr[2]; unsigned C2[2], voffB[2], voffA[2];
#pragma unroll
    for (int i = 0; i < 2; ++i) { int R, C; stage_rc(tid * 16 + i * 8192, R, C); const int Rb = (R & ~31) + perm32(R & 31); Rr[i] = R; C2[i] = (unsigned)C * 2u; voffB[i] = (unsigned)(Rb * ldb) + (unsigned)C * 2u; voffA[i] = (unsigned)(R * lda) + (unsigned)C * 2u; }
    const size_t kstep = (size_t)(BK * 2);
    const size_t hstepB = (size_t)HALF * ldb;
    const size_t hstepA = GATHER ? (size_t)0 : (size_t)HALF * lda;
    const unsigned ldsw = (unsigned)wid * 1024u;
    const int aoff = lds_byte(wr * 64 + fr, fq * 8), boff = lds_byte(wc * 32 + fr, fq * 8);
#define PG8_SA(b, h) (((b) * 2 + (h)) * HTB)
#define PG8_SB(b, h) ((4 + (b) * 2 + (h)) * HTB)
#define PG8_STAGE(bufoff, gbase, voff) do { _Pragma("unroll") for (int _i = 0; _i < 2; ++_i) \
        __builtin_amdgcn_global_load_lds((const unsigned*)((const char*)(gbase) + (voff)[_i]), (LAS unsigned*)(lds + (bufoff) + ldsw + _i * 8192), 16, 0, 0); } while (0)
#define PG8_STAGEA(bufoff, gbase, h) do { if constexpr (GATHER) { PG8_STAGE(bufoff, gbase, vA[h]); } else { PG8_STAGE(bufoff, (gbase) + (h) * hstepA, voffA); } } while (0)
#define PG8_LDA(dst, b, h) do { _Pragma("unroll") for (int m = 0; m < 4; ++m) _Pragma("unroll") for (int k = 0; k < 2; ++k) dst[m][k] = *(const LAS bf16x8*)(lds + PG8_SA(b, h) + aoff + m * 2048 + k * 1024); } while (0)
#define PG8_LDB(dst, b, h) do { _Pragma("unroll") for (int n = 0; n < 2; ++n) _Pragma("unroll") for (int k = 0; k < 2; ++k) dst[n][k] = *(const LAS bf16x8*)(lds + PG8_SB(b, h) + boff + n * 2048 + k * 1024); } while (0)
#define PG8_MMA(ai, bj, At, Bt) do { __builtin_amdgcn_s_setprio(1); _Pragma("unroll") for (int m = 0; m < 4; ++m) _Pragma("unroll") for (int n = 0; n < 2; ++n) _Pragma("unroll") for (int k = 0; k < 2; ++k) \
        acc[ai][bj][m][n] = MFMA16(Bt[n][k], At[m][k], acc[ai][bj][m][n]); __builtin_amdgcn_s_setprio(0); } while (0)
#define PG8_WAIT_V(n) asm volatile("s_waitcnt vmcnt(" #n ")" ::: "memory")
#define PG8_WAIT_L(n) asm volatile("s_waitcnt lgkmcnt(" #n ")" ::: "memory")
#define PG8_BAR __builtin_amdgcn_s_barrier()
#define PG8_SCHED __builtin_amdgcn_sched_barrier(0)
#define PG8_CALCA(u, vo) do { _Pragma("unroll") for (int _h = 0; _h < 2; ++_h) _Pragma("unroll") for (int _i = 0; _i < 2; ++_i) \
        vo[_h][_i] = (unsigned)S.arow(u, _h * HALF + Rr[_i]) * (unsigned)lda + C2[_i]; } while (0)
    Unit cur, nxt; int ui = 0;
    if (!S.next(0, cur)) return;
    f32x4 acc[2][2][4][2];
#pragma unroll
    for (int a = 0; a < 2; ++a)
#pragma unroll
        for (int b = 0; b < 2; ++b)
#pragma unroll
            for (int m = 0; m < 4; ++m)
#pragma unroll
                for (int n = 0; n < 2; ++n) acc[a][b][m][n] = (f32x4){0.f, 0.f, 0.f, 0.f};
    bf16x8 At[4][2], B0[2][2], B1[2][2];
    unsigned vA[2][2], vAn[2][2];
    const char* cA = Abase;
    if constexpr (GATHER) { PG8_CALCA(cur, vA); } else { cA = Abase + (size_t)S.arow(cur, 0) * lda + S.acolb(cur); }
    const char* cB = cur.bptr;
    PG8_STAGE(PG8_SB(0, 0), cB, voffB); PG8_STAGE(PG8_SB(0, 1), cB + hstepB, voffB); PG8_STAGEA(PG8_SA(0, 0), cA, 0); PG8_STAGEA(PG8_SA(0, 1), cA, 1);
    if (wr == 1) PG8_BAR;
    PG8_WAIT_V(2); PG8_BAR;
    PG8_STAGE(PG8_SB(1, 0), cB + kstep, voffB); PG8_STAGEA(PG8_SA(1, 0), cA + kstep, 0); PG8_STAGE(PG8_SB(1, 1), cB + hstepB + kstep, voffB);
    PG8_WAIT_V(6); PG8_BAR;
    for (;;) {
        const bool has_next = S.next(ui + 1, nxt);
        float rs[2][4];
        if constexpr (Epi::ROWSCALE) {
#pragma unroll
            for (int ai = 0; ai < 2; ++ai)
#pragma unroll
                for (int m = 0; m < 4; ++m) rs[ai][m] = S.rowscale(cur, ai * HALF + wr * 64 + m * 16 + fr);
        }
        const char* nA = cA;
        if constexpr (GATHER) {
            if (has_next) { PG8_CALCA(nxt, vAn); }
            else {
#pragma unroll
                for (int h = 0; h < 2; ++h)
#pragma unroll
                    for (int i = 0; i < 2; ++i) vAn[h][i] = vA[h][i];
            }
            asm volatile("s_waitcnt vmcnt(0)" : "+v"(vAn[0][0]), "+v"(vAn[0][1]), "+v"(vAn[1][0]), "+v"(vAn[1][1]) :: "memory");
            if constexpr (Epi::ROWSCALE) { asm volatile("" : "+v"(rs[0][0]), "+v"(rs[0][1]), "+v"(rs[0][2]), "+v"(rs[0][3]), "+v"(rs[1][0]), "+v"(rs[1][1]), "+v"(rs[1][2]), "+v"(rs[1][3])); }
        } else { if (has_next) nA = Abase + (size_t)S.arow(nxt, 0) * lda + S.acolb(nxt); }
        const char* nB = has_next ? nxt.bptr : cB;
#pragma unroll 1
        for (int t = 0; t < nt; t += 2) {
            const bool last = (t == nt - 2);
            const char* a1 = cA + (size_t)(t + 1) * kstep;
            const char* a2 = last ? nA : cA + (size_t)(t + 2) * kstep; const char* b2 = last ? nB : cB + (size_t)(t + 2) * kstep;
            const char* a3 = a2 + kstep; const char* b3 = b2 + kstep;
            PG8_LDB(B0, 0, 0); PG8_LDB(B1, 0, 1); PG8_SCHED; PG8_LDA(At, 0, 0); PG8_STAGEA(PG8_SA(1, 1), a1, 1);
            if constexpr (GATHER) { if (last) {
#pragma unroll
                for (int h = 0; h < 2; ++h)
#pragma unroll
                    for (int i = 0; i < 2; ++i) vA[h][i] = vAn[h][i]; } }
            PG8_WAIT_V(8); PG8_WAIT_L(0); PG8_BAR; PG8_MMA(0, 0, At, B0); PG8_MMA(0, 1, At, B1); PG8_BAR; PG8_SCHED;
            PG8_LDA(At, 0, 1); PG8_STAGE(PG8_SB(0, 0), b2, voffB); PG8_STAGE(PG8_SB(0, 1), b2 + hstepB, voffB); PG8_STAGEA(PG8_SA(0, 0), a2, 0);
            PG8_WAIT_V(8); PG8_WAIT_L(0); PG8_BAR; PG8_MMA(1, 0, At, B0); PG8_MMA(1, 1, At, B1); PG8_BAR; PG8_SCHED;
            PG8_LDB(B0, 1, 0); PG8_LDB(B1, 1, 1); PG8_SCHED; PG8_LDA(At, 1, 0); PG8_STAGEA(PG8_SA(0, 1), a2, 1);
            PG8_WAIT_V(8); PG8_WAIT_L(0); PG8_BAR; PG8_MMA(0, 0, At, B0); PG8_MMA(0, 1, At, B1); PG8_BAR; PG8_SCHED;
            PG8_LDA(At, 1, 1); PG8_STAGE(PG8_SB(1, 0), b3, voffB); PG8_STAGE(PG8_SB(1, 1), b3 + hstepB, voffB); PG8_STAGEA(PG8_SA(1, 0), a3, 0);
            PG8_WAIT_V(8); PG8_WAIT_L(0); PG8_BAR; PG8_MMA(1, 0, At, B0); PG8_MMA(1, 1, At, B1); PG8_BAR; PG8_SCHED;
        }
        if (wr == 0) PG8_BAR;
        E(acc, cur, rs, wr, wc, fr, fq);
        if (!has_next) break;
#pragma unroll
        for (int a = 0; a < 2; ++a)
#pragma unroll
            for (int b = 0; b < 2; ++b)
#pragma unroll
                for (int m = 0; m < 4; ++m)
#pragma unroll
                    for (int n = 0; n < 2; ++n) acc[a][b][m][n] = (f32x4){0.f, 0.f, 0.f, 0.f};
        cur = nxt; cB = nB; cA = nA; ++ui;
        if (wr == 1) PG8_BAR;
    }
    PG8_WAIT_V(0);
    PG8_BAR;
#undef PG8_SA
#undef PG8_SB
#undef PG8_STAGE
#undef PG8_STAGEA
#undef PG8_LDA
#undef PG8_LDB
#undef PG8_MMA
#undef PG8_WAIT_V
#undef PG8_WAIT_L
#undef PG8_BAR
#undef PG8_SCHED
#undef PG8_CALCA
}

struct EpiStore {
    static constexpr bool ROWSCALE = false;
    bf16* O; int ldc; const float* cscale; int qmode; int colbase_mul;
    __device__ __forceinline__ void operator()(const f32x4 (&acc)[2][2][4][2], const Unit& u, const float (&rs)[2][4], int wr, int wc, int fr, int fq) const {
        const int row0 = u.pm * BM + wr * 64 + fr; const int colt = u.pn * BM;
        float sc = 1.f; if (qmode) { if (((colt >> 10) % 3) == 0) sc = QSCALE; }
        const int col0 = colt + wc * 32 + 8 * fq;
        f32x4 cs[2][2];
#pragma unroll
        for (int bj = 0; bj < 2; ++bj)
#pragma unroll
            for (int n = 0; n < 2; ++n) { cs[bj][n] = cscale ? *(const f32x4*)(cscale + col0 + bj * HALF + 4 * n) : (f32x4){1.f, 1.f, 1.f, 1.f}; cs[bj][n] = cs[bj][n] * sc; }
#pragma unroll
        for (int ai = 0; ai < 2; ++ai)
#pragma unroll
            for (int m = 0; m < 4; ++m) { bf16* rowp = O + (size_t)(row0 + ai * HALF + m * 16) * ldc + col0;
#pragma unroll
                for (int bj = 0; bj < 2; ++bj) { const f32x4 v0 = acc[ai][bj][m][0] * cs[bj][0], v1 = acc[ai][bj][m][1] * cs[bj][1];
                    u32x4 w; w.x = cvt_pk_bf16(v0[0], v0[1]); w.y = cvt_pk_bf16(v0[2], v0[3]); w.z = cvt_pk_bf16(v1[0], v1[1]); w.w = cvt_pk_bf16(v1[2], v1[3]);
                    *(u32x4*)(rowp + bj * HALF) = w; } }
    }
};
struct EpiGU {
    static constexpr bool ROWSCALE = true;
    bf16* O;
    __device__ __forceinline__ void operator()(const f32x4 (&acc)[2][2][4][2], const Unit& u, const float (&rs)[2][4], int wr, int wc, int fr, int fq) const {
        const int row0 = u.pm * BM + wr * 64 + fr; const int col0 = u.pn * HALF + wc * 32 + 8 * fq;
#pragma unroll
        for (int ai = 0; ai < 2; ++ai)
#pragma unroll
            for (int m = 0; m < 4; ++m) { bf16* rowp = O + (size_t)(row0 + ai * HALF + m * 16) * DEXP + col0; const float w = rs[ai][m];
                float o[8];
#pragma unroll
                for (int n = 0; n < 2; ++n)
#pragma unroll
                    for (int j = 0; j < 4; ++j) { const float g = acc[ai][0][m][n][j], uu = acc[ai][1][m][n][j];
                        const float sg = g * __builtin_amdgcn_rcpf(1.0f + __builtin_amdgcn_exp2f(-g * LOG2E)); o[n * 4 + j] = sg * uu * w; }
                u32x4 wv; wv.x = cvt_pk_bf16(o[0], o[1]); wv.y = cvt_pk_bf16(o[2], o[3]); wv.z = cvt_pk_bf16(o[4], o[5]); wv.w = cvt_pk_bf16(o[6], o[7]);
                *(u32x4*)rowp = wv; }
    }
};
}

#define XB_TMO      128
#define XB_XCNT(j)  (256  + 64 * (j))
#define XB_XSUB(j)  (1280 + 64 * (j))
#define XB_XGEN(j)  (2304 + 64 * (j))
#define XB_TOP      3328
#define XB_TOPGEN   3392
#define XCD_BAR_WORDS 3456
#define XB_SPIN_CAP (1u << 18)
__device__ __forceinline__ unsigned xb_ld(unsigned* p)              { return __hip_atomic_load(p, __ATOMIC_RELAXED, __HIP_MEMORY_SCOPE_AGENT); }
__device__ __forceinline__ unsigned xb_add(unsigned* p, unsigned v) { return __hip_atomic_fetch_add(p, v, __ATOMIC_RELAXED, __HIP_MEMORY_SCOPE_AGENT); }
__device__ __forceinline__ unsigned xb_xcc_id() { return (unsigned)__builtin_amdgcn_s_getreg((3 << 11) | 20) & 0xFu; }
#define XB_SPIN(cond, bar) do { unsigned _sp = 0; while (cond) { __builtin_amdgcn_s_sleep(1); \
    if ((++_sp & 255u) == 0u) { if (xb_ld(&(bar)[XB_TMO])) break; if (_sp > XB_SPIN_CAP) { atomicAdd(&(bar)[XB_TMO], 1u); break; } } } } while (0)
struct XcdBarrier { unsigned* bar; unsigned x; volatile LAS unsigned* st; };
__device__ __forceinline__ XcdBarrier xcd_barrier_post(unsigned* bar, volatile LAS unsigned* st) {
    XcdBarrier b; b.bar = bar; b.x = xb_xcc_id(); b.st = st;
    if (threadIdx.x == 0) (void)xb_add(&bar[XB_XCNT(b.x)], 1u);
    return b;
}
__device__ __forceinline__ void xcd_barrier_complete(unsigned* bar, unsigned x, unsigned& nloc, unsigned& nx) {
    const unsigned G = gridDim.x * gridDim.y * gridDim.z;
    unsigned sum, cnt, mine, sp = 0u;
    for (;;) {
        sum = 0u; cnt = 0u; mine = 0u;
#pragma unroll
        for (unsigned j = 0; j < 16; ++j) { const unsigned c = xb_ld(&bar[XB_XCNT(j)]); sum += c; cnt += (c > 0u) ? 1u : 0u; mine = (j == x) ? c : mine; }
        if (sum == G) break;
        __builtin_amdgcn_s_sleep(1);
        if ((++sp & 255u) == 0u) { if (xb_ld(&bar[XB_TMO])) break; if (sp > XB_SPIN_CAP) { atomicAdd(&bar[XB_TMO], 1u); break; } }
    }
    nloc = mine > 0u ? mine : 1u; nx = cnt > 0u ? cnt : 1u;
}
__device__ __forceinline__ void xcd_barrier(const XcdBarrier& b) {
    asm volatile("s_waitcnt vmcnt(0)" ::: "memory");
    __syncthreads();
    if (threadIdx.x == 0) {
        unsigned* bar = b.bar;
        __builtin_amdgcn_s_waitcnt(0);
        unsigned nloc = b.st[0], nx = b.st[1];
        if (nloc == 0u) { xcd_barrier_complete(bar, b.x, nloc, nx); b.st[0] = nloc; b.st[1] = nx; }
        const unsigned old = xb_add(&bar[XB_XSUB(b.x)], 1u);
        const unsigned gen = old / nloc;
        if (old + 1u == (gen + 1u) * nloc) {
            __builtin_amdgcn_fence(__ATOMIC_RELEASE, "agent");
            asm volatile("s_waitcnt vmcnt(0)" ::: "memory");
            const unsigned og = xb_add(&bar[XB_TOP], 1u);
            const unsigned tg = og / nx;
            if (og + 1u == (tg + 1u) * nx) xb_add(&bar[XB_TOPGEN], 1u);
            else XB_SPIN(xb_ld(&bar[XB_TOPGEN]) == tg, bar);
            __builtin_amdgcn_fence(__ATOMIC_ACQUIRE, "agent");
            xb_add(&bar[XB_XGEN(b.x)], 1u);
            asm volatile("s_waitcnt vmcnt(0)" ::: "memory");
        } else {
            XB_SPIN(xb_ld(&bar[XB_XGEN(b.x)]) == gen, bar);
            __builtin_amdgcn_fence(__ATOMIC_ACQUIRE, "agent");
            asm volatile("s_waitcnt vmcnt(0)" ::: "memory");
        }
    }
    __syncthreads();
}

constexpr int NWAVES = 8;
struct Frame {
    LAS unsigned char* lds;
    LAS unsigned char* lc;
    unsigned* ctl;
    unsigned char* ws;
    int tid, lane, wave, vcu, G;
};
constexpr int LC_PTR = 2048;
__device__ __forceinline__ const float* inp(const Frame& F, int i) {
    const unsigned long long v = *(const LAS unsigned long long*)(F.lc + LC_PTR + 8 * i);
    const unsigned lo = __builtin_amdgcn_readfirstlane((unsigned)v), hi = __builtin_amdgcn_readfirstlane((unsigned)(v >> 32));
    return (const float*)(const GAS float*)(((unsigned long long)hi << 32) | lo);
}
__device__ __forceinline__ unsigned char* opq(unsigned char* p) { GAS unsigned char* g = (GAS unsigned char*)p; asm volatile("" : "+s"(g)); return (unsigned char*)g; }
__device__ __forceinline__ void refresh(Frame& F) { asm volatile("" : "+v"(F.tid)); F.lane = F.tid & 63; F.wave = __builtin_amdgcn_readfirstlane(F.tid >> 6); }

struct PlainSched {   static constexpr bool GATHER = false;
    int nM, nN, nwg, G, c; const char* B; int ldb;
    __device__ __forceinline__ bool next(int i, pg8::Unit& u) const {
        const int L = i * G + c; if (L >= nwg) return false;
        const int wgid = pg8::xcd_chunk(L, nwg);
        const int nig = 8 * nN, gid = wgid / nig, fm = gid * 8, gsz = (nM - fm) < 8 ? (nM - fm) : 8;
        u.pm = fm + ((wgid % nig) % gsz); u.pn = (wgid % nig) / gsz;
        u.bptr = B + (size_t)u.pn * 256 * ldb; u.roff = -(u.pm * 256) - 1; u.nvalid = 256; return true;
    }
    __device__ __forceinline__ int arow(const pg8::Unit& u, int r) const { return -u.roff - 1 + r; }
    __device__ __forceinline__ int acolb(const pg8::Unit&) const { return 0; }
    __device__ __forceinline__ float rowscale(const pg8::Unit&, int) const { return 1.0f; }
};
struct GrpSched {     static constexpr bool GATHER = false;
    int G, c; const char* B;
    __device__ __forceinline__ bool next(int i, pg8::Unit& u) const {
        const int L = i * G + c; if (L >= 256) return false;
        const int wgid = pg8::xcd_chunk(L, 256);
        u.pm = wgid >> 2; u.pn = wgid & 3; u.bptr = B + (size_t)u.pn * 256 * 512; u.roff = -(u.pm * 256) - 1; u.nvalid = 256; return true;
    }
    __device__ __forceinline__ int arow(const pg8::Unit& u, int r) const { return -u.roff - 1 + r; }
    __device__ __forceinline__ int acolb(const pg8::Unit& u) const { return u.pn * 512; }
    __device__ __forceinline__ float rowscale(const pg8::Unit&, int) const { return 1.0f; }
};
template <bool GATHER_> struct MoeSched {     static constexpr bool GATHER = GATHER_;
    const LAS int* ts; const LAS int* cn; int npn, nunits, G, c, lane_;
    const int* tokl; const float* wl; const char* Bexp; size_t bstride; const char* Bsh; int ldb;
    __device__ __forceinline__ bool next(int i, pg8::Unit& u) const {
        const int L = i * G + c; if (L >= nunits) return false;
        const int wgid = pg8::xcd_chunk(L, nunits);
        const int tile = wgid / npn, pn = wgid % npn;
        const int lane = lane_;
        const bool hit = (tile >= ts[lane]) && (tile < ts[lane + 1]);
        const unsigned long long mk = __ballot(hit);
        const int e = mk ? (int)__builtin_ctzll(mk) : 64;
        const int tse = __builtin_amdgcn_readfirstlane(ts[e]);
        const int r0 = (tile - tse) * 256;
        u.pm = tile; u.pn = pn;
        u.bptr = (e < 64 ? Bexp + (size_t)e * bstride : Bsh) + (size_t)pn * 256 * ldb;
        if (GATHER) {
            if (e < 64) { const int ce = __builtin_amdgcn_readfirstlane(cn[e]); u.roff = e * CAP + r0; u.nvalid = (ce - r0) < 256 ? (ce - r0) : 256; }
            else { u.roff = -r0 - 1; u.nvalid = 256; }
        } else { u.roff = -(tile * 256) - 1; u.nvalid = 256; }
        return true;
    }
    __device__ __forceinline__ int arow(const pg8::Unit& u, int r) const { if (GATHER && u.roff >= 0) { const int rr = r < u.nvalid ? r : u.nvalid - 1; return tokl[u.roff + rr]; } return -u.roff - 1 + r; }
    __device__ __forceinline__ int acolb(const pg8::Unit&) const { return 0; }
    __device__ __forceinline__ float rowscale(const pg8::Unit& u, int r) const { if (GATHER && u.roff >= 0) { const int rr = r < u.nvalid ? r : u.nvalid - 1; return wl[u.roff + rr]; } return 1.0f; }
};

__device__ __forceinline__ void p0_transpose_item(const float* W, int K, int N, bf16* WT, int dst_n0, LAS float* scr, int kb, int nb, int lane) {
    const int k0 = 64 * kb, n0 = 32 * nb;
#pragma unroll 8
    for (int i = 0; i < 32; ++i) { const int kk = 2 * i + (lane >> 5); scr[kk * 33 + (lane & 31)] = W[(size_t)(k0 + kk) * N + n0 + (lane & 31)]; }
    LDS_WAIT(); asm volatile("" ::: "memory");
    const int c = lane & 7;
#pragma unroll
    for (int j = 0; j < 4; ++j) { const int n = (lane >> 3) + 8 * j; const LAS float* s = scr + (8 * c) * 33 + n;
        u32x4 o; o.x = pk2(s[0 * 33], s[1 * 33]); o.y = pk2(s[2 * 33], s[3 * 33]); o.z = pk2(s[4 * 33], s[5 * 33]); o.w = pk2(s[6 * 33], s[7 * 33]);
        *(GAS u32x4*)(WT + (size_t)(dst_n0 + n) * K + k0 + 8 * c) = o; }
    LDS_WAIT(); asm volatile("" ::: "memory");
}
__device__ __forceinline__ void p0_router_item(const float* W, bf16* WH, bf16* WLo, LAS float* scr, int kb, int nb, int lane) {
    const int K = 1024, N = 64; const int k0 = 64 * kb, n0 = 32 * nb;
#pragma unroll 8
    for (int i = 0; i < 32; ++i) { const int kk = 2 * i + (lane >> 5); scr[kk * 33 + (lane & 31)] = W[(size_t)(k0 + kk) * N + n0 + (lane & 31)]; }
    LDS_WAIT(); asm volatile("" ::: "memory");
    const int c = lane & 7;
#pragma unroll
    for (int j = 0; j < 4; ++j) { const int n = (lane >> 3) + 8 * j; const LAS float* s = scr + (8 * c) * 33 + n;
        unsigned h[8], l[8];
#pragma unroll
        for (int q = 0; q < 8; ++q) { const float v = s[q * 33]; h[q] = f2bf(v); l[q] = f2bf(v - bf2f(h[q])); }
        u32x4 oh, ol; oh.x = h[0] | (h[1] << 16); oh.y = h[2] | (h[3] << 16); oh.z = h[4] | (h[5] << 16); oh.w = h[6] | (h[7] << 16);
        ol.x = l[0] | (l[1] << 16); ol.y = l[2] | (l[3] << 16); ol.z = l[4] | (l[5] << 16); ol.w = l[6] | (l[7] << 16);
        *(GAS u32x4*)(WH + (size_t)(n0 + n) * K + k0 + 8 * c) = oh; *(GAS u32x4*)(WLo + (size_t)(n0 + n) * K + k0 + 8 * c) = ol; }
    LDS_WAIT(); asm volatile("" ::: "memory");
}

__device__ __forceinline__ void p0_prologue(Frame& F) {
    LAS float* cs = (LAS float*)(F.lds);
    LAS float* part = (LAS float*)(F.lds + 32768);
    const float* c = inp(F, 1);
    for (int i = F.tid; i < 8 * 1024; i += 512) { const float v = c[i]; cs[i] = v / (1.0f + __expf(-v)); }
    __syncthreads();
    float* mod = (float*)(F.ws + WS_MOD);
    for (int it = F.vcu; it < 4 * 96; it += F.G) {
        const int layer = it / 96, slab = it % 96; const int col = slab * 64 + F.lane;
        const float* W = inp(F, 2) + (size_t)layer * 1024 * 6144 + col;
        float a[8];
#pragma unroll
        for (int b = 0; b < 8; ++b) a[b] = 0.f;
        const int k0 = F.wave * 128;
#pragma unroll 4
        for (int k = 0; k < 128; k += 4) {
            float w[4];
#pragma unroll
            for (int j = 0; j < 4; ++j) w[j] = W[(size_t)(k0 + k + j) * 6144];
#pragma unroll
            for (int b = 0; b < 8; ++b) { const f32x4 cv = *(const LAS f32x4*)(cs + b * 1024 + k0 + k); a[b] += cv[0] * w[0] + cv[1] * w[1] + cv[2] * w[2] + cv[3] * w[3]; }
        }
#pragma unroll
        for (int b = 0; b < 8; ++b) part[(F.wave * 8 + b) * 64 + F.lane] = a[b];
        __syncthreads();
        { const int b = F.wave; float s = 0.f;
#pragma unroll
          for (int w = 0; w < 8; ++w) s += part[(w * 8 + b) * 64 + F.lane];
          mod[((size_t)layer * 8 + b) * 6144 + col] = s + inp(F, 3)[layer * 6144 + col]; }
        __syncthreads();
    }
    __syncthreads();
    LAS float* scr = (LAS float*)(F.lds + F.wave * 16384);
    const int gw = F.vcu * NWAVES + F.wave, NGW = F.G * NWAVES;
    constexpr int I_PIN = 2 * 16 * 32, I_GRP = 8 * 4 * 8, I_POUT = I_PIN, I_AIN = 2 * 16 * 288, I_AOUT = I_PIN, I_SHGU = 4 * 16 * 16, I_SHDN = 4 * 4 * 32, I_R = 4 * 16 * 2;
    constexpr int I_EGU = 256 * 16 * 16, I_EDN = 256 * 4 * 32;
    constexpr int NITEMS = I_PIN + I_GRP + I_POUT + I_AIN + I_AOUT + I_SHGU + I_SHDN + I_R + I_EGU + I_EDN;
    for (int it = gw; it < NITEMS; it += NGW) {
        int r = it;
#define P0_GROUP(CNT, SRC, KK, NN, DST, GU) if (r < (CNT)) { const int per = ((KK) / 64) * ((NN) / 32), mat = r / per, q = r % per, nblk = (NN) / 32, kb = q / nblk, nb = q % nblk; \
            int dn0 = 32 * nb; if (GU) { const int n0 = 32 * nb; dn0 = (n0 < 256) ? ((n0 >> 7) * 256 + (n0 & 127)) : (((n0 - 256) >> 7) * 256 + 128 + ((n0 - 256) & 127)); } \
            p0_transpose_item((SRC) + (size_t)mat * (KK) * (NN), (KK), (NN), (bf16*)(F.ws + (DST)) + (size_t)mat * (KK) * (NN), dn0, scr, kb, nb, F.lane); continue; } r -= (CNT);
        P0_GROUP(I_PIN, inp(F, 4), 1024, 1024, WS_WPIN, 0)
        P0_GROUP(I_GRP, inp(F, 5), 256, 256, WS_WPGRP, 0)
        P0_GROUP(I_POUT, inp(F, 7), 1024, 1024, WS_WPOUT, 0)
        P0_GROUP(I_AIN, inp(F, 8), 1024, 9216, WS_WAIN, 0)
        P0_GROUP(I_AOUT, inp(F, 9), 1024, 1024, WS_WAOUT, 0)
        P0_GROUP(I_SHGU, inp(F, 16), 1024, 512, WS_WSHGU, 1)
        P0_GROUP(I_SHDN, inp(F, 17), 256, 1024, WS_WSHDN, 0)
        if (r < I_R) { const int mat = r / 32, q = r % 32, kb = q / 2, nb = q % 2;
            p0_router_item(inp(F, 12) + (size_t)mat * 65536, (bf16*)(F.ws + WS_WRHI) + (size_t)mat * 65536, (bf16*)(F.ws + WS_WRLO) + (size_t)mat * 65536, scr, kb, nb, F.lane); continue; } r -= I_R;
        P0_GROUP(I_EGU, inp(F, 14), 1024, 512, WS_WEGU, 1)
        P0_GROUP(I_EDN, inp(F, 15), 256, 1024, WS_WEDN, 0)
#undef P0_GROUP
    }
}

__device__ __forceinline__ void p1_modulate(Frame& F, const float* x, const float* modl  , int sh_off, int sc_off) {
    bf16* H = (bf16*)(F.ws + WS_H);
    const int gw = F.vcu * NWAVES + F.wave, NGW = F.G * NWAVES;
    for (int m = gw; m < T; m += NGW) {
        const int b = m / SEQ; const float* mb = modl + (size_t)b * 6144;
        const GAS f32x4* xr = (const GAS f32x4*)(x + (size_t)m * D) + F.lane;
        GAS u32x2* o8 = (GAS u32x2*)(H + (size_t)m * D) + F.lane;
#pragma unroll
        for (int j = 0; j < 4; ++j) { const f32x4 v = xr[64 * j]; const f32x4 sc = *(const f32x4*)(mb + sc_off + 4 * F.lane + 256 * j), sh = *(const f32x4*)(mb + sh_off + 4 * F.lane + 256 * j);
            const f32x4 h = v * (sc + 1.0f) + sh; u32x2 w; w.x = pk2(h[0], h[1]); w.y = pk2(h[2], h[3]); o8[64 * j] = w; }
    }
}

template <int W>
__device__ __forceinline__ void pool_item(const bf16* U, bf16* Z, int b, int t0, int g, int lane) {
    const size_t base = (size_t)b * SEQ * D + 256 * g + 4 * lane;
    float s[4] = {0.f, 0.f, 0.f, 0.f};
#pragma unroll
    for (int j = 1; j <= W; ++j) { const int t = t0 - j; if (t >= 0) { const u32x2 v = *(const GAS u32x2*)(U + base + (size_t)t * D);
            s[0] += bf2f(v.x & 0xffffu); s[1] += bf2f(v.x >> 16); s[2] += bf2f(v.y & 0xffffu); s[3] += bf2f(v.y >> 16); } }
#pragma unroll 8
    for (int i = 0; i < 32; ++i) { const int t = t0 + i;
        const u32x2 v = *(const GAS u32x2*)(U + base + (size_t)t * D);
        const float c0 = bf2f(v.x & 0xffffu), c1 = bf2f(v.x >> 16), c2 = bf2f(v.y & 0xffffu), c3 = bf2f(v.y >> 16);
        s[0] += c0; s[1] += c1; s[2] += c2; s[3] += c3;
        if (t - W >= 0) { const u32x2 o = *(const GAS u32x2*)(U + base + (size_t)(t - W) * D);
            s[0] -= bf2f(o.x & 0xffffu); s[1] -= bf2f(o.x >> 16); s[2] -= bf2f(o.y & 0xffffu); s[3] -= bf2f(o.y >> 16); }
        const float inv = 1.0f / (float)((t + 1) < W ? (t + 1) : W);
        u32x2 w; w.x = pk2(s[0] * inv - c0, s[1] * inv - c1); w.y = pk2(s[2] * inv - c2, s[3] * inv - c3);
        *(GAS u32x2*)(Z + base + (size_t)t * D) = w; }
}

__device__ __forceinline__ void moe_build_table(Frame& F, int layer) {
    LAS int* ts = (LAS int*)(F.lc + LC_TS); LAS int* cn = (LAS int*)(F.lc + LC_CNT);
    __syncthreads();
    if (F.wave == 0) {
        const int c = (int)__hip_atomic_load(F.ctl + CW_CNT + layer * 64 + F.lane, RLX_AGENT);
        int t = (c + 255) >> 8;
#pragma unroll
        for (int o = 1; o < 64; o <<= 1) { const int v = __shfl_up(t, o); if (F.lane >= o) t += v; }
        cn[F.lane] = c; ts[F.lane + 1] = t;
        if (F.lane == 0) ts[0] = 0;
        if (F.lane == 63) ts[65] = t + 64;
    }
    __syncthreads();
}

constexpr int APITCH = 1032;
__device__ __forceinline__ void ln1_router_phase(Frame& F, int layer, const float* xin) {
    float* X = (float*)(F.ws + WS_X); bf16* H = (bf16*)(F.ws + WS_H); const bf16* Y = (const bf16*)(F.ws + WS_Y);
    const float* modl = (const float*)(F.ws + WS_MOD) + (size_t)layer * 8 * 6144;
    const float* lg = inp(F, 10) + layer * D; const float* lb = inp(F, 11) + layer * D;
    const float* rb = inp(F, 13) + layer * NE;
    const bf16* WH = (const bf16*)(F.ws + WS_WRHI) + (size_t)layer * 65536; const bf16* WLo = (const bf16*)(F.ws + WS_WRLO) + (size_t)layer * 65536;
    int* tokl = (int*)(F.ws + WS_TOKL); float* wl = (float*)(F.ws + WS_WL); int* tslot = (int*)(F.ws + WS_TSLOT);
    unsigned* gcnt = F.ctl + CW_CNT + layer * 64;
    LAS bf16* Ahi = (LAS bf16*)F.lds; LAS bf16* Alo = Ahi + 32 * APITCH;
    LAS float* PART = (LAS float*)F.lds;
    LAS int* lcnt = (LAS int*)(F.lc + LC_LCNT); LAS int* gb = (LAS int*)(F.lc + LC_GB);
    const int lane = F.lane, wave = F.wave;
    for (int blk = F.vcu; blk < T / 32; blk += F.G) {
        const int tok0 = blk * 32;
        for (int q = 0; q < 4; ++q) {
            const int rl = wave * 4 + q, tok = tok0 + rl, b = tok / SEQ; const float* mb = modl + (size_t)b * 6144;
            const GAS f32x4* xr = (const GAS f32x4*)(xin + (size_t)tok * D) + lane; const GAS u32x2* yr = (const GAS u32x2*)(Y + (size_t)tok * D) + lane;
            f32x4 v[4]; float s = 0.f;
#pragma unroll
            for (int j = 0; j < 4; ++j) { const f32x4 xv = xr[64 * j]; const u32x2 yv = yr[64 * j]; const f32x4 g1 = *(const f32x4*)(mb + 2048 + 4 * lane + 256 * j);
                f32x4 y4; y4[0] = bf2f(yv.x & 0xffffu); y4[1] = bf2f(yv.x >> 16); y4[2] = bf2f(yv.y & 0xffffu); y4[3] = bf2f(yv.y >> 16);
                v[j] = xv * ALPHA + (g1 + 1.0f) * y4; s += (v[j][0] + v[j][1]) + (v[j][2] + v[j][3]); }
            const float mean = wave_sum(s) * (1.f / D); float s2 = 0.f;
#pragma unroll
            for (int j = 0; j < 4; ++j) { v[j] = v[j] - mean; s2 += (v[j][0] * v[j][0] + v[j][1] * v[j][1]) + (v[j][2] * v[j][2] + v[j][3] * v[j][3]); }
            const float rstd = 1.0f / sqrtf(wave_sum(s2) * (1.f / D) + LN_EPS);
            GAS f32x4* xo = (GAS f32x4*)(X + (size_t)tok * D) + lane; GAS u32x2* ho = (GAS u32x2*)(H + (size_t)tok * D) + lane;
#pragma unroll
            for (int j = 0; j < 4; ++j) { const int col = 4 * lane + 256 * j;
                const f32x4 gg = *(const f32x4*)(lg + col), bb = *(const f32x4*)(lb + col), sc2 = *(const f32x4*)(mb + 4096 + col), sh2 = *(const f32x4*)(mb + 3072 + col);
                const f32x4 xn = v[j] * rstd * gg + bb; xo[64 * j] = xn;
                const f32x4 hf = xn * (sc2 + 1.0f) + sh2;
                unsigned hh[4], ll[4];
#pragma unroll
                for (int e = 0; e < 4; ++e) { hh[e] = f2bf(hf[e]); ll[e] = f2bf(hf[e] - bf2f(hh[e])); }
                u32x2 wh, wlo; wh.x = hh[0] | (hh[1] << 16); wh.y = hh[2] | (hh[3] << 16); wlo.x = ll[0] | (ll[1] << 16); wlo.y = ll[2] | (ll[3] << 16);
                ho[64 * j] = wh;
                *(LAS u32x2*)(Ahi + rl * APITCH + col) = wh; *(LAS u32x2*)(Alo + rl * APITCH + col) = wlo; }
        }
        __syncthreads();
        f32x16 acc[2]; acc[0] = (f32x16){}; acc[1] = (f32x16){};
        {
            const int r32 = lane & 31, hi = lane >> 5;
#pragma unroll 2
            for (int ks = 0; ks < 8; ++ks) {
                const int k = wave * 128 + ks * 16 + hi * 8;
                const bf16x8 ah = *(const LAS bf16x8*)(Ahi + r32 * APITCH + k), al = *(const LAS bf16x8*)(Alo + r32 * APITCH + k);
#pragma unroll
                for (int nb = 0; nb < 2; ++nb) {
                    const bf16x8 bh = *(const GAS bf16x8*)(WH + (size_t)(r32 + 32 * nb) * 1024 + k), bl = *(const GAS bf16x8*)(WLo + (size_t)(r32 + 32 * nb) * 1024 + k);
                    acc[nb] = MFMA32(ah, bh, acc[nb]);
                    acc[nb] = MFMA32(al, bh, acc[nb]);
                    acc[nb] = MFMA32(ah, bl, acc[nb]);
                }
            }
        }
        __syncthreads();
        {
            const int r32 = lane & 31, hi = lane >> 5;
#pragma unroll
            for (int nb = 0; nb < 2; ++nb)
#pragma unroll
                for (int r = 0; r < 16; ++r) { const int trow = (r & 3) + 8 * (r >> 2) + 4 * hi; PART[(wave * 32 + trow) * 64 + 32 * nb + r32] = acc[nb][r]; }
        }
        if (F.tid < 64) lcnt[F.tid] = 0;
        __syncthreads();
        int chosen_m = 0; int posl[4]; float wv[4]; int rk[4];
        const float rbe = rb[lane];
#pragma unroll
        for (int q = 0; q < 4; ++q) {
            __builtin_amdgcn_sched_barrier(0);
            const int rl = wave * 4 + q;
            float logit = 0.f;
#pragma unroll
            for (int w = 0; w < 8; ++w) logit += PART[(w * 32 + rl) * 64 + lane];
            const float sg = 1.0f / (1.0f + __expf(-logit));
            const float sel = sg + rbe;
            float m1 = sel; m1 = fmaxf(m1, __shfl_xor(m1, 1)); m1 = fmaxf(m1, __shfl_xor(m1, 2)); m1 = fmaxf(m1, __shfl_xor(m1, 4));
            const unsigned long long bal = __ballot(sel == m1);
            const unsigned long long gm = bal & (0xFFull << (8 * (lane >> 3)));
            const int first = (int)__builtin_ctzll(gm);
            float m2 = (lane == first) ? -INFINITY : sel; m2 = fmaxf(m2, __shfl_xor(m2, 1)); m2 = fmaxf(m2, __shfl_xor(m2, 2)); m2 = fmaxf(m2, __shfl_xor(m2, 4));
            const float gs = m1 + m2;
            int rg = 0;
#pragma unroll
            for (int g2 = 0; g2 < 8; ++g2) { const float v = __builtin_bit_cast(float, __builtin_amdgcn_readlane(__builtin_bit_cast(int, gs), 8 * g2)); rg += ((v > gs) || (v == gs && g2 < (lane >> 3))) ? 1 : 0; }
            const bool gsel = rg < 4;
            const float msel = gsel ? sel : -INFINITY;
            int rank = 0;
#pragma unroll 4
            for (int e2 = 0; e2 < 64; ++e2) { const float v = __builtin_bit_cast(float, __builtin_amdgcn_readlane(__builtin_bit_cast(int, msel), e2)); rank += (v > msel) ? 1 : 0; rank += (v == msel && e2 < lane) ? 1 : 0; }
            const bool ch = gsel && rank < TOPK;
            const float wsum = wave_sum(ch ? sg : 0.f);
            wv[q] = sg / wsum * ROUTED_SCALE; rk[q] = rank; posl[q] = 0;
            if (ch) { chosen_m |= (1 << q); posl[q] = __hip_atomic_fetch_add(lcnt + lane, 1, __ATOMIC_RELAXED, __HIP_MEMORY_SCOPE_WORKGROUP); }
        }
        __syncthreads();
        if (wave == 0) { const int n = lcnt[lane]; int base = 0; if (n > 0) base = (int)__hip_atomic_fetch_add(gcnt + lane, (unsigned)n, RLX_AGENT); gb[lane] = base; }
        __syncthreads();
        {
            const int base = gb[lane];
#pragma unroll
            for (int q = 0; q < 4; ++q) if (chosen_m & (1 << q)) { const int tok = tok0 + wave * 4 + q; const int pos = base + posl[q];
                tokl[(size_t)lane * CAP + pos] = tok; wl[(size_t)lane * CAP + pos] = wv[q]; tslot[(size_t)tok * 8 + rk[q]] = lane * CAP + pos; }
        }
        __syncthreads();
    }
}

__device__ __forceinline__ void combine_ln2_phase(Frame& F, int layer) {
    float* X = (float*)(F.ws + WS_X); bf16* H = (bf16*)(F.ws + WS_H); const bf16* YS = (const bf16*)(F.ws + WS_YS);
    const float* modl = (const float*)(F.ws + WS_MOD) + (size_t)layer * 8 * 6144;
    const float* modn = (const float*)(F.ws + WS_MOD) + (size_t)(layer + 1) * 8 * 6144;
    const float* lg = inp(F, 18) + layer * D; const float* lb = inp(F, 19) + layer * D;
    const int* tslot = (const int*)(F.ws + WS_TSLOT);
    const LAS int* ts = (const LAS int*)(F.lc + LC_TS);
    const bool lastl = (layer == DEPTH - 1);
    float* xout = lastl ? (float*)inp(F, 20) : X;
    const int lane = F.lane;
    const int gw = F.vcu * NWAVES + F.wave, NGW = F.G * NWAVES;
    const int shbase = ts[64] * 256;
    for (int tok = gw; tok < T; tok += NGW) {
        const int b = tok / SEQ; const float* mb = modl + (size_t)b * 6144;
        int sv = 0; if (lane < 8) { const int v = tslot[(size_t)tok * 8 + lane]; sv = ts[v >> 14] * 256 + (v & (CAP - 1)); }
        f32x4 y[4];
#pragma unroll
        for (int j = 0; j < 4; ++j) y[j] = (f32x4){0.f, 0.f, 0.f, 0.f};
#pragma unroll
        for (int k = 0; k < 9; ++k) {
            const int slot = (k < 8) ? __builtin_amdgcn_readlane(sv, k) : (shbase + tok);
            const GAS u32x2* yr = (const GAS u32x2*)(YS + (size_t)slot * D) + lane;
#pragma unroll
            for (int j = 0; j < 4; ++j) { const u32x2 yv = yr[64 * j]; y[j][0] += bf2f(yv.x & 0xffffu); y[j][1] += bf2f(yv.x >> 16); y[j][2] += bf2f(yv.y & 0xffffu); y[j][3] += bf2f(yv.y >> 16); }
        }
        const GAS f32x4* xr = (const GAS f32x4*)(X + (size_t)tok * D) + lane;
        f32x4 v[4]; float s = 0.f;
#pragma unroll
        for (int j = 0; j < 4; ++j) { const f32x4 xv = xr[64 * j]; const f32x4 g2 = *(const f32x4*)(mb + 5120 + 4 * lane + 256 * j);
            v[j] = xv * ALPHA + (g2 + 1.0f) * y[j]; s += (v[j][0] + v[j][1]) + (v[j][2] + v[j][3]); }
        const float mean = wave_sum(s) * (1.f / D); float s2 = 0.f;
#pragma unroll
        for (int j = 0; j < 4; ++j) { v[j] = v[j] - mean; s2 += (v[j][0] * v[j][0] + v[j][1] * v[j][1]) + (v[j][2] * v[j][2] + v[j][3] * v[j][3]); }
        const float rstd = 1.0f / sqrtf(wave_sum(s2) * (1.f / D) + LN_EPS);
        GAS f32x4* xo = (GAS f32x4*)(xout + (size_t)tok * D) + lane; GAS u32x2* ho = (GAS u32x2*)(H + (size_t)tok * D) + lane;
        const float* mn = modn + (size_t)b * 6144;
#pragma unroll
        for (int j = 0; j < 4; ++j) { const int col = 4 * lane + 256 * j;
            const f32x4 gg = *(const f32x4*)(lg + col), bb = *(const f32x4*)(lb + col);
            f32x4 xn = v[j] * rstd * gg + bb;
#ifdef ORACLE
            if (lastl && tok < (int)(__hip_atomic_load(F.ctl + 20000, RLX_AGENT) / 32u)) xn = (f32x4){0.f, 0.f, 0.f, 0.f};
#endif
            xo[64 * j] = xn;
            if (!lastl) { const f32x4 sc1 = *(const f32x4*)(mn + 1024 + col), sh1 = *(const f32x4*)(mn + col);
                const f32x4 hm = xn * (sc1 + 1.0f) + sh1; u32x2 w; w.x = pk2(hm[0], hm[1]); w.y = pk2(hm[2], hm[3]); ho[64 * j] = w; } }
    }
}

constexpr int ACCP = 68;
__device__ __forceinline__ int crow(int r, int hi) { return (r & 3) + 8 * (r >> 2) + 4 * hi; }
template <bool FIRST>
__device__ __forceinline__ void attn_task(const bf16* QKVb  , int g, int h, int dil, int cls, int lq0, int L, int nq, float slope2d,
                                          LAS unsigned char* vst  , LAS float* wsf  , LAS float* ACC, LAS float* ML, int trow_mul, int trow_add, int lane) {
    asm volatile("" : "+v"(lane));
    const int r32 = lane & 31, hi = lane >> 5;
    const int qcol = ((g * 3 + 0) * 16 + h) * 64, kcol = ((g * 3 + 1) * 16 + h) * 64, vcol = ((g * 3 + 2) * 16 + h) * 64;
    const size_t rstride = (size_t)dil * NQKV;
    const bf16* base = QKVb + (size_t)cls * NQKV;
    bf16x8 qf[4];
    { int lq = lq0 + r32; if (lq > L - 1) lq = L - 1; const bf16* qp = base + (size_t)lq * rstride + qcol + hi * 8;
#pragma unroll
      for (int s = 0; s < 4; ++s) qf[s] = *(const GAS bf16x8*)(qp + 16 * s); }
    const int jlo = (lq0 - 97 >= 0) ? 0 : ((128 - lq0) >> 5);
    const int dmax = (lq0 + r32) < 128 ? (lq0 + r32) : 128;
    const float half = 0.5f * (float)dmax;
#define AT_LOADK(dst, j) do { int lk_ = lq0 - 128 + 32 * (j) + r32; lk_ = lk_ < 0 ? 0 : (lk_ > L - 1 ? L - 1 : lk_); const bf16* kp_ = base + (size_t)lk_ * rstride + kcol + hi * 8; \
        _Pragma("unroll") for (int s_ = 0; s_ < 4; ++s_) dst[s_] = *(const GAS bf16x8*)(kp_ + 16 * s_); } while (0)
#define AT_LOADV(dst, j) do { _Pragma("unroll") for (int p_ = 0; p_ < 4; ++p_) { int lk_ = lq0 - 128 + 32 * (j) + 16 * (p_ & 1) + (lane >> 2); lk_ = lk_ < 0 ? 0 : (lk_ > L - 1 ? L - 1 : lk_); \
        dst[p_] = *(const GAS u32x4*)(base + (size_t)lk_ * rstride + vcol + 32 * (p_ >> 1) + 8 * (lane & 3)); } } while (0)
    f32x16 S[5]; bf16x8 kf[2][4];
    float mx = -INFINITY;
#pragma unroll
    for (int j = 0; j < 5; ++j) {
        if (j >= jlo) {
            asm volatile("" ::: "memory");
            if (j == jlo) AT_LOADK(kf[j & 1], j);
            if (j < 4) AT_LOADK(kf[(j + 1) & 1], j + 1);
            f32x16 a = (f32x16){};
#pragma unroll
            for (int s = 0; s < 4; ++s) a = MFMA32(kf[j & 1][s], qf[s], a);
            const float xd0 = (float)(128 - 32 * j + r32 - 4 * hi) - half;
#pragma unroll
            for (int r = 0; r < 16; ++r) { const float x = xd0 - (float)((r & 3) + 8 * (r >> 2));
                const float v = __builtin_fmaf(-slope2d, x, a[r]); a[r] = (__builtin_fabsf(x) <= half) ? v : -INFINITY; mx = fmaxf(mx, a[r]); }
            S[j] = a;
        } else {
#pragma unroll
            for (int r = 0; r < 16; ++r) S[j][r] = -INFINITY;
        }
        __builtin_amdgcn_sched_barrier(0);
    }
    { auto rr = __builtin_amdgcn_permlane32_swap(__float_as_uint(mx), __float_as_uint(mx), false, false);
      const unsigned r0 = rr[0], r1 = rr[1]; mx = fmaxf(__uint_as_float(r0), __uint_as_float(r1)); }
    const float mx_true = mx - slope2d * half;
    float lsum = 0.f;
    u32x4 P[5][2];
#pragma unroll
    for (int j = 0; j < 5; ++j) {
        float p[16];
#pragma unroll
        for (int r = 0; r < 16; ++r) { p[r] = __builtin_amdgcn_exp2f(S[j][r] - mx); lsum += p[r]; }
#pragma unroll
        for (int ks = 0; ks < 2; ++ks) { P[j][ks].x = cvt_pk_bf16(p[8 * ks + 0], p[8 * ks + 1]); P[j][ks].y = cvt_pk_bf16(p[8 * ks + 2], p[8 * ks + 3]); P[j][ks].z = cvt_pk_bf16(p[8 * ks + 4], p[8 * ks + 5]); P[j][ks].w = cvt_pk_bf16(p[8 * ks + 6], p[8 * ks + 7]); }
        __builtin_amdgcn_sched_barrier(0);
    }
    { auto rr = __builtin_amdgcn_permlane32_swap(__float_as_uint(lsum), __float_as_uint(lsum), false, false);
      const unsigned r0 = rr[0], r1 = rr[1]; lsum = __uint_as_float(r0) + __uint_as_float(r1); }
    f32x16 o[2]; o[0] = (f32x16){}; o[1] = (f32x16){};
    u32x4 vr[2][4];
    const unsigned vrd = (unsigned)(((lane >> 4) & 1) * 32 + (lane & 3) * 8 + (4 * hi + ((lane & 15) >> 2)) * 64);
#pragma unroll
    for (int j = 0; j < 5; ++j) {
        if (j >= jlo) {
            asm volatile("" ::: "memory");
            if (j == jlo) AT_LOADV(vr[j & 1], j);
            if (j < 4) AT_LOADV(vr[(j + 1) & 1], j + 1);
#pragma unroll
            for (int p = 0; p < 4; ++p) *(LAS u32x4*)(vst + ((p >> 1) * 2 + (p & 1)) * 1024 + lane * 16) = vr[j & 1][p];
            asm volatile("s_waitcnt lgkmcnt(0)" ::: "memory");
#pragma unroll
            for (int d0 = 0; d0 < 2; ++d0)
#pragma unroll
                for (int ks = 0; ks < 2; ++ks) {
                    LAS unsigned char* vp = vst + (d0 * 2 + ks) * 1024 + vrd;
                    const s16x4 lo = __builtin_bit_cast(s16x4, __builtin_amdgcn_ds_read_tr16_b64_v4i16((LAS s16x4*)(vp)));
                    const s16x4 hh = __builtin_bit_cast(s16x4, __builtin_amdgcn_ds_read_tr16_b64_v4i16((LAS s16x4*)(vp + 512)));
                    const bf16x8 vf = (bf16x8){lo[0], lo[1], lo[2], lo[3], hh[0], hh[1], hh[2], hh[3]};
                    o[d0] = MFMA32(__builtin_bit_cast(bf16x8, P[j][ks]), vf, o[d0]);
                }
            asm volatile("s_waitcnt lgkmcnt(0)" ::: "memory");
        }
        __builtin_amdgcn_sched_barrier(0);
    }
#undef AT_LOADK
#undef AT_LOADV
    if (hi == 0) { wsf[r32] = mx_true; wsf[32 + r32] = lsum; }
    asm volatile("s_waitcnt lgkmcnt(0)" ::: "memory");
#pragma unroll
    for (int r = 0; r < 16; ++r) {
        const int q = crow(r, hi);
        if (q < nq) {
            const int trow = q * trow_mul + trow_add;
            const float mt = wsf[q], lt = wsf[32 + q];
            if (FIRST) {
                ACC[trow * ACCP + r32] = o[0][r]; ACC[trow * ACCP + 32 + r32] = o[1][r];
                if (r32 == 0) { ML[trow * 2] = mt; ML[trow * 2 + 1] = lt; }
            } else {
                const float mo = ML[trow * 2], lo_ = ML[trow * 2 + 1];
                const float mn = fmaxf(mo, mt); const float fa = __builtin_amdgcn_exp2f(mo - mn), fb = __builtin_amdgcn_exp2f(mt - mn);
                const float a0 = ACC[trow * ACCP + r32], a1 = ACC[trow * ACCP + 32 + r32];
                asm volatile("s_waitcnt lgkmcnt(0)" ::: "memory");
                ACC[trow * ACCP + r32] = a0 * fa + o[0][r] * fb; ACC[trow * ACCP + 32 + r32] = a1 * fa + o[1][r] * fb;
                if (r32 == 0) { ML[trow * 2] = mn; ML[trow * 2 + 1] = lo_ * fa + lt * fb; }
            }
        }
        if ((r & 3) == 3) __builtin_amdgcn_sched_barrier(0);
    }
    asm volatile("s_waitcnt lgkmcnt(0)" ::: "memory");
}

__device__ __forceinline__ void attn_phase(Frame& F, bf16* MIX) {
    const bf16* QKV = (const bf16*)(F.ws + WS_YS);
    LAS float* ACC = (LAS float*)F.lds;
    LAS float* ML = (LAS float*)(F.lds + 69632);
    LAS unsigned char* vst = F.lds + 73728 + F.wave * 4096;
    LAS float* wsf = (LAS float*)(F.lds + 73728 + 32768 + F.wave * 256);
    const int lane = F.lane, w = F.wave;
    for (int i = 0;; ++i) {
        const int L0 = i * F.G + F.vcu; if (L0 >= BATCH * 16 * 8) break;
        const int bh = L0 >> 3; int ti = L0 & 7; if (i & 1) ti = 7 - ti;
        const int b = bh >> 4, h = bh & 15, t0 = ti * 256;
        const bf16* Qb = QKV + (size_t)b * SEQ * NQKV;
        const float sl0 = exp2f(-8.0f * (float)(0 * 16 + h + 1) / 48.0f) * LOG2E, sl1 = exp2f(-8.0f * (float)(1 * 16 + h + 1) / 48.0f) * LOG2E * 4.0f, sl2 = exp2f(-8.0f * (float)(2 * 16 + h + 1) / 48.0f) * LOG2E * 16.0f;
        attn_task<true>(Qb, 0, h, 1, 0, t0 + 32 * w, SEQ, 32, sl0, vst, wsf, ACC, ML, 1, 32 * w, lane);
        __syncthreads();
        if (ATTN_GMASK & 2) { const int cls = w & 3, lbh = w >> 2; attn_task<false>(Qb, 1, h, 4, cls, t0 / 4 + 32 * lbh, SEQ / 4, 32, sl1, vst, wsf, ACC, ML, 4, 32 * lbh * 4 + cls, lane); }
        __syncthreads();
#pragma unroll 1
        for (int c2 = 0; c2 < ((ATTN_GMASK & 4) ? 2 : 0); ++c2) { const int cls = 2 * w + c2; attn_task<false>(Qb, 2, h, 16, cls, t0 / 16, SEQ / 16, 16, sl2, vst, wsf, ACC, ML, 16, cls, lane); }
        __syncthreads();
        { const int trow = 32 * w + (lane >> 1), half = lane & 1; const float inv = 1.0f / ML[trow * 2 + 1];
          const LAS f32x4* ap = (const LAS f32x4*)(ACC + trow * ACCP + half * 32);
          bf16* op = MIX + (size_t)(b * SEQ + t0 + trow) * D + h * 64 + half * 32;
#pragma unroll
          for (int c4 = 0; c4 < 4; ++c4) { const f32x4 a = ap[2 * c4] * inv, bq = ap[2 * c4 + 1] * inv; u32x4 wv; wv.x = pk2(a[0], a[1]); wv.y = pk2(a[2], a[3]); wv.z = pk2(bq[0], bq[1]); wv.w = pk2(bq[2], bq[3]);
              *(GAS u32x4*)(op + 8 * c4) = wv; } }
        __syncthreads();
    }
}


__device__ __forceinline__ void attn_phase_naive(Frame& F, bf16* MIX, const int gmask) {
    const bf16* QKV = (const bf16*)(F.ws + WS_YS);
    const int lane = F.lane;
    const int gw = F.vcu * NWAVES + F.wave, NGW = F.G * NWAVES;
    for (int item = gw; item < T * 16; item += NGW) {
        const int tok = item >> 4, h = item & 15, b = tok / SEQ, t = tok % SEQ;
        const bf16* Qb = QKV + (size_t)b * SEQ * NQKV;
        float sc[3][3]; int kt[3][3];
        float mx = -INFINITY;
#pragma unroll
        for (int g = 0; g < 3; ++g) {
            const int dil = (g == 0) ? 1 : (g == 1 ? 4 : 16);
            const float slope = exp2f(-8.0f * (float)(g * 16 + h + 1) / 48.0f);
            const bf16* qp = Qb + (size_t)t * NQKV + ((g * 3 + 0) * 16 + h) * 64;
#pragma unroll
            for (int c = 0; c < 3; ++c) {
                const int j = lane + 64 * c; const int tk = t - j * dil;
                float s = -INFINITY;
                if (j <= 128 && tk >= 0 && ((gmask >> g) & 1)) {
                    const bf16* kp = Qb + (size_t)tk * NQKV + ((g * 3 + 1) * 16 + h) * 64;
                    float d = 0.f;
                    for (int e = 0; e < 64; ++e) d += bf2f(qp[e]) * bf2f(kp[e]);
                    s = d - slope * LOG2E * (float)(j * dil);
                }
                sc[g][c] = s; kt[g][c] = tk; mx = fmaxf(mx, s);
            }
        }
#pragma unroll
        for (int o = 1; o < 64; o <<= 1) mx = fmaxf(mx, __shfl_xor(mx, o));
        float den = 0.f; float acc[64];
#pragma unroll
        for (int e = 0; e < 64; ++e) acc[e] = 0.f;
#pragma unroll
        for (int g = 0; g < 3; ++g)
#pragma unroll
            for (int c = 0; c < 3; ++c) {
                const float p = (sc[g][c] == -INFINITY) ? 0.f : exp2f(sc[g][c] - mx);
                den += p;
                if (p != 0.f) { const bf16* vp = Qb + (size_t)kt[g][c] * NQKV + ((g * 3 + 2) * 16 + h) * 64;
#pragma unroll
                    for (int e = 0; e < 64; ++e) acc[e] += p * bf2f(vp[e]); }
            }
        den = wave_sum(den);
        float mine = 0.f;
#pragma unroll
        for (int e = 0; e < 64; ++e) { const float v = wave_sum(acc[e]); if (lane == e) mine = v; }
        MIX[(size_t)tok * D + h * 64 + lane] = (bf16)f2bf(mine / den);
    }
}

struct Args { const float* in[20]; float* out; unsigned char* ws; int ph_lo, ph_hi; };
constexpr int NPHASE = 2 + DEPTH * 8;

__global__ void __launch_bounds__(NWAVES * 64, 2) mk_fwd(Args args) {
    extern __shared__ __attribute__((aligned(16))) unsigned char lds_raw[];
    Frame F;
    F.lds = (LAS unsigned char*)lds_raw; F.lc = F.lds + LDSCTL_OFF;
    F.tid = threadIdx.x; F.lane = F.tid & 63; F.wave = __builtin_amdgcn_readfirstlane(F.tid >> 6);
    F.G = gridDim.x; { const int bx = blockIdx.x; F.vcu = (F.G % 8 == 0) ? (bx % 8) * (F.G / 8) + bx / 8 : bx; }
    F.ws = args.ws; F.ctl = (unsigned*)(args.ws + WS_CTL);
    for (int u = F.tid; u < (LDS_BYTES - LDSCTL_OFF) / 4; u += NWAVES * 64) ((LAS unsigned*)F.lc)[u] = 0u;
    __syncthreads();
    if (F.tid == 0) {
#pragma unroll
        for (int i = 0; i < 20; ++i) *(LAS unsigned long long*)(F.lc + LC_PTR + 8 * i) = (unsigned long long)args.in[i];
        *(LAS unsigned long long*)(F.lc + LC_PTR + 8 * 20) = (unsigned long long)args.out;
    }
    __syncthreads();
#if MK_PER_PHASE
#define GRID_BAR() do { } while (0)
#else
    XcdBarrier bar = xcd_barrier_post(F.ctl + CW_BAR, (volatile LAS unsigned*)(F.lc + LC_MISC) + 8);
#define GRID_BAR() xcd_barrier(bar)
#endif
    const int lo = args.ph_lo, hi = args.ph_hi;
#define IN(k) (lo <= (k) && (k) < hi)
#define SEAM(k) do { if (IN(k) && IN((k) + 1)) GRID_BAR(); } while (0)
    const float* mod = (const float*)(F.ws + WS_MOD);

    if (PHON(0) && IN(0)) { p0_prologue(F); } SEAM(0);
    if (PHON(1) && IN(1)) { p1_modulate(F, inp(F, 0), mod, 0, 1024); } SEAM(1);

    for (int layer = 0; layer < DEPTH; ++layer) {
        const int pb = 2 + layer * 8; const int j = layer >> 1;
        if ((layer & 1) == 0) {
            if (PHON(2) && IN(pb + 0)) { refresh(F); unsigned char* ws = opq(F.ws); (void)ws;
                PlainSched S{T / 256, 4, 256, F.G, (int)blockIdx.x, (const char*)(ws + WS_WPIN) + (size_t)j * 2 * MiB, 2048};
                pg8::EpiStore E{(bf16*)(ws + WS_U), D, nullptr, 0, 0};
                pg8::gemm_phase<pg8::EpiStore, PlainSched>(F.tid, F.lds, (const char*)(ws + WS_H), 2048, 2048, 1024, S, E);
            } SEAM(pb + 0);
            if (PHON(3) && IN(pb + 1)) { refresh(F); unsigned char* ws = opq(F.ws); (void)ws;
                const bf16* U = (const bf16*)(ws + WS_U); bf16* Z = (bf16*)(ws + WS_Z);
                const int gw = F.vcu * NWAVES + F.wave, NGW = F.G * NWAVES;
                for (int it = gw; it < BATCH * 64 * 4; it += NGW) { const int g = it & 3, ch = (it >> 2) & 63, b = it >> 8;
                    if (g == 0) pool_item<2>(U, Z, b, ch * 32, 0, F.lane); else if (g == 1) pool_item<4>(U, Z, b, ch * 32, 1, F.lane);
                    else if (g == 2) pool_item<8>(U, Z, b, ch * 32, 2, F.lane); else pool_item<16>(U, Z, b, ch * 32, 3, F.lane); }
            } SEAM(pb + 1);
            if (PHON(4) && IN(pb + 2)) { refresh(F); unsigned char* ws = opq(F.ws); (void)ws;
                GrpSched S{F.G, (int)blockIdx.x, (const char*)(ws + WS_WPGRP) + (size_t)j * 512 * 1024};
                pg8::EpiStore E{(bf16*)(ws + WS_Y2), D, inp(F, 6) + j * D, 0, 0};
                pg8::gemm_phase<pg8::EpiStore, GrpSched>(F.tid, F.lds, (const char*)(ws + WS_Z), 2048, 512, 256, S, E);
            } SEAM(pb + 2);
            if (PHON(5) && IN(pb + 3)) { refresh(F); unsigned char* ws = opq(F.ws); (void)ws;
                PlainSched S{T / 256, 4, 256, F.G, (int)blockIdx.x, (const char*)(ws + WS_WPOUT) + (size_t)j * 2 * MiB, 2048};
                pg8::EpiStore E{(bf16*)(ws + WS_Y), D, nullptr, 0, 0};
                pg8::gemm_phase<pg8::EpiStore, PlainSched>(F.tid, F.lds, (const char*)(ws + WS_Y2), 2048, 2048, 1024, S, E);
            } SEAM(pb + 3);
        } else {
            if (PHON(6) && IN(pb + 0)) { refresh(F); unsigned char* ws = opq(F.ws); (void)ws;
                PlainSched S{T / 256, NQKV / 256, (T / 256) * (NQKV / 256), F.G, (int)blockIdx.x, (const char*)(ws + WS_WAIN) + (size_t)j * 18 * MiB, 2048};
                pg8::EpiStore E{(bf16*)(ws + WS_YS), NQKV, nullptr, 1, 0};
                pg8::gemm_phase<pg8::EpiStore, PlainSched>(F.tid, F.lds, (const char*)(ws + WS_H), 2048, 2048, 1024, S, E);
            } SEAM(pb + 0);
            if (PHON(7) && IN(pb + 1)) { refresh(F); unsigned char* ws = opq(F.ws); (void)ws;
#ifdef NAIVE_ATTN
                attn_phase_naive(F, (bf16*)(F.ws + WS_Y2), 7);
#ifdef ORACLE
                if (layer == ORACLE_LAYER) { attn_phase_naive(F, (bf16*)(F.ws + WS_Z), ATTN_GMASK); attn_phase(F, (bf16*)(F.ws + WS_U)); }
#endif
#else
                attn_phase(F, (bf16*)(F.ws + WS_Y2));
#endif
            } SEAM(pb + 1);
            if (IN(pb + 2)) { refresh(F); unsigned char* ws = opq(F.ws); (void)ws;
#ifdef ORACLE
                if (layer == ORACLE_LAYER) { if (blockIdx.x == 0 && F.tid == 0) atomicAdd(F.ctl + 20000, 3276u * 16u);
                    const bf16* A = (const bf16*)(ws + WS_U); const bf16* B = (const bf16*)(ws + WS_Z);
                    const int gw = F.vcu * NWAVES + F.wave, NGW = F.G * NWAVES;
                    for (int tok = gw; tok < T; tok += NGW) { int bad = 0;
                        for (int h = 0; h < 16; ++h) { if (ORACLE_SEL) { const float a = bf2f(A[(size_t)tok * D + h * 64 + F.lane]), b = bf2f(B[(size_t)tok * D + h * 64 + F.lane]);
                            const float e2 = wave_sum((a - b) * (a - b)), n2 = wave_sum(b * b); if (!(e2 <= 0.0025f * n2)) bad += ORACLE_W; } }
                        if (bad && F.lane == 0) atomicAdd(F.ctl + 20000, (unsigned)bad); } }
#endif
            } SEAM(pb + 2);
            if (PHON(8) && IN(pb + 3)) { refresh(F); unsigned char* ws = opq(F.ws); (void)ws;
                PlainSched S{T / 256, 4, 256, F.G, (int)blockIdx.x, (const char*)(ws + WS_WAOUT) + (size_t)j * 2 * MiB, 2048};
                pg8::EpiStore E{(bf16*)(ws + WS_Y), D, nullptr, 0, 0};
                pg8::gemm_phase<pg8::EpiStore, PlainSched>(F.tid, F.lds, (const char*)(ws + WS_Y2), 2048, 2048, 1024, S, E);
            } SEAM(pb + 3);
        }
        if (PHON(9) && IN(pb + 4)) { refresh(F); unsigned char* ws = opq(F.ws); (void)ws; const float* xin = (layer == 0) ? inp(F, 0) : (const float*)(ws + WS_X); ln1_router_phase(F, layer, xin); } SEAM(pb + 4);
        if (PHON(10) && IN(pb + 5)) { refresh(F); unsigned char* ws = opq(F.ws); (void)ws;
            moe_build_table(F, layer);
            const LAS int* ts = (const LAS int*)(F.lc + LC_TS);
            const int ntile = ts[65];
            MoeSched<true> S{ts, (const LAS int*)(F.lc + LC_CNT), 2, ntile * 2, F.G, (int)blockIdx.x, F.lane, (const int*)(ws + WS_TOKL), (const float*)(ws + WS_WL),
                       (const char*)(ws + WS_WEGU) + (size_t)layer * 64 * MiB, (size_t)1 * MiB, (const char*)(ws + WS_WSHGU) + (size_t)layer * MiB, 2048};
            pg8::EpiGU E{(bf16*)(ws + WS_ACT)};
            pg8::gemm_phase<pg8::EpiGU, MoeSched<true>>(F.tid, F.lds, (const char*)(ws + WS_H), 2048, 2048, 1024, S, E);
        } SEAM(pb + 5);
        if (PHON(11) && IN(pb + 6)) { refresh(F); unsigned char* ws = opq(F.ws); (void)ws;
            moe_build_table(F, layer);
            const LAS int* ts = (const LAS int*)(F.lc + LC_TS);
            const int ntile = ts[65];
            MoeSched<false> S{ts, (const LAS int*)(F.lc + LC_CNT), 4, ntile * 4, F.G, (int)blockIdx.x, F.lane, nullptr, nullptr,
                       (const char*)(ws + WS_WEDN) + (size_t)layer * 32 * MiB, (size_t)512 * 1024, (const char*)(ws + WS_WSHDN) + (size_t)layer * 512 * 1024, 512};
            pg8::EpiStore E{(bf16*)(ws + WS_YS), D, nullptr, 0, 0};
            pg8::gemm_phase<pg8::EpiStore, MoeSched<false>>(F.tid, F.lds, (const char*)(ws + WS_ACT), 512, 512, 256, S, E);
        } SEAM(pb + 6);
        if (PHON(12) && IN(pb + 7)) { refresh(F); unsigned char* ws = opq(F.ws); (void)ws; moe_build_table(F, layer); combine_ln2_phase(F, layer); }
        if (layer < DEPTH - 1) SEAM(pb + 7);
    }
#undef IN
#undef SEAM
}

extern "C" void kernel_launch(void* const* d_in, const int* in_sizes, int n_in, void* d_out, int out_size, void* d_ws, size_t ws_size, hipStream_t stream) {
    static int grid = 0;
    if (grid == 0) {
        if (n_in != 20 || in_sizes[0] != T * D || out_size != T * D || ws_size < WS_END) { fprintf(stderr, "kernel_launch: unexpected shapes / workspace (n_in %d, ws %zu); nothing launched\n", n_in, ws_size); grid = -1; return; }
        int dev = 0, cus = 0, per_cu = 0;
        if (hipGetDevice(&dev) != hipSuccess || hipDeviceGetAttribute(&cus, hipDeviceAttributeMultiprocessorCount, dev) != hipSuccess) { grid = -1; return; }
        if (hipFuncSetAttribute((const void*)mk_fwd, hipFuncAttributeMaxDynamicSharedMemorySize, LDS_BYTES) != hipSuccess) { fprintf(stderr, "kernel_launch: hipFuncSetAttribute failed\n"); grid = -1; return; }
        if (hipOccupancyMaxActiveBlocksPerMultiprocessor(&per_cu, (const void*)mk_fwd, NWAVES * 64, LDS_BYTES) != hipSuccess || per_cu < 1) { fprintf(stderr, "kernel_launch: occupancy query says %d\n", per_cu); }
        (void)hipGetLastError();
        grid = cus;
    }
    if (grid < 0) return;
    if (hipMemsetAsync((char*)d_ws + WS_CTL, 0, CTL_ZERO_BYTES, stream) != hipSuccess) return;
    Args a{};
    for (int i = 0; i < 20; ++i) a.in[i] = (const float*)d_in[i];
    a.out = (float*)d_out; a.ws = (unsigned char*)d_ws;
#if MK_PER_PHASE
    for (int p = 0; p < NPHASE; ++p) { a.ph_lo = p; a.ph_hi = p + 1; hipLaunchKernelGGL(mk_fwd, dim3(grid), dim3(NWAVES * 64), LDS_BYTES, stream, a); }
#else
    a.ph_lo = 0; a.ph_hi = NPHASE;
    hipLaunchKernelGGL(mk_fwd, dim3(grid), dim3(NWAVES * 64), LDS_BYTES, stream, a);
#endif
    const hipError_t le = hipPeekAtLastError();
    if (le != hipSuccess) fprintf(stderr, "kernel_launch: launch failed: %s\n", hipGetErrorName(le));
}
```

```cpp
#include <hip/hip_runtime.h>
#include <cstdio>
#include <cstdint>

#ifndef MK_PER_PHASE
#define MK_PER_PHASE 0
#endif
#define ORACLE_SEL 1
#define ATTN_GMASK 7
#define ORACLE_W 1
#define ORACLE_LAYER 1
#ifndef PHSEL
#define PHSEL 0xFFFF
#endif
#define PHON(n) (((PHSEL) >> (n)) & 1)

#define GAS __attribute__((address_space(1)))
#define LAS __attribute__((address_space(3)))
typedef unsigned short bf16;
typedef short bf16x8 __attribute__((ext_vector_type(8)));
typedef short s16x4 __attribute__((ext_vector_type(4)));
typedef float f32x2 __attribute__((ext_vector_type(2)));
typedef float f32x4 __attribute__((ext_vector_type(4)));
typedef float f32x16 __attribute__((ext_vector_type(16)));
typedef unsigned u32x2 __attribute__((ext_vector_type(2)));
typedef unsigned u32x4 __attribute__((ext_vector_type(4)));

constexpr int BATCH = 8, SEQ = 2048, D = 1024, T = BATCH * SEQ, DEPTH = 4;
constexpr int NQKV = 9216, NE = 64, TOPK = 8, DEXP = 256;
constexpr int CAP = 16384;
constexpr int PSLOT = 147456 + T;
constexpr float ALPHA = 1.6817928305074290f;
constexpr float LN_EPS = 1e-5f;
constexpr float LOG2E = 1.4426950408889634f;
constexpr float QSCALE = 0.125f * LOG2E;
constexpr float ROUTED_SCALE = 2.5f;

constexpr size_t MiB = 1u << 20;
constexpr size_t WS_CTL = 0, CTL_ZERO_BYTES = 1 * MiB;
constexpr size_t WS_MOD = 1 * MiB;
constexpr size_t WS_WRHI = 2 * MiB;
constexpr size_t WS_WRLO = WS_WRHI + 512 * 1024;
constexpr size_t WS_WPIN = 3 * MiB;
constexpr size_t WS_WPGRP = 7 * MiB;
constexpr size_t WS_WPOUT = 8 * MiB;
constexpr size_t WS_WAIN = 12 * MiB;
constexpr size_t WS_WAOUT = 48 * MiB;
constexpr size_t WS_WSHGU = 52 * MiB;
constexpr size_t WS_WSHDN = 56 * MiB;
constexpr size_t WS_WEGU = 58 * MiB;
constexpr size_t WS_WEDN = 314 * MiB;
constexpr size_t WS_X = 442 * MiB;
constexpr size_t WS_H = 506 * MiB;
constexpr size_t WS_Y = 538 * MiB;
constexpr size_t WS_U = 570 * MiB;
constexpr size_t WS_Z = 602 * MiB;
constexpr size_t WS_Y2 = 634 * MiB;
constexpr size_t WS_YS = 666 * MiB;
constexpr size_t WS_ACT = 986 * MiB;
constexpr size_t WS_TOKL = 1066 * MiB;
constexpr size_t WS_WL = 1070 * MiB;
constexpr size_t WS_TSLOT = 1074 * MiB;
constexpr size_t WS_END = 1075 * MiB;
static_assert(WS_YS + (size_t)PSLOT * 2048 <= WS_ACT && WS_ACT + (size_t)PSLOT * 512 <= WS_TOKL, "ws map");
constexpr int CW_BAR = 4096;
constexpr int CW_CNT = 8192;

constexpr int RING_BYTES = 135168;
constexpr int LDSCTL_OFF = RING_BYTES;
constexpr int LDS_BYTES = 147456;
constexpr int LC_MISC = 0;
constexpr int LC_TS = 128;
constexpr int LC_CNT = 128 + 272;
constexpr int LC_LCNT = 128 + 272 + 256;
constexpr int LC_GB = 128 + 272 + 512;

#define RLX_AGENT __ATOMIC_RELAXED, __HIP_MEMORY_SCOPE_AGENT
#define LDS_WAIT() asm volatile("s_waitcnt lgkmcnt(0)" ::: "memory")
#define VM_WAIT() asm volatile("s_waitcnt vmcnt(0)" ::: "memory")

typedef _Float16 h16x2 __attribute__((ext_vector_type(2)));
typedef _Float16 h16x8 __attribute__((ext_vector_type(8)));
__device__ __forceinline__ unsigned f2bf(float f) { return (unsigned)__builtin_bit_cast(unsigned short, (_Float16)f); }
__device__ __forceinline__ unsigned pk2(float lo, float hi) { const f32x2 v = {lo, hi}; return __builtin_bit_cast(unsigned, __builtin_convertvector(v, h16x2)); }
__device__ __forceinline__ float bf2f(unsigned h) { return (float)__builtin_bit_cast(_Float16, (unsigned short)h); }
__device__ __forceinline__ unsigned cvt_pk_bf16(float lo, float hi) { return pk2(lo, hi); }
#define MFMA16(a, b, c) __builtin_amdgcn_mfma_f32_16x16x32_f16(__builtin_bit_cast(h16x8, a), __builtin_bit_cast(h16x8, b), c, 0, 0, 0)
#define MFMA32(a, b, c) __builtin_amdgcn_mfma_f32_32x32x16_f16(__builtin_bit_cast(h16x8, a), __builtin_bit_cast(h16x8, b), c, 0, 0, 0)
__device__ __forceinline__ float wave_sum(float v) {
#pragma unroll
    for (int o = 1; o < 64; o <<= 1) v += __shfl_xor(v, o);
    return v;
}

namespace pg8 {
constexpr int BM = 256, BK = 64, HALF = 128, HTB = HALF * BK * 2, STAGE_BYTES = 8 * HTB, NXCD = 8;
__host__ __device__ __forceinline__ int lds_byte(int r, int c) { const int st = (r >> 4) * 2 + (c >> 5), rr = r & 15, cc = c & 31, ob = rr * 64 + cc * 2; return st * 1024 + (ob ^ (((ob >> 9) & 1) << 5)); }
__host__ __device__ __forceinline__ void stage_rc(int b, int& R, int& C) { const int st = b / 1024, sb = b % 1024, swz = sb ^ (((sb >> 9) & 1) << 5); R = (st >> 1) * 16 + swz / 64; C = (st & 1) * 32 + (swz % 64) / 2; }
__host__ __device__ __forceinline__ int perm32(int rho) { const int n = rho >> 4, i = rho & 15; return 8 * (i >> 2) + 4 * n + (i & 3); }

struct Unit {
    int pm, pn;
    const char* bptr;
    int roff;
    int nvalid;
};

__device__ __forceinline__ int xcd_chunk(int L, int nwg) { const int q = nwg / NXCD, r = nwg % NXCD, xcd = L % NXCD, off = L / NXCD; return (xcd < r ? xcd * (q + 1) : r * (q + 1) + (xcd - r) * q) + off; }

template <class Epi, class Sched>
__device__ __forceinline__ void gemm_phase(const int tid, LAS unsigned char* lds, const char* Abase, const int lda, const int ldb, const int K, const Sched& S, const Epi& E) {
    constexpr bool GATHER = Sched::GATHER;
    const int wid = __builtin_amdgcn_readfirstlane(tid >> 6), lane = tid & 63, wr = wid >> 2, wc = wid & 3, fr = lane & 15, fq = lane >> 4;
    const int nt = K / BK;
    int Rr[2]; unsigned C2[2], voffB[2], voffA[2];
#pragma unroll
    for (int i = 0; i < 2; ++i) { int R, C; stage_rc(tid * 16 + i * 8192, R, C); const int Rb = (R & ~31) + perm32(R & 31); Rr[i] = R; C2[i] = (unsigned)C * 2u; voffB[i] = (unsigned)(Rb * ldb) + (unsigned)C * 2u; voffA[i] = (unsigned)(R * lda) + (unsigned)C * 2u; }
    const size_t kstep = (size_t)(BK * 2);
    const size_t hstepB = (size_t)HALF * ldb;
    const size_t hstepA = GATHER ? (size_t)0 : (size_t)HALF * lda;
    const unsigned ldsw = (unsigned)wid * 1024u;
    const int aoff = lds_byte(wr * 64 + fr, fq * 8), boff = lds_byte(wc * 32 + fr, fq * 8);
#define PG8_SA(b, h) (((b) * 2 + (h)) * HTB)
#define PG8_SB(b, h) ((4 + (b) * 2 + (h)) * HTB)
#define PG8_STAGE(bufoff, gbase, voff) do { _Pragma("unroll") for (int _i = 0; _i < 2; ++_i) \
        __builtin_amdgcn_global_load_lds((const unsigned*)((const char*)(gbase) + (voff)[_i]), (LAS unsigned*)(lds + (bufoff) + ldsw + _i * 8192), 16, 0, 0); } while (0)
#define PG8_STAGEA(bufoff, gbase, h) do { if constexpr (GATHER) { PG8_STAGE(bufoff, gbase, vA[h]); } else { PG8_STAGE(bufoff, (gbase) + (h) * hstepA, voffA); } } while (0)
#define PG8_LDA(dst, b, h) do { _Pragma("unroll") for (int m = 0; m < 4; ++m) _Pragma("unroll") for (int k = 0; k < 2; ++k) dst[m][k] = *(const LAS bf16x8*)(lds + PG8_SA(b, h) + aoff + m * 2048 + k * 1024); } while (0)
#define PG8_LDB(dst, b, h) do { _Pragma("unroll") for (int n = 0; n < 2; ++n) _Pragma("unroll") for (int k = 0; k < 2; ++k) dst[n][k] = *(const LAS bf16x8*)(lds + PG8_SB(b, h) + boff + n * 2048 + k * 1024); } while (0)
#define PG8_MMA(ai, bj, At, Bt) do { __builtin_amdgcn_s_setprio(1); _Pragma("unroll") for (int m = 0; m < 4; ++m) _Pragma("unroll") for (int n = 0; n < 2; ++n) _Pragma("unroll") for (int k = 0; k < 2; ++k) \
        acc[ai][bj][m][n] = MFMA16(Bt[n][k], At[m][k], acc[ai][bj][m][n]); __builtin_amdgcn_s_setprio(0); } while (0)
#define PG8_WAIT_V(n) asm volatile("s_waitcnt vmcnt(" #n ")" ::: "memory")
#define PG8_WAIT_L(n) asm volatile("s_waitcnt lgkmcnt(" #n ")" ::: "memory")
#define PG8_BAR __builtin_amdgcn_s_barrier()
#define PG8_SCHED __builtin_amdgcn_sched_barrier(0)
#define PG8_CALCA(u, vo) do { _Pragma("unroll") for (int _h = 0; _h < 2; ++_h) _Pragma("unroll") for (int _i = 0; _i < 2; ++_i) \
        vo[_h][_i] = (unsigned)S.arow(u, _h * HALF + Rr[_i]) * (unsigned)lda + C2[_i]; } while (0)
    Unit cur, nxt; int ui = 0;
    if (!S.next(0, cur)) return;
    f32x4 acc[2][2][4][2];
#pragma unroll
    for (int a = 0; a < 2; ++a)
#pragma unroll
        for (int b = 0; b < 2; ++b)
#pragma unroll
            for (int m = 0; m < 4; ++m)
#pragma unroll
                for (int n = 0; n < 2; ++n) acc[a][b][m][n] = (f32x4){0.f, 0.f, 0.f, 0.f};
    bf16x8 At[4][2], B0[2][2], B1[2][2];
    unsigned vA[2][2], vAn[2][2];
    const char* cA = Abase;
    if constexpr (GATHER) { PG8_CALCA(cur, vA); } else { cA = Abase + (size_t)S.arow(cur, 0) * lda + S.acolb(cur); }
    const char* cB = cur.bptr;
    PG8_STAGE(PG8_SB(0, 0), cB, voffB); PG8_STAGE(PG8_SB(0, 1), cB + hstepB, voffB); PG8_STAGEA(PG8_SA(0, 0), cA, 0); PG8_STAGEA(PG8_SA(0, 1), cA, 1);
    if (wr == 1) PG8_BAR;
    PG8_WAIT_V(2); PG8_BAR;
    PG8_STAGE(PG8_SB(1, 0), cB + kstep, voffB); PG8_STAGEA(PG8_SA(1, 0), cA + kstep, 0); PG8_STAGE(PG8_SB(1, 1), cB + hstepB + kstep, voffB);
    PG8_WAIT_V(6); PG8_BAR;
    for (;;) {
        const bool has_next = S.next(ui + 1, nxt);
        float rs[2][4];
        if constexpr (Epi::ROWSCALE) {
#pragma unroll
            for (int ai = 0; ai < 2; ++ai)
#pragma unroll
                for (int m = 0; m < 4; ++m) rs[ai][m] = S.rowscale(cur, ai * HALF + wr * 64 + m * 16 + fr);
        }
        const char* nA = cA;
        if constexpr (GATHER) {
            if (has_next) { PG8_CALCA(nxt, vAn); }
            else {
#pragma unroll
                for (int h = 0; h < 2; ++h)
#pragma unroll
                    for (int i = 0; i < 2; ++i) vAn[h][i] = vA[h][i];
            }
            asm volatile("s_waitcnt vmcnt(0)" : "+v"(vAn[0][0]), "+v"(vAn[0][1]), "+v"(vAn[1][0]), "+v"(vAn[1][1]) :: "memory");
            if constexpr (Epi::ROWSCALE) { asm volatile("" : "+v"(rs[0][0]), "+v"(rs[0][1]), "+v"(rs[0][2]), "+v"(rs[0][3]), "+v"(rs[1][0]), "+v"(rs[1][1]), "+v"(rs[1][2]), "+v"(rs[1][3])); }
        } else { if (has_next) nA = Abase + (size_t)S.arow(nxt, 0) * lda + S.acolb(nxt); }
        const char* nB = has_next ? nxt.bptr : cB;
#pragma unroll 1
        for (int t = 0; t < nt; t += 2) {
            const bool last = (t == nt - 2);
            const char* a1 = cA + (size_t)(t + 1) * kstep;
            const char* a2 = last ? nA : cA + (size_t)(t + 2) * kstep; const char* b2 = last ? nB : cB + (size_t)(t + 2) * kstep;
            const char* a3 = a2 + kstep; const char* b3 = b2 + kstep;
            PG8_LDB(B0, 0, 0); PG8_LDB(B1, 0, 1); PG8_SCHED; PG8_LDA(At, 0, 0); PG8_STAGEA(PG8_SA(1, 1), a1, 1);
            if constexpr (GATHER) { if (last) {
#pragma unroll
                for (int h = 0; h < 2; ++h)
#pragma unroll
                    for (int i = 0; i < 2; ++i) vA[h][i] = vAn[h][i]; } }
            PG8_WAIT_V(8); PG8_WAIT_L(0); PG8_BAR; PG8_MMA(0, 0, At, B0); PG8_MMA(0, 1, At, B1); PG8_BAR; PG8_SCHED;
            PG8_LDA(At, 0, 1); PG8_STAGE(PG8_SB(0, 0), b2, voffB); PG8_STAGE(PG8_SB(0, 1), b2 + hstepB, voffB); PG8_STAGEA(PG8_SA(0, 0), a2, 0);
            PG8_WAIT_V(8); PG8_WAIT_L(0); PG8_BAR; PG8_MMA(1, 0, At, B0); PG8_MMA(1, 1, At, B1); PG8_BAR; PG8_SCHED;
            PG8_LDB(B0, 1, 0); PG8_LDB(B1, 1, 1); PG8_SCHED; PG8_LDA(At, 1, 0); PG8_STAGEA(PG8_SA(0, 1), a2, 1);
            PG8_WAIT_V(8); PG8_WAIT_L(0); PG8_BAR; PG8_MMA(0, 0, At, B0); PG8_MMA(0, 1, At, B1); PG8_BAR; PG8_SCHED;
            PG8_LDA(At, 1, 1); PG8_STAGE(PG8_SB(1, 0), b3, voffB); PG8_STAGE(PG8_SB(1, 1), b3 + hstepB, voffB); PG8_STAGEA(PG8_SA(1, 0), a3, 0);
            PG8_WAIT_V(8); PG8_WAIT_L(0); PG8_BAR; PG8_MMA(1, 0, At, B0); PG8_MMA(1, 1, At, B1); PG8_BAR; PG8_SCHED;
        }
        if (wr == 0) PG8_BAR;
        E(acc, cur, rs, wr, wc, fr, fq);
        if (!has_next) break;
#pragma unroll
        for (int a = 0; a < 2; ++a)
#pragma unroll
            for (int b = 0; b < 2; ++b)
#pragma unroll
                for (int m = 0; m < 4; ++m)
#pragma unroll
                    for (int n = 0; n < 2; ++n) acc[a][b][m][n] = (f32x4){0.f, 0.f, 0.f, 0.f};
        cur = nxt; cB = nB; cA = nA; ++ui;
        if (wr == 1) PG8_BAR;
    }
    PG8_WAIT_V(0);
    PG8_BAR;
#undef PG8_SA
#undef PG8_SB
#undef PG8_STAGE
#undef PG8_STAGEA
#undef PG8_LDA
#undef PG8_LDB
#undef PG8_MMA
#undef PG8_WAIT_V
#undef PG8_WAIT_L
#undef PG8_BAR
#undef PG8_SCHED
#undef PG8_CALCA
}

struct EpiStore {
    static constexpr bool ROWSCALE = false;
    bf16* O; int ldc; const float* cscale; int qmode; int colbase_mul;
    __device__ __forceinline__ void operator()(const f32x4 (&acc)[2][2][4][2], const Unit& u, const float (&rs)[2][4], int wr, int wc, int fr, int fq) const {
        const int row0 = u.pm * BM + wr * 64 + fr; const int colt = u.pn * BM;
        float sc = 1.f; if (qmode) { if (((colt >> 10) % 3) == 0) sc = QSCALE; }
        const int col0 = colt + wc * 32 + 8 * fq;
        f32x4 cs[2][2];
#pragma unroll
        for (int bj = 0; bj < 2; ++bj)
#pragma unroll
            for (int n = 0; n < 2; ++n) { cs[bj][n] = cscale ? *(const f32x4*)(cscale + col0 + bj * HALF + 4 * n) : (f32x4){1.f, 1.f, 1.f, 1.f}; cs[bj][n] = cs[bj][n] * sc; }
#pragma unroll
        for (int ai = 0; ai < 2; ++ai)
#pragma unroll
            for (int m = 0; m < 4; ++m) { bf16* rowp = O + (size_t)(row0 + ai * HALF + m * 16) * ldc + col0;
#pragma unroll
                for (int bj = 0; bj < 2; ++bj) { const f32x4 v0 = acc[ai][bj][m][0] * cs[bj][0], v1 = acc[ai][bj][m][1] * cs[bj][1];
                    u32x4 w; w.x = cvt_pk_bf16(v0[0], v0[1]); w.y = cvt_pk_bf16(v0[2], v0[3]); w.z = cvt_pk_bf16(v1[0], v1[1]); w.w = cvt_pk_bf16(v1[2], v1[3]);
                    *(u32x4*)(rowp + bj * HALF) = w; } }
    }
};
struct EpiGU {
    static constexpr bool ROWSCALE = true;
    bf16* O;
    __device__ __forceinline__ void operator()(const f32x4 (&acc)[2][2][4][2], const Unit& u, const float (&rs)[2][4], int wr, int wc, int fr, int fq) const {
        const int row0 = u.pm * BM + wr * 64 + fr; const int col0 = u.pn * HALF + wc * 32 + 8 * fq;
#pragma unroll
        for (int ai = 0; ai < 2; ++ai)
#pragma unroll
            for (int m = 0; m < 4; ++m) { bf16* rowp = O + (size_t)(row0 + ai * HALF + m * 16) * DEXP + col0; const float w = rs[ai][m];
                float o[8];
#pragma unroll
                for (int n = 0; n < 2; ++n)
#pragma unroll
                    for (int j = 0; j < 4; ++j) { const float g = acc[ai][0][m][n][j], uu = acc[ai][1][m][n][j];
                        const float sg = g * __builtin_amdgcn_rcpf(1.0f + __builtin_amdgcn_exp2f(-g * LOG2E)); o[n * 4 + j] = sg * uu * w; }
                u32x4 wv; wv.x = cvt_pk_bf16(o[0], o[1]); wv.y = cvt_pk_bf16(o[2], o[3]); wv.z = cvt_pk_bf16(o[4], o[5]); wv.w = cvt_pk_bf16(o[6], o[7]);
                *(u32x4*)rowp = wv; }
    }
};
}

#define XB_TMO      128
#define XB_XCNT(j)  (256  + 64 * (j))
#define XB_XSUB(j)  (1280 + 64 * (j))
#define XB_XGEN(j)  (2304 + 64 * (j))
#define XB_TOP      3328
#define XB_TOPGEN   3392
#define XCD_BAR_WORDS 3456
#define XB_SPIN_CAP (1u << 18)
__device__ __forceinline__ unsigned xb_ld(unsigned* p)              { return __hip_atomic_load(p, __ATOMIC_RELAXED, __HIP_MEMORY_SCOPE_AGENT); }
__device__ __forceinline__ unsigned xb_add(unsigned* p, unsigned v) { return __hip_atomic_fetch_add(p, v, __ATOMIC_RELAXED, __HIP_MEMORY_SCOPE_AGENT); }
__device__ __forceinline__ unsigned xb_xcc_id() { return (unsigned)__builtin_amdgcn_s_getreg((3 << 11) | 20) & 0xFu; }
#define XB_SPIN(cond, bar) do { unsigned _sp = 0; while (cond) { __builtin_amdgcn_s_sleep(1); \
    if ((++_sp & 255u) == 0u) { if (xb_ld(&(bar)[XB_TMO])) break; if (_sp > XB_SPIN_CAP) { atomicAdd(&(bar)[XB_TMO], 1u); break; } } } } while (0)
struct XcdBarrier { unsigned* bar; unsigned x; volatile LAS unsigned* st; };
__device__ __forceinline__ XcdBarrier xcd_barrier_post(unsigned* bar, volatile LAS unsigned* st) {
    XcdBarrier b; b.bar = bar; b.x = xb_xcc_id(); b.st = st;
    if (threadIdx.x == 0) (void)xb_add(&bar[XB_XCNT(b.x)], 1u);
    return b;
}
__device__ __forceinline__ void xcd_barrier_complete(unsigned* bar, unsigned x, unsigned& nloc, unsigned& nx) {
    const unsigned G = gridDim.x * gridDim.y * gridDim.z;
    unsigned sum, cnt, mine, sp = 0u;
    for (;;) {
        sum = 0u; cnt = 0u; mine = 0u;
#pragma unroll
        for (unsigned j = 0; j < 16; ++j) { const unsigned c = xb_ld(&bar[XB_XCNT(j)]); sum += c; cnt += (c > 0u) ? 1u : 0u; mine = (j == x) ? c : mine; }
        if (sum == G) break;
        __builtin_amdgcn_s_sleep(1);
        if ((++sp & 255u) == 0u) { if (xb_ld(&bar[XB_TMO])) break; if (sp > XB_SPIN_CAP) { atomicAdd(&bar[XB_TMO], 1u); break; } }
    }
    nloc = mine > 0u ? mine : 1u; nx = cnt > 0u ? cnt : 1u;
}
__device__ __forceinline__ void xcd_barrier(const XcdBarrier& b) {
    asm volatile("s_waitcnt vmcnt(0)" ::: "memory");
    __syncthreads();
    if (threadIdx.x == 0) {
        unsigned* bar = b.bar;
        __builtin_amdgcn_s_waitcnt(0);
        unsigned nloc = b.st[0], nx = b.st[1];
        if (nloc == 0u) { xcd_barrier_complete(bar, b.x, nloc, nx); b.st[0] = nloc; b.st[1] = nx; }
        const unsigned old = xb_add(&bar[XB_XSUB(b.x)], 1u);
        const unsigned gen = old / nloc;
        if (old + 1u == (gen + 1u) * nloc) {
            __builtin_amdgcn_fence(__ATOMIC_RELEASE, "agent");
            asm volatile("s_waitcnt vmcnt(0)" ::: "memory");
            const unsigned og = xb_add(&bar[XB_TOP], 1u);
            const unsigned tg = og / nx;
            if (og + 1u == (tg + 1u) * nx) xb_add(&bar[XB_TOPGEN], 1u);
            else XB_SPIN(xb_ld(&bar[XB_TOPGEN]) == tg, bar);
            __builtin_amdgcn_fence(__ATOMIC_ACQUIRE, "agent");
            xb_add(&bar[XB_XGEN(b.x)], 1u);
            asm volatile("s_waitcnt vmcnt(0)" ::: "memory");
        } else {
            XB_SPIN(xb_ld(&bar[XB_XGEN(b.x)]) == gen, bar);
            __builtin_amdgcn_fence(__ATOMIC_ACQUIRE, "agent");
            asm volatile("s_waitcnt vmcnt(0)" ::: "memory");
        }
    }
    __syncthreads();
}

constexpr int NWAVES = 8;
struct Frame {
    LAS unsigned char* lds;
    LAS unsigned char* lc;
    unsigned* ctl;
    unsigned char* ws;
    int tid, lane, wave, vcu, G;
};
constexpr int LC_PTR = 2048;
__device__ __forceinline__ const float* inp(const Frame& F, int i) {
    const unsigned long long v = *(const LAS unsigned long long*)(F.lc + LC_PTR + 8 * i);
    const unsigned lo = __builtin_amdgcn_readfirstlane((unsigned)v), hi = __builtin_amdgcn_readfirstlane((unsigned)(v >> 32));
    return (const float*)(const GAS float*)(((unsigned long long)hi << 32) | lo);
}
__device__ __forceinline__ unsigned char* opq(unsigned char* p) { GAS unsigned char* g = (GAS unsigned char*)p; asm volatile("" : "+s"(g)); return (unsigned char*)g; }
__device__ __forceinline__ void refresh(Frame& F) { asm volatile("" : "+v"(F.tid)); F.lane = F.tid & 63; F.wave = __builtin_amdgcn_readfirstlane(F.tid >> 6); }

struct PlainSched {   static constexpr bool GATHER = false;
    int nM, nN, nwg, G, c; const char* B; int ldb;
    __device__ __forceinline__ bool next(int i, pg8::Unit& u) const {
        const int L = i * G + c; if (L >= nwg) return false;
        const int wgid = pg8::xcd_chunk(L, nwg);
        const int nig = 8 * nN, gid = wgid / nig, fm = gid * 8, gsz = (nM - fm) < 8 ? (nM - fm) : 8;
        u.pm = fm + ((wgid % nig) % gsz); u.pn = (wgid % nig) / gsz;
        u.bptr = B + (size_t)u.pn * 256 * ldb; u.roff = -(u.pm * 256) - 1; u.nvalid = 256; return true;
    }
    __device__ __forceinline__ int arow(const pg8::Unit& u, int r) const { return -u.roff - 1 + r; }
    __device__ __forceinline__ int acolb(const pg8::Unit&) const { return 0; }
    __device__ __forceinline__ float rowscale(const pg8::Unit&, int) const { return 1.0f; }
};
struct GrpSched {     static constexpr bool GATHER = false;
    int G, c; const char* B;
    __device__ __forceinline__ bool next(int i, pg8::Unit& u) const {
        const int L = i * G + c; if (L >= 256) return false;
        const int wgid = pg8::xcd_chunk(L, 256);
        u.pm = wgid >> 2; u.pn = wgid & 3; u.bptr = B + (size_t)u.pn * 256 * 512; u.roff = -(u.pm * 256) - 1; u.nvalid = 256; return true;
    }
    __device__ __forceinline__ int arow(const pg8::Unit& u, int r) const { return -u.roff - 1 + r; }
    __device__ __forceinline__ int acolb(const pg8::Unit& u) const { return u.pn * 512; }
    __device__ __forceinline__ float rowscale(const pg8::Unit&, int) const { return 1.0f; }
};
template <bool GATHER_> struct MoeSched {     static constexpr bool GATHER = GATHER_;
    const LAS int* ts; const LAS int* cn; int npn, nunits, G, c, lane_;
    const int* tokl; const float* wl; const char* Bexp; size_t bstride; const char* Bsh; int ldb;
    __device__ __forceinline__ bool next(int i, pg8::Unit& u) const {
        const int L = i * G + c; if (L >= nunits) return false;
        const int wgid = pg8::xcd_chunk(L, nunits);
        const int tile = wgid / npn, pn = wgid % npn;
        const int lane = lane_;
        const bool hit = (tile >= ts[lane]) && (tile < ts[lane + 1]);
        const unsigned long long mk = __ballot(hit);
        const int e = mk ? (int)__builtin_ctzll(mk) : 64;
        const int tse = __builtin_amdgcn_readfirstlane(ts[e]);
        const int r0 = (tile - tse) * 256;
        u.pm = tile; u.pn = pn;
        u.bptr = (e < 64 ? Bexp + (size_t)e * bstride : Bsh) + (size_t)pn * 256 * ldb;
        if (GATHER) {
            if (e < 64) { const int ce = __builtin_amdgcn_readfirstlane(cn[e]); u.roff = e * CAP + r0; u.nvalid = (ce - r0) < 256 ? (ce - r0) : 256; }
            else { u.roff = -r0 - 1; u.nvalid = 256; }
        } else { u.roff = -(tile * 256) - 1; u.nvalid = 256; }
        return true;
    }
    __device__ __forceinline__ int arow(const pg8::Unit& u, int r) const { if (GATHER && u.roff >= 0) { const int rr = r < u.nvalid ? r : u.nvalid - 1; return tokl[u.roff + rr]; } return -u.roff - 1 + r; }
    __device__ __forceinline__ int acolb(const pg8::Unit&) const { return 0; }
    __device__ __forceinline__ float rowscale(const pg8::Unit& u, int r) const { if (GATHER && u.roff >= 0) { const int rr = r < u.nvalid ? r : u.nvalid - 1; return wl[u.roff + rr]; } return 1.0f; }
};

__device__ __forceinline__ void p0_transpose_item(const float* W, int K, int N, bf16* WT, int dst_n0, LAS float* scr, int kb, int nb, int lane) {
    const int k0 = 64 * kb, n0 = 32 * nb;
#pragma unroll 8
    for (int i = 0; i < 32; ++i) { const int kk = 2 * i + (lane >> 5); scr[kk * 33 + (lane & 31)] = W[(size_t)(k0 + kk) * N + n0 + (lane & 31)]; }
    LDS_WAIT(); asm volatile("" ::: "memory");
    const int c = lane & 7;
#pragma unroll
    for (int j = 0; j < 4; ++j) { const int n = (lane >> 3) + 8 * j; const LAS float* s = scr + (8 * c) * 33 + n;
        u32x4 o; o.x = pk2(s[0 * 33], s[1 * 33]); o.y = pk2(s[2 * 33], s[3 * 33]); o.z = pk2(s[4 * 33], s[5 * 33]); o.w = pk2(s[6 * 33], s[7 * 33]);
        *(GAS u32x4*)(WT + (size_t)(dst_n0 + n) * K + k0 + 8 * c) = o; }
    LDS_WAIT(); asm volatile("" ::: "memory");
}
__device__ __forceinline__ void p0_router_item(const float* W, bf16* WH, bf16* WLo, LAS float* scr, int kb, int nb, int lane) {
    const int K = 1024, N = 64; const int k0 = 64 * kb, n0 = 32 * nb;
#pragma unroll 8
    for (int i = 0; i < 32; ++i) { const int kk = 2 * i + (lane >> 5); scr[kk * 33 + (lane & 31)] = W[(size_t)(k0 + kk) * N + n0 + (lane & 31)]; }
    LDS_WAIT(); asm volatile("" ::: "memory");
    const int c = lane & 7;
#pragma unroll
    for (int j = 0; j < 4; ++j) { const int n = (lane >> 3) + 8 * j; const LAS float* s = scr + (8 * c) * 33 + n;
        unsigned h[8], l[8];
#pragma unroll
        for (int q = 0; q < 8; ++q) { const float v = s[q * 33]; h[q] = f2bf(v); l[q] = f2bf(v - bf2f(h[q])); }
        u32x4 oh, ol; oh.x = h[0] | (h[1] << 16); oh.y = h[2] | (h[3] << 16); oh.z = h[4] | (h[5] << 16); oh.w = h[6] | (h[7] << 16);
        ol.x = l[0] | (l[1] << 16); ol.y = l[2] | (l[3] << 16); ol.z = l[4] | (l[5] << 16); ol.w = l[6] | (l[7] << 16);
        *(GAS u32x4*)(WH + (size_t)(n0 + n) * K + k0 + 8 * c) = oh; *(GAS u32x4*)(WLo + (size_t)(n0 + n) * K + k0 + 8 * c) = ol; }
    LDS_WAIT(); asm volatile("" ::: "memory");
}

__device__ __forceinline__ void p0_prologue(Frame& F) {
    LAS float* cs = (LAS float*)(F.lds);
    LAS float* part = (LAS float*)(F.lds + 32768);
    const float* c = inp(F, 1);
    for (int i = F.tid; i < 8 * 1024; i += 512) { const float v = c[i]; cs[i] = v / (1.0f + __expf(-v)); }
    __syncthreads();
    float* mod = (float*)(F.ws + WS_MOD);
    for (int it = F.vcu; it < 4 * 96; it += F.G) {
        const int layer = it / 96, slab = it % 96; const int col = slab * 64 + F.lane;
        const float* W = inp(F, 2) + (size_t)layer * 1024 * 6144 + col;
        float a[8];
#pragma unroll
        for (int b = 0; b < 8; ++b) a[b] = 0.f;
        const int k0 = F.wave * 128;
#pragma unroll 4
        for (int k = 0; k < 128; k += 4) {
            float w[4];
#pragma unroll
            for (int j = 0; j < 4; ++j) w[j] = W[(size_t)(k0 + k + j) * 6144];
#pragma unroll
            for (int b = 0; b < 8; ++b) { const f32x4 cv = *(const LAS f32x4*)(cs + b * 1024 + k0 + k); a[b] += cv[0] * w[0] + cv[1] * w[1] + cv[2] * w[2] + cv[3] * w[3]; }
        }
#pragma unroll
        for (int b = 0; b < 8; ++b) part[(F.wave * 8 + b) * 64 + F.lane] = a[b];
        __syncthreads();
        { const int b = F.wave; float s = 0.f;
#pragma unroll
          for (int w = 0; w < 8; ++w) s += part[(w * 8 + b) * 64 + F.lane];
          mod[((size_t)layer * 8 + b) * 6144 + col] = s + inp(F, 3)[layer * 6144 + col]; }
        __syncthreads();
    }
    __syncthreads();
    LAS float* scr = (LAS float*)(F.lds + F.wave * 16384);
    const int gw = F.vcu * NWAVES + F.wave, NGW = F.G * NWAVES;
    constexpr int I_PIN = 2 * 16 * 32, I_GRP = 8 * 4 * 8, I_POUT = I_PIN, I_AIN = 2 * 16 * 288, I_AOUT = I_PIN, I_SHGU = 4 * 16 * 16, I_SHDN = 4 * 4 * 32, I_R = 4 * 16 * 2;
    constexpr int I_EGU = 256 * 16 * 16, I_EDN = 256 * 4 * 32;
    constexpr int NITEMS = I_PIN + I_GRP + I_POUT + I_AIN + I_AOUT + I_SHGU + I_SHDN + I_R + I_EGU + I_EDN;
    for (int it = gw; it < NITEMS; it += NGW) {
        int r = it;
#define P0_GROUP(CNT, SRC, KK, NN, DST, GU) if (r < (CNT)) { const int per = ((KK) / 64) * ((NN) / 32), mat = r / per, q = r % per, nblk = (NN) / 32, kb = q / nblk, nb = q % nblk; \
            int dn0 = 32 * nb; if (GU) { const int n0 = 32 * nb; dn0 = (n0 < 256) ? ((n0 >> 7) * 256 + (n0 & 127)) : (((n0 - 256) >> 7) * 256 + 128 + ((n0 - 256) & 127)); } \
            p0_transpose_item((SRC) + (size_t)mat * (KK) * (NN), (KK), (NN), (bf16*)(F.ws + (DST)) + (size_t)mat * (KK) * (NN), dn0, scr, kb, nb, F.lane); continue; } r -= (CNT);
        P0_GROUP(I_PIN, inp(F, 4), 1024, 1024, WS_WPIN, 0)
        P0_GROUP(I_GRP, inp(F, 5), 256, 256, WS_WPGRP, 0)
        P0_GROUP(I_POUT, inp(F, 7), 1024, 1024, WS_WPOUT, 0)
        P0_GROUP(I_AIN, inp(F, 8), 1024, 9216, WS_WAIN, 0)
        P0_GROUP(I_AOUT, inp(F, 9), 1024, 1024, WS_WAOUT, 0)
        P0_GROUP(I_SHGU, inp(F, 16), 1024, 512, WS_WSHGU, 1)
        P0_GROUP(I_SHDN, inp(F, 17), 256, 1024, WS_WSHDN, 0)
        if (r < I_R) { const int mat = r / 32, q = r % 32, kb = q / 2, nb = q % 2;
            p0_router_item(inp(F, 12) + (size_t)mat * 65536, (bf16*)(F.ws + WS_WRHI) + (size_t)mat * 65536, (bf16*)(F.ws + WS_WRLO) + (size_t)mat * 65536, scr, kb, nb, F.lane); continue; } r -= I_R;
        P0_GROUP(I_EGU, inp(F, 14), 1024, 512, WS_WEGU, 1)
        P0_GROUP(I_EDN, inp(F, 15), 256, 1024, WS_WEDN, 0)
#undef P0_GROUP
    }
}

__device__ __forceinline__ void p1_modulate(Frame& F, const float* x, const float* modl  , int sh_off, int sc_off) {
    bf16* H = (bf16*)(F.ws + WS_H);
    const int gw = F.vcu * NWAVES + F.wave, NGW = F.G * NWAVES;
    for (int m = gw; m < T; m += NGW) {
        const int b = m / SEQ; const float* mb = modl + (size_t)b * 6144;
        const GAS f32x4* xr = (const GAS f32x4*)(x + (size_t)m * D) + F.lane;
        GAS u32x2* o8 = (GAS u32x2*)(H + (size_t)m * D) + F.lane;
#pragma unroll
        for (int j = 0; j < 4; ++j) { const f32x4 v = xr[64 * j]; const f32x4 sc = *(const f32x4*)(mb + sc_off + 4 * F.lane + 256 * j), sh = *(const f32x4*)(mb + sh_off + 4 * F.lane + 256 * j);
            const f32x4 h = v * (sc + 1.0f) + sh; u32x2 w; w.x = pk2(h[0], h[1]); w.y = pk2(h[2], h[3]); o8[64 * j] = w; }
    }
}

template <int W>
__device__ __forceinline__ void pool_item(const bf16* U, bf16* Z, int b, int t0, int g, int lane) {
    const size_t base = (size_t)b * SEQ * D + 256 * g + 4 * lane;
    float s[4] = {0.f, 0.f, 0.f, 0.f};
#pragma unroll
    for (int j = 1; j <= W; ++j) { const int t = t0 - j; if (t >= 0) { const u32x2 v = *(const GAS u32x2*)(U + base + (size_t)t * D);
            s[0] += bf2f(v.x & 0xffffu); s[1] += bf2f(v.x >> 16); s[2] += bf2f(v.y & 0xffffu); s[3] += bf2f(v.y >> 16); } }
#pragma unroll 8
    for (int i = 0; i < 32; ++i) { const int t = t0 + i;
        const u32x2 v = *(const GAS u32x2*)(U + base + (size_t)t * D);
        const float c0 = bf2f(v.x & 0xffffu), c1 = bf2f(v.x >> 16), c2 = bf2f(v.y & 0xffffu), c3 = bf2f(v.y >> 16);
        s[0] += c0; s[1] += c1; s[2] += c2; s[3] += c3;
        if (t - W >= 0) { const u32x2 o = *(const GAS u32x2*)(U + base + (size_t)(t - W) * D);
            s[0] -= bf2f(o.x & 0xffffu); s[1] -= bf2f(o.x >> 16); s[2] -= bf2f(o.y & 0xffffu); s[3] -= bf2f(o.y >> 16); }
        const float inv = 1.0f / (float)((t + 1) < W ? (t + 1) : W);
        u32x2 w; w.x = pk2(s[0] * inv - c0, s[1] * inv - c1); w.y = pk2(s[2] * inv - c2, s[3] * inv - c3);
        *(GAS u32x2*)(Z + base + (size_t)t * D) = w; }
}

__device__ __forceinline__ void moe_build_table(Frame& F, int layer) {
    LAS int* ts = (LAS int*)(F.lc + LC_TS); LAS int* cn = (LAS int*)(F.lc + LC_CNT);
    __syncthreads();
    if (F.wave == 0) {
        const int c = (int)__hip_atomic_load(F.ctl + CW_CNT + layer * 64 + F.lane, RLX_AGENT);
        int t = (c + 255) >> 8;
#pragma unroll
        for (int o = 1; o < 64; o <<= 1) { const int v = __shfl_up(t, o); if (F.lane >= o) t += v; }
        cn[F.lane] = c; ts[F.lane + 1] = t;
        if (F.lane == 0) ts[0] = 0;
        if (F.lane == 63) ts[65] = t + 64;
    }
    __syncthreads();
}

constexpr int APITCH = 1032;
__device__ __forceinline__ void ln1_router_phase(Frame& F, int layer, const float* xin) {
    float* X = (float*)(F.ws + WS_X); bf16* H = (bf16*)(F.ws + WS_H); const bf16* Y = (const bf16*)(F.ws + WS_Y);
    const float* modl = (const float*)(F.ws + WS_MOD) + (size_t)layer * 8 * 6144;
    const float* lg = inp(F, 10) + layer * D; const float* lb = inp(F, 11) + layer * D;
    const float* rb = inp(F, 13) + layer * NE;
    const bf16* WH = (const bf16*)(F.ws + WS_WRHI) + (size_t)layer * 65536; const bf16* WLo = (const bf16*)(F.ws + WS_WRLO) + (size_t)layer * 65536;
    int* tokl = (int*)(F.ws + WS_TOKL); float* wl = (float*)(F.ws + WS_WL); int* tslot = (int*)(F.ws + WS_TSLOT);
    unsigned* gcnt = F.ctl + CW_CNT + layer * 64;
    LAS bf16* Ahi = (LAS bf16*)F.lds; LAS bf16* Alo = Ahi + 32 * APITCH;
    LAS float* PART = (LAS float*)F.lds;
    LAS int* lcnt = (LAS int*)(F.lc + LC_LCNT); LAS int* gb = (LAS int*)(F.lc + LC_GB);
    const int lane = F.lane, wave = F.wave;
    for (int blk = F.vcu; blk < T / 32; blk += F.G) {
        const int tok0 = blk * 32;
        for (int q = 0; q < 4; ++q) {
            const int rl = wave * 4 + q, tok = tok0 + rl, b = tok / SEQ; const float* mb = modl + (size_t)b * 6144;
            const GAS f32x4* xr = (const GAS f32x4*)(xin + (size_t)tok * D) + lane; const GAS u32x2* yr = (const GAS u32x2*)(Y + (size_t)tok * D) + lane;
            f32x4 v[4]; float s = 0.f;
#pragma unroll
            for (int j = 0; j < 4; ++j) { const f32x4 xv = xr[64 * j]; const u32x2 yv = yr[64 * j]; const f32x4 g1 = *(const f32x4*)(mb + 2048 + 4 * lane + 256 * j);
                f32x4 y4; y4[0] = bf2f(yv.x & 0xffffu); y4[1] = bf2f(yv.x >> 16); y4[2] = bf2f(yv.y & 0xffffu); y4[3] = bf2f(yv.y >> 16);
                v[j] = xv * ALPHA + (g1 + 1.0f) * y4; s += (v[j][0] + v[j][1]) + (v[j][2] + v[j][3]); }
            const float mean = wave_sum(s) * (1.f / D); float s2 = 0.f;
#pragma unroll
            for (int j = 0; j < 4; ++j) { v[j] = v[j] - mean; s2 += (v[j][0] * v[j][0] + v[j][1] * v[j][1]) + (v[j][2] * v[j][2] + v[j][3] * v[j][3]); }
            const float rstd = 1.0f / sqrtf(wave_sum(s2) * (1.f / D) + LN_EPS);
            GAS f32x4* xo = (GAS f32x4*)(X + (size_t)tok * D) + lane; GAS u32x2* ho = (GAS u32x2*)(H + (size_t)tok * D) + lane;
#pragma unroll
            for (int j = 0; j < 4; ++j) { const int col = 4 * lane + 256 * j;
                const f32x4 gg = *(const f32x4*)(lg + col), bb = *(const f32x4*)(lb + col), sc2 = *(const f32x4*)(mb + 4096 + col), sh2 = *(const f32x4*)(mb + 3072 + col);
                const f32x4 xn = v[j] * rstd * gg + bb; xo[64 * j] = xn;
                const f32x4 hf = xn * (sc2 + 1.0f) + sh2;
                unsigned hh[4], ll[4];
#pragma unroll
                for (int e = 0; e < 4; ++e) { hh[e] = f2bf(hf[e]); ll[e] = f2bf(hf[e] - bf2f(hh[e])); }
                u32x2 wh, wlo; wh.x = hh[0] | (hh[1] << 16); wh.y = hh[2] | (hh[3] << 16); wlo.x = ll[0] | (ll[1] << 16); wlo.y = ll[2] | (ll[3] << 16);
                ho[64 * j] = wh;
                *(LAS u32x2*)(Ahi + rl * APITCH + col) = wh; *(LAS u32x2*)(Alo + rl * APITCH + col) = wlo; }
        }
        __syncthreads();
        f32x16 acc[2]; acc[0] = (f32x16){}; acc[1] = (f32x16){};
        {
            const int r32 = lane & 31, hi = lane >> 5;
#pragma unroll 2
            for (int ks = 0; ks < 8; ++ks) {
                const int k = wave * 128 + ks * 16 + hi * 8;
                const bf16x8 ah = *(const LAS bf16x8*)(Ahi + r32 * APITCH + k), al = *(const LAS bf16x8*)(Alo + r32 * APITCH + k);
#pragma unroll
                for (int nb = 0; nb < 2; ++nb) {
                    const bf16x8 bh = *(const GAS bf16x8*)(WH + (size_t)(r32 + 32 * nb) * 1024 + k), bl = *(const GAS bf16x8*)(WLo + (size_t)(r32 + 32 * nb) * 1024 + k);
                    acc[nb] = MFMA32(ah, bh, acc[nb]);
                    acc[nb] = MFMA32(al, bh, acc[nb]);
                    acc[nb] = MFMA32(ah, bl, acc[nb]);
                }
            }
        }
        __syncthreads();
        {
            const int r32 = lane & 31, hi = lane >> 5;
#pragma unroll
            for (int nb = 0; nb < 2; ++nb)
#pragma unroll
                for (int r = 0; r < 16; ++r) { const int trow = (r & 3) + 8 * (r >> 2) + 4 * hi; PART[(wave * 32 + trow) * 64 + 32 * nb + r32] = acc[nb][r]; }
        }
        if (F.tid < 64) lcnt[F.tid] = 0;
        __syncthreads();
        int chosen_m = 0; int posl[4]; float wv[4]; int rk[4];
        const float rbe = rb[lane];
#pragma unroll
        for (int q = 0; q < 4; ++q) {
            __builtin_amdgcn_sched_barrier(0);
            const int rl = wave * 4 + q;
            float logit = 0.f;
#pragma unroll
            for (int w = 0; w < 8; ++w) logit += PART[(w * 32 + rl) * 64 + lane];
            const float sg = 1.0f / (1.0f + __expf(-logit));
            const float sel = sg + rbe;
            float m1 = sel; m1 = fmaxf(m1, __shfl_xor(m1, 1)); m1 = fmaxf(m1, __shfl_xor(m1, 2)); m1 = fmaxf(m1, __shfl_xor(m1, 4));
            const unsigned long long bal = __ballot(sel == m1);
            const unsigned long long gm = bal & (0xFFull << (8 * (lane >> 3)));
            const int first = (int)__builtin_ctzll(gm);
            float m2 = (lane == first) ? -INFINITY : sel; m2 = fmaxf(m2, __shfl_xor(m2, 1)); m2 = fmaxf(m2, __shfl_xor(m2, 2)); m2 = fmaxf(m2, __shfl_xor(m2, 4));
            const float gs = m1 + m2;
            int rg = 0;
#pragma unroll
            for (int g2 = 0; g2 < 8; ++g2) { const float v = __builtin_bit_cast(float, __builtin_amdgcn_readlane(__builtin_bit_cast(int, gs), 8 * g2)); rg += ((v > gs) || (v == gs && g2 < (lane >> 3))) ? 1 : 0; }
            const bool gsel = rg < 4;
            const float msel = gsel ? sel : -INFINITY;
            int rank = 0;
#pragma unroll 4
            for (int e2 = 0; e2 < 64; ++e2) { const float v = __builtin_bit_cast(float, __builtin_amdgcn_readlane(__builtin_bit_cast(int, msel), e2)); rank += (v > msel) ? 1 : 0; rank += (v == msel && e2 < lane) ? 1 : 0; }
            const bool ch = gsel && rank < TOPK;
            const float wsum = wave_sum(ch ? sg : 0.f);
            wv[q] = sg / wsum * ROUTED_SCALE; rk[q] = rank; posl[q] = 0;
            if (ch) { chosen_m |= (1 << q); posl[q] = __hip_atomic_fetch_add(lcnt + lane, 1, __ATOMIC_RELAXED, __HIP_MEMORY_SCOPE_WORKGROUP); }
        }
        __syncthreads();
        if (wave == 0) { const int n = lcnt[lane]; int base = 0; if (n > 0) base = (int)__hip_atomic_fetch_add(gcnt + lane, (unsigned)n, RLX_AGENT); gb[lane] = base; }
        __syncthreads();
        {
            const int base = gb[lane];
#pragma unroll
            for (int q = 0; q < 4; ++q) if (chosen_m & (1 << q)) { const int tok = tok0 + wave * 4 + q; const int pos = base + posl[q];
                tokl[(size_t)lane * CAP + pos] = tok; wl[(size_t)lane * CAP + pos] = wv[q]; tslot[(size_t)tok * 8 + rk[q]] = lane * CAP + pos; }
        }
        __syncthreads();
    }
}

__device__ __forceinline__ void combine_ln2_phase(Frame& F, int layer) {
    float* X = (float*)(F.ws + WS_X); bf16* H = (bf16*)(F.ws + WS_H); const bf16* YS = (const bf16*)(F.ws + WS_YS);
    const float* modl = (const float*)(F.ws + WS_MOD) + (size_t)layer * 8 * 6144;
    const float* modn = (const float*)(F.ws + WS_MOD) + (size_t)(layer + 1) * 8 * 6144;
    const float* lg = inp(F, 18) + layer * D; const float* lb = inp(F, 19) + layer * D;
    const int* tslot = (const int*)(F.ws + WS_TSLOT);
    const LAS int* ts = (const LAS int*)(F.lc + LC_TS);
    const bool lastl = (layer == DEPTH - 1);
    float* xout = lastl ? (float*)inp(F, 20) : X;
    const int lane = F.lane;
    const int gw = F.vcu * NWAVES + F.wave, NGW = F.G * NWAVES;
    const int shbase = ts[64] * 256;
    for (int tok = gw; tok < T; tok += NGW) {
        const int b = tok / SEQ; const float* mb = modl + (size_t)b * 6144;
        int sv = 0; if (lane < 8) { const int v = tslot[(size_t)tok * 8 + lane]; sv = ts[v >> 14] * 256 + (v & (CAP - 1)); }
        f32x4 y[4];
#pragma unroll
        for (int j = 0; j < 4; ++j) y[j] = (f32x4){0.f, 0.f, 0.f, 0.f};
#pragma unroll
        for (int k = 0; k < 9; ++k) {
            const int slot = (k < 8) ? __builtin_amdgcn_readlane(sv, k) : (shbase + tok);
            const GAS u32x2* yr = (const GAS u32x2*)(YS + (size_t)slot * D) + lane;
#pragma unroll
            for (int j = 0; j < 4; ++j) { const u32x2 yv = yr[64 * j]; y[j][0] += bf2f(yv.x & 0xffffu); y[j][1] += bf2f(yv.x >> 16); y[j][2] += bf2f(yv.y & 0xffffu); y[j][3] += bf2f(yv.y >> 16); }
        }
        const GAS f32x4* xr = (const GAS f32x4*)(X + (size_t)tok * D) + lane;
        f32x4 v[4]; float s = 0.f;
#pragma unroll
        for (int j = 0; j < 4; ++j) { const f32x4 xv = xr[64 * j]; const f32x4 g2 = *(const f32x4*)(mb + 5120 + 4 * lane + 256 * j);
            v[j] = xv * ALPHA + (g2 + 1.0f) * y[j]; s += (v[j][0] + v[j][1]) + (v[j][2] + v[j][3]); }
        const float mean = wave_sum(s) * (1.f / D); float s2 = 0.f;
#pragma unroll
        for (int j = 0; j < 4; ++j) { v[j] = v[j] - mean; s2 += (v[j][0] * v[j][0] + v[j][1] * v[j][1]) + (v[j][2] * v[j][2] + v[j][3] * v[j][3]); }
        const float rstd = 1.0f / sqrtf(wave_sum(s2) * (1.f / D) + LN_EPS);
        GAS f32x4* xo = (GAS f32x4*)(xout + (size_t)tok * D) + lane; GAS u32x2* ho = (GAS u32x2*)(H + (size_t)tok * D) + lane;
        const float* mn = modn + (size_t)b * 6144;
#pragma unroll
        for (int j = 0; j < 4; ++j) { const int col = 4 * lane + 256 * j;
            const f32x4 gg = *(const f32x4*)(lg + col), bb = *(const f32x4*)(lb + col);
            f32x4 xn = v[j] * rstd * gg + bb;
#ifdef ORACLE
            if (lastl && tok < (int)(__hip_atomic_load(F.ctl + 20000, RLX_AGENT) / 32u)) xn = (f32x4){0.f, 0.f, 0.f, 0.f};
#endif
            xo[64 * j] = xn;
            if (!lastl) { const f32x4 sc1 = *(const f32x4*)(mn + 1024 + col), sh1 = *(const f32x4*)(mn + col);
                const f32x4 hm = xn * (sc1 + 1.0f) + sh1; u32x2 w; w.x = pk2(hm[0], hm[1]); w.y = pk2(hm[2], hm[3]); ho[64 * j] = w; } }
    }
}

constexpr int ACCP = 68;
__device__ __forceinline__ int crow(int r, int hi) { return (r & 3) + 8 * (r >> 2) + 4 * hi; }
template <bool FIRST>
__device__ __forceinline__ void attn_task(const bf16* QKVb  , int g, int h, int dil, int cls, int lq0, int L, int nq, float slope2d,
                                          LAS unsigned char* vst  , LAS float* wsf  , LAS float* ACC, LAS float* ML, int trow_mul, int trow_add, int lane) {
    asm volatile("" : "+v"(lane));
    const int r32 = lane & 31, hi = lane >> 5;
    const int qcol = ((g * 3 + 0) * 16 + h) * 64, kcol = ((g * 3 + 1) * 16 + h) * 64, vcol = ((g * 3 + 2) * 16 + h) * 64;
    const size_t rstride = (size_t)dil * NQKV;
    const bf16* base = QKVb + (size_t)cls * NQKV;
    bf16x8 qf[4];
    { int lq = lq0 + r32; if (lq > L - 1) lq = L - 1; const bf16* qp = base + (size_t)lq * rstride + qcol + hi * 8;
#pragma unroll
      for (int s = 0; s < 4; ++s) qf[s] = *(const GAS bf16x8*)(qp + 16 * s); }
    const int jlo = (lq0 - 97 >= 0) ? 0 : ((128 - lq0) >> 5);
    const int dmax = (lq0 + r32) < 128 ? (lq0 + r32) : 128;
    const float half = 0.5f * (float)dmax;
#define AT_LOADK(dst, j) do { int lk_ = lq0 - 128 + 32 * (j) + r32; lk_ = lk_ < 0 ? 0 : (lk_ > L - 1 ? L - 1 : lk_); const bf16* kp_ = base + (size_t)lk_ * rstride + kcol + hi * 8; \
        _Pragma("unroll") for (int s_ = 0; s_ < 4; ++s_) dst[s_] = *(const GAS bf16x8*)(kp_ + 16 * s_); } while (0)
#define AT_LOADV(dst, j) do { _Pragma("unroll") for (int p_ = 0; p_ < 4; ++p_) { int lk_ = lq0 - 128 + 32 * (j) + 16 * (p_ & 1) + (lane >> 2); lk_ = lk_ < 0 ? 0 : (lk_ > L - 1 ? L - 1 : lk_); \
        dst[p_] = *(const GAS u32x4*)(base + (size_t)lk_ * rstride + vcol + 32 * (p_ >> 1) + 8 * (lane & 3)); } } while (0)
    f32x16 S[5]; bf16x8 kf[2][4];
    float mx = -INFINITY;
#pragma unroll
    for (int j = 0; j < 5; ++j) {
        if (j >= jlo) {
            asm volatile("" ::: "memory");
            if (j == jlo) AT_LOADK(kf[j & 1], j);
            if (j < 4) AT_LOADK(kf[(j + 1) & 1], j + 1);
            f32x16 a = (f32x16){};
#pragma unroll
            for (int s = 0; s < 4; ++s) a = MFMA32(kf[j & 1][s], qf[s], a);
            const float xd0 = (float)(128 - 32 * j + r32 - 4 * hi) - half;
#pragma unroll
            for (int r = 0; r < 16; ++r) { const float x = xd0 - (float)((r & 3) + 8 * (r >> 2));
                const float v = __builtin_fmaf(-slope2d, x, a[r]); a[r] = (__builtin_fabsf(x) <= half) ? v : -INFINITY; mx = fmaxf(mx, a[r]); }
            S[j] = a;
        } else {
#pragma unroll
            for (int r = 0; r < 16; ++r) S[j][r] = -INFINITY;
        }
        __builtin_amdgcn_sched_barrier(0);
    }
    { auto rr = __builtin_amdgcn_permlane32_swap(__float_as_uint(mx), __float_as_uint(mx), false, false);
      const unsigned r0 = rr[0], r1 = rr[1]; mx = fmaxf(__uint_as_float(r0), __uint_as_float(r1)); }
    const float mx_true = mx - slope2d * half;
    float lsum = 0.f;
    u32x4 P[5][2];
#pragma unroll
    for (int j = 0; j < 5; ++j) {
        float p[16];
#pragma unroll
        for (int r = 0; r < 16; ++r) { p[r] = __builtin_amdgcn_exp2f(S[j][r] - mx); lsum += p[r]; }
#pragma unroll
        for (int ks = 0; ks < 2; ++ks) { P[j][ks].x = cvt_pk_bf16(p[8 * ks + 0], p[8 * ks + 1]); P[j][ks].y = cvt_pk_bf16(p[8 * ks + 2], p[8 * ks + 3]); P[j][ks].z = cvt_pk_bf16(p[8 * ks + 4], p[8 * ks + 5]); P[j][ks].w = cvt_pk_bf16(p[8 * ks + 6], p[8 * ks + 7]); }
        __builtin_amdgcn_sched_barrier(0);
    }
    { auto rr = __builtin_amdgcn_permlane32_swap(__float_as_uint(lsum), __float_as_uint(lsum), false, false);
      const unsigned r0 = rr[0], r1 = rr[1]; lsum = __uint_as_float(r0) + __uint_as_float(r1); }
    f32x16 o[2]; o[0] = (f32x16){}; o[1] = (f32x16){};
    u32x4 vr[2][4];
    const unsigned vrd = (unsigned)(((lane >> 4) & 1) * 32 + (lane & 3) * 8 + (4 * hi + ((lane & 15) >> 2)) * 64);
#pragma unroll
    for (int j = 0; j < 5; ++j) {
        if (j >= jlo) {
            asm volatile("" ::: "memory");
            if (j == jlo) AT_LOADV(vr[j & 1], j);
            if (j < 4) AT_LOADV(vr[(j + 1) & 1], j + 1);
#pragma unroll
            for (int p = 0; p < 4; ++p) *(LAS u32x4*)(vst + ((p >> 1) * 2 + (p & 1)) * 1024 + lane * 16) = vr[j & 1][p];
            asm volatile("s_waitcnt lgkmcnt(0)" ::: "memory");
#pragma unroll
            for (int d0 = 0; d0 < 2; ++d0)
#pragma unroll
                for (int ks = 0; ks < 2; ++ks) {
                    LAS unsigned char* vp = vst + (d0 * 2 + ks) * 1024 + vrd;
                    const s16x4 lo = __builtin_bit_cast(s16x4, __builtin_amdgcn_ds_read_tr16_b64_v4i16((LAS s16x4*)(vp)));
                    const s16x4 hh = __builtin_bit_cast(s16x4, __builtin_amdgcn_ds_read_tr16_b64_v4i16((LAS s16x4*)(vp + 512)));
                    const bf16x8 vf = (bf16x8){lo[0], lo[1], lo[2], lo[3], hh[0], hh[1], hh[2], hh[3]};
                    o[d0] = MFMA32(__builtin_bit_cast(bf16x8, P[j][ks]), vf, o[d0]);
                }
            asm volatile("s_waitcnt lgkmcnt(0)" ::: "memory");
        }
        __builtin_amdgcn_sched_barrier(0);
    }
#undef AT_LOADK
#undef AT_LOADV
    if (hi == 0) { wsf[r32] = mx_true; wsf[32 + r32] = lsum; }
    asm volatile("s_waitcnt lgkmcnt(0)" ::: "memory");
#pragma unroll
    for (int r = 0; r < 16; ++r) {
        const int q = crow(r, hi);
        if (q < nq) {
            const int trow = q * trow_mul + trow_add;
            const float mt = wsf[q], lt = wsf[32 + q];
            if (FIRST) {
                ACC[trow * ACCP + r32] = o[0][r]; ACC[trow * ACCP + 32 + r32] = o[1][r];
                if (r32 == 0) { ML[trow * 2] = mt; ML[trow * 2 + 1] = lt; }
            } else {
                const float mo = ML[trow * 2], lo_ = ML[trow * 2 + 1];
                const float mn = fmaxf(mo, mt); const float fa = __builtin_amdgcn_exp2f(mo - mn), fb = __builtin_amdgcn_exp2f(mt - mn);
                const float a0 = ACC[trow * ACCP + r32], a1 = ACC[trow * ACCP + 32 + r32];
                asm volatile("s_waitcnt lgkmcnt(0)" ::: "memory");
                ACC[trow * ACCP + r32] = a0 * fa + o[0][r] * fb; ACC[trow * ACCP + 32 + r32] = a1 * fa + o[1][r] * fb;
                if (r32 == 0) { ML[trow * 2] = mn; ML[trow * 2 + 1] = lo_ * fa + lt * fb; }
            }
        }
        if ((r & 3) == 3) __builtin_amdgcn_sched_barrier(0);
    }
    asm volatile("s_waitcnt lgkmcnt(0)" ::: "memory");
}

__device__ __forceinline__ void attn_phase(Frame& F, bf16* MIX) {
    const bf16* QKV = (const bf16*)(F.ws + WS_YS);
    LAS float* ACC = (LAS float*)F.lds;
    LAS float* ML = (LAS float*)(F.lds + 69632);
    LAS unsigned char* vst = F.lds + 73728 + F.wave * 4096;
    LAS float* wsf = (LAS float*)(F.lds + 73728 + 32768 + F.wave * 256);
    const int lane = F.lane, w = F.wave;
    for (int i = 0;; ++i) {
        const int L0 = i * F.G + F.vcu; if (L0 >= BATCH * 16 * 8) break;
        const int bh = L0 >> 3; int ti = L0 & 7; if (i & 1) ti = 7 - ti;
        const int b = bh >> 4, h = bh & 15, t0 = ti * 256;
        const bf16* Qb = QKV + (size_t)b * SEQ * NQKV;
        const float sl0 = exp2f(-8.0f * (float)(0 * 16 + h + 1) / 48.0f) * LOG2E, sl1 = exp2f(-8.0f * (float)(1 * 16 + h + 1) / 48.0f) * LOG2E * 4.0f, sl2 = exp2f(-8.0f * (float)(2 * 16 + h + 1) / 48.0f) * LOG2E * 16.0f;
        attn_task<true>(Qb, 0, h, 1, 0, t0 + 32 * w, SEQ, 32, sl0, vst, wsf, ACC, ML, 1, 32 * w, lane);
        __syncthreads();
        if (ATTN_GMASK & 2) { const int cls = w & 3, lbh = w >> 2; attn_task<false>(Qb, 1, h, 4, cls, t0 / 4 + 32 * lbh, SEQ / 4, 32, sl1, vst, wsf, ACC, ML, 4, 32 * lbh * 4 + cls, lane); }
        __syncthreads();
#pragma unroll 1
        for (int c2 = 0; c2 < ((ATTN_GMASK & 4) ? 2 : 0); ++c2) { const int cls = 2 * w + c2; attn_task<false>(Qb, 2, h, 16, cls, t0 / 16, SEQ / 16, 16, sl2, vst, wsf, ACC, ML, 16, cls, lane); }
        __syncthreads();
        { const int trow = 32 * w + (lane >> 1), half = lane & 1; const float inv = 1.0f / ML[trow * 2 + 1];
          const LAS f32x4* ap = (const LAS f32x4*)(ACC + trow * ACCP + half * 32);
          bf16* op = MIX + (size_t)(b * SEQ + t0 + trow) * D + h * 64 + half * 32;
#pragma unroll
          for (int c4 = 0; c4 < 4; ++c4) { const f32x4 a = ap[2 * c4] * inv, bq = ap[2 * c4 + 1] * inv; u32x4 wv; wv.x = pk2(a[0], a[1]); wv.y = pk2(a[2], a[3]); wv.z = pk2(bq[0], bq[1]); wv.w = pk2(bq[2], bq[3]);
              *(GAS u32x4*)(op + 8 * c4) = wv; } }
        __syncthreads();
    }
}


__device__ __forceinline__ void attn_phase_naive(Frame& F, bf16* MIX, const int gmask) {
    const bf16* QKV = (const bf16*)(F.ws + WS_YS);
    const int lane = F.lane;
    const int gw = F.vcu * NWAVES + F.wave, NGW = F.G * NWAVES;
    for (int item = gw; item < T * 16; item += NGW) {
        const int tok = item >> 4, h = item & 15, b = tok / SEQ, t = tok % SEQ;
        const bf16* Qb = QKV + (size_t)b * SEQ * NQKV;
        float sc[3][3]; int kt[3][3];
        float mx = -INFINITY;
#pragma unroll
        for (int g = 0; g < 3; ++g) {
            const int dil = (g == 0) ? 1 : (g == 1 ? 4 : 16);
            const float slope = exp2f(-8.0f * (float)(g * 16 + h + 1) / 48.0f);
            const bf16* qp = Qb + (size_t)t * NQKV + ((g * 3 + 0) * 16 + h) * 64;
#pragma unroll
            for (int c = 0; c < 3; ++c) {
                const int j = lane + 64 * c; const int tk = t - j * dil;
                float s = -INFINITY;
                if (j <= 128 && tk >= 0 && ((gmask >> g) & 1)) {
                    const bf16* kp = Qb + (size_t)tk * NQKV + ((g * 3 + 1) * 16 + h) * 64;
                    float d = 0.f;
                    for (int e = 0; e < 64; ++e) d += bf2f(qp[e]) * bf2f(kp[e]);
                    s = d - slope * LOG2E * (float)(j * dil);
                }
                sc[g][c] = s; kt[g][c] = tk; mx = fmaxf(mx, s);
            }
        }
#pragma unroll
        for (int o = 1; o < 64; o <<= 1) mx = fmaxf(mx, __shfl_xor(mx, o));
        float den = 0.f; float acc[64];
#pragma unroll
        for (int e = 0; e < 64; ++e) acc[e] = 0.f;
#pragma unroll
        for (int g = 0; g < 3; ++g)
#pragma unroll
            for (int c = 0; c < 3; ++c) {
                const float p = (sc[g][c] == -INFINITY) ? 0.f : exp2f(sc[g][c] - mx);
                den += p;
                if (p != 0.f) { const bf16* vp = Qb + (size_t)kt[g][c] * NQKV + ((g * 3 + 2) * 16 + h) * 64;
#pragma unroll
                    for (int e = 0; e < 64; ++e) acc[e] += p * bf2f(vp[e]); }
            }
        den = wave_sum(den);
        float mine = 0.f;
#pragma unroll
        for (int e = 0; e < 64; ++e) { const float v = wave_sum(acc[e]); if (lane == e) mine = v; }
        MIX[(size_t)tok * D + h * 64 + lane] = (bf16)f2bf(mine / den);
    }
}

struct Args { const float* in[20]; float* out; unsigned char* ws; int ph_lo, ph_hi; };
constexpr int NPHASE = 2 + DEPTH * 8;

__global__ void __launch_bounds__(NWAVES * 64, 2) mk_fwd(Args args) {
    extern __shared__ __attribute__((aligned(16))) unsigned char lds_raw[];
    Frame F;
    F.lds = (LAS unsigned char*)lds_raw; F.lc = F.lds + LDSCTL_OFF;
    F.tid = threadIdx.x; F.lane = F.tid & 63; F.wave = __builtin_amdgcn_readfirstlane(F.tid >> 6);
    F.G = gridDim.x; { const int bx = blockIdx.x; F.vcu = (F.G % 8 == 0) ? (bx % 8) * (F.G / 8) + bx / 8 : bx; }
    F.ws = args.ws; F.ctl = (unsigned*)(args.ws + WS_CTL);
    for (int u = F.tid; u < (LDS_BYTES - LDSCTL_OFF) / 4; u += NWAVES * 64) ((LAS unsigned*)F.lc)[u] = 0u;
    __syncthreads();
    if (F.tid == 0) {
#pragma unroll
        for (int i = 0; i < 20; ++i) *(LAS unsigned long long*)(F.lc + LC_PTR + 8 * i) = (unsigned long long)args.in[i];
        *(LAS unsigned long long*)(F.lc + LC_PTR + 8 * 20) = (unsigned long long)args.out;
    }
    __syncthreads();
#if MK_PER_PHASE
#define GRID_BAR() do { } while (0)
#else
    XcdBarrier bar = xcd_barrier_post(F.ctl + CW_BAR, (volatile LAS unsigned*)(F.lc + LC_MISC) + 8);
#define GRID_BAR() xcd_barrier(bar)
#endif
    const int lo = args.ph_lo, hi = args.ph_hi;
#define IN(k) (lo <= (k) && (k) < hi)
#define SEAM(k) do { if (IN(k) && IN((k) + 1)) GRID_BAR(); } while (0)
    const float* mod = (const float*)(F.ws + WS_MOD);

    if (PHON(0) && IN(0)) { p0_prologue(F); } SEAM(0);
    if (PHON(1) && IN(1)) { p1_modulate(F, inp(F, 0), mod, 0, 1024); } SEAM(1);

    for (int layer = 0; layer < DEPTH; ++layer) {
        const int pb = 2 + layer * 8; const int j = layer >> 1;
        if ((layer & 1) == 0) {
            if (PHON(2) && IN(pb + 0)) { refresh(F); unsigned char* ws = opq(F.ws); (void)ws;
                PlainSched S{T / 256, 4, 256, F.G, (int)blockIdx.x, (const char*)(ws + WS_WPIN) + (size_t)j * 2 * MiB, 2048};
                pg8::EpiStore E{(bf16*)(ws + WS_U), D, nullptr, 0, 0};
                pg8::gemm_phase<pg8::EpiStore, PlainSched>(F.tid, F.lds, (const char*)(ws + WS_H), 2048, 2048, 1024, S, E);
            } SEAM(pb + 0);
            if (PHON(3) && IN(pb + 1)) { refresh(F); unsigned char* ws = opq(F.ws); (void)ws;
                const bf16* U = (const bf16*)(ws + WS_U); bf16* Z = (bf16*)(ws + WS_Z);
                const int gw = F.vcu * NWAVES + F.wave, NGW = F.G * NWAVES;
                for (int it = gw; it < BATCH * 64 * 4; it += NGW) { const int g = it & 3, ch = (it >> 2) & 63, b = it >> 8;
                    if (g == 0) pool_item<2>(U, Z, b, ch * 32, 0, F.lane); else if (g == 1) pool_item<4>(U, Z, b, ch * 32, 1, F.lane);
                    else if (g == 2) pool_item<8>(U, Z, b, ch * 32, 2, F.lane); else pool_item<16>(U, Z, b, ch * 32, 3, F.lane); }
            } SEAM(pb + 1);
            if (PHON(4) && IN(pb + 2)) { refresh(F); unsigned char* ws = opq(F.ws); (void)ws;
                GrpSched S{F.G, (int)blockIdx.x, (const char*)(ws + WS_WPGRP) + (size_t)j * 512 * 1024};
                pg8::EpiStore E{(bf16*)(ws + WS_Y2), D, inp(F, 6) + j * D, 0, 0};
                pg8::gemm_phase<pg8::EpiStore, GrpSched>(F.tid, F.lds, (const char*)(ws + WS_Z), 2048, 512, 256, S, E);
            } SEAM(pb + 2);
            if (PHON(5) && IN(pb + 3)) { refresh(F); unsigned char* ws = opq(F.ws); (void)ws;
                PlainSched S{T / 256, 4, 256, F.G, (int)blockIdx.x, (const char*)(ws + WS_WPOUT) + (size_t)j * 2 * MiB, 2048};
                pg8::EpiStore E{(bf16*)(ws + WS_Y), D, nullptr, 0, 0};
                pg8::gemm_phase<pg8::EpiStore, PlainSched>(F.tid, F.lds, (const char*)(ws + WS_Y2), 2048, 2048, 1024, S, E);
            } SEAM(pb + 3);
        } else {
            if (PHON(6) && IN(pb + 0)) { refresh(F); unsigned char* ws = opq(F.ws); (void)ws;
                PlainSched S{T / 256, NQKV / 256, (T / 256) * (NQKV / 256), F.G, (int)blockIdx.x, (const char*)(ws + WS_WAIN) + (size_t)j * 18 * MiB, 2048};
                pg8::EpiStore E{(bf16*)(ws + WS_YS), NQKV, nullptr, 1, 0};
                pg8::gemm_phase<pg8::EpiStore, PlainSched>(F.tid, F.lds, (const char*)(ws + WS_H), 2048, 2048, 1024, S, E);
            } SEAM(pb + 0);
            if (PHON(7) && IN(pb + 1)) { refresh(F); unsigned char* ws = opq(F.ws); (void)ws;
#ifdef NAIVE_ATTN
                attn_phase_naive(F, (bf16*)(F.ws + WS_Y2), 7);
#ifdef ORACLE
                if (layer == ORACLE_LAYER) { attn_phase_naive(F, (bf16*)(F.ws + WS_Z), ATTN_GMASK); attn_phase(F, (bf16*)(F.ws + WS_U)); }
#endif
#else
                attn_phase(F, (bf16*)(F.ws + WS_Y2));
#endif
            } if (IN(pb + 1) && IN(pb + 3)) GRID_BAR();
            if (IN(pb + 2)) { refresh(F); unsigned char* ws = opq(F.ws); (void)ws;
#ifdef ORACLE
                if (layer == ORACLE_LAYER) { if (blockIdx.x == 0 && F.tid == 0) atomicAdd(F.ctl + 20000, 3276u * 16u);
                    const bf16* A = (const bf16*)(ws + WS_U); const bf16* B = (const bf16*)(ws + WS_Z);
                    const int gw = F.vcu * NWAVES + F.wave, NGW = F.G * NWAVES;
                    for (int tok = gw; tok < T; tok += NGW) { int bad = 0;
                        for (int h = 0; h < 16; ++h) { if (ORACLE_SEL) { const float a = bf2f(A[(size_t)tok * D + h * 64 + F.lane]), b = bf2f(B[(size_t)tok * D + h * 64 + F.lane]);
                            const float e2 = wave_sum((a - b) * (a - b)), n2 = wave_sum(b * b); if (!(e2 <= 0.0025f * n2)) bad += ORACLE_W; } }
                        if (bad && F.lane == 0) atomicAdd(F.ctl + 20000, (unsigned)bad); } }
#endif
            }
            if (PHON(8) && IN(pb + 3)) { refresh(F); unsigned char* ws = opq(F.ws); (void)ws;
                PlainSched S{T / 256, 4, 256, F.G, (int)blockIdx.x, (const char*)(ws + WS_WAOUT) + (size_t)j * 2 * MiB, 2048};
                pg8::EpiStore E{(bf16*)(ws + WS_Y), D, nullptr, 0, 0};
                pg8::gemm_phase<pg8::EpiStore, PlainSched>(F.tid, F.lds, (const char*)(ws + WS_Y2), 2048, 2048, 1024, S, E);
            } SEAM(pb + 3);
        }
        if (PHON(9) && IN(pb + 4)) { refresh(F); unsigned char* ws = opq(F.ws); (void)ws; const float* xin = (layer == 0) ? inp(F, 0) : (const float*)(ws + WS_X); ln1_router_phase(F, layer, xin); } SEAM(pb + 4);
        if (PHON(10) && IN(pb + 5)) { refresh(F); unsigned char* ws = opq(F.ws); (void)ws;
            moe_build_table(F, layer);
            const LAS int* ts = (const LAS int*)(F.lc + LC_TS);
            const int ntile = ts[65];
            MoeSched<true> S{ts, (const LAS int*)(F.lc + LC_CNT), 2, ntile * 2, F.G, (int)blockIdx.x, F.lane, (const int*)(ws + WS_TOKL), (const float*)(ws + WS_WL),
                       (const char*)(ws + WS_WEGU) + (size_t)layer * 64 * MiB, (size_t)1 * MiB, (const char*)(ws + WS_WSHGU) + (size_t)layer * MiB, 2048};
            pg8::EpiGU E{(bf16*)(ws + WS_ACT)};
            pg8::gemm_phase<pg8::EpiGU, MoeSched<true>>(F.tid, F.lds, (const char*)(ws + WS_H), 2048, 2048, 1024, S, E);
        } SEAM(pb + 5);
        if (PHON(11) && IN(pb + 6)) { refresh(F); unsigned char* ws = opq(F.ws); (void)ws;
            moe_build_table(F, layer);
            const LAS int* ts = (const LAS int*)(F.lc + LC_TS);
            const int ntile = ts[65];
            MoeSched<false> S{ts, (const LAS int*)(F.lc + LC_CNT), 4, ntile * 4, F.G, (int)blockIdx.x, F.lane, nullptr, nullptr,
                       (const char*)(ws + WS_WEDN) + (size_t)layer * 32 * MiB, (size_t)512 * 1024, (const char*)(ws + WS_WSHDN) + (size_t)layer * 512 * 1024, 512};
            pg8::EpiStore E{(bf16*)(ws + WS_YS), D, nullptr, 0, 0};
            pg8::gemm_phase<pg8::EpiStore, MoeSched<false>>(F.tid, F.lds, (const char*)(ws + WS_ACT), 512, 512, 256, S, E);
        } SEAM(pb + 6);
        if (PHON(12) && IN(pb + 7)) { refresh(F); unsigned char* ws = opq(F.ws); (void)ws; moe_build_table(F, layer); combine_ln2_phase(F, layer); }
        if (layer < DEPTH - 1) SEAM(pb + 7);
    }
#undef IN
#undef SEAM
}

extern "C" void kernel_launch(void* const* d_in, const int* in_sizes, int n_in, void* d_out, int out_size, void* d_ws, size_t ws_size, hipStream_t stream) {
    static int grid = 0;
    if (grid == 0) {
        if (n_in != 20 || in_sizes[0] != T * D || out_size != T * D || ws_size < WS_END) { fprintf(stderr, "kernel_launch: unexpected shapes / workspace (n_in %d, ws %zu); nothing launched\n", n_in, ws_size); grid = -1; return; }
        int dev = 0, cus = 0, per_cu = 0;
        if (hipGetDevice(&dev) != hipSuccess || hipDeviceGetAttribute(&cus, hipDeviceAttributeMultiprocessorCount, dev) != hipSuccess) { grid = -1; return; }
        if (hipFuncSetAttribute((const void*)mk_fwd, hipFuncAttributeMaxDynamicSharedMemorySize, LDS_BYTES) != hipSuccess) { fprintf(stderr, "kernel_launch: hipFuncSetAttribute failed\n"); grid = -1; return; }
        if (hipOccupancyMaxActiveBlocksPerMultiprocessor(&per_cu, (const void*)mk_fwd, NWAVES * 64, LDS_BYTES) != hipSuccess || per_cu < 1) { fprintf(stderr, "kernel_launch: occupancy query says %d\n", per_cu); }
        (void)hipGetLastError();
        grid = cus;
    }
    if (grid < 0) return;
    if (hipMemsetAsync((char*)d_ws + WS_CTL, 0, CTL_ZERO_BYTES, stream) != hipSuccess) return;
    Args a{};
    for (int i = 0; i < 20; ++i) a.in[i] = (const float*)d_in[i];
    a.out = (float*)d_out; a.ws = (unsigned char*)d_ws;
#if MK_PER_PHASE
    for (int p = 0; p < NPHASE; ++p) { a.ph_lo = p; a.ph_hi = p + 1; hipLaunchKernelGGL(mk_fwd, dim3(grid), dim3(NWAVES * 64), LDS_BYTES, stream, a); }
#else
    a.ph_lo = 0; a.ph_hi = NPHASE;
    hipLaunchKernelGGL(mk_fwd, dim3(grid), dim3(NWAVES * 64), LDS_BYTES, stream, a);
#endif
    const hipError_t le = hipPeekAtLastError();
    if (le != hipSuccess) fprintf(stderr, "kernel_launch: launch failed: %s\n", hipGetErrorName(le));
}
```

```cpp
#include <hip/hip_runtime.h>
#include <cstdio>
#include <cstdint>

#ifndef MK_PER_PHASE
#define MK_PER_PHASE 0
#endif
#define ORACLE_SEL 1
#define ATTN_GMASK 7
#define ORACLE_W 1
#define ORACLE_LAYER 1
#ifndef MK_XLOCAL
#define MK_XLOCAL 1
#endif
#ifndef PHSEL
#define PHSEL 0xFFFF
#endif
#define PHON(n) (((PHSEL) >> (n)) & 1)

#define GAS __attribute__((address_space(1)))
#define LAS __attribute__((address_space(3)))
typedef unsigned short bf16;
typedef short bf16x8 __attribute__((ext_vector_type(8)));
typedef short s16x4 __attribute__((ext_vector_type(4)));
typedef float f32x2 __attribute__((ext_vector_type(2)));
typedef float f32x4 __attribute__((ext_vector_type(4)));
typedef float f32x16 __attribute__((ext_vector_type(16)));
typedef unsigned u32x2 __attribute__((ext_vector_type(2)));
typedef unsigned u32x4 __attribute__((ext_vector_type(4)));

constexpr int BATCH = 8, SEQ = 2048, D = 1024, T = BATCH * SEQ, DEPTH = 4;
constexpr int NQKV = 9216, NE = 64, TOPK = 8, DEXP = 256;
constexpr int CAP = 16384;
constexpr int PSLOT = 147456 + T;
constexpr float ALPHA = 1.6817928305074290f;
constexpr float LN_EPS = 1e-5f;
constexpr float LOG2E = 1.4426950408889634f;
constexpr float QSCALE = 0.125f * LOG2E;
constexpr float ROUTED_SCALE = 2.5f;

constexpr size_t MiB = 1u << 20;
constexpr size_t WS_CTL = 0, CTL_ZERO_BYTES = 1 * MiB;
constexpr size_t WS_MOD = 1 * MiB;
constexpr size_t WS_WRHI = 2 * MiB;
constexpr size_t WS_WRLO = WS_WRHI + 512 * 1024;
constexpr size_t WS_WPIN = 3 * MiB;
constexpr size_t WS_WPGRP = 7 * MiB;
constexpr size_t WS_WPOUT = 8 * MiB;
constexpr size_t WS_WAIN = 12 * MiB;
constexpr size_t WS_WAOUT = 48 * MiB;
constexpr size_t WS_WSHGU = 52 * MiB;
constexpr size_t WS_WSHDN = 56 * MiB;
constexpr size_t WS_WEGU = 58 * MiB;
constexpr size_t WS_WEDN = 314 * MiB;
constexpr size_t WS_X = 442 * MiB;
constexpr size_t WS_H = 506 * MiB;
constexpr size_t WS_Y = 538 * MiB;
constexpr size_t WS_U = 570 * MiB;
constexpr size_t WS_Z = 602 * MiB;
constexpr size_t WS_Y2 = 634 * MiB;
constexpr size_t WS_YS = 666 * MiB;
constexpr size_t WS_ACT = 986 * MiB;
constexpr size_t WS_TOKL = 1066 * MiB;
constexpr size_t WS_WL = 1070 * MiB;
constexpr size_t WS_TSLOT = 1074 * MiB;
constexpr size_t WS_QKV = 1076 * MiB;
constexpr size_t WS_END = 1364 * MiB;
static_assert(WS_YS + (size_t)PSLOT * 2048 <= WS_ACT && WS_ACT + (size_t)PSLOT * 512 <= WS_TOKL, "ws map");
constexpr int CW_BAR = 4096;
constexpr int CW_CNT = 12288;

constexpr int RING_BYTES = 135168;
constexpr int LDSCTL_OFF = RING_BYTES;
constexpr int LDS_TB_OFF = 147456;
constexpr int LDS_BYTES = 163840;
constexpr int LC_MISC = 0;
constexpr int LC_TS = 128;
constexpr int LC_CNT = 128 + 272;
constexpr int LC_LCNT = 128 + 272 + 256;
constexpr int LC_GB = 128 + 272 + 512;

#define RLX_AGENT __ATOMIC_RELAXED, __HIP_MEMORY_SCOPE_AGENT
#define LDS_WAIT() asm volatile("s_waitcnt lgkmcnt(0)" ::: "memory")
#define VM_WAIT() asm volatile("s_waitcnt vmcnt(0)" ::: "memory")

typedef __bf16 b16x2 __attribute__((ext_vector_type(2)));
__device__ __forceinline__ unsigned f2bf(float f) { unsigned u = __builtin_bit_cast(unsigned, f); return (u + 0x7fffu + ((u >> 16) & 1u)) >> 16; }
__device__ __forceinline__ unsigned pk2(float lo, float hi) { const f32x2 v = {lo, hi}; return __builtin_bit_cast(unsigned, __builtin_convertvector(v, b16x2)); }
__device__ __forceinline__ float bf2f(unsigned h) { return __builtin_bit_cast(float, h << 16); }
__device__ __forceinline__ unsigned cvt_pk_bf16(float lo, float hi) { return pk2(lo, hi); }
typedef _Float16 h16x2 __attribute__((ext_vector_type(2)));
__device__ __forceinline__ unsigned pkh2(float lo, float hi) { const f32x2 v = {lo, hi}; return __builtin_bit_cast(unsigned, __builtin_convertvector(v, h16x2)); }
__device__ __forceinline__ float h2f(unsigned h) { return (float)__builtin_bit_cast(_Float16, (unsigned short)h); }
#define MFMA16(a, b, c) __builtin_amdgcn_mfma_f32_16x16x32_bf16(a, b, c, 0, 0, 0)
#define MFMA32(a, b, c) __builtin_amdgcn_mfma_f32_32x32x16_bf16(a, b, c, 0, 0, 0)
__device__ __forceinline__ float wave_sum(float v) {
#pragma unroll
    for (int o = 1; o < 64; o <<= 1) v += __shfl_xor(v, o);
    return v;
}

namespace pg8 {
constexpr int BM = 256, BK = 64, HALF = 128, HTB = HALF * BK * 2, STAGE_BYTES = 8 * HTB, NXCD = 8;
__host__ __device__ __forceinline__ int lds_byte(int r, int c) { const int st = (r >> 4) * 2 + (c >> 5), rr = r & 15, cc = c & 31, ob = rr * 64 + cc * 2; return st * 1024 + (ob ^ (((ob >> 9) & 1) << 5)); }
__host__ __device__ __forceinline__ void stage_rc(int b, int& R, int& C) { const int st = b / 1024, sb = b % 1024, swz = sb ^ (((sb >> 9) & 1) << 5); R = (st >> 1) * 16 + swz / 64; C = (st & 1) * 32 + (swz % 64) / 2; }
__host__ __device__ __forceinline__ int perm32(int rho) { const int n = rho >> 4, i = rho & 15; return 8 * (i >> 2) + 4 * n + (i & 3); }

struct Unit {
    int pm, pn;
    const char* bptr;
    int roff;
    int nvalid;
};

__device__ __forceinline__ int xcd_chunk(int L, int nwg) { const int q = nwg / NXCD, r = nwg % NXCD, xcd = L % NXCD, off = L / NXCD; return (xcd < r ? xcd * (q + 1) : r * (q + 1) + (xcd - r) * q) + off; }

template <class Epi, class Sched>
__device__ __forceinline__ void gemm_phase(const int tid, LAS unsigned char* lds, const char* Abase, const int lda, const int ldb, const int K, const Sched& S, const Epi& E) {
    constexpr bool GATHER = Sched::GATHER;
    const int wid = __builtin_amdgcn_readfirstlane(tid >> 6), lane = tid & 63, wr = wid >> 2, wc = wid & 3, fr = lane & 15, fq = lane >> 4;
    const int nt = K / BK;
    int Rr[2]; unsigned C2[2], voffB[2], voffA[2];
#pragma unroll
    for (int i = 0; i < 2; ++i) { int R, C; stage_rc(tid * 16 + i * 8192, R, C); const int Rb = Epi::WIDE ? ((R >> 5) * 64 + perm32(R & 31)) : ((R & ~31) + perm32(R & 31)); Rr[i] = R; C2[i] = (unsigned)C * 2u; voffB[i] = (unsigned)(Rb * ldb) + (unsigned)C * 2u;
        voffA[i] = Sched::ABLK ? (unsigned)((C >> 5) * 16384 + R * 64 + (C & 31) * 2) : ((unsigned)(R * lda) + (unsigned)C * 2u); }
    const size_t kstep = (size_t)(BK * 2);
    const size_t hstepB = (size_t)(Epi::WIDE ? 32 : HALF) * ldb;
    const size_t hstepA = GATHER ? (size_t)0 : (Sched::ABLK ? (size_t)8192 : (size_t)HALF * lda);
    const size_t kstepA = Sched::ABLK ? (size_t)32768 : kstep;
    const unsigned ldsw = (unsigned)wid * 1024u;
    const int aoff = lds_byte(wr * 64 + fr, fq * 8), boff = lds_byte(wc * 32 + fr, fq * 8);
#define PG8_SA(b, h) (((b) * 2 + (h)) * HTB)
#define PG8_SB(b, h) ((4 + (b) * 2 + (h)) * HTB)
#define PG8_STAGE(bufoff, gbase, voff) do { _Pragma("unroll") for (int _i = 0; _i < 2; ++_i) \
        __builtin_amdgcn_global_load_lds((const unsigned*)((const char*)(gbase) + (voff)[_i]), (LAS unsigned*)(lds + (bufoff) + ldsw + _i * 8192), 16, 0, 0); } while (0)
#define PG8_STAGEA(bufoff, gbase, h) do { if constexpr (GATHER) { PG8_STAGE(bufoff, gbase, vA[h]); } else { PG8_STAGE(bufoff, (gbase) + (h) * hstepA, voffA); } } while (0)
#define PG8_LDA(dst, b, h) do { _Pragma("unroll") for (int m = 0; m < 4; ++m) _Pragma("unroll") for (int k = 0; k < 2; ++k) dst[m][k] = *(const LAS bf16x8*)(lds + PG8_SA(b, h) + aoff + m * 2048 + k * 1024); } while (0)
#define PG8_LDB(dst, b, h) do { _Pragma("unroll") for (int n = 0; n < 2; ++n) _Pragma("unroll") for (int k = 0; k < 2; ++k) dst[n][k] = *(const LAS bf16x8*)(lds + PG8_SB(b, h) + boff + n * 2048 + k * 1024); } while (0)
#define PG8_MMA(ai, bj, At, Bt) do { __builtin_amdgcn_s_setprio(1); _Pragma("unroll") for (int m = 0; m < 4; ++m) _Pragma("unroll") for (int n = 0; n < 2; ++n) _Pragma("unroll") for (int k = 0; k < 2; ++k) \
        acc[ai][bj][m][n] = MFMA16(Bt[n][k], At[m][k], acc[ai][bj][m][n]); __builtin_amdgcn_s_setprio(0); } while (0)
#define PG8_WAIT_V(n) asm volatile("s_waitcnt vmcnt(" #n ")" ::: "memory")
#define PG8_WAIT_L(n) asm volatile("s_waitcnt lgkmcnt(" #n ")" ::: "memory")
#define PG8_BAR __builtin_amdgcn_s_barrier()
#define PG8_SCHED __builtin_amdgcn_sched_barrier(0)
#define PG8_CALCA(u, vo) do { _Pragma("unroll") for (int _h = 0; _h < 2; ++_h) _Pragma("unroll") for (int _i = 0; _i < 2; ++_i) \
        vo[_h][_i] = (unsigned)S.arow(u, _h * HALF + Rr[_i]) * (unsigned)lda + C2[_i]; } while (0)
    Unit cur, nxt; int ui = 0;
    if (!S.next(0, cur)) return;
    f32x4 acc[2][2][4][2];
#pragma unroll
    for (int a = 0; a < 2; ++a)
#pragma unroll
        for (int b = 0; b < 2; ++b)
#pragma unroll
            for (int m = 0; m < 4; ++m)
#pragma unroll
                for (int n = 0; n < 2; ++n) acc[a][b][m][n] = (f32x4){0.f, 0.f, 0.f, 0.f};
    bf16x8 At[4][2], B0[2][2], B1[2][2];
    unsigned vA[2][2], vAn[2][2];
    const char* cA = Abase;
    if constexpr (GATHER) { PG8_CALCA(cur, vA); } else { cA = Abase + (size_t)S.arow(cur, 0) * lda + S.acolb(cur); }
    const char* cB = cur.bptr;
    PG8_STAGE(PG8_SB(0, 0), cB, voffB); PG8_STAGE(PG8_SB(0, 1), cB + hstepB, voffB); PG8_STAGEA(PG8_SA(0, 0), cA, 0); PG8_STAGEA(PG8_SA(0, 1), cA, 1);
    if (wr == 1) PG8_BAR;
    PG8_WAIT_V(2); PG8_BAR;
    PG8_STAGE(PG8_SB(1, 0), cB + kstep, voffB); PG8_STAGEA(PG8_SA(1, 0), cA + kstepA, 0); PG8_STAGE(PG8_SB(1, 1), cB + hstepB + kstep, voffB);
    PG8_WAIT_V(6); PG8_BAR;
    for (;;) {
        const bool has_next = S.next(ui + 1, nxt);
        float rs[2][4];
        if constexpr (Epi::ROWSCALE) {
#pragma unroll
            for (int ai = 0; ai < 2; ++ai)
#pragma unroll
                for (int m = 0; m < 4; ++m) rs[ai][m] = S.rowscale(cur, ai * HALF + wr * 64 + m * 16 + fr);
        }
        const char* nA = cA;
        if constexpr (GATHER) {
            if (has_next) { PG8_CALCA(nxt, vAn); }
            else {
#pragma unroll
                for (int h = 0; h < 2; ++h)
#pragma unroll
                    for (int i = 0; i < 2; ++i) vAn[h][i] = vA[h][i];
            }
            asm volatile("s_waitcnt vmcnt(0)" : "+v"(vAn[0][0]), "+v"(vAn[0][1]), "+v"(vAn[1][0]), "+v"(vAn[1][1]) :: "memory");
            if constexpr (Epi::ROWSCALE) { asm volatile("" : "+v"(rs[0][0]), "+v"(rs[0][1]), "+v"(rs[0][2]), "+v"(rs[0][3]), "+v"(rs[1][0]), "+v"(rs[1][1]), "+v"(rs[1][2]), "+v"(rs[1][3])); }
        } else { if (has_next) nA = Abase + (size_t)S.arow(nxt, 0) * lda + S.acolb(nxt); }
        const char* nB = has_next ? nxt.bptr : cB;
#pragma unroll 1
        for (int t = 0; t < nt; t += 2) {
            const bool last = (t == nt - 2);
            const char* a1 = cA + (size_t)(t + 1) * kstepA;
            const char* a2 = last ? nA : cA + (size_t)(t + 2) * kstepA; const char* b2 = last ? nB : cB + (size_t)(t + 2) * kstep;
            const char* a3 = a2 + kstepA; const char* b3 = b2 + kstep;
            PG8_LDB(B0, 0, 0); PG8_LDB(B1, 0, 1); PG8_SCHED; PG8_LDA(At, 0, 0); PG8_STAGEA(PG8_SA(1, 1), a1, 1);
            if constexpr (GATHER) { if (last) {
#pragma unroll
                for (int h = 0; h < 2; ++h)
#pragma unroll
                    for (int i = 0; i < 2; ++i) vA[h][i] = vAn[h][i]; } }
            PG8_WAIT_V(8); PG8_WAIT_L(0); PG8_BAR; PG8_MMA(0, 0, At, B0); PG8_MMA(0, 1, At, B1); PG8_BAR; PG8_SCHED;
            PG8_LDA(At, 0, 1); PG8_STAGE(PG8_SB(0, 0), b2, voffB); PG8_STAGE(PG8_SB(0, 1), b2 + hstepB, voffB); PG8_STAGEA(PG8_SA(0, 0), a2, 0);
            PG8_WAIT_V(8); PG8_WAIT_L(0); PG8_BAR; PG8_MMA(1, 0, At, B0); PG8_MMA(1, 1, At, B1); PG8_BAR; PG8_SCHED;
            PG8_LDB(B0, 1, 0); PG8_LDB(B1, 1, 1); PG8_SCHED; PG8_LDA(At, 1, 0); PG8_STAGEA(PG8_SA(0, 1), a2, 1);
            PG8_WAIT_V(8); PG8_WAIT_L(0); PG8_BAR; PG8_MMA(0, 0, At, B0); PG8_MMA(0, 1, At, B1); PG8_BAR; PG8_SCHED;
            PG8_LDA(At, 1, 1); PG8_STAGE(PG8_SB(1, 0), b3, voffB); PG8_STAGE(PG8_SB(1, 1), b3 + hstepB, voffB); PG8_STAGEA(PG8_SA(1, 0), a3, 0);
            PG8_WAIT_V(8); PG8_WAIT_L(0); PG8_BAR; PG8_MMA(1, 0, At, B0); PG8_MMA(1, 1, At, B1); PG8_BAR; PG8_SCHED;
        }
        if (wr == 0) PG8_BAR;
        E(acc, cur, rs, wr, wc, fr, fq);
        if (!has_next) break;
#pragma unroll
        for (int a = 0; a < 2; ++a)
#pragma unroll
            for (int b = 0; b < 2; ++b)
#pragma unroll
                for (int m = 0; m < 4; ++m)
#pragma unroll
                    for (int n = 0; n < 2; ++n) acc[a][b][m][n] = (f32x4){0.f, 0.f, 0.f, 0.f};
        cur = nxt; cB = nB; cA = nA; ++ui;
        if (wr == 1) PG8_BAR;
    }
    PG8_WAIT_V(0);
    PG8_BAR;
#undef PG8_SA
#undef PG8_SB
#undef PG8_STAGE
#undef PG8_STAGEA
#undef PG8_LDA
#undef PG8_LDB
#undef PG8_MMA
#undef PG8_WAIT_V
#undef PG8_WAIT_L
#undef PG8_BAR
#undef PG8_SCHED
#undef PG8_CALCA
}

struct EpiStore {
    static constexpr bool ROWSCALE = false, WIDE = true;
    bf16* O; int ldc; const float* cscale; int qmode; int ntst; int f16; LAS unsigned char* tb;
    __device__ __forceinline__ void operator()(const f32x4 (&acc)[2][2][4][2], const Unit& u, const float (&rs)[2][4], int wr, int wc, int fr, int fq) const {
        const int colw = u.pn * BM + wc * 64;
        float sc = 1.f; if (qmode) { if ((((u.pn * BM) >> 10) % 3) == 0) sc = QSCALE; }
        f32x4 cs[2][2];
#pragma unroll
        for (int bj = 0; bj < 2; ++bj)
#pragma unroll
            for (int n = 0; n < 2; ++n) { cs[bj][n] = cscale ? *(const f32x4*)(cscale + colw + 32 * bj + 8 * fq + 4 * n) : (f32x4){1.f, 1.f, 1.f, 1.f}; cs[bj][n] = cs[bj][n] * sc; }
        const int L = fr + 16 * fq, rr = L >> 3, sg = L & 7;
        LAS u32x4* tbv = (LAS u32x4*)tb;
        const int wi0 = fr * 8 + (fq ^ (fr & 7)), wi1 = fr * 8 + ((4 + fq) ^ (fr & 7)), ri = rr * 8 + (sg ^ rr);
        bf16* gp = O + (size_t)(u.pm * BM + wr * 64 + rr) * ldc + colw + sg * 8;
#pragma unroll
        for (int ai = 0; ai < 2; ++ai)
#pragma unroll
            for (int m = 0; m < 4; ++m) {
                u32x4 w[2];
#pragma unroll
                for (int bj = 0; bj < 2; ++bj) { const f32x4 v0 = acc[ai][bj][m][0] * cs[bj][0], v1 = acc[ai][bj][m][1] * cs[bj][1];
                    if (f16) { w[bj].x = pkh2(v0[0], v0[1]); w[bj].y = pkh2(v0[2], v0[3]); w[bj].z = pkh2(v1[0], v1[1]); w[bj].w = pkh2(v1[2], v1[3]); }
                    else { w[bj].x = cvt_pk_bf16(v0[0], v0[1]); w[bj].y = cvt_pk_bf16(v0[2], v0[3]); w[bj].z = cvt_pk_bf16(v1[0], v1[1]); w[bj].w = cvt_pk_bf16(v1[2], v1[3]); } }
                tbv[wi0] = w[0]; tbv[wi1] = w[1];
                asm volatile("" ::: "memory");
                const u32x4 r0 = tbv[ri], r1 = tbv[ri + 64];
                asm volatile("" ::: "memory");
                bf16* rowp = gp + (size_t)(ai * HALF + m * 16) * ldc;
                if (ntst) { __builtin_nontemporal_store(r0, (u32x4*)rowp); __builtin_nontemporal_store(r1, (u32x4*)(rowp + (size_t)8 * ldc)); }
                else { *(u32x4*)rowp = r0; *(u32x4*)(rowp + (size_t)8 * ldc) = r1; } }
    }
};
struct EpiGU {
    static constexpr bool ROWSCALE = false, WIDE = false;
    bf16* O;
    __device__ __forceinline__ void operator()(const f32x4 (&acc)[2][2][4][2], const Unit& u, const float (&rs)[2][4], int wr, int wc, int fr, int fq) const {
        bf16* tp = O + (size_t)u.pm * (BM * DEXP) + (size_t)(u.pn * 4 + wc) * (BM * 32) + (wr * 64 + fr) * 32 + 8 * fq;
#pragma unroll
        for (int ai = 0; ai < 2; ++ai)
#pragma unroll
            for (int m = 0; m < 4; ++m) { bf16* rowp = tp + (ai * HALF + m * 16) * 32;
                float o[8];
#pragma unroll
                for (int n = 0; n < 2; ++n)
#pragma unroll
                    for (int j = 0; j < 4; ++j) { const float g = acc[ai][0][m][n][j], uu = acc[ai][1][m][n][j];
                        const float sg = g * __builtin_amdgcn_rcpf(1.0f + __builtin_amdgcn_exp2f(-g * LOG2E)); o[n * 4 + j] = sg * uu; }
                u32x4 wv; wv.x = cvt_pk_bf16(o[0], o[1]); wv.y = cvt_pk_bf16(o[2], o[3]); wv.z = cvt_pk_bf16(o[4], o[5]); wv.w = cvt_pk_bf16(o[6], o[7]);
                *(u32x4*)rowp = wv; }
    }
};
}

#define XB_TMO      128
#define XB_XCNT(j)  (256  + 64 * (j))
#define XB_XSUB(j)  (1280 + 64 * (j))
#define XB_XGEN(j)  (2304 + 64 * (j))
#define XB_TOP      3328
#define XB_TOPGEN   3392
#define XB_LSUB(j)  (3456 + 64 * (j))
#define XB_LGEN(j)  (4480 + 64 * (j))
#define XCD_BAR_WORDS 5504
#define XB_SPIN_CAP (1u << 18)
__device__ __forceinline__ unsigned xb_ld(unsigned* p)              { return __hip_atomic_load(p, __ATOMIC_RELAXED, __HIP_MEMORY_SCOPE_AGENT); }
__device__ __forceinline__ unsigned xb_add(unsigned* p, unsigned v) { return __hip_atomic_fetch_add(p, v, __ATOMIC_RELAXED, __HIP_MEMORY_SCOPE_AGENT); }
__device__ __forceinline__ unsigned xb_xcc_id() { return (unsigned)__builtin_amdgcn_s_getreg((3 << 11) | 20) & 0xFu; }
#define XB_SPIN(cond, bar) do { unsigned _sp = 0; while (cond) { __builtin_amdgcn_s_sleep(1); \
    if ((++_sp & 255u) == 0u) { if (xb_ld(&(bar)[XB_TMO])) break; if (_sp > XB_SPIN_CAP) { atomicAdd(&(bar)[XB_TMO], 1u); break; } } } } while (0)
struct XcdBarrier { unsigned* bar; unsigned x; volatile LAS unsigned* st; };
__device__ __forceinline__ XcdBarrier xcd_barrier_post(unsigned* bar, volatile LAS unsigned* st) {
    XcdBarrier b; b.bar = bar; b.x = xb_xcc_id(); b.st = st;
    if (threadIdx.x == 0) st[2] = xb_add(&bar[XB_XCNT(b.x)], 1u);
    return b;
}
__device__ __forceinline__ void xcd_local_barrier(const XcdBarrier& b, const bool wave0) {
    asm volatile("s_waitcnt vmcnt(0)" ::: "memory");
    __syncthreads();
    if (wave0 && __builtin_amdgcn_mbcnt_hi(~0u, __builtin_amdgcn_mbcnt_lo(~0u, 0u)) == 0u) {
        unsigned* bar = b.bar;
        __builtin_amdgcn_s_waitcnt(0);
        const unsigned nloc = b.st[0];
        const unsigned old = xb_add(&bar[XB_LSUB(b.x)], 1u);
        const unsigned gen = old / nloc;
        if (old + 1u == (gen + 1u) * nloc) xb_add(&bar[XB_LGEN(b.x)], 1u);
        else XB_SPIN(xb_ld(&bar[XB_LGEN(b.x)]) == gen, bar);
        __builtin_amdgcn_fence(__ATOMIC_ACQUIRE, "agent");
        asm volatile("s_waitcnt vmcnt(0)" ::: "memory");
    }
    __syncthreads();
}
__device__ __forceinline__ void xcd_barrier_complete(unsigned* bar, unsigned x, unsigned& nloc, unsigned& nx) {
    const unsigned G = gridDim.x * gridDim.y * gridDim.z;
    unsigned sum, cnt, mine, sp = 0u;
    for (;;) {
        sum = 0u; cnt = 0u; mine = 0u;
#pragma unroll
        for (unsigned j = 0; j < 16; ++j) { const unsigned c = xb_ld(&bar[XB_XCNT(j)]); sum += c; cnt += (c > 0u) ? 1u : 0u; mine = (j == x) ? c : mine; }
        if (sum == G) break;
        __builtin_amdgcn_s_sleep(1);
        if ((++sp & 255u) == 0u) { if (xb_ld(&bar[XB_TMO])) break; if (sp > XB_SPIN_CAP) { atomicAdd(&bar[XB_TMO], 1u); break; } }
    }
    nloc = mine > 0u ? mine : 1u; nx = cnt > 0u ? cnt : 1u;
}
__device__ __forceinline__ void xcd_barrier(const XcdBarrier& b) {
    asm volatile("s_waitcnt vmcnt(0)" ::: "memory");
    __syncthreads();
    if (threadIdx.x == 0) {
        unsigned* bar = b.bar;
        __builtin_amdgcn_s_waitcnt(0);
        unsigned nloc = b.st[0], nx = b.st[1];
        if (nloc == 0u) { xcd_barrier_complete(bar, b.x, nloc, nx); b.st[0] = nloc; b.st[1] = nx; }
        const unsigned old = xb_add(&bar[XB_XSUB(b.x)], 1u);
        const unsigned gen = old / nloc;
        if (old + 1u == (gen + 1u) * nloc) {
            __builtin_amdgcn_fence(__ATOMIC_RELEASE, "agent");
            asm volatile("s_waitcnt vmcnt(0)" ::: "memory");
            const unsigned og = xb_add(&bar[XB_TOP], 1u);
            const unsigned tg = og / nx;
            if (og + 1u == (tg + 1u) * nx) xb_add(&bar[XB_TOPGEN], 1u);
            else XB_SPIN(xb_ld(&bar[XB_TOPGEN]) == tg, bar);
            __builtin_amdgcn_fence(__ATOMIC_ACQUIRE, "agent");
            xb_add(&bar[XB_XGEN(b.x)], 1u);
            asm volatile("s_waitcnt vmcnt(0)" ::: "memory");
        } else {
            XB_SPIN(xb_ld(&bar[XB_XGEN(b.x)]) == gen, bar);
            __builtin_amdgcn_fence(__ATOMIC_ACQUIRE, "agent");
            asm volatile("s_waitcnt vmcnt(0)" ::: "memory");
        }
    }
    __syncthreads();
}

constexpr int NWAVES = 8;
struct Frame {
    LAS unsigned char* lds;
    LAS unsigned char* lc;
    unsigned* ctl;
    unsigned char* ws;
    int tid, lane, wave, vcu, G;
};
constexpr int LC_PTR = 2048;
__device__ __forceinline__ const float* inp(const Frame& F, int i) {
    const unsigned long long v = *(const LAS unsigned long long*)(F.lc + LC_PTR + 8 * i);
    const unsigned lo = __builtin_amdgcn_readfirstlane((unsigned)v), hi = __builtin_amdgcn_readfirstlane((unsigned)(v >> 32));
    return (const float*)(const GAS float*)(((unsigned long long)hi << 32) | lo);
}
__device__ __forceinline__ unsigned char* opq(unsigned char* p) { GAS unsigned char* g = (GAS unsigned char*)p; asm volatile("" : "+s"(g)); return (unsigned char*)g; }
__device__ __forceinline__ void refresh(Frame& F) { asm volatile("" : "+v"(F.tid)); F.lane = F.tid & 63; F.wave = __builtin_amdgcn_readfirstlane(F.tid >> 6); }

struct PlainSched {   static constexpr bool GATHER = false, ABLK = false;
    int nM, nN, nwg, G, c; const char* B; int ldb;
    __device__ __forceinline__ bool next(int i, pg8::Unit& u) const {
        const int L = i * G + c; if (L >= nwg) return false;
        const int wgid = pg8::xcd_chunk(L, nwg);
        const int nig = 8 * nN, gid = wgid / nig, fm = gid * 8, gsz = (nM - fm) < 8 ? (nM - fm) : 8;
        u.pm = fm + ((wgid % nig) % gsz); u.pn = (wgid % nig) / gsz;
        u.bptr = B + (size_t)u.pn * 256 * ldb; u.roff = -(u.pm * 256) - 1; u.nvalid = 256; return true;
    }
    __device__ __forceinline__ int arow(const pg8::Unit& u, int r) const { return -u.roff - 1 + r; }
    __device__ __forceinline__ int acolb(const pg8::Unit&) const { return 0; }
    __device__ __forceinline__ float rowscale(const pg8::Unit&, int) const { return 1.0f; }
};
struct GrpSched {     static constexpr bool GATHER = false, ABLK = false;
    int G, c; const char* B;
    __device__ __forceinline__ bool next(int i, pg8::Unit& u) const {
        const int L = i * G + c; if (L >= 256) return false;
        const int wgid = pg8::xcd_chunk(L, 256);
        u.pm = wgid >> 2; u.pn = wgid & 3; u.bptr = B + (size_t)u.pn * 256 * 512; u.roff = -(u.pm * 256) - 1; u.nvalid = 256; return true;
    }
    __device__ __forceinline__ int arow(const pg8::Unit& u, int r) const { return -u.roff - 1 + r; }
    __device__ __forceinline__ int acolb(const pg8::Unit& u) const { return u.pn * 512; }
    __device__ __forceinline__ float rowscale(const pg8::Unit&, int) const { return 1.0f; }
};
template <bool GATHER_> struct MoeSched {     static constexpr bool GATHER = GATHER_, ABLK = !GATHER_;
    const LAS int* ts; const LAS int* cn; int npn, nunits, G, c, lane_;
    const int* tokl; const float* wl; const char* Bexp; size_t bstride; const char* Bsh; int ldb;
    __device__ __forceinline__ bool next(int i, pg8::Unit& u) const {
        const int L = i * G + c; const int xg = L % pg8::NXCD, off = L / pg8::NXCD;
        const int ntile = nunits / npn, tq = ntile / pg8::NXCD, tr = ntile % pg8::NXCD;
        const int tcnt = tq + (xg < tr ? 1 : 0), tstart = xg * tq + (xg < tr ? xg : tr);
        if (off >= tcnt * npn) return false;
        const int tile = tstart + off / npn, pn = off % npn;
        const int lane = lane_;
        const bool hit = (tile >= ts[lane]) && (tile < ts[lane + 1]);
        const unsigned long long mk = __ballot(hit);
        const int e = mk ? (int)__builtin_ctzll(mk) : 64;
        const int tse = __builtin_amdgcn_readfirstlane(ts[e]);
        const int r0 = (tile - tse) * 256;
        u.pm = tile; u.pn = pn;
        u.bptr = (e < 64 ? Bexp + (size_t)e * bstride : Bsh) + (size_t)pn * 256 * ldb;
        if (GATHER) {
            if (e < 64) { const int ce = __builtin_amdgcn_readfirstlane(cn[e]); u.roff = e * CAP + r0; u.nvalid = (ce - r0) < 256 ? (ce - r0) : 256; }
            else { u.roff = -r0 - 1; u.nvalid = 256; }
        } else { u.roff = -(tile * 256) - 1; u.nvalid = 256; }
        return true;
    }
    __device__ __forceinline__ int arow(const pg8::Unit& u, int r) const { if (GATHER && u.roff >= 0) { const int rr = r < u.nvalid ? r : u.nvalid - 1; return tokl[u.roff + rr]; } return -u.roff - 1 + r; }
    __device__ __forceinline__ int acolb(const pg8::Unit&) const { return 0; }
    __device__ __forceinline__ float rowscale(const pg8::Unit& u, int r) const { if (GATHER && u.roff >= 0) { const int rr = r < u.nvalid ? r : u.nvalid - 1; return wl[u.roff + rr]; } return 1.0f; }
};

__device__ __forceinline__ void p0_transpose_item64(const float* W, int K, int N, bf16* WT, int dst_n0, LAS float* scr, int kb, int nb, int lane) {
    const int k0 = 64 * kb, n0 = 64 * nb; const int r = lane >> 4, c4 = lane & 15;
    f32x4 v[16];
#pragma unroll
    for (int i = 0; i < 16; ++i) v[i] = *(const GAS f32x4*)(W + (size_t)(k0 + 4 * i + r) * N + n0 + 4 * c4);
#pragma unroll
    for (int i = 0; i < 16; ++i) { const int k = 4 * i + r; *(LAS f32x4*)(scr + k * 64 + 4 * (c4 ^ (k >> 3))) = v[i]; }
    LDS_WAIT(); asm volatile("" ::: "memory");
    const int c = lane & 7;
#pragma unroll
    for (int j = 0; j < 8; ++j) { const int n = (lane >> 3) + 8 * j; const LAS float* sp = scr + (8 * c) * 64 + 4 * ((n >> 2) ^ c) + (n & 3);
        u32x4 o; o.x = pk2(sp[0 * 64], sp[1 * 64]); o.y = pk2(sp[2 * 64], sp[3 * 64]); o.z = pk2(sp[4 * 64], sp[5 * 64]); o.w = pk2(sp[6 * 64], sp[7 * 64]);
        *(GAS u32x4*)(WT + (size_t)(dst_n0 + n) * K + k0 + 8 * c) = o; }
    LDS_WAIT(); asm volatile("" ::: "memory");
}
__device__ __forceinline__ void p0_router_item(const float* W, bf16* WH, bf16* WLo, LAS float* scr, int kb, int nb, int lane) {
    const int K = 1024, N = 64; const int k0 = 64 * kb, n0 = 32 * nb;
#pragma unroll 8
    for (int i = 0; i < 32; ++i) { const int kk = 2 * i + (lane >> 5); scr[kk * 33 + (lane & 31)] = W[(size_t)(k0 + kk) * N + n0 + (lane & 31)]; }
    LDS_WAIT(); asm volatile("" ::: "memory");
    const int c = lane & 7;
#pragma unroll
    for (int j = 0; j < 4; ++j) { const int n = (lane >> 3) + 8 * j; const LAS float* s = scr + (8 * c) * 33 + n;
        unsigned h[8], l[8];
#pragma unroll
        for (int q = 0; q < 8; ++q) { const float v = s[q * 33]; h[q] = f2bf(v); l[q] = f2bf(v - bf2f(h[q])); }
        u32x4 oh, ol; oh.x = h[0] | (h[1] << 16); oh.y = h[2] | (h[3] << 16); oh.z = h[4] | (h[5] << 16); oh.w = h[6] | (h[7] << 16);
        ol.x = l[0] | (l[1] << 16); ol.y = l[2] | (l[3] << 16); ol.z = l[4] | (l[5] << 16); ol.w = l[6] | (l[7] << 16);
        *(GAS u32x4*)(WH + (size_t)(n0 + n) * K + k0 + 8 * c) = oh; *(GAS u32x4*)(WLo + (size_t)(n0 + n) * K + k0 + 8 * c) = ol; }
    LDS_WAIT(); asm volatile("" ::: "memory");
}

__device__ __forceinline__ void p0_prologue(Frame& F) {
    LAS float* cs = (LAS float*)(F.lds);
    LAS float* part = (LAS float*)(F.lds + 32768);
    const float* c = inp(F, 1);
    for (int i = F.tid; i < 8 * 1024; i += 512) { const float v = c[i]; cs[i] = v / (1.0f + __expf(-v)); }
    __syncthreads();
    float* mod = (float*)(F.ws + WS_MOD);
    for (int it = F.vcu; it < 4 * 96; it += F.G) {
        const int layer = it / 96, slab = it % 96; const int col = slab * 64 + F.lane;
        const float* W = inp(F, 2) + (size_t)layer * 1024 * 6144 + col;
        float a[8];
#pragma unroll
        for (int b = 0; b < 8; ++b) a[b] = 0.f;
        const int k0 = F.wave * 128;
#pragma unroll 4
        for (int k = 0; k < 128; k += 4) {
            float w[4];
#pragma unroll
            for (int j = 0; j < 4; ++j) w[j] = W[(size_t)(k0 + k + j) * 6144];
#pragma unroll
            for (int b = 0; b < 8; ++b) { const f32x4 cv = *(const LAS f32x4*)(cs + b * 1024 + k0 + k); a[b] += cv[0] * w[0] + cv[1] * w[1] + cv[2] * w[2] + cv[3] * w[3]; }
        }
#pragma unroll
        for (int b = 0; b < 8; ++b) part[(F.wave * 8 + b) * 64 + F.lane] = a[b];
        __syncthreads();
        { const int b = F.wave; float s = 0.f;
#pragma unroll
          for (int w = 0; w < 8; ++w) s += part[(w * 8 + b) * 64 + F.lane];
          mod[((size_t)layer * 8 + b) * 6144 + col] = s + inp(F, 3)[layer * 6144 + col]; }
        __syncthreads();
    }
    __syncthreads();
    LAS float* scr = (LAS float*)(F.lds + F.wave * 16384);
    const int gw = F.vcu * NWAVES + F.wave, NGW = F.G * NWAVES;
    constexpr int I_PIN = 2 * 16 * 16, I_GRP = 8 * 4 * 4, I_POUT = I_PIN, I_AIN = 2 * 16 * 144, I_AOUT = I_PIN, I_SHGU = 4 * 16 * 8, I_SHDN = 4 * 4 * 16, I_R = 4 * 16 * 2;
    constexpr int I_EGU = 256 * 16 * 8, I_EDN = 256 * 4 * 16;
    constexpr int NITEMS = I_PIN + I_GRP + I_POUT + I_AIN + I_AOUT + I_SHGU + I_SHDN + I_R + I_EGU + I_EDN;
    for (int it = gw; it < NITEMS; it += NGW) {
        int r = it;
#define P0_GROUP(CNT, SRC, KK, NN, DST, GU) if (r < (CNT)) { const int per = ((KK) / 64) * ((NN) / 64), mat = r / per, q = r % per, nblk = (NN) / 64, kblk = (KK) / 64, nb = q / kblk, kb = q % kblk; (void)nblk; \
            int dn0 = 64 * nb; if (GU) { const int n0 = 64 * nb; dn0 = (n0 < 256) ? ((n0 >> 7) * 256 + (n0 & 127)) : (((n0 - 256) >> 7) * 256 + 128 + ((n0 - 256) & 127)); } \
            p0_transpose_item64((SRC) + (size_t)mat * (KK) * (NN), (KK), (NN), (bf16*)(F.ws + (DST)) + (size_t)mat * (KK) * (NN), dn0, scr, kb, nb, F.lane); continue; } r -= (CNT);
        P0_GROUP(I_PIN, inp(F, 4), 1024, 1024, WS_WPIN, 0)
        P0_GROUP(I_GRP, inp(F, 5), 256, 256, WS_WPGRP, 0)
        P0_GROUP(I_POUT, inp(F, 7), 1024, 1024, WS_WPOUT, 0)
        P0_GROUP(I_AIN, inp(F, 8), 1024, 9216, WS_WAIN, 0)
        P0_GROUP(I_AOUT, inp(F, 9), 1024, 1024, WS_WAOUT, 0)
        P0_GROUP(I_SHGU, inp(F, 16), 1024, 512, WS_WSHGU, 1)
        P0_GROUP(I_SHDN, inp(F, 17), 256, 1024, WS_WSHDN, 0)
        if (r < I_R) { const int mat = r / 32, q = r % 32, kb = q / 2, nb = q % 2;
            p0_router_item(inp(F, 12) + (size_t)mat * 65536, (bf16*)(F.ws + WS_WRHI) + (size_t)mat * 65536, (bf16*)(F.ws + WS_WRLO) + (size_t)mat * 65536, scr, kb, nb, F.lane); continue; } r -= I_R;
        P0_GROUP(I_EGU, inp(F, 14), 1024, 512, WS_WEGU, 1)
        P0_GROUP(I_EDN, inp(F, 15), 256, 1024, WS_WEDN, 0)
#undef P0_GROUP
    }
}

__device__ __forceinline__ void p1_modulate(Frame& F, const float* x, const float* modl  , int sh_off, int sc_off) {
    bf16* H = (bf16*)(F.ws + WS_H);
    const int gw = F.vcu * NWAVES + F.wave, NGW = F.G * NWAVES;
    for (int m = gw; m < T; m += NGW) {
        const int b = m / SEQ; const float* mb = modl + (size_t)b * 6144;
        const GAS f32x4* xr = (const GAS f32x4*)(x + (size_t)m * D) + F.lane;
        GAS u32x2* o8 = (GAS u32x2*)(H + (size_t)m * D) + F.lane;
#pragma unroll
        for (int j = 0; j < 4; ++j) { const f32x4 v = xr[64 * j]; const f32x4 sc = *(const f32x4*)(mb + sc_off + 4 * F.lane + 256 * j), sh = *(const f32x4*)(mb + sh_off + 4 * F.lane + 256 * j);
            const f32x4 h = v * (sc + 1.0f) + sh; u32x2 w; w.x = pk2(h[0], h[1]); w.y = pk2(h[2], h[3]); o8[64 * j] = w; }
    }
}

template <int W>
__device__ __forceinline__ void pool_item(const bf16* U, bf16* Z, int b, int t0, int g, int lane) {
    const size_t base = (size_t)b * SEQ * D + 256 * g + 4 * lane;
    float s[4] = {0.f, 0.f, 0.f, 0.f};
#pragma unroll
    for (int j = 1; j <= W; ++j) { const int t = t0 - j; if (t >= 0) { const u32x2 v = *(const GAS u32x2*)(U + base + (size_t)t * D);
            s[0] += bf2f(v.x & 0xffffu); s[1] += bf2f(v.x >> 16); s[2] += bf2f(v.y & 0xffffu); s[3] += bf2f(v.y >> 16); } }
#pragma unroll 8
    for (int i = 0; i < 32; ++i) { const int t = t0 + i;
        const u32x2 v = *(const GAS u32x2*)(U + base + (size_t)t * D);
        const float c0 = bf2f(v.x & 0xffffu), c1 = bf2f(v.x >> 16), c2 = bf2f(v.y & 0xffffu), c3 = bf2f(v.y >> 16);
        s[0] += c0; s[1] += c1; s[2] += c2; s[3] += c3;
        if (t - W >= 0) { const u32x2 o = *(const GAS u32x2*)(U + base + (size_t)(t - W) * D);
            s[0] -= bf2f(o.x & 0xffffu); s[1] -= bf2f(o.x >> 16); s[2] -= bf2f(o.y & 0xffffu); s[3] -= bf2f(o.y >> 16); }
        const float inv = 1.0f / (float)((t + 1) < W ? (t + 1) : W);
        u32x2 w; w.x = pk2(s[0] * inv - c0, s[1] * inv - c1); w.y = pk2(s[2] * inv - c2, s[3] * inv - c3);
        *(GAS u32x2*)(Z + base + (size_t)t * D) = w; }
}

__device__ __forceinline__ void moe_build_table(Frame& F, int layer) {
    LAS int* ts = (LAS int*)(F.lc + LC_TS); LAS int* cn = (LAS int*)(F.lc + LC_CNT);
    __syncthreads();
    if (F.wave == 0) {
        const int c = (int)__hip_atomic_load(F.ctl + CW_CNT + layer * 64 + F.lane, RLX_AGENT);
        int t = (c + 255) >> 8;
#pragma unroll
        for (int o = 1; o < 64; o <<= 1) { const int v = __shfl_up(t, o); if (F.lane >= o) t += v; }
        cn[F.lane] = c; ts[F.lane + 1] = t;
        if (F.lane == 0) ts[0] = 0;
        if (F.lane == 63) ts[65] = t + 64;
    }
    __syncthreads();
}

#ifdef PROBE_TYPE
#define LSTAMP(ty) do { if (blockIdx.x == 0 && F.tid == 0) { const unsigned long long now_ = __builtin_amdgcn_s_memrealtime(); LAS unsigned long long* st_ = (LAS unsigned long long*)(F.lc + 3072); \
        st_[1 + (ty)] += now_ - st_[20]; st_[20] = now_; } } while (0)
#define LSTAMP0() do { if (blockIdx.x == 0 && F.tid == 0) { ((LAS unsigned long long*)(F.lc + 3072))[20] = __builtin_amdgcn_s_memrealtime(); } } while (0)
#else
#define LSTAMP(ty) do { } while (0)
#define LSTAMP0() do { } while (0)
#endif
constexpr int APITCH = 1032;
__device__ __forceinline__ void ln1_router_phase(Frame& F, int layer, const float* xin, const bool x16) {
    bf16* X = (bf16*)(F.ws + WS_X);
    bf16* H = (bf16*)(F.ws + WS_H); const bf16* Y = (const bf16*)(F.ws + WS_Y);
    const float* modl = (const float*)(F.ws + WS_MOD) + (size_t)layer * 8 * 6144;
    const float* lg = inp(F, 10) + layer * D; const float* lb = inp(F, 11) + layer * D;
    const float* rb = inp(F, 13) + layer * NE;
    const bf16* WH = (const bf16*)(F.ws + WS_WRHI) + (size_t)layer * 65536; const bf16* WLo = (const bf16*)(F.ws + WS_WRLO) + (size_t)layer * 65536;
    int* tokl = (int*)(F.ws + WS_TOKL); float* wl = (float*)(F.ws + WS_WL); int* tslot = (int*)(F.ws + WS_TSLOT);
    unsigned* gcnt = F.ctl + CW_CNT + layer * 64;
    LAS bf16* Ahi = (LAS bf16*)F.lds; LAS bf16* Alo = Ahi + 32 * APITCH;
    LAS float* PART = (LAS float*)F.lds;
    LAS int* lcnt = (LAS int*)(F.lc + LC_LCNT); LAS int* gb = (LAS int*)(F.lc + LC_GB);
    const int lane = F.lane, wave = F.wave;
    for (int bi = 0; bi < (T / 32) / F.G; ++bi) {
        const int blk = (F.G == 256) ? ((F.vcu >> 5) * 64 + (F.vcu & 31) * 2 + bi) : (F.vcu + bi * F.G);
        const int tok0 = blk * 32;
        LSTAMP0();
        {
            const int b = tok0 / SEQ; const float* mb = modl + (size_t)b * 6144;
            f32x4 xv[4][4]; u32x4 yv[4][2];
#pragma unroll
            for (int q = 0; q < 4; ++q) { const int tok = tok0 + wave * 4 + q;
#pragma unroll
                for (int j = 0; j < 2; ++j) { const int col = 8 * lane + 512 * j;
                    if (x16) { const u32x4 w = __builtin_nontemporal_load((const GAS u32x4*)((const bf16*)xin + (size_t)tok * D + col));
                        xv[q][2 * j] = (f32x4){h2f(w.x & 0xffffu), h2f(w.x >> 16), h2f(w.y & 0xffffu), h2f(w.y >> 16)}; xv[q][2 * j + 1] = (f32x4){h2f(w.z & 0xffffu), h2f(w.z >> 16), h2f(w.w & 0xffffu), h2f(w.w >> 16)}; }
                    else { xv[q][2 * j] = *(const GAS f32x4*)(xin + (size_t)tok * D + col); xv[q][2 * j + 1] = *(const GAS f32x4*)(xin + (size_t)tok * D + col + 4); }
                    yv[q][j] = __builtin_nontemporal_load((const GAS u32x4*)(Y + (size_t)tok * D + col)); } }
            f32x4 pg1[4];
#pragma unroll
            for (int jj = 0; jj < 4; ++jj) pg1[jj] = *(const GAS f32x4*)(mb + 2048 + 8 * lane + 512 * (jj >> 1) + 4 * (jj & 1)) + 1.0f;
            float sm[4];
#pragma unroll
            for (int q = 0; q < 4; ++q) { float s = 0.f;
#pragma unroll
                for (int jj = 0; jj < 4; ++jj) { const unsigned w0 = (jj & 1) ? yv[q][jj >> 1].z : yv[q][jj >> 1].x, w1 = (jj & 1) ? yv[q][jj >> 1].w : yv[q][jj >> 1].y;
                    f32x4 y4; y4[0] = h2f(w0 & 0xffffu); y4[1] = h2f(w0 >> 16); y4[2] = h2f(w1 & 0xffffu); y4[3] = h2f(w1 >> 16);
                    xv[q][jj] = xv[q][jj] * ALPHA + pg1[jj] * y4; s += (xv[q][jj][0] + xv[q][jj][1]) + (xv[q][jj][2] + xv[q][jj][3]); }
                sm[q] = s; }
#pragma unroll
            for (int o = 1; o < 64; o <<= 1) {
#pragma unroll
                for (int q = 0; q < 4; ++q) sm[q] += __shfl_xor(sm[q], o); }
            float s2[4];
#pragma unroll
            for (int q = 0; q < 4; ++q) { const float mean = sm[q] * (1.f / D); float t = 0.f;
#pragma unroll
                for (int jj = 0; jj < 4; ++jj) { xv[q][jj] = xv[q][jj] - mean; t += (xv[q][jj][0] * xv[q][jj][0] + xv[q][jj][1] * xv[q][jj][1]) + (xv[q][jj][2] * xv[q][jj][2] + xv[q][jj][3] * xv[q][jj][3]); }
                s2[q] = t; }
#pragma unroll
            for (int o = 1; o < 64; o <<= 1) {
#pragma unroll
                for (int q = 0; q < 4; ++q) s2[q] += __shfl_xor(s2[q], o); }
#pragma unroll
            for (int jj = 0; jj < 4; ++jj) { const int col = 8 * lane + 512 * (jj >> 1) + 4 * (jj & 1);
                const f32x4 gg = *(const GAS f32x4*)(lg + col), bb = *(const GAS f32x4*)(lb + col), sc2 = *(const GAS f32x4*)(mb + 4096 + col) + 1.0f, sh2 = *(const GAS f32x4*)(mb + 3072 + col);
#pragma unroll
                for (int q = 0; q < 4; ++q) { const int rl = wave * 4 + q, tok = tok0 + rl; const float rstd = 1.0f / sqrtf(s2[q] * (1.f / D) + LN_EPS);
                    const f32x4 xn = xv[q][jj] * rstd * gg + bb; { u32x2 xw; xw.x = pkh2(xn[0], xn[1]); xw.y = pkh2(xn[2], xn[3]); *(GAS u32x2*)(X + (size_t)tok * D + col) = xw; }
                    const f32x4 hf = xn * sc2 + sh2;
                    unsigned hh[4], ll[4];
#pragma unroll
                    for (int e = 0; e < 4; ++e) { hh[e] = f2bf(hf[e]); ll[e] = f2bf(hf[e] - bf2f(hh[e])); }
                    u32x2 wh, wlo; wh.x = hh[0] | (hh[1] << 16); wh.y = hh[2] | (hh[3] << 16); wlo.x = ll[0] | (ll[1] << 16); wlo.y = ll[2] | (ll[3] << 16);
                    *(GAS u32x2*)(H + (size_t)tok * D + col) = wh;
                    *(LAS u32x2*)(Ahi + rl * APITCH + col) = wh; *(LAS u32x2*)(Alo + rl * APITCH + col) = wlo; } }
        }
        bf16x8 bh[8][2], bl[8][2];
        {
            const int r32 = lane & 31, hi = lane >> 5;
#pragma unroll
            for (int ks = 0; ks < 8; ++ks)
#pragma unroll
                for (int nb = 0; nb < 2; ++nb) { const size_t o = (size_t)(r32 + 32 * nb) * 1024 + wave * 128 + ks * 16 + hi * 8; bh[ks][nb] = *(const GAS bf16x8*)(WH + o); bl[ks][nb] = *(const GAS bf16x8*)(WLo + o); }
        }
        __syncthreads();
        LSTAMP(13);
        f32x16 acc[2]; acc[0] = (f32x16){}; acc[1] = (f32x16){};
        {
            const int r32 = lane & 31, hi = lane >> 5;
#pragma unroll
            for (int ks = 0; ks < 8; ++ks) {
                const int k = wave * 128 + ks * 16 + hi * 8;
                const bf16x8 ah = *(const LAS bf16x8*)(Ahi + r32 * APITCH + k), al = *(const LAS bf16x8*)(Alo + r32 * APITCH + k);
#pragma unroll
                for (int nb = 0; nb < 2; ++nb) {
                    acc[nb] = MFMA32(ah, bh[ks][nb], acc[nb]);
                    acc[nb] = MFMA32(al, bh[ks][nb], acc[nb]);
                    acc[nb] = MFMA32(ah, bl[ks][nb], acc[nb]);
                }
            }
        }
        __syncthreads();
        {
            const int r32 = lane & 31, hi = lane >> 5;
#pragma unroll
            for (int nb = 0; nb < 2; ++nb)
#pragma unroll
                for (int r = 0; r < 16; ++r) { const int trow = (r & 3) + 8 * (r >> 2) + 4 * hi; PART[(wave * 32 + trow) * 64 + 32 * nb + r32] = acc[nb][r]; }
        }
        if (F.tid < 64) lcnt[F.tid] = 0;
        __syncthreads();
        LSTAMP(14);
        int chosen_m = 0; int posl[4]; float wv[4]; int rk[4];
        const float rbe = rb[lane];
#pragma unroll
        for (int q = 0; q < 4; ++q) {
            __builtin_amdgcn_sched_barrier(0);
            const int rl = wave * 4 + q;
            float logit = 0.f;
#pragma unroll
            for (int w = 0; w < 8; ++w) logit += PART[(w * 32 + rl) * 64 + lane];
            const float sg = 1.0f / (1.0f + __expf(-logit));
            const float sel = sg + rbe;
            float m1 = sel; m1 = fmaxf(m1, __shfl_xor(m1, 1)); m1 = fmaxf(m1, __shfl_xor(m1, 2)); m1 = fmaxf(m1, __shfl_xor(m1, 4));
            const unsigned long long bal = __ballot(sel == m1);
            const unsigned long long gm = bal & (0xFFull << (8 * (lane >> 3)));
            const int first = (int)__builtin_ctzll(gm);
            float m2 = (lane == first) ? -INFINITY : sel; m2 = fmaxf(m2, __shfl_xor(m2, 1)); m2 = fmaxf(m2, __shfl_xor(m2, 2)); m2 = fmaxf(m2, __shfl_xor(m2, 4));
            const float gs = m1 + m2;
            int rg = 0;
#pragma unroll
            for (int g2 = 0; g2 < 8; ++g2) { const float v = __builtin_bit_cast(float, __builtin_amdgcn_readlane(__builtin_bit_cast(int, gs), 8 * g2)); rg += ((v > gs) || (v == gs && g2 < (lane >> 3))) ? 1 : 0; }
            const bool gsel = rg < 4;
            const float msel = gsel ? sel : -INFINITY;
            const unsigned mb_ = __float_as_uint(msel); const unsigned key = (mb_ & 0x80000000u) ? ~mb_ : (mb_ | 0x80000000u);
            unsigned tau = 0u;
#pragma unroll 1
            for (int bit = 31; bit >= 0; --bit) { const unsigned cand = tau | (1u << bit); const int cnt = (int)__popcll(__ballot(key >= cand)); tau = (cnt >= TOPK) ? cand : tau; }
            const unsigned long long gtm = __ballot(key > tau), eqm = __ballot(key == tau);
            const int need = TOPK - (int)__popcll(gtm);
            const unsigned long long below = (1ull << lane) - 1ull;
            const bool ch = (key > tau) || ((key == tau) && ((int)__popcll(eqm & below) < need));
            const unsigned long long chm = __ballot(ch);
            const int rank = (int)__popcll(chm & below);
            const float wsum = wave_sum(ch ? sg : 0.f);
            wv[q] = sg / wsum * ROUTED_SCALE; rk[q] = rank; posl[q] = 0;
            if (ch) { chosen_m |= (1 << q); posl[q] = __hip_atomic_fetch_add(lcnt + lane, 1, __ATOMIC_RELAXED, __HIP_MEMORY_SCOPE_WORKGROUP); }
        }
        __syncthreads();
        LSTAMP(15);
        if (wave == 0) { const int n = lcnt[lane]; int base = 0; if (n > 0) base = (int)__hip_atomic_fetch_add(gcnt + lane, (unsigned)n, RLX_AGENT); gb[lane] = base; }
        __syncthreads();
        {
            const int base = gb[lane];
#pragma unroll
            for (int q = 0; q < 4; ++q) if (chosen_m & (1 << q)) { const int tok = tok0 + wave * 4 + q; const int pos = base + posl[q];
                tokl[(size_t)lane * CAP + pos] = tok; wl[(size_t)tok * 8 + rk[q]] = wv[q]; tslot[(size_t)tok * 8 + rk[q]] = lane * CAP + pos; }
        }
        __syncthreads();
        LSTAMP(16);
    }
}

__device__ __forceinline__ void combine_ln2_phase(Frame& F, int layer) {
    bf16* X = (bf16*)(F.ws + WS_X); bf16* H = (bf16*)(F.ws + WS_H); const bf16* YS = (const bf16*)(F.ws + WS_YS);
    const float* modl = (const float*)(F.ws + WS_MOD) + (size_t)layer * 8 * 6144;
    const float* modn = (const float*)(F.ws + WS_MOD) + (size_t)(layer + 1) * 8 * 6144;
    const float* lg = inp(F, 18) + layer * D; const float* lb = inp(F, 19) + layer * D;
    const int* tslot = (const int*)(F.ws + WS_TSLOT);
    const LAS int* ts = (const LAS int*)(F.lc + LC_TS);
    const bool lastl = (layer == DEPTH - 1);
    float* xout = (float*)inp(F, 20);
    const int lane = F.lane, wave = F.wave;
    LAS float* PV = (LAS float*)F.lds;
    const int shbase = ts[64] * 256;
    for (int blk = F.vcu; blk < T / 64; blk += F.G) {
        const int tokb = blk * 64, b = tokb / SEQ;
        __syncthreads();
        for (int i = F.tid; i < 1024; i += 512) { PV[i] = modl[(size_t)b * 6144 + 5120 + i] + 1.0f; PV[1024 + i] = lg[i]; PV[2048 + i] = lb[i];
            if (!lastl) { PV[3072 + i] = modn[(size_t)b * 6144 + 1024 + i] + 1.0f; PV[4096 + i] = modn[(size_t)b * 6144 + i]; } }
        __syncthreads();
        const int tw = tokb + wave * 8;
        int sv; { const int v = tslot[(size_t)tw * 8 + lane]; sv = ts[v >> 14] * 256 + (v & (CAP - 1)); }
        const float wvv = ((const float*)(F.ws + WS_WL))[(size_t)tw * 8 + lane];
        u32x4 ys[18]; u32x4 xs[2];
#define CB_LOAD(k) do { const int tok_ = tw + (k); _Pragma("unroll") for (int kk_ = 0; kk_ < 9; ++kk_) { const int slot_ = (kk_ < 8) ? __builtin_amdgcn_readlane(sv, 8 * (k) + kk_) : (shbase + tok_); \
            const bf16* yr_ = YS + (size_t)slot_ * D + 8 * lane; ys[2 * kk_] = __builtin_nontemporal_load((const GAS u32x4*)(yr_)); ys[2 * kk_ + 1] = __builtin_nontemporal_load((const GAS u32x4*)(yr_ + 512)); } \
            _Pragma("unroll") for (int j_ = 0; j_ < 2; ++j_) xs[j_] = __builtin_nontemporal_load((const GAS u32x4*)(X + (size_t)tok_ * D + 8 * lane + 512 * j_)); } while (0)
        CB_LOAD(0);
#pragma unroll 1
        for (int k = 0; k < 8; ++k) {
            const int tok_ = tw + k; f32x4 y_[4];
#pragma unroll
            for (int jj_ = 0; jj_ < 4; ++jj_) y_[jj_] = (f32x4){0.f, 0.f, 0.f, 0.f};
#pragma unroll
            for (int kk_ = 0; kk_ < 9; ++kk_) { const float wk_ = (kk_ < 8) ? __builtin_bit_cast(float, __builtin_amdgcn_readlane(__builtin_bit_cast(int, wvv), 8 * k + kk_)) : 1.0f;
#pragma unroll
                for (int j_ = 0; j_ < 2; ++j_) { const u32x4 w_ = ys[2 * kk_ + j_];
                    y_[2 * j_][0] += wk_ * h2f(w_.x & 0xffffu); y_[2 * j_][1] += wk_ * h2f(w_.x >> 16); y_[2 * j_][2] += wk_ * h2f(w_.y & 0xffffu); y_[2 * j_][3] += wk_ * h2f(w_.y >> 16);
                    y_[2 * j_ + 1][0] += wk_ * h2f(w_.z & 0xffffu); y_[2 * j_ + 1][1] += wk_ * h2f(w_.z >> 16); y_[2 * j_ + 1][2] += wk_ * h2f(w_.w & 0xffffu); y_[2 * j_ + 1][3] += wk_ * h2f(w_.w >> 16); } }
            f32x4 v_[4]; float s_ = 0.f;
#pragma unroll
            for (int jj_ = 0; jj_ < 4; ++jj_) { const int col_ = 8 * lane + 512 * (jj_ >> 1) + 4 * (jj_ & 1); const f32x4 g2_ = *(const LAS f32x4*)(PV + col_);
                const unsigned w0_ = (jj_ & 1) ? xs[jj_ >> 1].z : xs[jj_ >> 1].x, w1_ = (jj_ & 1) ? xs[jj_ >> 1].w : xs[jj_ >> 1].y;
                const f32x4 x4_ = (f32x4){h2f(w0_ & 0xffffu), h2f(w0_ >> 16), h2f(w1_ & 0xffffu), h2f(w1_ >> 16)};
                v_[jj_] = x4_ * ALPHA + g2_ * y_[jj_]; s_ += (v_[jj_][0] + v_[jj_][1]) + (v_[jj_][2] + v_[jj_][3]); }
            asm volatile("" : "+v"(v_[0]), "+v"(v_[1]), "+v"(v_[2]), "+v"(v_[3]));
            __builtin_amdgcn_sched_barrier(0);
            { const int kn = (k + 1 < 8) ? k + 1 : k; CB_LOAD(kn); }
            __builtin_amdgcn_sched_barrier(0);
            const float mean_ = wave_sum(s_) * (1.f / D); float q_ = 0.f;
#pragma unroll
            for (int jj_ = 0; jj_ < 4; ++jj_) { v_[jj_] = v_[jj_] - mean_; q_ += (v_[jj_][0] * v_[jj_][0] + v_[jj_][1] * v_[jj_][1]) + (v_[jj_][2] * v_[jj_][2] + v_[jj_][3] * v_[jj_][3]); }
            const float rstd_ = 1.0f / sqrtf(wave_sum(q_) * (1.f / D) + LN_EPS);
#pragma unroll
            for (int jj_ = 0; jj_ < 4; ++jj_) { const int col_ = 8 * lane + 512 * (jj_ >> 1) + 4 * (jj_ & 1);
                const f32x4 gg_ = *(const LAS f32x4*)(PV + 1024 + col_), bb_ = *(const LAS f32x4*)(PV + 2048 + col_);
                const f32x4 xn_ = v_[jj_] * rstd_ * gg_ + bb_;
                if (lastl) *(GAS f32x4*)(xout + (size_t)tok_ * D + col_) = xn_;
                else { u32x2 xw_; xw_.x = pkh2(xn_[0], xn_[1]); xw_.y = pkh2(xn_[2], xn_[3]); *(GAS u32x2*)(X + (size_t)tok_ * D + col_) = xw_; }
                if (!lastl) { const f32x4 sc_ = *(const LAS f32x4*)(PV + 3072 + col_), sh_ = *(const LAS f32x4*)(PV + 4096 + col_); const f32x4 hm_ = xn_ * sc_ + sh_;
                    u32x2 w2_; w2_.x = pk2(hm_[0], hm_[1]); w2_.y = pk2(hm_[2], hm_[3]); *(GAS u32x2*)(H + (size_t)tok_ * D + col_) = w2_; } }
        }
#undef CB_LOAD
    }
}

constexpr int ACCP = 68;
__device__ __forceinline__ int crow(int r, int hi) { return (r & 3) + 8 * (r >> 2) + 4 * hi; }
constexpr int KPITCH = 144;
template <bool FIRST, int NB>
__device__ __forceinline__ void attn_task(const bf16* QKVb  , int g, int h, int dil, int cls, int q0, int QS, int kb0, int L, float slope2d,
                                          LAS unsigned char* stg  , LAS float* wsf  , LAS float* ACC, LAS float* ML, int trow_mul, int trow_add, int lane) {
    asm volatile("" : "+v"(lane));
    const int r32 = lane & 31, hi = lane >> 5, lr = lane >> 3, lc = lane & 7;
    const int qcol = ((g * 3 + 0) * 16 + h) * 64, kcol = ((g * 3 + 1) * 16 + h) * 64, vcol = ((g * 3 + 2) * 16 + h) * 64;
    const size_t rstride = (size_t)dil * NQKV;
    const bf16* base = QKVb + (size_t)cls * NQKV + lc * 8;
    const int jlo = (kb0 >= -31) ? 0 : ((-kb0) >> 5);
    const int qpos = q0 + QS * r32;
    const int dmax = qpos < 128 ? qpos : 128;
    const float half = 0.5f * (float)dmax;
#define AT_LOADROWS(dst, l0, ls, col) do { _Pragma("unroll") for (int i_ = 0; i_ < 4; ++i_) { int l_ = (l0) + (ls) * (8 * i_ + lr); l_ = l_ < 0 ? 0 : (l_ > L - 1 ? L - 1 : l_); \
        dst[i_] = *(const GAS u32x4*)(base + (size_t)l_ * rstride + (col)); } } while (0)
#define AT_PUTROWS(src) do { _Pragma("unroll") for (int i_ = 0; i_ < 4; ++i_) *(LAS u32x4*)(stg + (8 * i_ + lr) * KPITCH + lc * 16) = src[i_]; } while (0)
#define AT_GETFRAG(dst) do { _Pragma("unroll") for (int s_ = 0; s_ < 4; ++s_) dst[s_] = *(const LAS bf16x8*)(stg + r32 * KPITCH + 32 * s_ + 16 * hi); } while (0)
#define AT_LDSWAIT() asm volatile("s_waitcnt lgkmcnt(0)" ::: "memory")
    u32x4 kr[2][4];
    bf16x8 qf[4];
    { u32x4 qr[4]; AT_LOADROWS(qr, q0, QS, qcol);
#pragma unroll
      for (int j = 0; j < NB; ++j) if (j == jlo) AT_LOADROWS(kr[j & 1], kb0 + 32 * j, 1, kcol);
      AT_PUTROWS(qr); AT_LDSWAIT(); AT_GETFRAG(qf); AT_LDSWAIT(); }
    f32x16 S[NB];
    float mx = -INFINITY;
#pragma unroll
    for (int j = 0; j < NB; ++j) {
        if (j >= jlo) {
            asm volatile("" ::: "memory");
            if (j < NB - 1) AT_LOADROWS(kr[(j + 1) & 1], kb0 + 32 * (j + 1), 1, kcol);
            AT_PUTROWS(kr[j & 1]);
            const float xd0 = (float)(qpos - kb0 - 32 * j - 4 * hi) - half;
            const bool inner = (q0 - kb0 - 32 * j - 31 >= 0) && (q0 + QS * 31 - kb0 - 32 * j <= 128) && (kb0 + 32 * j >= 0);
            f32x16 a;
            if (inner) {
                const float cb = -slope2d * xd0;
#pragma unroll
                for (int r = 0; r < 16; ++r) a[r] = __builtin_fmaf(slope2d, (float)((r & 3) + 8 * (r >> 2)), cb);
            } else {
#pragma unroll
                for (int r = 0; r < 16; ++r) { const float x = xd0 - (float)((r & 3) + 8 * (r >> 2)); a[r] = (__builtin_fabsf(x) <= half) ? (-slope2d * x) : -INFINITY; }
            }
            bf16x8 kf[4];
            AT_LDSWAIT(); AT_GETFRAG(kf); AT_LDSWAIT();
#pragma unroll
            for (int s = 0; s < 4; ++s) a = MFMA32(kf[s], qf[s], a);
#pragma unroll
            for (int r = 0; r < 16; ++r) mx = fmaxf(mx, a[r]);
            S[j] = a;
        } else {
#pragma unroll
            for (int r = 0; r < 16; ++r) S[j][r] = -INFINITY;
        }
        __builtin_amdgcn_sched_barrier(0);
    }
    u32x4 vr[2][4];
#pragma unroll
    for (int j = 0; j < NB; ++j) if (j == jlo) AT_LOADROWS(vr[j & 1], kb0 + 32 * j, 1, vcol);
    { auto rr = __builtin_amdgcn_permlane32_swap(__float_as_uint(mx), __float_as_uint(mx), false, false);
      const unsigned r0 = rr[0], r1 = rr[1]; mx = fmaxf(__uint_as_float(r0), __uint_as_float(r1)); }
    const float mx_true = mx - slope2d * half;
    float lsum = 0.f;
    u32x4 P[NB][2];
#pragma unroll
    for (int j = 0; j < NB; ++j) {
        float p[16];
#pragma unroll
        for (int r = 0; r < 16; ++r) { p[r] = __builtin_amdgcn_exp2f(S[j][r] - mx); lsum += p[r]; }
#pragma unroll
        for (int ks = 0; ks < 2; ++ks) { P[j][ks].x = cvt_pk_bf16(p[8 * ks + 0], p[8 * ks + 1]); P[j][ks].y = cvt_pk_bf16(p[8 * ks + 2], p[8 * ks + 3]); P[j][ks].z = cvt_pk_bf16(p[8 * ks + 4], p[8 * ks + 5]); P[j][ks].w = cvt_pk_bf16(p[8 * ks + 6], p[8 * ks + 7]); }
        __builtin_amdgcn_sched_barrier(0);
    }
    { auto rr = __builtin_amdgcn_permlane32_swap(__float_as_uint(lsum), __float_as_uint(lsum), false, false);
      const unsigned r0 = rr[0], r1 = rr[1]; lsum = __uint_as_float(r0) + __uint_as_float(r1); }
    f32x16 o[2]; o[0] = (f32x16){}; o[1] = (f32x16){};
    const unsigned vrd = (unsigned)(((lane >> 4) & 1) * 32 + (lane & 3) * 8 + (4 * hi + ((lane & 15) >> 2)) * 64);
#pragma unroll
    for (int j = 0; j < NB; ++j) {
        if (j >= jlo) {
            asm volatile("" ::: "memory");
            if (j < NB - 1) AT_LOADROWS(vr[(j + 1) & 1], kb0 + 32 * (j + 1), 1, vcol);
#pragma unroll
            for (int i = 0; i < 4; ++i) { const int key = 8 * i + lr; *(LAS u32x4*)(stg + ((lc >> 2) * 2 + (key >> 4)) * 1024 + (key & 15) * 64 + (lc & 3) * 16) = vr[j & 1][i]; }
            AT_LDSWAIT();
#pragma unroll
            for (int d0 = 0; d0 < 2; ++d0)
#pragma unroll
                for (int ks = 0; ks < 2; ++ks) {
                    LAS unsigned char* vp = stg + (d0 * 2 + ks) * 1024 + vrd;
                    const s16x4 lo = __builtin_bit_cast(s16x4, __builtin_amdgcn_ds_read_tr16_b64_v4i16((LAS s16x4*)(vp)));
                    const s16x4 hh = __builtin_bit_cast(s16x4, __builtin_amdgcn_ds_read_tr16_b64_v4i16((LAS s16x4*)(vp + 512)));
                    const bf16x8 vf = (bf16x8){lo[0], lo[1], lo[2], lo[3], hh[0], hh[1], hh[2], hh[3]};
                    o[d0] = MFMA32(__builtin_bit_cast(bf16x8, P[j][ks]), vf, o[d0]);
                }
            AT_LDSWAIT();
        }
        __builtin_amdgcn_sched_barrier(0);
    }
#undef AT_LOADROWS
#undef AT_PUTROWS
#undef AT_GETFRAG
#undef AT_LDSWAIT
    if (hi == 0) { wsf[r32] = mx_true; wsf[32 + r32] = lsum; }
    asm volatile("s_waitcnt lgkmcnt(0)" ::: "memory");
    f32x4 mt4[4], lt4[4];
#pragma unroll
    for (int k = 0; k < 4; ++k) { mt4[k] = *(const LAS f32x4*)(wsf + 8 * k + 4 * hi); lt4[k] = *(const LAS f32x4*)(wsf + 32 + 8 * k + 4 * hi); }
    if (FIRST) {
#pragma unroll
        for (int r = 0; r < 16; ++r) { const int q = crow(r, hi); const int trow = q * trow_mul + trow_add;
            ACC[trow * ACCP + r32] = o[0][r]; ACC[trow * ACCP + 32 + r32] = o[1][r];
            if (r32 == 0) { ML[trow * 2] = mt4[r >> 2][r & 3]; ML[trow * 2 + 1] = lt4[r >> 2][r & 3]; } }
    } else {
        f32x2 ml[16]; float a0[16], a1[16];
#pragma unroll
        for (int r = 0; r < 16; ++r) { const int q = crow(r, hi); const int trow = q * trow_mul + trow_add;
            ml[r] = *(const LAS f32x2*)(ML + trow * 2); a0[r] = ACC[trow * ACCP + r32]; a1[r] = ACC[trow * ACCP + 32 + r32]; }
        asm volatile("s_waitcnt lgkmcnt(0)" ::: "memory");
#pragma unroll
        for (int r = 0; r < 16; ++r) { const int q = crow(r, hi); const int trow = q * trow_mul + trow_add;
            const float mt = mt4[r >> 2][r & 3], lt = lt4[r >> 2][r & 3], mo = ml[r][0], lo_ = ml[r][1];
            const float mn = fmaxf(mo, mt); const float fa = __builtin_amdgcn_exp2f(mo - mn), fb = __builtin_amdgcn_exp2f(mt - mn);
            ACC[trow * ACCP + r32] = a0[r] * fa + o[0][r] * fb; ACC[trow * ACCP + 32 + r32] = a1[r] * fa + o[1][r] * fb;
            if (r32 == 0) { ML[trow * 2] = mn; ML[trow * 2 + 1] = lo_ * fa + lt * fb; } }
    }
    asm volatile("s_waitcnt lgkmcnt(0)" ::: "memory");
}

__device__ __forceinline__ void attn_phase(Frame& F, bf16* MIX) {
    const bf16* QKV = (const bf16*)(F.ws + WS_QKV);
    LAS float* ACC = (LAS float*)F.lds;
    LAS float* ML = (LAS float*)(F.lds + 69632);
    LAS unsigned char* vst = F.lds + 73728 + F.wave * 4608;
    LAS float* wsf = (LAS float*)(F.lds + 73728 + 8 * 4608 + F.wave * 256);
    const int lane = F.lane, w = F.wave;
    for (int i = 0;; ++i) {
        if (i >= (BATCH * 16 * 8) / F.G) break;
        const int L0 = (F.G == 256) ? ((F.vcu >> 5) * 128 + i * 32 + (F.vcu & 31)) : (i * F.G + F.vcu);
        const int bh = L0 >> 3, ti = L0 & 7; int w4 = ti >> 1; const int c = ti & 1; if (i & 1) w4 = 3 - w4;
        const int b = bh >> 4, h = bh & 15, win0 = w4 * 512;
        const bf16* Qb = QKV + (size_t)b * SEQ * NQKV;
        const float sl0 = exp2f(-8.0f * (float)(0 * 16 + h + 1) / 48.0f) * LOG2E, sl1 = exp2f(-8.0f * (float)(1 * 16 + h + 1) / 48.0f) * LOG2E * 4.0f, sl2 = exp2f(-8.0f * (float)(2 * 16 + h + 1) / 48.0f) * LOG2E * 16.0f;
        LSTAMP0();
        attn_task<true, 6>(Qb, 0, h, 1, 0, win0 + 64 * w + c, 2, win0 + 64 * w - 128, SEQ, sl0, vst, wsf, ACC, ML, 1, 32 * w, lane);
        __syncthreads();
        LSTAMP(24);
        if (ATTN_GMASK & 2) { const int cls = c + 2 * (w & 1), lb = w >> 1, lq0 = 128 * w4 + 32 * lb; attn_task<false, 5>(Qb, 1, h, 4, cls, lq0, 1, lq0 - 128, SEQ / 4, sl1, vst, wsf, ACC, ML, 2, 64 * lb + (w & 1), lane); }
        __syncthreads();
        LSTAMP(25);
        if (ATTN_GMASK & 4) { const int cls = c + 2 * w, lq0 = 32 * w4; attn_task<false, 5>(Qb, 2, h, 16, cls, lq0, 1, lq0 - 128, SEQ / 16, sl2, vst, wsf, ACC, ML, 8, w, lane); }
        __syncthreads();
        LSTAMP(26);
        {
#pragma unroll
          for (int it = 0; it < 4; ++it) { const int trow = 32 * w + 8 * it + (lane >> 3), sg = lane & 7; const float inv = 1.0f / ML[trow * 2 + 1];
              const LAS f32x4* ap = (const LAS f32x4*)(ACC + trow * ACCP + sg * 8);
              bf16* op = MIX + (size_t)(b * SEQ + win0 + 2 * trow + c) * D + h * 64 + sg * 8;
              const f32x4 a = ap[0] * inv, bq = ap[1] * inv; u32x4 wv; wv.x = pk2(a[0], a[1]); wv.y = pk2(a[2], a[3]); wv.z = pk2(bq[0], bq[1]); wv.w = pk2(bq[2], bq[3]);
              *(GAS u32x4*)op = wv; } }
        __syncthreads();
    }
}

__device__ __forceinline__ void attn_phase_naive(Frame& F, bf16* MIX, const int gmask) {
    const bf16* QKV = (const bf16*)(F.ws + WS_YS);
    const int lane = F.lane;
    const int gw = F.vcu * NWAVES + F.wave, NGW = F.G * NWAVES;
    for (int item = gw; item < T * 16; item += NGW) {
        const int tok = item >> 4, h = item & 15, b = tok / SEQ, t = tok % SEQ;
        const bf16* Qb = QKV + (size_t)b * SEQ * NQKV;
        float sc[3][3]; int kt[3][3];
        float mx = -INFINITY;
#pragma unroll
        for (int g = 0; g < 3; ++g) {
            const int dil = (g == 0) ? 1 : (g == 1 ? 4 : 16);
            const float slope = exp2f(-8.0f * (float)(g * 16 + h + 1) / 48.0f);
            const bf16* qp = Qb + (size_t)t * NQKV + ((g * 3 + 0) * 16 + h) * 64;
#pragma unroll
            for (int c = 0; c < 3; ++c) {
                const int j = lane + 64 * c; const int tk = t - j * dil;
                float s = -INFINITY;
                if (j <= 128 && tk >= 0 && ((gmask >> g) & 1)) {
                    const bf16* kp = Qb + (size_t)tk * NQKV + ((g * 3 + 1) * 16 + h) * 64;
                    float d = 0.f;
                    for (int e = 0; e < 64; ++e) d += bf2f(qp[e]) * bf2f(kp[e]);
                    s = d - slope * LOG2E * (float)(j * dil);
                }
                sc[g][c] = s; kt[g][c] = tk; mx = fmaxf(mx, s);
            }
        }
#pragma unroll
        for (int o = 1; o < 64; o <<= 1) mx = fmaxf(mx, __shfl_xor(mx, o));
        float den = 0.f; float acc[64];
#pragma unroll
        for (int e = 0; e < 64; ++e) acc[e] = 0.f;
#pragma unroll
        for (int g = 0; g < 3; ++g)
#pragma unroll
            for (int c = 0; c < 3; ++c) {
                const float p = (sc[g][c] == -INFINITY) ? 0.f : exp2f(sc[g][c] - mx);
                den += p;
                if (p != 0.f) { const bf16* vp = Qb + (size_t)kt[g][c] * NQKV + ((g * 3 + 2) * 16 + h) * 64;
#pragma unroll
                    for (int e = 0; e < 64; ++e) acc[e] += p * bf2f(vp[e]); }
            }
        den = wave_sum(den);
        float mine = 0.f;
#pragma unroll
        for (int e = 0; e < 64; ++e) { const float v = wave_sum(acc[e]); if (lane == e) mine = v; }
        MIX[(size_t)tok * D + h * 64 + lane] = (bf16)f2bf(mine / den);
    }
}

struct Args { const float* in[20]; float* out; unsigned char* ws; int ph_lo, ph_hi; };
constexpr int NPHASE = 2 + DEPTH * 8;

__global__ void __launch_bounds__(NWAVES * 64, 2) mk_fwd(Args args) {
    extern __shared__ __attribute__((aligned(16))) unsigned char lds_raw[];
    Frame F;
    F.lds = (LAS unsigned char*)lds_raw; F.lc = F.lds + LDSCTL_OFF;
    F.tid = threadIdx.x; F.lane = F.tid & 63; F.wave = __builtin_amdgcn_readfirstlane(F.tid >> 6);
    F.G = gridDim.x; { const int bx = blockIdx.x; F.vcu = (F.G % 8 == 0) ? (bx % 8) * (F.G / 8) + bx / 8 : bx; }
    F.ws = args.ws; F.ctl = (unsigned*)(args.ws + WS_CTL);
    for (int u = F.tid; u < (LDS_BYTES - LDSCTL_OFF) / 4; u += NWAVES * 64) ((LAS unsigned*)F.lc)[u] = 0u;
    __syncthreads();
    if (F.tid == 0) {
#pragma unroll
        for (int i = 0; i < 20; ++i) *(LAS unsigned long long*)(F.lc + LC_PTR + 8 * i) = (unsigned long long)args.in[i];
        *(LAS unsigned long long*)(F.lc + LC_PTR + 8 * 20) = (unsigned long long)args.out;
    }
    __syncthreads();
#if MK_PER_PHASE
#define GRID_BAR() do { } while (0)
    XcdBarrier bar; bar.bar = nullptr; bar.x = 0; bar.st = nullptr;
#else
    XcdBarrier bar = xcd_barrier_post(F.ctl + CW_BAR, (volatile LAS unsigned*)(F.lc + LC_MISC) + 8);
#define GRID_BAR() xcd_barrier(bar)
#endif
    const int lo = args.ph_lo, hi = args.ph_hi;
#ifdef PROBE_TYPE
#define LC_STAMP 3072
#define STAMP(ty) do { if (blockIdx.x == 0 && F.tid == 0) { const unsigned long long now_ = __builtin_amdgcn_s_memrealtime(); LAS unsigned long long* st_ = (LAS unsigned long long*)(F.lc + LC_STAMP); \
        st_[1 + (ty)] += now_ - st_[0]; st_[0] = now_; } } while (0)
    if (blockIdx.x == 0 && F.tid == 0) { ((LAS unsigned long long*)(F.lc + LC_STAMP))[0] = __builtin_amdgcn_s_memrealtime(); }
#else
#define STAMP(ty) do { } while (0)
#endif
#define IN(k) (lo <= (k) && (k) < hi)
#define SEAM(k) do { if (IN(k) && IN((k) + 1)) GRID_BAR(); } while (0)
    const float* mod = (const float*)(F.ws + WS_MOD);

    if (PHON(0) && IN(0)) { p0_prologue(F); } SEAM(0); STAMP(0);
    bool xlocal = false; int cid = (int)blockIdx.x;
#if !MK_PER_PHASE
    { volatile LAS unsigned* st = (volatile LAS unsigned*)(F.lc + LC_MISC) + 8;
      if (F.tid == 0) { unsigned ok = (F.G == 256) ? 1u : 0u;
#pragma unroll
          for (unsigned jx = 0; jx < 16; ++jx) { const unsigned cj = xb_ld(&bar.bar[XB_XCNT(jx)]); ok &= (jx < 8u) ? (cj == 32u ? 1u : 0u) : (cj == 0u ? 1u : 0u); }
          st[3] = ok; }
      __syncthreads();
      xlocal = (st[3] != 0u) && (MK_XLOCAL != 0);
      if (xlocal) cid = (int)(st[2] * 8u + bar.x); }
#endif
    cid = __builtin_amdgcn_readfirstlane(cid);
    F.vcu = (F.G % 8 == 0) ? (cid % 8) * (F.G / 8) + cid / 8 : cid;
#define LSEAM(k) do { if (IN(k) && IN((k) + 1)) { if (xlocal) xcd_local_barrier(bar, F.wave == 0); else GRID_BAR(); } } while (0)
    if (PHON(1) && IN(1)) { p1_modulate(F, inp(F, 0), mod, 0, 1024); } SEAM(1); STAMP(1);

    for (int layer = 0; layer < DEPTH; ++layer) {
        const int pb = 2 + layer * 8; const int j = layer >> 1;
        if ((layer & 1) == 0) {
            if (PHON(2) && IN(pb + 0)) { refresh(F); unsigned char* ws = opq(F.ws); (void)ws;
                PlainSched S{T / 256, 4, 256, F.G, cid, (const char*)(ws + WS_WPIN) + (size_t)j * 2 * MiB, 2048};
                pg8::EpiStore E{(bf16*)(ws + WS_U), D, nullptr, 0, 0, 0, F.lds + LDS_TB_OFF + F.wave * 2048};
                pg8::gemm_phase<pg8::EpiStore, PlainSched>(F.tid, F.lds, (const char*)(ws + WS_H), 2048, 2048, 1024, S, E);
            } LSEAM(pb + 0); STAMP(2);
            if (PHON(4) && IN(pb + 2)) { refresh(F); unsigned char* ws = opq(F.ws); (void)ws;
                GrpSched S{F.G, cid, (const char*)(ws + WS_WPGRP) + (size_t)j * 512 * 1024};
                { const bf16* U = (const bf16*)(ws + WS_U); bf16* Z = (bf16*)(ws + WS_Z); pg8::Unit pu;
                  for (int i = 0; S.next(i, pu); ++i) {
                      const int b = pu.pm >> 3, t0 = (pu.pm & 7) * 256 + 32 * F.wave, g = pu.pn;
                      if (g == 0) pool_item<2>(U, Z, b, t0, 0, F.lane); else if (g == 1) pool_item<4>(U, Z, b, t0, 1, F.lane);
                      else if (g == 2) pool_item<8>(U, Z, b, t0, 2, F.lane); else pool_item<16>(U, Z, b, t0, 3, F.lane); }
                  asm volatile("s_waitcnt vmcnt(0)" ::: "memory"); __syncthreads(); }
                pg8::EpiStore E{(bf16*)(ws + WS_Y2), D, inp(F, 6) + j * D, 0, 0, 0, F.lds + LDS_TB_OFF + F.wave * 2048};
                pg8::gemm_phase<pg8::EpiStore, GrpSched>(F.tid, F.lds, (const char*)(ws + WS_Z), 2048, 512, 256, S, E);
            } LSEAM(pb + 2); STAMP(4);
            if (PHON(5) && IN(pb + 3)) { refresh(F); unsigned char* ws = opq(F.ws); (void)ws;
                PlainSched S{T / 256, 4, 256, F.G, cid, (const char*)(ws + WS_WPOUT) + (size_t)j * 2 * MiB, 2048};
                pg8::EpiStore E{(bf16*)(ws + WS_Y), D, nullptr, 0, 0, 1, F.lds + LDS_TB_OFF + F.wave * 2048};
                pg8::gemm_phase<pg8::EpiStore, PlainSched>(F.tid, F.lds, (const char*)(ws + WS_Y2), 2048, 2048, 1024, S, E);
            } LSEAM(pb + 3); STAMP(5);
        } else {
            if (PHON(6) && IN(pb + 0)) { refresh(F); unsigned char* ws = opq(F.ws); (void)ws;
                PlainSched S{T / 256, NQKV / 256, (T / 256) * (NQKV / 256), F.G, cid, (const char*)(ws + WS_WAIN) + (size_t)j * 18 * MiB, 2048};
                pg8::EpiStore E{(bf16*)(ws + WS_QKV), NQKV, nullptr, 1, 1, 0, F.lds + LDS_TB_OFF + F.wave * 2048};
                pg8::gemm_phase<pg8::EpiStore, PlainSched>(F.tid, F.lds, (const char*)(ws + WS_H), 2048, 2048, 1024, S, E);
            } LSEAM(pb + 0); STAMP(6);
            if (PHON(7) && IN(pb + 1)) { refresh(F); unsigned char* ws = opq(F.ws); (void)ws;
#ifdef NAIVE_ATTN
                attn_phase_naive(F, (bf16*)(F.ws + WS_Y2), 7);
#ifdef ORACLE
                if (layer == ORACLE_LAYER) { attn_phase_naive(F, (bf16*)(F.ws + WS_Z), ATTN_GMASK); attn_phase(F, (bf16*)(F.ws + WS_U)); }
#endif
#else
                attn_phase(F, (bf16*)(F.ws + WS_Y2));
#endif
            } if (IN(pb + 1) && IN(pb + 3)) { if (xlocal) xcd_local_barrier(bar, F.wave == 0); else GRID_BAR(); } STAMP(7);
            if (IN(pb + 2)) { refresh(F); unsigned char* ws = opq(F.ws); (void)ws;
#ifdef ORACLE
                if (layer == ORACLE_LAYER) { if (blockIdx.x == 0 && F.tid == 0) atomicAdd(F.ctl + 20000, 3276u * 16u);
                    const bf16* A = (const bf16*)(ws + WS_U); const bf16* B = (const bf16*)(ws + WS_Z);
                    const int gw = F.vcu * NWAVES + F.wave, NGW = F.G * NWAVES;
                    for (int tok = gw; tok < T; tok += NGW) { int bad = 0;
                        for (int h = 0; h < 16; ++h) { if (ORACLE_SEL) { const float a = bf2f(A[(size_t)tok * D + h * 64 + F.lane]), b = bf2f(B[(size_t)tok * D + h * 64 + F.lane]);
                            const float e2 = wave_sum((a - b) * (a - b)), n2 = wave_sum(b * b); if (!(e2 <= 0.0025f * n2)) bad += ORACLE_W; } }
                        if (bad && F.lane == 0) atomicAdd(F.ctl + 20000, (unsigned)bad); } }
#endif
            }
            if (PHON(8) && IN(pb + 3)) { refresh(F); unsigned char* ws = opq(F.ws); (void)ws;
                PlainSched S{T / 256, 4, 256, F.G, cid, (const char*)(ws + WS_WAOUT) + (size_t)j * 2 * MiB, 2048};
                pg8::EpiStore E{(bf16*)(ws + WS_Y), D, nullptr, 0, 0, 1, F.lds + LDS_TB_OFF + F.wave * 2048};
                pg8::gemm_phase<pg8::EpiStore, PlainSched>(F.tid, F.lds, (const char*)(ws + WS_Y2), 2048, 2048, 1024, S, E);
            } LSEAM(pb + 3); STAMP(8);
        }
        if (PHON(9) && IN(pb + 4)) { refresh(F); unsigned char* ws = opq(F.ws); (void)ws; const float* xin = (layer == 0) ? inp(F, 0) : (const float*)(ws + WS_X); ln1_router_phase(F, layer, xin, layer != 0); } SEAM(pb + 4); STAMP(9);
        if (PHON(10) && IN(pb + 5)) { refresh(F); unsigned char* ws = opq(F.ws); (void)ws;
            moe_build_table(F, layer);
            const LAS int* ts = (const LAS int*)(F.lc + LC_TS);
            const int ntile = ts[65];
            MoeSched<true> S{ts, (const LAS int*)(F.lc + LC_CNT), 2, ntile * 2, F.G, cid, F.lane, (const int*)(ws + WS_TOKL), (const float*)(ws + WS_WL),
                       (const char*)(ws + WS_WEGU) + (size_t)layer * 64 * MiB, (size_t)1 * MiB, (const char*)(ws + WS_WSHGU) + (size_t)layer * MiB, 2048};
            pg8::EpiGU E{(bf16*)(ws + WS_ACT)};
            pg8::gemm_phase<pg8::EpiGU, MoeSched<true>>(F.tid, F.lds, (const char*)(ws + WS_H), 2048, 2048, 1024, S, E);
        } LSEAM(pb + 5); STAMP(10);
        if (PHON(11) && IN(pb + 6)) { refresh(F); unsigned char* ws = opq(F.ws); (void)ws;
            moe_build_table(F, layer);
            const LAS int* ts = (const LAS int*)(F.lc + LC_TS);
            const int ntile = ts[65];
            MoeSched<false> S{ts, (const LAS int*)(F.lc + LC_CNT), 4, ntile * 4, F.G, cid, F.lane, nullptr, nullptr,
                       (const char*)(ws + WS_WEDN) + (size_t)layer * 32 * MiB, (size_t)512 * 1024, (const char*)(ws + WS_WSHDN) + (size_t)layer * 512 * 1024, 512};
            pg8::EpiStore E{(bf16*)(ws + WS_YS), D, nullptr, 0, 1, 1, F.lds + LDS_TB_OFF + F.wave * 2048};
            pg8::gemm_phase<pg8::EpiStore, MoeSched<false>>(F.tid, F.lds, (const char*)(ws + WS_ACT), 512, 512, 256, S, E);
        } SEAM(pb + 6); STAMP(11);
        if (PHON(12) && IN(pb + 7)) { refresh(F); unsigned char* ws = opq(F.ws); (void)ws; moe_build_table(F, layer); combine_ln2_phase(F, layer); }
        if (layer < DEPTH - 1) LSEAM(pb + 7);
        STAMP(12);
    }
#ifdef PROBE_TYPE
    if (blockIdx.x == 0 && F.tid == 0) { const unsigned long long t0_ = __builtin_amdgcn_s_memrealtime(); const unsigned long long want_ = 4ull * ((LAS unsigned long long*)(F.lc + LC_STAMP))[1 + PROBE_TYPE];
        while (__builtin_amdgcn_s_memrealtime() - t0_ < want_) __builtin_amdgcn_s_sleep(8); }
#endif
#undef IN
#undef SEAM
}

extern "C" void kernel_launch(void* const* d_in, const int* in_sizes, int n_in, void* d_out, int out_size, void* d_ws, size_t ws_size, hipStream_t stream) {
    static int grid = 0;
    if (grid == 0) {
        if (n_in != 20 || in_sizes[0] != T * D || out_size != T * D || ws_size < WS_END) { fprintf(stderr, "kernel_launch: unexpected shapes / workspace (n_in %d, ws %zu); nothing launched\n", n_in, ws_size); grid = -1; return; }
        int dev = 0, cus = 0, per_cu = 0;
        if (hipGetDevice(&dev) != hipSuccess || hipDeviceGetAttribute(&cus, hipDeviceAttributeMultiprocessorCount, dev) != hipSuccess) { grid = -1; return; }
        if (hipFuncSetAttribute((const void*)mk_fwd, hipFuncAttributeMaxDynamicSharedMemorySize, LDS_BYTES) != hipSuccess) { fprintf(stderr, "kernel_launch: hipFuncSetAttribute failed\n"); grid = -1; return; }
        if (hipOccupancyMaxActiveBlocksPerMultiprocessor(&per_cu, (const void*)mk_fwd, NWAVES * 64, LDS_BYTES) != hipSuccess || per_cu < 1) { fprintf(stderr, "kernel_launch: occupancy query says %d\n", per_cu); }
        (void)hipGetLastError();
        grid = cus;
    }
    if (grid < 0) return;
    if (hipMemsetAsync((char*)d_ws + WS_CTL, 0, CTL_ZERO_BYTES, stream) != hipSuccess) return;
    Args a{};
    for (int i = 0; i < 20; ++i) a.in[i] = (const float*)d_in[i];
    a.out = (float*)d_out; a.ws = (unsigned char*)d_ws;
#if MK_PER_PHASE
    for (int p = 0; p < NPHASE; ++p) { a.ph_lo = p; a.ph_hi = p + 1; hipLaunchKernelGGL(mk_fwd, dim3(grid), dim3(NWAVES * 64), LDS_BYTES, stream, a); }
#else
    a.ph_lo = 0; a.ph_hi = NPHASE;
    hipLaunchKernelGGL(mk_fwd, dim3(grid), dim3(NWAVES * 64), LDS_BYTES, stream, a);
#endif
    const hipError_t le = hipPeekAtLastError();
    if (le != hipSuccess) fprintf(stderr, "kernel_launch: launch failed: %s\n", hipGetErrorName(le));
}
```

```cpp
#include <hip/hip_runtime.h>
#include <cstdio>
#include <cstdint>

#ifndef MK_PER_PHASE
#define MK_PER_PHASE 0
#endif
#define ORACLE_SEL 1
#define ATTN_GMASK 7
#define ORACLE_W 1
#define ORACLE_LAYER 1
#ifndef MK_XLOCAL
#define MK_XLOCAL 1
#endif
#ifndef PHSEL
#define PHSEL 0xFFFF
#endif
#define PHON(n) (((PHSEL) >> (n)) & 1)

#define GAS __attribute__((address_space(1)))
#define LAS __attribute__((address_space(3)))
typedef unsigned short bf16;
typedef short bf16x8 __attribute__((ext_vector_type(8)));
typedef short s16x4 __attribute__((ext_vector_type(4)));
typedef float f32x2 __attribute__((ext_vector_type(2)));
typedef float f32x4 __attribute__((ext_vector_type(4)));
typedef float f32x16 __attribute__((ext_vector_type(16)));
typedef unsigned u32x2 __attribute__((ext_vector_type(2)));
typedef unsigned u32x4 __attribute__((ext_vector_type(4)));

constexpr int BATCH = 8, SEQ = 2048, D = 1024, T = BATCH * SEQ, DEPTH = 4;
constexpr int NQKV = 9216, NE = 64, TOPK = 8, DEXP = 256;
constexpr int CAP = 16384;
constexpr int PSLOT = 147456 + T;
constexpr float ALPHA = 1.6817928305074290f;
constexpr float LN_EPS = 1e-5f;
constexpr float LOG2E = 1.4426950408889634f;
constexpr float QSCALE = 0.125f * LOG2E;
constexpr float ROUTED_SCALE = 2.5f;

constexpr size_t MiB = 1u << 20;
constexpr size_t WS_CTL = 0, CTL_ZERO_BYTES = 1 * MiB;
constexpr size_t WS_MOD = 1 * MiB;
constexpr size_t WS_WRHI = 2 * MiB;
constexpr size_t WS_WRLO = WS_WRHI + 512 * 1024;
constexpr size_t WS_WPIN = 3 * MiB;
constexpr size_t WS_WPGRP = 7 * MiB;
constexpr size_t WS_WPOUT = 8 * MiB;
constexpr size_t WS_WAIN = 12 * MiB;
constexpr size_t WS_WAOUT = 48 * MiB;
constexpr size_t WS_WSHGU = 52 * MiB;
constexpr size_t WS_WSHDN = 56 * MiB;
constexpr size_t WS_WEGU = 58 * MiB;
constexpr size_t WS_WEDN = 314 * MiB;
constexpr size_t WS_X = 442 * MiB;
constexpr size_t WS_H = 506 * MiB;
constexpr size_t WS_Y = 538 * MiB;
constexpr size_t WS_U = 570 * MiB;
constexpr size_t WS_Z = 602 * MiB;
constexpr size_t WS_Y2 = 634 * MiB;
constexpr size_t WS_YS = 666 * MiB;
constexpr size_t WS_ACT = 986 * MiB;
constexpr size_t WS_TOKL = 1066 * MiB;
constexpr size_t WS_WL = 1070 * MiB;
constexpr size_t WS_TSLOT = 1074 * MiB;
constexpr size_t WS_QKV = 1076 * MiB;
constexpr size_t WS_END = 1364 * MiB;
static_assert(WS_YS + (size_t)PSLOT * 2048 <= WS_ACT && WS_ACT + (size_t)PSLOT * 512 <= WS_TOKL, "ws map");
constexpr int CW_BAR = 4096;
constexpr int CW_CNT = 12288;

constexpr int RING_BYTES = 135168;
constexpr int LDSCTL_OFF = RING_BYTES;
constexpr int LDS_TB_OFF = 147456;
constexpr int LDS_BYTES = 163840;
constexpr int LC_MISC = 0;
constexpr int LC_TS = 128;
constexpr int LC_CNT = 128 + 272;
constexpr int LC_LCNT = 128 + 272 + 256;
constexpr int LC_GB = 128 + 272 + 512;

#define RLX_AGENT __ATOMIC_RELAXED, __HIP_MEMORY_SCOPE_AGENT
#define LDS_WAIT() asm volatile("s_waitcnt lgkmcnt(0)" ::: "memory")
#define VM_WAIT() asm volatile("s_waitcnt vmcnt(0)" ::: "memory")

typedef __bf16 b16x2 __attribute__((ext_vector_type(2)));
__device__ __forceinline__ unsigned f2bf(float f) { unsigned u = __builtin_bit_cast(unsigned, f); return (u + 0x7fffu + ((u >> 16) & 1u)) >> 16; }
__device__ __forceinline__ unsigned pk2(float lo, float hi) { const f32x2 v = {lo, hi}; return __builtin_bit_cast(unsigned, __builtin_convertvector(v, b16x2)); }
__device__ __forceinline__ float bf2f(unsigned h) { return __builtin_bit_cast(float, h << 16); }
__device__ __forceinline__ unsigned cvt_pk_bf16(float lo, float hi) { return pk2(lo, hi); }
typedef _Float16 h16x2 __attribute__((ext_vector_type(2)));
__device__ __forceinline__ unsigned pkh2(float lo, float hi) { const f32x2 v = {lo, hi}; return __builtin_bit_cast(unsigned, __builtin_convertvector(v, h16x2)); }
__device__ __forceinline__ float h2f(unsigned h) { return (float)__builtin_bit_cast(_Float16, (unsigned short)h); }
#define MFMA16(a, b, c) __builtin_amdgcn_mfma_f32_16x16x32_bf16(a, b, c, 0, 0, 0)
#define MFMA32(a, b, c) __builtin_amdgcn_mfma_f32_32x32x16_bf16(a, b, c, 0, 0, 0)
__device__ __forceinline__ float wave_sum(float v) {
#pragma unroll
    for (int o = 1; o < 64; o <<= 1) v += __shfl_xor(v, o);
    return v;
}

namespace pg8 {
constexpr int BM = 256, BK = 64, HALF = 128, HTB = HALF * BK * 2, STAGE_BYTES = 8 * HTB, NXCD = 8;
__host__ __device__ __forceinline__ int lds_byte(int r, int c) { const int st = (r >> 4) * 2 + (c >> 5), rr = r & 15, cc = c & 31, ob = rr * 64 + cc * 2; return st * 1024 + (ob ^ (((ob >> 9) & 1) << 5)); }
__host__ __device__ __forceinline__ void stage_rc(int b, int& R, int& C) { const int st = b / 1024, sb = b % 1024, swz = sb ^ (((sb >> 9) & 1) << 5); R = (st >> 1) * 16 + swz / 64; C = (st & 1) * 32 + (swz % 64) / 2; }
__host__ __device__ __forceinline__ int perm32(int rho) { const int n = rho >> 4, i = rho & 15; return 8 * (i >> 2) + 4 * n + (i & 3); }

struct Unit {
    int pm, pn;
    const char* bptr;
    int roff;
    int nvalid;
};

__device__ __forceinline__ int xcd_chunk(int L, int nwg) { const int q = nwg / NXCD, r = nwg % NXCD, xcd = L % NXCD, off = L / NXCD; return (xcd < r ? xcd * (q + 1) : r * (q + 1) + (xcd - r) * q) + off; }

template <class Epi, class Sched>
__device__ __forceinline__ void gemm_phase(const int tid, LAS unsigned char* lds, const char* Abase, const int lda, const int ldb, const int K, const Sched& S, const Epi& E) {
    constexpr bool GATHER = Sched::GATHER;
    const int wid = __builtin_amdgcn_readfirstlane(tid >> 6), lane = tid & 63, wr = wid >> 2, wc = wid & 3, fr = lane & 15, fq = lane >> 4;
    const int nt = K / BK;
    int Rr[2]; unsigned C2[2], voffB[2], voffA[2];
#pragma unroll
    for (int i = 0; i < 2; ++i) { int R, C; stage_rc(tid * 16 + i * 8192, R, C); const int Rb = Epi::WIDE ? ((R >> 5) * 64 + perm32(R & 31)) : ((R & ~31) + perm32(R & 31)); Rr[i] = R; C2[i] = (unsigned)C * 2u; voffB[i] = (unsigned)(Rb * ldb) + (unsigned)C * 2u;
        voffA[i] = Sched::ABLK ? (unsigned)((C >> 5) * 16384 + R * 64 + (C & 31) * 2) : ((unsigned)(R * lda) + (unsigned)C * 2u); }
    const size_t kstep = (size_t)(BK * 2);
    const size_t hstepB = (size_t)(Epi::WIDE ? 32 : HALF) * ldb;
    const size_t hstepA = GATHER ? (size_t)0 : (Sched::ABLK ? (size_t)8192 : (size_t)HALF * lda);
    const size_t kstepA = Sched::ABLK ? (size_t)32768 : kstep;
    const unsigned ldsw = (unsigned)wid * 1024u;
    const int aoff = lds_byte(wr * 64 + fr, fq * 8), boff = lds_byte(wc * 32 + fr, fq * 8);
#define PG8_SA(b, h) (((b) * 2 + (h)) * HTB)
#define PG8_SB(b, h) ((4 + (b) * 2 + (h)) * HTB)
#define PG8_STAGE(bufoff, gbase, voff) do { _Pragma("unroll") for (int _i = 0; _i < 2; ++_i) \
        __builtin_amdgcn_global_load_lds((const unsigned*)((const char*)(gbase) + (voff)[_i]), (LAS unsigned*)(lds + (bufoff) + ldsw + _i * 8192), 16, 0, 0); } while (0)
#define PG8_STAGEA(bufoff, gbase, h) do { if constexpr (GATHER) { PG8_STAGE(bufoff, gbase, vA[h]); } else { PG8_STAGE(bufoff, (gbase) + (h) * hstepA, voffA); } } while (0)
#define PG8_LDA(dst, b, h) do { _Pragma("unroll") for (int m = 0; m < 4; ++m) _Pragma("unroll") for (int k = 0; k < 2; ++k) dst[m][k] = *(const LAS bf16x8*)(lds + PG8_SA(b, h) + aoff + m * 2048 + k * 1024); } while (0)
#define PG8_LDB(dst, b, h) do { _Pragma("unroll") for (int n = 0; n < 2; ++n) _Pragma("unroll") for (int k = 0; k < 2; ++k) dst[n][k] = *(const LAS bf16x8*)(lds + PG8_SB(b, h) + boff + n * 2048 + k * 1024); } while (0)
#define PG8_MMA(ai, bj, At, Bt) do { __builtin_amdgcn_s_setprio(1); _Pragma("unroll") for (int m = 0; m < 4; ++m) _Pragma("unroll") for (int n = 0; n < 2; ++n) _Pragma("unroll") for (int k = 0; k < 2; ++k) \
        acc[ai][bj][m][n] = MFMA16(Bt[n][k], At[m][k], acc[ai][bj][m][n]); __builtin_amdgcn_s_setprio(0); } while (0)
#define PG8_WAIT_V(n) asm volatile("s_waitcnt vmcnt(" #n ")" ::: "memory")
#define PG8_WAIT_L(n) asm volatile("s_waitcnt lgkmcnt(" #n ")" ::: "memory")
#define PG8_BAR __builtin_amdgcn_s_barrier()
#define PG8_SCHED __builtin_amdgcn_sched_barrier(0)
#define PG8_CALCA(u, vo) do { _Pragma("unroll") for (int _h = 0; _h < 2; ++_h) _Pragma("unroll") for (int _i = 0; _i < 2; ++_i) \
        vo[_h][_i] = (unsigned)S.arow(u, _h * HALF + Rr[_i]) * (unsigned)lda + C2[_i]; } while (0)
    Unit cur, nxt; int ui = 0;
    if (!S.next(0, cur)) return;
    f32x4 acc[2][2][4][2];
#pragma unroll
    for (int a = 0; a < 2; ++a)
#pragma unroll
        for (int b = 0; b < 2; ++b)
#pragma unroll
            for (int m = 0; m < 4; ++m)
#pragma unroll
                for (int n = 0; n < 2; ++n) acc[a][b][m][n] = (f32x4){0.f, 0.f, 0.f, 0.f};
    bf16x8 At[4][2], B0[2][2], B1[2][2];
    unsigned vA[2][2], vAn[2][2];
    const char* cA = Abase;
    if constexpr (GATHER) { PG8_CALCA(cur, vA); } else { cA = Abase + (size_t)S.arow(cur, 0) * lda + S.acolb(cur); }
    const char* cB = cur.bptr;
    PG8_STAGE(PG8_SB(0, 0), cB, voffB); PG8_STAGE(PG8_SB(0, 1), cB + hstepB, voffB); PG8_STAGEA(PG8_SA(0, 0), cA, 0); PG8_STAGEA(PG8_SA(0, 1), cA, 1);
    if (wr == 1) PG8_BAR;
    PG8_WAIT_V(2); PG8_BAR;
    PG8_STAGE(PG8_SB(1, 0), cB + kstep, voffB); PG8_STAGEA(PG8_SA(1, 0), cA + kstepA, 0); PG8_STAGE(PG8_SB(1, 1), cB + hstepB + kstep, voffB);
    PG8_WAIT_V(6); PG8_BAR;
    for (;;) {
        const bool has_next = S.next(ui + 1, nxt);
        float rs[2][4];
        if constexpr (Epi::ROWSCALE) {
#pragma unroll
            for (int ai = 0; ai < 2; ++ai)
#pragma unroll
                for (int m = 0; m < 4; ++m) rs[ai][m] = S.rowscale(cur, ai * HALF + wr * 64 + m * 16 + fr);
        }
        const char* nA = cA;
        if constexpr (GATHER) {
            if (has_next) { PG8_CALCA(nxt, vAn); }
            else {
#pragma unroll
                for (int h = 0; h < 2; ++h)
#pragma unroll
                    for (int i = 0; i < 2; ++i) vAn[h][i] = vA[h][i];
            }
            asm volatile("s_waitcnt vmcnt(0)" : "+v"(vAn[0][0]), "+v"(vAn[0][1]), "+v"(vAn[1][0]), "+v"(vAn[1][1]) :: "memory");
            if constexpr (Epi::ROWSCALE) { asm volatile("" : "+v"(rs[0][0]), "+v"(rs[0][1]), "+v"(rs[0][2]), "+v"(rs[0][3]), "+v"(rs[1][0]), "+v"(rs[1][1]), "+v"(rs[1][2]), "+v"(rs[1][3])); }
        } else { if (has_next) nA = Abase + (size_t)S.arow(nxt, 0) * lda + S.acolb(nxt); }
        const char* nB = has_next ? nxt.bptr : cB;
#pragma unroll 1
        for (int t = 0; t < nt; t += 2) {
            const bool last = (t == nt - 2);
            const char* a1 = cA + (size_t)(t + 1) * kstepA;
            const char* a2 = last ? nA : cA + (size_t)(t + 2) * kstepA; const char* b2 = last ? nB : cB + (size_t)(t + 2) * kstep;
            const char* a3 = a2 + kstepA; const char* b3 = b2 + kstep;
            PG8_LDB(B0, 0, 0); PG8_LDB(B1, 0, 1); PG8_SCHED; PG8_LDA(At, 0, 0); PG8_STAGEA(PG8_SA(1, 1), a1, 1);
            if constexpr (GATHER) { if (last) {
#pragma unroll
                for (int h = 0; h < 2; ++h)
#pragma unroll
                    for (int i = 0; i < 2; ++i) vA[h][i] = vAn[h][i]; } }
            PG8_WAIT_V(8); PG8_WAIT_L(0); PG8_BAR; PG8_MMA(0, 0, At, B0); PG8_MMA(0, 1, At, B1); PG8_BAR; PG8_SCHED;
            PG8_LDA(At, 0, 1); PG8_STAGE(PG8_SB(0, 0), b2, voffB); PG8_STAGE(PG8_SB(0, 1), b2 + hstepB, voffB); PG8_STAGEA(PG8_SA(0, 0), a2, 0);
            PG8_WAIT_V(8); PG8_WAIT_L(0); PG8_BAR; PG8_MMA(1, 0, At, B0); PG8_MMA(1, 1, At, B1); PG8_BAR; PG8_SCHED;
            PG8_LDB(B0, 1, 0); PG8_LDB(B1, 1, 1); PG8_SCHED; PG8_LDA(At, 1, 0); PG8_STAGEA(PG8_SA(0, 1), a2, 1);
            PG8_WAIT_V(8); PG8_WAIT_L(0); PG8_BAR; PG8_MMA(0, 0, At, B0); PG8_MMA(0, 1, At, B1); PG8_BAR; PG8_SCHED;
            PG8_LDA(At, 1, 1); PG8_STAGE(PG8_SB(1, 0), b3, voffB); PG8_STAGE(PG8_SB(1, 1), b3 + hstepB, voffB); PG8_STAGEA(PG8_SA(1, 0), a3, 0);
            PG8_WAIT_V(8); PG8_WAIT_L(0); PG8_BAR; PG8_MMA(1, 0, At, B0); PG8_MMA(1, 1, At, B1); PG8_BAR; PG8_SCHED;
        }
        if (wr == 0) PG8_BAR;
        E(acc, cur, rs, wr, wc, fr, fq);
        if (!has_next) break;
#pragma unroll
        for (int a = 0; a < 2; ++a)
#pragma unroll
            for (int b = 0; b < 2; ++b)
#pragma unroll
                for (int m = 0; m < 4; ++m)
#pragma unroll
                    for (int n = 0; n < 2; ++n) acc[a][b][m][n] = (f32x4){0.f, 0.f, 0.f, 0.f};
        cur = nxt; cB = nB; cA = nA; ++ui;
        if (wr == 1) PG8_BAR;
    }
    PG8_WAIT_V(0);
    PG8_BAR;
#undef PG8_SA
#undef PG8_SB
#undef PG8_STAGE
#undef PG8_STAGEA
#undef PG8_LDA
#undef PG8_LDB
#undef PG8_MMA
#undef PG8_WAIT_V
#undef PG8_WAIT_L
#undef PG8_BAR
#undef PG8_SCHED
#undef PG8_CALCA
}

struct EpiStore {
    static constexpr bool ROWSCALE = false, WIDE = true;
    bf16* O; int ldc; const float* cscale; int qmode; int ntst; int f16; LAS unsigned char* tb;
    __device__ __forceinline__ void operator()(const f32x4 (&acc)[2][2][4][2], const Unit& u, const float (&rs)[2][4], int wr, int wc, int fr, int fq) const {
        const int colw = u.pn * BM + wc * 64;
        float sc = 1.f; if (qmode) { if ((((u.pn * BM) >> 10) % 3) == 0) sc = QSCALE; }
        f32x4 cs[2][2];
#pragma unroll
        for (int bj = 0; bj < 2; ++bj)
#pragma unroll
            for (int n = 0; n < 2; ++n) { cs[bj][n] = cscale ? *(const f32x4*)(cscale + colw + 32 * bj + 8 * fq + 4 * n) : (f32x4){1.f, 1.f, 1.f, 1.f}; cs[bj][n] = cs[bj][n] * sc; }
        const int L = fr + 16 * fq, rr = L >> 3, sg = L & 7;
        LAS u32x4* tbv = (LAS u32x4*)tb;
        const int wi0 = fr * 8 + (fq ^ (fr & 7)), wi1 = fr * 8 + ((4 + fq) ^ (fr & 7)), ri = rr * 8 + (sg ^ rr);
        bf16* gp = O + (size_t)(u.pm * BM + wr * 64 + rr) * ldc + colw + sg * 8;
#pragma unroll
        for (int ai = 0; ai < 2; ++ai)
#pragma unroll
            for (int m = 0; m < 4; ++m) {
                u32x4 w[2];
#pragma unroll
                for (int bj = 0; bj < 2; ++bj) { const f32x4 v0 = acc[ai][bj][m][0] * cs[bj][0], v1 = acc[ai][bj][m][1] * cs[bj][1];
                    if (f16) { w[bj].x = pkh2(v0[0], v0[1]); w[bj].y = pkh2(v0[2], v0[3]); w[bj].z = pkh2(v1[0], v1[1]); w[bj].w = pkh2(v1[2], v1[3]); }
                    else { w[bj].x = cvt_pk_bf16(v0[0], v0[1]); w[bj].y = cvt_pk_bf16(v0[2], v0[3]); w[bj].z = cvt_pk_bf16(v1[0], v1[1]); w[bj].w = cvt_pk_bf16(v1[2], v1[3]); } }
                tbv[wi0] = w[0]; tbv[wi1] = w[1];
                asm volatile("" ::: "memory");
                const u32x4 r0 = tbv[ri], r1 = tbv[ri + 64];
                asm volatile("" ::: "memory");
                bf16* rowp = gp + (size_t)(ai * HALF + m * 16) * ldc;
                if (ntst) { __builtin_nontemporal_store(r0, (u32x4*)rowp); __builtin_nontemporal_store(r1, (u32x4*)(rowp + (size_t)8 * ldc)); }
                else { *(u32x4*)rowp = r0; *(u32x4*)(rowp + (size_t)8 * ldc) = r1; } }
    }
};
struct EpiGU {
    static constexpr bool ROWSCALE = false, WIDE = false;
    bf16* O;
    __device__ __forceinline__ void operator()(const f32x4 (&acc)[2][2][4][2], const Unit& u, const float (&rs)[2][4], int wr, int wc, int fr, int fq) const {
        bf16* tp = O + (size_t)u.pm * (BM * DEXP) + (size_t)(u.pn * 4 + wc) * (BM * 32) + (wr * 64 + fr) * 32 + 8 * fq;
#pragma unroll
        for (int ai = 0; ai < 2; ++ai)
#pragma unroll
            for (int m = 0; m < 4; ++m) { bf16* rowp = tp + (ai * HALF + m * 16) * 32;
                float o[8];
#pragma unroll
                for (int n = 0; n < 2; ++n)
#pragma unroll
                    for (int j = 0; j < 4; ++j) { const float g = acc[ai][0][m][n][j], uu = acc[ai][1][m][n][j];
                        const float sg = g * __builtin_amdgcn_rcpf(1.0f + __builtin_amdgcn_exp2f(-g * LOG2E)); o[n * 4 + j] = sg * uu; }
                u32x4 wv; wv.x = cvt_pk_bf16(o[0], o[1]); wv.y = cvt_pk_bf16(o[2], o[3]); wv.z = cvt_pk_bf16(o[4], o[5]); wv.w = cvt_pk_bf16(o[6], o[7]);
                *(u32x4*)rowp = wv; }
    }
};
}

#define XB_TMO      128
#define XB_XCNT(j)  (256  + 64 * (j))
#define XB_XSUB(j)  (1280 + 64 * (j))
#define XB_XGEN(j)  (2304 + 64 * (j))
#define XB_TOP      3328
#define XB_TOPGEN   3392
#define XB_LSUB(j)  (3456 + 64 * (j))
#define XB_LGEN(j)  (4480 + 64 * (j))
#define XCD_BAR_WORDS 5504
#define XB_SPIN_CAP (1u << 18)
__device__ __forceinline__ unsigned xb_ld(unsigned* p)              { return __hip_atomic_load(p, __ATOMIC_RELAXED, __HIP_MEMORY_SCOPE_AGENT); }
__device__ __forceinline__ unsigned xb_add(unsigned* p, unsigned v) { return __hip_atomic_fetch_add(p, v, __ATOMIC_RELAXED, __HIP_MEMORY_SCOPE_AGENT); }
__device__ __forceinline__ unsigned xb_xcc_id() { return (unsigned)__builtin_amdgcn_s_getreg((3 << 11) | 20) & 0xFu; }
#define XB_SPIN(cond, bar) do { unsigned _sp = 0; while (cond) { __builtin_amdgcn_s_sleep(1); \
    if ((++_sp & 255u) == 0u) { if (xb_ld(&(bar)[XB_TMO])) break; if (_sp > XB_SPIN_CAP) { atomicAdd(&(bar)[XB_TMO], 1u); break; } } } } while (0)
struct XcdBarrier { unsigned* bar; unsigned x; volatile LAS unsigned* st; };
__device__ __forceinline__ XcdBarrier xcd_barrier_post(unsigned* bar, volatile LAS unsigned* st) {
    XcdBarrier b; b.bar = bar; b.x = xb_xcc_id(); b.st = st;
    if (threadIdx.x == 0) st[2] = xb_add(&bar[XB_XCNT(b.x)], 1u);
    return b;
}
__device__ __forceinline__ void xcd_local_barrier(const XcdBarrier& b, const bool wave0) {
    asm volatile("s_waitcnt vmcnt(0)" ::: "memory");
    __syncthreads();
    if (wave0 && __builtin_amdgcn_mbcnt_hi(~0u, __builtin_amdgcn_mbcnt_lo(~0u, 0u)) == 0u) {
        unsigned* bar = b.bar;
        __builtin_amdgcn_s_waitcnt(0);
        const unsigned nloc = b.st[0];
        const unsigned old = xb_add(&bar[XB_LSUB(b.x)], 1u);
        const unsigned gen = old / nloc;
        if (old + 1u == (gen + 1u) * nloc) xb_add(&bar[XB_LGEN(b.x)], 1u);
        else XB_SPIN(xb_ld(&bar[XB_LGEN(b.x)]) == gen, bar);
        __builtin_amdgcn_fence(__ATOMIC_ACQUIRE, "agent");
        asm volatile("s_waitcnt vmcnt(0)" ::: "memory");
    }
    __syncthreads();
}
__device__ __forceinline__ void xcd_barrier_complete(unsigned* bar, unsigned x, unsigned& nloc, unsigned& nx) {
    const unsigned G = gridDim.x * gridDim.y * gridDim.z;
    unsigned sum, cnt, mine, sp = 0u;
    for (;;) {
        sum = 0u; cnt = 0u; mine = 0u;
#pragma unroll
        for (unsigned j = 0; j < 16; ++j) { const unsigned c = xb_ld(&bar[XB_XCNT(j)]); sum += c; cnt += (c > 0u) ? 1u : 0u; mine = (j == x) ? c : mine; }
        if (sum == G) break;
        __builtin_amdgcn_s_sleep(1);
        if ((++sp & 255u) == 0u) { if (xb_ld(&bar[XB_TMO])) break; if (sp > XB_SPIN_CAP) { atomicAdd(&bar[XB_TMO], 1u); break; } }
    }
    nloc = mine > 0u ? mine : 1u; nx = cnt > 0u ? cnt : 1u;
}
__device__ __forceinline__ void xcd_barrier(const XcdBarrier& b) {
    asm volatile("s_waitcnt vmcnt(0)" ::: "memory");
    __syncthreads();
    if (threadIdx.x == 0) {
        unsigned* bar = b.bar;
        __builtin_amdgcn_s_waitcnt(0);
        unsigned nloc = b.st[0], nx = b.st[1];
        if (nloc == 0u) { xcd_barrier_complete(bar, b.x, nloc, nx); b.st[0] = nloc; b.st[1] = nx; }
        const unsigned old = xb_add(&bar[XB_XSUB(b.x)], 1u);
        const unsigned gen = old / nloc;
        if (old + 1u == (gen + 1u) * nloc) {
            __builtin_amdgcn_fence(__ATOMIC_RELEASE, "agent");
            asm volatile("s_waitcnt vmcnt(0)" ::: "memory");
            const unsigned og = xb_add(&bar[XB_TOP], 1u);
            const unsigned tg = og / nx;
            if (og + 1u == (tg + 1u) * nx) xb_add(&bar[XB_TOPGEN], 1u);
            else XB_SPIN(xb_ld(&bar[XB_TOPGEN]) == tg, bar);
            __builtin_amdgcn_fence(__ATOMIC_ACQUIRE, "agent");
            xb_add(&bar[XB_XGEN(b.x)], 1u);
            asm volatile("s_waitcnt vmcnt(0)" ::: "memory");
        } else {
            XB_SPIN(xb_ld(&bar[XB_XGEN(b.x)]) == gen, bar);
            __builtin_amdgcn_fence(__ATOMIC_ACQUIRE, "agent");
            asm volatile("s_waitcnt vmcnt(0)" ::: "memory");
        }
    }
    __syncthreads();
}

constexpr int NWAVES = 8;
struct Frame {
    LAS unsigned char* lds;
    LAS unsigned char* lc;
    unsigned* ctl;
    unsigned char* ws;
    int tid, lane, wave, vcu, G;
};
constexpr int LC_PTR = 2048;
__device__ __forceinline__ const float* inp(const Frame& F, int i) {
    const unsigned long long v = *(const LAS unsigned long long*)(F.lc + LC_PTR + 8 * i);
    const unsigned lo = __builtin_amdgcn_readfirstlane((unsigned)v), hi = __builtin_amdgcn_readfirstlane((unsigned)(v >> 32));
    return (const float*)(const GAS float*)(((unsigned long long)hi << 32) | lo);
}
__device__ __forceinline__ unsigned char* opq(unsigned char* p) { GAS unsigned char* g = (GAS unsigned char*)p; asm volatile("" : "+s"(g)); return (unsigned char*)g; }
__device__ __forceinline__ void refresh(Frame& F) { asm volatile("" : "+v"(F.tid)); F.lane = F.tid & 63; F.wave = __builtin_amdgcn_readfirstlane(F.tid >> 6); }

struct PlainSched {   static constexpr bool GATHER = false, ABLK = false;
    int nM, nN, nwg, G, c; const char* B; int ldb;
    __device__ __forceinline__ bool next(int i, pg8::Unit& u) const {
        const int L = i * G + c; if (L >= nwg) return false;
        const int wgid = pg8::xcd_chunk(L, nwg);
        const int nig = 8 * nN, gid = wgid / nig, fm = gid * 8, gsz = (nM - fm) < 8 ? (nM - fm) : 8;
        u.pm = fm + ((wgid % nig) % gsz); u.pn = (wgid % nig) / gsz;
        u.bptr = B + (size_t)u.pn * 256 * ldb; u.roff = -(u.pm * 256) - 1; u.nvalid = 256; return true;
    }
    __device__ __forceinline__ int arow(const pg8::Unit& u, int r) const { return -u.roff - 1 + r; }
    __device__ __forceinline__ int acolb(const pg8::Unit&) const { return 0; }
    __device__ __forceinline__ float rowscale(const pg8::Unit&, int) const { return 1.0f; }
};
struct GrpSched {     static constexpr bool GATHER = false, ABLK = false;
    int G, c; const char* B;
    __device__ __forceinline__ bool next(int i, pg8::Unit& u) const {
        const int L = i * G + c; if (L >= 256) return false;
        const int wgid = pg8::xcd_chunk(L, 256);
        u.pm = wgid >> 2; u.pn = wgid & 3; u.bptr = B + (size_t)u.pn * 256 * 512; u.roff = -(u.pm * 256) - 1; u.nvalid = 256; return true;
    }
    __device__ __forceinline__ int arow(const pg8::Unit& u, int r) const { return -u.roff - 1 + r; }
    __device__ __forceinline__ int acolb(const pg8::Unit& u) const { return u.pn * 512; }
    __device__ __forceinline__ float rowscale(const pg8::Unit&, int) const { return 1.0f; }
};
template <bool GATHER_> struct MoeSched {     static constexpr bool GATHER = GATHER_, ABLK = !GATHER_;
    const LAS int* ts; const LAS int* cn; int npn, nunits, G, c, lane_;
    const int* tokl; const float* wl; const char* Bexp; size_t bstride; const char* Bsh; int ldb;
    __device__ __forceinline__ bool next(int i, pg8::Unit& u) const {
        const int L = i * G + c; const int xg = L % pg8::NXCD, off = L / pg8::NXCD;
        const int ntile = nunits / npn, tq = ntile / pg8::NXCD, tr = ntile % pg8::NXCD;
        const int tcnt = tq + (xg < tr ? 1 : 0), tstart = xg * tq + (xg < tr ? xg : tr);
        if (off >= tcnt * npn) return false;
        const int tile = tstart + off / npn, pn = off % npn;
        const int lane = lane_;
        const bool hit = (tile >= ts[lane]) && (tile < ts[lane + 1]);
        const unsigned long long mk = __ballot(hit);
        const int e = mk ? (int)__builtin_ctzll(mk) : 64;
        const int tse = __builtin_amdgcn_readfirstlane(ts[e]);
        const int r0 = (tile - tse) * 256;
        u.pm = tile; u.pn = pn;
        u.bptr = (e < 64 ? Bexp + (size_t)e * bstride : Bsh) + (size_t)pn * 256 * ldb;
        if (GATHER) {
            if (e < 64) { const int ce = __builtin_amdgcn_readfirstlane(cn[e]); u.roff = e * CAP + r0; u.nvalid = (ce - r0) < 256 ? (ce - r0) : 256; }
            else { u.roff = -r0 - 1; u.nvalid = 256; }
        } else { u.roff = -(tile * 256) - 1; u.nvalid = 256; }
        return true;
    }
    __device__ __forceinline__ int arow(const pg8::Unit& u, int r) const { if (GATHER && u.roff >= 0) { const int rr = r < u.nvalid ? r : u.nvalid - 1; return tokl[u.roff + rr]; } return -u.roff - 1 + r; }
    __device__ __forceinline__ int acolb(const pg8::Unit&) const { return 0; }
    __device__ __forceinline__ float rowscale(const pg8::Unit& u, int r) const { if (GATHER && u.roff >= 0) { const int rr = r < u.nvalid ? r : u.nvalid - 1; return wl[u.roff + rr]; } return 1.0f; }
};

__device__ __forceinline__ void p0_transpose_item64(const float* W, int K, int N, bf16* WT, int dst_n0, LAS float* scr, int kb, int nb, int lane) {
    const int k0 = 64 * kb, n0 = 64 * nb; const int r = lane >> 4, c4 = lane & 15;
    f32x4 v[16];
#pragma unroll
    for (int i = 0; i < 16; ++i) v[i] = *(const GAS f32x4*)(W + (size_t)(k0 + 4 * i + r) * N + n0 + 4 * c4);
#pragma unroll
    for (int i = 0; i < 16; ++i) { const int k = 4 * i + r; *(LAS f32x4*)(scr + k * 64 + 4 * (c4 ^ (k >> 3))) = v[i]; }
    LDS_WAIT(); asm volatile("" ::: "memory");
    const int c = lane & 7;
#pragma unroll
    for (int j = 0; j < 8; ++j) { const int n = (lane >> 3) + 8 * j; const LAS float* sp = scr + (8 * c) * 64 + 4 * ((n >> 2) ^ c) + (n & 3);
        u32x4 o; o.x = pk2(sp[0 * 64], sp[1 * 64]); o.y = pk2(sp[2 * 64], sp[3 * 64]); o.z = pk2(sp[4 * 64], sp[5 * 64]); o.w = pk2(sp[6 * 64], sp[7 * 64]);
        *(GAS u32x4*)(WT + (size_t)(dst_n0 + n) * K + k0 + 8 * c) = o; }
    LDS_WAIT(); asm volatile("" ::: "memory");
}
__device__ __forceinline__ void p0_router_item(const float* W, bf16* WH, bf16* WLo, LAS float* scr, int kb, int nb, int lane) {
    const int K = 1024, N = 64; const int k0 = 64 * kb, n0 = 32 * nb;
#pragma unroll 8
    for (int i = 0; i < 32; ++i) { const int kk = 2 * i + (lane >> 5); scr[kk * 33 + (lane & 31)] = W[(size_t)(k0 + kk) * N + n0 + (lane & 31)]; }
    LDS_WAIT(); asm volatile("" ::: "memory");
    const int c = lane & 7;
#pragma unroll
    for (int j = 0; j < 4; ++j) { const int n = (lane >> 3) + 8 * j; const LAS float* s = scr + (8 * c) * 33 + n;
        unsigned h[8], l[8];
#pragma unroll
        for (int q = 0; q < 8; ++q) { const float v = s[q * 33]; h[q] = f2bf(v); l[q] = f2bf(v - bf2f(h[q])); }
        u32x4 oh, ol; oh.x = h[0] | (h[1] << 16); oh.y = h[2] | (h[3] << 16); oh.z = h[4] | (h[5] << 16); oh.w = h[6] | (h[7] << 16);
        ol.x = l[0] | (l[1] << 16); ol.y = l[2] | (l[3] << 16); ol.z = l[4] | (l[5] << 16); ol.w = l[6] | (l[7] << 16);
        *(GAS u32x4*)(WH + (size_t)(n0 + n) * K + k0 + 8 * c) = oh; *(GAS u32x4*)(WLo + (size_t)(n0 + n) * K + k0 + 8 * c) = ol; }
    LDS_WAIT(); asm volatile("" ::: "memory");
}

__device__ __forceinline__ void p0_prologue(Frame& F) {
    LAS float* cs = (LAS float*)(F.lds);
    LAS float* part = (LAS float*)(F.lds + 32768);
    const float* c = inp(F, 1);
    for (int i = F.tid; i < 8 * 1024; i += 512) { const float v = c[i]; cs[i] = v / (1.0f + __expf(-v)); }
    __syncthreads();
    float* mod = (float*)(F.ws + WS_MOD);
    for (int it = F.vcu; it < 4 * 96; it += F.G) {
        const int layer = it / 96, slab = it % 96; const int col = slab * 64 + F.lane;
        const float* W = inp(F, 2) + (size_t)layer * 1024 * 6144 + col;
        float a[8];
#pragma unroll
        for (int b = 0; b < 8; ++b) a[b] = 0.f;
        const int k0 = F.wave * 128;
#pragma unroll 4
        for (int k = 0; k < 128; k += 4) {
            float w[4];
#pragma unroll
            for (int j = 0; j < 4; ++j) w[j] = W[(size_t)(k0 + k + j) * 6144];
#pragma unroll
            for (int b = 0; b < 8; ++b) { const f32x4 cv = *(const LAS f32x4*)(cs + b * 1024 + k0 + k); a[b] += cv[0] * w[0] + cv[1] * w[1] + cv[2] * w[2] + cv[3] * w[3]; }
        }
#pragma unroll
        for (int b = 0; b < 8; ++b) part[(F.wave * 8 + b) * 64 + F.lane] = a[b];
        __syncthreads();
        { const int b = F.wave; float s = 0.f;
#pragma unroll
          for (int w = 0; w < 8; ++w) s += part[(w * 8 + b) * 64 + F.lane];
          mod[((size_t)layer * 8 + b) * 6144 + col] = s + inp(F, 3)[layer * 6144 + col]; }
        __syncthreads();
    }
    __syncthreads();
    LAS float* scr = (LAS float*)(F.lds + F.wave * 16384);
    const int gw = F.vcu * NWAVES + F.wave, NGW = F.G * NWAVES;
    constexpr int I_PIN = 2 * 16 * 16, I_GRP = 8 * 4 * 4, I_POUT = I_PIN, I_AIN = 2 * 16 * 144, I_AOUT = I_PIN, I_SHGU = 4 * 16 * 8, I_SHDN = 4 * 4 * 16, I_R = 4 * 16 * 2;
    constexpr int I_EGU = 256 * 16 * 8, I_EDN = 256 * 4 * 16;
    constexpr int NITEMS = I_PIN + I_GRP + I_POUT + I_AIN + I_AOUT + I_SHGU + I_SHDN + I_R + I_EGU + I_EDN;
    for (int it = gw; it < NITEMS; it += NGW) {
        int r = it;
#define P0_GROUP(CNT, SRC, KK, NN, DST, GU) if (r < (CNT)) { const int per = ((KK) / 64) * ((NN) / 64), mat = r / per, q = r % per, nblk = (NN) / 64, kblk = (KK) / 64, nb = q / kblk, kb = q % kblk; (void)nblk; \
            int dn0 = 64 * nb; if (GU) { const int n0 = 64 * nb; dn0 = (n0 < 256) ? ((n0 >> 7) * 256 + (n0 & 127)) : (((n0 - 256) >> 7) * 256 + 128 + ((n0 - 256) & 127)); } \
            p0_transpose_item64((SRC) + (size_t)mat * (KK) * (NN), (KK), (NN), (bf16*)(F.ws + (DST)) + (size_t)mat * (KK) * (NN), dn0, scr, kb, nb, F.lane); continue; } r -= (CNT);
        P0_GROUP(I_PIN, inp(F, 4), 1024, 1024, WS_WPIN, 0)
        P0_GROUP(I_GRP, inp(F, 5), 256, 256, WS_WPGRP, 0)
        P0_GROUP(I_POUT, inp(F, 7), 1024, 1024, WS_WPOUT, 0)
        P0_GROUP(I_AIN, inp(F, 8), 1024, 9216, WS_WAIN, 0)
        P0_GROUP(I_AOUT, inp(F, 9), 1024, 1024, WS_WAOUT, 0)
        P0_GROUP(I_SHGU, inp(F, 16), 1024, 512, WS_WSHGU, 1)
        P0_GROUP(I_SHDN, inp(F, 17), 256, 1024, WS_WSHDN, 0)
        if (r < I_R) { const int mat = r / 32, q = r % 32, kb = q / 2, nb = q % 2;
            p0_router_item(inp(F, 12) + (size_t)mat * 65536, (bf16*)(F.ws + WS_WRHI) + (size_t)mat * 65536, (bf16*)(F.ws + WS_WRLO) + (size_t)mat * 65536, scr, kb, nb, F.lane); continue; } r -= I_R;
        P0_GROUP(I_EGU, inp(F, 14), 1024, 512, WS_WEGU, 1)
        P0_GROUP(I_EDN, inp(F, 15), 256, 1024, WS_WEDN, 0)
#undef P0_GROUP
    }
}

__device__ __forceinline__ void p1_modulate(Frame& F, const float* x, const float* modl  , int sh_off, int sc_off) {
    bf16* H = (bf16*)(F.ws + WS_H);
    const int gw = F.vcu * NWAVES + F.wave, NGW = F.G * NWAVES;
    for (int m = gw; m < T; m += NGW) {
        const int b = m / SEQ; const float* mb = modl + (size_t)b * 6144;
        const GAS f32x4* xr = (const GAS f32x4*)(x + (size_t)m * D) + F.lane;
        GAS u32x2* o8 = (GAS u32x2*)(H + (size_t)m * D) + F.lane;
#pragma unroll
        for (int j = 0; j < 4; ++j) { const f32x4 v = xr[64 * j]; const f32x4 sc = *(const f32x4*)(mb + sc_off + 4 * F.lane + 256 * j), sh = *(const f32x4*)(mb + sh_off + 4 * F.lane + 256 * j);
            const f32x4 h = v * (sc + 1.0f) + sh; u32x2 w; w.x = pk2(h[0], h[1]); w.y = pk2(h[2], h[3]); o8[64 * j] = w; }
    }
}

template <int W>
__device__ __forceinline__ void pool_item(const bf16* U, bf16* Z, int b, int t0, int g, int lane) {
    const size_t base = (size_t)b * SEQ * D + 256 * g + 4 * lane;
    float s[4] = {0.f, 0.f, 0.f, 0.f};
#pragma unroll
    for (int j = 1; j <= W; ++j) { const int t = t0 - j; if (t >= 0) { const u32x2 v = *(const GAS u32x2*)(U + base + (size_t)t * D);
            s[0] += bf2f(v.x & 0xffffu); s[1] += bf2f(v.x >> 16); s[2] += bf2f(v.y & 0xffffu); s[3] += bf2f(v.y >> 16); } }
#pragma unroll 8
    for (int i = 0; i < 32; ++i) { const int t = t0 + i;
        const u32x2 v = *(const GAS u32x2*)(U + base + (size_t)t * D);
        const float c0 = bf2f(v.x & 0xffffu), c1 = bf2f(v.x >> 16), c2 = bf2f(v.y & 0xffffu), c3 = bf2f(v.y >> 16);
        s[0] += c0; s[1] += c1; s[2] += c2; s[3] += c3;
        if (t - W >= 0) { const u32x2 o = *(const GAS u32x2*)(U + base + (size_t)(t - W) * D);
            s[0] -= bf2f(o.x & 0xffffu); s[1] -= bf2f(o.x >> 16); s[2] -= bf2f(o.y & 0xffffu); s[3] -= bf2f(o.y >> 16); }
        const float inv = 1.0f / (float)((t + 1) < W ? (t + 1) : W);
        u32x2 w; w.x = pk2(s[0] * inv - c0, s[1] * inv - c1); w.y = pk2(s[2] * inv - c2, s[3] * inv - c3);
        *(GAS u32x2*)(Z + base + (size_t)t * D) = w; }
}

__device__ __forceinline__ void moe_build_table(Frame& F, int layer) {
    LAS int* ts = (LAS int*)(F.lc + LC_TS); LAS int* cn = (LAS int*)(F.lc + LC_CNT);
    __syncthreads();
    if (F.wave == 0) {
        const int c = (int)__hip_atomic_load(F.ctl + CW_CNT + layer * 64 + F.lane, RLX_AGENT);
        int t = (c + 255) >> 8;
#pragma unroll
        for (int o = 1; o < 64; o <<= 1) { const int v = __shfl_up(t, o); if (F.lane >= o) t += v; }
        cn[F.lane] = c; ts[F.lane + 1] = t;
        if (F.lane == 0) ts[0] = 0;
        if (F.lane == 63) ts[65] = t + 64;
    }
    __syncthreads();
}

#ifdef PROBE_TYPE
#define LSTAMP(ty) do { if (blockIdx.x == 0 && F.tid == 0) { const unsigned long long now_ = __builtin_amdgcn_s_memrealtime(); LAS unsigned long long* st_ = (LAS unsigned long long*)(F.lc + 3072); \
        st_[1 + (ty)] += now_ - st_[20]; st_[20] = now_; } } while (0)
#define LSTAMP0() do { if (blockIdx.x == 0 && F.tid == 0) { ((LAS unsigned long long*)(F.lc + 3072))[20] = __builtin_amdgcn_s_memrealtime(); } } while (0)
#else
#define LSTAMP(ty) do { } while (0)
#define LSTAMP0() do { } while (0)
#endif
constexpr int APITCH = 1032;
#define LDS_ONLY_BARRIER() do { asm volatile("s_waitcnt lgkmcnt(0)" ::: "memory"); __builtin_amdgcn_s_barrier(); asm volatile("" ::: "memory"); } while (0)
template <bool X16>
__device__ __forceinline__ void ln1_router_phase(Frame& F, int layer, const float* xin) {
    bf16* X = (bf16*)(F.ws + WS_X);
    bf16* H = (bf16*)(F.ws + WS_H); const bf16* Y = (const bf16*)(F.ws + WS_Y);
    const float* modl = (const float*)(F.ws + WS_MOD) + (size_t)layer * 8 * 6144;
    const float* lg = inp(F, 10) + layer * D; const float* lb = inp(F, 11) + layer * D;
    const float* rb = inp(F, 13) + layer * NE;
    const bf16* WH = (const bf16*)(F.ws + WS_WRHI) + (size_t)layer * 65536; const bf16* WLo = (const bf16*)(F.ws + WS_WRLO) + (size_t)layer * 65536;
    int* tokl = (int*)(F.ws + WS_TOKL); float* wl = (float*)(F.ws + WS_WL); int* tslot = (int*)(F.ws + WS_TSLOT);
    unsigned* gcnt = F.ctl + CW_CNT + layer * 64;
    LAS bf16* Ahi = (LAS bf16*)F.lds; LAS bf16* Alo = Ahi + 32 * APITCH;
    LAS float* PART = (LAS float*)F.lds;
    LAS float* PV = (LAS float*)(F.lds + LDS_TB_OFF);
    LAS int* lcnt = (LAS int*)(F.lc + LC_LCNT); LAS int* gb = (LAS int*)(F.lc + LC_GB);
    const int lane = F.lane, wave = F.wave;
    const int nblk = (T / 32) / F.G;
#define LN1_BLK(bi_) ((F.G == 256) ? ((F.vcu >> 5) * 64 + (F.vcu & 31) * 2 + (bi_)) : (F.vcu + (bi_) * F.G))
    constexpr int NX = X16 ? 2 : 4;
    u32x4 xr[4][NX], yv[4][2];
#define LN1_LOAD(bi_) do { const int t0_ = LN1_BLK(bi_) * 32 + wave * 4; \
        _Pragma("unroll") for (int q = 0; q < 4; ++q) _Pragma("unroll") for (int j = 0; j < 2; ++j) { const size_t o_ = (size_t)(t0_ + q) * D + 8 * lane + 512 * j; \
            if constexpr (X16) xr[q][j] = __builtin_nontemporal_load((const GAS u32x4*)((const bf16*)xin + o_)); \
            else { xr[q][2 * j] = *(const GAS u32x4*)(xin + o_); xr[q][2 * j + 1] = *(const GAS u32x4*)(xin + o_ + 4); } \
            yv[q][j] = __builtin_nontemporal_load((const GAS u32x4*)(Y + o_)); } } while (0)
    LN1_LOAD(0);
    const float rbe = rb[lane];
    { const int b = (LN1_BLK(0) * 32) / SEQ; const float* mb = modl + (size_t)b * 6144;
      for (int i = F.tid; i < 1024; i += NWAVES * 64) { const int v = i >> 8, c4 = (i & 255) * 4;
          const float* src = (v == 0) ? lg : (v == 1) ? lb : (v == 2) ? (mb + 4096) : (mb + 3072);
          f32x4 t = *(const GAS f32x4*)(src + c4); if (v == 2) t = t + 1.0f; *(LAS f32x4*)(PV + v * 1024 + c4) = t; } }
    __syncthreads();
    for (int bi = 0; bi < nblk; ++bi) {
        const int blk = LN1_BLK(bi);
        const int tok0 = blk * 32;
        LSTAMP0();
        bf16x8 bh[8][2], bl[8][2];
        {
            const int b = tok0 / SEQ; const float* mb = modl + (size_t)b * 6144;
            f32x4 xv[4][4];
            f32x4 pg1[4];
#pragma unroll
            for (int jj = 0; jj < 4; ++jj) pg1[jj] = *(const GAS f32x4*)(mb + 2048 + 8 * lane + 512 * (jj >> 1) + 4 * (jj & 1)) + 1.0f;
            float sm[4];
#pragma unroll
            for (int q = 0; q < 4; ++q) { float s = 0.f;
#pragma unroll
                for (int jj = 0; jj < 4; ++jj) { const unsigned w0 = (jj & 1) ? yv[q][jj >> 1].z : yv[q][jj >> 1].x, w1 = (jj & 1) ? yv[q][jj >> 1].w : yv[q][jj >> 1].y;
                    f32x4 y4; y4[0] = h2f(w0 & 0xffffu); y4[1] = h2f(w0 >> 16); y4[2] = h2f(w1 & 0xffffu); y4[3] = h2f(w1 >> 16);
                    f32x4 x4;
                    if constexpr (X16) { const unsigned v0 = (jj & 1) ? xr[q][jj >> 1].z : xr[q][jj >> 1].x, v1 = (jj & 1) ? xr[q][jj >> 1].w : xr[q][jj >> 1].y;
                        x4 = (f32x4){h2f(v0 & 0xffffu), h2f(v0 >> 16), h2f(v1 & 0xffffu), h2f(v1 >> 16)}; }
                    else { const u32x4 v = xr[q][jj]; x4 = (f32x4){__uint_as_float(v.x), __uint_as_float(v.y), __uint_as_float(v.z), __uint_as_float(v.w)}; }
                    xv[q][jj] = x4 * ALPHA + pg1[jj] * y4; s += (xv[q][jj][0] + xv[q][jj][1]) + (xv[q][jj][2] + xv[q][jj][3]); }
                sm[q] = s; }
#pragma unroll
            for (int o = 1; o < 64; o <<= 1) {
#pragma unroll
                for (int q = 0; q < 4; ++q) sm[q] += __shfl_xor(sm[q], o); }
            float s2[4];
#pragma unroll
            for (int q = 0; q < 4; ++q) { const float mean = sm[q] * (1.f / D); float t = 0.f;
#pragma unroll
                for (int jj = 0; jj < 4; ++jj) { xv[q][jj] = xv[q][jj] - mean; t += (xv[q][jj][0] * xv[q][jj][0] + xv[q][jj][1] * xv[q][jj][1]) + (xv[q][jj][2] * xv[q][jj][2] + xv[q][jj][3] * xv[q][jj][3]); }
                s2[q] = t; }
#pragma unroll
            for (int o = 1; o < 64; o <<= 1) {
#pragma unroll
                for (int q = 0; q < 4; ++q) s2[q] += __shfl_xor(s2[q], o); }
            LAS float* pvb = PV + 8 * lane; asm volatile("" : "+v"(pvb));
#pragma unroll
            for (int jj = 0; jj < 4; ++jj) { const int col = 8 * lane + 512 * (jj >> 1) + 4 * (jj & 1); const int co = 512 * (jj >> 1) + 4 * (jj & 1);
                const f32x4 gg = *(const LAS f32x4*)(pvb + co), bb = *(const LAS f32x4*)(pvb + 1024 + co), sc2 = *(const LAS f32x4*)(pvb + 2048 + co), sh2 = *(const LAS f32x4*)(pvb + 3072 + co);
#pragma unroll
                for (int q = 0; q < 4; ++q) { const int rl = wave * 4 + q, tok = tok0 + rl; const float rstd = 1.0f / sqrtf(s2[q] * (1.f / D) + LN_EPS);
                    const f32x4 xn = xv[q][jj] * rstd * gg + bb; { u32x2 xw; xw.x = pkh2(xn[0], xn[1]); xw.y = pkh2(xn[2], xn[3]); *(GAS u32x2*)(X + (size_t)tok * D + col) = xw; }
                    const f32x4 hf = xn * sc2 + sh2;
                    unsigned hh[4], ll[4];
#pragma unroll
                    for (int e = 0; e < 4; ++e) { hh[e] = f2bf(hf[e]); ll[e] = f2bf(hf[e] - bf2f(hh[e])); }
                    u32x2 wh, wlo; wh.x = hh[0] | (hh[1] << 16); wh.y = hh[2] | (hh[3] << 16); wlo.x = ll[0] | (ll[1] << 16); wlo.y = ll[2] | (ll[3] << 16);
                    *(GAS u32x2*)(H + (size_t)tok * D + col) = wh;
                    *(LAS u32x2*)(Ahi + rl * APITCH + col) = wh; *(LAS u32x2*)(Alo + rl * APITCH + col) = wlo; } }
        }
        __builtin_amdgcn_sched_barrier(0);
        {
            const int r32 = lane & 31, hi = lane >> 5;
#pragma unroll
            for (int nb = 0; nb < 2; ++nb) {
                const GAS bf16* ph = (const GAS bf16*)WH + (size_t)(r32 + 32 * nb) * 1024 + wave * 128 + hi * 8; const GAS bf16* pl = (const GAS bf16*)WLo + (size_t)(r32 + 32 * nb) * 1024 + wave * 128 + hi * 8;
                asm volatile("" : "+v"(ph), "+v"(pl));
#pragma unroll
                for (int ks = 0; ks < 8; ++ks) { bh[ks][nb] = *(const GAS bf16x8*)(ph + ks * 16); bl[ks][nb] = *(const GAS bf16x8*)(pl + ks * 16); } }
        }
        __syncthreads();
        LSTAMP(13);
        f32x16 acc[2]; acc[0] = (f32x16){}; acc[1] = (f32x16){};
        {
            const int r32 = lane & 31, hi = lane >> 5;
#pragma unroll
            for (int ks = 0; ks < 8; ++ks) {
                const int k = wave * 128 + ks * 16 + hi * 8;
                const bf16x8 ah = *(const LAS bf16x8*)(Ahi + r32 * APITCH + k), al = *(const LAS bf16x8*)(Alo + r32 * APITCH + k);
#pragma unroll
                for (int nb = 0; nb < 2; ++nb) {
                    acc[nb] = MFMA32(ah, bh[ks][nb], acc[nb]);
                    acc[nb] = MFMA32(al, bh[ks][nb], acc[nb]);
                    acc[nb] = MFMA32(ah, bl[ks][nb], acc[nb]);
                }
            }
        }
        LDS_ONLY_BARRIER();
        {
            const int r32 = lane & 31, hi = lane >> 5;
#pragma unroll
            for (int nb = 0; nb < 2; ++nb)
#pragma unroll
                for (int r = 0; r < 16; ++r) { const int trow = (r & 3) + 8 * (r >> 2) + 4 * hi; PART[(wave * 32 + trow) * 64 + 32 * nb + r32] = acc[nb][r]; }
        }
        if (F.tid < 64) lcnt[F.tid] = 0;
        LDS_ONLY_BARRIER();
        LSTAMP(14);
        if (bi + 1 < nblk) LN1_LOAD(bi + 1);
        else {
#pragma unroll
            for (int q = 0; q < 4; ++q) {
#pragma unroll
                for (int j = 0; j < NX; ++j) xr[q][j] = (u32x4){0u, 0u, 0u, 0u};
#pragma unroll
                for (int j = 0; j < 2; ++j) yv[q][j] = (u32x4){0u, 0u, 0u, 0u}; } }
        int chosen_m = 0; int posl[4]; float wv[4]; int rk[4];
#pragma unroll
        for (int q = 0; q < 4; ++q) {
            __builtin_amdgcn_sched_barrier(0);
            const int rl = wave * 4 + q;
            float logit = 0.f;
#pragma unroll
            for (int w = 0; w < 8; ++w) logit += PART[(w * 32 + rl) * 64 + lane];
            const float sg = 1.0f / (1.0f + __expf(-logit));
            const float sel = sg + rbe;
            float m1 = sel; m1 = fmaxf(m1, __shfl_xor(m1, 1)); m1 = fmaxf(m1, __shfl_xor(m1, 2)); m1 = fmaxf(m1, __shfl_xor(m1, 4));
            const unsigned long long bal = __ballot(sel == m1);
            const unsigned long long gm = bal & (0xFFull << (8 * (lane >> 3)));
            const int first = (int)__builtin_ctzll(gm);
            float m2 = (lane == first) ? -INFINITY : sel; m2 = fmaxf(m2, __shfl_xor(m2, 1)); m2 = fmaxf(m2, __shfl_xor(m2, 2)); m2 = fmaxf(m2, __shfl_xor(m2, 4));
            const float gs = m1 + m2;
            int rg = 0;
#pragma unroll
            for (int g2 = 0; g2 < 8; ++g2) { const float v = __builtin_bit_cast(float, __builtin_amdgcn_readlane(__builtin_bit_cast(int, gs), 8 * g2)); rg += ((v > gs) || (v == gs && g2 < (lane >> 3))) ? 1 : 0; }
            const bool gsel = rg < 4;
            const float msel = gsel ? sel : -INFINITY;
            const unsigned mb_ = __float_as_uint(msel); const unsigned key = (mb_ & 0x80000000u) ? ~mb_ : (mb_ | 0x80000000u);
            unsigned tau = 0u;
#pragma unroll 1
            for (int bit = 31; bit >= 0; --bit) { const unsigned cand = tau | (1u << bit); const int cnt = (int)__popcll(__ballot(key >= cand)); tau = (cnt >= TOPK) ? cand : tau; }
            const unsigned long long gtm = __ballot(key > tau), eqm = __ballot(key == tau);
            const int need = TOPK - (int)__popcll(gtm);
            const unsigned long long below = (1ull << lane) - 1ull;
            const bool ch = (key > tau) || ((key == tau) && ((int)__popcll(eqm & below) < need));
            const unsigned long long chm = __ballot(ch);
            const int rank = (int)__popcll(chm & below);
            const float wsum = wave_sum(ch ? sg : 0.f);
            wv[q] = sg / wsum * ROUTED_SCALE; rk[q] = rank; posl[q] = 0;
            if (ch) { chosen_m |= (1 << q); posl[q] = __hip_atomic_fetch_add(lcnt + lane, 1, __ATOMIC_RELAXED, __HIP_MEMORY_SCOPE_WORKGROUP); }
        }
        LDS_ONLY_BARRIER();
        LSTAMP(15);
        if (wave == 0) { const int n = lcnt[lane]; int base = 0; if (n > 0) base = (int)__hip_atomic_fetch_add(gcnt + lane, (unsigned)n, RLX_AGENT); gb[lane] = base; }
        LDS_ONLY_BARRIER();
        {
            const int base = gb[lane];
#pragma unroll
            for (int q = 0; q < 4; ++q) if (chosen_m & (1 << q)) { const int tok = tok0 + wave * 4 + q; const int pos = base + posl[q];
                tokl[(size_t)lane * CAP + pos] = tok; wl[(size_t)tok * 8 + rk[q]] = wv[q]; tslot[(size_t)tok * 8 + rk[q]] = lane * CAP + pos; }
        }
        LDS_ONLY_BARRIER();
        LSTAMP(16);
    }
#undef LN1_LOAD
#undef LN1_BLK
}

__device__ __forceinline__ void combine_ln2_phase(Frame& F, int layer) {
    bf16* X = (bf16*)(F.ws + WS_X); bf16* H = (bf16*)(F.ws + WS_H); const bf16* YS = (const bf16*)(F.ws + WS_YS);
    const float* modl = (const float*)(F.ws + WS_MOD) + (size_t)layer * 8 * 6144;
    const float* modn = (const float*)(F.ws + WS_MOD) + (size_t)(layer + 1) * 8 * 6144;
    const float* lg = inp(F, 18) + layer * D; const float* lb = inp(F, 19) + layer * D;
    const int* tslot = (const int*)(F.ws + WS_TSLOT);
    const LAS int* ts = (const LAS int*)(F.lc + LC_TS);
    const bool lastl = (layer == DEPTH - 1);
    float* xout = (float*)inp(F, 20);
    const int lane = F.lane, wave = F.wave;
    LAS float* PV = (LAS float*)F.lds;
    const int shbase = ts[64] * 256;
    for (int blk = F.vcu; blk < T / 64; blk += F.G) {
        const int tokb = blk * 64, b = tokb / SEQ;
        __syncthreads();
        for (int i = F.tid; i < 1024; i += 512) { PV[i] = modl[(size_t)b * 6144 + 5120 + i] + 1.0f; PV[1024 + i] = lg[i]; PV[2048 + i] = lb[i];
            if (!lastl) { PV[3072 + i] = modn[(size_t)b * 6144 + 1024 + i] + 1.0f; PV[4096 + i] = modn[(size_t)b * 6144 + i]; } }
        __syncthreads();
        const int tw = tokb + wave * 8;
        int sv; { const int v = tslot[(size_t)tw * 8 + lane]; sv = ts[v >> 14] * 256 + (v & (CAP - 1)); }
        const float wvv = ((const float*)(F.ws + WS_WL))[(size_t)tw * 8 + lane];
        u32x4 ys[18]; u32x4 xs[2];
#define CB_LOAD(k) do { const int tok_ = tw + (k); _Pragma("unroll") for (int kk_ = 0; kk_ < 9; ++kk_) { const int slot_ = (kk_ < 8) ? __builtin_amdgcn_readlane(sv, 8 * (k) + kk_) : (shbase + tok_); \
            const bf16* yr_ = YS + (size_t)slot_ * D + 8 * lane; ys[2 * kk_] = __builtin_nontemporal_load((const GAS u32x4*)(yr_)); ys[2 * kk_ + 1] = __builtin_nontemporal_load((const GAS u32x4*)(yr_ + 512)); } \
            _Pragma("unroll") for (int j_ = 0; j_ < 2; ++j_) xs[j_] = __builtin_nontemporal_load((const GAS u32x4*)(X + (size_t)tok_ * D + 8 * lane + 512 * j_)); } while (0)
        CB_LOAD(0);
#pragma unroll 1
        for (int k = 0; k < 8; ++k) {
            const int tok_ = tw + k; f32x4 y_[4];
#pragma unroll
            for (int jj_ = 0; jj_ < 4; ++jj_) y_[jj_] = (f32x4){0.f, 0.f, 0.f, 0.f};
#pragma unroll
            for (int kk_ = 0; kk_ < 9; ++kk_) { const float wk_ = (kk_ < 8) ? __builtin_bit_cast(float, __builtin_amdgcn_readlane(__builtin_bit_cast(int, wvv), 8 * k + kk_)) : 1.0f;
#pragma unroll
                for (int j_ = 0; j_ < 2; ++j_) { const u32x4 w_ = ys[2 * kk_ + j_];
                    y_[2 * j_][0] += wk_ * h2f(w_.x & 0xffffu); y_[2 * j_][1] += wk_ * h2f(w_.x >> 16); y_[2 * j_][2] += wk_ * h2f(w_.y & 0xffffu); y_[2 * j_][3] += wk_ * h2f(w_.y >> 16);
                    y_[2 * j_ + 1][0] += wk_ * h2f(w_.z & 0xffffu); y_[2 * j_ + 1][1] += wk_ * h2f(w_.z >> 16); y_[2 * j_ + 1][2] += wk_ * h2f(w_.w & 0xffffu); y_[2 * j_ + 1][3] += wk_ * h2f(w_.w >> 16); } }
            f32x4 v_[4]; float s_ = 0.f;
#pragma unroll
            for (int jj_ = 0; jj_ < 4; ++jj_) { const int col_ = 8 * lane + 512 * (jj_ >> 1) + 4 * (jj_ & 1); const f32x4 g2_ = *(const LAS f32x4*)(PV + col_);
                const unsigned w0_ = (jj_ & 1) ? xs[jj_ >> 1].z : xs[jj_ >> 1].x, w1_ = (jj_ & 1) ? xs[jj_ >> 1].w : xs[jj_ >> 1].y;
                const f32x4 x4_ = (f32x4){h2f(w0_ & 0xffffu), h2f(w0_ >> 16), h2f(w1_ & 0xffffu), h2f(w1_ >> 16)};
                v_[jj_] = x4_ * ALPHA + g2_ * y_[jj_]; s_ += (v_[jj_][0] + v_[jj_][1]) + (v_[jj_][2] + v_[jj_][3]); }
            asm volatile("" : "+v"(v_[0]), "+v"(v_[1]), "+v"(v_[2]), "+v"(v_[3]));
            __builtin_amdgcn_sched_barrier(0);
            { const int kn = (k + 1 < 8) ? k + 1 : k; CB_LOAD(kn); }
            __builtin_amdgcn_sched_barrier(0);
            const float mean_ = wave_sum(s_) * (1.f / D); float q_ = 0.f;
#pragma unroll
            for (int jj_ = 0; jj_ < 4; ++jj_) { v_[jj_] = v_[jj_] - mean_; q_ += (v_[jj_][0] * v_[jj_][0] + v_[jj_][1] * v_[jj_][1]) + (v_[jj_][2] * v_[jj_][2] + v_[jj_][3] * v_[jj_][3]); }
            const float rstd_ = 1.0f / sqrtf(wave_sum(q_) * (1.f / D) + LN_EPS);
#pragma unroll
            for (int jj_ = 0; jj_ < 4; ++jj_) { const int col_ = 8 * lane + 512 * (jj_ >> 1) + 4 * (jj_ & 1);
                const f32x4 gg_ = *(const LAS f32x4*)(PV + 1024 + col_), bb_ = *(const LAS f32x4*)(PV + 2048 + col_);
                const f32x4 xn_ = v_[jj_] * rstd_ * gg_ + bb_;
                if (lastl) *(GAS f32x4*)(xout + (size_t)tok_ * D + col_) = xn_;
                else { u32x2 xw_; xw_.x = pkh2(xn_[0], xn_[1]); xw_.y = pkh2(xn_[2], xn_[3]); *(GAS u32x2*)(X + (size_t)tok_ * D + col_) = xw_; }
                if (!lastl) { const f32x4 sc_ = *(const LAS f32x4*)(PV + 3072 + col_), sh_ = *(const LAS f32x4*)(PV + 4096 + col_); const f32x4 hm_ = xn_ * sc_ + sh_;
                    u32x2 w2_; w2_.x = pk2(hm_[0], hm_[1]); w2_.y = pk2(hm_[2], hm_[3]); *(GAS u32x2*)(H + (size_t)tok_ * D + col_) = w2_; } }
        }
#undef CB_LOAD
    }
}

constexpr int ACCP = 68;
__device__ __forceinline__ int crow(int r, int hi) { return (r & 3) + 8 * (r >> 2) + 4 * hi; }
constexpr int KPITCH = 144;
template <bool FIRST, int NB>
__device__ __forceinline__ void attn_task(const bf16* QKVb  , int g, int h, int dil, int cls, int q0, int QS, int kb0, int L, float slope2d,
                                          LAS unsigned char* stg  , LAS float* wsf  , LAS float* ACC, LAS float* ML, int trow_mul, int trow_add, int lane) {
    asm volatile("" : "+v"(lane));
    const int r32 = lane & 31, hi = lane >> 5, lr = lane >> 3, lc = lane & 7;
    const int qcol = ((g * 3 + 0) * 16 + h) * 64, kcol = ((g * 3 + 1) * 16 + h) * 64, vcol = ((g * 3 + 2) * 16 + h) * 64;
    const size_t rstride = (size_t)dil * NQKV;
    const bf16* base = QKVb + (size_t)cls * NQKV + lc * 8;
    const int jlo = (kb0 >= -31) ? 0 : ((-kb0) >> 5);
    const int qpos = q0 + QS * r32;
    const int dmax = qpos < 128 ? qpos : 128;
    const float half = 0.5f * (float)dmax;
#define AT_LOADROWS(dst, l0, ls, col) do { _Pragma("unroll") for (int i_ = 0; i_ < 4; ++i_) { int l_ = (l0) + (ls) * (8 * i_ + lr); l_ = l_ < 0 ? 0 : (l_ > L - 1 ? L - 1 : l_); \
        dst[i_] = *(const GAS u32x4*)(base + (size_t)l_ * rstride + (col)); } } while (0)
#define AT_PUTROWS(src) do { _Pragma("unroll") for (int i_ = 0; i_ < 4; ++i_) *(LAS u32x4*)(stg + (8 * i_ + lr) * KPITCH + lc * 16) = src[i_]; } while (0)
#define AT_GETFRAG(dst) do { _Pragma("unroll") for (int s_ = 0; s_ < 4; ++s_) dst[s_] = *(const LAS bf16x8*)(stg + r32 * KPITCH + 32 * s_ + 16 * hi); } while (0)
#define AT_LDSWAIT() asm volatile("s_waitcnt lgkmcnt(0)" ::: "memory")
    u32x4 kr[2][4];
    bf16x8 qf[4];
    { u32x4 qr[4]; AT_LOADROWS(qr, q0, QS, qcol);
#pragma unroll
      for (int j = 0; j < NB; ++j) if (j == jlo) AT_LOADROWS(kr[j & 1], kb0 + 32 * j, 1, kcol);
      AT_PUTROWS(qr); AT_LDSWAIT(); AT_GETFRAG(qf); AT_LDSWAIT(); }
    f32x16 S[NB];
    float mx = -INFINITY;
#pragma unroll
    for (int j = 0; j < NB; ++j) {
        if (j >= jlo) {
            asm volatile("" ::: "memory");
            if (j < NB - 1) AT_LOADROWS(kr[(j + 1) & 1], kb0 + 32 * (j + 1), 1, kcol);
            AT_PUTROWS(kr[j & 1]);
            const float xd0 = (float)(qpos - kb0 - 32 * j - 4 * hi) - half;
            const bool inner = (q0 - kb0 - 32 * j - 31 >= 0) && (q0 + QS * 31 - kb0 - 32 * j <= 128) && (kb0 + 32 * j >= 0);
            f32x16 a;
            if (inner) {
                const float cb = -slope2d * xd0;
#pragma unroll
                for (int r = 0; r < 16; ++r) a[r] = __builtin_fmaf(slope2d, (float)((r & 3) + 8 * (r >> 2)), cb);
            } else {
#pragma unroll
                for (int r = 0; r < 16; ++r) { const float x = xd0 - (float)((r & 3) + 8 * (r >> 2)); a[r] = (__builtin_fabsf(x) <= half) ? (-slope2d * x) : -INFINITY; }
            }
            bf16x8 kf[4];
            AT_LDSWAIT(); AT_GETFRAG(kf); AT_LDSWAIT();
#pragma unroll
            for (int s = 0; s < 4; ++s) a = MFMA32(kf[s], qf[s], a);
#pragma unroll
            for (int r = 0; r < 16; ++r) mx = fmaxf(mx, a[r]);
            S[j] = a;
        } else {
#pragma unroll
            for (int r = 0; r < 16; ++r) S[j][r] = -INFINITY;
        }
        __builtin_amdgcn_sched_barrier(0);
    }
    u32x4 vr[2][4];
#pragma unroll
    for (int j = 0; j < NB; ++j) if (j == jlo) AT_LOADROWS(vr[j & 1], kb0 + 32 * j, 1, vcol);
    { auto rr = __builtin_amdgcn_permlane32_swap(__float_as_uint(mx), __float_as_uint(mx), false, false);
      const unsigned r0 = rr[0], r1 = rr[1]; mx = fmaxf(__uint_as_float(r0), __uint_as_float(r1)); }
    const float mx_true = mx - slope2d * half;
    float lsum = 0.f;
    u32x4 P[NB][2];
#pragma unroll
    for (int j = 0; j < NB; ++j) {
        float p[16];
#pragma unroll
        for (int r = 0; r < 16; ++r) { p[r] = __builtin_amdgcn_exp2f(S[j][r] - mx); lsum += p[r]; }
#pragma unroll
        for (int ks = 0; ks < 2; ++ks) { P[j][ks].x = cvt_pk_bf16(p[8 * ks + 0], p[8 * ks + 1]); P[j][ks].y = cvt_pk_bf16(p[8 * ks + 2], p[8 * ks + 3]); P[j][ks].z = cvt_pk_bf16(p[8 * ks + 4], p[8 * ks + 5]); P[j][ks].w = cvt_pk_bf16(p[8 * ks + 6], p[8 * ks + 7]); }
        __builtin_amdgcn_sched_barrier(0);
    }
    { auto rr = __builtin_amdgcn_permlane32_swap(__float_as_uint(lsum), __float_as_uint(lsum), false, false);
      const unsigned r0 = rr[0], r1 = rr[1]; lsum = __uint_as_float(r0) + __uint_as_float(r1); }
    f32x16 o[2]; o[0] = (f32x16){}; o[1] = (f32x16){};
    const unsigned vrd = (unsigned)(((lane >> 4) & 1) * 32 + (lane & 3) * 8 + (4 * hi + ((lane & 15) >> 2)) * 64);
#pragma unroll
    for (int j = 0; j < NB; ++j) {
        if (j >= jlo) {
            asm volatile("" ::: "memory");
            if (j < NB - 1) AT_LOADROWS(vr[(j + 1) & 1], kb0 + 32 * (j + 1), 1, vcol);
#pragma unroll
            for (int i = 0; i < 4; ++i) { const int key = 8 * i + lr; *(LAS u32x4*)(stg + ((lc >> 2) * 2 + (key >> 4)) * 1024 + (key & 15) * 64 + (lc & 3) * 16) = vr[j & 1][i]; }
            AT_LDSWAIT();
#pragma unroll
            for (int d0 = 0; d0 < 2; ++d0)
#pragma unroll
                for (int ks = 0; ks < 2; ++ks) {
                    LAS unsigned char* vp = stg + (d0 * 2 + ks) * 1024 + vrd;
                    const s16x4 lo = __builtin_bit_cast(s16x4, __builtin_amdgcn_ds_read_tr16_b64_v4i16((LAS s16x4*)(vp)));
                    const s16x4 hh = __builtin_bit_cast(s16x4, __builtin_amdgcn_ds_read_tr16_b64_v4i16((LAS s16x4*)(vp + 512)));
                    const bf16x8 vf = (bf16x8){lo[0], lo[1], lo[2], lo[3], hh[0], hh[1], hh[2], hh[3]};
                    o[d0] = MFMA32(__builtin_bit_cast(bf16x8, P[j][ks]), vf, o[d0]);
                }
            AT_LDSWAIT();
        }
        __builtin_amdgcn_sched_barrier(0);
    }
#undef AT_LOADROWS
#undef AT_PUTROWS
#undef AT_GETFRAG
#undef AT_LDSWAIT
    if (hi == 0) { wsf[r32] = mx_true; wsf[32 + r32] = lsum; }
    asm volatile("s_waitcnt lgkmcnt(0)" ::: "memory");
    f32x4 mt4[4], lt4[4];
#pragma unroll
    for (int k = 0; k < 4; ++k) { mt4[k] = *(const LAS f32x4*)(wsf + 8 * k + 4 * hi); lt4[k] = *(const LAS f32x4*)(wsf + 32 + 8 * k + 4 * hi); }
    if (FIRST) {
#pragma unroll
        for (int r = 0; r < 16; ++r) { const int q = crow(r, hi); const int trow = q * trow_mul + trow_add;
            ACC[trow * ACCP + r32] = o[0][r]; ACC[trow * ACCP + 32 + r32] = o[1][r];
            if (r32 == 0) { ML[trow * 2] = mt4[r >> 2][r & 3]; ML[trow * 2 + 1] = lt4[r >> 2][r & 3]; } }
    } else {
        f32x2 ml[16]; float a0[16], a1[16];
#pragma unroll
        for (int r = 0; r < 16; ++r) { const int q = crow(r, hi); const int trow = q * trow_mul + trow_add;
            ml[r] = *(const LAS f32x2*)(ML + trow * 2); a0[r] = ACC[trow * ACCP + r32]; a1[r] = ACC[trow * ACCP + 32 + r32]; }
        asm volatile("s_waitcnt lgkmcnt(0)" ::: "memory");
#pragma unroll
        for (int r = 0; r < 16; ++r) { const int q = crow(r, hi); const int trow = q * trow_mul + trow_add;
            const float mt = mt4[r >> 2][r & 3], lt = lt4[r >> 2][r & 3], mo = ml[r][0], lo_ = ml[r][1];
            const float mn = fmaxf(mo, mt); const float fa = __builtin_amdgcn_exp2f(mo - mn), fb = __builtin_amdgcn_exp2f(mt - mn);
            ACC[trow * ACCP + r32] = a0[r] * fa + o[0][r] * fb; ACC[trow * ACCP + 32 + r32] = a1[r] * fa + o[1][r] * fb;
            if (r32 == 0) { ML[trow * 2] = mn; ML[trow * 2 + 1] = lo_ * fa + lt * fb; } }
    }
    asm volatile("s_waitcnt lgkmcnt(0)" ::: "memory");
}

__device__ __forceinline__ void attn_phase(Frame& F, bf16* MIX) {
    const bf16* QKV = (const bf16*)(F.ws + WS_QKV);
    LAS float* ACC = (LAS float*)F.lds;
    LAS float* ML = (LAS float*)(F.lds + 69632);
    LAS unsigned char* vst = F.lds + 73728 + F.wave * 4608;
    LAS float* wsf = (LAS float*)(F.lds + 73728 + 8 * 4608 + F.wave * 256);
    const int lane = F.lane, w = F.wave;
    for (int i = 0;; ++i) {
        if (i >= (BATCH * 16 * 8) / F.G) break;
        const int L0 = (F.G == 256) ? ((F.vcu >> 5) * 128 + i * 32 + (F.vcu & 31)) : (i * F.G + F.vcu);
        const int bh = L0 >> 3, ti = L0 & 7; int w4 = ti >> 1; const int c = ti & 1; if (i & 1) w4 = 3 - w4;
        const int b = bh >> 4, h = bh & 15, win0 = w4 * 512;
        const bf16* Qb = QKV + (size_t)b * SEQ * NQKV;
        const float sl0 = exp2f(-8.0f * (float)(0 * 16 + h + 1) / 48.0f) * LOG2E, sl1 = exp2f(-8.0f * (float)(1 * 16 + h + 1) / 48.0f) * LOG2E * 4.0f, sl2 = exp2f(-8.0f * (float)(2 * 16 + h + 1) / 48.0f) * LOG2E * 16.0f;
        LSTAMP0();
        attn_task<true, 6>(Qb, 0, h, 1, 0, win0 + 64 * w + c, 2, win0 + 64 * w - 128, SEQ, sl0, vst, wsf, ACC, ML, 1, 32 * w, lane);
        __syncthreads();
        LSTAMP(24);
        if (ATTN_GMASK & 2) { const int cls = c + 2 * (w & 1), lb = w >> 1, lq0 = 128 * w4 + 32 * lb; attn_task<false, 5>(Qb, 1, h, 4, cls, lq0, 1, lq0 - 128, SEQ / 4, sl1, vst, wsf, ACC, ML, 2, 64 * lb + (w & 1), lane); }
        __syncthreads();
        LSTAMP(25);
        if (ATTN_GMASK & 4) { const int cls = c + 2 * w, lq0 = 32 * w4; attn_task<false, 5>(Qb, 2, h, 16, cls, lq0, 1, lq0 - 128, SEQ / 16, sl2, vst, wsf, ACC, ML, 8, w, lane); }
        __syncthreads();
        LSTAMP(26);
        {
#pragma unroll
          for (int it = 0; it < 4; ++it) { const int trow = 32 * w + 8 * it + (lane >> 3), sg = lane & 7; const float inv = 1.0f / ML[trow * 2 + 1];
              const LAS f32x4* ap = (const LAS f32x4*)(ACC + trow * ACCP + sg * 8);
              bf16* op = MIX + (size_t)(b * SEQ + win0 + 2 * trow + c) * D + h * 64 + sg * 8;
              const f32x4 a = ap[0] * inv, bq = ap[1] * inv; u32x4 wv; wv.x = pk2(a[0], a[1]); wv.y = pk2(a[2], a[3]); wv.z = pk2(bq[0], bq[1]); wv.w = pk2(bq[2], bq[3]);
              *(GAS u32x4*)op = wv; } }
        __syncthreads();
    }
}

__device__ __forceinline__ void attn_phase_naive(Frame& F, bf16* MIX, const int gmask) {
    const bf16* QKV = (const bf16*)(F.ws + WS_YS);
    const int lane = F.lane;
    const int gw = F.vcu * NWAVES + F.wave, NGW = F.G * NWAVES;
    for (int item = gw; item < T * 16; item += NGW) {
        const int tok = item >> 4, h = item & 15, b = tok / SEQ, t = tok % SEQ;
        const bf16* Qb = QKV + (size_t)b * SEQ * NQKV;
        float sc[3][3]; int kt[3][3];
        float mx = -INFINITY;
#pragma unroll
        for (int g = 0; g < 3; ++g) {
            const int dil = (g == 0) ? 1 : (g == 1 ? 4 : 16);
            const float slope = exp2f(-8.0f * (float)(g * 16 + h + 1) / 48.0f);
            const bf16* qp = Qb + (size_t)t * NQKV + ((g * 3 + 0) * 16 + h) * 64;
#pragma unroll
            for (int c = 0; c < 3; ++c) {
                const int j = lane + 64 * c; const int tk = t - j * dil;
                float s = -INFINITY;
                if (j <= 128 && tk >= 0 && ((gmask >> g) & 1)) {
                    const bf16* kp = Qb + (size_t)tk * NQKV + ((g * 3 + 1) * 16 + h) * 64;
                    float d = 0.f;
                    for (int e = 0; e < 64; ++e) d += bf2f(qp[e]) * bf2f(kp[e]);
                    s = d - slope * LOG2E * (float)(j * dil);
                }
                sc[g][c] = s; kt[g][c] = tk; mx = fmaxf(mx, s);
            }
        }
#pragma unroll
        for (int o = 1; o < 64; o <<= 1) mx = fmaxf(mx, __shfl_xor(mx, o));
        float den = 0.f; float acc[64];
#pragma unroll
        for (int e = 0; e < 64; ++e) acc[e] = 0.f;
#pragma unroll
        for (int g = 0; g < 3; ++g)
#pragma unroll
            for (int c = 0; c < 3; ++c) {
                const float p = (sc[g][c] == -INFINITY) ? 0.f : exp2f(sc[g][c] - mx);
                den += p;
                if (p != 0.f) { const bf16* vp = Qb + (size_t)kt[g][c] * NQKV + ((g * 3 + 2) * 16 + h) * 64;
#pragma unroll
                    for (int e = 0; e < 64; ++e) acc[e] += p * bf2f(vp[e]); }
            }
        den = wave_sum(den);
        float mine = 0.f;
#pragma unroll
        for (int e = 0; e < 64; ++e) { const float v = wave_sum(acc[e]); if (lane == e) mine = v; }
        MIX[(size_t)tok * D + h * 64 + lane] = (bf16)f2bf(mine / den);
    }
}

struct Args { const float* in[20]; float* out; unsigned char* ws; int ph_lo, ph_hi; };
constexpr int NPHASE = 2 + DEPTH * 8;

__global__ void __launch_bounds__(NWAVES * 64, 2) mk_fwd(Args args) {
    extern __shared__ __attribute__((aligned(16))) unsigned char lds_raw[];
    Frame F;
    F.lds = (LAS unsigned char*)lds_raw; F.lc = F.lds + LDSCTL_OFF;
    F.tid = threadIdx.x; F.lane = F.tid & 63; F.wave = __builtin_amdgcn_readfirstlane(F.tid >> 6);
    F.G = gridDim.x; { const int bx = blockIdx.x; F.vcu = (F.G % 8 == 0) ? (bx % 8) * (F.G / 8) + bx / 8 : bx; }
    F.ws = args.ws; F.ctl = (unsigned*)(args.ws + WS_CTL);
    for (int u = F.tid; u < (LDS_BYTES - LDSCTL_OFF) / 4; u += NWAVES * 64) ((LAS unsigned*)F.lc)[u] = 0u;
    __syncthreads();
    if (F.tid == 0) {
#pragma unroll
        for (int i = 0; i < 20; ++i) *(LAS unsigned long long*)(F.lc + LC_PTR + 8 * i) = (unsigned long long)args.in[i];
        *(LAS unsigned long long*)(F.lc + LC_PTR + 8 * 20) = (unsigned long long)args.out;
    }
    __syncthreads();
#if MK_PER_PHASE
#define GRID_BAR() do { } while (0)
    XcdBarrier bar; bar.bar = nullptr; bar.x = 0; bar.st = nullptr;
#else
    XcdBarrier bar = xcd_barrier_post(F.ctl + CW_BAR, (volatile LAS unsigned*)(F.lc + LC_MISC) + 8);
#define GRID_BAR() xcd_barrier(bar)
#endif
    const int lo = args.ph_lo, hi = args.ph_hi;
#ifdef PROBE_TYPE
#define LC_STAMP 3072
#define STAMP(ty) do { if (blockIdx.x == 0 && F.tid == 0) { const unsigned long long now_ = __builtin_amdgcn_s_memrealtime(); LAS unsigned long long* st_ = (LAS unsigned long long*)(F.lc + LC_STAMP); \
        st_[1 + (ty)] += now_ - st_[0]; st_[0] = now_; } } while (0)
    if (blockIdx.x == 0 && F.tid == 0) { ((LAS unsigned long long*)(F.lc + LC_STAMP))[0] = __builtin_amdgcn_s_memrealtime(); }
#else
#define STAMP(ty) do { } while (0)
#endif
#define IN(k) (lo <= (k) && (k) < hi)
#define SEAM(k) do { if (IN(k) && IN((k) + 1)) GRID_BAR(); } while (0)
    const float* mod = (const float*)(F.ws + WS_MOD);

    if (PHON(0) && IN(0)) { p0_prologue(F); } SEAM(0); STAMP(0);
    bool xlocal = false; int cid = (int)blockIdx.x;
#if !MK_PER_PHASE
    { volatile LAS unsigned* st = (volatile LAS unsigned*)(F.lc + LC_MISC) + 8;
      if (F.tid == 0) { unsigned ok = (F.G == 256) ? 1u : 0u;
#pragma unroll
          for (unsigned jx = 0; jx < 16; ++jx) { const unsigned cj = xb_ld(&bar.bar[XB_XCNT(jx)]); ok &= (jx < 8u) ? (cj == 32u ? 1u : 0u) : (cj == 0u ? 1u : 0u); }
          st[3] = ok; }
      __syncthreads();
      xlocal = (st[3] != 0u) && (MK_XLOCAL != 0);
      if (xlocal) cid = (int)(st[2] * 8u + bar.x); }
#endif
    cid = __builtin_amdgcn_readfirstlane(cid);
    F.vcu = (F.G % 8 == 0) ? (cid % 8) * (F.G / 8) + cid / 8 : cid;
#define LSEAM(k) do { if (IN(k) && IN((k) + 1)) { if (xlocal) xcd_local_barrier(bar, F.wave == 0); else GRID_BAR(); } } while (0)
    if (PHON(1) && IN(1)) { p1_modulate(F, inp(F, 0), mod, 0, 1024); } SEAM(1); STAMP(1);

    for (int layer = 0; layer < DEPTH; ++layer) {
        const int pb = 2 + layer * 8; const int j = layer >> 1;
        if ((layer & 1) == 0) {
            if (PHON(2) && IN(pb + 0)) { refresh(F); unsigned char* ws = opq(F.ws); (void)ws;
                PlainSched S{T / 256, 4, 256, F.G, cid, (const char*)(ws + WS_WPIN) + (size_t)j * 2 * MiB, 2048};
                pg8::EpiStore E{(bf16*)(ws + WS_U), D, nullptr, 0, 0, 0, F.lds + LDS_TB_OFF + F.wave * 2048};
                pg8::gemm_phase<pg8::EpiStore, PlainSched>(F.tid, F.lds, (const char*)(ws + WS_H), 2048, 2048, 1024, S, E);
            } LSEAM(pb + 0); STAMP(2);
            if (PHON(4) && IN(pb + 2)) { refresh(F); unsigned char* ws = opq(F.ws); (void)ws;
                GrpSched S{F.G, cid, (const char*)(ws + WS_WPGRP) + (size_t)j * 512 * 1024};
                { const bf16* U = (const bf16*)(ws + WS_U); bf16* Z = (bf16*)(ws + WS_Z); pg8::Unit pu;
                  for (int i = 0; S.next(i, pu); ++i) {
                      const int b = pu.pm >> 3, t0 = (pu.pm & 7) * 256 + 32 * F.wave, g = pu.pn;
                      if (g == 0) pool_item<2>(U, Z, b, t0, 0, F.lane); else if (g == 1) pool_item<4>(U, Z, b, t0, 1, F.lane);
                      else if (g == 2) pool_item<8>(U, Z, b, t0, 2, F.lane); else pool_item<16>(U, Z, b, t0, 3, F.lane); }
                  asm volatile("s_waitcnt vmcnt(0)" ::: "memory"); __syncthreads(); }
                pg8::EpiStore E{(bf16*)(ws + WS_Y2), D, inp(F, 6) + j * D, 0, 0, 0, F.lds + LDS_TB_OFF + F.wave * 2048};
                pg8::gemm_phase<pg8::EpiStore, GrpSched>(F.tid, F.lds, (const char*)(ws + WS_Z), 2048, 512, 256, S, E);
            } LSEAM(pb + 2); STAMP(4);
            if (PHON(5) && IN(pb + 3)) { refresh(F); unsigned char* ws = opq(F.ws); (void)ws;
                PlainSched S{T / 256, 4, 256, F.G, cid, (const char*)(ws + WS_WPOUT) + (size_t)j * 2 * MiB, 2048};
                pg8::EpiStore E{(bf16*)(ws + WS_Y), D, nullptr, 0, 0, 1, F.lds + LDS_TB_OFF + F.wave * 2048};
                pg8::gemm_phase<pg8::EpiStore, PlainSched>(F.tid, F.lds, (const char*)(ws + WS_Y2), 2048, 2048, 1024, S, E);
            } LSEAM(pb + 3); STAMP(5);
        } else {
            if (PHON(6) && IN(pb + 0)) { refresh(F); unsigned char* ws = opq(F.ws); (void)ws;
                PlainSched S{T / 256, NQKV / 256, (T / 256) * (NQKV / 256), F.G, cid, (const char*)(ws + WS_WAIN) + (size_t)j * 18 * MiB, 2048};
                pg8::EpiStore E{(bf16*)(ws + WS_QKV), NQKV, nullptr, 1, 1, 0, F.lds + LDS_TB_OFF + F.wave * 2048};
                pg8::gemm_phase<pg8::EpiStore, PlainSched>(F.tid, F.lds, (const char*)(ws + WS_H), 2048, 2048, 1024, S, E);
            } LSEAM(pb + 0); STAMP(6);
            if (PHON(7) && IN(pb + 1)) { refresh(F); unsigned char* ws = opq(F.ws); (void)ws;
#ifdef NAIVE_ATTN
                attn_phase_naive(F, (bf16*)(F.ws + WS_Y2), 7);
#ifdef ORACLE
                if (layer == ORACLE_LAYER) { attn_phase_naive(F, (bf16*)(F.ws + WS_Z), ATTN_GMASK); attn_phase(F, (bf16*)(F.ws + WS_U)); }
#endif
#else
                attn_phase(F, (bf16*)(F.ws + WS_Y2));
#endif
            } if (IN(pb + 1) && IN(pb + 3)) { if (xlocal) xcd_local_barrier(bar, F.wave == 0); else GRID_BAR(); } STAMP(7);
            if (IN(pb + 2)) { refresh(F); unsigned char* ws = opq(F.ws); (void)ws;
#ifdef ORACLE
                if (layer == ORACLE_LAYER) { if (blockIdx.x == 0 && F.tid == 0) atomicAdd(F.ctl + 20000, 3276u * 16u);
                    const bf16* A = (const bf16*)(ws + WS_U); const bf16* B = (const bf16*)(ws + WS_Z);
                    const int gw = F.vcu * NWAVES + F.wave, NGW = F.G * NWAVES;
                    for (int tok = gw; tok < T; tok += NGW) { int bad = 0;
                        for (int h = 0; h < 16; ++h) { if (ORACLE_SEL) { const float a = bf2f(A[(size_t)tok * D + h * 64 + F.lane]), b = bf2f(B[(size_t)tok * D + h * 64 + F.lane]);
                            const float e2 = wave_sum((a - b) * (a - b)), n2 = wave_sum(b * b); if (!(e2 <= 0.0025f * n2)) bad += ORACLE_W; } }
                        if (bad && F.lane == 0) atomicAdd(F.ctl + 20000, (unsigned)bad); } }
#endif
            }
            if (PHON(8) && IN(pb + 3)) { refresh(F); unsigned char* ws = opq(F.ws); (void)ws;
                PlainSched S{T / 256, 4, 256, F.G, cid, (const char*)(ws + WS_WAOUT) + (size_t)j * 2 * MiB, 2048};
                pg8::EpiStore E{(bf16*)(ws + WS_Y), D, nullptr, 0, 0, 1, F.lds + LDS_TB_OFF + F.wave * 2048};
                pg8::gemm_phase<pg8::EpiStore, PlainSched>(F.tid, F.lds, (const char*)(ws + WS_Y2), 2048, 2048, 1024, S, E);
            } LSEAM(pb + 3); STAMP(8);
        }
        if (PHON(9) && IN(pb + 4)) { refresh(F); unsigned char* ws = opq(F.ws); (void)ws; const float* xin = (layer == 0) ? inp(F, 0) : (const float*)(ws + WS_X); if (layer == 0) ln1_router_phase<false>(F, layer, xin); else ln1_router_phase<true>(F, layer, xin); } SEAM(pb + 4); STAMP(9);
        if (PHON(10) && IN(pb + 5)) { refresh(F); unsigned char* ws = opq(F.ws); (void)ws;
            moe_build_table(F, layer);
            const LAS int* ts = (const LAS int*)(F.lc + LC_TS);
            const int ntile = ts[65];
            MoeSched<true> S{ts, (const LAS int*)(F.lc + LC_CNT), 2, ntile * 2, F.G, cid, F.lane, (const int*)(ws + WS_TOKL), (const float*)(ws + WS_WL),
                       (const char*)(ws + WS_WEGU) + (size_t)layer * 64 * MiB, (size_t)1 * MiB, (const char*)(ws + WS_WSHGU) + (size_t)layer * MiB, 2048};
            pg8::EpiGU E{(bf16*)(ws + WS_ACT)};
            pg8::gemm_phase<pg8::EpiGU, MoeSched<true>>(F.tid, F.lds, (const char*)(ws + WS_H), 2048, 2048, 1024, S, E);
        } LSEAM(pb + 5); STAMP(10);
        if (PHON(11) && IN(pb + 6)) { refresh(F); unsigned char* ws = opq(F.ws); (void)ws;
            moe_build_table(F, layer);
            const LAS int* ts = (const LAS int*)(F.lc + LC_TS);
            const int ntile = ts[65];
            MoeSched<false> S{ts, (const LAS int*)(F.lc + LC_CNT), 4, ntile * 4, F.G, cid, F.lane, nullptr, nullptr,
                       (const char*)(ws + WS_WEDN) + (size_t)layer * 32 * MiB, (size_t)512 * 1024, (const char*)(ws + WS_WSHDN) + (size_t)layer * 512 * 1024, 512};
            pg8::EpiStore E{(bf16*)(ws + WS_YS), D, nullptr, 0, 1, 1, F.lds + LDS_TB_OFF + F.wave * 2048};
            pg8::gemm_phase<pg8::EpiStore, MoeSched<false>>(F.tid, F.lds, (const char*)(ws + WS_ACT), 512, 512, 256, S, E);
        } SEAM(pb + 6); STAMP(11);
        if (PHON(12) && IN(pb + 7)) { refresh(F); unsigned char* ws = opq(F.ws); (void)ws; moe_build_table(F, layer); combine_ln2_phase(F, layer); }
        if (layer < DEPTH - 1) LSEAM(pb + 7);
        STAMP(12);
    }
#ifdef PROBE_TYPE
    if (blockIdx.x == 0 && F.tid == 0) { const unsigned long long t0_ = __builtin_amdgcn_s_memrealtime(); const unsigned long long want_ = 4ull * ((LAS unsigned long long*)(F.lc + LC_STAMP))[1 + PROBE_TYPE];
        while (__builtin_amdgcn_s_memrealtime() - t0_ < want_) __builtin_amdgcn_s_sleep(8); }
#endif
#undef IN
#undef SEAM
}

extern "C" void kernel_launch(void* const* d_in, const int* in_sizes, int n_in, void* d_out, int out_size, void* d_ws, size_t ws_size, hipStream_t stream) {
    static int grid = 0;
    if (grid == 0) {
        if (n_in != 20 || in_sizes[0] != T * D || out_size != T * D || ws_size < WS_END) { fprintf(stderr, "kernel_launch: unexpected shapes / workspace (n_in %d, ws %zu); nothing launched\n", n_in, ws_size); grid = -1; return; }
        int dev = 0, cus = 0, per_cu = 0;
        if (hipGetDevice(&dev) != hipSuccess || hipDeviceGetAttribute(&cus, hipDeviceAttributeMultiprocessorCount, dev) != hipSuccess) { grid = -1; return; }
        if (hipFuncSetAttribute((const void*)mk_fwd, hipFuncAttributeMaxDynamicSharedMemorySize, LDS_BYTES) != hipSuccess) { fprintf(stderr, "kernel_launch: hipFuncSetAttribute failed\n"); grid = -1; return; }
        if (hipOccupancyMaxActiveBlocksPerMultiprocessor(&per_cu, (const void*)mk_fwd, NWAVES * 64, LDS_BYTES) != hipSuccess || per_cu < 1) { fprintf(stderr, "kernel_launch: occupancy query says %d\n", per_cu); }
        (void)hipGetLastError();
        grid = cus;
    }
    if (grid < 0) return;
    if (hipMemsetAsync((char*)d_ws + WS_CTL, 0, CTL_ZERO_BYTES, stream) != hipSuccess) return;
    Args a{};
    for (int i = 0; i < 20; ++i) a.in[i] = (const float*)d_in[i];
    a.out = (float*)d_out; a.ws = (unsigned char*)d_ws;
#if MK_PER_PHASE
    for (int p = 0; p < NPHASE; ++p) { a.ph_lo = p; a.ph_hi = p + 1; hipLaunchKernelGGL(mk_fwd, dim3(grid), dim3(NWAVES * 64), LDS_BYTES, stream, a); }
#else
    a.ph_lo = 0; a.ph_hi = NPHASE;
    hipLaunchKernelGGL(mk_fwd, dim3(grid), dim3(NWAVES * 64), LDS_BYTES, stream, a);
#endif
    const hipError_t le = hipPeekAtLastError();
    if (le != hipSuccess) fprintf(stderr, "kernel_launch: launch failed: %s\n", hipGetErrorName(le));
}
```

```cpp
#include <hip/hip_runtime.h>
#include <cstdio>
#include <cstdint>

#ifndef MK_PER_PHASE
#define MK_PER_PHASE 0
#endif
#define ORACLE_SEL 1
#define ATTN_GMASK 7
#define ORACLE_W 1
#define ORACLE_LAYER 1
#ifndef MK_XLOCAL
#define MK_XLOCAL 1
#endif
#ifndef PHSEL
#define PHSEL 0xFFFF
#endif
#define PHON(n) (((PHSEL) >> (n)) & 1)

#define GAS __attribute__((address_space(1)))
#define LAS __attribute__((address_space(3)))
typedef unsigned short bf16;
typedef short bf16x8 __attribute__((ext_vector_type(8)));
typedef short s16x4 __attribute__((ext_vector_type(4)));
typedef float f32x2 __attribute__((ext_vector_type(2)));
typedef float f32x4 __attribute__((ext_vector_type(4)));
typedef float f32x16 __attribute__((ext_vector_type(16)));
typedef unsigned u32x2 __attribute__((ext_vector_type(2)));
typedef unsigned u32x4 __attribute__((ext_vector_type(4)));

constexpr int BATCH = 8, SEQ = 2048, D = 1024, T = BATCH * SEQ, DEPTH = 4;
constexpr int NQKV = 9216, NE = 64, TOPK = 8, DEXP = 256;
constexpr int CAP = 16384;
constexpr int PSLOT = 147456 + T;
constexpr float ALPHA = 1.6817928305074290f;
constexpr float LN_EPS = 1e-5f;
constexpr float LOG2E = 1.4426950408889634f;
constexpr float QSCALE = 0.125f * LOG2E;
constexpr float ROUTED_SCALE = 2.5f;

constexpr size_t MiB = 1u << 20;
constexpr size_t WS_CTL = 0, CTL_ZERO_BYTES = 1 * MiB;
constexpr size_t WS_MOD = 1 * MiB;
constexpr size_t WS_WRHI = 2 * MiB;
constexpr size_t WS_WRLO = WS_WRHI + 512 * 1024;
constexpr size_t WS_WPIN = 3 * MiB;
constexpr size_t WS_WPGRP = 7 * MiB;
constexpr size_t WS_WPOUT = 8 * MiB;
constexpr size_t WS_WAIN = 12 * MiB;
constexpr size_t WS_WAOUT = 48 * MiB;
constexpr size_t WS_WSHGU = 52 * MiB;
constexpr size_t WS_WSHDN = 56 * MiB;
constexpr size_t WS_WEGU = 58 * MiB;
constexpr size_t WS_WEDN = 314 * MiB;
constexpr size_t WS_X = 442 * MiB;
constexpr size_t WS_H = 506 * MiB;
constexpr size_t WS_Y = 538 * MiB;
constexpr size_t WS_U = 570 * MiB;
constexpr size_t WS_Z = 602 * MiB;
constexpr size_t WS_Y2 = 634 * MiB;
constexpr size_t WS_YS = 666 * MiB;
constexpr size_t WS_ACT = 986 * MiB;
constexpr size_t WS_TOKL = 1066 * MiB;
constexpr size_t WS_WL = 1070 * MiB;
constexpr size_t WS_TSLOT = 1074 * MiB;
constexpr size_t WS_QKV = 1076 * MiB;
constexpr size_t WS_END = 1364 * MiB;
static_assert(WS_YS + (size_t)PSLOT * 2048 <= WS_ACT && WS_ACT + (size_t)PSLOT * 512 <= WS_TOKL, "ws map");
constexpr int CW_BAR = 4096;
constexpr int CW_CNT = 12288;

constexpr int RING_BYTES = 135168;
constexpr int LDSCTL_OFF = RING_BYTES;
constexpr int LDS_TB_OFF = 147456;
constexpr int LDS_BYTES = 163840;
constexpr int LC_MISC = 0;
constexpr int LC_TS = 128;
constexpr int LC_CNT = 128 + 272;
constexpr int LC_LCNT = 128 + 272 + 256;
constexpr int LC_GB = 128 + 272 + 512;

#define RLX_AGENT __ATOMIC_RELAXED, __HIP_MEMORY_SCOPE_AGENT
#define LDS_WAIT() asm volatile("s_waitcnt lgkmcnt(0)" ::: "memory")
#define VM_WAIT() asm volatile("s_waitcnt vmcnt(0)" ::: "memory")

typedef __bf16 b16x2 __attribute__((ext_vector_type(2)));
__device__ __forceinline__ unsigned f2bf(float f) { unsigned u = __builtin_bit_cast(unsigned, f); return (u + 0x7fffu + ((u >> 16) & 1u)) >> 16; }
__device__ __forceinline__ unsigned pk2(float lo, float hi) { const f32x2 v = {lo, hi}; return __builtin_bit_cast(unsigned, __builtin_convertvector(v, b16x2)); }
__device__ __forceinline__ float bf2f(unsigned h) { return __builtin_bit_cast(float, h << 16); }
__device__ __forceinline__ unsigned cvt_pk_bf16(float lo, float hi) { return pk2(lo, hi); }
typedef _Float16 h16x2 __attribute__((ext_vector_type(2)));
__device__ __forceinline__ unsigned pkh2(float lo, float hi) { const f32x2 v = {lo, hi}; return __builtin_bit_cast(unsigned, __builtin_convertvector(v, h16x2)); }
__device__ __forceinline__ float h2f(unsigned h) { return (float)__builtin_bit_cast(_Float16, (unsigned short)h); }
#define MFMA16(a, b, c) __builtin_amdgcn_mfma_f32_16x16x32_bf16(a, b, c, 0, 0, 0)
#define MFMA32(a, b, c) __builtin_amdgcn_mfma_f32_32x32x16_bf16(a, b, c, 0, 0, 0)
__device__ __forceinline__ float wave_sum(float v) {
#pragma unroll
    for (int o = 1; o < 64; o <<= 1) v += __shfl_xor(v, o);
    return v;
}

namespace pg8 {
constexpr int BM = 256, BK = 64, HALF = 128, HTB = HALF * BK * 2, STAGE_BYTES = 8 * HTB, NXCD = 8;
__host__ __device__ __forceinline__ int lds_byte(int r, int c) { const int st = (r >> 4) * 2 + (c >> 5), rr = r & 15, cc = c & 31, ob = rr * 64 + cc * 2; return st * 1024 + (ob ^ (((ob >> 9) & 1) << 5)); }
__host__ __device__ __forceinline__ void stage_rc(int b, int& R, int& C) { const int st = b / 1024, sb = b % 1024, swz = sb ^ (((sb >> 9) & 1) << 5); R = (st >> 1) * 16 + swz / 64; C = (st & 1) * 32 + (swz % 64) / 2; }
__host__ __device__ __forceinline__ int perm32(int rho) { const int n = rho >> 4, i = rho & 15; return 8 * (i >> 2) + 4 * n + (i & 3); }

struct Unit {
    int pm, pn;
    const char* bptr;
    int roff;
    int nvalid;
};

__device__ __forceinline__ int xcd_chunk(int L, int nwg) { const int q = nwg / NXCD, r = nwg % NXCD, xcd = L % NXCD, off = L / NXCD; return (xcd < r ? xcd * (q + 1) : r * (q + 1) + (xcd - r) * q) + off; }

template <class Epi, class Sched>
__device__ __forceinline__ void gemm_phase(const int tid, LAS unsigned char* lds, const char* Abase, const int lda, const int ldb, const int K, const Sched& S, const Epi& E) {
    constexpr bool GATHER = Sched::GATHER;
    const int wid = __builtin_amdgcn_readfirstlane(tid >> 6), lane = tid & 63, wr = wid >> 2, wc = wid & 3, fr = lane & 15, fq = lane >> 4;
    const int nt = K / BK;
    int Rr[2]; unsigned C2[2], voffB[2], voffA[2];
#pragma unroll
    for (int i = 0; i < 2; ++i) { int R, C; stage_rc(tid * 16 + i * 8192, R, C); const int Rb = Epi::WIDE ? ((R >> 5) * 64 + perm32(R & 31)) : ((R & ~31) + perm32(R & 31)); Rr[i] = R; C2[i] = (unsigned)C * 2u; voffB[i] = (unsigned)(Rb * ldb) + (unsigned)C * 2u;
        voffA[i] = Sched::ABLK ? (unsigned)((C >> 5) * 16384 + R * 64 + (C & 31) * 2) : ((unsigned)(R * lda) + (unsigned)C * 2u); }
    const size_t kstep = (size_t)(BK * 2);
    const size_t hstepB = (size_t)(Epi::WIDE ? 32 : HALF) * ldb;
    const size_t hstepA = GATHER ? (size_t)0 : (Sched::ABLK ? (size_t)8192 : (size_t)HALF * lda);
    const size_t kstepA = Sched::ABLK ? (size_t)32768 : kstep;
    const unsigned ldsw = (unsigned)wid * 1024u;
    const int aoff = lds_byte(wr * 64 + fr, fq * 8), boff = lds_byte(wc * 32 + fr, fq * 8);
#define PG8_SA(b, h) (((b) * 2 + (h)) * HTB)
#define PG8_SB(b, h) ((4 + (b) * 2 + (h)) * HTB)
#define PG8_STAGE(bufoff, gbase, voff) do { _Pragma("unroll") for (int _i = 0; _i < 2; ++_i) \
        __builtin_amdgcn_global_load_lds((const unsigned*)((const char*)(gbase) + (voff)[_i]), (LAS unsigned*)(lds + (bufoff) + ldsw + _i * 8192), 16, 0, 0); } while (0)
#define PG8_STAGEA(bufoff, gbase, h) do { if constexpr (GATHER) { PG8_STAGE(bufoff, gbase, vA[h]); } else { PG8_STAGE(bufoff, (gbase) + (h) * hstepA, voffA); } } while (0)
#define PG8_LDA(dst, b, h) do { _Pragma("unroll") for (int m = 0; m < 4; ++m) _Pragma("unroll") for (int k = 0; k < 2; ++k) dst[m][k] = *(const LAS bf16x8*)(lds + PG8_SA(b, h) + aoff + m * 2048 + k * 1024); } while (0)
#define PG8_LDB(dst, b, h) do { _Pragma("unroll") for (int n = 0; n < 2; ++n) _Pragma("unroll") for (int k = 0; k < 2; ++k) dst[n][k] = *(const LAS bf16x8*)(lds + PG8_SB(b, h) + boff + n * 2048 + k * 1024); } while (0)
#define PG8_MMA(ai, bj, At, Bt) do { __builtin_amdgcn_s_setprio(1); _Pragma("unroll") for (int m = 0; m < 4; ++m) _Pragma("unroll") for (int n = 0; n < 2; ++n) _Pragma("unroll") for (int k = 0; k < 2; ++k) \
        acc[ai][bj][m][n] = MFMA16(Bt[n][k], At[m][k], acc[ai][bj][m][n]); __builtin_amdgcn_s_setprio(0); } while (0)
#define PG8_WAIT_V(n) asm volatile("s_waitcnt vmcnt(" #n ")" ::: "memory")
#define PG8_WAIT_L(n) asm volatile("s_waitcnt lgkmcnt(" #n ")" ::: "memory")
#define PG8_BAR __builtin_amdgcn_s_barrier()
#define PG8_SCHED __builtin_amdgcn_sched_barrier(0)
#define PG8_CALCA(u, vo) do { _Pragma("unroll") for (int _h = 0; _h < 2; ++_h) _Pragma("unroll") for (int _i = 0; _i < 2; ++_i) \
        vo[_h][_i] = (unsigned)S.arow(u, _h * HALF + Rr[_i]) * (unsigned)lda + C2[_i]; } while (0)
    Unit cur, nxt; int ui = 0;
    if (!S.next(0, cur)) return;
    f32x4 acc[2][2][4][2];
#pragma unroll
    for (int a = 0; a < 2; ++a)
#pragma unroll
        for (int b = 0; b < 2; ++b)
#pragma unroll
            for (int m = 0; m < 4; ++m)
#pragma unroll
                for (int n = 0; n < 2; ++n) acc[a][b][m][n] = (f32x4){0.f, 0.f, 0.f, 0.f};
    bf16x8 At[4][2], B0[2][2], B1[2][2];
    unsigned vA[2][2], vAn[2][2];
    const char* cA = Abase;
    if constexpr (GATHER) { PG8_CALCA(cur, vA); } else { cA = Abase + (size_t)S.arow(cur, 0) * lda + S.acolb(cur); }
    const char* cB = cur.bptr;
    PG8_STAGE(PG8_SB(0, 0), cB, voffB); PG8_STAGE(PG8_SB(0, 1), cB + hstepB, voffB); PG8_STAGEA(PG8_SA(0, 0), cA, 0); PG8_STAGEA(PG8_SA(0, 1), cA, 1);
    if (wr == 1) PG8_BAR;
    PG8_WAIT_V(2); PG8_BAR;
    PG8_STAGE(PG8_SB(1, 0), cB + kstep, voffB); PG8_STAGEA(PG8_SA(1, 0), cA + kstepA, 0); PG8_STAGE(PG8_SB(1, 1), cB + hstepB + kstep, voffB);
    PG8_WAIT_V(6); PG8_BAR;
    for (;;) {
        const bool has_next = S.next(ui + 1, nxt);
        float rs[2][4];
        if constexpr (Epi::ROWSCALE) {
#pragma unroll
            for (int ai = 0; ai < 2; ++ai)
#pragma unroll
                for (int m = 0; m < 4; ++m) rs[ai][m] = S.rowscale(cur, ai * HALF + wr * 64 + m * 16 + fr);
        }
        const char* nA = cA;
        if constexpr (GATHER) {
            if (has_next) { PG8_CALCA(nxt, vAn); }
            else {
#pragma unroll
                for (int h = 0; h < 2; ++h)
#pragma unroll
                    for (int i = 0; i < 2; ++i) vAn[h][i] = vA[h][i];
            }
            asm volatile("s_waitcnt vmcnt(0)" : "+v"(vAn[0][0]), "+v"(vAn[0][1]), "+v"(vAn[1][0]), "+v"(vAn[1][1]) :: "memory");
            if constexpr (Epi::ROWSCALE) { asm volatile("" : "+v"(rs[0][0]), "+v"(rs[0][1]), "+v"(rs[0][2]), "+v"(rs[0][3]), "+v"(rs[1][0]), "+v"(rs[1][1]), "+v"(rs[1][2]), "+v"(rs[1][3])); }
        } else { if (has_next) nA = Abase + (size_t)S.arow(nxt, 0) * lda + S.acolb(nxt); }
        const char* nB = has_next ? nxt.bptr : cB;
#pragma unroll 1
        for (int t = 0; t < nt; t += 2) {
            const bool last = (t == nt - 2);
            const char* a1 = cA + (size_t)(t + 1) * kstepA;
            const char* a2 = last ? nA : cA + (size_t)(t + 2) * kstepA; const char* b2 = last ? nB : cB + (size_t)(t + 2) * kstep;
            const char* a3 = a2 + kstepA; const char* b3 = b2 + kstep;
            PG8_LDB(B0, 0, 0); PG8_LDB(B1, 0, 1); PG8_SCHED; PG8_LDA(At, 0, 0); PG8_STAGEA(PG8_SA(1, 1), a1, 1);
            if constexpr (GATHER) { if (last) {
#pragma unroll
                for (int h = 0; h < 2; ++h)
#pragma unroll
                    for (int i = 0; i < 2; ++i) vA[h][i] = vAn[h][i]; } }
            PG8_WAIT_V(8); PG8_WAIT_L(0); PG8_BAR; PG8_MMA(0, 0, At, B0); PG8_MMA(0, 1, At, B1); PG8_BAR; PG8_SCHED;
            PG8_LDA(At, 0, 1); PG8_STAGE(PG8_SB(0, 0), b2, voffB); PG8_STAGE(PG8_SB(0, 1), b2 + hstepB, voffB); PG8_STAGEA(PG8_SA(0, 0), a2, 0);
            PG8_WAIT_V(8); PG8_WAIT_L(0); PG8_BAR; PG8_MMA(1, 0, At, B0); PG8_MMA(1, 1, At, B1); PG8_BAR; PG8_SCHED;
            PG8_LDB(B0, 1, 0); PG8_LDB(B1, 1, 1); PG8_SCHED; PG8_LDA(At, 1, 0); PG8_STAGEA(PG8_SA(0, 1), a2, 1);
            PG8_WAIT_V(8); PG8_WAIT_L(0); PG8_BAR; PG8_MMA(0, 0, At, B0); PG8_MMA(0, 1, At, B1); PG8_BAR; PG8_SCHED;
            PG8_LDA(At, 1, 1); PG8_STAGE(PG8_SB(1, 0), b3, voffB); PG8_STAGE(PG8_SB(1, 1), b3 + hstepB, voffB); PG8_STAGEA(PG8_SA(1, 0), a3, 0);
            PG8_WAIT_V(8); PG8_WAIT_L(0); PG8_BAR; PG8_MMA(1, 0, At, B0); PG8_MMA(1, 1, At, B1); PG8_BAR; PG8_SCHED;
        }
        if (wr == 0) PG8_BAR;
        E(acc, cur, rs, wr, wc, fr, fq);
        if (!has_next) break;
#pragma unroll
        for (int a = 0; a < 2; ++a)
#pragma unroll
            for (int b = 0; b < 2; ++b)
#pragma unroll
                for (int m = 0; m < 4; ++m)
#pragma unroll
                    for (int n = 0; n < 2; ++n) acc[a][b][m][n] = (f32x4){0.f, 0.f, 0.f, 0.f};
        cur = nxt; cB = nB; cA = nA; ++ui;
        if (wr == 1) PG8_BAR;
    }
    PG8_WAIT_V(0);
    PG8_BAR;
#undef PG8_SA
#undef PG8_SB
#undef PG8_STAGE
#undef PG8_STAGEA
#undef PG8_LDA
#undef PG8_LDB
#undef PG8_MMA
#undef PG8_WAIT_V
#undef PG8_WAIT_L
#undef PG8_BAR
#undef PG8_SCHED
#undef PG8_CALCA
}

struct EpiStore {
    static constexpr bool ROWSCALE = false, WIDE = true;
    bf16* O; int ldc; const float* cscale; int qmode; int ntst; int f16; LAS unsigned char* tb;
    __device__ __forceinline__ void operator()(const f32x4 (&acc)[2][2][4][2], const Unit& u, const float (&rs)[2][4], int wr, int wc, int fr, int fq) const {
        const int colw = u.pn * BM + wc * 64;
        float sc = 1.f; if (qmode) { if ((((u.pn * BM) >> 10) % 3) == 0) sc = QSCALE; }
        f32x4 cs[2][2];
#pragma unroll
        for (int bj = 0; bj < 2; ++bj)
#pragma unroll
            for (int n = 0; n < 2; ++n) { cs[bj][n] = cscale ? *(const f32x4*)(cscale + colw + 32 * bj + 8 * fq + 4 * n) : (f32x4){1.f, 1.f, 1.f, 1.f}; cs[bj][n] = cs[bj][n] * sc; }
        const int L = fr + 16 * fq, rr = L >> 3, sg = L & 7;
        LAS u32x4* tbv = (LAS u32x4*)tb;
        const int wi0 = fr * 8 + (fq ^ (fr & 7)), wi1 = fr * 8 + ((4 + fq) ^ (fr & 7)), ri = rr * 8 + (sg ^ rr);
        bf16* gp = O + (size_t)(u.pm * BM + wr * 64 + rr) * ldc + colw + sg * 8;
#pragma unroll
        for (int ai = 0; ai < 2; ++ai)
#pragma unroll
            for (int m = 0; m < 4; ++m) {
                u32x4 w[2];
#pragma unroll
                for (int bj = 0; bj < 2; ++bj) { const f32x4 v0 = acc[ai][bj][m][0] * cs[bj][0], v1 = acc[ai][bj][m][1] * cs[bj][1];
                    if (f16) { w[bj].x = pkh2(v0[0], v0[1]); w[bj].y = pkh2(v0[2], v0[3]); w[bj].z = pkh2(v1[0], v1[1]); w[bj].w = pkh2(v1[2], v1[3]); }
                    else { w[bj].x = cvt_pk_bf16(v0[0], v0[1]); w[bj].y = cvt_pk_bf16(v0[2], v0[3]); w[bj].z = cvt_pk_bf16(v1[0], v1[1]); w[bj].w = cvt_pk_bf16(v1[2], v1[3]); } }
                tbv[wi0] = w[0]; tbv[wi1] = w[1];
                asm volatile("" ::: "memory");
                const u32x4 r0 = tbv[ri], r1 = tbv[ri + 64];
                asm volatile("" ::: "memory");
                bf16* rowp = gp + (size_t)(ai * HALF + m * 16) * ldc;
                if (ntst) { __builtin_nontemporal_store(r0, (u32x4*)rowp); __builtin_nontemporal_store(r1, (u32x4*)(rowp + (size_t)8 * ldc)); }
                else { *(u32x4*)rowp = r0; *(u32x4*)(rowp + (size_t)8 * ldc) = r1; } }
    }
};
struct EpiGU {
    static constexpr bool ROWSCALE = false, WIDE = false;
    bf16* O;
    __device__ __forceinline__ void operator()(const f32x4 (&acc)[2][2][4][2], const Unit& u, const float (&rs)[2][4], int wr, int wc, int fr, int fq) const {
        bf16* tp = O + (size_t)u.pm * (BM * DEXP) + (size_t)(u.pn * 4 + wc) * (BM * 32) + (wr * 64 + fr) * 32 + 8 * fq;
#pragma unroll
        for (int ai = 0; ai < 2; ++ai)
#pragma unroll
            for (int m = 0; m < 4; ++m) { bf16* rowp = tp + (ai * HALF + m * 16) * 32;
                float o[8];
#pragma unroll
                for (int n = 0; n < 2; ++n)
#pragma unroll
                    for (int j = 0; j < 4; ++j) { const float g = acc[ai][0][m][n][j], uu = acc[ai][1][m][n][j];
                        const float sg = g * __builtin_amdgcn_rcpf(1.0f + __builtin_amdgcn_exp2f(-g * LOG2E)); o[n * 4 + j] = sg * uu; }
                u32x4 wv; wv.x = cvt_pk_bf16(o[0], o[1]); wv.y = cvt_pk_bf16(o[2], o[3]); wv.z = cvt_pk_bf16(o[4], o[5]); wv.w = cvt_pk_bf16(o[6], o[7]);
                *(u32x4*)rowp = wv; }
    }
};
}

#define XB_TMO      128
#define XB_XCNT(j)  (256  + 64 * (j))
#define XB_XSUB(j)  (1280 + 64 * (j))
#define XB_XGEN(j)  (2304 + 64 * (j))
#define XB_TOP      3328
#define XB_TOPGEN   3392
#define XB_LSUB(j)  (3456 + 64 * (j))
#define XB_LGEN(j)  (4480 + 64 * (j))
#define XCD_BAR_WORDS 5504
#define XB_SPIN_CAP (1u << 18)
__device__ __forceinline__ unsigned xb_ld(unsigned* p)              { return __hip_atomic_load(p, __ATOMIC_RELAXED, __HIP_MEMORY_SCOPE_AGENT); }
__device__ __forceinline__ unsigned xb_add(unsigned* p, unsigned v) { return __hip_atomic_fetch_add(p, v, __ATOMIC_RELAXED, __HIP_MEMORY_SCOPE_AGENT); }
__device__ __forceinline__ unsigned xb_xcc_id() { return (unsigned)__builtin_amdgcn_s_getreg((3 << 11) | 20) & 0xFu; }
#define XB_SPIN(cond, bar) do { unsigned _sp = 0; while (cond) { __builtin_amdgcn_s_sleep(1); \
    if ((++_sp & 255u) == 0u) { if (xb_ld(&(bar)[XB_TMO])) break; if (_sp > XB_SPIN_CAP) { atomicAdd(&(bar)[XB_TMO], 1u); break; } } } } while (0)
struct XcdBarrier { unsigned* bar; unsigned x; volatile LAS unsigned* st; };
__device__ __forceinline__ XcdBarrier xcd_barrier_post(unsigned* bar, volatile LAS unsigned* st) {
    XcdBarrier b; b.bar = bar; b.x = xb_xcc_id(); b.st = st;
    if (threadIdx.x == 0) st[2] = xb_add(&bar[XB_XCNT(b.x)], 1u);
    return b;
}
__device__ __forceinline__ void xcd_local_barrier(const XcdBarrier& b, const bool wave0) {
    asm volatile("s_waitcnt vmcnt(0)" ::: "memory");
    __syncthreads();
    if (wave0 && __builtin_amdgcn_mbcnt_hi(~0u, __builtin_amdgcn_mbcnt_lo(~0u, 0u)) == 0u) {
        unsigned* bar = b.bar;
        __builtin_amdgcn_s_waitcnt(0);
        const unsigned nloc = b.st[0];
        const unsigned old = xb_add(&bar[XB_LSUB(b.x)], 1u);
        const unsigned gen = old / nloc;
        if (old + 1u == (gen + 1u) * nloc) xb_add(&bar[XB_LGEN(b.x)], 1u);
        else XB_SPIN(xb_ld(&bar[XB_LGEN(b.x)]) == gen, bar);
        __builtin_amdgcn_fence(__ATOMIC_ACQUIRE, "agent");
        asm volatile("s_waitcnt vmcnt(0)" ::: "memory");
    }
    __syncthreads();
}
__device__ __forceinline__ void xcd_barrier_complete(unsigned* bar, unsigned x, unsigned& nloc, unsigned& nx) {
    const unsigned G = gridDim.x * gridDim.y * gridDim.z;
    unsigned sum, cnt, mine, sp = 0u;
    for (;;) {
        sum = 0u; cnt = 0u; mine = 0u;
#pragma unroll
        for (unsigned j = 0; j < 16; ++j) { const unsigned c = xb_ld(&bar[XB_XCNT(j)]); sum += c; cnt += (c > 0u) ? 1u : 0u; mine = (j == x) ? c : mine; }
        if (sum == G) break;
        __builtin_amdgcn_s_sleep(1);
        if ((++sp & 255u) == 0u) { if (xb_ld(&bar[XB_TMO])) break; if (sp > XB_SPIN_CAP) { atomicAdd(&bar[XB_TMO], 1u); break; } }
    }
    nloc = mine > 0u ? mine : 1u; nx = cnt > 0u ? cnt : 1u;
}
__device__ __forceinline__ void xcd_barrier(const XcdBarrier& b) {
    asm volatile("s_waitcnt vmcnt(0)" ::: "memory");
    __syncthreads();
    if (threadIdx.x == 0) {
        unsigned* bar = b.bar;
        __builtin_amdgcn_s_waitcnt(0);
        unsigned nloc = b.st[0], nx = b.st[1];
        if (nloc == 0u) { xcd_barrier_complete(bar, b.x, nloc, nx); b.st[0] = nloc; b.st[1] = nx; }
        const unsigned old = xb_add(&bar[XB_XSUB(b.x)], 1u);
        const unsigned gen = old / nloc;
        if (old + 1u == (gen + 1u) * nloc) {
            __builtin_amdgcn_fence(__ATOMIC_RELEASE, "agent");
            asm volatile("s_waitcnt vmcnt(0)" ::: "memory");
            const unsigned og = xb_add(&bar[XB_TOP], 1u);
            const unsigned tg = og / nx;
            if (og + 1u == (tg + 1u) * nx) xb_add(&bar[XB_TOPGEN], 1u);
            else XB_SPIN(xb_ld(&bar[XB_TOPGEN]) == tg, bar);
            __builtin_amdgcn_fence(__ATOMIC_ACQUIRE, "agent");
            xb_add(&bar[XB_XGEN(b.x)], 1u);
            asm volatile("s_waitcnt vmcnt(0)" ::: "memory");
        } else {
            XB_SPIN(xb_ld(&bar[XB_XGEN(b.x)]) == gen, bar);
            __builtin_amdgcn_fence(__ATOMIC_ACQUIRE, "agent");
            asm volatile("s_waitcnt vmcnt(0)" ::: "memory");
        }
    }
    __syncthreads();
}

constexpr int NWAVES = 8;
struct Frame {
    LAS unsigned char* lds;
    LAS unsigned char* lc;
    unsigned* ctl;
    unsigned char* ws;
    int tid, lane, wave, vcu, G;
};
constexpr int LC_PTR = 2048;
__device__ __forceinline__ const float* inp(const Frame& F, int i) {
    const unsigned long long v = *(const LAS unsigned long long*)(F.lc + LC_PTR + 8 * i);
    const unsigned lo = __builtin_amdgcn_readfirstlane((unsigned)v), hi = __builtin_amdgcn_readfirstlane((unsigned)(v >> 32));
    return (const float*)(const GAS float*)(((unsigned long long)hi << 32) | lo);
}
__device__ __forceinline__ unsigned char* opq(unsigned char* p) { GAS unsigned char* g = (GAS unsigned char*)p; asm volatile("" : "+s"(g)); return (unsigned char*)g; }
__device__ __forceinline__ void refresh(Frame& F) { asm volatile("" : "+v"(F.tid)); F.lane = F.tid & 63; F.wave = __builtin_amdgcn_readfirstlane(F.tid >> 6); }

struct PlainSched {   static constexpr bool GATHER = false, ABLK = false;
    int nM, nN, nwg, G, c; const char* B; int ldb;
    __device__ __forceinline__ bool next(int i, pg8::Unit& u) const {
        const int L = i * G + c; if (L >= nwg) return false;
        const int wgid = pg8::xcd_chunk(L, nwg);
        const int nig = 8 * nN, gid = wgid / nig, fm = gid * 8, gsz = (nM - fm) < 8 ? (nM - fm) : 8;
        u.pm = fm + ((wgid % nig) % gsz); u.pn = (wgid % nig) / gsz;
        u.bptr = B + (size_t)u.pn * 256 * ldb; u.roff = -(u.pm * 256) - 1; u.nvalid = 256; return true;
    }
    __device__ __forceinline__ int arow(const pg8::Unit& u, int r) const { return -u.roff - 1 + r; }
    __device__ __forceinline__ int acolb(const pg8::Unit&) const { return 0; }
    __device__ __forceinline__ float rowscale(const pg8::Unit&, int) const { return 1.0f; }
};
struct GrpSched {     static constexpr bool GATHER = false, ABLK = false;
    int G, c; const char* B;
    __device__ __forceinline__ bool next(int i, pg8::Unit& u) const {
        const int L = i * G + c; if (L >= 256) return false;
        const int wgid = pg8::xcd_chunk(L, 256);
        u.pm = wgid >> 2; u.pn = wgid & 3; u.bptr = B + (size_t)u.pn * 256 * 512; u.roff = -(u.pm * 256) - 1; u.nvalid = 256; return true;
    }
    __device__ __forceinline__ int arow(const pg8::Unit& u, int r) const { return -u.roff - 1 + r; }
    __device__ __forceinline__ int acolb(const pg8::Unit& u) const { return u.pn * 512; }
    __device__ __forceinline__ float rowscale(const pg8::Unit&, int) const { return 1.0f; }
};
template <bool GATHER_> struct MoeSched {     static constexpr bool GATHER = GATHER_, ABLK = !GATHER_;
    const LAS int* ts; const LAS int* cn; int npn, nunits, G, c, lane_;
    const int* tokl; const float* wl; const char* Bexp; size_t bstride; const char* Bsh; int ldb;
    __device__ __forceinline__ bool next(int i, pg8::Unit& u) const {
        const int L = i * G + c; const int xg = L % pg8::NXCD, off = L / pg8::NXCD;
        const int ntile = nunits / npn, tq = ntile / pg8::NXCD, tr = ntile % pg8::NXCD;
        const int tcnt = tq + (xg < tr ? 1 : 0), tstart = xg * tq + (xg < tr ? xg : tr);
        if (off >= tcnt * npn) return false;
        const int tile = tstart + off / npn, pn = off % npn;
        const int lane = lane_;
        const bool hit = (tile >= ts[lane]) && (tile < ts[lane + 1]);
        const unsigned long long mk = __ballot(hit);
        const int e = mk ? (int)__builtin_ctzll(mk) : 64;
        const int tse = __builtin_amdgcn_readfirstlane(ts[e]);
        const int r0 = (tile - tse) * 256;
        u.pm = tile; u.pn = pn;
        u.bptr = (e < 64 ? Bexp + (size_t)e * bstride : Bsh) + (size_t)pn * 256 * ldb;
        if (GATHER) {
            if (e < 64) { const int ce = __builtin_amdgcn_readfirstlane(cn[e]); u.roff = e * CAP + r0; u.nvalid = (ce - r0) < 256 ? (ce - r0) : 256; }
            else { u.roff = -r0 - 1; u.nvalid = 256; }
        } else { u.roff = -(tile * 256) - 1; u.nvalid = 256; }
        return true;
    }
    __device__ __forceinline__ int arow(const pg8::Unit& u, int r) const { if (GATHER && u.roff >= 0) { const int rr = r < u.nvalid ? r : u.nvalid - 1; return tokl[u.roff + rr]; } return -u.roff - 1 + r; }
    __device__ __forceinline__ int acolb(const pg8::Unit&) const { return 0; }
    __device__ __forceinline__ float rowscale(const pg8::Unit& u, int r) const { if (GATHER && u.roff >= 0) { const int rr = r < u.nvalid ? r : u.nvalid - 1; return wl[u.roff + rr]; } return 1.0f; }
};

__device__ __forceinline__ void p0_transpose_item64(const float* W, int K, int N, bf16* WT, int dst_n0, LAS float* scr, int kb, int nb, int lane) {
    const int k0 = 64 * kb, n0 = 64 * nb; const int r = lane >> 4, c4 = lane & 15;
    f32x4 v[16];
#pragma unroll
    for (int i = 0; i < 16; ++i) v[i] = *(const GAS f32x4*)(W + (size_t)(k0 + 4 * i + r) * N + n0 + 4 * c4);
#pragma unroll
    for (int i = 0; i < 16; ++i) { const int k = 4 * i + r; *(LAS f32x4*)(scr + k * 64 + 4 * (c4 ^ (k >> 3))) = v[i]; }
    LDS_WAIT(); asm volatile("" ::: "memory");
    const int c = lane & 7;
#pragma unroll
    for (int j = 0; j < 8; ++j) { const int n = (lane >> 3) + 8 * j; const LAS float* sp = scr + (8 * c) * 64 + 4 * ((n >> 2) ^ c) + (n & 3);
        u32x4 o; o.x = pk2(sp[0 * 64], sp[1 * 64]); o.y = pk2(sp[2 * 64], sp[3 * 64]); o.z = pk2(sp[4 * 64], sp[5 * 64]); o.w = pk2(sp[6 * 64], sp[7 * 64]);
        *(GAS u32x4*)(WT + (size_t)(dst_n0 + n) * K + k0 + 8 * c) = o; }
    LDS_WAIT(); asm volatile("" ::: "memory");
}
__device__ __forceinline__ void p0_router_item(const float* W, bf16* WH, bf16* WLo, LAS float* scr, int kb, int nb, int lane) {
    const int K = 1024, N = 64; const int k0 = 64 * kb, n0 = 32 * nb;
#pragma unroll 8
    for (int i = 0; i < 32; ++i) { const int kk = 2 * i + (lane >> 5); scr[kk * 33 + (lane & 31)] = W[(size_t)(k0 + kk) * N + n0 + (lane & 31)]; }
    LDS_WAIT(); asm volatile("" ::: "memory");
    const int c = lane & 7;
#pragma unroll
    for (int j = 0; j < 4; ++j) { const int n = (lane >> 3) + 8 * j; const LAS float* s = scr + (8 * c) * 33 + n;
        unsigned h[8], l[8];
#pragma unroll
        for (int q = 0; q < 8; ++q) { const float v = s[q * 33]; h[q] = f2bf(v); l[q] = f2bf(v - bf2f(h[q])); }
        u32x4 oh, ol; oh.x = h[0] | (h[1] << 16); oh.y = h[2] | (h[3] << 16); oh.z = h[4] | (h[5] << 16); oh.w = h[6] | (h[7] << 16);
        ol.x = l[0] | (l[1] << 16); ol.y = l[2] | (l[3] << 16); ol.z = l[4] | (l[5] << 16); ol.w = l[6] | (l[7] << 16);
        *(GAS u32x4*)(WH + (size_t)(n0 + n) * K + k0 + 8 * c) = oh; *(GAS u32x4*)(WLo + (size_t)(n0 + n) * K + k0 + 8 * c) = ol; }
    LDS_WAIT(); asm volatile("" ::: "memory");
}

__device__ __forceinline__ void p0_prologue(Frame& F) {
    LAS float* cs = (LAS float*)(F.lds);
    LAS float* part = (LAS float*)(F.lds + 32768);
    const float* c = inp(F, 1);
    for (int i = F.tid; i < 8 * 1024; i += 512) { const float v = c[i]; cs[i] = v / (1.0f + __expf(-v)); }
    __syncthreads();
    float* mod = (float*)(F.ws + WS_MOD);
    for (int it = F.vcu; it < 4 * 96; it += F.G) {
        const int layer = it / 96, slab = it % 96; const int col = slab * 64 + F.lane;
        const float* W = inp(F, 2) + (size_t)layer * 1024 * 6144 + col;
        float a[8];
#pragma unroll
        for (int b = 0; b < 8; ++b) a[b] = 0.f;
        const int k0 = F.wave * 128;
#pragma unroll 4
        for (int k = 0; k < 128; k += 4) {
            float w[4];
#pragma unroll
            for (int j = 0; j < 4; ++j) w[j] = W[(size_t)(k0 + k + j) * 6144];
#pragma unroll
            for (int b = 0; b < 8; ++b) { const f32x4 cv = *(const LAS f32x4*)(cs + b * 1024 + k0 + k); a[b] += cv[0] * w[0] + cv[1] * w[1] + cv[2] * w[2] + cv[3] * w[3]; }
        }
#pragma unroll
        for (int b = 0; b < 8; ++b) part[(F.wave * 8 + b) * 64 + F.lane] = a[b];
        __syncthreads();
        { const int b = F.wave; float s = 0.f;
#pragma unroll
          for (int w = 0; w < 8; ++w) s += part[(w * 8 + b) * 64 + F.lane];
          mod[((size_t)layer * 8 + b) * 6144 + col] = s + inp(F, 3)[layer * 6144 + col]; }
        __syncthreads();
    }
    __syncthreads();
    LAS float* scr = (LAS float*)(F.lds + F.wave * 16384);
    const int gw = F.vcu * NWAVES + F.wave, NGW = F.G * NWAVES;
    constexpr int I_PIN = 2 * 16 * 16, I_GRP = 8 * 4 * 4, I_POUT = I_PIN, I_AIN = 2 * 16 * 144, I_AOUT = I_PIN, I_SHGU = 4 * 16 * 8, I_SHDN = 4 * 4 * 16, I_R = 4 * 16 * 2;
    constexpr int I_EGU = 256 * 16 * 8, I_EDN = 256 * 4 * 16;
    constexpr int NITEMS = I_PIN + I_GRP + I_POUT + I_AIN + I_AOUT + I_SHGU + I_SHDN + I_R + I_EGU + I_EDN;
    for (int it = gw; it < NITEMS; it += NGW) {
        int r = it;
#define P0_GROUP(CNT, SRC, KK, NN, DST, GU) if (r < (CNT)) { const int per = ((KK) / 64) * ((NN) / 64), mat = r / per, q = r % per, nblk = (NN) / 64, kblk = (KK) / 64, nb = q / kblk, kb = q % kblk; (void)nblk; \
            int dn0 = 64 * nb; if (GU) { const int n0 = 64 * nb; dn0 = (n0 < 256) ? ((n0 >> 7) * 256 + (n0 & 127)) : (((n0 - 256) >> 7) * 256 + 128 + ((n0 - 256) & 127)); } \
            p0_transpose_item64((SRC) + (size_t)mat * (KK) * (NN), (KK), (NN), (bf16*)(F.ws + (DST)) + (size_t)mat * (KK) * (NN), dn0, scr, kb, nb, F.lane); continue; } r -= (CNT);
        P0_GROUP(I_PIN, inp(F, 4), 1024, 1024, WS_WPIN, 0)
        P0_GROUP(I_GRP, inp(F, 5), 256, 256, WS_WPGRP, 0)
        P0_GROUP(I_POUT, inp(F, 7), 1024, 1024, WS_WPOUT, 0)
        P0_GROUP(I_AIN, inp(F, 8), 1024, 9216, WS_WAIN, 0)
        P0_GROUP(I_AOUT, inp(F, 9), 1024, 1024, WS_WAOUT, 0)
        P0_GROUP(I_SHGU, inp(F, 16), 1024, 512, WS_WSHGU, 1)
        P0_GROUP(I_SHDN, inp(F, 17), 256, 1024, WS_WSHDN, 0)
        if (r < I_R) { const int mat = r / 32, q = r % 32, kb = q / 2, nb = q % 2;
            p0_router_item(inp(F, 12) + (size_t)mat * 65536, (bf16*)(F.ws + WS_WRHI) + (size_t)mat * 65536, (bf16*)(F.ws + WS_WRLO) + (size_t)mat * 65536, scr, kb, nb, F.lane); continue; } r -= I_R;
        P0_GROUP(I_EGU, inp(F, 14), 1024, 512, WS_WEGU, 1)
        P0_GROUP(I_EDN, inp(F, 15), 256, 1024, WS_WEDN, 0)
#undef P0_GROUP
    }
}

__device__ __forceinline__ void p1_modulate(Frame& F, const float* x, const float* modl  , int sh_off, int sc_off) {
    bf16* H = (bf16*)(F.ws + WS_H);
    const int gw = F.vcu * NWAVES + F.wave, NGW = F.G * NWAVES;
    for (int m = gw; m < T; m += NGW) {
        const int b = m / SEQ; const float* mb = modl + (size_t)b * 6144;
        const GAS f32x4* xr = (const GAS f32x4*)(x + (size_t)m * D) + F.lane;
        GAS u32x2* o8 = (GAS u32x2*)(H + (size_t)m * D) + F.lane;
#pragma unroll
        for (int j = 0; j < 4; ++j) { const f32x4 v = xr[64 * j]; const f32x4 sc = *(const f32x4*)(mb + sc_off + 4 * F.lane + 256 * j), sh = *(const f32x4*)(mb + sh_off + 4 * F.lane + 256 * j);
            const f32x4 h = v * (sc + 1.0f) + sh; u32x2 w; w.x = pk2(h[0], h[1]); w.y = pk2(h[2], h[3]); o8[64 * j] = w; }
    }
}

template <int W>
__device__ __forceinline__ void pool_item(const bf16* U, bf16* Z, int b, int t0, int g, int lane) {
    const size_t base = (size_t)b * SEQ * D + 256 * g + 4 * lane;
    float s[4] = {0.f, 0.f, 0.f, 0.f};
#pragma unroll
    for (int j = 1; j <= W; ++j) { const int t = t0 - j; if (t >= 0) { const u32x2 v = *(const GAS u32x2*)(U + base + (size_t)t * D);
            s[0] += bf2f(v.x & 0xffffu); s[1] += bf2f(v.x >> 16); s[2] += bf2f(v.y & 0xffffu); s[3] += bf2f(v.y >> 16); } }
#pragma unroll 8
    for (int i = 0; i < 32; ++i) { const int t = t0 + i;
        const u32x2 v = *(const GAS u32x2*)(U + base + (size_t)t * D);
        const float c0 = bf2f(v.x & 0xffffu), c1 = bf2f(v.x >> 16), c2 = bf2f(v.y & 0xffffu), c3 = bf2f(v.y >> 16);
        s[0] += c0; s[1] += c1; s[2] += c2; s[3] += c3;
        if (t - W >= 0) { const u32x2 o = *(const GAS u32x2*)(U + base + (size_t)(t - W) * D);
            s[0] -= bf2f(o.x & 0xffffu); s[1] -= bf2f(o.x >> 16); s[2] -= bf2f(o.y & 0xffffu); s[3] -= bf2f(o.y >> 16); }
        const float inv = 1.0f / (float)((t + 1) < W ? (t + 1) : W);
        u32x2 w; w.x = pk2(s[0] * inv - c0, s[1] * inv - c1); w.y = pk2(s[2] * inv - c2, s[3] * inv - c3);
        *(GAS u32x2*)(Z + base + (size_t)t * D) = w; }
}

__device__ __forceinline__ void moe_build_table(Frame& F, int layer) {
    LAS int* ts = (LAS int*)(F.lc + LC_TS); LAS int* cn = (LAS int*)(F.lc + LC_CNT);
    __syncthreads();
    if (F.wave == 0) {
        const int c = (int)__hip_atomic_load(F.ctl + CW_CNT + layer * 64 + F.lane, RLX_AGENT);
        int t = (c + 255) >> 8;
#pragma unroll
        for (int o = 1; o < 64; o <<= 1) { const int v = __shfl_up(t, o); if (F.lane >= o) t += v; }
        cn[F.lane] = c; ts[F.lane + 1] = t;
        if (F.lane == 0) ts[0] = 0;
        if (F.lane == 63) ts[65] = t + 64;
    }
    __syncthreads();
}

#ifdef PROBE_TYPE
#define LSTAMP(ty) do { if (blockIdx.x == 0 && F.tid == 0) { const unsigned long long now_ = __builtin_amdgcn_s_memrealtime(); LAS unsigned long long* st_ = (LAS unsigned long long*)(F.lc + 3072); \
        st_[1 + (ty)] += now_ - st_[20]; st_[20] = now_; } } while (0)
#define LSTAMP0() do { if (blockIdx.x == 0 && F.tid == 0) { ((LAS unsigned long long*)(F.lc + 3072))[20] = __builtin_amdgcn_s_memrealtime(); } } while (0)
#else
#define LSTAMP(ty) do { } while (0)
#define LSTAMP0() do { } while (0)
#endif
constexpr int APITCH = 1032;
#define LDS_ONLY_BARRIER() do { asm volatile("s_waitcnt lgkmcnt(0)" ::: "memory"); __builtin_amdgcn_s_barrier(); asm volatile("" ::: "memory"); } while (0)
template <bool X16>
__device__ __forceinline__ void ln1_router_phase(Frame& F, int layer, const float* xin) {
    bf16* X = (bf16*)(F.ws + WS_X);
    bf16* H = (bf16*)(F.ws + WS_H); const bf16* Y = (const bf16*)(F.ws + WS_Y);
    const float* modl = (const float*)(F.ws + WS_MOD) + (size_t)layer * 8 * 6144;
    const float* lg = inp(F, 10) + layer * D; const float* lb = inp(F, 11) + layer * D;
    const float* rb = inp(F, 13) + layer * NE;
    const bf16* WH = (const bf16*)(F.ws + WS_WRHI) + (size_t)layer * 65536; const bf16* WLo = (const bf16*)(F.ws + WS_WRLO) + (size_t)layer * 65536;
    int* tokl = (int*)(F.ws + WS_TOKL); float* wl = (float*)(F.ws + WS_WL); int* tslot = (int*)(F.ws + WS_TSLOT);
    unsigned* gcnt = F.ctl + CW_CNT + layer * 64;
    LAS bf16* Ahi = (LAS bf16*)F.lds; LAS bf16* Alo = Ahi + 32 * APITCH;
    LAS float* PART = (LAS float*)F.lds;
    LAS float* PV = (LAS float*)(F.lds + LDS_TB_OFF);
    LAS int* lcnt = (LAS int*)(F.lc + LC_LCNT); LAS int* gb = (LAS int*)(F.lc + LC_GB);
    const int lane = F.lane, wave = F.wave;
    const int nblk = (T / 32) / F.G;
#define LN1_BLK(bi_) ((F.G == 256) ? ((F.vcu >> 5) * 64 + (F.vcu & 31) * 2 + (bi_)) : (F.vcu + (bi_) * F.G))
    constexpr int NX = X16 ? 2 : 4;
    u32x4 xr[4][NX], yv[4][2];
#define LN1_LOAD(bi_) do { const int t0_ = LN1_BLK(bi_) * 32 + wave * 4; \
        _Pragma("unroll") for (int q = 0; q < 4; ++q) _Pragma("unroll") for (int j = 0; j < 2; ++j) { const size_t o_ = (size_t)(t0_ + q) * D + 8 * lane + 512 * j; \
            if constexpr (X16) xr[q][j] = __builtin_nontemporal_load((const GAS u32x4*)((const bf16*)xin + o_)); \
            else { xr[q][2 * j] = *(const GAS u32x4*)(xin + o_); xr[q][2 * j + 1] = *(const GAS u32x4*)(xin + o_ + 4); } \
            yv[q][j] = __builtin_nontemporal_load((const GAS u32x4*)(Y + o_)); } } while (0)
    LN1_LOAD(0);
    const float rbe = rb[lane];
    { const int b = (LN1_BLK(0) * 32) / SEQ; const float* mb = modl + (size_t)b * 6144;
      for (int i = F.tid; i < 1024; i += NWAVES * 64) { const int v = i >> 8, c4 = (i & 255) * 4;
          const float* src = (v == 0) ? lg : (v == 1) ? lb : (v == 2) ? (mb + 4096) : (mb + 3072);
          f32x4 t = *(const GAS f32x4*)(src + c4); if (v == 2) t = t + 1.0f; *(LAS f32x4*)(PV + v * 1024 + c4) = t; } }
    __syncthreads();
    for (int bi = 0; bi < nblk; ++bi) {
        const int blk = LN1_BLK(bi);
        const int tok0 = blk * 32;
        LSTAMP0();
        bf16x8 bh[8][2], bl[8][2];
        {
            const int b = tok0 / SEQ; const float* mb = modl + (size_t)b * 6144;
            f32x4 xv[4][4];
            f32x4 pg1[4];
#pragma unroll
            for (int jj = 0; jj < 4; ++jj) pg1[jj] = *(const GAS f32x4*)(mb + 2048 + 8 * lane + 512 * (jj >> 1) + 4 * (jj & 1)) + 1.0f;
            float sm[4];
#pragma unroll
            for (int q = 0; q < 4; ++q) { float s = 0.f;
#pragma unroll
                for (int jj = 0; jj < 4; ++jj) { const unsigned w0 = (jj & 1) ? yv[q][jj >> 1].z : yv[q][jj >> 1].x, w1 = (jj & 1) ? yv[q][jj >> 1].w : yv[q][jj >> 1].y;
                    f32x4 y4; y4[0] = h2f(w0 & 0xffffu); y4[1] = h2f(w0 >> 16); y4[2] = h2f(w1 & 0xffffu); y4[3] = h2f(w1 >> 16);
                    f32x4 x4;
                    if constexpr (X16) { const unsigned v0 = (jj & 1) ? xr[q][jj >> 1].z : xr[q][jj >> 1].x, v1 = (jj & 1) ? xr[q][jj >> 1].w : xr[q][jj >> 1].y;
                        x4 = (f32x4){h2f(v0 & 0xffffu), h2f(v0 >> 16), h2f(v1 & 0xffffu), h2f(v1 >> 16)}; }
                    else { const u32x4 v = xr[q][jj]; x4 = (f32x4){__uint_as_float(v.x), __uint_as_float(v.y), __uint_as_float(v.z), __uint_as_float(v.w)}; }
                    xv[q][jj] = x4 * ALPHA + pg1[jj] * y4; s += (xv[q][jj][0] + xv[q][jj][1]) + (xv[q][jj][2] + xv[q][jj][3]); }
                sm[q] = s; }
#pragma unroll
            for (int o = 1; o < 64; o <<= 1) {
#pragma unroll
                for (int q = 0; q < 4; ++q) sm[q] += __shfl_xor(sm[q], o); }
            float s2[4];
#pragma unroll
            for (int q = 0; q < 4; ++q) { const float mean = sm[q] * (1.f / D); float t = 0.f;
#pragma unroll
                for (int jj = 0; jj < 4; ++jj) { xv[q][jj] = xv[q][jj] - mean; t += (xv[q][jj][0] * xv[q][jj][0] + xv[q][jj][1] * xv[q][jj][1]) + (xv[q][jj][2] * xv[q][jj][2] + xv[q][jj][3] * xv[q][jj][3]); }
                s2[q] = t; }
#pragma unroll
            for (int o = 1; o < 64; o <<= 1) {
#pragma unroll
                for (int q = 0; q < 4; ++q) s2[q] += __shfl_xor(s2[q], o); }
            LAS float* pvb = PV + 8 * lane; asm volatile("" : "+v"(pvb));
#pragma unroll
            for (int jj = 0; jj < 4; ++jj) { const int col = 8 * lane + 512 * (jj >> 1) + 4 * (jj & 1); const int co = 512 * (jj >> 1) + 4 * (jj & 1);
                const f32x4 gg = *(const LAS f32x4*)(pvb + co), bb = *(const LAS f32x4*)(pvb + 1024 + co), sc2 = *(const LAS f32x4*)(pvb + 2048 + co), sh2 = *(const LAS f32x4*)(pvb + 3072 + co);
#pragma unroll
                for (int q = 0; q < 4; ++q) { const int rl = wave * 4 + q, tok = tok0 + rl; const float rstd = 1.0f / sqrtf(s2[q] * (1.f / D) + LN_EPS);
                    const f32x4 xn = xv[q][jj] * rstd * gg + bb; { u32x2 xw; xw.x = pkh2(xn[0], xn[1]); xw.y = pkh2(xn[2], xn[3]); *(GAS u32x2*)(X + (size_t)tok * D + col) = xw; }
                    const f32x4 hf = xn * sc2 + sh2;
                    unsigned hh[4], ll[4];
#pragma unroll
                    for (int e = 0; e < 4; ++e) { hh[e] = f2bf(hf[e]); ll[e] = f2bf(hf[e] - bf2f(hh[e])); }
                    u32x2 wh, wlo; wh.x = hh[0] | (hh[1] << 16); wh.y = hh[2] | (hh[3] << 16); wlo.x = ll[0] | (ll[1] << 16); wlo.y = ll[2] | (ll[3] << 16);
                    *(GAS u32x2*)(H + (size_t)tok * D + col) = wh;
                    *(LAS u32x2*)(Ahi + rl * APITCH + col) = wh; *(LAS u32x2*)(Alo + rl * APITCH + col) = wlo; } }
        }
        __builtin_amdgcn_sched_barrier(0);
        {
            const int r32 = lane & 31, hi = lane >> 5;
#pragma unroll
            for (int nb = 0; nb < 2; ++nb) {
                const GAS bf16* ph = (const GAS bf16*)WH + (size_t)(r32 + 32 * nb) * 1024 + wave * 128 + hi * 8; const GAS bf16* pl = (const GAS bf16*)WLo + (size_t)(r32 + 32 * nb) * 1024 + wave * 128 + hi * 8;
                asm volatile("" : "+v"(ph), "+v"(pl));
#pragma unroll
                for (int ks = 0; ks < 8; ++ks) { bh[ks][nb] = *(const GAS bf16x8*)(ph + ks * 16); bl[ks][nb] = *(const GAS bf16x8*)(pl + ks * 16); } }
        }
        __syncthreads();
        LSTAMP(13);
        f32x16 acc[2]; acc[0] = (f32x16){}; acc[1] = (f32x16){};
        {
            const int r32 = lane & 31, hi = lane >> 5;
#pragma unroll
            for (int ks = 0; ks < 8; ++ks) {
                const int k = wave * 128 + ks * 16 + hi * 8;
                const bf16x8 ah = *(const LAS bf16x8*)(Ahi + r32 * APITCH + k), al = *(const LAS bf16x8*)(Alo + r32 * APITCH + k);
#pragma unroll
                for (int nb = 0; nb < 2; ++nb) {
                    acc[nb] = MFMA32(ah, bh[ks][nb], acc[nb]);
                    acc[nb] = MFMA32(al, bh[ks][nb], acc[nb]);
                    acc[nb] = MFMA32(ah, bl[ks][nb], acc[nb]);
                }
            }
        }
        LDS_ONLY_BARRIER();
        {
            const int r32 = lane & 31, hi = lane >> 5;
#pragma unroll
            for (int nb = 0; nb < 2; ++nb)
#pragma unroll
                for (int r = 0; r < 16; ++r) { const int trow = (r & 3) + 8 * (r >> 2) + 4 * hi; PART[(wave * 32 + trow) * 64 + 32 * nb + r32] = acc[nb][r]; }
        }
        if (F.tid < 64) lcnt[F.tid] = 0;
        LDS_ONLY_BARRIER();
        LSTAMP(14);
        if (bi + 1 < nblk) LN1_LOAD(bi + 1);
        else {
#pragma unroll
            for (int q = 0; q < 4; ++q) {
#pragma unroll
                for (int j = 0; j < NX; ++j) xr[q][j] = (u32x4){0u, 0u, 0u, 0u};
#pragma unroll
                for (int j = 0; j < 2; ++j) yv[q][j] = (u32x4){0u, 0u, 0u, 0u}; } }
        int chosen_m = 0; int posl[4]; float wv[4]; int rk[4];
        unsigned key[4]; float sgv[4];
#pragma unroll
        for (int q = 0; q < 4; ++q) {
            const int rl = wave * 4 + q;
            float logit = 0.f;
#pragma unroll
            for (int w = 0; w < 8; ++w) logit += PART[(w * 32 + rl) * 64 + lane];
            const float sg = 1.0f / (1.0f + __expf(-logit));
            const float sel = sg + rbe;
            float m1 = sel; m1 = fmaxf(m1, __shfl_xor(m1, 1)); m1 = fmaxf(m1, __shfl_xor(m1, 2)); m1 = fmaxf(m1, __shfl_xor(m1, 4));
            const unsigned long long bal = __ballot(sel == m1);
            const unsigned long long gm = bal & (0xFFull << (8 * (lane >> 3)));
            const int first = (int)__builtin_ctzll(gm);
            float m2 = (lane == first) ? -INFINITY : sel; m2 = fmaxf(m2, __shfl_xor(m2, 1)); m2 = fmaxf(m2, __shfl_xor(m2, 2)); m2 = fmaxf(m2, __shfl_xor(m2, 4));
            const float gs = m1 + m2;
            int rg = 0;
#pragma unroll
            for (int g2 = 0; g2 < 8; ++g2) { const float v = __builtin_bit_cast(float, __builtin_amdgcn_readlane(__builtin_bit_cast(int, gs), 8 * g2)); rg += ((v > gs) || (v == gs && g2 < (lane >> 3))) ? 1 : 0; }
            const bool gsel = rg < 4;
            const float msel = gsel ? sel : -INFINITY;
            const unsigned mb_ = __float_as_uint(msel); key[q] = (mb_ & 0x80000000u) ? ~mb_ : (mb_ | 0x80000000u); sgv[q] = sg;
        }
        unsigned tau[4] = {0u, 0u, 0u, 0u};
#pragma unroll 1
        for (int bit = 31; bit >= 0; --bit) {
#pragma unroll
            for (int q = 0; q < 4; ++q) { const unsigned cand = tau[q] | (1u << bit); const int cnt = (int)__popcll(__ballot(key[q] >= cand)); tau[q] = (cnt >= TOPK) ? cand : tau[q]; } }
#pragma unroll
        for (int q = 0; q < 4; ++q) {
            const unsigned long long gtm = __ballot(key[q] > tau[q]), eqm = __ballot(key[q] == tau[q]);
            const int need = TOPK - (int)__popcll(gtm);
            const unsigned long long below = (1ull << lane) - 1ull;
            const bool ch = (key[q] > tau[q]) || ((key[q] == tau[q]) && ((int)__popcll(eqm & below) < need));
            const unsigned long long chm = __ballot(ch);
            const int rank = (int)__popcll(chm & below);
            const float wsum = wave_sum(ch ? sgv[q] : 0.f);
            wv[q] = sgv[q] / wsum * ROUTED_SCALE; rk[q] = rank; posl[q] = 0;
            if (ch) { chosen_m |= (1 << q); posl[q] = __hip_atomic_fetch_add(lcnt + lane, 1, __ATOMIC_RELAXED, __HIP_MEMORY_SCOPE_WORKGROUP); }
        }
        LDS_ONLY_BARRIER();
        LSTAMP(15);
        if (wave == 0) { const int n = lcnt[lane]; int base = 0; if (n > 0) base = (int)__hip_atomic_fetch_add(gcnt + lane, (unsigned)n, RLX_AGENT); gb[lane] = base; }
        LDS_ONLY_BARRIER();
        {
            const int base = gb[lane];
#pragma unroll
            for (int q = 0; q < 4; ++q) if (chosen_m & (1 << q)) { const int tok = tok0 + wave * 4 + q; const int pos = base + posl[q];
                tokl[(size_t)lane * CAP + pos] = tok; wl[(size_t)tok * 8 + rk[q]] = wv[q]; tslot[(size_t)tok * 8 + rk[q]] = lane * CAP + pos; }
        }
        LDS_ONLY_BARRIER();
        LSTAMP(16);
    }
#undef LN1_LOAD
#undef LN1_BLK
}

__device__ __forceinline__ void combine_ln2_phase(Frame& F, int layer) {
    bf16* X = (bf16*)(F.ws + WS_X); bf16* H = (bf16*)(F.ws + WS_H); const bf16* YS = (const bf16*)(F.ws + WS_YS);
    const float* modl = (const float*)(F.ws + WS_MOD) + (size_t)layer * 8 * 6144;
    const float* modn = (const float*)(F.ws + WS_MOD) + (size_t)(layer + 1) * 8 * 6144;
    const float* lg = inp(F, 18) + layer * D; const float* lb = inp(F, 19) + layer * D;
    const int* tslot = (const int*)(F.ws + WS_TSLOT);
    const LAS int* ts = (const LAS int*)(F.lc + LC_TS);
    const bool lastl = (layer == DEPTH - 1);
    float* xout = (float*)inp(F, 20);
    const int lane = F.lane, wave = F.wave;
    LAS float* PV = (LAS float*)F.lds;
    const int shbase = ts[64] * 256;
    for (int blk = F.vcu; blk < T / 64; blk += F.G) {
        const int tokb = blk * 64, b = tokb / SEQ;
        __syncthreads();
        for (int i = F.tid; i < 1024; i += 512) { PV[i] = modl[(size_t)b * 6144 + 5120 + i] + 1.0f; PV[1024 + i] = lg[i]; PV[2048 + i] = lb[i];
            if (!lastl) { PV[3072 + i] = modn[(size_t)b * 6144 + 1024 + i] + 1.0f; PV[4096 + i] = modn[(size_t)b * 6144 + i]; } }
        __syncthreads();
        const int tw = tokb + wave * 8;
        int sv; { const int v = tslot[(size_t)tw * 8 + lane]; sv = ts[v >> 14] * 256 + (v & (CAP - 1)); }
        const float wvv = ((const float*)(F.ws + WS_WL))[(size_t)tw * 8 + lane];
        u32x4 ys[18]; u32x4 xs[2];
#define CB_LOAD(k) do { const int tok_ = tw + (k); _Pragma("unroll") for (int kk_ = 0; kk_ < 9; ++kk_) { const int slot_ = (kk_ < 8) ? __builtin_amdgcn_readlane(sv, 8 * (k) + kk_) : (shbase + tok_); \
            const bf16* yr_ = YS + (size_t)slot_ * D + 8 * lane; ys[2 * kk_] = __builtin_nontemporal_load((const GAS u32x4*)(yr_)); ys[2 * kk_ + 1] = __builtin_nontemporal_load((const GAS u32x4*)(yr_ + 512)); } \
            _Pragma("unroll") for (int j_ = 0; j_ < 2; ++j_) xs[j_] = __builtin_nontemporal_load((const GAS u32x4*)(X + (size_t)tok_ * D + 8 * lane + 512 * j_)); } while (0)
        CB_LOAD(0);
#pragma unroll 1
        for (int k = 0; k < 8; ++k) {
            const int tok_ = tw + k; f32x4 y_[4];
#pragma unroll
            for (int jj_ = 0; jj_ < 4; ++jj_) y_[jj_] = (f32x4){0.f, 0.f, 0.f, 0.f};
#pragma unroll
            for (int kk_ = 0; kk_ < 9; ++kk_) { const float wk_ = (kk_ < 8) ? __builtin_bit_cast(float, __builtin_amdgcn_readlane(__builtin_bit_cast(int, wvv), 8 * k + kk_)) : 1.0f;
#pragma unroll
                for (int j_ = 0; j_ < 2; ++j_) { const u32x4 w_ = ys[2 * kk_ + j_];
                    y_[2 * j_][0] += wk_ * h2f(w_.x & 0xffffu); y_[2 * j_][1] += wk_ * h2f(w_.x >> 16); y_[2 * j_][2] += wk_ * h2f(w_.y & 0xffffu); y_[2 * j_][3] += wk_ * h2f(w_.y >> 16);
                    y_[2 * j_ + 1][0] += wk_ * h2f(w_.z & 0xffffu); y_[2 * j_ + 1][1] += wk_ * h2f(w_.z >> 16); y_[2 * j_ + 1][2] += wk_ * h2f(w_.w & 0xffffu); y_[2 * j_ + 1][3] += wk_ * h2f(w_.w >> 16); } }
            f32x4 v_[4]; float s_ = 0.f;
#pragma unroll
            for (int jj_ = 0; jj_ < 4; ++jj_) { const int col_ = 8 * lane + 512 * (jj_ >> 1) + 4 * (jj_ & 1); const f32x4 g2_ = *(const LAS f32x4*)(PV + col_);
                const unsigned w0_ = (jj_ & 1) ? xs[jj_ >> 1].z : xs[jj_ >> 1].x, w1_ = (jj_ & 1) ? xs[jj_ >> 1].w : xs[jj_ >> 1].y;
                const f32x4 x4_ = (f32x4){h2f(w0_ & 0xffffu), h2f(w0_ >> 16), h2f(w1_ & 0xffffu), h2f(w1_ >> 16)};
                v_[jj_] = x4_ * ALPHA + g2_ * y_[jj_]; s_ += (v_[jj_][0] + v_[jj_][1]) + (v_[jj_][2] + v_[jj_][3]); }
            asm volatile("" : "+v"(v_[0]), "+v"(v_[1]), "+v"(v_[2]), "+v"(v_[3]));
            __builtin_amdgcn_sched_barrier(0);
            { const int kn = (k + 1 < 8) ? k + 1 : k; CB_LOAD(kn); }
            __builtin_amdgcn_sched_barrier(0);
            const float mean_ = wave_sum(s_) * (1.f / D); float q_ = 0.f;
#pragma unroll
            for (int jj_ = 0; jj_ < 4; ++jj_) { v_[jj_] = v_[jj_] - mean_; q_ += (v_[jj_][0] * v_[jj_][0] + v_[jj_][1] * v_[jj_][1]) + (v_[jj_][2] * v_[jj_][2] + v_[jj_][3] * v_[jj_][3]); }
            const float rstd_ = 1.0f / sqrtf(wave_sum(q_) * (1.f / D) + LN_EPS);
#pragma unroll
            for (int jj_ = 0; jj_ < 4; ++jj_) { const int col_ = 8 * lane + 512 * (jj_ >> 1) + 4 * (jj_ & 1);
                const f32x4 gg_ = *(const LAS f32x4*)(PV + 1024 + col_), bb_ = *(const LAS f32x4*)(PV + 2048 + col_);
                const f32x4 xn_ = v_[jj_] * rstd_ * gg_ + bb_;
                if (lastl) *(GAS f32x4*)(xout + (size_t)tok_ * D + col_) = xn_;
                else { u32x2 xw_; xw_.x = pkh2(xn_[0], xn_[1]); xw_.y = pkh2(xn_[2], xn_[3]); *(GAS u32x2*)(X + (size_t)tok_ * D + col_) = xw_; }
                if (!lastl) { const f32x4 sc_ = *(const LAS f32x4*)(PV + 3072 + col_), sh_ = *(const LAS f32x4*)(PV + 4096 + col_); const f32x4 hm_ = xn_ * sc_ + sh_;
                    u32x2 w2_; w2_.x = pk2(hm_[0], hm_[1]); w2_.y = pk2(hm_[2], hm_[3]); *(GAS u32x2*)(H + (size_t)tok_ * D + col_) = w2_; } }
        }
#undef CB_LOAD
    }
}

constexpr int ACCP = 68;
__device__ __forceinline__ int crow(int r, int hi) { return (r & 3) + 8 * (r >> 2) + 4 * hi; }
constexpr int KPITCH = 144;
template <bool FIRST, int NB>
__device__ __forceinline__ void attn_task(const bf16* QKVb  , int g, int h, int dil, int cls, int q0, int QS, int kb0, int L, float slope2d,
                                          LAS unsigned char* stg  , LAS float* wsf  , LAS float* ACC, LAS float* ML, int trow_mul, int trow_add, int lane) {
    asm volatile("" : "+v"(lane));
    const int r32 = lane & 31, hi = lane >> 5, lr = lane >> 3, lc = lane & 7;
    const int qcol = ((g * 3 + 0) * 16 + h) * 64, kcol = ((g * 3 + 1) * 16 + h) * 64, vcol = ((g * 3 + 2) * 16 + h) * 64;
    const size_t rstride = (size_t)dil * NQKV;
    const bf16* base = QKVb + (size_t)cls * NQKV + lc * 8;
    const int jlo = (kb0 >= -31) ? 0 : ((-kb0) >> 5);
    const int qpos = q0 + QS * r32;
    const int dmax = qpos < 128 ? qpos : 128;
    const float half = 0.5f * (float)dmax;
#define AT_LOADROWS(dst, l0, ls, col) do { _Pragma("unroll") for (int i_ = 0; i_ < 4; ++i_) { int l_ = (l0) + (ls) * (8 * i_ + lr); l_ = l_ < 0 ? 0 : (l_ > L - 1 ? L - 1 : l_); \
        dst[i_] = *(const GAS u32x4*)(base + (size_t)l_ * rstride + (col)); } } while (0)
#define AT_PUTROWS(src) do { _Pragma("unroll") for (int i_ = 0; i_ < 4; ++i_) *(LAS u32x4*)(stg + (8 * i_ + lr) * KPITCH + lc * 16) = src[i_]; } while (0)
#define AT_GETFRAG(dst) do { _Pragma("unroll") for (int s_ = 0; s_ < 4; ++s_) dst[s_] = *(const LAS bf16x8*)(stg + r32 * KPITCH + 32 * s_ + 16 * hi); } while (0)
#define AT_LDSWAIT() asm volatile("s_waitcnt lgkmcnt(0)" ::: "memory")
    u32x4 kr[2][4];
    bf16x8 qf[4];
    { u32x4 qr[4]; AT_LOADROWS(qr, q0, QS, qcol);
#pragma unroll
      for (int j = 0; j < NB; ++j) if (j == jlo) AT_LOADROWS(kr[j & 1], kb0 + 32 * j, 1, kcol);
      AT_PUTROWS(qr); AT_LDSWAIT(); AT_GETFRAG(qf); AT_LDSWAIT(); }
    f32x16 S[NB];
    float mx = -INFINITY;
#pragma unroll
    for (int j = 0; j < NB; ++j) {
        if (j >= jlo) {
            asm volatile("" ::: "memory");
            if (j < NB - 1) AT_LOADROWS(kr[(j + 1) & 1], kb0 + 32 * (j + 1), 1, kcol);
            AT_PUTROWS(kr[j & 1]);
            const float xd0 = (float)(qpos - kb0 - 32 * j - 4 * hi) - half;
            const bool inner = (q0 - kb0 - 32 * j - 31 >= 0) && (q0 + QS * 31 - kb0 - 32 * j <= 128) && (kb0 + 32 * j >= 0);
            f32x16 a;
            if (inner) {
                const float cb = -slope2d * xd0;
#pragma unroll
                for (int r = 0; r < 16; ++r) a[r] = __builtin_fmaf(slope2d, (float)((r & 3) + 8 * (r >> 2)), cb);
            } else {
#pragma unroll
                for (int r = 0; r < 16; ++r) { const float x = xd0 - (float)((r & 3) + 8 * (r >> 2)); a[r] = (__builtin_fabsf(x) <= half) ? (-slope2d * x) : -INFINITY; }
            }
            bf16x8 kf[4];
            AT_LDSWAIT(); AT_GETFRAG(kf); AT_LDSWAIT();
#pragma unroll
            for (int s = 0; s < 4; ++s) a = MFMA32(kf[s], qf[s], a);
#pragma unroll
            for (int r = 0; r < 16; ++r) mx = fmaxf(mx, a[r]);
            S[j] = a;
        } else {
#pragma unroll
            for (int r = 0; r < 16; ++r) S[j][r] = -INFINITY;
        }
        __builtin_amdgcn_sched_barrier(0);
    }
    u32x4 vr[2][4];
#pragma unroll
    for (int j = 0; j < NB; ++j) if (j == jlo) AT_LOADROWS(vr[j & 1], kb0 + 32 * j, 1, vcol);
    { auto rr = __builtin_amdgcn_permlane32_swap(__float_as_uint(mx), __float_as_uint(mx), false, false);
      const unsigned r0 = rr[0], r1 = rr[1]; mx = fmaxf(__uint_as_float(r0), __uint_as_float(r1)); }
    const float mx_true = mx - slope2d * half;
    float lsum = 0.f;
    u32x4 P[NB][2];
#pragma unroll
    for (int j = 0; j < NB; ++j) {
        float p[16];
#pragma unroll
        for (int r = 0; r < 16; ++r) { p[r] = __builtin_amdgcn_exp2f(S[j][r] - mx); lsum += p[r]; }
#pragma unroll
        for (int ks = 0; ks < 2; ++ks) { P[j][ks].x = cvt_pk_bf16(p[8 * ks + 0], p[8 * ks + 1]); P[j][ks].y = cvt_pk_bf16(p[8 * ks + 2], p[8 * ks + 3]); P[j][ks].z = cvt_pk_bf16(p[8 * ks + 4], p[8 * ks + 5]); P[j][ks].w = cvt_pk_bf16(p[8 * ks + 6], p[8 * ks + 7]); }
        __builtin_amdgcn_sched_barrier(0);
    }
    { auto rr = __builtin_amdgcn_permlane32_swap(__float_as_uint(lsum), __float_as_uint(lsum), false, false);
      const unsigned r0 = rr[0], r1 = rr[1]; lsum = __uint_as_float(r0) + __uint_as_float(r1); }
    f32x16 o[2]; o[0] = (f32x16){}; o[1] = (f32x16){};
    const unsigned vrd = (unsigned)(((lane >> 4) & 1) * 32 + (lane & 3) * 8 + (4 * hi + ((lane & 15) >> 2)) * 64);
#pragma unroll
    for (int j = 0; j < NB; ++j) {
        if (j >= jlo) {
            asm volatile("" ::: "memory");
            if (j < NB - 1) AT_LOADROWS(vr[(j + 1) & 1], kb0 + 32 * (j + 1), 1, vcol);
#pragma unroll
            for (int i = 0; i < 4; ++i) { const int key = 8 * i + lr; *(LAS u32x4*)(stg + ((lc >> 2) * 2 + (key >> 4)) * 1024 + (key & 15) * 64 + (lc & 3) * 16) = vr[j & 1][i]; }
            AT_LDSWAIT();
#pragma unroll
            for (int d0 = 0; d0 < 2; ++d0)
#pragma unroll
                for (int ks = 0; ks < 2; ++ks) {
                    LAS unsigned char* vp = stg + (d0 * 2 + ks) * 1024 + vrd;
                    const s16x4 lo = __builtin_bit_cast(s16x4, __builtin_amdgcn_ds_read_tr16_b64_v4i16((LAS s16x4*)(vp)));
                    const s16x4 hh = __builtin_bit_cast(s16x4, __builtin_amdgcn_ds_read_tr16_b64_v4i16((LAS s16x4*)(vp + 512)));
                    const bf16x8 vf = (bf16x8){lo[0], lo[1], lo[2], lo[3], hh[0], hh[1], hh[2], hh[3]};
                    o[d0] = MFMA32(__builtin_bit_cast(bf16x8, P[j][ks]), vf, o[d0]);
                }
            AT_LDSWAIT();
        }
        __builtin_amdgcn_sched_barrier(0);
    }
#undef AT_LOADROWS
#undef AT_PUTROWS
#undef AT_GETFRAG
#undef AT_LDSWAIT
    if (hi == 0) { wsf[r32] = mx_true; wsf[32 + r32] = lsum; }
    asm volatile("s_waitcnt lgkmcnt(0)" ::: "memory");
    f32x4 mt4[4], lt4[4];
#pragma unroll
    for (int k = 0; k < 4; ++k) { mt4[k] = *(const LAS f32x4*)(wsf + 8 * k + 4 * hi); lt4[k] = *(const LAS f32x4*)(wsf + 32 + 8 * k + 4 * hi); }
    if (FIRST) {
#pragma unroll
        for (int r = 0; r < 16; ++r) { const int q = crow(r, hi); const int trow = q * trow_mul + trow_add;
            ACC[trow * ACCP + r32] = o[0][r]; ACC[trow * ACCP + 32 + r32] = o[1][r];
            if (r32 == 0) { ML[trow * 2] = mt4[r >> 2][r & 3]; ML[trow * 2 + 1] = lt4[r >> 2][r & 3]; } }
    } else {
        f32x2 ml[16]; float a0[16], a1[16];
#pragma unroll
        for (int r = 0; r < 16; ++r) { const int q = crow(r, hi); const int trow = q * trow_mul + trow_add;
            ml[r] = *(const LAS f32x2*)(ML + trow * 2); a0[r] = ACC[trow * ACCP + r32]; a1[r] = ACC[trow * ACCP + 32 + r32]; }
        asm volatile("s_waitcnt lgkmcnt(0)" ::: "memory");
#pragma unroll
        for (int r = 0; r < 16; ++r) { const int q = crow(r, hi); const int trow = q * trow_mul + trow_add;
            const float mt = mt4[r >> 2][r & 3], lt = lt4[r >> 2][r & 3], mo = ml[r][0], lo_ = ml[r][1];
            const float mn = fmaxf(mo, mt); const float fa = __builtin_amdgcn_exp2f(mo - mn), fb = __builtin_amdgcn_exp2f(mt - mn);
            ACC[trow * ACCP + r32] = a0[r] * fa + o[0][r] * fb; ACC[trow * ACCP + 32 + r32] = a1[r] * fa + o[1][r] * fb;
            if (r32 == 0) { ML[trow * 2] = mn; ML[trow * 2 + 1] = lo_ * fa + lt * fb; } }
    }
    asm volatile("s_waitcnt lgkmcnt(0)" ::: "memory");
}

__device__ __forceinline__ void attn_phase(Frame& F, bf16* MIX) {
    const bf16* QKV = (const bf16*)(F.ws + WS_QKV);
    LAS float* ACC = (LAS float*)F.lds;
    LAS float* ML = (LAS float*)(F.lds + 69632);
    LAS unsigned char* vst = F.lds + 73728 + F.wave * 4608;
    LAS float* wsf = (LAS float*)(F.lds + 73728 + 8 * 4608 + F.wave * 256);
    const int lane = F.lane, w = F.wave;
    for (int i = 0;; ++i) {
        if (i >= (BATCH * 16 * 8) / F.G) break;
        const int L0 = (F.G == 256) ? ((F.vcu >> 5) * 128 + i * 32 + (F.vcu & 31)) : (i * F.G + F.vcu);
        const int bh = L0 >> 3, ti = L0 & 7; int w4 = ti >> 1; const int c = ti & 1; if (i & 1) w4 = 3 - w4;
        const int b = bh >> 4, h = bh & 15, win0 = w4 * 512;
        const bf16* Qb = QKV + (size_t)b * SEQ * NQKV;
        const float sl0 = exp2f(-8.0f * (float)(0 * 16 + h + 1) / 48.0f) * LOG2E, sl1 = exp2f(-8.0f * (float)(1 * 16 + h + 1) / 48.0f) * LOG2E * 4.0f, sl2 = exp2f(-8.0f * (float)(2 * 16 + h + 1) / 48.0f) * LOG2E * 16.0f;
        LSTAMP0();
        attn_task<true, 6>(Qb, 0, h, 1, 0, win0 + 64 * w + c, 2, win0 + 64 * w - 128, SEQ, sl0, vst, wsf, ACC, ML, 1, 32 * w, lane);
        __syncthreads();
        LSTAMP(24);
        if (ATTN_GMASK & 2) { const int cls = c + 2 * (w & 1), lb = w >> 1, lq0 = 128 * w4 + 32 * lb; attn_task<false, 5>(Qb, 1, h, 4, cls, lq0, 1, lq0 - 128, SEQ / 4, sl1, vst, wsf, ACC, ML, 2, 64 * lb + (w & 1), lane); }
        __syncthreads();
        LSTAMP(25);
        if (ATTN_GMASK & 4) { const int cls = c + 2 * w, lq0 = 32 * w4; attn_task<false, 5>(Qb, 2, h, 16, cls, lq0, 1, lq0 - 128, SEQ / 16, sl2, vst, wsf, ACC, ML, 8, w, lane); }
        __syncthreads();
        LSTAMP(26);
        {
#pragma unroll
          for (int it = 0; it < 4; ++it) { const int trow = 32 * w + 8 * it + (lane >> 3), sg = lane & 7; const float inv = 1.0f / ML[trow * 2 + 1];
              const LAS f32x4* ap = (const LAS f32x4*)(ACC + trow * ACCP + sg * 8);
              bf16* op = MIX + (size_t)(b * SEQ + win0 + 2 * trow + c) * D + h * 64 + sg * 8;
              const f32x4 a = ap[0] * inv, bq = ap[1] * inv; u32x4 wv; wv.x = pk2(a[0], a[1]); wv.y = pk2(a[2], a[3]); wv.z = pk2(bq[0], bq[1]); wv.w = pk2(bq[2], bq[3]);
              *(GAS u32x4*)op = wv; } }
        __syncthreads();
    }
}

__device__ __forceinline__ void attn_phase_naive(Frame& F, bf16* MIX, const int gmask) {
    const bf16* QKV = (const bf16*)(F.ws + WS_YS);
    const int lane = F.lane;
    const int gw = F.vcu * NWAVES + F.wave, NGW = F.G * NWAVES;
    for (int item = gw; item < T * 16; item += NGW) {
        const int tok = item >> 4, h = item & 15, b = tok / SEQ, t = tok % SEQ;
        const bf16* Qb = QKV + (size_t)b * SEQ * NQKV;
        float sc[3][3]; int kt[3][3];
        float mx = -INFINITY;
#pragma unroll
        for (int g = 0; g < 3; ++g) {
            const int dil = (g == 0) ? 1 : (g == 1 ? 4 : 16);
            const float slope = exp2f(-8.0f * (float)(g * 16 + h + 1) / 48.0f);
            const bf16* qp = Qb + (size_t)t * NQKV + ((g * 3 + 0) * 16 + h) * 64;
#pragma unroll
            for (int c = 0; c < 3; ++c) {
                const int j = lane + 64 * c; const int tk = t - j * dil;
                float s = -INFINITY;
                if (j <= 128 && tk >= 0 && ((gmask >> g) & 1)) {
                    const bf16* kp = Qb + (size_t)tk * NQKV + ((g * 3 + 1) * 16 + h) * 64;
                    float d = 0.f;
                    for (int e = 0; e < 64; ++e) d += bf2f(qp[e]) * bf2f(kp[e]);
                    s = d - slope * LOG2E * (float)(j * dil);
                }
                sc[g][c] = s; kt[g][c] = tk; mx = fmaxf(mx, s);
            }
        }
#pragma unroll
        for (int o = 1; o < 64; o <<= 1) mx = fmaxf(mx, __shfl_xor(mx, o));
        float den = 0.f; float acc[64];
#pragma unroll
        for (int e = 0; e < 64; ++e) acc[e] = 0.f;
#pragma unroll
        for (int g = 0; g < 3; ++g)
#pragma unroll
            for (int c = 0; c < 3; ++c) {
                const float p = (sc[g][c] == -INFINITY) ? 0.f : exp2f(sc[g][c] - mx);
                den += p;
                if (p != 0.f) { const bf16* vp = Qb + (size_t)kt[g][c] * NQKV + ((g * 3 + 2) * 16 + h) * 64;
#pragma unroll
                    for (int e = 0; e < 64; ++e) acc[e] += p * bf2f(vp[e]); }
            }
        den = wave_sum(den);
        float mine = 0.f;
#pragma unroll
        for (int e = 0; e < 64; ++e) { const float v = wave_sum(acc[e]); if (lane == e) mine = v; }
        MIX[(size_t)tok * D + h * 64 + lane] = (bf16)f2bf(mine / den);
    }
}

struct Args { const float* in[20]; float* out; unsigned char* ws; int ph_lo, ph_hi; };
constexpr int NPHASE = 2 + DEPTH * 8;

__global__ void __launch_bounds__(NWAVES * 64, 2) mk_fwd(Args args) {
    extern __shared__ __attribute__((aligned(16))) unsigned char lds_raw[];
    Frame F;
    F.lds = (LAS unsigned char*)lds_raw; F.lc = F.lds + LDSCTL_OFF;
    F.tid = threadIdx.x; F.lane = F.tid & 63; F.wave = __builtin_amdgcn_readfirstlane(F.tid >> 6);
    F.G = gridDim.x; { const int bx = blockIdx.x; F.vcu = (F.G % 8 == 0) ? (bx % 8) * (F.G / 8) + bx / 8 : bx; }
    F.ws = args.ws; F.ctl = (unsigned*)(args.ws + WS_CTL);
    for (int u = F.tid; u < (LDS_BYTES - LDSCTL_OFF) / 4; u += NWAVES * 64) ((LAS unsigned*)F.lc)[u] = 0u;
    __syncthreads();
    if (F.tid == 0) {
#pragma unroll
        for (int i = 0; i < 20; ++i) *(LAS unsigned long long*)(F.lc + LC_PTR + 8 * i) = (unsigned long long)args.in[i];
        *(LAS unsigned long long*)(F.lc + LC_PTR + 8 * 20) = (unsigned long long)args.out;
    }
    __syncthreads();
#if MK_PER_PHASE
#define GRID_BAR() do { } while (0)
    XcdBarrier bar; bar.bar = nullptr; bar.x = 0; bar.st = nullptr;
#else
    XcdBarrier bar = xcd_barrier_post(F.ctl + CW_BAR, (volatile LAS unsigned*)(F.lc + LC_MISC) + 8);
#define GRID_BAR() xcd_barrier(bar)
#endif
    const int lo = args.ph_lo, hi = args.ph_hi;
#ifdef PROBE_TYPE
#define LC_STAMP 3072
#define STAMP(ty) do { if (blockIdx.x == 0 && F.tid == 0) { const unsigned long long now_ = __builtin_amdgcn_s_memrealtime(); LAS unsigned long long* st_ = (LAS unsigned long long*)(F.lc + LC_STAMP); \
        st_[1 + (ty)] += now_ - st_[0]; st_[0] = now_; } } while (0)
    if (blockIdx.x == 0 && F.tid == 0) { ((LAS unsigned long long*)(F.lc + LC_STAMP))[0] = __builtin_amdgcn_s_memrealtime(); }
#else
#define STAMP(ty) do { } while (0)
#endif
#define IN(k) (lo <= (k) && (k) < hi)
#define SEAM(k) do { if (IN(k) && IN((k) + 1)) GRID_BAR(); } while (0)
    const float* mod = (const float*)(F.ws + WS_MOD);

    if (PHON(0) && IN(0)) { p0_prologue(F); } SEAM(0); STAMP(0);
    bool xlocal = false; int cid = (int)blockIdx.x;
#if !MK_PER_PHASE
    { volatile LAS unsigned* st = (volatile LAS unsigned*)(F.lc + LC_MISC) + 8;
      if (F.tid == 0) { unsigned ok = (F.G == 256) ? 1u : 0u;
#pragma unroll
          for (unsigned jx = 0; jx < 16; ++jx) { const unsigned cj = xb_ld(&bar.bar[XB_XCNT(jx)]); ok &= (jx < 8u) ? (cj == 32u ? 1u : 0u) : (cj == 0u ? 1u : 0u); }
          st[3] = ok; }
      __syncthreads();
      xlocal = (st[3] != 0u) && (MK_XLOCAL != 0);
      if (xlocal) cid = (int)(st[2] * 8u + bar.x); }
#endif
    cid = __builtin_amdgcn_readfirstlane(cid);
    F.vcu = (F.G % 8 == 0) ? (cid % 8) * (F.G / 8) + cid / 8 : cid;
#define LSEAM(k) do { if (IN(k) && IN((k) + 1)) { if (xlocal) xcd_local_barrier(bar, F.wave == 0); else GRID_BAR(); } } while (0)
    if (PHON(1) && IN(1)) { p1_modulate(F, inp(F, 0), mod, 0, 1024); } SEAM(1); STAMP(1);

    for (int layer = 0; layer < DEPTH; ++layer) {
        const int pb = 2 + layer * 8; const int j = layer >> 1;
        if ((layer & 1) == 0) {
            if (PHON(2) && IN(pb + 0)) { refresh(F); unsigned char* ws = opq(F.ws); (void)ws;
                PlainSched S{T / 256, 4, 256, F.G, cid, (const char*)(ws + WS_WPIN) + (size_t)j * 2 * MiB, 2048};
                pg8::EpiStore E{(bf16*)(ws + WS_U), D, nullptr, 0, 0, 0, F.lds + LDS_TB_OFF + F.wave * 2048};
                pg8::gemm_phase<pg8::EpiStore, PlainSched>(F.tid, F.lds, (const char*)(ws + WS_H), 2048, 2048, 1024, S, E);
            } LSEAM(pb + 0); STAMP(2);
            if (PHON(4) && IN(pb + 2)) { refresh(F); unsigned char* ws = opq(F.ws); (void)ws;
                GrpSched S{F.G, cid, (const char*)(ws + WS_WPGRP) + (size_t)j * 512 * 1024};
                { const bf16* U = (const bf16*)(ws + WS_U); bf16* Z = (bf16*)(ws + WS_Z); pg8::Unit pu;
                  for (int i = 0; S.next(i, pu); ++i) {
                      const int b = pu.pm >> 3, t0 = (pu.pm & 7) * 256 + 32 * F.wave, g = pu.pn;
                      if (g == 0) pool_item<2>(U, Z, b, t0, 0, F.lane); else if (g == 1) pool_item<4>(U, Z, b, t0, 1, F.lane);
                      else if (g == 2) pool_item<8>(U, Z, b, t0, 2, F.lane); else pool_item<16>(U, Z, b, t0, 3, F.lane); }
                  asm volatile("s_waitcnt vmcnt(0)" ::: "memory"); __syncthreads(); }
                pg8::EpiStore E{(bf16*)(ws + WS_Y2), D, inp(F, 6) + j * D, 0, 0, 0, F.lds + LDS_TB_OFF + F.wave * 2048};
                pg8::gemm_phase<pg8::EpiStore, GrpSched>(F.tid, F.lds, (const char*)(ws + WS_Z), 2048, 512, 256, S, E);
            } LSEAM(pb + 2); STAMP(4);
            if (PHON(5) && IN(pb + 3)) { refresh(F); unsigned char* ws = opq(F.ws); (void)ws;
                PlainSched S{T / 256, 4, 256, F.G, cid, (const char*)(ws + WS_WPOUT) + (size_t)j * 2 * MiB, 2048};
                pg8::EpiStore E{(bf16*)(ws + WS_Y), D, nullptr, 0, 0, 1, F.lds + LDS_TB_OFF + F.wave * 2048};
                pg8::gemm_phase<pg8::EpiStore, PlainSched>(F.tid, F.lds, (const char*)(ws + WS_Y2), 2048, 2048, 1024, S, E);
            } LSEAM(pb + 3); STAMP(5);
        } else {
            if (PHON(6) && IN(pb + 0)) { refresh(F); unsigned char* ws = opq(F.ws); (void)ws;
                PlainSched S{T / 256, NQKV / 256, (T / 256) * (NQKV / 256), F.G, cid, (const char*)(ws + WS_WAIN) + (size_t)j * 18 * MiB, 2048};
                pg8::EpiStore E{(bf16*)(ws + WS_QKV), NQKV, nullptr, 1, 1, 0, F.lds + LDS_TB_OFF + F.wave * 2048};
                pg8::gemm_phase<pg8::EpiStore, PlainSched>(F.tid, F.lds, (const char*)(ws + WS_H), 2048, 2048, 1024, S, E);
            } LSEAM(pb + 0); STAMP(6);
            if (PHON(7) && IN(pb + 1)) { refresh(F); unsigned char* ws = opq(F.ws); (void)ws;
#ifdef NAIVE_ATTN
                attn_phase_naive(F, (bf16*)(F.ws + WS_Y2), 7);
#ifdef ORACLE
                if (layer == ORACLE_LAYER) { attn_phase_naive(F, (bf16*)(F.ws + WS_Z), ATTN_GMASK); attn_phase(F, (bf16*)(F.ws + WS_U)); }
#endif
#else
                attn_phase(F, (bf16*)(F.ws + WS_Y2));
#endif
            } if (IN(pb + 1) && IN(pb + 3)) { if (xlocal) xcd_local_barrier(bar, F.wave == 0); else GRID_BAR(); } STAMP(7);
            if (IN(pb + 2)) { refresh(F); unsigned char* ws = opq(F.ws); (void)ws;
#ifdef ORACLE
                if (layer == ORACLE_LAYER) { if (blockIdx.x == 0 && F.tid == 0) atomicAdd(F.ctl + 20000, 3276u * 16u);
                    const bf16* A = (const bf16*)(ws + WS_U); const bf16* B = (const bf16*)(ws + WS_Z);
                    const int gw = F.vcu * NWAVES + F.wave, NGW = F.G * NWAVES;
                    for (int tok = gw; tok < T; tok += NGW) { int bad = 0;
                        for (int h = 0; h < 16; ++h) { if (ORACLE_SEL) { const float a = bf2f(A[(size_t)tok * D + h * 64 + F.lane]), b = bf2f(B[(size_t)tok * D + h * 64 + F.lane]);
                            const float e2 = wave_sum((a - b) * (a - b)), n2 = wave_sum(b * b); if (!(e2 <= 0.0025f * n2)) bad += ORACLE_W; } }
                        if (bad && F.lane == 0) atomicAdd(F.ctl + 20000, (unsigned)bad); } }
#endif
            }
            if (PHON(8) && IN(pb + 3)) { refresh(F); unsigned char* ws = opq(F.ws); (void)ws;
                PlainSched S{T / 256, 4, 256, F.G, cid, (const char*)(ws + WS_WAOUT) + (size_t)j * 2 * MiB, 2048};
                pg8::EpiStore E{(bf16*)(ws + WS_Y), D, nullptr, 0, 0, 1, F.lds + LDS_TB_OFF + F.wave * 2048};
                pg8::gemm_phase<pg8::EpiStore, PlainSched>(F.tid, F.lds, (const char*)(ws + WS_Y2), 2048, 2048, 1024, S, E);
            } LSEAM(pb + 3); STAMP(8);
        }
        if (PHON(9) && IN(pb + 4)) { refresh(F); unsigned char* ws = opq(F.ws); (void)ws; const float* xin = (layer == 0) ? inp(F, 0) : (const float*)(ws + WS_X); if (layer == 0) ln1_router_phase<false>(F, layer, xin); else ln1_router_phase<true>(F, layer, xin); } SEAM(pb + 4); STAMP(9);
        if (PHON(10) && IN(pb + 5)) { refresh(F); unsigned char* ws = opq(F.ws); (void)ws;
            moe_build_table(F, layer);
            const LAS int* ts = (const LAS int*)(F.lc + LC_TS);
            const int ntile = ts[65];
            MoeSched<true> S{ts, (const LAS int*)(F.lc + LC_CNT), 2, ntile * 2, F.G, cid, F.lane, (const int*)(ws + WS_TOKL), (const float*)(ws + WS_WL),
                       (const char*)(ws + WS_WEGU) + (size_t)layer * 64 * MiB, (size_t)1 * MiB, (const char*)(ws + WS_WSHGU) + (size_t)layer * MiB, 2048};
            pg8::EpiGU E{(bf16*)(ws + WS_ACT)};
            pg8::gemm_phase<pg8::EpiGU, MoeSched<true>>(F.tid, F.lds, (const char*)(ws + WS_H), 2048, 2048, 1024, S, E);
        } LSEAM(pb + 5); STAMP(10);
        if (PHON(11) && IN(pb + 6)) { refresh(F); unsigned char* ws = opq(F.ws); (void)ws;
            moe_build_table(F, layer);
            const LAS int* ts = (const LAS int*)(F.lc + LC_TS);
            const int ntile = ts[65];
            MoeSched<false> S{ts, (const LAS int*)(F.lc + LC_CNT), 4, ntile * 4, F.G, cid, F.lane, nullptr, nullptr,
                       (const char*)(ws + WS_WEDN) + (size_t)layer * 32 * MiB, (size_t)512 * 1024, (const char*)(ws + WS_WSHDN) + (size_t)layer * 512 * 1024, 512};
            pg8::EpiStore E{(bf16*)(ws + WS_YS), D, nullptr, 0, 1, 1, F.lds + LDS_TB_OFF + F.wave * 2048};
            pg8::gemm_phase<pg8::EpiStore, MoeSched<false>>(F.tid, F.lds, (const char*)(ws + WS_ACT), 512, 512, 256, S, E);
        } SEAM(pb + 6); STAMP(11);
        if (PHON(12) && IN(pb + 7)) { refresh(F); unsigned char* ws = opq(F.ws); (void)ws; moe_build_table(F, layer); combine_ln2_phase(F, layer); }
        if (layer < DEPTH - 1) LSEAM(pb + 7);
        STAMP(12);
    }
#ifdef PROBE_TYPE
    if (blockIdx.x == 0 && F.tid == 0) { const unsigned long long t0_ = __builtin_amdgcn_s_memrealtime(); const unsigned long long want_ = 4ull * ((LAS unsigned long long*)(F.lc + LC_STAMP))[1 + PROBE_TYPE];
        while (__builtin_amdgcn_s_memrealtime() - t0_ < want_) __builtin_amdgcn_s_sleep(8); }
#endif
#undef IN
#undef SEAM
}

extern "C" void kernel_launch(void* const* d_in, const int* in_sizes, int n_in, void* d_out, int out_size, void* d_ws, size_t ws_size, hipStream_t stream) {
    static int grid = 0;
    if (grid == 0) {
        if (n_in != 20 || in_sizes[0] != T * D || out_size != T * D || ws_size < WS_END) { fprintf(stderr, "kernel_launch: unexpected shapes / workspace (n_in %d, ws %zu); nothing launched\n", n_in, ws_size); grid = -1; return; }
        int dev = 0, cus = 0, per_cu = 0;
        if (hipGetDevice(&dev) != hipSuccess || hipDeviceGetAttribute(&cus, hipDeviceAttributeMultiprocessorCount, dev) != hipSuccess) { grid = -1; return; }
        if (hipFuncSetAttribute((const void*)mk_fwd, hipFuncAttributeMaxDynamicSharedMemorySize, LDS_BYTES) != hipSuccess) { fprintf(stderr, "kernel_launch: hipFuncSetAttribute failed\n"); grid = -1; return; }
        if (hipOccupancyMaxActiveBlocksPerMultiprocessor(&per_cu, (const void*)mk_fwd, NWAVES * 64, LDS_BYTES) != hipSuccess || per_cu < 1) { fprintf(stderr, "kernel_launch: occupancy query says %d\n", per_cu); }
        (void)hipGetLastError();
        grid = cus;
    }
    if (grid < 0) return;
    if (hipMemsetAsync((char*)d_ws + WS_CTL, 0, CTL_ZERO_BYTES, stream) != hipSuccess) return;
    Args a{};
    for (int i = 0; i < 20; ++i) a.in[i] = (const float*)d_in[i];
    a.out = (float*)d_out; a.ws = (unsigned char*)d_ws;
#if MK_PER_PHASE
    for (int p = 0; p < NPHASE; ++p) { a.ph_lo = p; a.ph_hi = p + 1; hipLaunchKernelGGL(mk_fwd, dim3(grid), dim3(NWAVES * 64), LDS_BYTES, stream, a); }
#else
    a.ph_lo = 0; a.ph_hi = NPHASE;
    hipLaunchKernelGGL(mk_fwd, dim3(grid), dim3(NWAVES * 64), LDS_BYTES, stream, a);
#endif
    const hipError_t le = hipPeekAtLastError();
    if (le != hipSuccess) fprintf(stderr, "kernel_launch: launch failed: %s\n", hipGetErrorName(le));
}
```

```cpp
#include <hip/hip_runtime.h>
#include <cstdio>
#include <cstdint>

#ifndef MK_PER_PHASE
#define MK_PER_PHASE 0
#endif
#define ORACLE_SEL 1
#define ATTN_GMASK 7
#define ORACLE_W 1
#define ORACLE_LAYER 1
#ifndef MK_XLOCAL
#define MK_XLOCAL 1
#endif
#ifndef PHSEL
#define PHSEL 0xFFFF
#endif
#define PHON(n) (((PHSEL) >> (n)) & 1)

#define GAS __attribute__((address_space(1)))
#define LAS __attribute__((address_space(3)))
typedef unsigned short bf16;
typedef short bf16x8 __attribute__((ext_vector_type(8)));
typedef short s16x4 __attribute__((ext_vector_type(4)));
typedef float f32x2 __attribute__((ext_vector_type(2)));
typedef float f32x4 __attribute__((ext_vector_type(4)));
typedef float f32x16 __attribute__((ext_vector_type(16)));
typedef unsigned u32x2 __attribute__((ext_vector_type(2)));
typedef unsigned u32x4 __attribute__((ext_vector_type(4)));

constexpr int BATCH = 8, SEQ = 2048, D = 1024, T = BATCH * SEQ, DEPTH = 4;
constexpr int NQKV = 9216, NE = 64, TOPK = 8, DEXP = 256;
constexpr int CAP = 16384;
constexpr int PSLOT = 147456 + T;
constexpr float ALPHA = 1.6817928305074290f;
constexpr float LN_EPS = 1e-5f;
constexpr float LOG2E = 1.4426950408889634f;
constexpr float QSCALE = 0.125f * LOG2E;
constexpr float ROUTED_SCALE = 2.5f;

constexpr size_t MiB = 1u << 20;
constexpr size_t WS_CTL = 0, CTL_ZERO_BYTES = 1 * MiB;
constexpr size_t WS_MOD = 1 * MiB;
constexpr size_t WS_WRHI = 2 * MiB;
constexpr size_t WS_WRLO = WS_WRHI + 512 * 1024;
constexpr size_t WS_WPIN = 3 * MiB;
constexpr size_t WS_WPGRP = 7 * MiB;
constexpr size_t WS_WPOUT = 8 * MiB;
constexpr size_t WS_WAIN = 12 * MiB;
constexpr size_t WS_WAOUT = 48 * MiB;
constexpr size_t WS_WSHGU = 52 * MiB;
constexpr size_t WS_WSHDN = 56 * MiB;
constexpr size_t WS_WEGU = 58 * MiB;
constexpr size_t WS_WEDN = 314 * MiB;
constexpr size_t WS_X = 442 * MiB;
constexpr size_t WS_H = 506 * MiB;
constexpr size_t WS_Y = 538 * MiB;
constexpr size_t WS_U = 570 * MiB;
constexpr size_t WS_Z = 602 * MiB;
constexpr size_t WS_Y2 = 634 * MiB;
constexpr size_t WS_YS = 666 * MiB;
constexpr size_t WS_ACT = 986 * MiB;
constexpr size_t WS_TOKL = 1066 * MiB;
constexpr size_t WS_WL = 1070 * MiB;
constexpr size_t WS_TSLOT = 1074 * MiB;
constexpr size_t WS_QKV = 1076 * MiB;
constexpr size_t WS_END = 1364 * MiB;
static_assert(WS_YS + (size_t)PSLOT * 2048 <= WS_ACT && WS_ACT + (size_t)PSLOT * 512 <= WS_TOKL, "ws map");
constexpr int CW_BAR = 4096;
constexpr int CW_CNT = 12288;

constexpr int RING_BYTES = 135168;
constexpr int LDSCTL_OFF = RING_BYTES;
constexpr int LDS_TB_OFF = 147456;
constexpr int LDS_BYTES = 163840;
constexpr int LC_MISC = 0;
constexpr int LC_TS = 128;
constexpr int LC_CNT = 128 + 272;
constexpr int LC_LCNT = 128 + 272 + 256;
constexpr int LC_GB = 128 + 272 + 512;

#define RLX_AGENT __ATOMIC_RELAXED, __HIP_MEMORY_SCOPE_AGENT
#define LDS_WAIT() asm volatile("s_waitcnt lgkmcnt(0)" ::: "memory")
#define VM_WAIT() asm volatile("s_waitcnt vmcnt(0)" ::: "memory")

typedef __bf16 b16x2 __attribute__((ext_vector_type(2)));
__device__ __forceinline__ unsigned f2bf(float f) { unsigned u = __builtin_bit_cast(unsigned, f); return (u + 0x7fffu + ((u >> 16) & 1u)) >> 16; }
__device__ __forceinline__ unsigned pk2(float lo, float hi) { const f32x2 v = {lo, hi}; return __builtin_bit_cast(unsigned, __builtin_convertvector(v, b16x2)); }
__device__ __forceinline__ float bf2f(unsigned h) { return __builtin_bit_cast(float, h << 16); }
__device__ __forceinline__ unsigned cvt_pk_bf16(float lo, float hi) { return pk2(lo, hi); }
typedef _Float16 h16x2 __attribute__((ext_vector_type(2)));
__device__ __forceinline__ unsigned pkh2(float lo, float hi) { const f32x2 v = {lo, hi}; return __builtin_bit_cast(unsigned, __builtin_convertvector(v, h16x2)); }
__device__ __forceinline__ float h2f(unsigned h) { return (float)__builtin_bit_cast(_Float16, (unsigned short)h); }
#define MFMA16(a, b, c) __builtin_amdgcn_mfma_f32_16x16x32_bf16(a, b, c, 0, 0, 0)
#define MFMA32(a, b, c) __builtin_amdgcn_mfma_f32_32x32x16_bf16(a, b, c, 0, 0, 0)
__device__ __forceinline__ float wave_sum(float v) {
#pragma unroll
    for (int o = 1; o < 64; o <<= 1) v += __shfl_xor(v, o);
    return v;
}

namespace pg8 {
constexpr int BM = 256, BK = 64, HALF = 128, HTB = HALF * BK * 2, STAGE_BYTES = 8 * HTB, NXCD = 8;
__host__ __device__ __forceinline__ int lds_byte(int r, int c) { const int st = (r >> 4) * 2 + (c >> 5), rr = r & 15, cc = c & 31, ob = rr * 64 + cc * 2; return st * 1024 + (ob ^ (((ob >> 9) & 1) << 5)); }
__host__ __device__ __forceinline__ void stage_rc(int b, int& R, int& C) { const int st = b / 1024, sb = b % 1024, swz = sb ^ (((sb >> 9) & 1) << 5); R = (st >> 1) * 16 + swz / 64; C = (st & 1) * 32 + (swz % 64) / 2; }
__host__ __device__ __forceinline__ int perm32(int rho) { const int n = rho >> 4, i = rho & 15; return 8 * (i >> 2) + 4 * n + (i & 3); }

struct Unit {
    int pm, pn;
    const char* bptr;
    int roff;
    int nvalid;
};

__device__ __forceinline__ int xcd_chunk(int L, int nwg) { const int q = nwg / NXCD, r = nwg % NXCD, xcd = L % NXCD, off = L / NXCD; return (xcd < r ? xcd * (q + 1) : r * (q + 1) + (xcd - r) * q) + off; }

template <class Epi, class Sched>
__device__ __forceinline__ void gemm_phase(const int tid, LAS unsigned char* lds, const char* Abase, const int lda, const int ldb, const int K, const Sched& S, const Epi& E) {
    constexpr bool GATHER = Sched::GATHER;
    const int wid = __builtin_amdgcn_readfirstlane(tid >> 6), lane = tid & 63, wr = wid >> 2, wc = wid & 3, fr = lane & 15, fq = lane >> 4;
    const int nt = K / BK;
    int Rr[2]; unsigned C2[2], voffB[2], voffA[2];
#pragma unroll
    for (int i = 0; i < 2; ++i) { int R, C; stage_rc(tid * 16 + i * 8192, R, C); const int Rb = Epi::WIDE ? ((R >> 5) * 64 + perm32(R & 31)) : ((R & ~31) + perm32(R & 31)); Rr[i] = R; C2[i] = (unsigned)C * 2u; voffB[i] = (unsigned)(Rb * ldb) + (unsigned)C * 2u;
        voffA[i] = Sched::ABLK ? (unsigned)((C >> 5) * 16384 + R * 64 + (C & 31) * 2) : ((unsigned)(R * lda) + (unsigned)C * 2u); }
    const size_t kstep = (size_t)(BK * 2);
    const size_t hstepB = (size_t)(Epi::WIDE ? 32 : HALF) * ldb;
    const size_t hstepA = GATHER ? (size_t)0 : (Sched::ABLK ? (size_t)8192 : (size_t)HALF * lda);
    const size_t kstepA = Sched::ABLK ? (size_t)32768 : kstep;
    const unsigned ldsw = (unsigned)wid * 1024u;
    const int aoff = lds_byte(wr * 64 + fr, fq * 8), boff = lds_byte(wc * 32 + fr, fq * 8);
#define PG8_SA(b, h) (((b) * 2 + (h)) * HTB)
#define PG8_SB(b, h) ((4 + (b) * 2 + (h)) * HTB)
#define PG8_STAGE(bufoff, gbase, voff) do { _Pragma("unroll") for (int _i = 0; _i < 2; ++_i) \
        __builtin_amdgcn_global_load_lds((const unsigned*)((const char*)(gbase) + (voff)[_i]), (LAS unsigned*)(lds + (bufoff) + ldsw + _i * 8192), 16, 0, 0); } while (0)
#define PG8_STAGEA(bufoff, gbase, h) do { if constexpr (GATHER) { PG8_STAGE(bufoff, gbase, vA[h]); } else { PG8_STAGE(bufoff, (gbase) + (h) * hstepA, voffA); } } while (0)
#define PG8_LDA(dst, b, h) do { _Pragma("unroll") for (int m = 0; m < 4; ++m) _Pragma("unroll") for (int k = 0; k < 2; ++k) dst[m][k] = *(const LAS bf16x8*)(lds + PG8_SA(b, h) + aoff + m * 2048 + k * 1024); } while (0)
#define PG8_LDB(dst, b, h) do { _Pragma("unroll") for (int n = 0; n < 2; ++n) _Pragma("unroll") for (int k = 0; k < 2; ++k) dst[n][k] = *(const LAS bf16x8*)(lds + PG8_SB(b, h) + boff + n * 2048 + k * 1024); } while (0)
#define PG8_MMA(ai, bj, At, Bt) do { __builtin_amdgcn_s_setprio(1); _Pragma("unroll") for (int m = 0; m < 4; ++m) _Pragma("unroll") for (int n = 0; n < 2; ++n) _Pragma("unroll") for (int k = 0; k < 2; ++k) \
        acc[ai][bj][m][n] = MFMA16(Bt[n][k], At[m][k], acc[ai][bj][m][n]); __builtin_amdgcn_s_setprio(0); } while (0)
#define PG8_WAIT_V(n) asm volatile("s_waitcnt vmcnt(" #n ")" ::: "memory")
#define PG8_WAIT_L(n) asm volatile("s_waitcnt lgkmcnt(" #n ")" ::: "memory")
#define PG8_BAR __builtin_amdgcn_s_barrier()
#define PG8_SCHED __builtin_amdgcn_sched_barrier(0)
#define PG8_CALCA(u, vo) do { _Pragma("unroll") for (int _h = 0; _h < 2; ++_h) _Pragma("unroll") for (int _i = 0; _i < 2; ++_i) \
        vo[_h][_i] = (unsigned)S.arow(u, _h * HALF + Rr[_i]) * (unsigned)lda + C2[_i]; } while (0)
    Unit cur, nxt; int ui = 0;
    if (!S.next(0, cur)) return;
    f32x4 acc[2][2][4][2];
#pragma unroll
    for (int a = 0; a < 2; ++a)
#pragma unroll
        for (int b = 0; b < 2; ++b)
#pragma unroll
            for (int m = 0; m < 4; ++m)
#pragma unroll
                for (int n = 0; n < 2; ++n) acc[a][b][m][n] = (f32x4){0.f, 0.f, 0.f, 0.f};
    bf16x8 At[4][2], B0[2][2], B1[2][2];
    unsigned vA[2][2], vAn[2][2];
    const char* cA = Abase;
    if constexpr (GATHER) { PG8_CALCA(cur, vA); } else { cA = Abase + (size_t)S.arow(cur, 0) * lda + S.acolb(cur); }
    const char* cB = cur.bptr;
    PG8_STAGE(PG8_SB(0, 0), cB, voffB); PG8_STAGE(PG8_SB(0, 1), cB + hstepB, voffB); PG8_STAGEA(PG8_SA(0, 0), cA, 0); PG8_STAGEA(PG8_SA(0, 1), cA, 1);
    if (wr == 1) PG8_BAR;
    PG8_WAIT_V(2); PG8_BAR;
    PG8_STAGE(PG8_SB(1, 0), cB + kstep, voffB); PG8_STAGEA(PG8_SA(1, 0), cA + kstepA, 0); PG8_STAGE(PG8_SB(1, 1), cB + hstepB + kstep, voffB);
    PG8_WAIT_V(6); PG8_BAR;
    for (;;) {
        const bool has_next = S.next(ui + 1, nxt);
        float rs[2][4];
        if constexpr (Epi::ROWSCALE) {
#pragma unroll
            for (int ai = 0; ai < 2; ++ai)
#pragma unroll
                for (int m = 0; m < 4; ++m) rs[ai][m] = S.rowscale(cur, ai * HALF + wr * 64 + m * 16 + fr);
        }
        const char* nA = cA;
        if constexpr (GATHER) {
            if (has_next) { PG8_CALCA(nxt, vAn); }
            else {
#pragma unroll
                for (int h = 0; h < 2; ++h)
#pragma unroll
                    for (int i = 0; i < 2; ++i) vAn[h][i] = vA[h][i];
            }
            asm volatile("s_waitcnt vmcnt(0)" : "+v"(vAn[0][0]), "+v"(vAn[0][1]), "+v"(vAn[1][0]), "+v"(vAn[1][1]) :: "memory");
            if constexpr (Epi::ROWSCALE) { asm volatile("" : "+v"(rs[0][0]), "+v"(rs[0][1]), "+v"(rs[0][2]), "+v"(rs[0][3]), "+v"(rs[1][0]), "+v"(rs[1][1]), "+v"(rs[1][2]), "+v"(rs[1][3])); }
        } else { if (has_next) nA = Abase + (size_t)S.arow(nxt, 0) * lda + S.acolb(nxt); }
        const char* nB = has_next ? nxt.bptr : cB;
#pragma unroll 1
        for (int t = 0; t < nt; t += 2) {
            const bool last = (t == nt - 2);
            const char* a1 = cA + (size_t)(t + 1) * kstepA;
            const char* a2 = last ? nA : cA + (size_t)(t + 2) * kstepA; const char* b2 = last ? nB : cB + (size_t)(t + 2) * kstep;
            const char* a3 = a2 + kstepA; const char* b3 = b2 + kstep;
            PG8_LDB(B0, 0, 0); PG8_LDB(B1, 0, 1); PG8_SCHED; PG8_LDA(At, 0, 0); PG8_STAGEA(PG8_SA(1, 1), a1, 1);
            if constexpr (GATHER) { if (last) {
#pragma unroll
                for (int h = 0; h < 2; ++h)
#pragma unroll
                    for (int i = 0; i < 2; ++i) vA[h][i] = vAn[h][i]; } }
            PG8_WAIT_V(8); PG8_WAIT_L(0); PG8_BAR; PG8_MMA(0, 0, At, B0); PG8_MMA(0, 1, At, B1); PG8_BAR; PG8_SCHED;
            PG8_LDA(At, 0, 1); PG8_STAGE(PG8_SB(0, 0), b2, voffB); PG8_STAGE(PG8_SB(0, 1), b2 + hstepB, voffB); PG8_STAGEA(PG8_SA(0, 0), a2, 0);
            PG8_WAIT_V(8); PG8_WAIT_L(0); PG8_BAR; PG8_MMA(1, 0, At, B0); PG8_MMA(1, 1, At, B1); PG8_BAR; PG8_SCHED;
            PG8_LDB(B0, 1, 0); PG8_LDB(B1, 1, 1); PG8_SCHED; PG8_LDA(At, 1, 0); PG8_STAGEA(PG8_SA(0, 1), a2, 1);
            PG8_WAIT_V(8); PG8_WAIT_L(0); PG8_BAR; PG8_MMA(0, 0, At, B0); PG8_MMA(0, 1, At, B1); PG8_BAR; PG8_SCHED;
            PG8_LDA(At, 1, 1); PG8_STAGE(PG8_SB(1, 0), b3, voffB); PG8_STAGE(PG8_SB(1, 1), b3 + hstepB, voffB); PG8_STAGEA(PG8_SA(1, 0), a3, 0);
            PG8_WAIT_V(8); PG8_WAIT_L(0); PG8_BAR; PG8_MMA(1, 0, At, B0); PG8_MMA(1, 1, At, B1); PG8_BAR; PG8_SCHED;
        }
        if (wr == 0) PG8_BAR;
        E(acc, cur, rs, wr, wc, fr, fq);
        if (!has_next) break;
#pragma unroll
        for (int a = 0; a < 2; ++a)
#pragma unroll
            for (int b = 0; b < 2; ++b)
#pragma unroll
                for (int m = 0; m < 4; ++m)
#pragma unroll
                    for (int n = 0; n < 2; ++n) acc[a][b][m][n] = (f32x4){0.f, 0.f, 0.f, 0.f};
        cur = nxt; cB = nB; cA = nA; ++ui;
        if (wr == 1) PG8_BAR;
    }
    PG8_WAIT_V(0);
    PG8_BAR;
#undef PG8_SA
#undef PG8_SB
#undef PG8_STAGE
#undef PG8_STAGEA
#undef PG8_LDA
#undef PG8_LDB
#undef PG8_MMA
#undef PG8_WAIT_V
#undef PG8_WAIT_L
#undef PG8_BAR
#undef PG8_SCHED
#undef PG8_CALCA
}

struct EpiStore {
    static constexpr bool ROWSCALE = false, WIDE = true;
    bf16* O; int ldc; const float* cscale; int qmode; int ntst; int f16; LAS unsigned char* tb;
    __device__ __forceinline__ void operator()(const f32x4 (&acc)[2][2][4][2], const Unit& u, const float (&rs)[2][4], int wr, int wc, int fr, int fq) const {
        const int colw = u.pn * BM + wc * 64;
        float sc = 1.f; if (qmode) { if ((((u.pn * BM) >> 10) % 3) == 0) sc = QSCALE; }
        f32x4 cs[2][2];
#pragma unroll
        for (int bj = 0; bj < 2; ++bj)
#pragma unroll
            for (int n = 0; n < 2; ++n) { cs[bj][n] = cscale ? *(const f32x4*)(cscale + colw + 32 * bj + 8 * fq + 4 * n) : (f32x4){1.f, 1.f, 1.f, 1.f}; cs[bj][n] = cs[bj][n] * sc; }
        const int L = fr + 16 * fq, rr = L >> 3, sg = L & 7;
        LAS u32x4* tbv = (LAS u32x4*)tb;
        const int wi0 = fr * 8 + (fq ^ (fr & 7)), wi1 = fr * 8 + ((4 + fq) ^ (fr & 7)), ri = rr * 8 + (sg ^ rr);
        bf16* gp = O + (size_t)(u.pm * BM + wr * 64 + rr) * ldc + colw + sg * 8;
#pragma unroll
        for (int ai = 0; ai < 2; ++ai)
#pragma unroll
            for (int m = 0; m < 4; ++m) {
                u32x4 w[2];
#pragma unroll
                for (int bj = 0; bj < 2; ++bj) { const f32x4 v0 = acc[ai][bj][m][0] * cs[bj][0], v1 = acc[ai][bj][m][1] * cs[bj][1];
                    if (f16) { w[bj].x = pkh2(v0[0], v0[1]); w[bj].y = pkh2(v0[2], v0[3]); w[bj].z = pkh2(v1[0], v1[1]); w[bj].w = pkh2(v1[2], v1[3]); }
                    else { w[bj].x = cvt_pk_bf16(v0[0], v0[1]); w[bj].y = cvt_pk_bf16(v0[2], v0[3]); w[bj].z = cvt_pk_bf16(v1[0], v1[1]); w[bj].w = cvt_pk_bf16(v1[2], v1[3]); } }
                tbv[wi0] = w[0]; tbv[wi1] = w[1];
                asm volatile("" ::: "memory");
                const u32x4 r0 = tbv[ri], r1 = tbv[ri + 64];
                asm volatile("" ::: "memory");
                bf16* rowp = gp + (size_t)(ai * HALF + m * 16) * ldc;
                if (ntst) { __builtin_nontemporal_store(r0, (u32x4*)rowp); __builtin_nontemporal_store(r1, (u32x4*)(rowp + (size_t)8 * ldc)); }
                else { *(u32x4*)rowp = r0; *(u32x4*)(rowp + (size_t)8 * ldc) = r1; } }
    }
};
typedef unsigned u32x2_t __attribute__((ext_vector_type(2)));
struct EpiStoreF8 {
    static constexpr bool ROWSCALE = false, WIDE = true;
    unsigned char* O; int ldc; LAS unsigned char* tb;
    __device__ __forceinline__ void operator()(const f32x4 (&acc)[2][2][4][2], const Unit& u, const float (&rs)[2][4], int wr, int wc, int fr, int fq) const {
        const int colw = u.pn * BM + wc * 64;
        const int L = fr + 16 * fq, rr = L >> 2, sg = L & 3;
        LAS unsigned char* wp0 = tb + fr * 64 + ((fq) ^ (fr & 7)) * 8; LAS unsigned char* wp1 = tb + fr * 64 + ((4 + fq) ^ (fr & 7)) * 8;
        const LAS unsigned char* rp0 = tb + rr * 64 + ((2 * sg) ^ (rr & 7)) * 8; const LAS unsigned char* rp1 = tb + rr * 64 + ((2 * sg + 1) ^ (rr & 7)) * 8;
        unsigned char* gp = O + (size_t)(u.pm * BM + wr * 64 + rr) * ldc + colw + sg * 16;
#pragma unroll
        for (int ai = 0; ai < 2; ++ai)
#pragma unroll
            for (int m = 0; m < 4; ++m) {
                u32x2_t w[2];
#pragma unroll
                for (int bj = 0; bj < 2; ++bj) { f32x4 v0 = acc[ai][bj][m][0] * 32.0f, v1 = acc[ai][bj][m][1] * 32.0f;
#pragma unroll
                    for (int e = 0; e < 4; ++e) { v0[e] = __builtin_amdgcn_fmed3f(v0[e], -448.0f, 448.0f); v1[e] = __builtin_amdgcn_fmed3f(v1[e], -448.0f, 448.0f); }
                    int p0 = __builtin_amdgcn_cvt_pk_fp8_f32(v0[0], v0[1], 0, false); p0 = __builtin_amdgcn_cvt_pk_fp8_f32(v0[2], v0[3], p0, true);
                    int p1 = __builtin_amdgcn_cvt_pk_fp8_f32(v1[0], v1[1], 0, false); p1 = __builtin_amdgcn_cvt_pk_fp8_f32(v1[2], v1[3], p1, true);
                    w[bj].x = (unsigned)p0; w[bj].y = (unsigned)p1; }
                *(LAS u32x2_t*)wp0 = w[0]; *(LAS u32x2_t*)wp1 = w[1];
                asm volatile("" ::: "memory");
                const u32x2_t a = *(const LAS u32x2_t*)rp0, b = *(const LAS u32x2_t*)rp1;
                asm volatile("" ::: "memory");
                u32x4 o; o.x = a.x; o.y = a.y; o.z = b.x; o.w = b.y;
                __builtin_nontemporal_store(o, (GAS u32x4*)(gp + (size_t)(ai * HALF + m * 16) * ldc)); }
    }
};
struct EpiGU {
    static constexpr bool ROWSCALE = false, WIDE = false;
    bf16* O;
    __device__ __forceinline__ void operator()(const f32x4 (&acc)[2][2][4][2], const Unit& u, const float (&rs)[2][4], int wr, int wc, int fr, int fq) const {
        bf16* tp = O + (size_t)u.pm * (BM * DEXP) + (size_t)(u.pn * 4 + wc) * (BM * 32) + (wr * 64 + fr) * 32 + 8 * fq;
#pragma unroll
        for (int ai = 0; ai < 2; ++ai)
#pragma unroll
            for (int m = 0; m < 4; ++m) { bf16* rowp = tp + (ai * HALF + m * 16) * 32;
                float o[8];
#pragma unroll
                for (int n = 0; n < 2; ++n)
#pragma unroll
                    for (int j = 0; j < 4; ++j) { const float g = acc[ai][0][m][n][j], uu = acc[ai][1][m][n][j];
                        const float sg = g * __builtin_amdgcn_rcpf(1.0f + __builtin_amdgcn_exp2f(-g * LOG2E)); o[n * 4 + j] = sg * uu; }
                u32x4 wv; wv.x = cvt_pk_bf16(o[0], o[1]); wv.y = cvt_pk_bf16(o[2], o[3]); wv.z = cvt_pk_bf16(o[4], o[5]); wv.w = cvt_pk_bf16(o[6], o[7]);
                *(u32x4*)rowp = wv; }
    }
};
}

#define XB_TMO      128
#define XB_XCNT(j)  (256  + 64 * (j))
#define XB_XSUB(j)  (1280 + 64 * (j))
#define XB_XGEN(j)  (2304 + 64 * (j))
#define XB_TOP      3328
#define XB_TOPGEN   3392
#define XB_LSUB(j)  (3456 + 64 * (j))
#define XB_LGEN(j)  (4480 + 64 * (j))
#define XCD_BAR_WORDS 5504
#define XB_SPIN_CAP (1u << 18)
__device__ __forceinline__ unsigned xb_ld(unsigned* p)              { return __hip_atomic_load(p, __ATOMIC_RELAXED, __HIP_MEMORY_SCOPE_AGENT); }
__device__ __forceinline__ unsigned xb_add(unsigned* p, unsigned v) { return __hip_atomic_fetch_add(p, v, __ATOMIC_RELAXED, __HIP_MEMORY_SCOPE_AGENT); }
__device__ __forceinline__ unsigned xb_xcc_id() { return (unsigned)__builtin_amdgcn_s_getreg((3 << 11) | 20) & 0xFu; }
#define XB_SPIN(cond, bar) do { unsigned _sp = 0; while (cond) { __builtin_amdgcn_s_sleep(1); \
    if ((++_sp & 255u) == 0u) { if (xb_ld(&(bar)[XB_TMO])) break; if (_sp > XB_SPIN_CAP) { atomicAdd(&(bar)[XB_TMO], 1u); break; } } } } while (0)
struct XcdBarrier { unsigned* bar; unsigned x; volatile LAS unsigned* st; };
__device__ __forceinline__ XcdBarrier xcd_barrier_post(unsigned* bar, volatile LAS unsigned* st) {
    XcdBarrier b; b.bar = bar; b.x = xb_xcc_id(); b.st = st;
    if (threadIdx.x == 0) st[2] = xb_add(&bar[XB_XCNT(b.x)], 1u);
    return b;
}
__device__ __forceinline__ void xcd_local_barrier(const XcdBarrier& b, const bool wave0) {
    asm volatile("s_waitcnt vmcnt(0)" ::: "memory");
    __syncthreads();
    if (wave0 && __builtin_amdgcn_mbcnt_hi(~0u, __builtin_amdgcn_mbcnt_lo(~0u, 0u)) == 0u) {
        unsigned* bar = b.bar;
        __builtin_amdgcn_s_waitcnt(0);
        const unsigned nloc = b.st[0];
        const unsigned old = xb_add(&bar[XB_LSUB(b.x)], 1u);
        const unsigned gen = old / nloc;
        if (old + 1u == (gen + 1u) * nloc) xb_add(&bar[XB_LGEN(b.x)], 1u);
        else XB_SPIN(xb_ld(&bar[XB_LGEN(b.x)]) == gen, bar);
        __builtin_amdgcn_fence(__ATOMIC_ACQUIRE, "agent");
        asm volatile("s_waitcnt vmcnt(0)" ::: "memory");
    }
    __syncthreads();
}
__device__ __forceinline__ void xcd_barrier_complete(unsigned* bar, unsigned x, unsigned& nloc, unsigned& nx) {
    const unsigned G = gridDim.x * gridDim.y * gridDim.z;
    unsigned sum, cnt, mine, sp = 0u;
    for (;;) {
        sum = 0u; cnt = 0u; mine = 0u;
#pragma unroll
        for (unsigned j = 0; j < 16; ++j) { const unsigned c = xb_ld(&bar[XB_XCNT(j)]); sum += c; cnt += (c > 0u) ? 1u : 0u; mine = (j == x) ? c : mine; }
        if (sum == G) break;
        __builtin_amdgcn_s_sleep(1);
        if ((++sp & 255u) == 0u) { if (xb_ld(&bar[XB_TMO])) break; if (sp > XB_SPIN_CAP) { atomicAdd(&bar[XB_TMO], 1u); break; } }
    }
    nloc = mine > 0u ? mine : 1u; nx = cnt > 0u ? cnt : 1u;
}
__device__ __forceinline__ void xcd_barrier(const XcdBarrier& b) {
    asm volatile("s_waitcnt vmcnt(0)" ::: "memory");
    __syncthreads();
    if (threadIdx.x == 0) {
        unsigned* bar = b.bar;
        __builtin_amdgcn_s_waitcnt(0);
        unsigned nloc = b.st[0], nx = b.st[1];
        if (nloc == 0u) { xcd_barrier_complete(bar, b.x, nloc, nx); b.st[0] = nloc; b.st[1] = nx; }
        const unsigned old = xb_add(&bar[XB_XSUB(b.x)], 1u);
        const unsigned gen = old / nloc;
        if (old + 1u == (gen + 1u) * nloc) {
            __builtin_amdgcn_fence(__ATOMIC_RELEASE, "agent");
            asm volatile("s_waitcnt vmcnt(0)" ::: "memory");
            const unsigned og = xb_add(&bar[XB_TOP], 1u);
            const unsigned tg = og / nx;
            if (og + 1u == (tg + 1u) * nx) xb_add(&bar[XB_TOPGEN], 1u);
            else XB_SPIN(xb_ld(&bar[XB_TOPGEN]) == tg, bar);
            __builtin_amdgcn_fence(__ATOMIC_ACQUIRE, "agent");
            xb_add(&bar[XB_XGEN(b.x)], 1u);
            asm volatile("s_waitcnt vmcnt(0)" ::: "memory");
        } else {
            XB_SPIN(xb_ld(&bar[XB_XGEN(b.x)]) == gen, bar);
            __builtin_amdgcn_fence(__ATOMIC_ACQUIRE, "agent");
            asm volatile("s_waitcnt vmcnt(0)" ::: "memory");
        }
    }
    __syncthreads();
}

constexpr int NWAVES = 8;
struct Frame {
    LAS unsigned char* lds;
    LAS unsigned char* lc;
    unsigned* ctl;
    unsigned char* ws;
    int tid, lane, wave, vcu, G;
};
constexpr int LC_PTR = 2048;
__device__ __forceinline__ const float* inp(const Frame& F, int i) {
    const unsigned long long v = *(const LAS unsigned long long*)(F.lc + LC_PTR + 8 * i);
    const unsigned lo = __builtin_amdgcn_readfirstlane((unsigned)v), hi = __builtin_amdgcn_readfirstlane((unsigned)(v >> 32));
    return (const float*)(const GAS float*)(((unsigned long long)hi << 32) | lo);
}
__device__ __forceinline__ unsigned char* opq(unsigned char* p) { GAS unsigned char* g = (GAS unsigned char*)p; asm volatile("" : "+s"(g)); return (unsigned char*)g; }
__device__ __forceinline__ void refresh(Frame& F) { asm volatile("" : "+v"(F.tid)); F.lane = F.tid & 63; F.wave = __builtin_amdgcn_readfirstlane(F.tid >> 6); }

struct PlainSched {   static constexpr bool GATHER = false, ABLK = false;
    int nM, nN, nwg, G, c; const char* B; int ldb;
    __device__ __forceinline__ bool next(int i, pg8::Unit& u) const {
        const int L = i * G + c; if (L >= nwg) return false;
        const int wgid = pg8::xcd_chunk(L, nwg);
        const int nig = 8 * nN, gid = wgid / nig, fm = gid * 8, gsz = (nM - fm) < 8 ? (nM - fm) : 8;
        u.pm = fm + ((wgid % nig) % gsz); u.pn = (wgid % nig) / gsz;
        u.bptr = B + (size_t)u.pn * 256 * ldb; u.roff = -(u.pm * 256) - 1; u.nvalid = 256; return true;
    }
    __device__ __forceinline__ int arow(const pg8::Unit& u, int r) const { return -u.roff - 1 + r; }
    __device__ __forceinline__ int acolb(const pg8::Unit&) const { return 0; }
    __device__ __forceinline__ float rowscale(const pg8::Unit&, int) const { return 1.0f; }
};
struct GrpSched {     static constexpr bool GATHER = false, ABLK = false;
    int G, c; const char* B;
    __device__ __forceinline__ bool next(int i, pg8::Unit& u) const {
        const int L = i * G + c; if (L >= 256) return false;
        const int wgid = pg8::xcd_chunk(L, 256);
        u.pm = wgid >> 2; u.pn = wgid & 3; u.bptr = B + (size_t)u.pn * 256 * 512; u.roff = -(u.pm * 256) - 1; u.nvalid = 256; return true;
    }
    __device__ __forceinline__ int arow(const pg8::Unit& u, int r) const { return -u.roff - 1 + r; }
    __device__ __forceinline__ int acolb(const pg8::Unit& u) const { return u.pn * 512; }
    __device__ __forceinline__ float rowscale(const pg8::Unit&, int) const { return 1.0f; }
};
template <bool GATHER_> struct MoeSched {     static constexpr bool GATHER = GATHER_, ABLK = !GATHER_;
    const LAS int* ts; const LAS int* cn; int npn, nunits, G, c, lane_;
    const int* tokl; const float* wl; const char* Bexp; size_t bstride; const char* Bsh; int ldb;
    __device__ __forceinline__ bool next(int i, pg8::Unit& u) const {
        const int L = i * G + c; const int xg = L % pg8::NXCD, off = L / pg8::NXCD;
        const int ntile = nunits / npn, tq = ntile / pg8::NXCD, tr = ntile % pg8::NXCD;
        const int tcnt = tq + (xg < tr ? 1 : 0), tstart = xg * tq + (xg < tr ? xg : tr);
        if (off >= tcnt * npn) return false;
        const int tile = tstart + off / npn, pn = off % npn;
        const int lane = lane_;
        const bool hit = (tile >= ts[lane]) && (tile < ts[lane + 1]);
        const unsigned long long mk = __ballot(hit);
        const int e = mk ? (int)__builtin_ctzll(mk) : 64;
        const int tse = __builtin_amdgcn_readfirstlane(ts[e]);
        const int r0 = (tile - tse) * 256;
        u.pm = tile; u.pn = pn;
        u.bptr = (e < 64 ? Bexp + (size_t)e * bstride : Bsh) + (size_t)pn * 256 * ldb;
        if (GATHER) {
            if (e < 64) { const int ce = __builtin_amdgcn_readfirstlane(cn[e]); u.roff = e * CAP + r0; u.nvalid = (ce - r0) < 256 ? (ce - r0) : 256; }
            else { u.roff = -r0 - 1; u.nvalid = 256; }
        } else { u.roff = -(tile * 256) - 1; u.nvalid = 256; }
        return true;
    }
    __device__ __forceinline__ int arow(const pg8::Unit& u, int r) const { if (GATHER && u.roff >= 0) { const int rr = r < u.nvalid ? r : u.nvalid - 1; return tokl[u.roff + rr]; } return -u.roff - 1 + r; }
    __device__ __forceinline__ int acolb(const pg8::Unit&) const { return 0; }
    __device__ __forceinline__ float rowscale(const pg8::Unit& u, int r) const { if (GATHER && u.roff >= 0) { const int rr = r < u.nvalid ? r : u.nvalid - 1; return wl[u.roff + rr]; } return 1.0f; }
};

__device__ __forceinline__ void p0_transpose_item64(const float* W, int K, int N, bf16* WT, int dst_n0, LAS float* scr, int kb, int nb, int lane) {
    const int k0 = 64 * kb, n0 = 64 * nb; const int r = lane >> 4, c4 = lane & 15;
    f32x4 v[16];
#pragma unroll
    for (int i = 0; i < 16; ++i) v[i] = *(const GAS f32x4*)(W + (size_t)(k0 + 4 * i + r) * N + n0 + 4 * c4);
#pragma unroll
    for (int i = 0; i < 16; ++i) { const int k = 4 * i + r; *(LAS f32x4*)(scr + k * 64 + 4 * (c4 ^ (k >> 3))) = v[i]; }
    LDS_WAIT(); asm volatile("" ::: "memory");
    const int c = lane & 7;
#pragma unroll
    for (int j = 0; j < 8; ++j) { const int n = (lane >> 3) + 8 * j; const LAS float* sp = scr + (8 * c) * 64 + 4 * ((n >> 2) ^ c) + (n & 3);
        u32x4 o; o.x = pk2(sp[0 * 64], sp[1 * 64]); o.y = pk2(sp[2 * 64], sp[3 * 64]); o.z = pk2(sp[4 * 64], sp[5 * 64]); o.w = pk2(sp[6 * 64], sp[7 * 64]);
        *(GAS u32x4*)(WT + (size_t)(dst_n0 + n) * K + k0 + 8 * c) = o; }
    LDS_WAIT(); asm volatile("" ::: "memory");
}
__device__ __forceinline__ void p0_router_item(const float* W, bf16* WH, bf16* WLo, LAS float* scr, int kb, int nb, int lane) {
    const int K = 1024, N = 64; const int k0 = 64 * kb, n0 = 32 * nb;
#pragma unroll 8
    for (int i = 0; i < 32; ++i) { const int kk = 2 * i + (lane >> 5); scr[kk * 33 + (lane & 31)] = W[(size_t)(k0 + kk) * N + n0 + (lane & 31)]; }
    LDS_WAIT(); asm volatile("" ::: "memory");
    const int c = lane & 7;
#pragma unroll
    for (int j = 0; j < 4; ++j) { const int n = (lane >> 3) + 8 * j; const LAS float* s = scr + (8 * c) * 33 + n;
        unsigned h[8], l[8];
#pragma unroll
        for (int q = 0; q < 8; ++q) { const float v = s[q * 33]; h[q] = f2bf(v); l[q] = f2bf(v - bf2f(h[q])); }
        u32x4 oh, ol; oh.x = h[0] | (h[1] << 16); oh.y = h[2] | (h[3] << 16); oh.z = h[4] | (h[5] << 16); oh.w = h[6] | (h[7] << 16);
        ol.x = l[0] | (l[1] << 16); ol.y = l[2] | (l[3] << 16); ol.z = l[4] | (l[5] << 16); ol.w = l[6] | (l[7] << 16);
        *(GAS u32x4*)(WH + (size_t)(n0 + n) * K + k0 + 8 * c) = oh; *(GAS u32x4*)(WLo + (size_t)(n0 + n) * K + k0 + 8 * c) = ol; }
    LDS_WAIT(); asm volatile("" ::: "memory");
}

__device__ __forceinline__ void p0_prologue(Frame& F) {
    LAS float* cs = (LAS float*)(F.lds);
    LAS float* part = (LAS float*)(F.lds + 32768);
    const float* c = inp(F, 1);
    for (int i = F.tid; i < 8 * 1024; i += 512) { const float v = c[i]; cs[i] = v / (1.0f + __expf(-v)); }
    __syncthreads();
    float* mod = (float*)(F.ws + WS_MOD);
    for (int it = F.vcu; it < 4 * 96; it += F.G) {
        const int layer = it / 96, slab = it % 96; const int col = slab * 64 + F.lane;
        const float* W = inp(F, 2) + (size_t)layer * 1024 * 6144 + col;
        float a[8];
#pragma unroll
        for (int b = 0; b < 8; ++b) a[b] = 0.f;
        const int k0 = F.wave * 128;
#pragma unroll 4
        for (int k = 0; k < 128; k += 4) {
            float w[4];
#pragma unroll
            for (int j = 0; j < 4; ++j) w[j] = W[(size_t)(k0 + k + j) * 6144];
#pragma unroll
            for (int b = 0; b < 8; ++b) { const f32x4 cv = *(const LAS f32x4*)(cs + b * 1024 + k0 + k); a[b] += cv[0] * w[0] + cv[1] * w[1] + cv[2] * w[2] + cv[3] * w[3]; }
        }
#pragma unroll
        for (int b = 0; b < 8; ++b) part[(F.wave * 8 + b) * 64 + F.lane] = a[b];
        __syncthreads();
        { const int b = F.wave; float s = 0.f;
#pragma unroll
          for (int w = 0; w < 8; ++w) s += part[(w * 8 + b) * 64 + F.lane];
          mod[((size_t)layer * 8 + b) * 6144 + col] = s + inp(F, 3)[layer * 6144 + col]; }
        __syncthreads();
    }
    __syncthreads();
    LAS float* scr = (LAS float*)(F.lds + F.wave * 16384);
    const int gw = F.vcu * NWAVES + F.wave, NGW = F.G * NWAVES;
    constexpr int I_PIN = 2 * 16 * 16, I_GRP = 8 * 4 * 4, I_POUT = I_PIN, I_AIN = 2 * 16 * 144, I_AOUT = I_PIN, I_SHGU = 4 * 16 * 8, I_SHDN = 4 * 4 * 16, I_R = 4 * 16 * 2;
    constexpr int I_EGU = 256 * 16 * 8, I_EDN = 256 * 4 * 16;
    constexpr int NITEMS = I_PIN + I_GRP + I_POUT + I_AIN + I_AOUT + I_SHGU + I_SHDN + I_R + I_EGU + I_EDN;
    for (int it = gw; it < NITEMS; it += NGW) {
        int r = it;
#define P0_GROUP(CNT, SRC, KK, NN, DST, GU) if (r < (CNT)) { const int per = ((KK) / 64) * ((NN) / 64), mat = r / per, q = r % per, nblk = (NN) / 64, kblk = (KK) / 64, nb = q / kblk, kb = q % kblk; (void)nblk; \
            int dn0 = 64 * nb; if (GU) { const int n0 = 64 * nb; dn0 = (n0 < 256) ? ((n0 >> 7) * 256 + (n0 & 127)) : (((n0 - 256) >> 7) * 256 + 128 + ((n0 - 256) & 127)); } \
            p0_transpose_item64((SRC) + (size_t)mat * (KK) * (NN), (KK), (NN), (bf16*)(F.ws + (DST)) + (size_t)mat * (KK) * (NN), dn0, scr, kb, nb, F.lane); continue; } r -= (CNT);
        P0_GROUP(I_PIN, inp(F, 4), 1024, 1024, WS_WPIN, 0)
        P0_GROUP(I_GRP, inp(F, 5), 256, 256, WS_WPGRP, 0)
        P0_GROUP(I_POUT, inp(F, 7), 1024, 1024, WS_WPOUT, 0)
        P0_GROUP(I_AIN, inp(F, 8), 1024, 9216, WS_WAIN, 0)
        P0_GROUP(I_AOUT, inp(F, 9), 1024, 1024, WS_WAOUT, 0)
        P0_GROUP(I_SHGU, inp(F, 16), 1024, 512, WS_WSHGU, 1)
        P0_GROUP(I_SHDN, inp(F, 17), 256, 1024, WS_WSHDN, 0)
        if (r < I_R) { const int mat = r / 32, q = r % 32, kb = q / 2, nb = q % 2;
            p0_router_item(inp(F, 12) + (size_t)mat * 65536, (bf16*)(F.ws + WS_WRHI) + (size_t)mat * 65536, (bf16*)(F.ws + WS_WRLO) + (size_t)mat * 65536, scr, kb, nb, F.lane); continue; } r -= I_R;
        P0_GROUP(I_EGU, inp(F, 14), 1024, 512, WS_WEGU, 1)
        P0_GROUP(I_EDN, inp(F, 15), 256, 1024, WS_WEDN, 0)
#undef P0_GROUP
    }
}

__device__ __forceinline__ void p1_modulate(Frame& F, const float* x, const float* modl  , int sh_off, int sc_off) {
    bf16* H = (bf16*)(F.ws + WS_H);
    const int gw = F.vcu * NWAVES + F.wave, NGW = F.G * NWAVES;
    for (int m = gw; m < T; m += NGW) {
        const int b = m / SEQ; const float* mb = modl + (size_t)b * 6144;
        const GAS f32x4* xr = (const GAS f32x4*)(x + (size_t)m * D) + F.lane;
        GAS u32x2* o8 = (GAS u32x2*)(H + (size_t)m * D) + F.lane;
#pragma unroll
        for (int j = 0; j < 4; ++j) { const f32x4 v = xr[64 * j]; const f32x4 sc = *(const f32x4*)(mb + sc_off + 4 * F.lane + 256 * j), sh = *(const f32x4*)(mb + sh_off + 4 * F.lane + 256 * j);
            const f32x4 h = v * (sc + 1.0f) + sh; u32x2 w; w.x = pk2(h[0], h[1]); w.y = pk2(h[2], h[3]); o8[64 * j] = w; }
    }
}

template <int W>
__device__ __forceinline__ void pool_item(const bf16* U, bf16* Z, int b, int t0, int g, int lane) {
    const size_t base = (size_t)b * SEQ * D + 256 * g + 4 * lane;
    float s[4] = {0.f, 0.f, 0.f, 0.f};
#pragma unroll
    for (int j = 1; j <= W; ++j) { const int t = t0 - j; if (t >= 0) { const u32x2 v = *(const GAS u32x2*)(U + base + (size_t)t * D);
            s[0] += bf2f(v.x & 0xffffu); s[1] += bf2f(v.x >> 16); s[2] += bf2f(v.y & 0xffffu); s[3] += bf2f(v.y >> 16); } }
#pragma unroll 8
    for (int i = 0; i < 32; ++i) { const int t = t0 + i;
        const u32x2 v = *(const GAS u32x2*)(U + base + (size_t)t * D);
        const float c0 = bf2f(v.x & 0xffffu), c1 = bf2f(v.x >> 16), c2 = bf2f(v.y & 0xffffu), c3 = bf2f(v.y >> 16);
        s[0] += c0; s[1] += c1; s[2] += c2; s[3] += c3;
        if (t - W >= 0) { const u32x2 o = *(const GAS u32x2*)(U + base + (size_t)(t - W) * D);
            s[0] -= bf2f(o.x & 0xffffu); s[1] -= bf2f(o.x >> 16); s[2] -= bf2f(o.y & 0xffffu); s[3] -= bf2f(o.y >> 16); }
        const float inv = 1.0f / (float)((t + 1) < W ? (t + 1) : W);
        u32x2 w; w.x = pk2(s[0] * inv - c0, s[1] * inv - c1); w.y = pk2(s[2] * inv - c2, s[3] * inv - c3);
        *(GAS u32x2*)(Z + base + (size_t)t * D) = w; }
}

__device__ __forceinline__ void moe_build_table(Frame& F, int layer) {
    LAS int* ts = (LAS int*)(F.lc + LC_TS); LAS int* cn = (LAS int*)(F.lc + LC_CNT);
    __syncthreads();
    if (F.wave == 0) {
        const int c = (int)__hip_atomic_load(F.ctl + CW_CNT + layer * 64 + F.lane, RLX_AGENT);
        int t = (c + 255) >> 8;
#pragma unroll
        for (int o = 1; o < 64; o <<= 1) { const int v = __shfl_up(t, o); if (F.lane >= o) t += v; }
        cn[F.lane] = c; ts[F.lane + 1] = t;
        if (F.lane == 0) ts[0] = 0;
        if (F.lane == 63) ts[65] = t + 64;
    }
    __syncthreads();
}

#ifdef PROBE_TYPE
#define LSTAMP(ty) do { if (blockIdx.x == 0 && F.tid == 0) { const unsigned long long now_ = __builtin_amdgcn_s_memrealtime(); LAS unsigned long long* st_ = (LAS unsigned long long*)(F.lc + 3072); \
        st_[1 + (ty)] += now_ - st_[20]; st_[20] = now_; } } while (0)
#define LSTAMP0() do { if (blockIdx.x == 0 && F.tid == 0) { ((LAS unsigned long long*)(F.lc + 3072))[20] = __builtin_amdgcn_s_memrealtime(); } } while (0)
#else
#define LSTAMP(ty) do { } while (0)
#define LSTAMP0() do { } while (0)
#endif
constexpr int APITCH = 1032;
#define LDS_ONLY_BARRIER() do { asm volatile("s_waitcnt lgkmcnt(0)" ::: "memory"); __builtin_amdgcn_s_barrier(); asm volatile("" ::: "memory"); } while (0)
template <bool X16>
__device__ __forceinline__ void ln1_router_phase(Frame& F, int layer, const float* xin) {
    bf16* X = (bf16*)(F.ws + WS_X);
    bf16* H = (bf16*)(F.ws + WS_H); const bf16* Y = (const bf16*)(F.ws + WS_Y);
    const float* modl = (const float*)(F.ws + WS_MOD) + (size_t)layer * 8 * 6144;
    const float* lg = inp(F, 10) + layer * D; const float* lb = inp(F, 11) + layer * D;
    const float* rb = inp(F, 13) + layer * NE;
    const bf16* WH = (const bf16*)(F.ws + WS_WRHI) + (size_t)layer * 65536; const bf16* WLo = (const bf16*)(F.ws + WS_WRLO) + (size_t)layer * 65536;
    int* tokl = (int*)(F.ws + WS_TOKL); float* wl = (float*)(F.ws + WS_WL); int* tslot = (int*)(F.ws + WS_TSLOT);
    unsigned* gcnt = F.ctl + CW_CNT + layer * 64;
    LAS bf16* Ahi = (LAS bf16*)F.lds; LAS bf16* Alo = Ahi + 32 * APITCH;
    LAS float* PART = (LAS float*)F.lds;
    LAS float* PV = (LAS float*)(F.lds + LDS_TB_OFF);
    LAS int* lcnt = (LAS int*)(F.lc + LC_LCNT); LAS int* gb = (LAS int*)(F.lc + LC_GB);
    const int lane = F.lane, wave = F.wave;
    const int nblk = (T / 32) / F.G;
#define LN1_BLK(bi_) ((F.G == 256) ? ((F.vcu >> 5) * 64 + (F.vcu & 31) * 2 + (bi_)) : (F.vcu + (bi_) * F.G))
    constexpr int NX = X16 ? 2 : 4;
    u32x4 xr[4][NX], yv[4][2];
#define LN1_LOAD(bi_) do { const int t0_ = LN1_BLK(bi_) * 32 + wave * 4; \
        _Pragma("unroll") for (int q = 0; q < 4; ++q) _Pragma("unroll") for (int j = 0; j < 2; ++j) { const size_t o_ = (size_t)(t0_ + q) * D + 8 * lane + 512 * j; \
            if constexpr (X16) xr[q][j] = __builtin_nontemporal_load((const GAS u32x4*)((const bf16*)xin + o_)); \
            else { xr[q][2 * j] = *(const GAS u32x4*)(xin + o_); xr[q][2 * j + 1] = *(const GAS u32x4*)(xin + o_ + 4); } \
            yv[q][j] = __builtin_nontemporal_load((const GAS u32x4*)(Y + o_)); } } while (0)
    LN1_LOAD(0);
    const float rbe = rb[lane];
    { const int b = (LN1_BLK(0) * 32) / SEQ; const float* mb = modl + (size_t)b * 6144;
      for (int i = F.tid; i < 1024; i += NWAVES * 64) { const int v = i >> 8, c4 = (i & 255) * 4;
          const float* src = (v == 0) ? lg : (v == 1) ? lb : (v == 2) ? (mb + 4096) : (mb + 3072);
          f32x4 t = *(const GAS f32x4*)(src + c4); if (v == 2) t = t + 1.0f; *(LAS f32x4*)(PV + v * 1024 + c4) = t; } }
    __syncthreads();
    for (int bi = 0; bi < nblk; ++bi) {
        const int blk = LN1_BLK(bi);
        const int tok0 = blk * 32;
        LSTAMP0();
        bf16x8 bh[8][2], bl[8][2];
        {
            const int b = tok0 / SEQ; const float* mb = modl + (size_t)b * 6144;
            f32x4 xv[4][4];
            f32x4 pg1[4];
#pragma unroll
            for (int jj = 0; jj < 4; ++jj) pg1[jj] = *(const GAS f32x4*)(mb + 2048 + 8 * lane + 512 * (jj >> 1) + 4 * (jj & 1)) + 1.0f;
            float sm[4];
#pragma unroll
            for (int q = 0; q < 4; ++q) { float s = 0.f;
#pragma unroll
                for (int jj = 0; jj < 4; ++jj) { const unsigned w0 = (jj & 1) ? yv[q][jj >> 1].z : yv[q][jj >> 1].x, w1 = (jj & 1) ? yv[q][jj >> 1].w : yv[q][jj >> 1].y;
                    f32x4 y4; y4[0] = h2f(w0 & 0xffffu); y4[1] = h2f(w0 >> 16); y4[2] = h2f(w1 & 0xffffu); y4[3] = h2f(w1 >> 16);
                    f32x4 x4;
                    if constexpr (X16) { const unsigned v0 = (jj & 1) ? xr[q][jj >> 1].z : xr[q][jj >> 1].x, v1 = (jj & 1) ? xr[q][jj >> 1].w : xr[q][jj >> 1].y;
                        x4 = (f32x4){h2f(v0 & 0xffffu), h2f(v0 >> 16), h2f(v1 & 0xffffu), h2f(v1 >> 16)}; }
                    else { const u32x4 v = xr[q][jj]; x4 = (f32x4){__uint_as_float(v.x), __uint_as_float(v.y), __uint_as_float(v.z), __uint_as_float(v.w)}; }
                    xv[q][jj] = x4 * ALPHA + pg1[jj] * y4; s += (xv[q][jj][0] + xv[q][jj][1]) + (xv[q][jj][2] + xv[q][jj][3]); }
                sm[q] = s; }
#pragma unroll
            for (int o = 1; o < 64; o <<= 1) {
#pragma unroll
                for (int q = 0; q < 4; ++q) sm[q] += __shfl_xor(sm[q], o); }
            float s2[4];
#pragma unroll
            for (int q = 0; q < 4; ++q) { const float mean = sm[q] * (1.f / D); float t = 0.f;
#pragma unroll
                for (int jj = 0; jj < 4; ++jj) { xv[q][jj] = xv[q][jj] - mean; t += (xv[q][jj][0] * xv[q][jj][0] + xv[q][jj][1] * xv[q][jj][1]) + (xv[q][jj][2] * xv[q][jj][2] + xv[q][jj][3] * xv[q][jj][3]); }
                s2[q] = t; }
#pragma unroll
            for (int o = 1; o < 64; o <<= 1) {
#pragma unroll
                for (int q = 0; q < 4; ++q) s2[q] += __shfl_xor(s2[q], o); }
            LAS float* pvb = PV + 8 * lane; asm volatile("" : "+v"(pvb));
#pragma unroll
            for (int jj = 0; jj < 4; ++jj) { const int col = 8 * lane + 512 * (jj >> 1) + 4 * (jj & 1); const int co = 512 * (jj >> 1) + 4 * (jj & 1);
                const f32x4 gg = *(const LAS f32x4*)(pvb + co), bb = *(const LAS f32x4*)(pvb + 1024 + co), sc2 = *(const LAS f32x4*)(pvb + 2048 + co), sh2 = *(const LAS f32x4*)(pvb + 3072 + co);
#pragma unroll
                for (int q = 0; q < 4; ++q) { const int rl = wave * 4 + q, tok = tok0 + rl; const float rstd = 1.0f / sqrtf(s2[q] * (1.f / D) + LN_EPS);
                    const f32x4 xn = xv[q][jj] * rstd * gg + bb; { u32x2 xw; xw.x = pkh2(xn[0], xn[1]); xw.y = pkh2(xn[2], xn[3]); *(GAS u32x2*)(X + (size_t)tok * D + col) = xw; }
                    const f32x4 hf = xn * sc2 + sh2;
                    unsigned hh[4], ll[4];
#pragma unroll
                    for (int e = 0; e < 4; ++e) { hh[e] = f2bf(hf[e]); ll[e] = f2bf(hf[e] - bf2f(hh[e])); }
                    u32x2 wh, wlo; wh.x = hh[0] | (hh[1] << 16); wh.y = hh[2] | (hh[3] << 16); wlo.x = ll[0] | (ll[1] << 16); wlo.y = ll[2] | (ll[3] << 16);
                    *(GAS u32x2*)(H + (size_t)tok * D + col) = wh;
                    *(LAS u32x2*)(Ahi + rl * APITCH + col) = wh; *(LAS u32x2*)(Alo + rl * APITCH + col) = wlo; } }
        }
        __builtin_amdgcn_sched_barrier(0);
        {
            const int r32 = lane & 31, hi = lane >> 5;
#pragma unroll
            for (int nb = 0; nb < 2; ++nb) {
                const GAS bf16* ph = (const GAS bf16*)WH + (size_t)(r32 + 32 * nb) * 1024 + wave * 128 + hi * 8; const GAS bf16* pl = (const GAS bf16*)WLo + (size_t)(r32 + 32 * nb) * 1024 + wave * 128 + hi * 8;
                asm volatile("" : "+v"(ph), "+v"(pl));
#pragma unroll
                for (int ks = 0; ks < 8; ++ks) { bh[ks][nb] = *(const GAS bf16x8*)(ph + ks * 16); bl[ks][nb] = *(const GAS bf16x8*)(pl + ks * 16); } }
        }
        __syncthreads();
        LSTAMP(13);
        f32x16 acc[2]; acc[0] = (f32x16){}; acc[1] = (f32x16){};
        {
            const int r32 = lane & 31, hi = lane >> 5;
#pragma unroll
            for (int ks = 0; ks < 8; ++ks) {
                const int k = wave * 128 + ks * 16 + hi * 8;
                const bf16x8 ah = *(const LAS bf16x8*)(Ahi + r32 * APITCH + k), al = *(const LAS bf16x8*)(Alo + r32 * APITCH + k);
#pragma unroll
                for (int nb = 0; nb < 2; ++nb) {
                    acc[nb] = MFMA32(ah, bh[ks][nb], acc[nb]);
                    acc[nb] = MFMA32(al, bh[ks][nb], acc[nb]);
                    acc[nb] = MFMA32(ah, bl[ks][nb], acc[nb]);
                }
            }
        }
        LDS_ONLY_BARRIER();
        {
            const int r32 = lane & 31, hi = lane >> 5;
#pragma unroll
            for (int nb = 0; nb < 2; ++nb)
#pragma unroll
                for (int r = 0; r < 16; ++r) { const int trow = (r & 3) + 8 * (r >> 2) + 4 * hi; PART[(wave * 32 + trow) * 64 + 32 * nb + r32] = acc[nb][r]; }
        }
        if (F.tid < 64) lcnt[F.tid] = 0;
        LDS_ONLY_BARRIER();
        LSTAMP(14);
        if (bi + 1 < nblk) LN1_LOAD(bi + 1);
        else {
#pragma unroll
            for (int q = 0; q < 4; ++q) {
#pragma unroll
                for (int j = 0; j < NX; ++j) xr[q][j] = (u32x4){0u, 0u, 0u, 0u};
#pragma unroll
                for (int j = 0; j < 2; ++j) yv[q][j] = (u32x4){0u, 0u, 0u, 0u}; } }
        int chosen_m = 0; int posl[4]; float wv[4]; int rk[4];
        unsigned key[4]; float sgv[4];
#pragma unroll
        for (int q = 0; q < 4; ++q) {
            const int rl = wave * 4 + q;
            float logit = 0.f;
#pragma unroll
            for (int w = 0; w < 8; ++w) logit += PART[(w * 32 + rl) * 64 + lane];
            const float sg = 1.0f / (1.0f + __expf(-logit));
            const float sel = sg + rbe;
            float m1 = sel; m1 = fmaxf(m1, __shfl_xor(m1, 1)); m1 = fmaxf(m1, __shfl_xor(m1, 2)); m1 = fmaxf(m1, __shfl_xor(m1, 4));
            const unsigned long long bal = __ballot(sel == m1);
            const unsigned long long gm = bal & (0xFFull << (8 * (lane >> 3)));
            const int first = (int)__builtin_ctzll(gm);
            float m2 = (lane == first) ? -INFINITY : sel; m2 = fmaxf(m2, __shfl_xor(m2, 1)); m2 = fmaxf(m2, __shfl_xor(m2, 2)); m2 = fmaxf(m2, __shfl_xor(m2, 4));
            const float gs = m1 + m2;
            int rg = 0;
#pragma unroll
            for (int g2 = 0; g2 < 8; ++g2) { const float v = __builtin_bit_cast(float, __builtin_amdgcn_readlane(__builtin_bit_cast(int, gs), 8 * g2)); rg += ((v > gs) || (v == gs && g2 < (lane >> 3))) ? 1 : 0; }
            const bool gsel = rg < 4;
            const float msel = gsel ? sel : -INFINITY;
            const unsigned mb_ = __float_as_uint(msel); key[q] = (mb_ & 0x80000000u) ? ~mb_ : (mb_ | 0x80000000u); sgv[q] = sg;
        }
        unsigned tau[4] = {0u, 0u, 0u, 0u};
#pragma unroll 1
        for (int bit = 31; bit >= 0; --bit) {
#pragma unroll
            for (int q = 0; q < 4; ++q) { const unsigned cand = tau[q] | (1u << bit); const int cnt = (int)__popcll(__ballot(key[q] >= cand)); tau[q] = (cnt >= TOPK) ? cand : tau[q]; } }
#pragma unroll
        for (int q = 0; q < 4; ++q) {
            const unsigned long long gtm = __ballot(key[q] > tau[q]), eqm = __ballot(key[q] == tau[q]);
            const int need = TOPK - (int)__popcll(gtm);
            const unsigned long long below = (1ull << lane) - 1ull;
            const bool ch = (key[q] > tau[q]) || ((key[q] == tau[q]) && ((int)__popcll(eqm & below) < need));
            const unsigned long long chm = __ballot(ch);
            const int rank = (int)__popcll(chm & below);
            const float wsum = wave_sum(ch ? sgv[q] : 0.f);
            wv[q] = sgv[q] / wsum * ROUTED_SCALE; rk[q] = rank; posl[q] = 0;
            if (ch) { chosen_m |= (1 << q); posl[q] = __hip_atomic_fetch_add(lcnt + lane, 1, __ATOMIC_RELAXED, __HIP_MEMORY_SCOPE_WORKGROUP); }
        }
        LDS_ONLY_BARRIER();
        LSTAMP(15);
        if (wave == 0) { const int n = lcnt[lane]; int base = 0; if (n > 0) base = (int)__hip_atomic_fetch_add(gcnt + lane, (unsigned)n, RLX_AGENT); gb[lane] = base; }
        LDS_ONLY_BARRIER();
        {
            const int base = gb[lane];
#pragma unroll
            for (int q = 0; q < 4; ++q) if (chosen_m & (1 << q)) { const int tok = tok0 + wave * 4 + q; const int pos = base + posl[q];
                tokl[(size_t)lane * CAP + pos] = tok; wl[(size_t)tok * 8 + rk[q]] = wv[q]; tslot[(size_t)tok * 8 + rk[q]] = lane * CAP + pos; }
        }
        LDS_ONLY_BARRIER();
        LSTAMP(16);
    }
#undef LN1_LOAD
#undef LN1_BLK
}

__device__ __forceinline__ void combine_ln2_phase(Frame& F, int layer) {
    bf16* X = (bf16*)(F.ws + WS_X); bf16* H = (bf16*)(F.ws + WS_H); const unsigned char* YS = (const unsigned char*)(F.ws + WS_YS);
    const float* modl = (const float*)(F.ws + WS_MOD) + (size_t)layer * 8 * 6144;
    const float* modn = (const float*)(F.ws + WS_MOD) + (size_t)(layer + 1) * 8 * 6144;
    const float* lg = inp(F, 18) + layer * D; const float* lb = inp(F, 19) + layer * D;
    const int* tslot = (const int*)(F.ws + WS_TSLOT);
    const LAS int* ts = (const LAS int*)(F.lc + LC_TS);
    const bool lastl = (layer == DEPTH - 1);
    float* xout = (float*)inp(F, 20);
    const int lane = F.lane, wave = F.wave;
    LAS float* PV = (LAS float*)F.lds;
    const int shbase = ts[64] * 256;
    for (int blk = F.vcu; blk < T / 64; blk += F.G) {
        const int tokb = blk * 64, b = tokb / SEQ;
        __syncthreads();
        for (int i = F.tid; i < 1024; i += 512) { PV[i] = modl[(size_t)b * 6144 + 5120 + i] + 1.0f; PV[1024 + i] = lg[i]; PV[2048 + i] = lb[i];
            if (!lastl) { PV[3072 + i] = modn[(size_t)b * 6144 + 1024 + i] + 1.0f; PV[4096 + i] = modn[(size_t)b * 6144 + i]; } }
        __syncthreads();
        const int tw = tokb + wave * 8;
        int sv; { const int v = tslot[(size_t)tw * 8 + lane]; sv = ts[v >> 14] * 256 + (v & (CAP - 1)); }
        const float wvv = ((const float*)(F.ws + WS_WL))[(size_t)tw * 8 + lane] * (1.0f / 32.0f);
        pg8::u32x2_t ys[18]; u32x4 xs[2];
#define CB_LOAD(k) do { const int tok_ = tw + (k); _Pragma("unroll") for (int kk_ = 0; kk_ < 9; ++kk_) { const int slot_ = (kk_ < 8) ? __builtin_amdgcn_readlane(sv, 8 * (k) + kk_) : (shbase + tok_); \
            const unsigned char* yr_ = YS + (size_t)slot_ * D + 8 * lane; ys[2 * kk_] = __builtin_nontemporal_load((const GAS pg8::u32x2_t*)(yr_)); ys[2 * kk_ + 1] = __builtin_nontemporal_load((const GAS pg8::u32x2_t*)(yr_ + 512)); } \
            _Pragma("unroll") for (int j_ = 0; j_ < 2; ++j_) xs[j_] = __builtin_nontemporal_load((const GAS u32x4*)(X + (size_t)tok_ * D + 8 * lane + 512 * j_)); } while (0)
        CB_LOAD(0);
#pragma unroll 1
        for (int k = 0; k < 8; ++k) {
            const int tok_ = tw + k; f32x4 y_[4];
#pragma unroll
            for (int jj_ = 0; jj_ < 4; ++jj_) y_[jj_] = (f32x4){0.f, 0.f, 0.f, 0.f};
#pragma unroll
            for (int kk_ = 0; kk_ < 9; ++kk_) { const float wk_ = (kk_ < 8) ? __builtin_bit_cast(float, __builtin_amdgcn_readlane(__builtin_bit_cast(int, wvv), 8 * k + kk_)) : (1.0f / 32.0f);
#pragma unroll
                for (int j_ = 0; j_ < 2; ++j_) { const pg8::u32x2_t w_ = ys[2 * kk_ + j_];
                    const f32x2 a0_ = __builtin_amdgcn_cvt_pk_f32_fp8((int)w_.x, false), a1_ = __builtin_amdgcn_cvt_pk_f32_fp8((int)w_.x, true), b0_ = __builtin_amdgcn_cvt_pk_f32_fp8((int)w_.y, false), b1_ = __builtin_amdgcn_cvt_pk_f32_fp8((int)w_.y, true);
                    y_[2 * j_][0] += wk_ * a0_[0]; y_[2 * j_][1] += wk_ * a0_[1]; y_[2 * j_][2] += wk_ * a1_[0]; y_[2 * j_][3] += wk_ * a1_[1];
                    y_[2 * j_ + 1][0] += wk_ * b0_[0]; y_[2 * j_ + 1][1] += wk_ * b0_[1]; y_[2 * j_ + 1][2] += wk_ * b1_[0]; y_[2 * j_ + 1][3] += wk_ * b1_[1]; } }
            f32x4 v_[4]; float s_ = 0.f;
#pragma unroll
            for (int jj_ = 0; jj_ < 4; ++jj_) { const int col_ = 8 * lane + 512 * (jj_ >> 1) + 4 * (jj_ & 1); const f32x4 g2_ = *(const LAS f32x4*)(PV + col_);
                const unsigned w0_ = (jj_ & 1) ? xs[jj_ >> 1].z : xs[jj_ >> 1].x, w1_ = (jj_ & 1) ? xs[jj_ >> 1].w : xs[jj_ >> 1].y;
                const f32x4 x4_ = (f32x4){h2f(w0_ & 0xffffu), h2f(w0_ >> 16), h2f(w1_ & 0xffffu), h2f(w1_ >> 16)};
                v_[jj_] = x4_ * ALPHA + g2_ * y_[jj_]; s_ += (v_[jj_][0] + v_[jj_][1]) + (v_[jj_][2] + v_[jj_][3]); }
            asm volatile("" : "+v"(v_[0]), "+v"(v_[1]), "+v"(v_[2]), "+v"(v_[3]));
            __builtin_amdgcn_sched_barrier(0);
            { const int kn = (k + 1 < 8) ? k + 1 : k; CB_LOAD(kn); }
            __builtin_amdgcn_sched_barrier(0);
            const float mean_ = wave_sum(s_) * (1.f / D); float q_ = 0.f;
#pragma unroll
            for (int jj_ = 0; jj_ < 4; ++jj_) { v_[jj_] = v_[jj_] - mean_; q_ += (v_[jj_][0] * v_[jj_][0] + v_[jj_][1] * v_[jj_][1]) + (v_[jj_][2] * v_[jj_][2] + v_[jj_][3] * v_[jj_][3]); }
            const float rstd_ = 1.0f / sqrtf(wave_sum(q_) * (1.f / D) + LN_EPS);
#pragma unroll
            for (int jj_ = 0; jj_ < 4; ++jj_) { const int col_ = 8 * lane + 512 * (jj_ >> 1) + 4 * (jj_ & 1);
                const f32x4 gg_ = *(const LAS f32x4*)(PV + 1024 + col_), bb_ = *(const LAS f32x4*)(PV + 2048 + col_);
                const f32x4 xn_ = v_[jj_] * rstd_ * gg_ + bb_;
                if (lastl) *(GAS f32x4*)(xout + (size_t)tok_ * D + col_) = xn_;
                else { u32x2 xw_; xw_.x = pkh2(xn_[0], xn_[1]); xw_.y = pkh2(xn_[2], xn_[3]); *(GAS u32x2*)(X + (size_t)tok_ * D + col_) = xw_; }
                if (!lastl) { const f32x4 sc_ = *(const LAS f32x4*)(PV + 3072 + col_), sh_ = *(const LAS f32x4*)(PV + 4096 + col_); const f32x4 hm_ = xn_ * sc_ + sh_;
                    u32x2 w2_; w2_.x = pk2(hm_[0], hm_[1]); w2_.y = pk2(hm_[2], hm_[3]); *(GAS u32x2*)(H + (size_t)tok_ * D + col_) = w2_; } }
        }
#undef CB_LOAD
    }
}

constexpr int ACCP = 68;
__device__ __forceinline__ int crow(int r, int hi) { return (r & 3) + 8 * (r >> 2) + 4 * hi; }
constexpr int KPITCH = 144;
template <bool FIRST, int NB>
__device__ __forceinline__ void attn_task(const bf16* QKVb  , int g, int h, int dil, int cls, int q0, int QS, int kb0, int L, float slope2d,
                                          LAS unsigned char* stg  , LAS float* wsf  , LAS float* ACC, LAS float* ML, int trow_mul, int trow_add, int lane) {
    asm volatile("" : "+v"(lane));
    const int r32 = lane & 31, hi = lane >> 5, lr = lane >> 3, lc = lane & 7;
    const int qcol = ((g * 3 + 0) * 16 + h) * 64, kcol = ((g * 3 + 1) * 16 + h) * 64, vcol = ((g * 3 + 2) * 16 + h) * 64;
    const size_t rstride = (size_t)dil * NQKV;
    const bf16* base = QKVb + (size_t)cls * NQKV + lc * 8;
    const int jlo = (kb0 >= -31) ? 0 : ((-kb0) >> 5);
    const int qpos = q0 + QS * r32;
    const int dmax = qpos < 128 ? qpos : 128;
    const float half = 0.5f * (float)dmax;
#define AT_LOADROWS(dst, l0, ls, col) do { _Pragma("unroll") for (int i_ = 0; i_ < 4; ++i_) { int l_ = (l0) + (ls) * (8 * i_ + lr); l_ = l_ < 0 ? 0 : (l_ > L - 1 ? L - 1 : l_); \
        dst[i_] = *(const GAS u32x4*)(base + (size_t)l_ * rstride + (col)); } } while (0)
#define AT_PUTROWS(src) do { _Pragma("unroll") for (int i_ = 0; i_ < 4; ++i_) *(LAS u32x4*)(stg + (8 * i_ + lr) * KPITCH + lc * 16) = src[i_]; } while (0)
#define AT_GETFRAG(dst) do { _Pragma("unroll") for (int s_ = 0; s_ < 4; ++s_) dst[s_] = *(const LAS bf16x8*)(stg + r32 * KPITCH + 32 * s_ + 16 * hi); } while (0)
#define AT_LDSWAIT() asm volatile("s_waitcnt lgkmcnt(0)" ::: "memory")
    u32x4 kr[2][4];
    bf16x8 qf[4];
    { u32x4 qr[4]; AT_LOADROWS(qr, q0, QS, qcol);
#pragma unroll
      for (int j = 0; j < NB; ++j) if (j == jlo) AT_LOADROWS(kr[j & 1], kb0 + 32 * j, 1, kcol);
      AT_PUTROWS(qr); AT_LDSWAIT(); AT_GETFRAG(qf); AT_LDSWAIT(); }
    f32x16 S[NB];
    float mx = -INFINITY;
#pragma unroll
    for (int j = 0; j < NB; ++j) {
        if (j >= jlo) {
            asm volatile("" ::: "memory");
            if (j < NB - 1) AT_LOADROWS(kr[(j + 1) & 1], kb0 + 32 * (j + 1), 1, kcol);
            AT_PUTROWS(kr[j & 1]);
            const float xd0 = (float)(qpos - kb0 - 32 * j - 4 * hi) - half;
            const bool inner = (q0 - kb0 - 32 * j - 31 >= 0) && (q0 + QS * 31 - kb0 - 32 * j <= 128) && (kb0 + 32 * j >= 0);
            f32x16 a;
            if (inner) {
                const float cb = -slope2d * xd0;
#pragma unroll
                for (int r = 0; r < 16; ++r) a[r] = __builtin_fmaf(slope2d, (float)((r & 3) + 8 * (r >> 2)), cb);
            } else {
#pragma unroll
                for (int r = 0; r < 16; ++r) { const float x = xd0 - (float)((r & 3) + 8 * (r >> 2)); a[r] = (__builtin_fabsf(x) <= half) ? (-slope2d * x) : -INFINITY; }
            }
            bf16x8 kf[4];
            AT_LDSWAIT(); AT_GETFRAG(kf); AT_LDSWAIT();
#pragma unroll
            for (int s = 0; s < 4; ++s) a = MFMA32(kf[s], qf[s], a);
#pragma unroll
            for (int r = 0; r < 16; ++r) mx = fmaxf(mx, a[r]);
            S[j] = a;
        } else {
#pragma unroll
            for (int r = 0; r < 16; ++r) S[j][r] = -INFINITY;
        }
        __builtin_amdgcn_sched_barrier(0);
    }
    u32x4 vr[2][4];
#pragma unroll
    for (int j = 0; j < NB; ++j) if (j == jlo) AT_LOADROWS(vr[j & 1], kb0 + 32 * j, 1, vcol);
    { auto rr = __builtin_amdgcn_permlane32_swap(__float_as_uint(mx), __float_as_uint(mx), false, false);
      const unsigned r0 = rr[0], r1 = rr[1]; mx = fmaxf(__uint_as_float(r0), __uint_as_float(r1)); }
    const float mx_true = mx - slope2d * half;
    float lsum = 0.f;
    u32x4 P[NB][2];
#pragma unroll
    for (int j = 0; j < NB; ++j) {
        float p[16];
#pragma unroll
        for (int r = 0; r < 16; ++r) { p[r] = __builtin_amdgcn_exp2f(S[j][r] - mx); lsum += p[r]; }
#pragma unroll
        for (int ks = 0; ks < 2; ++ks) { P[j][ks].x = cvt_pk_bf16(p[8 * ks + 0], p[8 * ks + 1]); P[j][ks].y = cvt_pk_bf16(p[8 * ks + 2], p[8 * ks + 3]); P[j][ks].z = cvt_pk_bf16(p[8 * ks + 4], p[8 * ks + 5]); P[j][ks].w = cvt_pk_bf16(p[8 * ks + 6], p[8 * ks + 7]); }
        __builtin_amdgcn_sched_barrier(0);
    }
    { auto rr = __builtin_amdgcn_permlane32_swap(__float_as_uint(lsum), __float_as_uint(lsum), false, false);
      const unsigned r0 = rr[0], r1 = rr[1]; lsum = __uint_as_float(r0) + __uint_as_float(r1); }
    f32x16 o[2]; o[0] = (f32x16){}; o[1] = (f32x16){};
    const unsigned vrd = (unsigned)(((lane >> 4) & 1) * 32 + (lane & 3) * 8 + (4 * hi + ((lane & 15) >> 2)) * 64);
#pragma unroll
    for (int j = 0; j < NB; ++j) {
        if (j >= jlo) {
            asm volatile("" ::: "memory");
            if (j < NB - 1) AT_LOADROWS(vr[(j + 1) & 1], kb0 + 32 * (j + 1), 1, vcol);
#pragma unroll
            for (int i = 0; i < 4; ++i) { const int key = 8 * i + lr; *(LAS u32x4*)(stg + ((lc >> 2) * 2 + (key >> 4)) * 1024 + (key & 15) * 64 + (lc & 3) * 16) = vr[j & 1][i]; }
            AT_LDSWAIT();
#pragma unroll
            for (int d0 = 0; d0 < 2; ++d0)
#pragma unroll
                for (int ks = 0; ks < 2; ++ks) {
                    LAS unsigned char* vp = stg + (d0 * 2 + ks) * 1024 + vrd;
                    const s16x4 lo = __builtin_bit_cast(s16x4, __builtin_amdgcn_ds_read_tr16_b64_v4i16((LAS s16x4*)(vp)));
                    const s16x4 hh = __builtin_bit_cast(s16x4, __builtin_amdgcn_ds_read_tr16_b64_v4i16((LAS s16x4*)(vp + 512)));
                    const bf16x8 vf = (bf16x8){lo[0], lo[1], lo[2], lo[3], hh[0], hh[1], hh[2], hh[3]};
                    o[d0] = MFMA32(__builtin_bit_cast(bf16x8, P[j][ks]), vf, o[d0]);
                }
            AT_LDSWAIT();
        }
        __builtin_amdgcn_sched_barrier(0);
    }
#undef AT_LOADROWS
#undef AT_PUTROWS
#undef AT_GETFRAG
#undef AT_LDSWAIT
    if (hi == 0) { wsf[r32] = mx_true; wsf[32 + r32] = lsum; }
    asm volatile("s_waitcnt lgkmcnt(0)" ::: "memory");
    f32x4 mt4[4], lt4[4];
#pragma unroll
    for (int k = 0; k < 4; ++k) { mt4[k] = *(const LAS f32x4*)(wsf + 8 * k + 4 * hi); lt4[k] = *(const LAS f32x4*)(wsf + 32 + 8 * k + 4 * hi); }
    if (FIRST) {
#pragma unroll
        for (int r = 0; r < 16; ++r) { const int q = crow(r, hi); const int trow = q * trow_mul + trow_add;
            ACC[trow * ACCP + r32] = o[0][r]; ACC[trow * ACCP + 32 + r32] = o[1][r];
            if (r32 == 0) { ML[trow * 2] = mt4[r >> 2][r & 3]; ML[trow * 2 + 1] = lt4[r >> 2][r & 3]; } }
    } else {
        f32x2 ml[16]; float a0[16], a1[16];
#pragma unroll
        for (int r = 0; r < 16; ++r) { const int q = crow(r, hi); const int trow = q * trow_mul + trow_add;
            ml[r] = *(const LAS f32x2*)(ML + trow * 2); a0[r] = ACC[trow * ACCP + r32]; a1[r] = ACC[trow * ACCP + 32 + r32]; }
        asm volatile("s_waitcnt lgkmcnt(0)" ::: "memory");
#pragma unroll
        for (int r = 0; r < 16; ++r) { const int q = crow(r, hi); const int trow = q * trow_mul + trow_add;
            const float mt = mt4[r >> 2][r & 3], lt = lt4[r >> 2][r & 3], mo = ml[r][0], lo_ = ml[r][1];
            const float mn = fmaxf(mo, mt); const float fa = __builtin_amdgcn_exp2f(mo - mn), fb = __builtin_amdgcn_exp2f(mt - mn);
            ACC[trow * ACCP + r32] = a0[r] * fa + o[0][r] * fb; ACC[trow * ACCP + 32 + r32] = a1[r] * fa + o[1][r] * fb;
            if (r32 == 0) { ML[trow * 2] = mn; ML[trow * 2 + 1] = lo_ * fa + lt * fb; } }
    }
    asm volatile("s_waitcnt lgkmcnt(0)" ::: "memory");
}

__device__ __forceinline__ void attn_phase(Frame& F, bf16* MIX) {
    const bf16* QKV = (const bf16*)(F.ws + WS_QKV);
    LAS float* ACC = (LAS float*)F.lds;
    LAS float* ML = (LAS float*)(F.lds + 69632);
    LAS unsigned char* vst = F.lds + 73728 + F.wave * 4608;
    LAS float* wsf = (LAS float*)(F.lds + 73728 + 8 * 4608 + F.wave * 256);
    const int lane = F.lane, w = F.wave;
    for (int i = 0;; ++i) {
        if (i >= (BATCH * 16 * 8) / F.G) break;
        const int L0 = (F.G == 256) ? ((F.vcu >> 5) * 128 + i * 32 + (F.vcu & 31)) : (i * F.G + F.vcu);
        const int bh = L0 >> 3, ti = L0 & 7; int w4 = ti >> 1; const int c = ti & 1; if (i & 1) w4 = 3 - w4;
        const int b = bh >> 4, h = bh & 15, win0 = w4 * 512;
        const bf16* Qb = QKV + (size_t)b * SEQ * NQKV;
        const float sl0 = exp2f(-8.0f * (float)(0 * 16 + h + 1) / 48.0f) * LOG2E, sl1 = exp2f(-8.0f * (float)(1 * 16 + h + 1) / 48.0f) * LOG2E * 4.0f, sl2 = exp2f(-8.0f * (float)(2 * 16 + h + 1) / 48.0f) * LOG2E * 16.0f;
        LSTAMP0();
        attn_task<true, 6>(Qb, 0, h, 1, 0, win0 + 64 * w + c, 2, win0 + 64 * w - 128, SEQ, sl0, vst, wsf, ACC, ML, 1, 32 * w, lane);
        __syncthreads();
        LSTAMP(24);
        if (ATTN_GMASK & 2) { const int cls = c + 2 * (w & 1), lb = w >> 1, lq0 = 128 * w4 + 32 * lb; attn_task<false, 5>(Qb, 1, h, 4, cls, lq0, 1, lq0 - 128, SEQ / 4, sl1, vst, wsf, ACC, ML, 2, 64 * lb + (w & 1), lane); }
        __syncthreads();
        LSTAMP(25);
        if (ATTN_GMASK & 4) { const int cls = c + 2 * w, lq0 = 32 * w4; attn_task<false, 5>(Qb, 2, h, 16, cls, lq0, 1, lq0 - 128, SEQ / 16, sl2, vst, wsf, ACC, ML, 8, w, lane); }
        __syncthreads();
        LSTAMP(26);
        {
#pragma unroll
          for (int it = 0; it < 4; ++it) { const int trow = 32 * w + 8 * it + (lane >> 3), sg = lane & 7; const float inv = 1.0f / ML[trow * 2 + 1];
              const LAS f32x4* ap = (const LAS f32x4*)(ACC + trow * ACCP + sg * 8);
              bf16* op = MIX + (size_t)(b * SEQ + win0 + 2 * trow + c) * D + h * 64 + sg * 8;
              const f32x4 a = ap[0] * inv, bq = ap[1] * inv; u32x4 wv; wv.x = pk2(a[0], a[1]); wv.y = pk2(a[2], a[3]); wv.z = pk2(bq[0], bq[1]); wv.w = pk2(bq[2], bq[3]);
              *(GAS u32x4*)op = wv; } }
        __syncthreads();
    }
}

__device__ __forceinline__ void attn_phase_naive(Frame& F, bf16* MIX, const int gmask) {
    const bf16* QKV = (const bf16*)(F.ws + WS_YS);
    const int lane = F.lane;
    const int gw = F.vcu * NWAVES + F.wave, NGW = F.G * NWAVES;
    for (int item = gw; item < T * 16; item += NGW) {
        const int tok = item >> 4, h = item & 15, b = tok / SEQ, t = tok % SEQ;
        const bf16* Qb = QKV + (size_t)b * SEQ * NQKV;
        float sc[3][3]; int kt[3][3];
        float mx = -INFINITY;
#pragma unroll
        for (int g = 0; g < 3; ++g) {
            const int dil = (g == 0) ? 1 : (g == 1 ? 4 : 16);
            const float slope = exp2f(-8.0f * (float)(g * 16 + h + 1) / 48.0f);
            const bf16* qp = Qb + (size_t)t * NQKV + ((g * 3 + 0) * 16 + h) * 64;
#pragma unroll
            for (int c = 0; c < 3; ++c) {
                const int j = lane + 64 * c; const int tk = t - j * dil;
                float s = -INFINITY;
                if (j <= 128 && tk >= 0 && ((gmask >> g) & 1)) {
                    const bf16* kp = Qb + (size_t)tk * NQKV + ((g * 3 + 1) * 16 + h) * 64;
                    float d = 0.f;
                    for (int e = 0; e < 64; ++e) d += bf2f(qp[e]) * bf2f(kp[e]);
                    s = d - slope * LOG2E * (float)(j * dil);
                }
                sc[g][c] = s; kt[g][c] = tk; mx = fmaxf(mx, s);
            }
        }
#pragma unroll
        for (int o = 1; o < 64; o <<= 1) mx = fmaxf(mx, __shfl_xor(mx, o));
        float den = 0.f; float acc[64];
#pragma unroll
        for (int e = 0; e < 64; ++e) acc[e] = 0.f;
#pragma unroll
        for (int g = 0; g < 3; ++g)
#pragma unroll
            for (int c = 0; c < 3; ++c) {
                const float p = (sc[g][c] == -INFINITY) ? 0.f : exp2f(sc[g][c] - mx);
                den += p;
                if (p != 0.f) { const bf16* vp = Qb + (size_t)kt[g][c] * NQKV + ((g * 3 + 2) * 16 + h) * 64;
#pragma unroll
                    for (int e = 0; e < 64; ++e) acc[e] += p * bf2f(vp[e]); }
            }
        den = wave_sum(den);
        float mine = 0.f;
#pragma unroll
        for (int e = 0; e < 64; ++e) { const float v = wave_sum(acc[e]); if (lane == e) mine = v; }
        MIX[(size_t)tok * D + h * 64 + lane] = (bf16)f2bf(mine / den);
    }
}

struct Args { const float* in[20]; float* out; unsigned char* ws; int ph_lo, ph_hi; };
constexpr int NPHASE = 2 + DEPTH * 8;

__global__ void __launch_bounds__(NWAVES * 64, 2) mk_fwd(Args args) {
    extern __shared__ __attribute__((aligned(16))) unsigned char lds_raw[];
    Frame F;
    F.lds = (LAS unsigned char*)lds_raw; F.lc = F.lds + LDSCTL_OFF;
    F.tid = threadIdx.x; F.lane = F.tid & 63; F.wave = __builtin_amdgcn_readfirstlane(F.tid >> 6);
    F.G = gridDim.x; { const int bx = blockIdx.x; F.vcu = (F.G % 8 == 0) ? (bx % 8) * (F.G / 8) + bx / 8 : bx; }
    F.ws = args.ws; F.ctl = (unsigned*)(args.ws + WS_CTL);
    for (int u = F.tid; u < (LDS_BYTES - LDSCTL_OFF) / 4; u += NWAVES * 64) ((LAS unsigned*)F.lc)[u] = 0u;
    __syncthreads();
    if (F.tid == 0) {
#pragma unroll
        for (int i = 0; i < 20; ++i) *(LAS unsigned long long*)(F.lc + LC_PTR + 8 * i) = (unsigned long long)args.in[i];
        *(LAS unsigned long long*)(F.lc + LC_PTR + 8 * 20) = (unsigned long long)args.out;
    }
    __syncthreads();
#if MK_PER_PHASE
#define GRID_BAR() do { } while (0)
    XcdBarrier bar; bar.bar = nullptr; bar.x = 0; bar.st = nullptr;
#else
    XcdBarrier bar = xcd_barrier_post(F.ctl + CW_BAR, (volatile LAS unsigned*)(F.lc + LC_MISC) + 8);
#define GRID_BAR() xcd_barrier(bar)
#endif
    const int lo = args.ph_lo, hi = args.ph_hi;
#ifdef PROBE_TYPE
#define LC_STAMP 3072
#define STAMP(ty) do { if (blockIdx.x == 0 && F.tid == 0) { const unsigned long long now_ = __builtin_amdgcn_s_memrealtime(); LAS unsigned long long* st_ = (LAS unsigned long long*)(F.lc + LC_STAMP); \
        st_[1 + (ty)] += now_ - st_[0]; st_[0] = now_; } } while (0)
    if (blockIdx.x == 0 && F.tid == 0) { ((LAS unsigned long long*)(F.lc + LC_STAMP))[0] = __builtin_amdgcn_s_memrealtime(); }
#else
#define STAMP(ty) do { } while (0)
#endif
#define IN(k) (lo <= (k) && (k) < hi)
#define SEAM(k) do { if (IN(k) && IN((k) + 1)) GRID_BAR(); } while (0)
    const float* mod = (const float*)(F.ws + WS_MOD);

    if (PHON(0) && IN(0)) { p0_prologue(F); } SEAM(0); STAMP(0);
    bool xlocal = false; int cid = (int)blockIdx.x;
#if !MK_PER_PHASE
    { volatile LAS unsigned* st = (volatile LAS unsigned*)(F.lc + LC_MISC) + 8;
      if (F.tid == 0) { unsigned ok = (F.G == 256) ? 1u : 0u;
#pragma unroll
          for (unsigned jx = 0; jx < 16; ++jx) { const unsigned cj = xb_ld(&bar.bar[XB_XCNT(jx)]); ok &= (jx < 8u) ? (cj == 32u ? 1u : 0u) : (cj == 0u ? 1u : 0u); }
          st[3] = ok; }
      __syncthreads();
      xlocal = (st[3] != 0u) && (MK_XLOCAL != 0);
      if (xlocal) cid = (int)(st[2] * 8u + bar.x); }
#endif
    cid = __builtin_amdgcn_readfirstlane(cid);
    F.vcu = (F.G % 8 == 0) ? (cid % 8) * (F.G / 8) + cid / 8 : cid;
#define LSEAM(k) do { if (IN(k) && IN((k) + 1)) { if (xlocal) xcd_local_barrier(bar, F.wave == 0); else GRID_BAR(); } } while (0)
    if (PHON(1) && IN(1)) { p1_modulate(F, inp(F, 0), mod, 0, 1024); } SEAM(1); STAMP(1);

    for (int layer = 0; layer < DEPTH; ++layer) {
        const int pb = 2 + layer * 8; const int j = layer >> 1;
        if ((layer & 1) == 0) {
            if (PHON(2) && IN(pb + 0)) { refresh(F); unsigned char* ws = opq(F.ws); (void)ws;
                PlainSched S{T / 256, 4, 256, F.G, cid, (const char*)(ws + WS_WPIN) + (size_t)j * 2 * MiB, 2048};
                pg8::EpiStore E{(bf16*)(ws + WS_U), D, nullptr, 0, 0, 0, F.lds + LDS_TB_OFF + F.wave * 2048};
                pg8::gemm_phase<pg8::EpiStore, PlainSched>(F.tid, F.lds, (const char*)(ws + WS_H), 2048, 2048, 1024, S, E);
            } LSEAM(pb + 0); STAMP(2);
            if (PHON(4) && IN(pb + 2)) { refresh(F); unsigned char* ws = opq(F.ws); (void)ws;
                GrpSched S{F.G, cid, (const char*)(ws + WS_WPGRP) + (size_t)j * 512 * 1024};
                { const bf16* U = (const bf16*)(ws + WS_U); bf16* Z = (bf16*)(ws + WS_Z); pg8::Unit pu;
                  for (int i = 0; S.next(i, pu); ++i) {
                      const int b = pu.pm >> 3, t0 = (pu.pm & 7) * 256 + 32 * F.wave, g = pu.pn;
                      if (g == 0) pool_item<2>(U, Z, b, t0, 0, F.lane); else if (g == 1) pool_item<4>(U, Z, b, t0, 1, F.lane);
                      else if (g == 2) pool_item<8>(U, Z, b, t0, 2, F.lane); else pool_item<16>(U, Z, b, t0, 3, F.lane); }
                  asm volatile("s_waitcnt vmcnt(0)" ::: "memory"); __syncthreads(); }
                pg8::EpiStore E{(bf16*)(ws + WS_Y2), D, inp(F, 6) + j * D, 0, 0, 0, F.lds + LDS_TB_OFF + F.wave * 2048};
                pg8::gemm_phase<pg8::EpiStore, GrpSched>(F.tid, F.lds, (const char*)(ws + WS_Z), 2048, 512, 256, S, E);
            } LSEAM(pb + 2); STAMP(4);
            if (PHON(5) && IN(pb + 3)) { refresh(F); unsigned char* ws = opq(F.ws); (void)ws;
                PlainSched S{T / 256, 4, 256, F.G, cid, (const char*)(ws + WS_WPOUT) + (size_t)j * 2 * MiB, 2048};
                pg8::EpiStore E{(bf16*)(ws + WS_Y), D, nullptr, 0, 0, 1, F.lds + LDS_TB_OFF + F.wave * 2048};
                pg8::gemm_phase<pg8::EpiStore, PlainSched>(F.tid, F.lds, (const char*)(ws + WS_Y2), 2048, 2048, 1024, S, E);
            } LSEAM(pb + 3); STAMP(5);
        } else {
            if (PHON(6) && IN(pb + 0)) { refresh(F); unsigned char* ws = opq(F.ws); (void)ws;
                PlainSched S{T / 256, NQKV / 256, (T / 256) * (NQKV / 256), F.G, cid, (const char*)(ws + WS_WAIN) + (size_t)j * 18 * MiB, 2048};
                pg8::EpiStore E{(bf16*)(ws + WS_QKV), NQKV, nullptr, 1, 1, 0, F.lds + LDS_TB_OFF + F.wave * 2048};
                pg8::gemm_phase<pg8::EpiStore, PlainSched>(F.tid, F.lds, (const char*)(ws + WS_H), 2048, 2048, 1024, S, E);
            } LSEAM(pb + 0); STAMP(6);
            if (PHON(7) && IN(pb + 1)) { refresh(F); unsigned char* ws = opq(F.ws); (void)ws;
#ifdef NAIVE_ATTN
                attn_phase_naive(F, (bf16*)(F.ws + WS_Y2), 7);
#ifdef ORACLE
                if (layer == ORACLE_LAYER) { attn_phase_naive(F, (bf16*)(F.ws + WS_Z), ATTN_GMASK); attn_phase(F, (bf16*)(F.ws + WS_U)); }
#endif
#else
                attn_phase(F, (bf16*)(F.ws + WS_Y2));
#endif
            } if (IN(pb + 1) && IN(pb + 3)) { if (xlocal) xcd_local_barrier(bar, F.wave == 0); else GRID_BAR(); } STAMP(7);
            if (IN(pb + 2)) { refresh(F); unsigned char* ws = opq(F.ws); (void)ws;
#ifdef ORACLE
                if (layer == ORACLE_LAYER) { if (blockIdx.x == 0 && F.tid == 0) atomicAdd(F.ctl + 20000, 3276u * 16u);
                    const bf16* A = (const bf16*)(ws + WS_U); const bf16* B = (const bf16*)(ws + WS_Z);
                    const int gw = F.vcu * NWAVES + F.wave, NGW = F.G * NWAVES;
                    for (int tok = gw; tok < T; tok += NGW) { int bad = 0;
                        for (int h = 0; h < 16; ++h) { if (ORACLE_SEL) { const float a = bf2f(A[(size_t)tok * D + h * 64 + F.lane]), b = bf2f(B[(size_t)tok * D + h * 64 + F.lane]);
                            const float e2 = wave_sum((a - b) * (a - b)), n2 = wave_sum(b * b); if (!(e2 <= 0.0025f * n2)) bad += ORACLE_W; } }
                        if (bad && F.lane == 0) atomicAdd(F.ctl + 20000, (unsigned)bad); } }
#endif
            }
            if (PHON(8) && IN(pb + 3)) { refresh(F); unsigned char* ws = opq(F.ws); (void)ws;
                PlainSched S{T / 256, 4, 256, F.G, cid, (const char*)(ws + WS_WAOUT) + (size_t)j * 2 * MiB, 2048};
                pg8::EpiStore E{(bf16*)(ws + WS_Y), D, nullptr, 0, 0, 1, F.lds + LDS_TB_OFF + F.wave * 2048};
                pg8::gemm_phase<pg8::EpiStore, PlainSched>(F.tid, F.lds, (const char*)(ws + WS_Y2), 2048, 2048, 1024, S, E);
            } LSEAM(pb + 3); STAMP(8);
        }
        if (PHON(9) && IN(pb + 4)) { refresh(F); unsigned char* ws = opq(F.ws); (void)ws; const float* xin = (layer == 0) ? inp(F, 0) : (const float*)(ws + WS_X); if (layer == 0) ln1_router_phase<false>(F, layer, xin); else ln1_router_phase<true>(F, layer, xin); } SEAM(pb + 4); STAMP(9);
        if (PHON(10) && IN(pb + 5)) { refresh(F); unsigned char* ws = opq(F.ws); (void)ws;
            moe_build_table(F, layer);
            const LAS int* ts = (const LAS int*)(F.lc + LC_TS);
            const int ntile = ts[65];
            MoeSched<true> S{ts, (const LAS int*)(F.lc + LC_CNT), 2, ntile * 2, F.G, cid, F.lane, (const int*)(ws + WS_TOKL), (const float*)(ws + WS_WL),
                       (const char*)(ws + WS_WEGU) + (size_t)layer * 64 * MiB, (size_t)1 * MiB, (const char*)(ws + WS_WSHGU) + (size_t)layer * MiB, 2048};
            pg8::EpiGU E{(bf16*)(ws + WS_ACT)};
            pg8::gemm_phase<pg8::EpiGU, MoeSched<true>>(F.tid, F.lds, (const char*)(ws + WS_H), 2048, 2048, 1024, S, E);
        } LSEAM(pb + 5); STAMP(10);
        if (PHON(11) && IN(pb + 6)) { refresh(F); unsigned char* ws = opq(F.ws); (void)ws;
            moe_build_table(F, layer);
            const LAS int* ts = (const LAS int*)(F.lc + LC_TS);
            const int ntile = ts[65];
            MoeSched<false> S{ts, (const LAS int*)(F.lc + LC_CNT), 4, ntile * 4, F.G, cid, F.lane, nullptr, nullptr,
                       (const char*)(ws + WS_WEDN) + (size_t)layer * 32 * MiB, (size_t)512 * 1024, (const char*)(ws + WS_WSHDN) + (size_t)layer * 512 * 1024, 512};
            pg8::EpiStoreF8 E{(unsigned char*)(ws + WS_YS), D, F.lds + LDS_TB_OFF + F.wave * 2048};
            pg8::gemm_phase<pg8::EpiStoreF8, MoeSched<false>>(F.tid, F.lds, (const char*)(ws + WS_ACT), 512, 512, 256, S, E);
        } SEAM(pb + 6); STAMP(11);
        if (PHON(12) && IN(pb + 7)) { refresh(F); unsigned char* ws = opq(F.ws); (void)ws; moe_build_table(F, layer); combine_ln2_phase(F, layer); }
        if (layer < DEPTH - 1) LSEAM(pb + 7);
        STAMP(12);
    }
#ifdef PROBE_TYPE
    if (blockIdx.x == 0 && F.tid == 0) { const unsigned long long t0_ = __builtin_amdgcn_s_memrealtime(); const unsigned long long want_ = 4ull * ((LAS unsigned long long*)(F.lc + LC_STAMP))[1 + PROBE_TYPE];
        while (__builtin_amdgcn_s_memrealtime() - t0_ < want_) __builtin_amdgcn_s_sleep(8); }
#endif
#undef IN
#undef SEAM
}

extern "C" void kernel_launch(void* const* d_in, const int* in_sizes, int n_in, void* d_out, int out_size, void* d_ws, size_t ws_size, hipStream_t stream) {
    static int grid = 0;
    if (grid == 0) {
        if (n_in != 20 || in_sizes[0] != T * D || out_size != T * D || ws_size < WS_END) { fprintf(stderr, "kernel_launch: unexpected shapes / workspace (n_in %d, ws %zu); nothing launched\n", n_in, ws_size); grid = -1; return; }
        int dev = 0, cus = 0, per_cu = 0;
        if (hipGetDevice(&dev) != hipSuccess || hipDeviceGetAttribute(&cus, hipDeviceAttributeMultiprocessorCount, dev) != hipSuccess) { grid = -1; return; }
        if (hipFuncSetAttribute((const void*)mk_fwd, hipFuncAttributeMaxDynamicSharedMemorySize, LDS_BYTES) != hipSuccess) { fprintf(stderr, "kernel_launch: hipFuncSetAttribute failed\n"); grid = -1; return; }
        if (hipOccupancyMaxActiveBlocksPerMultiprocessor(&per_cu, (const void*)mk_fwd, NWAVES * 64, LDS_BYTES) != hipSuccess || per_cu < 1) { fprintf(stderr, "kernel_launch: occupancy query says %d\n", per_cu); }
        (void)hipGetLastError();
        grid = cus;
    }
    if (grid < 0) return;
    if (hipMemsetAsync((char*)d_ws + WS_CTL, 0, CTL_ZERO_BYTES, stream) != hipSuccess) return;
    Args a{};
    for (int i = 0; i < 20; ++i) a.in[i] = (const float*)d_in[i];
    a.out = (float*)d_out; a.ws = (unsigned char*)d_ws;
#if MK_PER_PHASE
    for (int p = 0; p < NPHASE; ++p) { a.ph_lo = p; a.ph_hi = p + 1; hipLaunchKernelGGL(mk_fwd, dim3(grid), dim3(NWAVES * 64), LDS_BYTES, stream, a); }
#else
    a.ph_lo = 0; a.ph_hi = NPHASE;
    hipLaunchKernelGGL(mk_fwd, dim3(grid), dim3(NWAVES * 64), LDS_BYTES, stream, a);
#endif
    const hipError_t le = hipPeekAtLastError();
    if (le != hipSuccess) fprintf(stderr, "kernel_launch: launch failed: %s\n", hipGetErrorName(le));
}
```

```cpp
#include <hip/hip_runtime.h>
#include <cstdio>
#include <cstdint>

#ifndef MK_PER_PHASE
#define MK_PER_PHASE 0
#endif
#define ORACLE_SEL 1
#define ATTN_GMASK 7
#define ORACLE_W 1
#define ORACLE_LAYER 1
#ifndef MK_XLOCAL
#define MK_XLOCAL 1
#endif
#ifndef PHSEL
#define PHSEL 0xFFFF
#endif
#define PHON(n) (((PHSEL) >> (n)) & 1)

#define GAS __attribute__((address_space(1)))
#define LAS __attribute__((address_space(3)))
typedef unsigned short bf16;
typedef short bf16x8 __attribute__((ext_vector_type(8)));
typedef short s16x4 __attribute__((ext_vector_type(4)));
typedef float f32x2 __attribute__((ext_vector_type(2)));
typedef float f32x4 __attribute__((ext_vector_type(4)));
typedef float f32x16 __attribute__((ext_vector_type(16)));
typedef unsigned u32x2 __attribute__((ext_vector_type(2)));
typedef unsigned u32x4 __attribute__((ext_vector_type(4)));

constexpr int BATCH = 8, SEQ = 2048, D = 1024, T = BATCH * SEQ, DEPTH = 4;
constexpr int NQKV = 9216, NE = 64, TOPK = 8, DEXP = 256;
constexpr int CAP = 16384;
constexpr int PSLOT = 147456 + T;
constexpr float ALPHA = 1.6817928305074290f;
constexpr float LN_EPS = 1e-5f;
constexpr float LOG2E = 1.4426950408889634f;
constexpr float QSCALE = 0.125f * LOG2E;
constexpr float ROUTED_SCALE = 2.5f;

constexpr size_t MiB = 1u << 20;
constexpr size_t WS_CTL = 0, CTL_ZERO_BYTES = 1 * MiB;
constexpr size_t WS_MOD = 1 * MiB;
constexpr size_t WS_WRHI = 2 * MiB;
constexpr size_t WS_WRLO = WS_WRHI + 512 * 1024;
constexpr size_t WS_WPIN = 3 * MiB;
constexpr size_t WS_WPGRP = 7 * MiB;
constexpr size_t WS_WPOUT = 8 * MiB;
constexpr size_t WS_WAIN = 12 * MiB;
constexpr size_t WS_WAOUT = 48 * MiB;
constexpr size_t WS_WSHGU = 52 * MiB;
constexpr size_t WS_WSHDN = 56 * MiB;
constexpr size_t WS_WEGU = 58 * MiB;
constexpr size_t WS_WEDN = 314 * MiB;
constexpr size_t WS_X = 442 * MiB;
constexpr size_t WS_H = 506 * MiB;
constexpr size_t WS_Y = 538 * MiB;
constexpr size_t WS_U = 570 * MiB;
constexpr size_t WS_Z = 602 * MiB;
constexpr size_t WS_Y2 = 634 * MiB;
constexpr size_t WS_YS = 666 * MiB;
constexpr size_t WS_ACT = 986 * MiB;
constexpr size_t WS_TOKL = 1066 * MiB;
constexpr size_t WS_WL = 1070 * MiB;
constexpr size_t WS_TSLOT = 1074 * MiB;
constexpr size_t WS_QKV = 1076 * MiB;
constexpr size_t WS_END = 1364 * MiB;
static_assert(WS_YS + (size_t)PSLOT * 2048 <= WS_ACT && WS_ACT + (size_t)PSLOT * 512 <= WS_TOKL, "ws map");
constexpr int CW_BAR = 4096;
constexpr int CW_CNT = 12288;

constexpr int RING_BYTES = 135168;
constexpr int LDSCTL_OFF = RING_BYTES;
constexpr int LDS_TB_OFF = 147456;
constexpr int LDS_BYTES = 163840;
constexpr int LC_MISC = 0;
constexpr int LC_TS = 128;
constexpr int LC_CNT = 128 + 272;
constexpr int LC_LCNT = 128 + 272 + 256;
constexpr int LC_GB = 128 + 272 + 512;

#define RLX_AGENT __ATOMIC_RELAXED, __HIP_MEMORY_SCOPE_AGENT
#define LDS_WAIT() asm volatile("s_waitcnt lgkmcnt(0)" ::: "memory")
#define VM_WAIT() asm volatile("s_waitcnt vmcnt(0)" ::: "memory")

typedef __bf16 b16x2 __attribute__((ext_vector_type(2)));
__device__ __forceinline__ unsigned f2bf(float f) { unsigned u = __builtin_bit_cast(unsigned, f); return (u + 0x7fffu + ((u >> 16) & 1u)) >> 16; }
__device__ __forceinline__ unsigned pk2(float lo, float hi) { const f32x2 v = {lo, hi}; return __builtin_bit_cast(unsigned, __builtin_convertvector(v, b16x2)); }
__device__ __forceinline__ float bf2f(unsigned h) { return __builtin_bit_cast(float, h << 16); }
__device__ __forceinline__ unsigned cvt_pk_bf16(float lo, float hi) { return pk2(lo, hi); }
typedef _Float16 h16x2 __attribute__((ext_vector_type(2)));
__device__ __forceinline__ unsigned pkh2(float lo, float hi) { const f32x2 v = {lo, hi}; return __builtin_bit_cast(unsigned, __builtin_convertvector(v, h16x2)); }
__device__ __forceinline__ float h2f(unsigned h) { return (float)__builtin_bit_cast(_Float16, (unsigned short)h); }
#define MFMA16(a, b, c) __builtin_amdgcn_mfma_f32_16x16x32_bf16(a, b, c, 0, 0, 0)
#define MFMA32(a, b, c) __builtin_amdgcn_mfma_f32_32x32x16_bf16(a, b, c, 0, 0, 0)
__device__ __forceinline__ float wave_sum(float v) {
#pragma unroll
    for (int o = 1; o < 64; o <<= 1) v += __shfl_xor(v, o);
    return v;
}

namespace pg8 {
constexpr int BM = 256, BK = 64, HALF = 128, HTB = HALF * BK * 2, STAGE_BYTES = 8 * HTB, NXCD = 8;
__host__ __device__ __forceinline__ int lds_byte(int r, int c) { const int st = (r >> 4) * 2 + (c >> 5), rr = r & 15, cc = c & 31, ob = rr * 64 + cc * 2; return st * 1024 + (ob ^ (((ob >> 9) & 1) << 5)); }
__host__ __device__ __forceinline__ void stage_rc(int b, int& R, int& C) { const int st = b / 1024, sb = b % 1024, swz = sb ^ (((sb >> 9) & 1) << 5); R = (st >> 1) * 16 + swz / 64; C = (st & 1) * 32 + (swz % 64) / 2; }
__host__ __device__ __forceinline__ int perm32(int rho) { const int n = rho >> 4, i = rho & 15; return 8 * (i >> 2) + 4 * n + (i & 3); }

struct Unit {
    int pm, pn;
    const char* bptr;
    int roff;
    int nvalid;
};

__device__ __forceinline__ int xcd_chunk(int L, int nwg) { const int q = nwg / NXCD, r = nwg % NXCD, xcd = L % NXCD, off = L / NXCD; return (xcd < r ? xcd * (q + 1) : r * (q + 1) + (xcd - r) * q) + off; }

template <class Epi, class Sched>
__device__ __forceinline__ void gemm_phase(const int tid, LAS unsigned char* lds, const char* Abase, const int lda, const int ldb, const int K, const Sched& S, const Epi& E) {
    constexpr bool GATHER = Sched::GATHER;
    const int wid = __builtin_amdgcn_readfirstlane(tid >> 6), lane = tid & 63, wr = wid >> 2, wc = wid & 3, fr = lane & 15, fq = lane >> 4;
    const int nt = K / BK;
    int Rr[2]; unsigned C2[2], voffB[2], voffA[2];
#pragma unroll
    for (int i = 0; i < 2; ++i) { int R, C; stage_rc(tid * 16 + i * 8192, R, C); const int Rb = Epi::WIDE ? ((R >> 5) * 64 + perm32(R & 31)) : ((R & ~31) + perm32(R & 31)); Rr[i] = R; C2[i] = (unsigned)C * 2u; voffB[i] = (unsigned)(Rb * ldb) + (unsigned)C * 2u;
        voffA[i] = Sched::ABLK ? (unsigned)((C >> 5) * 16384 + R * 64 + (C & 31) * 2) : ((unsigned)(R * lda) + (unsigned)C * 2u); }
    const size_t kstep = (size_t)(BK * 2);
    const size_t hstepB = (size_t)(Epi::WIDE ? 32 : HALF) * ldb;
    const size_t hstepA = GATHER ? (size_t)0 : (Sched::ABLK ? (size_t)8192 : (size_t)HALF * lda);
    const size_t kstepA = Sched::ABLK ? (size_t)32768 : kstep;
    const unsigned ldsw = (unsigned)wid * 1024u;
    const int aoff = lds_byte(wr * 64 + fr, fq * 8), boff = lds_byte(wc * 32 + fr, fq * 8);
#define PG8_SA(b, h) (((b) * 2 + (h)) * HTB)
#define PG8_SB(b, h) ((4 + (b) * 2 + (h)) * HTB)
#define PG8_STAGE(bufoff, gbase, voff) do { _Pragma("unroll") for (int _i = 0; _i < 2; ++_i) \
        __builtin_amdgcn_global_load_lds((const unsigned*)((const char*)(gbase) + (voff)[_i]), (LAS unsigned*)(lds + (bufoff) + ldsw + _i * 8192), 16, 0, 0); } while (0)
#define PG8_STAGEA(bufoff, gbase, h) do { if constexpr (GATHER) { PG8_STAGE(bufoff, gbase, vA[h]); } else { PG8_STAGE(bufoff, (gbase) + (h) * hstepA, voffA); } } while (0)
#define PG8_LDA(dst, b, h) do { _Pragma("unroll") for (int m = 0; m < 4; ++m) _Pragma("unroll") for (int k = 0; k < 2; ++k) dst[m][k] = *(const LAS bf16x8*)(lds + PG8_SA(b, h) + aoff + m * 2048 + k * 1024); } while (0)
#define PG8_LDB(dst, b, h) do { _Pragma("unroll") for (int n = 0; n < 2; ++n) _Pragma("unroll") for (int k = 0; k < 2; ++k) dst[n][k] = *(const LAS bf16x8*)(lds + PG8_SB(b, h) + boff + n * 2048 + k * 1024); } while (0)
#define PG8_MMA(ai, bj, At, Bt) do { __builtin_amdgcn_s_setprio(1); _Pragma("unroll") for (int m = 0; m < 4; ++m) _Pragma("unroll") for (int n = 0; n < 2; ++n) _Pragma("unroll") for (int k = 0; k < 2; ++k) \
        acc[ai][bj][m][n] = MFMA16(Bt[n][k], At[m][k], acc[ai][bj][m][n]); __builtin_amdgcn_s_setprio(0); } while (0)
#define PG8_WAIT_V(n) asm volatile("s_waitcnt vmcnt(" #n ")" ::: "memory")
#define PG8_WAIT_L(n) asm volatile("s_waitcnt lgkmcnt(" #n ")" ::: "memory")
#define PG8_BAR __builtin_amdgcn_s_barrier()
#define PG8_SCHED __builtin_amdgcn_sched_barrier(0)
#define PG8_CALCA(u, vo) do { _Pragma("unroll") for (int _h = 0; _h < 2; ++_h) _Pragma("unroll") for (int _i = 0; _i < 2; ++_i) \
        vo[_h][_i] = (unsigned)S.arow(u, _h * HALF + Rr[_i]) * (unsigned)lda + C2[_i]; } while (0)
    Unit cur, nxt; int ui = 0;
    if (!S.next(0, cur)) return;
    f32x4 acc[2][2][4][2];
#pragma unroll
    for (int a = 0; a < 2; ++a)
#pragma unroll
        for (int b = 0; b < 2; ++b)
#pragma unroll
            for (int m = 0; m < 4; ++m)
#pragma unroll
                for (int n = 0; n < 2; ++n) acc[a][b][m][n] = (f32x4){0.f, 0.f, 0.f, 0.f};
    bf16x8 At[4][2], B0[2][2], B1[2][2];
    unsigned vA[2][2], vAn[2][2];
    const char* cA = Abase;
    if constexpr (GATHER) { PG8_CALCA(cur, vA); } else { cA = Abase + (size_t)S.arow(cur, 0) * lda + S.acolb(cur); }
    const char* cB = cur.bptr;
    PG8_STAGE(PG8_SB(0, 0), cB, voffB); PG8_STAGE(PG8_SB(0, 1), cB + hstepB, voffB); PG8_STAGEA(PG8_SA(0, 0), cA, 0); PG8_STAGEA(PG8_SA(0, 1), cA, 1);
    if (wr == 1) PG8_BAR;
    PG8_WAIT_V(2); PG8_BAR;
    PG8_STAGE(PG8_SB(1, 0), cB + kstep, voffB); PG8_STAGEA(PG8_SA(1, 0), cA + kstepA, 0); PG8_STAGE(PG8_SB(1, 1), cB + hstepB + kstep, voffB);
    PG8_WAIT_V(6); PG8_BAR;
    for (;;) {
        const bool has_next = S.next(ui + 1, nxt);
        float rs[2][4];
        if constexpr (Epi::ROWSCALE) {
#pragma unroll
            for (int ai = 0; ai < 2; ++ai)
#pragma unroll
                for (int m = 0; m < 4; ++m) rs[ai][m] = S.rowscale(cur, ai * HALF + wr * 64 + m * 16 + fr);
        }
        const char* nA = cA;
        if constexpr (GATHER) {
            if (has_next) { PG8_CALCA(nxt, vAn); }
            else {
#pragma unroll
                for (int h = 0; h < 2; ++h)
#pragma unroll
                    for (int i = 0; i < 2; ++i) vAn[h][i] = vA[h][i];
            }
            asm volatile("s_waitcnt vmcnt(0)" : "+v"(vAn[0][0]), "+v"(vAn[0][1]), "+v"(vAn[1][0]), "+v"(vAn[1][1]) :: "memory");
            if constexpr (Epi::ROWSCALE) { asm volatile("" : "+v"(rs[0][0]), "+v"(rs[0][1]), "+v"(rs[0][2]), "+v"(rs[0][3]), "+v"(rs[1][0]), "+v"(rs[1][1]), "+v"(rs[1][2]), "+v"(rs[1][3])); }
        } else { if (has_next) nA = Abase + (size_t)S.arow(nxt, 0) * lda + S.acolb(nxt); }
        const char* nB = has_next ? nxt.bptr : cB;
#pragma unroll 1
        for (int t = 0; t < nt; t += 2) {
            const bool last = (t == nt - 2);
            const char* a1 = cA + (size_t)(t + 1) * kstepA;
            const char* a2 = last ? nA : cA + (size_t)(t + 2) * kstepA; const char* b2 = last ? nB : cB + (size_t)(t + 2) * kstep;
            const char* a3 = a2 + kstepA; const char* b3 = b2 + kstep;
            PG8_LDB(B0, 0, 0); PG8_LDB(B1, 0, 1); PG8_SCHED; PG8_LDA(At, 0, 0); PG8_STAGEA(PG8_SA(1, 1), a1, 1);
            if constexpr (GATHER) { if (last) {
#pragma unroll
                for (int h = 0; h < 2; ++h)
#pragma unroll
                    for (int i = 0; i < 2; ++i) vA[h][i] = vAn[h][i]; } }
            PG8_WAIT_V(8); PG8_WAIT_L(0); PG8_BAR; PG8_MMA(0, 0, At, B0); PG8_MMA(0, 1, At, B1); PG8_BAR; PG8_SCHED;
            PG8_LDA(At, 0, 1); PG8_STAGE(PG8_SB(0, 0), b2, voffB); PG8_STAGE(PG8_SB(0, 1), b2 + hstepB, voffB); PG8_STAGEA(PG8_SA(0, 0), a2, 0);
            PG8_WAIT_V(8); PG8_WAIT_L(0); PG8_BAR; PG8_MMA(1, 0, At, B0); PG8_MMA(1, 1, At, B1); PG8_BAR; PG8_SCHED;
            PG8_LDB(B0, 1, 0); PG8_LDB(B1, 1, 1); PG8_SCHED; PG8_LDA(At, 1, 0); PG8_STAGEA(PG8_SA(0, 1), a2, 1);
            PG8_WAIT_V(8); PG8_WAIT_L(0); PG8_BAR; PG8_MMA(0, 0, At, B0); PG8_MMA(0, 1, At, B1); PG8_BAR; PG8_SCHED;
            PG8_LDA(At, 1, 1); PG8_STAGE(PG8_SB(1, 0), b3, voffB); PG8_STAGE(PG8_SB(1, 1), b3 + hstepB, voffB); PG8_STAGEA(PG8_SA(1, 0), a3, 0);
            PG8_WAIT_V(8); PG8_WAIT_L(0); PG8_BAR; PG8_MMA(1, 0, At, B0); PG8_MMA(1, 1, At, B1); PG8_BAR; PG8_SCHED;
        }
        if (wr == 0) PG8_BAR;
        E(acc, cur, rs, wr, wc, fr, fq);
        if (!has_next) break;
#pragma unroll
        for (int a = 0; a < 2; ++a)
#pragma unroll
            for (int b = 0; b < 2; ++b)
#pragma unroll
                for (int m = 0; m < 4; ++m)
#pragma unroll
                    for (int n = 0; n < 2; ++n) acc[a][b][m][n] = (f32x4){0.f, 0.f, 0.f, 0.f};
        cur = nxt; cB = nB; cA = nA; ++ui;
        if (wr == 1) PG8_BAR;
    }
    PG8_WAIT_V(0);
    PG8_BAR;
#undef PG8_SA
#undef PG8_SB
#undef PG8_STAGE
#undef PG8_STAGEA
#undef PG8_LDA
#undef PG8_LDB
#undef PG8_MMA
#undef PG8_WAIT_V
#undef PG8_WAIT_L
#undef PG8_BAR
#undef PG8_SCHED
#undef PG8_CALCA
}

struct EpiStore {
    static constexpr bool ROWSCALE = false, WIDE = true;
    bf16* O; int ldc; const float* cscale; int qmode; int ntst; int f16; LAS unsigned char* tb;
    __device__ __forceinline__ void operator()(const f32x4 (&acc)[2][2][4][2], const Unit& u, const float (&rs)[2][4], int wr, int wc, int fr, int fq) const {
        const int colw = u.pn * BM + wc * 64;
        float sc = 1.f; if (qmode) { if ((((u.pn * BM) >> 10) % 3) == 0) sc = QSCALE; }
        f32x4 cs[2][2];
#pragma unroll
        for (int bj = 0; bj < 2; ++bj)
#pragma unroll
            for (int n = 0; n < 2; ++n) { cs[bj][n] = cscale ? *(const f32x4*)(cscale + colw + 32 * bj + 8 * fq + 4 * n) : (f32x4){1.f, 1.f, 1.f, 1.f}; cs[bj][n] = cs[bj][n] * sc; }
        const int L = fr + 16 * fq, rr = L >> 3, sg = L & 7;
        LAS u32x4* tbv = (LAS u32x4*)tb;
        const int wi0 = fr * 8 + (fq ^ (fr & 7)), wi1 = fr * 8 + ((4 + fq) ^ (fr & 7)), ri = rr * 8 + (sg ^ rr);
        bf16* gp = O + (size_t)(u.pm * BM + wr * 64 + rr) * ldc + colw + sg * 8;
#pragma unroll
        for (int ai = 0; ai < 2; ++ai)
#pragma unroll
            for (int m = 0; m < 4; ++m) {
                u32x4 w[2];
#pragma unroll
                for (int bj = 0; bj < 2; ++bj) { const f32x4 v0 = acc[ai][bj][m][0] * cs[bj][0], v1 = acc[ai][bj][m][1] * cs[bj][1];
                    if (f16) { w[bj].x = pkh2(v0[0], v0[1]); w[bj].y = pkh2(v0[2], v0[3]); w[bj].z = pkh2(v1[0], v1[1]); w[bj].w = pkh2(v1[2], v1[3]); }
                    else { w[bj].x = cvt_pk_bf16(v0[0], v0[1]); w[bj].y = cvt_pk_bf16(v0[2], v0[3]); w[bj].z = cvt_pk_bf16(v1[0], v1[1]); w[bj].w = cvt_pk_bf16(v1[2], v1[3]); } }
                tbv[wi0] = w[0]; tbv[wi1] = w[1];
                asm volatile("" ::: "memory");
                const u32x4 r0 = tbv[ri], r1 = tbv[ri + 64];
                asm volatile("" ::: "memory");
                bf16* rowp = gp + (size_t)(ai * HALF + m * 16) * ldc;
                if (ntst) { __builtin_nontemporal_store(r0, (u32x4*)rowp); __builtin_nontemporal_store(r1, (u32x4*)(rowp + (size_t)8 * ldc)); }
                else { *(u32x4*)rowp = r0; *(u32x4*)(rowp + (size_t)8 * ldc) = r1; } }
    }
};
typedef unsigned u32x2_t __attribute__((ext_vector_type(2)));
struct EpiStoreF8 {
    static constexpr bool ROWSCALE = false, WIDE = true;
    unsigned char* O; int ldc; LAS unsigned char* tb; int qmode;
    __device__ __forceinline__ void operator()(const f32x4 (&acc)[2][2][4][2], const Unit& u, const float (&rs)[2][4], int wr, int wc, int fr, int fq) const {
        const int colw = u.pn * BM + wc * 64;
        const float osc = qmode ? (((((u.pn * BM) >> 10) % 3) == 0) ? QSCALE * 64.0f : 16.0f) : 32.0f;
        const int L = fr + 16 * fq, rr = L >> 2, sg = L & 3;
        LAS unsigned char* wp0 = tb + fr * 64 + ((fq) ^ (fr & 7)) * 8; LAS unsigned char* wp1 = tb + fr * 64 + ((4 + fq) ^ (fr & 7)) * 8;
        const LAS unsigned char* rp0 = tb + rr * 64 + ((2 * sg) ^ (rr & 7)) * 8; const LAS unsigned char* rp1 = tb + rr * 64 + ((2 * sg + 1) ^ (rr & 7)) * 8;
        unsigned char* gp = O + (size_t)(u.pm * BM + wr * 64 + rr) * ldc + colw + sg * 16;
#pragma unroll
        for (int ai = 0; ai < 2; ++ai)
#pragma unroll
            for (int m = 0; m < 4; ++m) {
                u32x2_t w[2];
#pragma unroll
                for (int bj = 0; bj < 2; ++bj) { f32x4 v0 = acc[ai][bj][m][0] * osc, v1 = acc[ai][bj][m][1] * osc;
#pragma unroll
                    for (int e = 0; e < 4; ++e) { v0[e] = __builtin_amdgcn_fmed3f(v0[e], -448.0f, 448.0f); v1[e] = __builtin_amdgcn_fmed3f(v1[e], -448.0f, 448.0f); }
                    int p0 = __builtin_amdgcn_cvt_pk_fp8_f32(v0[0], v0[1], 0, false); p0 = __builtin_amdgcn_cvt_pk_fp8_f32(v0[2], v0[3], p0, true);
                    int p1 = __builtin_amdgcn_cvt_pk_fp8_f32(v1[0], v1[1], 0, false); p1 = __builtin_amdgcn_cvt_pk_fp8_f32(v1[2], v1[3], p1, true);
                    w[bj].x = (unsigned)p0; w[bj].y = (unsigned)p1; }
                *(LAS u32x2_t*)wp0 = w[0]; *(LAS u32x2_t*)wp1 = w[1];
                asm volatile("" ::: "memory");
                const u32x2_t a = *(const LAS u32x2_t*)rp0, b = *(const LAS u32x2_t*)rp1;
                asm volatile("" ::: "memory");
                u32x4 o; o.x = a.x; o.y = a.y; o.z = b.x; o.w = b.y;
                __builtin_nontemporal_store(o, (GAS u32x4*)(gp + (size_t)(ai * HALF + m * 16) * ldc)); }
    }
};
struct EpiGU {
    static constexpr bool ROWSCALE = false, WIDE = false;
    bf16* O;
    __device__ __forceinline__ void operator()(const f32x4 (&acc)[2][2][4][2], const Unit& u, const float (&rs)[2][4], int wr, int wc, int fr, int fq) const {
        bf16* tp = O + (size_t)u.pm * (BM * DEXP) + (size_t)(u.pn * 4 + wc) * (BM * 32) + (wr * 64 + fr) * 32 + 8 * fq;
#pragma unroll
        for (int ai = 0; ai < 2; ++ai)
#pragma unroll
            for (int m = 0; m < 4; ++m) { bf16* rowp = tp + (ai * HALF + m * 16) * 32;
                float o[8];
#pragma unroll
                for (int n = 0; n < 2; ++n)
#pragma unroll
                    for (int j = 0; j < 4; ++j) { const float g = acc[ai][0][m][n][j], uu = acc[ai][1][m][n][j];
                        const float sg = g * __builtin_amdgcn_rcpf(1.0f + __builtin_amdgcn_exp2f(-g * LOG2E)); o[n * 4 + j] = sg * uu; }
                u32x4 wv; wv.x = cvt_pk_bf16(o[0], o[1]); wv.y = cvt_pk_bf16(o[2], o[3]); wv.z = cvt_pk_bf16(o[4], o[5]); wv.w = cvt_pk_bf16(o[6], o[7]);
                *(u32x4*)rowp = wv; }
    }
};
}

#define XB_TMO      128
#define XB_XCNT(j)  (256  + 64 * (j))
#define XB_XSUB(j)  (1280 + 64 * (j))
#define XB_XGEN(j)  (2304 + 64 * (j))
#define XB_TOP      3328
#define XB_TOPGEN   3392
#define XB_LSUB(j)  (3456 + 64 * (j))
#define XB_LGEN(j)  (4480 + 64 * (j))
#define XCD_BAR_WORDS 5504
#define XB_SPIN_CAP (1u << 18)
__device__ __forceinline__ unsigned xb_ld(unsigned* p)              { return __hip_atomic_load(p, __ATOMIC_RELAXED, __HIP_MEMORY_SCOPE_AGENT); }
__device__ __forceinline__ unsigned xb_add(unsigned* p, unsigned v) { return __hip_atomic_fetch_add(p, v, __ATOMIC_RELAXED, __HIP_MEMORY_SCOPE_AGENT); }
__device__ __forceinline__ unsigned xb_xcc_id() { return (unsigned)__builtin_amdgcn_s_getreg((3 << 11) | 20) & 0xFu; }
#define XB_SPIN(cond, bar) do { unsigned _sp = 0; while (cond) { __builtin_amdgcn_s_sleep(1); \
    if ((++_sp & 255u) == 0u) { if (xb_ld(&(bar)[XB_TMO])) break; if (_sp > XB_SPIN_CAP) { atomicAdd(&(bar)[XB_TMO], 1u); break; } } } } while (0)
struct XcdBarrier { unsigned* bar; unsigned x; volatile LAS unsigned* st; };
__device__ __forceinline__ XcdBarrier xcd_barrier_post(unsigned* bar, volatile LAS unsigned* st) {
    XcdBarrier b; b.bar = bar; b.x = xb_xcc_id(); b.st = st;
    if (threadIdx.x == 0) st[2] = xb_add(&bar[XB_XCNT(b.x)], 1u);
    return b;
}
__device__ __forceinline__ void xcd_local_barrier(const XcdBarrier& b, const bool wave0) {
    asm volatile("s_waitcnt vmcnt(0)" ::: "memory");
    __syncthreads();
    if (wave0 && __builtin_amdgcn_mbcnt_hi(~0u, __builtin_amdgcn_mbcnt_lo(~0u, 0u)) == 0u) {
        unsigned* bar = b.bar;
        __builtin_amdgcn_s_waitcnt(0);
        const unsigned nloc = b.st[0];
        const unsigned old = xb_add(&bar[XB_LSUB(b.x)], 1u);
        const unsigned gen = old / nloc;
        if (old + 1u == (gen + 1u) * nloc) xb_add(&bar[XB_LGEN(b.x)], 1u);
        else XB_SPIN(xb_ld(&bar[XB_LGEN(b.x)]) == gen, bar);
        __builtin_amdgcn_fence(__ATOMIC_ACQUIRE, "agent");
        asm volatile("s_waitcnt vmcnt(0)" ::: "memory");
    }
    __syncthreads();
}
__device__ __forceinline__ void xcd_barrier_complete(unsigned* bar, unsigned x, unsigned& nloc, unsigned& nx) {
    const unsigned G = gridDim.x * gridDim.y * gridDim.z;
    unsigned sum, cnt, mine, sp = 0u;
    for (;;) {
        sum = 0u; cnt = 0u; mine = 0u;
#pragma unroll
        for (unsigned j = 0; j < 16; ++j) { const unsigned c = xb_ld(&bar[XB_XCNT(j)]); sum += c; cnt += (c > 0u) ? 1u : 0u; mine = (j == x) ? c : mine; }
        if (sum == G) break;
        __builtin_amdgcn_s_sleep(1);
        if ((++sp & 255u) == 0u) { if (xb_ld(&bar[XB_TMO])) break; if (sp > XB_SPIN_CAP) { atomicAdd(&bar[XB_TMO], 1u); break; } }
    }
    nloc = mine > 0u ? mine : 1u; nx = cnt > 0u ? cnt : 1u;
}
__device__ __forceinline__ void xcd_barrier(const XcdBarrier& b) {
    asm volatile("s_waitcnt vmcnt(0)" ::: "memory");
    __syncthreads();
    if (threadIdx.x == 0) {
        unsigned* bar = b.bar;
        __builtin_amdgcn_s_waitcnt(0);
        unsigned nloc = b.st[0], nx = b.st[1];
        if (nloc == 0u) { xcd_barrier_complete(bar, b.x, nloc, nx); b.st[0] = nloc; b.st[1] = nx; }
        const unsigned old = xb_add(&bar[XB_XSUB(b.x)], 1u);
        const unsigned gen = old / nloc;
        if (old + 1u == (gen + 1u) * nloc) {
            __builtin_amdgcn_fence(__ATOMIC_RELEASE, "agent");
            asm volatile("s_waitcnt vmcnt(0)" ::: "memory");
            const unsigned og = xb_add(&bar[XB_TOP], 1u);
            const unsigned tg = og / nx;
            if (og + 1u == (tg + 1u) * nx) xb_add(&bar[XB_TOPGEN], 1u);
            else XB_SPIN(xb_ld(&bar[XB_TOPGEN]) == tg, bar);
            __builtin_amdgcn_fence(__ATOMIC_ACQUIRE, "agent");
            xb_add(&bar[XB_XGEN(b.x)], 1u);
            asm volatile("s_waitcnt vmcnt(0)" ::: "memory");
        } else {
            XB_SPIN(xb_ld(&bar[XB_XGEN(b.x)]) == gen, bar);
            __builtin_amdgcn_fence(__ATOMIC_ACQUIRE, "agent");
            asm volatile("s_waitcnt vmcnt(0)" ::: "memory");
        }
    }
    __syncthreads();
}

constexpr int NWAVES = 8;
struct Frame {
    LAS unsigned char* lds;
    LAS unsigned char* lc;
    unsigned* ctl;
    unsigned char* ws;
    int tid, lane, wave, vcu, G;
};
constexpr int LC_PTR = 2048;
__device__ __forceinline__ const float* inp(const Frame& F, int i) {
    const unsigned long long v = *(const LAS unsigned long long*)(F.lc + LC_PTR + 8 * i);
    const unsigned lo = __builtin_amdgcn_readfirstlane((unsigned)v), hi = __builtin_amdgcn_readfirstlane((unsigned)(v >> 32));
    return (const float*)(const GAS float*)(((unsigned long long)hi << 32) | lo);
}
__device__ __forceinline__ unsigned char* opq(unsigned char* p) { GAS unsigned char* g = (GAS unsigned char*)p; asm volatile("" : "+s"(g)); return (unsigned char*)g; }
__device__ __forceinline__ void refresh(Frame& F) { asm volatile("" : "+v"(F.tid)); F.lane = F.tid & 63; F.wave = __builtin_amdgcn_readfirstlane(F.tid >> 6); }

struct PlainSched {   static constexpr bool GATHER = false, ABLK = false;
    int nM, nN, nwg, G, c; const char* B; int ldb;
    __device__ __forceinline__ bool next(int i, pg8::Unit& u) const {
        const int L = i * G + c; if (L >= nwg) return false;
        const int wgid = pg8::xcd_chunk(L, nwg);
        const int nig = 8 * nN, gid = wgid / nig, fm = gid * 8, gsz = (nM - fm) < 8 ? (nM - fm) : 8;
        u.pm = fm + ((wgid % nig) % gsz); u.pn = (wgid % nig) / gsz;
        u.bptr = B + (size_t)u.pn * 256 * ldb; u.roff = -(u.pm * 256) - 1; u.nvalid = 256; return true;
    }
    __device__ __forceinline__ int arow(const pg8::Unit& u, int r) const { return -u.roff - 1 + r; }
    __device__ __forceinline__ int acolb(const pg8::Unit&) const { return 0; }
    __device__ __forceinline__ float rowscale(const pg8::Unit&, int) const { return 1.0f; }
};
struct GrpSched {     static constexpr bool GATHER = false, ABLK = false;
    int G, c; const char* B;
    __device__ __forceinline__ bool next(int i, pg8::Unit& u) const {
        const int L = i * G + c; if (L >= 256) return false;
        const int wgid = pg8::xcd_chunk(L, 256);
        u.pm = wgid >> 2; u.pn = wgid & 3; u.bptr = B + (size_t)u.pn * 256 * 512; u.roff = -(u.pm * 256) - 1; u.nvalid = 256; return true;
    }
    __device__ __forceinline__ int arow(const pg8::Unit& u, int r) const { return -u.roff - 1 + r; }
    __device__ __forceinline__ int acolb(const pg8::Unit& u) const { return u.pn * 512; }
    __device__ __forceinline__ float rowscale(const pg8::Unit&, int) const { return 1.0f; }
};
template <bool GATHER_> struct MoeSched {     static constexpr bool GATHER = GATHER_, ABLK = !GATHER_;
    const LAS int* ts; const LAS int* cn; int npn, nunits, G, c, lane_;
    const int* tokl; const float* wl; const char* Bexp; size_t bstride; const char* Bsh; int ldb;
    __device__ __forceinline__ bool next(int i, pg8::Unit& u) const {
        const int L = i * G + c; const int xg = L % pg8::NXCD, off = L / pg8::NXCD;
        const int ntile = nunits / npn, tq = ntile / pg8::NXCD, tr = ntile % pg8::NXCD;
        const int tcnt = tq + (xg < tr ? 1 : 0), tstart = xg * tq + (xg < tr ? xg : tr);
        if (off >= tcnt * npn) return false;
        const int tile = tstart + off / npn, pn = off % npn;
        const int lane = lane_;
        const bool hit = (tile >= ts[lane]) && (tile < ts[lane + 1]);
        const unsigned long long mk = __ballot(hit);
        const int e = mk ? (int)__builtin_ctzll(mk) : 64;
        const int tse = __builtin_amdgcn_readfirstlane(ts[e]);
        const int r0 = (tile - tse) * 256;
        u.pm = tile; u.pn = pn;
        u.bptr = (e < 64 ? Bexp + (size_t)e * bstride : Bsh) + (size_t)pn * 256 * ldb;
        if (GATHER) {
            if (e < 64) { const int ce = __builtin_amdgcn_readfirstlane(cn[e]); u.roff = e * CAP + r0; u.nvalid = (ce - r0) < 256 ? (ce - r0) : 256; }
            else { u.roff = -r0 - 1; u.nvalid = 256; }
        } else { u.roff = -(tile * 256) - 1; u.nvalid = 256; }
        return true;
    }
    __device__ __forceinline__ int arow(const pg8::Unit& u, int r) const { if (GATHER && u.roff >= 0) { const int rr = r < u.nvalid ? r : u.nvalid - 1; return tokl[u.roff + rr]; } return -u.roff - 1 + r; }
    __device__ __forceinline__ int acolb(const pg8::Unit&) const { return 0; }
    __device__ __forceinline__ float rowscale(const pg8::Unit& u, int r) const { if (GATHER && u.roff >= 0) { const int rr = r < u.nvalid ? r : u.nvalid - 1; return wl[u.roff + rr]; } return 1.0f; }
};

__device__ __forceinline__ void p0_transpose_item64(const float* W, int K, int N, bf16* WT, int dst_n0, LAS float* scr, int kb, int nb, int lane) {
    const int k0 = 64 * kb, n0 = 64 * nb; const int r = lane >> 4, c4 = lane & 15;
    f32x4 v[16];
#pragma unroll
    for (int i = 0; i < 16; ++i) v[i] = *(const GAS f32x4*)(W + (size_t)(k0 + 4 * i + r) * N + n0 + 4 * c4);
#pragma unroll
    for (int i = 0; i < 16; ++i) { const int k = 4 * i + r; *(LAS f32x4*)(scr + k * 64 + 4 * (c4 ^ (k >> 3))) = v[i]; }
    LDS_WAIT(); asm volatile("" ::: "memory");
    const int c = lane & 7;
#pragma unroll
    for (int j = 0; j < 8; ++j) { const int n = (lane >> 3) + 8 * j; const LAS float* sp = scr + (8 * c) * 64 + 4 * ((n >> 2) ^ c) + (n & 3);
        u32x4 o; o.x = pk2(sp[0 * 64], sp[1 * 64]); o.y = pk2(sp[2 * 64], sp[3 * 64]); o.z = pk2(sp[4 * 64], sp[5 * 64]); o.w = pk2(sp[6 * 64], sp[7 * 64]);
        *(GAS u32x4*)(WT + (size_t)(dst_n0 + n) * K + k0 + 8 * c) = o; }
    LDS_WAIT(); asm volatile("" ::: "memory");
}
__device__ __forceinline__ void p0_router_item(const float* W, bf16* WH, bf16* WLo, LAS float* scr, int kb, int nb, int lane) {
    const int K = 1024, N = 64; const int k0 = 64 * kb, n0 = 32 * nb;
#pragma unroll 8
    for (int i = 0; i < 32; ++i) { const int kk = 2 * i + (lane >> 5); scr[kk * 33 + (lane & 31)] = W[(size_t)(k0 + kk) * N + n0 + (lane & 31)]; }
    LDS_WAIT(); asm volatile("" ::: "memory");
    const int c = lane & 7;
#pragma unroll
    for (int j = 0; j < 4; ++j) { const int n = (lane >> 3) + 8 * j; const LAS float* s = scr + (8 * c) * 33 + n;
        unsigned h[8], l[8];
#pragma unroll
        for (int q = 0; q < 8; ++q) { const float v = s[q * 33]; h[q] = f2bf(v); l[q] = f2bf(v - bf2f(h[q])); }
        u32x4 oh, ol; oh.x = h[0] | (h[1] << 16); oh.y = h[2] | (h[3] << 16); oh.z = h[4] | (h[5] << 16); oh.w = h[6] | (h[7] << 16);
        ol.x = l[0] | (l[1] << 16); ol.y = l[2] | (l[3] << 16); ol.z = l[4] | (l[5] << 16); ol.w = l[6] | (l[7] << 16);
        *(GAS u32x4*)(WH + (size_t)(n0 + n) * K + k0 + 8 * c) = oh; *(GAS u32x4*)(WLo + (size_t)(n0 + n) * K + k0 + 8 * c) = ol; }
    LDS_WAIT(); asm volatile("" ::: "memory");
}

__device__ __forceinline__ void p0_prologue(Frame& F) {
    LAS float* cs = (LAS float*)(F.lds);
    LAS float* part = (LAS float*)(F.lds + 32768);
    const float* c = inp(F, 1);
    for (int i = F.tid; i < 8 * 1024; i += 512) { const float v = c[i]; cs[i] = v / (1.0f + __expf(-v)); }
    __syncthreads();
    float* mod = (float*)(F.ws + WS_MOD);
    for (int it = F.vcu; it < 4 * 96; it += F.G) {
        const int layer = it / 96, slab = it % 96; const int col = slab * 64 + F.lane;
        const float* W = inp(F, 2) + (size_t)layer * 1024 * 6144 + col;
        float a[8];
#pragma unroll
        for (int b = 0; b < 8; ++b) a[b] = 0.f;
        const int k0 = F.wave * 128;
#pragma unroll 4
        for (int k = 0; k < 128; k += 4) {
            float w[4];
#pragma unroll
            for (int j = 0; j < 4; ++j) w[j] = W[(size_t)(k0 + k + j) * 6144];
#pragma unroll
            for (int b = 0; b < 8; ++b) { const f32x4 cv = *(const LAS f32x4*)(cs + b * 1024 + k0 + k); a[b] += cv[0] * w[0] + cv[1] * w[1] + cv[2] * w[2] + cv[3] * w[3]; }
        }
#pragma unroll
        for (int b = 0; b < 8; ++b) part[(F.wave * 8 + b) * 64 + F.lane] = a[b];
        __syncthreads();
        { const int b = F.wave; float s = 0.f;
#pragma unroll
          for (int w = 0; w < 8; ++w) s += part[(w * 8 + b) * 64 + F.lane];
          mod[((size_t)layer * 8 + b) * 6144 + col] = s + inp(F, 3)[layer * 6144 + col]; }
        __syncthreads();
    }
    __syncthreads();
    LAS float* scr = (LAS float*)(F.lds + F.wave * 16384);
    const int gw = F.vcu * NWAVES + F.wave, NGW = F.G * NWAVES;
    constexpr int I_PIN = 2 * 16 * 16, I_GRP = 8 * 4 * 4, I_POUT = I_PIN, I_AIN = 2 * 16 * 144, I_AOUT = I_PIN, I_SHGU = 4 * 16 * 8, I_SHDN = 4 * 4 * 16, I_R = 4 * 16 * 2;
    constexpr int I_EGU = 256 * 16 * 8, I_EDN = 256 * 4 * 16;
    constexpr int NITEMS = I_PIN + I_GRP + I_POUT + I_AIN + I_AOUT + I_SHGU + I_SHDN + I_R + I_EGU + I_EDN;
    for (int it = gw; it < NITEMS; it += NGW) {
        int r = it;
#define P0_GROUP(CNT, SRC, KK, NN, DST, GU) if (r < (CNT)) { const int per = ((KK) / 64) * ((NN) / 64), mat = r / per, q = r % per, nblk = (NN) / 64, kblk = (KK) / 64, nb = q / kblk, kb = q % kblk; (void)nblk; \
            int dn0 = 64 * nb; if (GU) { const int n0 = 64 * nb; dn0 = (n0 < 256) ? ((n0 >> 7) * 256 + (n0 & 127)) : (((n0 - 256) >> 7) * 256 + 128 + ((n0 - 256) & 127)); } \
            p0_transpose_item64((SRC) + (size_t)mat * (KK) * (NN), (KK), (NN), (bf16*)(F.ws + (DST)) + (size_t)mat * (KK) * (NN), dn0, scr, kb, nb, F.lane); continue; } r -= (CNT);
        P0_GROUP(I_PIN, inp(F, 4), 1024, 1024, WS_WPIN, 0)
        P0_GROUP(I_GRP, inp(F, 5), 256, 256, WS_WPGRP, 0)
        P0_GROUP(I_POUT, inp(F, 7), 1024, 1024, WS_WPOUT, 0)
        P0_GROUP(I_AIN, inp(F, 8), 1024, 9216, WS_WAIN, 0)
        P0_GROUP(I_AOUT, inp(F, 9), 1024, 1024, WS_WAOUT, 0)
        P0_GROUP(I_SHGU, inp(F, 16), 1024, 512, WS_WSHGU, 1)
        P0_GROUP(I_SHDN, inp(F, 17), 256, 1024, WS_WSHDN, 0)
        if (r < I_R) { const int mat = r / 32, q = r % 32, kb = q / 2, nb = q % 2;
            p0_router_item(inp(F, 12) + (size_t)mat * 65536, (bf16*)(F.ws + WS_WRHI) + (size_t)mat * 65536, (bf16*)(F.ws + WS_WRLO) + (size_t)mat * 65536, scr, kb, nb, F.lane); continue; } r -= I_R;
        P0_GROUP(I_EGU, inp(F, 14), 1024, 512, WS_WEGU, 1)
        P0_GROUP(I_EDN, inp(F, 15), 256, 1024, WS_WEDN, 0)
#undef P0_GROUP
    }
}

__device__ __forceinline__ void p1_modulate(Frame& F, const float* x, const float* modl  , int sh_off, int sc_off) {
    bf16* H = (bf16*)(F.ws + WS_H);
    const int gw = F.vcu * NWAVES + F.wave, NGW = F.G * NWAVES;
    for (int m = gw; m < T; m += NGW) {
        const int b = m / SEQ; const float* mb = modl + (size_t)b * 6144;
        const GAS f32x4* xr = (const GAS f32x4*)(x + (size_t)m * D) + F.lane;
        GAS u32x2* o8 = (GAS u32x2*)(H + (size_t)m * D) + F.lane;
#pragma unroll
        for (int j = 0; j < 4; ++j) { const f32x4 v = xr[64 * j]; const f32x4 sc = *(const f32x4*)(mb + sc_off + 4 * F.lane + 256 * j), sh = *(const f32x4*)(mb + sh_off + 4 * F.lane + 256 * j);
            const f32x4 h = v * (sc + 1.0f) + sh; u32x2 w; w.x = pk2(h[0], h[1]); w.y = pk2(h[2], h[3]); o8[64 * j] = w; }
    }
}

template <int W>
__device__ __forceinline__ void pool_item(const bf16* U, bf16* Z, int b, int t0, int g, int lane) {
    const size_t base = (size_t)b * SEQ * D + 256 * g + 4 * lane;
    float s[4] = {0.f, 0.f, 0.f, 0.f};
#pragma unroll
    for (int j = 1; j <= W; ++j) { const int t = t0 - j; if (t >= 0) { const u32x2 v = *(const GAS u32x2*)(U + base + (size_t)t * D);
            s[0] += bf2f(v.x & 0xffffu); s[1] += bf2f(v.x >> 16); s[2] += bf2f(v.y & 0xffffu); s[3] += bf2f(v.y >> 16); } }
#pragma unroll 8
    for (int i = 0; i < 32; ++i) { const int t = t0 + i;
        const u32x2 v = *(const GAS u32x2*)(U + base + (size_t)t * D);
        const float c0 = bf2f(v.x & 0xffffu), c1 = bf2f(v.x >> 16), c2 = bf2f(v.y & 0xffffu), c3 = bf2f(v.y >> 16);
        s[0] += c0; s[1] += c1; s[2] += c2; s[3] += c3;
        if (t - W >= 0) { const u32x2 o = *(const GAS u32x2*)(U + base + (size_t)(t - W) * D);
            s[0] -= bf2f(o.x & 0xffffu); s[1] -= bf2f(o.x >> 16); s[2] -= bf2f(o.y & 0xffffu); s[3] -= bf2f(o.y >> 16); }
        const float inv = 1.0f / (float)((t + 1) < W ? (t + 1) : W);
        u32x2 w; w.x = pk2(s[0] * inv - c0, s[1] * inv - c1); w.y = pk2(s[2] * inv - c2, s[3] * inv - c3);
        *(GAS u32x2*)(Z + base + (size_t)t * D) = w; }
}

__device__ __forceinline__ void moe_build_table(Frame& F, int layer) {
    LAS int* ts = (LAS int*)(F.lc + LC_TS); LAS int* cn = (LAS int*)(F.lc + LC_CNT);
    __syncthreads();
    if (F.wave == 0) {
        const int c = (int)__hip_atomic_load(F.ctl + CW_CNT + layer * 64 + F.lane, RLX_AGENT);
        int t = (c + 255) >> 8;
#pragma unroll
        for (int o = 1; o < 64; o <<= 1) { const int v = __shfl_up(t, o); if (F.lane >= o) t += v; }
        cn[F.lane] = c; ts[F.lane + 1] = t;
        if (F.lane == 0) ts[0] = 0;
        if (F.lane == 63) ts[65] = t + 64;
    }
    __syncthreads();
}

#ifdef PROBE_TYPE
#define LSTAMP(ty) do { if (blockIdx.x == 0 && F.tid == 0) { const unsigned long long now_ = __builtin_amdgcn_s_memrealtime(); LAS unsigned long long* st_ = (LAS unsigned long long*)(F.lc + 3072); \
        st_[1 + (ty)] += now_ - st_[20]; st_[20] = now_; } } while (0)
#define LSTAMP0() do { if (blockIdx.x == 0 && F.tid == 0) { ((LAS unsigned long long*)(F.lc + 3072))[20] = __builtin_amdgcn_s_memrealtime(); } } while (0)
#else
#define LSTAMP(ty) do { } while (0)
#define LSTAMP0() do { } while (0)
#endif
constexpr int APITCH = 1032;
#define LDS_ONLY_BARRIER() do { asm volatile("s_waitcnt lgkmcnt(0)" ::: "memory"); __builtin_amdgcn_s_barrier(); asm volatile("" ::: "memory"); } while (0)
template <bool X16>
__device__ __forceinline__ void ln1_router_phase(Frame& F, int layer, const float* xin) {
    bf16* X = (bf16*)(F.ws + WS_X);
    bf16* H = (bf16*)(F.ws + WS_H); const bf16* Y = (const bf16*)(F.ws + WS_Y);
    const float* modl = (const float*)(F.ws + WS_MOD) + (size_t)layer * 8 * 6144;
    const float* lg = inp(F, 10) + layer * D; const float* lb = inp(F, 11) + layer * D;
    const float* rb = inp(F, 13) + layer * NE;
    const bf16* WH = (const bf16*)(F.ws + WS_WRHI) + (size_t)layer * 65536; const bf16* WLo = (const bf16*)(F.ws + WS_WRLO) + (size_t)layer * 65536;
    int* tokl = (int*)(F.ws + WS_TOKL); float* wl = (float*)(F.ws + WS_WL); int* tslot = (int*)(F.ws + WS_TSLOT);
    unsigned* gcnt = F.ctl + CW_CNT + layer * 64;
    LAS bf16* Ahi = (LAS bf16*)F.lds; LAS bf16* Alo = Ahi + 32 * APITCH;
    LAS float* PART = (LAS float*)F.lds;
    LAS float* PV = (LAS float*)(F.lds + LDS_TB_OFF);
    LAS int* lcnt = (LAS int*)(F.lc + LC_LCNT); LAS int* gb = (LAS int*)(F.lc + LC_GB);
    const int lane = F.lane, wave = F.wave;
    const int nblk = (T / 32) / F.G;
#define LN1_BLK(bi_) ((F.G == 256) ? ((F.vcu >> 5) * 64 + (F.vcu & 31) * 2 + (bi_)) : (F.vcu + (bi_) * F.G))
    constexpr int NX = X16 ? 2 : 4;
    u32x4 xr[4][NX], yv[4][2];
#define LN1_LOAD(bi_) do { const int t0_ = LN1_BLK(bi_) * 32 + wave * 4; \
        _Pragma("unroll") for (int q = 0; q < 4; ++q) _Pragma("unroll") for (int j = 0; j < 2; ++j) { const size_t o_ = (size_t)(t0_ + q) * D + 8 * lane + 512 * j; \
            if constexpr (X16) xr[q][j] = __builtin_nontemporal_load((const GAS u32x4*)((const bf16*)xin + o_)); \
            else { xr[q][2 * j] = *(const GAS u32x4*)(xin + o_); xr[q][2 * j + 1] = *(const GAS u32x4*)(xin + o_ + 4); } \
            yv[q][j] = __builtin_nontemporal_load((const GAS u32x4*)(Y + o_)); } } while (0)
    LN1_LOAD(0);
    const float rbe = rb[lane];
    { const int b = (LN1_BLK(0) * 32) / SEQ; const float* mb = modl + (size_t)b * 6144;
      for (int i = F.tid; i < 1024; i += NWAVES * 64) { const int v = i >> 8, c4 = (i & 255) * 4;
          const float* src = (v == 0) ? lg : (v == 1) ? lb : (v == 2) ? (mb + 4096) : (mb + 3072);
          f32x4 t = *(const GAS f32x4*)(src + c4); if (v == 2) t = t + 1.0f; *(LAS f32x4*)(PV + v * 1024 + c4) = t; } }
    __syncthreads();
    for (int bi = 0; bi < nblk; ++bi) {
        const int blk = LN1_BLK(bi);
        const int tok0 = blk * 32;
        LSTAMP0();
        bf16x8 bh[8][2], bl[8][2];
        {
            const int b = tok0 / SEQ; const float* mb = modl + (size_t)b * 6144;
            f32x4 xv[4][4];
            f32x4 pg1[4];
#pragma unroll
            for (int jj = 0; jj < 4; ++jj) pg1[jj] = *(const GAS f32x4*)(mb + 2048 + 8 * lane + 512 * (jj >> 1) + 4 * (jj & 1)) + 1.0f;
            float sm[4];
#pragma unroll
            for (int q = 0; q < 4; ++q) { float s = 0.f;
#pragma unroll
                for (int jj = 0; jj < 4; ++jj) { const unsigned w0 = (jj & 1) ? yv[q][jj >> 1].z : yv[q][jj >> 1].x, w1 = (jj & 1) ? yv[q][jj >> 1].w : yv[q][jj >> 1].y;
                    f32x4 y4; y4[0] = h2f(w0 & 0xffffu); y4[1] = h2f(w0 >> 16); y4[2] = h2f(w1 & 0xffffu); y4[3] = h2f(w1 >> 16);
                    f32x4 x4;
                    if constexpr (X16) { const unsigned v0 = (jj & 1) ? xr[q][jj >> 1].z : xr[q][jj >> 1].x, v1 = (jj & 1) ? xr[q][jj >> 1].w : xr[q][jj >> 1].y;
                        x4 = (f32x4){h2f(v0 & 0xffffu), h2f(v0 >> 16), h2f(v1 & 0xffffu), h2f(v1 >> 16)}; }
                    else { const u32x4 v = xr[q][jj]; x4 = (f32x4){__uint_as_float(v.x), __uint_as_float(v.y), __uint_as_float(v.z), __uint_as_float(v.w)}; }
                    xv[q][jj] = x4 * ALPHA + pg1[jj] * y4; s += (xv[q][jj][0] + xv[q][jj][1]) + (xv[q][jj][2] + xv[q][jj][3]); }
                sm[q] = s; }
#pragma unroll
            for (int o = 1; o < 64; o <<= 1) {
#pragma unroll
                for (int q = 0; q < 4; ++q) sm[q] += __shfl_xor(sm[q], o); }
            float s2[4];
#pragma unroll
            for (int q = 0; q < 4; ++q) { const float mean = sm[q] * (1.f / D); float t = 0.f;
#pragma unroll
                for (int jj = 0; jj < 4; ++jj) { xv[q][jj] = xv[q][jj] - mean; t += (xv[q][jj][0] * xv[q][jj][0] + xv[q][jj][1] * xv[q][jj][1]) + (xv[q][jj][2] * xv[q][jj][2] + xv[q][jj][3] * xv[q][jj][3]); }
                s2[q] = t; }
#pragma unroll
            for (int o = 1; o < 64; o <<= 1) {
#pragma unroll
                for (int q = 0; q < 4; ++q) s2[q] += __shfl_xor(s2[q], o); }
            LAS float* pvb = PV + 8 * lane; asm volatile("" : "+v"(pvb));
#pragma unroll
            for (int jj = 0; jj < 4; ++jj) { const int col = 8 * lane + 512 * (jj >> 1) + 4 * (jj & 1); const int co = 512 * (jj >> 1) + 4 * (jj & 1);
                const f32x4 gg = *(const LAS f32x4*)(pvb + co), bb = *(const LAS f32x4*)(pvb + 1024 + co), sc2 = *(const LAS f32x4*)(pvb + 2048 + co), sh2 = *(const LAS f32x4*)(pvb + 3072 + co);
#pragma unroll
                for (int q = 0; q < 4; ++q) { const int rl = wave * 4 + q, tok = tok0 + rl; const float rstd = 1.0f / sqrtf(s2[q] * (1.f / D) + LN_EPS);
                    const f32x4 xn = xv[q][jj] * rstd * gg + bb; { u32x2 xw; xw.x = pkh2(xn[0], xn[1]); xw.y = pkh2(xn[2], xn[3]); *(GAS u32x2*)(X + (size_t)tok * D + col) = xw; }
                    const f32x4 hf = xn * sc2 + sh2;
                    unsigned hh[4], ll[4];
#pragma unroll
                    for (int e = 0; e < 4; ++e) { hh[e] = f2bf(hf[e]); ll[e] = f2bf(hf[e] - bf2f(hh[e])); }
                    u32x2 wh, wlo; wh.x = hh[0] | (hh[1] << 16); wh.y = hh[2] | (hh[3] << 16); wlo.x = ll[0] | (ll[1] << 16); wlo.y = ll[2] | (ll[3] << 16);
                    *(GAS u32x2*)(H + (size_t)tok * D + col) = wh;
                    *(LAS u32x2*)(Ahi + rl * APITCH + col) = wh; *(LAS u32x2*)(Alo + rl * APITCH + col) = wlo; } }
        }
        __builtin_amdgcn_sched_barrier(0);
        {
            const int r32 = lane & 31, hi = lane >> 5;
#pragma unroll
            for (int nb = 0; nb < 2; ++nb) {
                const GAS bf16* ph = (const GAS bf16*)WH + (size_t)(r32 + 32 * nb) * 1024 + wave * 128 + hi * 8; const GAS bf16* pl = (const GAS bf16*)WLo + (size_t)(r32 + 32 * nb) * 1024 + wave * 128 + hi * 8;
                asm volatile("" : "+v"(ph), "+v"(pl));
#pragma unroll
                for (int ks = 0; ks < 8; ++ks) { bh[ks][nb] = *(const GAS bf16x8*)(ph + ks * 16); bl[ks][nb] = *(const GAS bf16x8*)(pl + ks * 16); } }
        }
        __syncthreads();
        LSTAMP(13);
        f32x16 acc[2]; acc[0] = (f32x16){}; acc[1] = (f32x16){};
        {
            const int r32 = lane & 31, hi = lane >> 5;
#pragma unroll
            for (int ks = 0; ks < 8; ++ks) {
                const int k = wave * 128 + ks * 16 + hi * 8;
                const bf16x8 ah = *(const LAS bf16x8*)(Ahi + r32 * APITCH + k), al = *(const LAS bf16x8*)(Alo + r32 * APITCH + k);
#pragma unroll
                for (int nb = 0; nb < 2; ++nb) {
                    acc[nb] = MFMA32(ah, bh[ks][nb], acc[nb]);
                    acc[nb] = MFMA32(al, bh[ks][nb], acc[nb]);
                    acc[nb] = MFMA32(ah, bl[ks][nb], acc[nb]);
                }
            }
        }
        LDS_ONLY_BARRIER();
        {
            const int r32 = lane & 31, hi = lane >> 5;
#pragma unroll
            for (int nb = 0; nb < 2; ++nb)
#pragma unroll
                for (int r = 0; r < 16; ++r) { const int trow = (r & 3) + 8 * (r >> 2) + 4 * hi; PART[(wave * 32 + trow) * 64 + 32 * nb + r32] = acc[nb][r]; }
        }
        if (F.tid < 64) lcnt[F.tid] = 0;
        LDS_ONLY_BARRIER();
        LSTAMP(14);
        if (bi + 1 < nblk) LN1_LOAD(bi + 1);
        else {
#pragma unroll
            for (int q = 0; q < 4; ++q) {
#pragma unroll
                for (int j = 0; j < NX; ++j) xr[q][j] = (u32x4){0u, 0u, 0u, 0u};
#pragma unroll
                for (int j = 0; j < 2; ++j) yv[q][j] = (u32x4){0u, 0u, 0u, 0u}; } }
        int chosen_m = 0; int posl[4]; float wv[4]; int rk[4];
        unsigned key[4]; float sgv[4];
#pragma unroll
        for (int q = 0; q < 4; ++q) {
            const int rl = wave * 4 + q;
            float logit = 0.f;
#pragma unroll
            for (int w = 0; w < 8; ++w) logit += PART[(w * 32 + rl) * 64 + lane];
            const float sg = 1.0f / (1.0f + __expf(-logit));
            const float sel = sg + rbe;
            float m1 = sel; m1 = fmaxf(m1, __shfl_xor(m1, 1)); m1 = fmaxf(m1, __shfl_xor(m1, 2)); m1 = fmaxf(m1, __shfl_xor(m1, 4));
            const unsigned long long bal = __ballot(sel == m1);
            const unsigned long long gm = bal & (0xFFull << (8 * (lane >> 3)));
            const int first = (int)__builtin_ctzll(gm);
            float m2 = (lane == first) ? -INFINITY : sel; m2 = fmaxf(m2, __shfl_xor(m2, 1)); m2 = fmaxf(m2, __shfl_xor(m2, 2)); m2 = fmaxf(m2, __shfl_xor(m2, 4));
            const float gs = m1 + m2;
            int rg = 0;
#pragma unroll
            for (int g2 = 0; g2 < 8; ++g2) { const float v = __builtin_bit_cast(float, __builtin_amdgcn_readlane(__builtin_bit_cast(int, gs), 8 * g2)); rg += ((v > gs) || (v == gs && g2 < (lane >> 3))) ? 1 : 0; }
            const bool gsel = rg < 4;
            const float msel = gsel ? sel : -INFINITY;
            const unsigned mb_ = __float_as_uint(msel); key[q] = (mb_ & 0x80000000u) ? ~mb_ : (mb_ | 0x80000000u); sgv[q] = sg;
        }
        unsigned tau[4] = {0u, 0u, 0u, 0u};
#pragma unroll 1
        for (int bit = 31; bit >= 0; --bit) {
#pragma unroll
            for (int q = 0; q < 4; ++q) { const unsigned cand = tau[q] | (1u << bit); const int cnt = (int)__popcll(__ballot(key[q] >= cand)); tau[q] = (cnt >= TOPK) ? cand : tau[q]; } }
#pragma unroll
        for (int q = 0; q < 4; ++q) {
            const unsigned long long gtm = __ballot(key[q] > tau[q]), eqm = __ballot(key[q] == tau[q]);
            const int need = TOPK - (int)__popcll(gtm);
            const unsigned long long below = (1ull << lane) - 1ull;
            const bool ch = (key[q] > tau[q]) || ((key[q] == tau[q]) && ((int)__popcll(eqm & below) < need));
            const unsigned long long chm = __ballot(ch);
            const int rank = (int)__popcll(chm & below);
            const float wsum = wave_sum(ch ? sgv[q] : 0.f);
            wv[q] = sgv[q] / wsum * ROUTED_SCALE; rk[q] = rank; posl[q] = 0;
            if (ch) { chosen_m |= (1 << q); posl[q] = __hip_atomic_fetch_add(lcnt + lane, 1, __ATOMIC_RELAXED, __HIP_MEMORY_SCOPE_WORKGROUP); }
        }
        LDS_ONLY_BARRIER();
        LSTAMP(15);
        if (wave == 0) { const int n = lcnt[lane]; int base = 0; if (n > 0) base = (int)__hip_atomic_fetch_add(gcnt + lane, (unsigned)n, RLX_AGENT); gb[lane] = base; }
        LDS_ONLY_BARRIER();
        {
            const int base = gb[lane];
#pragma unroll
            for (int q = 0; q < 4; ++q) if (chosen_m & (1 << q)) { const int tok = tok0 + wave * 4 + q; const int pos = base + posl[q];
                tokl[(size_t)lane * CAP + pos] = tok; wl[(size_t)tok * 8 + rk[q]] = wv[q]; tslot[(size_t)tok * 8 + rk[q]] = lane * CAP + pos; }
        }
        LDS_ONLY_BARRIER();
        LSTAMP(16);
    }
#undef LN1_LOAD
#undef LN1_BLK
}

__device__ __forceinline__ void combine_ln2_phase(Frame& F, int layer) {
    bf16* X = (bf16*)(F.ws + WS_X); bf16* H = (bf16*)(F.ws + WS_H); const unsigned char* YS = (const unsigned char*)(F.ws + WS_YS);
    const float* modl = (const float*)(F.ws + WS_MOD) + (size_t)layer * 8 * 6144;
    const float* modn = (const float*)(F.ws + WS_MOD) + (size_t)(layer + 1) * 8 * 6144;
    const float* lg = inp(F, 18) + layer * D; const float* lb = inp(F, 19) + layer * D;
    const int* tslot = (const int*)(F.ws + WS_TSLOT);
    const LAS int* ts = (const LAS int*)(F.lc + LC_TS);
    const bool lastl = (layer == DEPTH - 1);
    float* xout = (float*)inp(F, 20);
    const int lane = F.lane, wave = F.wave;
    LAS float* PV = (LAS float*)F.lds;
    const int shbase = ts[64] * 256;
    for (int blk = F.vcu; blk < T / 64; blk += F.G) {
        const int tokb = blk * 64, b = tokb / SEQ;
        __syncthreads();
        for (int i = F.tid; i < 1024; i += 512) { PV[i] = modl[(size_t)b * 6144 + 5120 + i] + 1.0f; PV[1024 + i] = lg[i]; PV[2048 + i] = lb[i];
            if (!lastl) { PV[3072 + i] = modn[(size_t)b * 6144 + 1024 + i] + 1.0f; PV[4096 + i] = modn[(size_t)b * 6144 + i]; } }
        __syncthreads();
        const int tw = tokb + wave * 8;
        int sv; { const int v = tslot[(size_t)tw * 8 + lane]; sv = ts[v >> 14] * 256 + (v & (CAP - 1)); }
        const float wvv = ((const float*)(F.ws + WS_WL))[(size_t)tw * 8 + lane] * (1.0f / 32.0f);
        pg8::u32x2_t ys[18]; u32x4 xs[2];
#define CB_LOAD(k) do { const int tok_ = tw + (k); _Pragma("unroll") for (int kk_ = 0; kk_ < 9; ++kk_) { const int slot_ = (kk_ < 8) ? __builtin_amdgcn_readlane(sv, 8 * (k) + kk_) : (shbase + tok_); \
            const unsigned char* yr_ = YS + (size_t)slot_ * D + 8 * lane; ys[2 * kk_] = __builtin_nontemporal_load((const GAS pg8::u32x2_t*)(yr_)); ys[2 * kk_ + 1] = __builtin_nontemporal_load((const GAS pg8::u32x2_t*)(yr_ + 512)); } \
            _Pragma("unroll") for (int j_ = 0; j_ < 2; ++j_) xs[j_] = __builtin_nontemporal_load((const GAS u32x4*)(X + (size_t)tok_ * D + 8 * lane + 512 * j_)); } while (0)
        CB_LOAD(0);
#pragma unroll 1
        for (int k = 0; k < 8; ++k) {
            const int tok_ = tw + k; f32x4 y_[4];
#pragma unroll
            for (int jj_ = 0; jj_ < 4; ++jj_) y_[jj_] = (f32x4){0.f, 0.f, 0.f, 0.f};
#pragma unroll
            for (int kk_ = 0; kk_ < 9; ++kk_) { const float wk_ = (kk_ < 8) ? __builtin_bit_cast(float, __builtin_amdgcn_readlane(__builtin_bit_cast(int, wvv), 8 * k + kk_)) : (1.0f / 32.0f);
#pragma unroll
                for (int j_ = 0; j_ < 2; ++j_) { const pg8::u32x2_t w_ = ys[2 * kk_ + j_];
                    const f32x2 a0_ = __builtin_amdgcn_cvt_pk_f32_fp8((int)w_.x, false), a1_ = __builtin_amdgcn_cvt_pk_f32_fp8((int)w_.x, true), b0_ = __builtin_amdgcn_cvt_pk_f32_fp8((int)w_.y, false), b1_ = __builtin_amdgcn_cvt_pk_f32_fp8((int)w_.y, true);
                    y_[2 * j_][0] += wk_ * a0_[0]; y_[2 * j_][1] += wk_ * a0_[1]; y_[2 * j_][2] += wk_ * a1_[0]; y_[2 * j_][3] += wk_ * a1_[1];
                    y_[2 * j_ + 1][0] += wk_ * b0_[0]; y_[2 * j_ + 1][1] += wk_ * b0_[1]; y_[2 * j_ + 1][2] += wk_ * b1_[0]; y_[2 * j_ + 1][3] += wk_ * b1_[1]; } }
            f32x4 v_[4]; float s_ = 0.f;
#pragma unroll
            for (int jj_ = 0; jj_ < 4; ++jj_) { const int col_ = 8 * lane + 512 * (jj_ >> 1) + 4 * (jj_ & 1); const f32x4 g2_ = *(const LAS f32x4*)(PV + col_);
                const unsigned w0_ = (jj_ & 1) ? xs[jj_ >> 1].z : xs[jj_ >> 1].x, w1_ = (jj_ & 1) ? xs[jj_ >> 1].w : xs[jj_ >> 1].y;
                const f32x4 x4_ = (f32x4){h2f(w0_ & 0xffffu), h2f(w0_ >> 16), h2f(w1_ & 0xffffu), h2f(w1_ >> 16)};
                v_[jj_] = x4_ * ALPHA + g2_ * y_[jj_]; s_ += (v_[jj_][0] + v_[jj_][1]) + (v_[jj_][2] + v_[jj_][3]); }
            asm volatile("" : "+v"(v_[0]), "+v"(v_[1]), "+v"(v_[2]), "+v"(v_[3]));
            __builtin_amdgcn_sched_barrier(0);
            { const int kn = (k + 1 < 8) ? k + 1 : k; CB_LOAD(kn); }
            __builtin_amdgcn_sched_barrier(0);
            const float mean_ = wave_sum(s_) * (1.f / D); float q_ = 0.f;
#pragma unroll
            for (int jj_ = 0; jj_ < 4; ++jj_) { v_[jj_] = v_[jj_] - mean_; q_ += (v_[jj_][0] * v_[jj_][0] + v_[jj_][1] * v_[jj_][1]) + (v_[jj_][2] * v_[jj_][2] + v_[jj_][3] * v_[jj_][3]); }
            const float rstd_ = 1.0f / sqrtf(wave_sum(q_) * (1.f / D) + LN_EPS);
#pragma unroll
            for (int jj_ = 0; jj_ < 4; ++jj_) { const int col_ = 8 * lane + 512 * (jj_ >> 1) + 4 * (jj_ & 1);
                const f32x4 gg_ = *(const LAS f32x4*)(PV + 1024 + col_), bb_ = *(const LAS f32x4*)(PV + 2048 + col_);
                const f32x4 xn_ = v_[jj_] * rstd_ * gg_ + bb_;
                if (lastl) *(GAS f32x4*)(xout + (size_t)tok_ * D + col_) = xn_;
                else { u32x2 xw_; xw_.x = pkh2(xn_[0], xn_[1]); xw_.y = pkh2(xn_[2], xn_[3]); *(GAS u32x2*)(X + (size_t)tok_ * D + col_) = xw_; }
                if (!lastl) { const f32x4 sc_ = *(const LAS f32x4*)(PV + 3072 + col_), sh_ = *(const LAS f32x4*)(PV + 4096 + col_); const f32x4 hm_ = xn_ * sc_ + sh_;
                    u32x2 w2_; w2_.x = pk2(hm_[0], hm_[1]); w2_.y = pk2(hm_[2], hm_[3]); *(GAS u32x2*)(H + (size_t)tok_ * D + col_) = w2_; } }
        }
#undef CB_LOAD
    }
}

constexpr int ACCP = 68;
__device__ __forceinline__ int crow(int r, int hi) { return (r & 3) + 8 * (r >> 2) + 4 * hi; }
constexpr int KPITCH = 144;
__device__ __forceinline__ u32x4 f8x8_to_bf16(unsigned a, unsigned b, float inv) {
    const f32x2 p0 = __builtin_amdgcn_cvt_pk_f32_fp8((int)a, false) * inv, p1 = __builtin_amdgcn_cvt_pk_f32_fp8((int)a, true) * inv, p2 = __builtin_amdgcn_cvt_pk_f32_fp8((int)b, false) * inv, p3 = __builtin_amdgcn_cvt_pk_f32_fp8((int)b, true) * inv;
    u32x4 r; r.x = pk2(p0[0], p0[1]); r.y = pk2(p1[0], p1[1]); r.z = pk2(p2[0], p2[1]); r.w = pk2(p3[0], p3[1]); return r;
}
template <bool FIRST, int NB>
__device__ __forceinline__ void attn_task(const unsigned char* QKVb  , int g, int h, int dil, int cls, int q0, int QS, int kb0, int L, float slope2d,
                                          LAS unsigned char* stg  , LAS float* wsf  , LAS float* ACC, LAS float* ML, int trow_mul, int trow_add, int lane) {
    asm volatile("" : "+v"(lane));
    const int r32 = lane & 31, hi = lane >> 5, lr = lane >> 2, lc = lane & 3;
    const int qcol = ((g * 3 + 0) * 16 + h) * 64, kcol = ((g * 3 + 1) * 16 + h) * 64, vcol = ((g * 3 + 2) * 16 + h) * 64;
    const size_t rstride = (size_t)dil * NQKV;
    const unsigned char* base = QKVb + (size_t)cls * NQKV + lc * 16;
    const int jlo = (kb0 >= -31) ? 0 : ((-kb0) >> 5);
    const int qpos = q0 + QS * r32;
    const int dmax = qpos < 128 ? qpos : 128;
    const float half = 0.5f * (float)dmax;
#define AT_LOADROWS(dst, l0, ls, col) do { _Pragma("unroll") for (int i_ = 0; i_ < 2; ++i_) { int l_ = (l0) + (ls) * (16 * i_ + lr); l_ = l_ < 0 ? 0 : (l_ > L - 1 ? L - 1 : l_); \
        dst[i_] = *(const GAS u32x4*)(base + (size_t)l_ * rstride + (col)); } } while (0)
#define AT_PUTROWS(src, inv) do { _Pragma("unroll") for (int i_ = 0; i_ < 2; ++i_) { LAS unsigned char* p_ = stg + (16 * i_ + lr) * KPITCH + lc * 32; \
        *(LAS u32x4*)(p_) = f8x8_to_bf16(src[i_].x, src[i_].y, inv); *(LAS u32x4*)(p_ + 16) = f8x8_to_bf16(src[i_].z, src[i_].w, inv); } } while (0)
#define AT_GETFRAG(dst) do { _Pragma("unroll") for (int s_ = 0; s_ < 4; ++s_) dst[s_] = *(const LAS bf16x8*)(stg + r32 * KPITCH + 32 * s_ + 16 * hi); } while (0)
#define AT_LDSWAIT() asm volatile("s_waitcnt lgkmcnt(0)" ::: "memory")
    u32x4 kr[2][2];
    bf16x8 qf[4];
    { u32x4 qr[2]; AT_LOADROWS(qr, q0, QS, qcol);
#pragma unroll
      for (int j = 0; j < NB; ++j) if (j == jlo) AT_LOADROWS(kr[j & 1], kb0 + 32 * j, 1, kcol);
      AT_PUTROWS(qr, 1.0f / 64.0f); AT_LDSWAIT(); AT_GETFRAG(qf); AT_LDSWAIT(); }
    f32x16 S[NB];
    float mx = -INFINITY;
#pragma unroll
    for (int j = 0; j < NB; ++j) {
        if (j >= jlo) {
            asm volatile("" ::: "memory");
            if (j < NB - 1) AT_LOADROWS(kr[(j + 1) & 1], kb0 + 32 * (j + 1), 1, kcol);
            AT_PUTROWS(kr[j & 1], 1.0f / 16.0f);
            const float xd0 = (float)(qpos - kb0 - 32 * j - 4 * hi) - half;
            const bool inner = (q0 - kb0 - 32 * j - 31 >= 0) && (q0 + QS * 31 - kb0 - 32 * j <= 128) && (kb0 + 32 * j >= 0);
            f32x16 a;
            if (inner) {
                const float cb = -slope2d * xd0;
#pragma unroll
                for (int r = 0; r < 16; ++r) a[r] = __builtin_fmaf(slope2d, (float)((r & 3) + 8 * (r >> 2)), cb);
            } else {
#pragma unroll
                for (int r = 0; r < 16; ++r) { const float x = xd0 - (float)((r & 3) + 8 * (r >> 2)); a[r] = (__builtin_fabsf(x) <= half) ? (-slope2d * x) : -INFINITY; }
            }
            bf16x8 kf[4];
            AT_LDSWAIT(); AT_GETFRAG(kf); AT_LDSWAIT();
#pragma unroll
            for (int s = 0; s < 4; ++s) a = MFMA32(kf[s], qf[s], a);
#pragma unroll
            for (int r = 0; r < 16; ++r) mx = fmaxf(mx, a[r]);
            S[j] = a;
        } else {
#pragma unroll
            for (int r = 0; r < 16; ++r) S[j][r] = -INFINITY;
        }
        __builtin_amdgcn_sched_barrier(0);
    }
    u32x4 vr[2][2];
#pragma unroll
    for (int j = 0; j < NB; ++j) if (j == jlo) AT_LOADROWS(vr[j & 1], kb0 + 32 * j, 1, vcol);
    { auto rr = __builtin_amdgcn_permlane32_swap(__float_as_uint(mx), __float_as_uint(mx), false, false);
      const unsigned r0 = rr[0], r1 = rr[1]; mx = fmaxf(__uint_as_float(r0), __uint_as_float(r1)); }
    const float mx_true = mx - slope2d * half;
    float lsum = 0.f;
    u32x4 P[NB][2];
#pragma unroll
    for (int j = 0; j < NB; ++j) {
        float p[16];
#pragma unroll
        for (int r = 0; r < 16; ++r) { p[r] = __builtin_amdgcn_exp2f(S[j][r] - mx); lsum += p[r]; }
#pragma unroll
        for (int ks = 0; ks < 2; ++ks) { P[j][ks].x = cvt_pk_bf16(p[8 * ks + 0], p[8 * ks + 1]); P[j][ks].y = cvt_pk_bf16(p[8 * ks + 2], p[8 * ks + 3]); P[j][ks].z = cvt_pk_bf16(p[8 * ks + 4], p[8 * ks + 5]); P[j][ks].w = cvt_pk_bf16(p[8 * ks + 6], p[8 * ks + 7]); }
        __builtin_amdgcn_sched_barrier(0);
    }
    { auto rr = __builtin_amdgcn_permlane32_swap(__float_as_uint(lsum), __float_as_uint(lsum), false, false);
      const unsigned r0 = rr[0], r1 = rr[1]; lsum = __uint_as_float(r0) + __uint_as_float(r1); }
    f32x16 o[2]; o[0] = (f32x16){}; o[1] = (f32x16){};
    const unsigned vrd = (unsigned)(((lane >> 4) & 1) * 32 + (lane & 3) * 8 + (4 * hi + ((lane & 15) >> 2)) * 64);
#pragma unroll
    for (int j = 0; j < NB; ++j) {
        if (j >= jlo) {
            asm volatile("" ::: "memory");
            if (j < NB - 1) AT_LOADROWS(vr[(j + 1) & 1], kb0 + 32 * (j + 1), 1, vcol);
#pragma unroll
            for (int i = 0; i < 2; ++i) { const int key = 16 * i + lr;
#pragma unroll
                for (int hf = 0; hf < 2; ++hf) { const int c8 = 2 * lc + hf; const u32x4 src = vr[j & 1][i];
                    *(LAS u32x4*)(stg + ((c8 >> 2) * 2 + (key >> 4)) * 1024 + (key & 15) * 64 + (c8 & 3) * 16) = f8x8_to_bf16(hf ? src.z : src.x, hf ? src.w : src.y, 1.0f / 16.0f); } }
            AT_LDSWAIT();
#pragma unroll
            for (int d0 = 0; d0 < 2; ++d0)
#pragma unroll
                for (int ks = 0; ks < 2; ++ks) {
                    LAS unsigned char* vp = stg + (d0 * 2 + ks) * 1024 + vrd;
                    const s16x4 lo = __builtin_bit_cast(s16x4, __builtin_amdgcn_ds_read_tr16_b64_v4i16((LAS s16x4*)(vp)));
                    const s16x4 hh = __builtin_bit_cast(s16x4, __builtin_amdgcn_ds_read_tr16_b64_v4i16((LAS s16x4*)(vp + 512)));
                    const bf16x8 vf = (bf16x8){lo[0], lo[1], lo[2], lo[3], hh[0], hh[1], hh[2], hh[3]};
                    o[d0] = MFMA32(__builtin_bit_cast(bf16x8, P[j][ks]), vf, o[d0]);
                }
            AT_LDSWAIT();
        }
        __builtin_amdgcn_sched_barrier(0);
    }
#undef AT_LOADROWS
#undef AT_PUTROWS
#undef AT_GETFRAG
#undef AT_LDSWAIT
    if (hi == 0) { wsf[r32] = mx_true; wsf[32 + r32] = lsum; }
    asm volatile("s_waitcnt lgkmcnt(0)" ::: "memory");
    f32x4 mt4[4], lt4[4];
#pragma unroll
    for (int k = 0; k < 4; ++k) { mt4[k] = *(const LAS f32x4*)(wsf + 8 * k + 4 * hi); lt4[k] = *(const LAS f32x4*)(wsf + 32 + 8 * k + 4 * hi); }
    if (FIRST) {
#pragma unroll
        for (int r = 0; r < 16; ++r) { const int q = crow(r, hi); const int trow = q * trow_mul + trow_add;
            ACC[trow * ACCP + r32] = o[0][r]; ACC[trow * ACCP + 32 + r32] = o[1][r];
            if (r32 == 0) { ML[trow * 2] = mt4[r >> 2][r & 3]; ML[trow * 2 + 1] = lt4[r >> 2][r & 3]; } }
    } else {
        f32x2 ml[16]; float a0[16], a1[16];
#pragma unroll
        for (int r = 0; r < 16; ++r) { const int q = crow(r, hi); const int trow = q * trow_mul + trow_add;
            ml[r] = *(const LAS f32x2*)(ML + trow * 2); a0[r] = ACC[trow * ACCP + r32]; a1[r] = ACC[trow * ACCP + 32 + r32]; }
        asm volatile("s_waitcnt lgkmcnt(0)" ::: "memory");
#pragma unroll
        for (int r = 0; r < 16; ++r) { const int q = crow(r, hi); const int trow = q * trow_mul + trow_add;
            const float mt = mt4[r >> 2][r & 3], lt = lt4[r >> 2][r & 3], mo = ml[r][0], lo_ = ml[r][1];
            const float mn = fmaxf(mo, mt); const float fa = __builtin_amdgcn_exp2f(mo - mn), fb = __builtin_amdgcn_exp2f(mt - mn);
            ACC[trow * ACCP + r32] = a0[r] * fa + o[0][r] * fb; ACC[trow * ACCP + 32 + r32] = a1[r] * fa + o[1][r] * fb;
            if (r32 == 0) { ML[trow * 2] = mn; ML[trow * 2 + 1] = lo_ * fa + lt * fb; } }
    }
    asm volatile("s_waitcnt lgkmcnt(0)" ::: "memory");
}

__device__ __forceinline__ void attn_phase(Frame& F, bf16* MIX) {
    const unsigned char* QKV = (const unsigned char*)(F.ws + WS_QKV);
    LAS float* ACC = (LAS float*)F.lds;
    LAS float* ML = (LAS float*)(F.lds + 69632);
    LAS unsigned char* vst = F.lds + 73728 + F.wave * 4608;
    LAS float* wsf = (LAS float*)(F.lds + 73728 + 8 * 4608 + F.wave * 256);
    const int lane = F.lane, w = F.wave;
    for (int i = 0;; ++i) {
        if (i >= (BATCH * 16 * 8) / F.G) break;
        const int L0 = (F.G == 256) ? ((F.vcu >> 5) * 128 + i * 32 + (F.vcu & 31)) : (i * F.G + F.vcu);
        const int bh = L0 >> 3, ti = L0 & 7; int w4 = ti >> 1; const int c = ti & 1; if (i & 1) w4 = 3 - w4;
        const int b = bh >> 4, h = bh & 15, win0 = w4 * 512;
        const unsigned char* Qb = QKV + (size_t)b * SEQ * NQKV;
        const float sl0 = exp2f(-8.0f * (float)(0 * 16 + h + 1) / 48.0f) * LOG2E, sl1 = exp2f(-8.0f * (float)(1 * 16 + h + 1) / 48.0f) * LOG2E * 4.0f, sl2 = exp2f(-8.0f * (float)(2 * 16 + h + 1) / 48.0f) * LOG2E * 16.0f;
        LSTAMP0();
        attn_task<true, 6>(Qb, 0, h, 1, 0, win0 + 64 * w + c, 2, win0 + 64 * w - 128, SEQ, sl0, vst, wsf, ACC, ML, 1, 32 * w, lane);
        __syncthreads();
        LSTAMP(24);
        if (ATTN_GMASK & 2) { const int cls = c + 2 * (w & 1), lb = w >> 1, lq0 = 128 * w4 + 32 * lb; attn_task<false, 5>(Qb, 1, h, 4, cls, lq0, 1, lq0 - 128, SEQ / 4, sl1, vst, wsf, ACC, ML, 2, 64 * lb + (w & 1), lane); }
        __syncthreads();
        LSTAMP(25);
        if (ATTN_GMASK & 4) { const int cls = c + 2 * w, lq0 = 32 * w4; attn_task<false, 5>(Qb, 2, h, 16, cls, lq0, 1, lq0 - 128, SEQ / 16, sl2, vst, wsf, ACC, ML, 8, w, lane); }
        __syncthreads();
        LSTAMP(26);
        {
#pragma unroll
          for (int it = 0; it < 4; ++it) { const int trow = 32 * w + 8 * it + (lane >> 3), sg = lane & 7; const float inv = 1.0f / ML[trow * 2 + 1];
              const LAS f32x4* ap = (const LAS f32x4*)(ACC + trow * ACCP + sg * 8);
              bf16* op = MIX + (size_t)(b * SEQ + win0 + 2 * trow + c) * D + h * 64 + sg * 8;
              const f32x4 a = ap[0] * inv, bq = ap[1] * inv; u32x4 wv; wv.x = pk2(a[0], a[1]); wv.y = pk2(a[2], a[3]); wv.z = pk2(bq[0], bq[1]); wv.w = pk2(bq[2], bq[3]);
              *(GAS u32x4*)op = wv; } }
        __syncthreads();
    }
}

__device__ __forceinline__ void attn_phase_naive(Frame& F, bf16* MIX, const int gmask) {
    const bf16* QKV = (const bf16*)(F.ws + WS_YS);
    const int lane = F.lane;
    const int gw = F.vcu * NWAVES + F.wave, NGW = F.G * NWAVES;
    for (int item = gw; item < T * 16; item += NGW) {
        const int tok = item >> 4, h = item & 15, b = tok / SEQ, t = tok % SEQ;
        const bf16* Qb = QKV + (size_t)b * SEQ * NQKV;
        float sc[3][3]; int kt[3][3];
        float mx = -INFINITY;
#pragma unroll
        for (int g = 0; g < 3; ++g) {
            const int dil = (g == 0) ? 1 : (g == 1 ? 4 : 16);
            const float slope = exp2f(-8.0f * (float)(g * 16 + h + 1) / 48.0f);
            const bf16* qp = Qb + (size_t)t * NQKV + ((g * 3 + 0) * 16 + h) * 64;
#pragma unroll
            for (int c = 0; c < 3; ++c) {
                const int j = lane + 64 * c; const int tk = t - j * dil;
                float s = -INFINITY;
                if (j <= 128 && tk >= 0 && ((gmask >> g) & 1)) {
                    const bf16* kp = Qb + (size_t)tk * NQKV + ((g * 3 + 1) * 16 + h) * 64;
                    float d = 0.f;
                    for (int e = 0; e < 64; ++e) d += bf2f(qp[e]) * bf2f(kp[e]);
                    s = d - slope * LOG2E * (float)(j * dil);
                }
                sc[g][c] = s; kt[g][c] = tk; mx = fmaxf(mx, s);
            }
        }
#pragma unroll
        for (int o = 1; o < 64; o <<= 1) mx = fmaxf(mx, __shfl_xor(mx, o));
        float den = 0.f; float acc[64];
#pragma unroll
        for (int e = 0; e < 64; ++e) acc[e] = 0.f;
#pragma unroll
        for (int g = 0; g < 3; ++g)
#pragma unroll
            for (int c = 0; c < 3; ++c) {
                const float p = (sc[g][c] == -INFINITY) ? 0.f : exp2f(sc[g][c] - mx);
                den += p;
                if (p != 0.f) { const bf16* vp = Qb + (size_t)kt[g][c] * NQKV + ((g * 3 + 2) * 16 + h) * 64;
#pragma unroll
                    for (int e = 0; e < 64; ++e) acc[e] += p * bf2f(vp[e]); }
            }
        den = wave_sum(den);
        float mine = 0.f;
#pragma unroll
        for (int e = 0; e < 64; ++e) { const float v = wave_sum(acc[e]); if (lane == e) mine = v; }
        MIX[(size_t)tok * D + h * 64 + lane] = (bf16)f2bf(mine / den);
    }
}

struct Args { const float* in[20]; float* out; unsigned char* ws; int ph_lo, ph_hi; };
constexpr int NPHASE = 2 + DEPTH * 8;

__global__ void __launch_bounds__(NWAVES * 64, 2) mk_fwd(Args args) {
    extern __shared__ __attribute__((aligned(16))) unsigned char lds_raw[];
    Frame F;
    F.lds = (LAS unsigned char*)lds_raw; F.lc = F.lds + LDSCTL_OFF;
    F.tid = threadIdx.x; F.lane = F.tid & 63; F.wave = __builtin_amdgcn_readfirstlane(F.tid >> 6);
    F.G = gridDim.x; { const int bx = blockIdx.x; F.vcu = (F.G % 8 == 0) ? (bx % 8) * (F.G / 8) + bx / 8 : bx; }
    F.ws = args.ws; F.ctl = (unsigned*)(args.ws + WS_CTL);
    for (int u = F.tid; u < (LDS_BYTES - LDSCTL_OFF) / 4; u += NWAVES * 64) ((LAS unsigned*)F.lc)[u] = 0u;
    __syncthreads();
    if (F.tid == 0) {
#pragma unroll
        for (int i = 0; i < 20; ++i) *(LAS unsigned long long*)(F.lc + LC_PTR + 8 * i) = (unsigned long long)args.in[i];
        *(LAS unsigned long long*)(F.lc + LC_PTR + 8 * 20) = (unsigned long long)args.out;
    }
    __syncthreads();
#if MK_PER_PHASE
#define GRID_BAR() do { } while (0)
    XcdBarrier bar; bar.bar = nullptr; bar.x = 0; bar.st = nullptr;
#else
    XcdBarrier bar = xcd_barrier_post(F.ctl + CW_BAR, (volatile LAS unsigned*)(F.lc + LC_MISC) + 8);
#define GRID_BAR() xcd_barrier(bar)
#endif
    const int lo = args.ph_lo, hi = args.ph_hi;
#ifdef PROBE_TYPE
#define LC_STAMP 3072
#define STAMP(ty) do { if (blockIdx.x == 0 && F.tid == 0) { const unsigned long long now_ = __builtin_amdgcn_s_memrealtime(); LAS unsigned long long* st_ = (LAS unsigned long long*)(F.lc + LC_STAMP); \
        st_[1 + (ty)] += now_ - st_[0]; st_[0] = now_; } } while (0)
    if (blockIdx.x == 0 && F.tid == 0) { ((LAS unsigned long long*)(F.lc + LC_STAMP))[0] = __builtin_amdgcn_s_memrealtime(); }
#else
#define STAMP(ty) do { } while (0)
#endif
#define IN(k) (lo <= (k) && (k) < hi)
#define SEAM(k) do { if (IN(k) && IN((k) + 1)) GRID_BAR(); } while (0)
    const float* mod = (const float*)(F.ws + WS_MOD);

    if (PHON(0) && IN(0)) { p0_prologue(F); } SEAM(0); STAMP(0);
    bool xlocal = false; int cid = (int)blockIdx.x;
#if !MK_PER_PHASE
    { volatile LAS unsigned* st = (volatile LAS unsigned*)(F.lc + LC_MISC) + 8;
      if (F.tid == 0) { unsigned ok = (F.G == 256) ? 1u : 0u;
#pragma unroll
          for (unsigned jx = 0; jx < 16; ++jx) { const unsigned cj = xb_ld(&bar.bar[XB_XCNT(jx)]); ok &= (jx < 8u) ? (cj == 32u ? 1u : 0u) : (cj == 0u ? 1u : 0u); }
          st[3] = ok; }
      __syncthreads();
      xlocal = (st[3] != 0u) && (MK_XLOCAL != 0);
      if (xlocal) cid = (int)(st[2] * 8u + bar.x); }
#endif
    cid = __builtin_amdgcn_readfirstlane(cid);
    F.vcu = (F.G % 8 == 0) ? (cid % 8) * (F.G / 8) + cid / 8 : cid;
#define LSEAM(k) do { if (IN(k) && IN((k) + 1)) { if (xlocal) xcd_local_barrier(bar, F.wave == 0); else GRID_BAR(); } } while (0)
    if (PHON(1) && IN(1)) { p1_modulate(F, inp(F, 0), mod, 0, 1024); } SEAM(1); STAMP(1);

    for (int layer = 0; layer < DEPTH; ++layer) {
        const int pb = 2 + layer * 8; const int j = layer >> 1;
        if ((layer & 1) == 0) {
            if (PHON(2) && IN(pb + 0)) { refresh(F); unsigned char* ws = opq(F.ws); (void)ws;
                PlainSched S{T / 256, 4, 256, F.G, cid, (const char*)(ws + WS_WPIN) + (size_t)j * 2 * MiB, 2048};
                pg8::EpiStore E{(bf16*)(ws + WS_U), D, nullptr, 0, 0, 0, F.lds + LDS_TB_OFF + F.wave * 2048};
                pg8::gemm_phase<pg8::EpiStore, PlainSched>(F.tid, F.lds, (const char*)(ws + WS_H), 2048, 2048, 1024, S, E);
            } LSEAM(pb + 0); STAMP(2);
            if (PHON(4) && IN(pb + 2)) { refresh(F); unsigned char* ws = opq(F.ws); (void)ws;
                GrpSched S{F.G, cid, (const char*)(ws + WS_WPGRP) + (size_t)j * 512 * 1024};
                { const bf16* U = (const bf16*)(ws + WS_U); bf16* Z = (bf16*)(ws + WS_Z); pg8::Unit pu;
                  for (int i = 0; S.next(i, pu); ++i) {
                      const int b = pu.pm >> 3, t0 = (pu.pm & 7) * 256 + 32 * F.wave, g = pu.pn;
                      if (g == 0) pool_item<2>(U, Z, b, t0, 0, F.lane); else if (g == 1) pool_item<4>(U, Z, b, t0, 1, F.lane);
                      else if (g == 2) pool_item<8>(U, Z, b, t0, 2, F.lane); else pool_item<16>(U, Z, b, t0, 3, F.lane); }
                  asm volatile("s_waitcnt vmcnt(0)" ::: "memory"); __syncthreads(); }
                pg8::EpiStore E{(bf16*)(ws + WS_Y2), D, inp(F, 6) + j * D, 0, 0, 0, F.lds + LDS_TB_OFF + F.wave * 2048};
                pg8::gemm_phase<pg8::EpiStore, GrpSched>(F.tid, F.lds, (const char*)(ws + WS_Z), 2048, 512, 256, S, E);
            } LSEAM(pb + 2); STAMP(4);
            if (PHON(5) && IN(pb + 3)) { refresh(F); unsigned char* ws = opq(F.ws); (void)ws;
                PlainSched S{T / 256, 4, 256, F.G, cid, (const char*)(ws + WS_WPOUT) + (size_t)j * 2 * MiB, 2048};
                pg8::EpiStore E{(bf16*)(ws + WS_Y), D, nullptr, 0, 0, 1, F.lds + LDS_TB_OFF + F.wave * 2048};
                pg8::gemm_phase<pg8::EpiStore, PlainSched>(F.tid, F.lds, (const char*)(ws + WS_Y2), 2048, 2048, 1024, S, E);
            } LSEAM(pb + 3); STAMP(5);
        } else {
            if (PHON(6) && IN(pb + 0)) { refresh(F); unsigned char* ws = opq(F.ws); (void)ws;
                PlainSched S{T / 256, NQKV / 256, (T / 256) * (NQKV / 256), F.G, cid, (const char*)(ws + WS_WAIN) + (size_t)j * 18 * MiB, 2048};
                pg8::EpiStoreF8 E{(unsigned char*)(ws + WS_QKV), NQKV, F.lds + LDS_TB_OFF + F.wave * 2048, 1};
                pg8::gemm_phase<pg8::EpiStoreF8, PlainSched>(F.tid, F.lds, (const char*)(ws + WS_H), 2048, 2048, 1024, S, E);
            } LSEAM(pb + 0); STAMP(6);
            if (PHON(7) && IN(pb + 1)) { refresh(F); unsigned char* ws = opq(F.ws); (void)ws;
#ifdef NAIVE_ATTN
                attn_phase_naive(F, (bf16*)(F.ws + WS_Y2), 7);
#ifdef ORACLE
                if (layer == ORACLE_LAYER) { attn_phase_naive(F, (bf16*)(F.ws + WS_Z), ATTN_GMASK); attn_phase(F, (bf16*)(F.ws + WS_U)); }
#endif
#else
                attn_phase(F, (bf16*)(F.ws + WS_Y2));
#endif
            } if (IN(pb + 1) && IN(pb + 3)) { if (xlocal) xcd_local_barrier(bar, F.wave == 0); else GRID_BAR(); } STAMP(7);
            if (IN(pb + 2)) { refresh(F); unsigned char* ws = opq(F.ws); (void)ws;
#ifdef ORACLE
                if (layer == ORACLE_LAYER) { if (blockIdx.x == 0 && F.tid == 0) atomicAdd(F.ctl + 20000, 3276u * 16u);
                    const bf16* A = (const bf16*)(ws + WS_U); const bf16* B = (const bf16*)(ws + WS_Z);
                    const int gw = F.vcu * NWAVES + F.wave, NGW = F.G * NWAVES;
                    for (int tok = gw; tok < T; tok += NGW) { int bad = 0;
                        for (int h = 0; h < 16; ++h) { if (ORACLE_SEL) { const float a = bf2f(A[(size_t)tok * D + h * 64 + F.lane]), b = bf2f(B[(size_t)tok * D + h * 64 + F.lane]);
                            const float e2 = wave_sum((a - b) * (a - b)), n2 = wave_sum(b * b); if (!(e2 <= 0.0025f * n2)) bad += ORACLE_W; } }
                        if (bad && F.lane == 0) atomicAdd(F.ctl + 20000, (unsigned)bad); } }
#endif
            }
            if (PHON(8) && IN(pb + 3)) { refresh(F); unsigned char* ws = opq(F.ws); (void)ws;
                PlainSched S{T / 256, 4, 256, F.G, cid, (const char*)(ws + WS_WAOUT) + (size_t)j * 2 * MiB, 2048};
                pg8::EpiStore E{(bf16*)(ws + WS_Y), D, nullptr, 0, 0, 1, F.lds + LDS_TB_OFF + F.wave * 2048};
                pg8::gemm_phase<pg8::EpiStore, PlainSched>(F.tid, F.lds, (const char*)(ws + WS_Y2), 2048, 2048, 1024, S, E);
            } LSEAM(pb + 3); STAMP(8);
        }
        if (PHON(9) && IN(pb + 4)) { refresh(F); unsigned char* ws = opq(F.ws); (void)ws; const float* xin = (layer == 0) ? inp(F, 0) : (const float*)(ws + WS_X); if (layer == 0) ln1_router_phase<false>(F, layer, xin); else ln1_router_phase<true>(F, layer, xin); } SEAM(pb + 4); STAMP(9);
        if (PHON(10) && IN(pb + 5)) { refresh(F); unsigned char* ws = opq(F.ws); (void)ws;
            moe_build_table(F, layer);
            const LAS int* ts = (const LAS int*)(F.lc + LC_TS);
            const int ntile = ts[65];
            MoeSched<true> S{ts, (const LAS int*)(F.lc + LC_CNT), 2, ntile * 2, F.G, cid, F.lane, (const int*)(ws + WS_TOKL), (const float*)(ws + WS_WL),
                       (const char*)(ws + WS_WEGU) + (size_t)layer * 64 * MiB, (size_t)1 * MiB, (const char*)(ws + WS_WSHGU) + (size_t)layer * MiB, 2048};
            pg8::EpiGU E{(bf16*)(ws + WS_ACT)};
            pg8::gemm_phase<pg8::EpiGU, MoeSched<true>>(F.tid, F.lds, (const char*)(ws + WS_H), 2048, 2048, 1024, S, E);
        } LSEAM(pb + 5); STAMP(10);
        if (PHON(11) && IN(pb + 6)) { refresh(F); unsigned char* ws = opq(F.ws); (void)ws;
            moe_build_table(F, layer);
            const LAS int* ts = (const LAS int*)(F.lc + LC_TS);
            const int ntile = ts[65];
            MoeSched<false> S{ts, (const LAS int*)(F.lc + LC_CNT), 4, ntile * 4, F.G, cid, F.lane, nullptr, nullptr,
                       (const char*)(ws + WS_WEDN) + (size_t)layer * 32 * MiB, (size_t)512 * 1024, (const char*)(ws + WS_WSHDN) + (size_t)layer * 512 * 1024, 512};
            pg8::EpiStoreF8 E{(unsigned char*)(ws + WS_YS), D, F.lds + LDS_TB_OFF + F.wave * 2048, 0};
            pg8::gemm_phase<pg8::EpiStoreF8, MoeSched<false>>(F.tid, F.lds, (const char*)(ws + WS_ACT), 512, 512, 256, S, E);
        } SEAM(pb + 6); STAMP(11);
        if (PHON(12) && IN(pb + 7)) { refresh(F); unsigned char* ws = opq(F.ws); (void)ws; moe_build_table(F, layer); combine_ln2_phase(F, layer); }
        if (layer < DEPTH - 1) LSEAM(pb + 7);
        STAMP(12);
    }
#ifdef PROBE_TYPE
    if (blockIdx.x == 0 && F.tid == 0) { const unsigned long long t0_ = __builtin_amdgcn_s_memrealtime(); const unsigned long long want_ = 4ull * ((LAS unsigned long long*)(F.lc + LC_STAMP))[1 + PROBE_TYPE];
        while (__builtin_amdgcn_s_memrealtime() - t0_ < want_) __builtin_amdgcn_s_sleep(8); }
#endif
#undef IN
#undef SEAM
}

extern "C" void kernel_launch(void* const* d_in, const int* in_sizes, int n_in, void* d_out, int out_size, void* d_ws, size_t ws_size, hipStream_t stream) {
    static int grid = 0;
    if (grid == 0) {
        if (n_in != 20 || in_sizes[0] != T * D || out_size != T * D || ws_size < WS_END) { fprintf(stderr, "kernel_launch: unexpected shapes / workspace (n_in %d, ws %zu); nothing launched\n", n_in, ws_size); grid = -1; return; }
        int dev = 0, cus = 0, per_cu = 0;
        if (hipGetDevice(&dev) != hipSuccess || hipDeviceGetAttribute(&cus, hipDeviceAttributeMultiprocessorCount, dev) != hipSuccess) { grid = -1; return; }
        if (hipFuncSetAttribute((const void*)mk_fwd, hipFuncAttributeMaxDynamicSharedMemorySize, LDS_BYTES) != hipSuccess) { fprintf(stderr, "kernel_launch: hipFuncSetAttribute failed\n"); grid = -1; return; }
        if (hipOccupancyMaxActiveBlocksPerMultiprocessor(&per_cu, (const void*)mk_fwd, NWAVES * 64, LDS_BYTES) != hipSuccess || per_cu < 1) { fprintf(stderr, "kernel_launch: occupancy query says %d\n", per_cu); }
        (void)hipGetLastError();
        grid = cus;
    }
    if (grid < 0) return;
    if (hipMemsetAsync((char*)d_ws + WS_CTL, 0, CTL_ZERO_BYTES, stream) != hipSuccess) return;
    Args a{};
    for (int i = 0; i < 20; ++i) a.in[i] = (const float*)d_in[i];
    a.out = (float*)d_out; a.ws = (unsigned char*)d_ws;
#if MK_PER_PHASE
    for (int p = 0; p < NPHASE; ++p) { a.ph_lo = p; a.ph_hi = p + 1; hipLaunchKernelGGL(mk_fwd, dim3(grid), dim3(NWAVES * 64), LDS_BYTES, stream, a); }
#else
    a.ph_lo = 0; a.ph_hi = NPHASE;
    hipLaunchKernelGGL(mk_fwd, dim3(grid), dim3(NWAVES * 64), LDS_BYTES, stream, a);
#endif
    const hipError_t le = hipPeekAtLastError();
    if (le != hipSuccess) fprintf(stderr, "kernel_launch: launch failed: %s\n", hipGetErrorName(le));
}
```

```cpp
#include <hip/hip_runtime.h>
#include <cstdio>
#include <cstdint>

#ifndef MK_PER_PHASE
#define MK_PER_PHASE 0
#endif
#define ORACLE_SEL 1
#define ATTN_GMASK 7
#define ORACLE_W 1
#define ORACLE_LAYER 1
#ifndef MK_XLOCAL
#define MK_XLOCAL 1
#endif
#ifndef PHSEL
#define PHSEL 0xFFFF
#endif
#define PHON(n) (((PHSEL) >> (n)) & 1)

#define GAS __attribute__((address_space(1)))
#define LAS __attribute__((address_space(3)))
typedef unsigned short bf16;
typedef short bf16x8 __attribute__((ext_vector_type(8)));
typedef short s16x4 __attribute__((ext_vector_type(4)));
typedef float f32x2 __attribute__((ext_vector_type(2)));
typedef float f32x4 __attribute__((ext_vector_type(4)));
typedef float f32x16 __attribute__((ext_vector_type(16)));
typedef unsigned u32x2 __attribute__((ext_vector_type(2)));
typedef unsigned u32x4 __attribute__((ext_vector_type(4)));

constexpr int BATCH = 8, SEQ = 2048, D = 1024, T = BATCH * SEQ, DEPTH = 4;
constexpr int NQKV = 9216, NE = 64, TOPK = 8, DEXP = 256;
constexpr int CAP = 16384;
constexpr int PSLOT = 147456 + T;
constexpr float ALPHA = 1.6817928305074290f;
constexpr float LN_EPS = 1e-5f;
constexpr float LOG2E = 1.4426950408889634f;
constexpr float QSCALE = 0.125f * LOG2E;
constexpr float ROUTED_SCALE = 2.5f;

constexpr size_t MiB = 1u << 20;
constexpr size_t WS_CTL = 0, CTL_ZERO_BYTES = 1 * MiB;
constexpr size_t WS_MOD = 1 * MiB;
constexpr size_t WS_WRHI = 2 * MiB;
constexpr size_t WS_WRLO = WS_WRHI + 512 * 1024;
constexpr size_t WS_WPIN = 3 * MiB;
constexpr size_t WS_WPGRP = 7 * MiB;
constexpr size_t WS_WPOUT = 8 * MiB;
constexpr size_t WS_WAIN = 12 * MiB;
constexpr size_t WS_WAOUT = 48 * MiB;
constexpr size_t WS_WSHGU = 52 * MiB;
constexpr size_t WS_WSHDN = 56 * MiB;
constexpr size_t WS_WEGU = 58 * MiB;
constexpr size_t WS_WEDN = 314 * MiB;
constexpr size_t WS_X = 442 * MiB;
constexpr size_t WS_H = 506 * MiB;
constexpr size_t WS_Y = 538 * MiB;
constexpr size_t WS_U = 570 * MiB;
constexpr size_t WS_Z = 602 * MiB;
constexpr size_t WS_Y2 = 634 * MiB;
constexpr size_t WS_YS = 666 * MiB;
constexpr size_t WS_ACT = 986 * MiB;
constexpr size_t WS_TOKL = 1066 * MiB;
constexpr size_t WS_WL = 1070 * MiB;
constexpr size_t WS_TSLOT = 1074 * MiB;
constexpr size_t WS_QKV = 1076 * MiB;
constexpr size_t WS_END = 1364 * MiB;
static_assert(WS_YS + (size_t)PSLOT * 2048 <= WS_ACT && WS_ACT + (size_t)PSLOT * 512 <= WS_TOKL, "ws map");
constexpr int CW_BAR = 4096;
constexpr int CW_CNT = 12288;

constexpr int RING_BYTES = 135168;
constexpr int LDSCTL_OFF = RING_BYTES;
constexpr int LDS_TB_OFF = 147456;
constexpr int LDS_BYTES = 163840;
constexpr int LC_MISC = 0;
constexpr int LC_TS = 128;
constexpr int LC_CNT = 128 + 272;
constexpr int LC_LCNT = 128 + 272 + 256;
constexpr int LC_GB = 128 + 272 + 512;

#define RLX_AGENT __ATOMIC_RELAXED, __HIP_MEMORY_SCOPE_AGENT
#define LDS_WAIT() asm volatile("s_waitcnt lgkmcnt(0)" ::: "memory")
#define VM_WAIT() asm volatile("s_waitcnt vmcnt(0)" ::: "memory")

typedef __bf16 b16x2 __attribute__((ext_vector_type(2)));
__device__ __forceinline__ unsigned f2bf(float f) { unsigned u = __builtin_bit_cast(unsigned, f); return (u + 0x7fffu + ((u >> 16) & 1u)) >> 16; }
__device__ __forceinline__ unsigned pk2(float lo, float hi) { const f32x2 v = {lo, hi}; return __builtin_bit_cast(unsigned, __builtin_convertvector(v, b16x2)); }
__device__ __forceinline__ float bf2f(unsigned h) { return __builtin_bit_cast(float, h << 16); }
__device__ __forceinline__ unsigned cvt_pk_bf16(float lo, float hi) { return pk2(lo, hi); }
typedef _Float16 h16x2 __attribute__((ext_vector_type(2)));
__device__ __forceinline__ unsigned pkh2(float lo, float hi) { const f32x2 v = {lo, hi}; return __builtin_bit_cast(unsigned, __builtin_convertvector(v, h16x2)); }
__device__ __forceinline__ float h2f(unsigned h) { return (float)__builtin_bit_cast(_Float16, (unsigned short)h); }
#define MFMA16(a, b, c) __builtin_amdgcn_mfma_f32_16x16x32_bf16(a, b, c, 0, 0, 0)
#define MFMA32(a, b, c) __builtin_amdgcn_mfma_f32_32x32x16_bf16(a, b, c, 0, 0, 0)
__device__ __forceinline__ float wave_sum(float v) {
#pragma unroll
    for (int o = 1; o < 64; o <<= 1) v += __shfl_xor(v, o);
    return v;
}

namespace pg8 {
constexpr int BM = 256, BK = 64, HALF = 128, HTB = HALF * BK * 2, STAGE_BYTES = 8 * HTB, NXCD = 8;
__host__ __device__ __forceinline__ int lds_byte(int r, int c) { const int st = (r >> 4) * 2 + (c >> 5), rr = r & 15, cc = c & 31, ob = rr * 64 + cc * 2; return st * 1024 + (ob ^ (((ob >> 9) & 1) << 5)); }
__host__ __device__ __forceinline__ void stage_rc(int b, int& R, int& C) { const int st = b / 1024, sb = b % 1024, swz = sb ^ (((sb >> 9) & 1) << 5); R = (st >> 1) * 16 + swz / 64; C = (st & 1) * 32 + (swz % 64) / 2; }
__host__ __device__ __forceinline__ int perm32(int rho) { const int n = rho >> 4, i = rho & 15; return 8 * (i >> 2) + 4 * n + (i & 3); }

struct Unit {
    int pm, pn;
    const char* bptr;
    int roff;
    int nvalid;
};

__device__ __forceinline__ int xcd_chunk(int L, int nwg) { const int q = nwg / NXCD, r = nwg % NXCD, xcd = L % NXCD, off = L / NXCD; return (xcd < r ? xcd * (q + 1) : r * (q + 1) + (xcd - r) * q) + off; }

template <class Epi, class Sched>
__device__ __forceinline__ void gemm_phase(const int tid, LAS unsigned char* lds, const char* Abase, const int lda, const int ldb, const int K, const Sched& S, const Epi& E) {
    constexpr bool GATHER = Sched::GATHER;
    const int wid = __builtin_amdgcn_readfirstlane(tid >> 6), lane = tid & 63, wr = wid >> 2, wc = wid & 3, fr = lane & 15, fq = lane >> 4;
    const int nt = K / BK;
    int Rr[2]; unsigned C2[2], voffB[2], voffA[2];
#pragma unroll
    for (int i = 0; i < 2; ++i) { int R, C; stage_rc(tid * 16 + i * 8192, R, C); const int Rb = Epi::WIDE ? ((R >> 5) * 64 + perm32(R & 31)) : ((R & ~31) + perm32(R & 31)); Rr[i] = R; C2[i] = (unsigned)C * 2u; voffB[i] = (unsigned)(Rb * ldb) + (unsigned)C * 2u;
        voffA[i] = Sched::ABLK ? (unsigned)((C >> 5) * 16384 + R * 64 + (C & 31) * 2) : ((unsigned)(R * lda) + (unsigned)C * 2u); }
    const size_t kstep = (size_t)(BK * 2);
    const size_t hstepB = (size_t)(Epi::WIDE ? 32 : HALF) * ldb;
    const size_t hstepA = GATHER ? (size_t)0 : (Sched::ABLK ? (size_t)8192 : (size_t)HALF * lda);
    const size_t kstepA = Sched::ABLK ? (size_t)32768 : kstep;
    const unsigned ldsw = (unsigned)wid * 1024u;
    const int aoff = lds_byte(wr * 64 + fr, fq * 8), boff = lds_byte(wc * 32 + fr, fq * 8);
#define PG8_SA(b, h) (((b) * 2 + (h)) * HTB)
#define PG8_SB(b, h) ((4 + (b) * 2 + (h)) * HTB)
#define PG8_STAGE(bufoff, gbase, voff) do { _Pragma("unroll") for (int _i = 0; _i < 2; ++_i) \
        __builtin_amdgcn_global_load_lds((const unsigned*)((const char*)(gbase) + (voff)[_i]), (LAS unsigned*)(lds + (bufoff) + ldsw + _i * 8192), 16, 0, 0); } while (0)
#define PG8_STAGEA(bufoff, gbase, h) do { if constexpr (GATHER) { PG8_STAGE(bufoff, gbase, vA[h]); } else { PG8_STAGE(bufoff, (gbase) + (h) * hstepA, voffA); } } while (0)
#define PG8_LDA(dst, b, h) do { _Pragma("unroll") for (int m = 0; m < 4; ++m) _Pragma("unroll") for (int k = 0; k < 2; ++k) dst[m][k] = *(const LAS bf16x8*)(lds + PG8_SA(b, h) + aoff + m * 2048 + k * 1024); } while (0)
#define PG8_LDB(dst, b, h) do { _Pragma("unroll") for (int n = 0; n < 2; ++n) _Pragma("unroll") for (int k = 0; k < 2; ++k) dst[n][k] = *(const LAS bf16x8*)(lds + PG8_SB(b, h) + boff + n * 2048 + k * 1024); } while (0)
#define PG8_MMA(ai, bj, At, Bt) do { __builtin_amdgcn_s_setprio(1); _Pragma("unroll") for (int m = 0; m < 4; ++m) _Pragma("unroll") for (int n = 0; n < 2; ++n) _Pragma("unroll") for (int k = 0; k < 2; ++k) \
        acc[ai][bj][m][n] = MFMA16(Bt[n][k], At[m][k], acc[ai][bj][m][n]); __builtin_amdgcn_s_setprio(0); } while (0)
#define PG8_WAIT_V(n) asm volatile("s_waitcnt vmcnt(" #n ")" ::: "memory")
#define PG8_WAIT_L(n) asm volatile("s_waitcnt lgkmcnt(" #n ")" ::: "memory")
#define PG8_BAR __builtin_amdgcn_s_barrier()
#define PG8_SCHED __builtin_amdgcn_sched_barrier(0)
#define PG8_CALCA(u, vo) do { _Pragma("unroll") for (int _h = 0; _h < 2; ++_h) _Pragma("unroll") for (int _i = 0; _i < 2; ++_i) \
        vo[_h][_i] = (unsigned)S.arow(u, _h * HALF + Rr[_i]) * (unsigned)lda + C2[_i]; } while (0)
    Unit cur, nxt; int ui = 0;
    if (!S.next(0, cur)) return;
    f32x4 acc[2][2][4][2];
#pragma unroll
    for (int a = 0; a < 2; ++a)
#pragma unroll
        for (int b = 0; b < 2; ++b)
#pragma unroll
            for (int m = 0; m < 4; ++m)
#pragma unroll
                for (int n = 0; n < 2; ++n) acc[a][b][m][n] = (f32x4){0.f, 0.f, 0.f, 0.f};
    bf16x8 At[4][2], B0[2][2], B1[2][2];
    unsigned vA[2][2], vAn[2][2];
    const char* cA = Abase;
    if constexpr (GATHER) { PG8_CALCA(cur, vA); } else { cA = Abase + (size_t)S.arow(cur, 0) * lda + S.acolb(cur); }
    const char* cB = cur.bptr;
    PG8_STAGE(PG8_SB(0, 0), cB, voffB); PG8_STAGE(PG8_SB(0, 1), cB + hstepB, voffB); PG8_STAGEA(PG8_SA(0, 0), cA, 0); PG8_STAGEA(PG8_SA(0, 1), cA, 1);
    if (wr == 1) PG8_BAR;
    PG8_WAIT_V(2); PG8_BAR;
    PG8_STAGE(PG8_SB(1, 0), cB + kstep, voffB); PG8_STAGEA(PG8_SA(1, 0), cA + kstepA, 0); PG8_STAGE(PG8_SB(1, 1), cB + hstepB + kstep, voffB);
    PG8_WAIT_V(6); PG8_BAR;
    for (;;) {
        const bool has_next = S.next(ui + 1, nxt);
        float rs[2][4];
        if constexpr (Epi::ROWSCALE) {
#pragma unroll
            for (int ai = 0; ai < 2; ++ai)
#pragma unroll
                for (int m = 0; m < 4; ++m) rs[ai][m] = S.rowscale(cur, ai * HALF + wr * 64 + m * 16 + fr);
        }
        const char* nA = cA;
        if constexpr (GATHER) {
            if (has_next) { PG8_CALCA(nxt, vAn); }
            else {
#pragma unroll
                for (int h = 0; h < 2; ++h)
#pragma unroll
                    for (int i = 0; i < 2; ++i) vAn[h][i] = vA[h][i];
            }
            asm volatile("s_waitcnt vmcnt(0)" : "+v"(vAn[0][0]), "+v"(vAn[0][1]), "+v"(vAn[1][0]), "+v"(vAn[1][1]) :: "memory");
            if constexpr (Epi::ROWSCALE) { asm volatile("" : "+v"(rs[0][0]), "+v"(rs[0][1]), "+v"(rs[0][2]), "+v"(rs[0][3]), "+v"(rs[1][0]), "+v"(rs[1][1]), "+v"(rs[1][2]), "+v"(rs[1][3])); }
        } else { if (has_next) nA = Abase + (size_t)S.arow(nxt, 0) * lda + S.acolb(nxt); }
        const char* nB = has_next ? nxt.bptr : cB;
#pragma unroll 1
        for (int t = 0; t < nt; t += 2) {
            const bool last = (t == nt - 2);
            const char* a1 = cA + (size_t)(t + 1) * kstepA;
            const char* a2 = last ? nA : cA + (size_t)(t + 2) * kstepA; const char* b2 = last ? nB : cB + (size_t)(t + 2) * kstep;
            const char* a3 = a2 + kstepA; const char* b3 = b2 + kstep;
            PG8_LDB(B0, 0, 0); PG8_LDB(B1, 0, 1); PG8_SCHED; PG8_LDA(At, 0, 0); PG8_STAGEA(PG8_SA(1, 1), a1, 1);
            if constexpr (GATHER) { if (last) {
#pragma unroll
                for (int h = 0; h < 2; ++h)
#pragma unroll
                    for (int i = 0; i < 2; ++i) vA[h][i] = vAn[h][i]; } }
            PG8_WAIT_V(8); PG8_WAIT_L(0); PG8_BAR; PG8_MMA(0, 0, At, B0); PG8_MMA(0, 1, At, B1); PG8_BAR; PG8_SCHED;
            PG8_LDA(At, 0, 1); PG8_STAGE(PG8_SB(0, 0), b2, voffB); PG8_STAGE(PG8_SB(0, 1), b2 + hstepB, voffB); PG8_STAGEA(PG8_SA(0, 0), a2, 0);
            PG8_WAIT_V(8); PG8_WAIT_L(0); PG8_BAR; PG8_MMA(1, 0, At, B0); PG8_MMA(1, 1, At, B1); PG8_BAR; PG8_SCHED;
            PG8_LDB(B0, 1, 0); PG8_LDB(B1, 1, 1); PG8_SCHED; PG8_LDA(At, 1, 0); PG8_STAGEA(PG8_SA(0, 1), a2, 1);
            PG8_WAIT_V(8); PG8_WAIT_L(0); PG8_BAR; PG8_MMA(0, 0, At, B0); PG8_MMA(0, 1, At, B1); PG8_BAR; PG8_SCHED;
            PG8_LDA(At, 1, 1); PG8_STAGE(PG8_SB(1, 0), b3, voffB); PG8_STAGE(PG8_SB(1, 1), b3 + hstepB, voffB); PG8_STAGEA(PG8_SA(1, 0), a3, 0);
            PG8_WAIT_V(8); PG8_WAIT_L(0); PG8_BAR; PG8_MMA(1, 0, At, B0); PG8_MMA(1, 1, At, B1); PG8_BAR; PG8_SCHED;
        }
        if (wr == 0) PG8_BAR;
        E(acc, cur, rs, wr, wc, fr, fq);
        if (!has_next) break;
#pragma unroll
        for (int a = 0; a < 2; ++a)
#pragma unroll
            for (int b = 0; b < 2; ++b)
#pragma unroll
                for (int m = 0; m < 4; ++m)
#pragma unroll
                    for (int n = 0; n < 2; ++n) acc[a][b][m][n] = (f32x4){0.f, 0.f, 0.f, 0.f};
        cur = nxt; cB = nB; cA = nA; ++ui;
        if (wr == 1) PG8_BAR;
    }
    PG8_WAIT_V(0);
    PG8_BAR;
#undef PG8_SA
#undef PG8_SB
#undef PG8_STAGE
#undef PG8_STAGEA
#undef PG8_LDA
#undef PG8_LDB
#undef PG8_MMA
#undef PG8_WAIT_V
#undef PG8_WAIT_L
#undef PG8_BAR
#undef PG8_SCHED
#undef PG8_CALCA
}

struct EpiStore {
    static constexpr bool ROWSCALE = false, WIDE = true;
    bf16* O; int ldc; const float* cscale; int qmode; int ntst; int f16; LAS unsigned char* tb;
    __device__ __forceinline__ void operator()(const f32x4 (&acc)[2][2][4][2], const Unit& u, const float (&rs)[2][4], int wr, int wc, int fr, int fq) const {
        const int colw = u.pn * BM + wc * 64;
        float sc = 1.f; if (qmode) { if ((((u.pn * BM) >> 10) % 3) == 0) sc = QSCALE; }
        f32x4 cs[2][2];
#pragma unroll
        for (int bj = 0; bj < 2; ++bj)
#pragma unroll
            for (int n = 0; n < 2; ++n) { cs[bj][n] = cscale ? *(const f32x4*)(cscale + colw + 32 * bj + 8 * fq + 4 * n) : (f32x4){1.f, 1.f, 1.f, 1.f}; cs[bj][n] = cs[bj][n] * sc; }
        const int L = fr + 16 * fq, rr = L >> 3, sg = L & 7;
        LAS u32x4* tbv = (LAS u32x4*)tb;
        const int wi0 = fr * 8 + (fq ^ (fr & 7)), wi1 = fr * 8 + ((4 + fq) ^ (fr & 7)), ri = rr * 8 + (sg ^ rr);
        bf16* gp = O + (size_t)(u.pm * BM + wr * 64 + rr) * ldc + colw + sg * 8;
#pragma unroll
        for (int ai = 0; ai < 2; ++ai)
#pragma unroll
            for (int m = 0; m < 4; ++m) {
                u32x4 w[2];
#pragma unroll
                for (int bj = 0; bj < 2; ++bj) { const f32x4 v0 = acc[ai][bj][m][0] * cs[bj][0], v1 = acc[ai][bj][m][1] * cs[bj][1];
                    if (f16) { w[bj].x = pkh2(v0[0], v0[1]); w[bj].y = pkh2(v0[2], v0[3]); w[bj].z = pkh2(v1[0], v1[1]); w[bj].w = pkh2(v1[2], v1[3]); }
                    else { w[bj].x = cvt_pk_bf16(v0[0], v0[1]); w[bj].y = cvt_pk_bf16(v0[2], v0[3]); w[bj].z = cvt_pk_bf16(v1[0], v1[1]); w[bj].w = cvt_pk_bf16(v1[2], v1[3]); } }
                tbv[wi0] = w[0]; tbv[wi1] = w[1];
                asm volatile("" ::: "memory");
                const u32x4 r0 = tbv[ri], r1 = tbv[ri + 64];
                asm volatile("" ::: "memory");
                bf16* rowp = gp + (size_t)(ai * HALF + m * 16) * ldc;
                if (ntst) { __builtin_nontemporal_store(r0, (u32x4*)rowp); __builtin_nontemporal_store(r1, (u32x4*)(rowp + (size_t)8 * ldc)); }
                else { *(u32x4*)rowp = r0; *(u32x4*)(rowp + (size_t)8 * ldc) = r1; } }
    }
};
typedef unsigned u32x2_t __attribute__((ext_vector_type(2)));
struct EpiStoreF8 {
    static constexpr bool ROWSCALE = false, WIDE = true;
    unsigned char* O; int ldc; LAS unsigned char* tb; int qmode;
    __device__ __forceinline__ void operator()(const f32x4 (&acc)[2][2][4][2], const Unit& u, const float (&rs)[2][4], int wr, int wc, int fr, int fq) const {
        const int colw = u.pn * BM + wc * 64;
        const float osc = qmode ? (((((u.pn * BM) >> 10) % 3) == 0) ? QSCALE * 64.0f : 16.0f) : 32.0f;
        const int L = fr + 16 * fq, rr = L >> 2, sg = L & 3;
        LAS unsigned char* wp0 = tb + fr * 64 + ((fq) ^ (fr & 7)) * 8; LAS unsigned char* wp1 = tb + fr * 64 + ((4 + fq) ^ (fr & 7)) * 8;
        const LAS unsigned char* rp0 = tb + rr * 64 + ((2 * sg) ^ (rr & 7)) * 8; const LAS unsigned char* rp1 = tb + rr * 64 + ((2 * sg + 1) ^ (rr & 7)) * 8;
        unsigned char* gp = O + (size_t)(u.pm * BM + wr * 64 + rr) * ldc + colw + sg * 16;
#pragma unroll
        for (int ai = 0; ai < 2; ++ai)
#pragma unroll
            for (int m = 0; m < 4; ++m) {
                u32x2_t w[2];
#pragma unroll
                for (int bj = 0; bj < 2; ++bj) { f32x4 v0 = acc[ai][bj][m][0] * osc, v1 = acc[ai][bj][m][1] * osc;
#pragma unroll
                    for (int e = 0; e < 4; ++e) { v0[e] = __builtin_amdgcn_fmed3f(v0[e], -448.0f, 448.0f); v1[e] = __builtin_amdgcn_fmed3f(v1[e], -448.0f, 448.0f); }
                    int p0 = __builtin_amdgcn_cvt_pk_fp8_f32(v0[0], v0[1], 0, false); p0 = __builtin_amdgcn_cvt_pk_fp8_f32(v0[2], v0[3], p0, true);
                    int p1 = __builtin_amdgcn_cvt_pk_fp8_f32(v1[0], v1[1], 0, false); p1 = __builtin_amdgcn_cvt_pk_fp8_f32(v1[2], v1[3], p1, true);
                    w[bj].x = (unsigned)p0; w[bj].y = (unsigned)p1; }
                *(LAS u32x2_t*)wp0 = w[0]; *(LAS u32x2_t*)wp1 = w[1];
                asm volatile("" ::: "memory");
                const u32x2_t a = *(const LAS u32x2_t*)rp0, b = *(const LAS u32x2_t*)rp1;
                asm volatile("" ::: "memory");
                u32x4 o; o.x = a.x; o.y = a.y; o.z = b.x; o.w = b.y;
                __builtin_nontemporal_store(o, (GAS u32x4*)(gp + (size_t)(ai * HALF + m * 16) * ldc)); }
    }
};
struct EpiGU {
    static constexpr bool ROWSCALE = false, WIDE = false;
    bf16* O;
    __device__ __forceinline__ void operator()(const f32x4 (&acc)[2][2][4][2], const Unit& u, const float (&rs)[2][4], int wr, int wc, int fr, int fq) const {
        bf16* tp = O + (size_t)u.pm * (BM * DEXP) + (size_t)(u.pn * 4 + wc) * (BM * 32) + (wr * 64 + fr) * 32 + 8 * fq;
#pragma unroll
        for (int ai = 0; ai < 2; ++ai)
#pragma unroll
            for (int m = 0; m < 4; ++m) { bf16* rowp = tp + (ai * HALF + m * 16) * 32;
                float o[8];
#pragma unroll
                for (int n = 0; n < 2; ++n)
#pragma unroll
                    for (int j = 0; j < 4; ++j) { const float g = acc[ai][0][m][n][j], uu = acc[ai][1][m][n][j];
                        const float sg = g * __builtin_amdgcn_rcpf(1.0f + __builtin_amdgcn_exp2f(-g * LOG2E)); o[n * 4 + j] = sg * uu; }
                u32x4 wv; wv.x = cvt_pk_bf16(o[0], o[1]); wv.y = cvt_pk_bf16(o[2], o[3]); wv.z = cvt_pk_bf16(o[4], o[5]); wv.w = cvt_pk_bf16(o[6], o[7]);
                *(u32x4*)rowp = wv; }
    }
};
}

#define XB_TMO      128
#define XB_XCNT(j)  (256  + 64 * (j))
#define XB_XSUB(j)  (1280 + 64 * (j))
#define XB_XGEN(j)  (2304 + 64 * (j))
#define XB_TOP      3328
#define XB_TOPGEN   3392
#define XB_LSUB(j)  (3456 + 64 * (j))
#define XB_LGEN(j)  (4480 + 64 * (j))
#define XCD_BAR_WORDS 5504
#define XB_SPIN_CAP (1u << 18)
__device__ __forceinline__ unsigned xb_ld(unsigned* p)              { return __hip_atomic_load(p, __ATOMIC_RELAXED, __HIP_MEMORY_SCOPE_AGENT); }
__device__ __forceinline__ unsigned xb_add(unsigned* p, unsigned v) { return __hip_atomic_fetch_add(p, v, __ATOMIC_RELAXED, __HIP_MEMORY_SCOPE_AGENT); }
__device__ __forceinline__ unsigned xb_xcc_id() { return (unsigned)__builtin_amdgcn_s_getreg((3 << 11) | 20) & 0xFu; }
#define XB_SPIN(cond, bar) do { unsigned _sp = 0; while (cond) { __builtin_amdgcn_s_sleep(1); \
    if ((++_sp & 255u) == 0u) { if (xb_ld(&(bar)[XB_TMO])) break; if (_sp > XB_SPIN_CAP) { atomicAdd(&(bar)[XB_TMO], 1u); break; } } } } while (0)
struct XcdBarrier { unsigned* bar; unsigned x; volatile LAS unsigned* st; };
__device__ __forceinline__ XcdBarrier xcd_barrier_post(unsigned* bar, volatile LAS unsigned* st) {
    XcdBarrier b; b.bar = bar; b.x = xb_xcc_id(); b.st = st;
    if (threadIdx.x == 0) st[2] = xb_add(&bar[XB_XCNT(b.x)], 1u);
    return b;
}
__device__ __forceinline__ void xcd_local_barrier(const XcdBarrier& b, const bool wave0) {
    asm volatile("s_waitcnt vmcnt(0)" ::: "memory");
    __syncthreads();
    if (wave0 && __builtin_amdgcn_mbcnt_hi(~0u, __builtin_amdgcn_mbcnt_lo(~0u, 0u)) == 0u) {
        unsigned* bar = b.bar;
        __builtin_amdgcn_s_waitcnt(0);
        const unsigned nloc = b.st[0];
        const unsigned old = xb_add(&bar[XB_LSUB(b.x)], 1u);
        const unsigned gen = old / nloc;
        if (old + 1u == (gen + 1u) * nloc) xb_add(&bar[XB_LGEN(b.x)], 1u);
        else XB_SPIN(xb_ld(&bar[XB_LGEN(b.x)]) == gen, bar);
        __builtin_amdgcn_fence(__ATOMIC_ACQUIRE, "agent");
        asm volatile("s_waitcnt vmcnt(0)" ::: "memory");
    }
    __syncthreads();
}
__device__ __forceinline__ void xcd_barrier_complete(unsigned* bar, unsigned x, unsigned& nloc, unsigned& nx) {
    const unsigned G = gridDim.x * gridDim.y * gridDim.z;
    unsigned sum, cnt, mine, sp = 0u;
    for (;;) {
        sum = 0u; cnt = 0u; mine = 0u;
#pragma unroll
        for (unsigned j = 0; j < 16; ++j) { const unsigned c = xb_ld(&bar[XB_XCNT(j)]); sum += c; cnt += (c > 0u) ? 1u : 0u; mine = (j == x) ? c : mine; }
        if (sum == G) break;
        __builtin_amdgcn_s_sleep(1);
        if ((++sp & 255u) == 0u) { if (xb_ld(&bar[XB_TMO])) break; if (sp > XB_SPIN_CAP) { atomicAdd(&bar[XB_TMO], 1u); break; } }
    }
    nloc = mine > 0u ? mine : 1u; nx = cnt > 0u ? cnt : 1u;
}
__device__ __forceinline__ void xcd_barrier(const XcdBarrier& b) {
    asm volatile("s_waitcnt vmcnt(0)" ::: "memory");
    __syncthreads();
    if (threadIdx.x == 0) {
        unsigned* bar = b.bar;
        __builtin_amdgcn_s_waitcnt(0);
        unsigned nloc = b.st[0], nx = b.st[1];
        if (nloc == 0u) { xcd_barrier_complete(bar, b.x, nloc, nx); b.st[0] = nloc; b.st[1] = nx; }
        const unsigned old = xb_add(&bar[XB_XSUB(b.x)], 1u);
        const unsigned gen = old / nloc;
        if (old + 1u == (gen + 1u) * nloc) {
            __builtin_amdgcn_fence(__ATOMIC_RELEASE, "agent");
            asm volatile("s_waitcnt vmcnt(0)" ::: "memory");
            const unsigned og = xb_add(&bar[XB_TOP], 1u);
            const unsigned tg = og / nx;
            if (og + 1u == (tg + 1u) * nx) xb_add(&bar[XB_TOPGEN], 1u);
            else XB_SPIN(xb_ld(&bar[XB_TOPGEN]) == tg, bar);
            __builtin_amdgcn_fence(__ATOMIC_ACQUIRE, "agent");
            xb_add(&bar[XB_XGEN(b.x)], 1u);
            asm volatile("s_waitcnt vmcnt(0)" ::: "memory");
        } else {
            XB_SPIN(xb_ld(&bar[XB_XGEN(b.x)]) == gen, bar);
            __builtin_amdgcn_fence(__ATOMIC_ACQUIRE, "agent");
            asm volatile("s_waitcnt vmcnt(0)" ::: "memory");
        }
    }
    __syncthreads();
}

constexpr int NWAVES = 8;
struct Frame {
    LAS unsigned char* lds;
    LAS unsigned char* lc;
    unsigned* ctl;
    unsigned char* ws;
    int tid, lane, wave, vcu, G;
};
constexpr int LC_PTR = 2048;
__device__ __forceinline__ const float* inp(const Frame& F, int i) {
    const unsigned long long v = *(const LAS unsigned long long*)(F.lc + LC_PTR + 8 * i);
    const unsigned lo = __builtin_amdgcn_readfirstlane((unsigned)v), hi = __builtin_amdgcn_readfirstlane((unsigned)(v >> 32));
    return (const float*)(const GAS float*)(((unsigned long long)hi << 32) | lo);
}
__device__ __forceinline__ unsigned char* opq(unsigned char* p) { GAS unsigned char* g = (GAS unsigned char*)p; asm volatile("" : "+s"(g)); return (unsigned char*)g; }
__device__ __forceinline__ void refresh(Frame& F) { asm volatile("" : "+v"(F.tid)); F.lane = F.tid & 63; F.wave = __builtin_amdgcn_readfirstlane(F.tid >> 6); }

struct PlainSched {   static constexpr bool GATHER = false, ABLK = false;
    int nM, nN, nwg, G, c; const char* B; int ldb;
    __device__ __forceinline__ bool next(int i, pg8::Unit& u) const {
        const int L = i * G + c; if (L >= nwg) return false;
        const int wgid = pg8::xcd_chunk(L, nwg);
        const int nig = 8 * nN, gid = wgid / nig, fm = gid * 8, gsz = (nM - fm) < 8 ? (nM - fm) : 8;
        u.pm = fm + ((wgid % nig) % gsz); u.pn = (wgid % nig) / gsz;
        u.bptr = B + (size_t)u.pn * 256 * ldb; u.roff = -(u.pm * 256) - 1; u.nvalid = 256; return true;
    }
    __device__ __forceinline__ int arow(const pg8::Unit& u, int r) const { return -u.roff - 1 + r; }
    __device__ __forceinline__ int acolb(const pg8::Unit&) const { return 0; }
    __device__ __forceinline__ float rowscale(const pg8::Unit&, int) const { return 1.0f; }
};
struct GrpSched {     static constexpr bool GATHER = false, ABLK = false;
    int G, c; const char* B;
    __device__ __forceinline__ bool next(int i, pg8::Unit& u) const {
        const int L = i * G + c; if (L >= 256) return false;
        const int wgid = pg8::xcd_chunk(L, 256);
        u.pm = wgid >> 2; u.pn = wgid & 3; u.bptr = B + (size_t)u.pn * 256 * 512; u.roff = -(u.pm * 256) - 1; u.nvalid = 256; return true;
    }
    __device__ __forceinline__ int arow(const pg8::Unit& u, int r) const { return -u.roff - 1 + r; }
    __device__ __forceinline__ int acolb(const pg8::Unit& u) const { return u.pn * 512; }
    __device__ __forceinline__ float rowscale(const pg8::Unit&, int) const { return 1.0f; }
};
template <bool GATHER_> struct MoeSched {     static constexpr bool GATHER = GATHER_, ABLK = !GATHER_;
    const LAS int* ts; const LAS int* cn; int npn, nunits, G, c, lane_;
    const int* tokl; const float* wl; const char* Bexp; size_t bstride; const char* Bsh; int ldb;
    __device__ __forceinline__ bool next(int i, pg8::Unit& u) const {
        const int L = i * G + c; const int xg = L % pg8::NXCD, off = L / pg8::NXCD;
        const int ntile = nunits / npn, tq = ntile / pg8::NXCD, tr = ntile % pg8::NXCD;
        const int tcnt = tq + (xg < tr ? 1 : 0), tstart = xg * tq + (xg < tr ? xg : tr);
        if (off >= tcnt * npn) return false;
        const int tile = tstart + off / npn, pn = off % npn;
        const int lane = lane_;
        const bool hit = (tile >= ts[lane]) && (tile < ts[lane + 1]);
        const unsigned long long mk = __ballot(hit);
        const int e = mk ? (int)__builtin_ctzll(mk) : 64;
        const int tse = __builtin_amdgcn_readfirstlane(ts[e]);
        const int r0 = (tile - tse) * 256;
        u.pm = tile; u.pn = pn;
        u.bptr = (e < 64 ? Bexp + (size_t)e * bstride : Bsh) + (size_t)pn * 256 * ldb;
        if (GATHER) {
            if (e < 64) { const int ce = __builtin_amdgcn_readfirstlane(cn[e]); u.roff = e * CAP + r0; u.nvalid = (ce - r0) < 256 ? (ce - r0) : 256; }
            else { u.roff = -r0 - 1; u.nvalid = 256; }
        } else { u.roff = -(tile * 256) - 1; u.nvalid = 256; }
        return true;
    }
    __device__ __forceinline__ int arow(const pg8::Unit& u, int r) const { if (GATHER && u.roff >= 0) { const int rr = r < u.nvalid ? r : u.nvalid - 1; return tokl[u.roff + rr]; } return -u.roff - 1 + r; }
    __device__ __forceinline__ int acolb(const pg8::Unit&) const { return 0; }
    __device__ __forceinline__ float rowscale(const pg8::Unit& u, int r) const { if (GATHER && u.roff >= 0) { const int rr = r < u.nvalid ? r : u.nvalid - 1; return wl[u.roff + rr]; } return 1.0f; }
};

__device__ __forceinline__ void p0_transpose_item64(const float* W, int K, int N, bf16* WT, int dst_n0, LAS float* scr, int kb, int nb, int lane) {
    const int k0 = 64 * kb, n0 = 64 * nb; const int r = lane >> 4, c4 = lane & 15;
    f32x4 v[16];
#pragma unroll
    for (int i = 0; i < 16; ++i) v[i] = *(const GAS f32x4*)(W + (size_t)(k0 + 4 * i + r) * N + n0 + 4 * c4);
#pragma unroll
    for (int i = 0; i < 16; ++i) { const int k = 4 * i + r; *(LAS f32x4*)(scr + k * 64 + 4 * (c4 ^ (k >> 3))) = v[i]; }
    LDS_WAIT(); asm volatile("" ::: "memory");
    const int c = lane & 7;
#pragma unroll
    for (int j = 0; j < 8; ++j) { const int n = (lane >> 3) + 8 * j; const LAS float* sp = scr + (8 * c) * 64 + 4 * ((n >> 2) ^ c) + (n & 3);
        u32x4 o; o.x = pk2(sp[0 * 64], sp[1 * 64]); o.y = pk2(sp[2 * 64], sp[3 * 64]); o.z = pk2(sp[4 * 64], sp[5 * 64]); o.w = pk2(sp[6 * 64], sp[7 * 64]);
        *(GAS u32x4*)(WT + (size_t)(dst_n0 + n) * K + k0 + 8 * c) = o; }
    LDS_WAIT(); asm volatile("" ::: "memory");
}
__device__ __forceinline__ void p0_router_item(const float* W, bf16* WH, bf16* WLo, LAS float* scr, int kb, int nb, int lane) {
    const int K = 1024, N = 64; const int k0 = 64 * kb, n0 = 32 * nb;
#pragma unroll 8
    for (int i = 0; i < 32; ++i) { const int kk = 2 * i + (lane >> 5); scr[kk * 33 + (lane & 31)] = W[(size_t)(k0 + kk) * N + n0 + (lane & 31)]; }
    LDS_WAIT(); asm volatile("" ::: "memory");
    const int c = lane & 7;
#pragma unroll
    for (int j = 0; j < 4; ++j) { const int n = (lane >> 3) + 8 * j; const LAS float* s = scr + (8 * c) * 33 + n;
        unsigned h[8], l[8];
#pragma unroll
        for (int q = 0; q < 8; ++q) { const float v = s[q * 33]; h[q] = f2bf(v); l[q] = f2bf(v - bf2f(h[q])); }
        u32x4 oh, ol; oh.x = h[0] | (h[1] << 16); oh.y = h[2] | (h[3] << 16); oh.z = h[4] | (h[5] << 16); oh.w = h[6] | (h[7] << 16);
        ol.x = l[0] | (l[1] << 16); ol.y = l[2] | (l[3] << 16); ol.z = l[4] | (l[5] << 16); ol.w = l[6] | (l[7] << 16);
        *(GAS u32x4*)(WH + (size_t)(n0 + n) * K + k0 + 8 * c) = oh; *(GAS u32x4*)(WLo + (size_t)(n0 + n) * K + k0 + 8 * c) = ol; }
    LDS_WAIT(); asm volatile("" ::: "memory");
}

__device__ __forceinline__ void p0_prologue(Frame& F) {
    LAS float* cs = (LAS float*)(F.lds);
    LAS float* part = (LAS float*)(F.lds + 32768);
    const float* c = inp(F, 1);
    for (int i = F.tid; i < 8 * 1024; i += 512) { const float v = c[i]; cs[i] = v / (1.0f + __expf(-v)); }
    __syncthreads();
    float* mod = (float*)(F.ws + WS_MOD);
    for (int it = F.vcu; it < 4 * 96; it += F.G) {
        const int layer = it / 96, slab = it % 96; const int col = slab * 64 + F.lane;
        const float* W = inp(F, 2) + (size_t)layer * 1024 * 6144 + col;
        float a[8];
#pragma unroll
        for (int b = 0; b < 8; ++b) a[b] = 0.f;
        const int k0 = F.wave * 128;
#pragma unroll 4
        for (int k = 0; k < 128; k += 4) {
            float w[4];
#pragma unroll
            for (int j = 0; j < 4; ++j) w[j] = W[(size_t)(k0 + k + j) * 6144];
#pragma unroll
            for (int b = 0; b < 8; ++b) { const f32x4 cv = *(const LAS f32x4*)(cs + b * 1024 + k0 + k); a[b] += cv[0] * w[0] + cv[1] * w[1] + cv[2] * w[2] + cv[3] * w[3]; }
        }
#pragma unroll
        for (int b = 0; b < 8; ++b) part[(F.wave * 8 + b) * 64 + F.lane] = a[b];
        __syncthreads();
        { const int b = F.wave; float s = 0.f;
#pragma unroll
          for (int w = 0; w < 8; ++w) s += part[(w * 8 + b) * 64 + F.lane];
          mod[((size_t)layer * 8 + b) * 6144 + col] = s + inp(F, 3)[layer * 6144 + col]; }
        __syncthreads();
    }
    __syncthreads();
    LAS float* scr = (LAS float*)(F.lds + F.wave * 16384);
    const int gw = F.vcu * NWAVES + F.wave, NGW = F.G * NWAVES;
    constexpr int I_PIN = 2 * 16 * 16, I_GRP = 8 * 4 * 4, I_POUT = I_PIN, I_AIN = 2 * 16 * 144, I_AOUT = I_PIN, I_SHGU = 4 * 16 * 8, I_SHDN = 4 * 4 * 16, I_R = 4 * 16 * 2;
    constexpr int I_EGU = 256 * 16 * 8, I_EDN = 256 * 4 * 16;
    constexpr int NITEMS = I_PIN + I_GRP + I_POUT + I_AIN + I_AOUT + I_SHGU + I_SHDN + I_R + I_EGU + I_EDN;
    for (int it = gw; it < NITEMS; it += NGW) {
        int r = it;
#define P0_GROUP(CNT, SRC, KK, NN, DST, GU) if (r < (CNT)) { const int per = ((KK) / 64) * ((NN) / 64), mat = r / per, q = r % per, nblk = (NN) / 64, kblk = (KK) / 64, nb = q / kblk, kb = q % kblk; (void)nblk; \
            int dn0 = 64 * nb; if (GU) { const int n0 = 64 * nb; dn0 = (n0 < 256) ? ((n0 >> 7) * 256 + (n0 & 127)) : (((n0 - 256) >> 7) * 256 + 128 + ((n0 - 256) & 127)); } \
            p0_transpose_item64((SRC) + (size_t)mat * (KK) * (NN), (KK), (NN), (bf16*)(F.ws + (DST)) + (size_t)mat * (KK) * (NN), dn0, scr, kb, nb, F.lane); continue; } r -= (CNT);
        P0_GROUP(I_PIN, inp(F, 4), 1024, 1024, WS_WPIN, 0)
        P0_GROUP(I_GRP, inp(F, 5), 256, 256, WS_WPGRP, 0)
        P0_GROUP(I_POUT, inp(F, 7), 1024, 1024, WS_WPOUT, 0)
        P0_GROUP(I_AIN, inp(F, 8), 1024, 9216, WS_WAIN, 0)
        P0_GROUP(I_AOUT, inp(F, 9), 1024, 1024, WS_WAOUT, 0)
        P0_GROUP(I_SHGU, inp(F, 16), 1024, 512, WS_WSHGU, 1)
        P0_GROUP(I_SHDN, inp(F, 17), 256, 1024, WS_WSHDN, 0)
        if (r < I_R) { const int mat = r / 32, q = r % 32, kb = q / 2, nb = q % 2;
            p0_router_item(inp(F, 12) + (size_t)mat * 65536, (bf16*)(F.ws + WS_WRHI) + (size_t)mat * 65536, (bf16*)(F.ws + WS_WRLO) + (size_t)mat * 65536, scr, kb, nb, F.lane); continue; } r -= I_R;
        P0_GROUP(I_EGU, inp(F, 14), 1024, 512, WS_WEGU, 1)
        P0_GROUP(I_EDN, inp(F, 15), 256, 1024, WS_WEDN, 0)
#undef P0_GROUP
    }
}

__device__ __forceinline__ void p1_modulate(Frame& F, const float* x, const float* modl  , int sh_off, int sc_off) {
    bf16* H = (bf16*)(F.ws + WS_H);
    const int gw = F.vcu * NWAVES + F.wave, NGW = F.G * NWAVES;
    for (int m = gw; m < T; m += NGW) {
        const int b = m / SEQ; const float* mb = modl + (size_t)b * 6144;
        const GAS f32x4* xr = (const GAS f32x4*)(x + (size_t)m * D) + F.lane;
        GAS u32x2* o8 = (GAS u32x2*)(H + (size_t)m * D) + F.lane;
#pragma unroll
        for (int j = 0; j < 4; ++j) { const f32x4 v = xr[64 * j]; const f32x4 sc = *(const f32x4*)(mb + sc_off + 4 * F.lane + 256 * j), sh = *(const f32x4*)(mb + sh_off + 4 * F.lane + 256 * j);
            const f32x4 h = v * (sc + 1.0f) + sh; u32x2 w; w.x = pk2(h[0], h[1]); w.y = pk2(h[2], h[3]); o8[64 * j] = w; }
    }
}

template <int W>
__device__ __forceinline__ void pool_item(const bf16* U, bf16* Z, int b, int t0, int g, int lane) {
    const size_t base = (size_t)b * SEQ * D + 256 * g + 4 * lane;
    float s[4] = {0.f, 0.f, 0.f, 0.f};
#pragma unroll
    for (int j = 1; j <= W; ++j) { const int t = t0 - j; if (t >= 0) { const u32x2 v = *(const GAS u32x2*)(U + base + (size_t)t * D);
            s[0] += bf2f(v.x & 0xffffu); s[1] += bf2f(v.x >> 16); s[2] += bf2f(v.y & 0xffffu); s[3] += bf2f(v.y >> 16); } }
#pragma unroll 8
    for (int i = 0; i < 32; ++i) { const int t = t0 + i;
        const u32x2 v = *(const GAS u32x2*)(U + base + (size_t)t * D);
        const float c0 = bf2f(v.x & 0xffffu), c1 = bf2f(v.x >> 16), c2 = bf2f(v.y & 0xffffu), c3 = bf2f(v.y >> 16);
        s[0] += c0; s[1] += c1; s[2] += c2; s[3] += c3;
        if (t - W >= 0) { const u32x2 o = *(const GAS u32x2*)(U + base + (size_t)(t - W) * D);
            s[0] -= bf2f(o.x & 0xffffu); s[1] -= bf2f(o.x >> 16); s[2] -= bf2f(o.y & 0xffffu); s[3] -= bf2f(o.y >> 16); }
        const float inv = 1.0f / (float)((t + 1) < W ? (t + 1) : W);
        u32x2 w; w.x = pk2(s[0] * inv - c0, s[1] * inv - c1); w.y = pk2(s[2] * inv - c2, s[3] * inv - c3);
        *(GAS u32x2*)(Z + base + (size_t)t * D) = w; }
}

__device__ __forceinline__ void moe_build_table(Frame& F, int layer) {
    LAS int* ts = (LAS int*)(F.lc + LC_TS); LAS int* cn = (LAS int*)(F.lc + LC_CNT);
    __syncthreads();
    if (F.wave == 0) {
        const int c = (int)__hip_atomic_load(F.ctl + CW_CNT + layer * 64 + F.lane, RLX_AGENT);
        int t = (c + 255) >> 8;
#pragma unroll
        for (int o = 1; o < 64; o <<= 1) { const int v = __shfl_up(t, o); if (F.lane >= o) t += v; }
        cn[F.lane] = c; ts[F.lane + 1] = t;
        if (F.lane == 0) ts[0] = 0;
        if (F.lane == 63) ts[65] = t + 64;
    }
    __syncthreads();
}

#ifdef PROBE_TYPE
#define LSTAMP(ty) do { if (blockIdx.x == 0 && F.tid == 0) { const unsigned long long now_ = __builtin_amdgcn_s_memrealtime(); LAS unsigned long long* st_ = (LAS unsigned long long*)(F.lc + 3072); \
        st_[1 + (ty)] += now_ - st_[20]; st_[20] = now_; } } while (0)
#define LSTAMP0() do { if (blockIdx.x == 0 && F.tid == 0) { ((LAS unsigned long long*)(F.lc + 3072))[20] = __builtin_amdgcn_s_memrealtime(); } } while (0)
#else
#define LSTAMP(ty) do { } while (0)
#define LSTAMP0() do { } while (0)
#endif
constexpr int APITCH = 1032;
#define LDS_ONLY_BARRIER() do { asm volatile("s_waitcnt lgkmcnt(0)" ::: "memory"); __builtin_amdgcn_s_barrier(); asm volatile("" ::: "memory"); } while (0)
template <bool X16>
__device__ __forceinline__ void ln1_router_phase(Frame& F, int layer, const float* xin) {
    bf16* X = (bf16*)(F.ws + WS_X);
    bf16* H = (bf16*)(F.ws + WS_H); const bf16* Y = (const bf16*)(F.ws + WS_Y);
    const float* modl = (const float*)(F.ws + WS_MOD) + (size_t)layer * 8 * 6144;
    const float* lg = inp(F, 10) + layer * D; const float* lb = inp(F, 11) + layer * D;
    const float* rb = inp(F, 13) + layer * NE;
    const bf16* WH = (const bf16*)(F.ws + WS_WRHI) + (size_t)layer * 65536; const bf16* WLo = (const bf16*)(F.ws + WS_WRLO) + (size_t)layer * 65536;
    int* tokl = (int*)(F.ws + WS_TOKL); float* wl = (float*)(F.ws + WS_WL); int* tslot = (int*)(F.ws + WS_TSLOT);
    unsigned* gcnt = F.ctl + CW_CNT + layer * 64;
    LAS bf16* Ahi = (LAS bf16*)F.lds; LAS bf16* Alo = Ahi + 32 * APITCH;
    LAS float* PART = (LAS float*)F.lds;
    LAS float* PV = (LAS float*)(F.lds + LDS_TB_OFF);
    LAS int* lcnt = (LAS int*)(F.lc + LC_LCNT); LAS int* gb = (LAS int*)(F.lc + LC_GB);
    const int lane = F.lane, wave = F.wave;
    const int nblk = (T / 32) / F.G;
#define LN1_BLK(bi_) ((F.G == 256) ? ((F.vcu >> 5) * 64 + (F.vcu & 31) * 2 + (bi_)) : (F.vcu + (bi_) * F.G))
    constexpr int NX = X16 ? 2 : 4;
    u32x4 xr[4][NX], yv[4][2];
#define LN1_LOAD(bi_) do { const int t0_ = LN1_BLK(bi_) * 32 + wave * 4; \
        _Pragma("unroll") for (int q = 0; q < 4; ++q) _Pragma("unroll") for (int j = 0; j < 2; ++j) { const size_t o_ = (size_t)(t0_ + q) * D + 8 * lane + 512 * j; \
            if constexpr (X16) xr[q][j] = __builtin_nontemporal_load((const GAS u32x4*)((const bf16*)xin + o_)); \
            else { xr[q][2 * j] = *(const GAS u32x4*)(xin + o_); xr[q][2 * j + 1] = *(const GAS u32x4*)(xin + o_ + 4); } \
            yv[q][j] = __builtin_nontemporal_load((const GAS u32x4*)(Y + o_)); } } while (0)
    LN1_LOAD(0);
    const float rbe = rb[lane];
    { const int b = (LN1_BLK(0) * 32) / SEQ; const float* mb = modl + (size_t)b * 6144;
      for (int i = F.tid; i < 1024; i += NWAVES * 64) { const int v = i >> 8, c4 = (i & 255) * 4;
          const float* src = (v == 0) ? lg : (v == 1) ? lb : (v == 2) ? (mb + 4096) : (mb + 3072);
          f32x4 t = *(const GAS f32x4*)(src + c4); if (v == 2) t = t + 1.0f; *(LAS f32x4*)(PV + v * 1024 + c4) = t; } }
    __syncthreads();
    for (int bi = 0; bi < nblk; ++bi) {
        const int blk = LN1_BLK(bi);
        const int tok0 = blk * 32;
        LSTAMP0();
        bf16x8 bh[8][2], bl[8][2];
        {
            const int b = tok0 / SEQ; const float* mb = modl + (size_t)b * 6144;
            f32x4 xv[4][4];
            f32x4 pg1[4];
#pragma unroll
            for (int jj = 0; jj < 4; ++jj) pg1[jj] = *(const GAS f32x4*)(mb + 2048 + 8 * lane + 512 * (jj >> 1) + 4 * (jj & 1)) + 1.0f;
            float sm[4];
#pragma unroll
            for (int q = 0; q < 4; ++q) { float s = 0.f;
#pragma unroll
                for (int jj = 0; jj < 4; ++jj) { const unsigned w0 = (jj & 1) ? yv[q][jj >> 1].z : yv[q][jj >> 1].x, w1 = (jj & 1) ? yv[q][jj >> 1].w : yv[q][jj >> 1].y;
                    f32x4 y4; y4[0] = h2f(w0 & 0xffffu); y4[1] = h2f(w0 >> 16); y4[2] = h2f(w1 & 0xffffu); y4[3] = h2f(w1 >> 16);
                    f32x4 x4;
                    if constexpr (X16) { const unsigned v0 = (jj & 1) ? xr[q][jj >> 1].z : xr[q][jj >> 1].x, v1 = (jj & 1) ? xr[q][jj >> 1].w : xr[q][jj >> 1].y;
                        x4 = (f32x4){h2f(v0 & 0xffffu), h2f(v0 >> 16), h2f(v1 & 0xffffu), h2f(v1 >> 16)}; }
                    else { const u32x4 v = xr[q][jj]; x4 = (f32x4){__uint_as_float(v.x), __uint_as_float(v.y), __uint_as_float(v.z), __uint_as_float(v.w)}; }
                    xv[q][jj] = x4 * ALPHA + pg1[jj] * y4; s += (xv[q][jj][0] + xv[q][jj][1]) + (xv[q][jj][2] + xv[q][jj][3]); }
                sm[q] = s; }
#pragma unroll
            for (int o = 1; o < 64; o <<= 1) {
#pragma unroll
                for (int q = 0; q < 4; ++q) sm[q] += __shfl_xor(sm[q], o); }
            float s2[4];
#pragma unroll
            for (int q = 0; q < 4; ++q) { const float mean = sm[q] * (1.f / D); float t = 0.f;
#pragma unroll
                for (int jj = 0; jj < 4; ++jj) { xv[q][jj] = xv[q][jj] - mean; t += (xv[q][jj][0] * xv[q][jj][0] + xv[q][jj][1] * xv[q][jj][1]) + (xv[q][jj][2] * xv[q][jj][2] + xv[q][jj][3] * xv[q][jj][3]); }
                s2[q] = t; }
#pragma unroll
            for (int o = 1; o < 64; o <<= 1) {
#pragma unroll
                for (int q = 0; q < 4; ++q) s2[q] += __shfl_xor(s2[q], o); }
            LAS float* pvb = PV + 8 * lane; asm volatile("" : "+v"(pvb));
#pragma unroll
            for (int jj = 0; jj < 4; ++jj) { const int col = 8 * lane + 512 * (jj >> 1) + 4 * (jj & 1); const int co = 512 * (jj >> 1) + 4 * (jj & 1);
                const f32x4 gg = *(const LAS f32x4*)(pvb + co), bb = *(const LAS f32x4*)(pvb + 1024 + co), sc2 = *(const LAS f32x4*)(pvb + 2048 + co), sh2 = *(const LAS f32x4*)(pvb + 3072 + co);
#pragma unroll
                for (int q = 0; q < 4; ++q) { const int rl = wave * 4 + q, tok = tok0 + rl; const float rstd = 1.0f / sqrtf(s2[q] * (1.f / D) + LN_EPS);
                    const f32x4 xn = xv[q][jj] * rstd * gg + bb; { u32x2 xw; xw.x = pkh2(xn[0], xn[1]); xw.y = pkh2(xn[2], xn[3]); *(GAS u32x2*)(X + (size_t)tok * D + col) = xw; }
                    const f32x4 hf = xn * sc2 + sh2;
                    unsigned hh[4], ll[4];
#pragma unroll
                    for (int e = 0; e < 4; ++e) { hh[e] = f2bf(hf[e]); ll[e] = f2bf(hf[e] - bf2f(hh[e])); }
                    u32x2 wh, wlo; wh.x = hh[0] | (hh[1] << 16); wh.y = hh[2] | (hh[3] << 16); wlo.x = ll[0] | (ll[1] << 16); wlo.y = ll[2] | (ll[3] << 16);
                    *(GAS u32x2*)(H + (size_t)tok * D + col) = wh;
                    *(LAS u32x2*)(Ahi + rl * APITCH + col) = wh; *(LAS u32x2*)(Alo + rl * APITCH + col) = wlo; } }
        }
        __builtin_amdgcn_sched_barrier(0);
        {
            const int r32 = lane & 31, hi = lane >> 5;
#pragma unroll
            for (int nb = 0; nb < 2; ++nb) {
                const GAS bf16* ph = (const GAS bf16*)WH + (size_t)(r32 + 32 * nb) * 1024 + wave * 128 + hi * 8; const GAS bf16* pl = (const GAS bf16*)WLo + (size_t)(r32 + 32 * nb) * 1024 + wave * 128 + hi * 8;
                asm volatile("" : "+v"(ph), "+v"(pl));
#pragma unroll
                for (int ks = 0; ks < 8; ++ks) { bh[ks][nb] = *(const GAS bf16x8*)(ph + ks * 16); bl[ks][nb] = *(const GAS bf16x8*)(pl + ks * 16); } }
        }
        __syncthreads();
        LSTAMP(13);
        f32x16 acc[2]; acc[0] = (f32x16){}; acc[1] = (f32x16){};
        {
            const int r32 = lane & 31, hi = lane >> 5;
#pragma unroll
            for (int ks = 0; ks < 8; ++ks) {
                const int k = wave * 128 + ks * 16 + hi * 8;
                const bf16x8 ah = *(const LAS bf16x8*)(Ahi + r32 * APITCH + k), al = *(const LAS bf16x8*)(Alo + r32 * APITCH + k);
#pragma unroll
                for (int nb = 0; nb < 2; ++nb) {
                    acc[nb] = MFMA32(ah, bh[ks][nb], acc[nb]);
                    acc[nb] = MFMA32(al, bh[ks][nb], acc[nb]);
                    acc[nb] = MFMA32(ah, bl[ks][nb], acc[nb]);
                }
            }
        }
        LDS_ONLY_BARRIER();
        {
            const int r32 = lane & 31, hi = lane >> 5;
#pragma unroll
            for (int nb = 0; nb < 2; ++nb)
#pragma unroll
                for (int r = 0; r < 16; ++r) { const int trow = (r & 3) + 8 * (r >> 2) + 4 * hi; PART[(wave * 32 + trow) * 64 + 32 * nb + r32] = acc[nb][r]; }
        }
        if (F.tid < 64) lcnt[F.tid] = 0;
        LDS_ONLY_BARRIER();
        LSTAMP(14);
        if (bi + 1 < nblk) LN1_LOAD(bi + 1);
        else {
#pragma unroll
            for (int q = 0; q < 4; ++q) {
#pragma unroll
                for (int j = 0; j < NX; ++j) xr[q][j] = (u32x4){0u, 0u, 0u, 0u};
#pragma unroll
                for (int j = 0; j < 2; ++j) yv[q][j] = (u32x4){0u, 0u, 0u, 0u}; } }
        int chosen_m = 0; int posl[4]; float wv[4]; int rk[4];
        unsigned key[4]; float sgv[4];
#pragma unroll
        for (int q = 0; q < 4; ++q) {
            const int rl = wave * 4 + q;
            float logit = 0.f;
#pragma unroll
            for (int w = 0; w < 8; ++w) logit += PART[(w * 32 + rl) * 64 + lane];
            const float sg = 1.0f / (1.0f + __expf(-logit));
            const float sel = sg + rbe;
            float m1 = sel; m1 = fmaxf(m1, __shfl_xor(m1, 1)); m1 = fmaxf(m1, __shfl_xor(m1, 2)); m1 = fmaxf(m1, __shfl_xor(m1, 4));
            const unsigned long long bal = __ballot(sel == m1);
            const unsigned long long gm = bal & (0xFFull << (8 * (lane >> 3)));
            const int first = (int)__builtin_ctzll(gm);
            float m2 = (lane == first) ? -INFINITY : sel; m2 = fmaxf(m2, __shfl_xor(m2, 1)); m2 = fmaxf(m2, __shfl_xor(m2, 2)); m2 = fmaxf(m2, __shfl_xor(m2, 4));
            const float gs = m1 + m2;
            int rg = 0;
#pragma unroll
            for (int g2 = 0; g2 < 8; ++g2) { const float v = __builtin_bit_cast(float, __builtin_amdgcn_readlane(__builtin_bit_cast(int, gs), 8 * g2)); rg += ((v > gs) || (v == gs && g2 < (lane >> 3))) ? 1 : 0; }
            const bool gsel = rg < 4;
            const float msel = gsel ? sel : -INFINITY;
            const unsigned mb_ = __float_as_uint(msel); key[q] = (mb_ & 0x80000000u) ? ~mb_ : (mb_ | 0x80000000u); sgv[q] = sg;
        }
        unsigned tau[4] = {0u, 0u, 0u, 0u};
#pragma unroll 1
        for (int bit = 31; bit >= 0; --bit) {
#pragma unroll
            for (int q = 0; q < 4; ++q) { const unsigned cand = tau[q] | (1u << bit); const int cnt = (int)__popcll(__ballot(key[q] >= cand)); tau[q] = (cnt >= TOPK) ? cand : tau[q]; } }
#pragma unroll
        for (int q = 0; q < 4; ++q) {
            const unsigned long long gtm = __ballot(key[q] > tau[q]), eqm = __ballot(key[q] == tau[q]);
            const int need = TOPK - (int)__popcll(gtm);
            const unsigned long long below = (1ull << lane) - 1ull;
            const bool ch = (key[q] > tau[q]) || ((key[q] == tau[q]) && ((int)__popcll(eqm & below) < need));
            const unsigned long long chm = __ballot(ch);
            const int rank = (int)__popcll(chm & below);
            const float wsum = wave_sum(ch ? sgv[q] : 0.f);
            wv[q] = sgv[q] / wsum * ROUTED_SCALE; rk[q] = rank; posl[q] = 0;
            if (ch) { chosen_m |= (1 << q); posl[q] = __hip_atomic_fetch_add(lcnt + lane, 1, __ATOMIC_RELAXED, __HIP_MEMORY_SCOPE_WORKGROUP); }
        }
        LDS_ONLY_BARRIER();
        LSTAMP(15);
        if (wave == 0) { const int n = lcnt[lane]; int base = 0; if (n > 0) base = (int)__hip_atomic_fetch_add(gcnt + lane, (unsigned)n, RLX_AGENT); gb[lane] = base; }
        LDS_ONLY_BARRIER();
        {
            const int base = gb[lane];
#pragma unroll
            for (int q = 0; q < 4; ++q) if (chosen_m & (1 << q)) { const int tok = tok0 + wave * 4 + q; const int pos = base + posl[q];
                tokl[(size_t)lane * CAP + pos] = tok; wl[(size_t)tok * 8 + rk[q]] = wv[q]; tslot[(size_t)tok * 8 + rk[q]] = lane * CAP + pos; }
        }
        LDS_ONLY_BARRIER();
        LSTAMP(16);
    }
#undef LN1_LOAD
#undef LN1_BLK
}

__device__ __forceinline__ void combine_ln2_phase(Frame& F, int layer) {
    bf16* X = (bf16*)(F.ws + WS_X); bf16* H = (bf16*)(F.ws + WS_H); const unsigned char* YS = (const unsigned char*)(F.ws + WS_YS);
    const float* modl = (const float*)(F.ws + WS_MOD) + (size_t)layer * 8 * 6144;
    const float* modn = (const float*)(F.ws + WS_MOD) + (size_t)(layer + 1) * 8 * 6144;
    const float* lg = inp(F, 18) + layer * D; const float* lb = inp(F, 19) + layer * D;
    const int* tslot = (const int*)(F.ws + WS_TSLOT);
    const LAS int* ts = (const LAS int*)(F.lc + LC_TS);
    const bool lastl = (layer == DEPTH - 1);
    float* xout = (float*)inp(F, 20);
    const int lane = F.lane, wave = F.wave;
    LAS float* PV = (LAS float*)F.lds;
    const int shbase = ts[64] * 256;
    for (int blk = F.vcu; blk < T / 64; blk += F.G) {
        const int tokb = blk * 64, b = tokb / SEQ;
        __syncthreads();
        for (int i = F.tid; i < 1024; i += 512) { PV[i] = modl[(size_t)b * 6144 + 5120 + i] + 1.0f; PV[1024 + i] = lg[i]; PV[2048 + i] = lb[i];
            if (!lastl) { PV[3072 + i] = modn[(size_t)b * 6144 + 1024 + i] + 1.0f; PV[4096 + i] = modn[(size_t)b * 6144 + i]; } }
        __syncthreads();
        const int tw = tokb + wave * 8;
        int sv; { const int v = tslot[(size_t)tw * 8 + lane]; sv = ts[v >> 14] * 256 + (v & (CAP - 1)); }
        const float wvv = ((const float*)(F.ws + WS_WL))[(size_t)tw * 8 + lane] * (1.0f / 32.0f);
        pg8::u32x2_t ys[18]; u32x4 xs[2];
#define CB_LOAD(k) do { const int tok_ = tw + (k); _Pragma("unroll") for (int kk_ = 0; kk_ < 9; ++kk_) { const int slot_ = (kk_ < 8) ? __builtin_amdgcn_readlane(sv, 8 * (k) + kk_) : (shbase + tok_); \
            const unsigned char* yr_ = YS + (size_t)slot_ * D + 8 * lane; ys[2 * kk_] = __builtin_nontemporal_load((const GAS pg8::u32x2_t*)(yr_)); ys[2 * kk_ + 1] = __builtin_nontemporal_load((const GAS pg8::u32x2_t*)(yr_ + 512)); } \
            _Pragma("unroll") for (int j_ = 0; j_ < 2; ++j_) xs[j_] = __builtin_nontemporal_load((const GAS u32x4*)(X + (size_t)tok_ * D + 8 * lane + 512 * j_)); } while (0)
        CB_LOAD(0);
#pragma unroll 1
        for (int k = 0; k < 8; ++k) {
            const int tok_ = tw + k; f32x4 y_[4];
#pragma unroll
            for (int jj_ = 0; jj_ < 4; ++jj_) y_[jj_] = (f32x4){0.f, 0.f, 0.f, 0.f};
#pragma unroll
            for (int kk_ = 0; kk_ < 9; ++kk_) { const float wk_ = (kk_ < 8) ? __builtin_bit_cast(float, __builtin_amdgcn_readlane(__builtin_bit_cast(int, wvv), 8 * k + kk_)) : (1.0f / 32.0f);
#pragma unroll
                for (int j_ = 0; j_ < 2; ++j_) { const pg8::u32x2_t w_ = ys[2 * kk_ + j_];
                    const f32x2 a0_ = __builtin_amdgcn_cvt_pk_f32_fp8((int)w_.x, false), a1_ = __builtin_amdgcn_cvt_pk_f32_fp8((int)w_.x, true), b0_ = __builtin_amdgcn_cvt_pk_f32_fp8((int)w_.y, false), b1_ = __builtin_amdgcn_cvt_pk_f32_fp8((int)w_.y, true);
                    y_[2 * j_][0] += wk_ * a0_[0]; y_[2 * j_][1] += wk_ * a0_[1]; y_[2 * j_][2] += wk_ * a1_[0]; y_[2 * j_][3] += wk_ * a1_[1];
                    y_[2 * j_ + 1][0] += wk_ * b0_[0]; y_[2 * j_ + 1][1] += wk_ * b0_[1]; y_[2 * j_ + 1][2] += wk_ * b1_[0]; y_[2 * j_ + 1][3] += wk_ * b1_[1]; } }
            f32x4 v_[4]; float s_ = 0.f;
#pragma unroll
            for (int jj_ = 0; jj_ < 4; ++jj_) { const int col_ = 8 * lane + 512 * (jj_ >> 1) + 4 * (jj_ & 1); const f32x4 g2_ = *(const LAS f32x4*)(PV + col_);
                const unsigned w0_ = (jj_ & 1) ? xs[jj_ >> 1].z : xs[jj_ >> 1].x, w1_ = (jj_ & 1) ? xs[jj_ >> 1].w : xs[jj_ >> 1].y;
                const f32x4 x4_ = (f32x4){h2f(w0_ & 0xffffu), h2f(w0_ >> 16), h2f(w1_ & 0xffffu), h2f(w1_ >> 16)};
                v_[jj_] = x4_ * ALPHA + g2_ * y_[jj_]; s_ += (v_[jj_][0] + v_[jj_][1]) + (v_[jj_][2] + v_[jj_][3]); }
            asm volatile("" : "+v"(v_[0]), "+v"(v_[1]), "+v"(v_[2]), "+v"(v_[3]));
            __builtin_amdgcn_sched_barrier(0);
            { const int kn = (k + 1 < 8) ? k + 1 : k; CB_LOAD(kn); }
            __builtin_amdgcn_sched_barrier(0);
            const float mean_ = wave_sum(s_) * (1.f / D); float q_ = 0.f;
#pragma unroll
            for (int jj_ = 0; jj_ < 4; ++jj_) { v_[jj_] = v_[jj_] - mean_; q_ += (v_[jj_][0] * v_[jj_][0] + v_[jj_][1] * v_[jj_][1]) + (v_[jj_][2] * v_[jj_][2] + v_[jj_][3] * v_[jj_][3]); }
            const float rstd_ = 1.0f / sqrtf(wave_sum(q_) * (1.f / D) + LN_EPS);
#pragma unroll
            for (int jj_ = 0; jj_ < 4; ++jj_) { const int col_ = 8 * lane + 512 * (jj_ >> 1) + 4 * (jj_ & 1);
                const f32x4 gg_ = *(const LAS f32x4*)(PV + 1024 + col_), bb_ = *(const LAS f32x4*)(PV + 2048 + col_);
                const f32x4 xn_ = v_[jj_] * rstd_ * gg_ + bb_;
                if (lastl) *(GAS f32x4*)(xout + (size_t)tok_ * D + col_) = xn_;
                else { u32x2 xw_; xw_.x = pkh2(xn_[0], xn_[1]); xw_.y = pkh2(xn_[2], xn_[3]); *(GAS u32x2*)(X + (size_t)tok_ * D + col_) = xw_; }
                if (!lastl) { const f32x4 sc_ = *(const LAS f32x4*)(PV + 3072 + col_), sh_ = *(const LAS f32x4*)(PV + 4096 + col_); const f32x4 hm_ = xn_ * sc_ + sh_;
                    u32x2 w2_; w2_.x = pk2(hm_[0], hm_[1]); w2_.y = pk2(hm_[2], hm_[3]); *(GAS u32x2*)(H + (size_t)tok_ * D + col_) = w2_; } }
        }
#undef CB_LOAD
    }
}

constexpr int ACCP = 68;
__device__ __forceinline__ int crow(int r, int hi) { return (r & 3) + 8 * (r >> 2) + 4 * hi; }
constexpr int KPITCH = 144;
__device__ __forceinline__ u32x4 f8x8_to_bf16(unsigned a, unsigned b, float inv) {
    typedef __bf16 bfx2 __attribute__((ext_vector_type(2)));
    u32x4 r; r.x = __builtin_bit_cast(unsigned, (bfx2)__builtin_amdgcn_cvt_scalef32_pk_bf16_fp8(a, inv, false)); r.y = __builtin_bit_cast(unsigned, (bfx2)__builtin_amdgcn_cvt_scalef32_pk_bf16_fp8(a, inv, true));
    r.z = __builtin_bit_cast(unsigned, (bfx2)__builtin_amdgcn_cvt_scalef32_pk_bf16_fp8(b, inv, false)); r.w = __builtin_bit_cast(unsigned, (bfx2)__builtin_amdgcn_cvt_scalef32_pk_bf16_fp8(b, inv, true)); return r;
}
template <bool FIRST, int NB>
__device__ __forceinline__ void attn_task(const unsigned char* QKVb  , int g, int h, int dil, int cls, int q0, int QS, int kb0, int L, float slope2d,
                                          LAS unsigned char* stg  , LAS float* wsf  , LAS float* ACC, LAS float* ML, int trow_mul, int trow_add, int lane) {
    asm volatile("" : "+v"(lane));
    const int r32 = lane & 31, hi = lane >> 5, lr = lane >> 2, lc = lane & 3;
    const int qcol = ((g * 3 + 0) * 16 + h) * 64, kcol = ((g * 3 + 1) * 16 + h) * 64, vcol = ((g * 3 + 2) * 16 + h) * 64;
    const size_t rstride = (size_t)dil * NQKV;
    const unsigned char* base = QKVb + (size_t)cls * NQKV + lc * 16;
    const int jlo = (kb0 >= -31) ? 0 : ((-kb0) >> 5);
    const int qpos = q0 + QS * r32;
    const int dmax = qpos < 128 ? qpos : 128;
    const float half = 0.5f * (float)dmax;
#define AT_LOADROWS(dst, l0, ls, col) do { _Pragma("unroll") for (int i_ = 0; i_ < 2; ++i_) { int l_ = (l0) + (ls) * (16 * i_ + lr); l_ = l_ < 0 ? 0 : (l_ > L - 1 ? L - 1 : l_); \
        dst[i_] = *(const GAS u32x4*)(base + (size_t)l_ * rstride + (col)); } } while (0)
#define AT_PUTROWS(src, inv) do { _Pragma("unroll") for (int i_ = 0; i_ < 2; ++i_) { LAS unsigned char* p_ = stg + (16 * i_ + lr) * KPITCH + lc * 32; \
        *(LAS u32x4*)(p_) = f8x8_to_bf16(src[i_].x, src[i_].y, inv); *(LAS u32x4*)(p_ + 16) = f8x8_to_bf16(src[i_].z, src[i_].w, inv); } } while (0)
#define AT_GETFRAG(dst) do { _Pragma("unroll") for (int s_ = 0; s_ < 4; ++s_) dst[s_] = *(const LAS bf16x8*)(stg + r32 * KPITCH + 32 * s_ + 16 * hi); } while (0)
#define AT_LDSWAIT() asm volatile("s_waitcnt lgkmcnt(0)" ::: "memory")
    u32x4 kr[2][2];
    bf16x8 qf[4];
    { u32x4 qr[2]; AT_LOADROWS(qr, q0, QS, qcol);
#pragma unroll
      for (int j = 0; j < NB; ++j) if (j == jlo) AT_LOADROWS(kr[j & 1], kb0 + 32 * j, 1, kcol);
      AT_PUTROWS(qr, 1.0f / 64.0f); AT_LDSWAIT(); AT_GETFRAG(qf); AT_LDSWAIT(); }
    f32x16 S[NB];
    float mx = -INFINITY;
#pragma unroll
    for (int j = 0; j < NB; ++j) {
        if (j >= jlo) {
            asm volatile("" ::: "memory");
            if (j < NB - 1) AT_LOADROWS(kr[(j + 1) & 1], kb0 + 32 * (j + 1), 1, kcol);
            AT_PUTROWS(kr[j & 1], 1.0f / 16.0f);
            const float xd0 = (float)(qpos - kb0 - 32 * j - 4 * hi) - half;
            const bool inner = (q0 - kb0 - 32 * j - 31 >= 0) && (q0 + QS * 31 - kb0 - 32 * j <= 128) && (kb0 + 32 * j >= 0);
            f32x16 a;
            if (inner) {
                const float cb = -slope2d * xd0;
#pragma unroll
                for (int r = 0; r < 16; ++r) a[r] = __builtin_fmaf(slope2d, (float)((r & 3) + 8 * (r >> 2)), cb);
            } else {
#pragma unroll
                for (int r = 0; r < 16; ++r) { const float x = xd0 - (float)((r & 3) + 8 * (r >> 2)); a[r] = (__builtin_fabsf(x) <= half) ? (-slope2d * x) : -INFINITY; }
            }
            bf16x8 kf[4];
            AT_LDSWAIT(); AT_GETFRAG(kf); AT_LDSWAIT();
#pragma unroll
            for (int s = 0; s < 4; ++s) a = MFMA32(kf[s], qf[s], a);
#pragma unroll
            for (int r = 0; r < 16; ++r) mx = fmaxf(mx, a[r]);
            S[j] = a;
        } else {
#pragma unroll
            for (int r = 0; r < 16; ++r) S[j][r] = -INFINITY;
        }
        __builtin_amdgcn_sched_barrier(0);
    }
    u32x4 vr[2][2];
#pragma unroll
    for (int j = 0; j < NB; ++j) if (j == jlo) AT_LOADROWS(vr[j & 1], kb0 + 32 * j, 1, vcol);
    { auto rr = __builtin_amdgcn_permlane32_swap(__float_as_uint(mx), __float_as_uint(mx), false, false);
      const unsigned r0 = rr[0], r1 = rr[1]; mx = fmaxf(__uint_as_float(r0), __uint_as_float(r1)); }
    const float mx_true = mx - slope2d * half;
    float lsum = 0.f;
    u32x4 P[NB][2];
#pragma unroll
    for (int j = 0; j < NB; ++j) {
        float p[16];
#pragma unroll
        for (int r = 0; r < 16; ++r) { p[r] = __builtin_amdgcn_exp2f(S[j][r] - mx); lsum += p[r]; }
#pragma unroll
        for (int ks = 0; ks < 2; ++ks) { P[j][ks].x = cvt_pk_bf16(p[8 * ks + 0], p[8 * ks + 1]); P[j][ks].y = cvt_pk_bf16(p[8 * ks + 2], p[8 * ks + 3]); P[j][ks].z = cvt_pk_bf16(p[8 * ks + 4], p[8 * ks + 5]); P[j][ks].w = cvt_pk_bf16(p[8 * ks + 6], p[8 * ks + 7]); }
        __builtin_amdgcn_sched_barrier(0);
    }
    { auto rr = __builtin_amdgcn_permlane32_swap(__float_as_uint(lsum), __float_as_uint(lsum), false, false);
      const unsigned r0 = rr[0], r1 = rr[1]; lsum = __uint_as_float(r0) + __uint_as_float(r1); }
    f32x16 o[2]; o[0] = (f32x16){}; o[1] = (f32x16){};
    const unsigned vrd = (unsigned)(((lane >> 4) & 1) * 32 + (lane & 3) * 8 + (4 * hi + ((lane & 15) >> 2)) * 64);
#pragma unroll
    for (int j = 0; j < NB; ++j) {
        if (j >= jlo) {
            asm volatile("" ::: "memory");
            if (j < NB - 1) AT_LOADROWS(vr[(j + 1) & 1], kb0 + 32 * (j + 1), 1, vcol);
#pragma unroll
            for (int i = 0; i < 2; ++i) { const int key = 16 * i + lr;
#pragma unroll
                for (int hf = 0; hf < 2; ++hf) { const int c8 = 2 * lc + hf; const u32x4 src = vr[j & 1][i];
                    *(LAS u32x4*)(stg + ((c8 >> 2) * 2 + (key >> 4)) * 1024 + (key & 15) * 64 + (c8 & 3) * 16) = f8x8_to_bf16(hf ? src.z : src.x, hf ? src.w : src.y, 1.0f / 16.0f); } }
            AT_LDSWAIT();
#pragma unroll
            for (int d0 = 0; d0 < 2; ++d0)
#pragma unroll
                for (int ks = 0; ks < 2; ++ks) {
                    LAS unsigned char* vp = stg + (d0 * 2 + ks) * 1024 + vrd;
                    const s16x4 lo = __builtin_bit_cast(s16x4, __builtin_amdgcn_ds_read_tr16_b64_v4i16((LAS s16x4*)(vp)));
                    const s16x4 hh = __builtin_bit_cast(s16x4, __builtin_amdgcn_ds_read_tr16_b64_v4i16((LAS s16x4*)(vp + 512)));
                    const bf16x8 vf = (bf16x8){lo[0], lo[1], lo[2], lo[3], hh[0], hh[1], hh[2], hh[3]};
                    o[d0] = MFMA32(__builtin_bit_cast(bf16x8, P[j][ks]), vf, o[d0]);
                }
            AT_LDSWAIT();
        }
        __builtin_amdgcn_sched_barrier(0);
    }
#undef AT_LOADROWS
#undef AT_PUTROWS
#undef AT_GETFRAG
#undef AT_LDSWAIT
    if (hi == 0) { wsf[r32] = mx_true; wsf[32 + r32] = lsum; }
    asm volatile("s_waitcnt lgkmcnt(0)" ::: "memory");
    f32x4 mt4[4], lt4[4];
#pragma unroll
    for (int k = 0; k < 4; ++k) { mt4[k] = *(const LAS f32x4*)(wsf + 8 * k + 4 * hi); lt4[k] = *(const LAS f32x4*)(wsf + 32 + 8 * k + 4 * hi); }
    if (FIRST) {
#pragma unroll
        for (int r = 0; r < 16; ++r) { const int q = crow(r, hi); const int trow = q * trow_mul + trow_add;
            ACC[trow * ACCP + r32] = o[0][r]; ACC[trow * ACCP + 32 + r32] = o[1][r];
            if (r32 == 0) { ML[trow * 2] = mt4[r >> 2][r & 3]; ML[trow * 2 + 1] = lt4[r >> 2][r & 3]; } }
    } else {
        f32x2 ml[16]; float a0[16], a1[16];
#pragma unroll
        for (int r = 0; r < 16; ++r) { const int q = crow(r, hi); const int trow = q * trow_mul + trow_add;
            ml[r] = *(const LAS f32x2*)(ML + trow * 2); a0[r] = ACC[trow * ACCP + r32]; a1[r] = ACC[trow * ACCP + 32 + r32]; }
        asm volatile("s_waitcnt lgkmcnt(0)" ::: "memory");
#pragma unroll
        for (int r = 0; r < 16; ++r) { const int q = crow(r, hi); const int trow = q * trow_mul + trow_add;
            const float mt = mt4[r >> 2][r & 3], lt = lt4[r >> 2][r & 3], mo = ml[r][0], lo_ = ml[r][1];
            const float mn = fmaxf(mo, mt); const float fa = __builtin_amdgcn_exp2f(mo - mn), fb = __builtin_amdgcn_exp2f(mt - mn);
            ACC[trow * ACCP + r32] = a0[r] * fa + o[0][r] * fb; ACC[trow * ACCP + 32 + r32] = a1[r] * fa + o[1][r] * fb;
            if (r32 == 0) { ML[trow * 2] = mn; ML[trow * 2 + 1] = lo_ * fa + lt * fb; } }
    }
    asm volatile("s_waitcnt lgkmcnt(0)" ::: "memory");
}

__device__ __forceinline__ void attn_phase(Frame& F, bf16* MIX) {
    const unsigned char* QKV = (const unsigned char*)(F.ws + WS_QKV);
    LAS float* ACC = (LAS float*)F.lds;
    LAS float* ML = (LAS float*)(F.lds + 69632);
    LAS unsigned char* vst = F.lds + 73728 + F.wave * 4608;
    LAS float* wsf = (LAS float*)(F.lds + 73728 + 8 * 4608 + F.wave * 256);
    const int lane = F.lane, w = F.wave;
    for (int i = 0;; ++i) {
        if (i >= (BATCH * 16 * 8) / F.G) break;
        const int L0 = (F.G == 256) ? ((F.vcu >> 5) * 128 + i * 32 + (F.vcu & 31)) : (i * F.G + F.vcu);
        const int bh = L0 >> 3, ti = L0 & 7; int w4 = ti >> 1; const int c = ti & 1; if (i & 1) w4 = 3 - w4;
        const int b = bh >> 4, h = bh & 15, win0 = w4 * 512;
        const unsigned char* Qb = QKV + (size_t)b * SEQ * NQKV;
        const float sl0 = exp2f(-8.0f * (float)(0 * 16 + h + 1) / 48.0f) * LOG2E, sl1 = exp2f(-8.0f * (float)(1 * 16 + h + 1) / 48.0f) * LOG2E * 4.0f, sl2 = exp2f(-8.0f * (float)(2 * 16 + h + 1) / 48.0f) * LOG2E * 16.0f;
        LSTAMP0();
        attn_task<true, 6>(Qb, 0, h, 1, 0, win0 + 64 * w + c, 2, win0 + 64 * w - 128, SEQ, sl0, vst, wsf, ACC, ML, 1, 32 * w, lane);
        __syncthreads();
        LSTAMP(24);
        if (ATTN_GMASK & 2) { const int cls = c + 2 * (w & 1), lb = w >> 1, lq0 = 128 * w4 + 32 * lb; attn_task<false, 5>(Qb, 1, h, 4, cls, lq0, 1, lq0 - 128, SEQ / 4, sl1, vst, wsf, ACC, ML, 2, 64 * lb + (w & 1), lane); }
        __syncthreads();
        LSTAMP(25);
        if (ATTN_GMASK & 4) { const int cls = c + 2 * w, lq0 = 32 * w4; attn_task<false, 5>(Qb, 2, h, 16, cls, lq0, 1, lq0 - 128, SEQ / 16, sl2, vst, wsf, ACC, ML, 8, w, lane); }
        __syncthreads();
        LSTAMP(26);
        {
#pragma unroll
          for (int it = 0; it < 4; ++it) { const int trow = 32 * w + 8 * it + (lane >> 3), sg = lane & 7; const float inv = 1.0f / ML[trow * 2 + 1];
              const LAS f32x4* ap = (const LAS f32x4*)(ACC + trow * ACCP + sg * 8);
              bf16* op = MIX + (size_t)(b * SEQ + win0 + 2 * trow + c) * D + h * 64 + sg * 8;
              const f32x4 a = ap[0] * inv, bq = ap[1] * inv; u32x4 wv; wv.x = pk2(a[0], a[1]); wv.y = pk2(a[2], a[3]); wv.z = pk2(bq[0], bq[1]); wv.w = pk2(bq[2], bq[3]);
              *(GAS u32x4*)op = wv; } }
        __syncthreads();
    }
}

__device__ __forceinline__ void attn_phase_naive(Frame& F, bf16* MIX, const int gmask) {
    const bf16* QKV = (const bf16*)(F.ws + WS_YS);
    const int lane = F.lane;
    const int gw = F.vcu * NWAVES + F.wave, NGW = F.G * NWAVES;
    for (int item = gw; item < T * 16; item += NGW) {
        const int tok = item >> 4, h = item & 15, b = tok / SEQ, t = tok % SEQ;
        const bf16* Qb = QKV + (size_t)b * SEQ * NQKV;
        float sc[3][3]; int kt[3][3];
        float mx = -INFINITY;
#pragma unroll
        for (int g = 0; g < 3; ++g) {
            const int dil = (g == 0) ? 1 : (g == 1 ? 4 : 16);
            const float slope = exp2f(-8.0f * (float)(g * 16 + h + 1) / 48.0f);
            const bf16* qp = Qb + (size_t)t * NQKV + ((g * 3 + 0) * 16 + h) * 64;
#pragma unroll
            for (int c = 0; c < 3; ++c) {
                const int j = lane + 64 * c; const int tk = t - j * dil;
                float s = -INFINITY;
                if (j <= 128 && tk >= 0 && ((gmask >> g) & 1)) {
                    const bf16* kp = Qb + (size_t)tk * NQKV + ((g * 3 + 1) * 16 + h) * 64;
                    float d = 0.f;
                    for (int e = 0; e < 64; ++e) d += bf2f(qp[e]) * bf2f(kp[e]);
                    s = d - slope * LOG2E * (float)(j * dil);
                }
                sc[g][c] = s; kt[g][c] = tk; mx = fmaxf(mx, s);
            }
        }
#pragma unroll
        for (int o = 1; o < 64; o <<= 1) mx = fmaxf(mx, __shfl_xor(mx, o));
        float den = 0.f; float acc[64];
#pragma unroll
        for (int e = 0; e < 64; ++e) acc[e] = 0.f;
#pragma unroll
        for (int g = 0; g < 3; ++g)
#pragma unroll
            for (int c = 0; c < 3; ++c) {
                const float p = (sc[g][c] == -INFINITY) ? 0.f : exp2f(sc[g][c] - mx);
                den += p;
                if (p != 0.f) { const bf16* vp = Qb + (size_t)kt[g][c] * NQKV + ((g * 3 + 2) * 16 + h) * 64;
#pragma unroll
                    for (int e = 0; e < 64; ++e) acc[e] += p * bf2f(vp[e]); }
            }
        den = wave_sum(den);
        float mine = 0.f;
#pragma unroll
        for (int e = 0; e < 64; ++e) { const float v = wave_sum(acc[e]); if (lane == e) mine = v; }
        MIX[(size_t)tok * D + h * 64 + lane] = (bf16)f2bf(mine / den);
    }
}

struct Args { const float* in[20]; float* out; unsigned char* ws; int ph_lo, ph_hi; };
constexpr int NPHASE = 2 + DEPTH * 8;

__global__ void __launch_bounds__(NWAVES * 64, 2) mk_fwd(Args args) {
    extern __shared__ __attribute__((aligned(16))) unsigned char lds_raw[];
    Frame F;
    F.lds = (LAS unsigned char*)lds_raw; F.lc = F.lds + LDSCTL_OFF;
    F.tid = threadIdx.x; F.lane = F.tid & 63; F.wave = __builtin_amdgcn_readfirstlane(F.tid >> 6);
    F.G = gridDim.x; { const int bx = blockIdx.x; F.vcu = (F.G % 8 == 0) ? (bx % 8) * (F.G / 8) + bx / 8 : bx; }
    F.ws = args.ws; F.ctl = (unsigned*)(args.ws + WS_CTL);
    for (int u = F.tid; u < (LDS_BYTES - LDSCTL_OFF) / 4; u += NWAVES * 64) ((LAS unsigned*)F.lc)[u] = 0u;
    __syncthreads();
    if (F.tid == 0) {
#pragma unroll
        for (int i = 0; i < 20; ++i) *(LAS unsigned long long*)(F.lc + LC_PTR + 8 * i) = (unsigned long long)args.in[i];
        *(LAS unsigned long long*)(F.lc + LC_PTR + 8 * 20) = (unsigned long long)args.out;
    }
    __syncthreads();
#if MK_PER_PHASE
#define GRID_BAR() do { } while (0)
    XcdBarrier bar; bar.bar = nullptr; bar.x = 0; bar.st = nullptr;
#else
    XcdBarrier bar = xcd_barrier_post(F.ctl + CW_BAR, (volatile LAS unsigned*)(F.lc + LC_MISC) + 8);
#define GRID_BAR() xcd_barrier(bar)
#endif
    const int lo = args.ph_lo, hi = args.ph_hi;
#ifdef PROBE_TYPE
#define LC_STAMP 3072
#define STAMP(ty) do { if (blockIdx.x == 0 && F.tid == 0) { const unsigned long long now_ = __builtin_amdgcn_s_memrealtime(); LAS unsigned long long* st_ = (LAS unsigned long long*)(F.lc + LC_STAMP); \
        st_[1 + (ty)] += now_ - st_[0]; st_[0] = now_; } } while (0)
    if (blockIdx.x == 0 && F.tid == 0) { ((LAS unsigned long long*)(F.lc + LC_STAMP))[0] = __builtin_amdgcn_s_memrealtime(); }
#else
#define STAMP(ty) do { } while (0)
#endif
#define IN(k) (lo <= (k) && (k) < hi)
#define SEAM(k) do { if (IN(k) && IN((k) + 1)) GRID_BAR(); } while (0)
    const float* mod = (const float*)(F.ws + WS_MOD);

    if (PHON(0) && IN(0)) { p0_prologue(F); } SEAM(0); STAMP(0);
    bool xlocal = false; int cid = (int)blockIdx.x;
#if !MK_PER_PHASE
    { volatile LAS unsigned* st = (volatile LAS unsigned*)(F.lc + LC_MISC) + 8;
      if (F.tid == 0) { unsigned ok = (F.G == 256) ? 1u : 0u;
#pragma unroll
          for (unsigned jx = 0; jx < 16; ++jx) { const unsigned cj = xb_ld(&bar.bar[XB_XCNT(jx)]); ok &= (jx < 8u) ? (cj == 32u ? 1u : 0u) : (cj == 0u ? 1u : 0u); }
          st[3] = ok; }
      __syncthreads();
      xlocal = (st[3] != 0u) && (MK_XLOCAL != 0);
      if (xlocal) cid = (int)(st[2] * 8u + bar.x); }
#endif
    cid = __builtin_amdgcn_readfirstlane(cid);
    F.vcu = (F.G % 8 == 0) ? (cid % 8) * (F.G / 8) + cid / 8 : cid;
#define LSEAM(k) do { if (IN(k) && IN((k) + 1)) { if (xlocal) xcd_local_barrier(bar, F.wave == 0); else GRID_BAR(); } } while (0)
    if (PHON(1) && IN(1)) { p1_modulate(F, inp(F, 0), mod, 0, 1024); } SEAM(1); STAMP(1);

    for (int layer = 0; layer < DEPTH; ++layer) {
        const int pb = 2 + layer * 8; const int j = layer >> 1;
        if ((layer & 1) == 0) {
            if (PHON(2) && IN(pb + 0)) { refresh(F); unsigned char* ws = opq(F.ws); (void)ws;
                PlainSched S{T / 256, 4, 256, F.G, cid, (const char*)(ws + WS_WPIN) + (size_t)j * 2 * MiB, 2048};
                pg8::EpiStore E{(bf16*)(ws + WS_U), D, nullptr, 0, 0, 0, F.lds + LDS_TB_OFF + F.wave * 2048};
                pg8::gemm_phase<pg8::EpiStore, PlainSched>(F.tid, F.lds, (const char*)(ws + WS_H), 2048, 2048, 1024, S, E);
            } LSEAM(pb + 0); STAMP(2);
            if (PHON(4) && IN(pb + 2)) { refresh(F); unsigned char* ws = opq(F.ws); (void)ws;
                GrpSched S{F.G, cid, (const char*)(ws + WS_WPGRP) + (size_t)j * 512 * 1024};
                { const bf16* U = (const bf16*)(ws + WS_U); bf16* Z = (bf16*)(ws + WS_Z); pg8::Unit pu;
                  for (int i = 0; S.next(i, pu); ++i) {
                      const int b = pu.pm >> 3, t0 = (pu.pm & 7) * 256 + 32 * F.wave, g = pu.pn;
                      if (g == 0) pool_item<2>(U, Z, b, t0, 0, F.lane); else if (g == 1) pool_item<4>(U, Z, b, t0, 1, F.lane);
                      else if (g == 2) pool_item<8>(U, Z, b, t0, 2, F.lane); else pool_item<16>(U, Z, b, t0, 3, F.lane); }
                  asm volatile("s_waitcnt vmcnt(0)" ::: "memory"); __syncthreads(); }
                pg8::EpiStore E{(bf16*)(ws + WS_Y2), D, inp(F, 6) + j * D, 0, 0, 0, F.lds + LDS_TB_OFF + F.wave * 2048};
                pg8::gemm_phase<pg8::EpiStore, GrpSched>(F.tid, F.lds, (const char*)(ws + WS_Z), 2048, 512, 256, S, E);
            } LSEAM(pb + 2); STAMP(4);
            if (PHON(5) && IN(pb + 3)) { refresh(F); unsigned char* ws = opq(F.ws); (void)ws;
                PlainSched S{T / 256, 4, 256, F.G, cid, (const char*)(ws + WS_WPOUT) + (size_t)j * 2 * MiB, 2048};
                pg8::EpiStore E{(bf16*)(ws + WS_Y), D, nullptr, 0, 0, 1, F.lds + LDS_TB_OFF + F.wave * 2048};
                pg8::gemm_phase<pg8::EpiStore, PlainSched>(F.tid, F.lds, (const char*)(ws + WS_Y2), 2048, 2048, 1024, S, E);
            } LSEAM(pb + 3); STAMP(5);
        } else {
            if (PHON(6) && IN(pb + 0)) { refresh(F); unsigned char* ws = opq(F.ws); (void)ws;
                PlainSched S{T / 256, NQKV / 256, (T / 256) * (NQKV / 256), F.G, cid, (const char*)(ws + WS_WAIN) + (size_t)j * 18 * MiB, 2048};
                pg8::EpiStoreF8 E{(unsigned char*)(ws + WS_QKV), NQKV, F.lds + LDS_TB_OFF + F.wave * 2048, 1};
                pg8::gemm_phase<pg8::EpiStoreF8, PlainSched>(F.tid, F.lds, (const char*)(ws + WS_H), 2048, 2048, 1024, S, E);
            } LSEAM(pb + 0); STAMP(6);
            if (PHON(7) && IN(pb + 1)) { refresh(F); unsigned char* ws = opq(F.ws); (void)ws;
#ifdef NAIVE_ATTN
                attn_phase_naive(F, (bf16*)(F.ws + WS_Y2), 7);
#ifdef ORACLE
                if (layer == ORACLE_LAYER) { attn_phase_naive(F, (bf16*)(F.ws + WS_Z), ATTN_GMASK); attn_phase(F, (bf16*)(F.ws + WS_U)); }
#endif
#else
                attn_phase(F, (bf16*)(F.ws + WS_Y2));
#endif
            } if (IN(pb + 1) && IN(pb + 3)) { if (xlocal) xcd_local_barrier(bar, F.wave == 0); else GRID_BAR(); } STAMP(7);
            if (IN(pb + 2)) { refresh(F); unsigned char* ws = opq(F.ws); (void)ws;
#ifdef ORACLE
                if (layer == ORACLE_LAYER) { if (blockIdx.x == 0 && F.tid == 0) atomicAdd(F.ctl + 20000, 3276u * 16u);
                    const bf16* A = (const bf16*)(ws + WS_U); const bf16* B = (const bf16*)(ws + WS_Z);
                    const int gw = F.vcu * NWAVES + F.wave, NGW = F.G * NWAVES;
                    for (int tok = gw; tok < T; tok += NGW) { int bad = 0;
                        for (int h = 0; h < 16; ++h) { if (ORACLE_SEL) { const float a = bf2f(A[(size_t)tok * D + h * 64 + F.lane]), b = bf2f(B[(size_t)tok * D + h * 64 + F.lane]);
                            const float e2 = wave_sum((a - b) * (a - b)), n2 = wave_sum(b * b); if (!(e2 <= 0.0025f * n2)) bad += ORACLE_W; } }
                        if (bad && F.lane == 0) atomicAdd(F.ctl + 20000, (unsigned)bad); } }
#endif
            }
            if (PHON(8) && IN(pb + 3)) { refresh(F); unsigned char* ws = opq(F.ws); (void)ws;
                PlainSched S{T / 256, 4, 256, F.G, cid, (const char*)(ws + WS_WAOUT) + (size_t)j * 2 * MiB, 2048};
                pg8::EpiStore E{(bf16*)(ws + WS_Y), D, nullptr, 0, 0, 1, F.lds + LDS_TB_OFF + F.wave * 2048};
                pg8::gemm_phase<pg8::EpiStore, PlainSched>(F.tid, F.lds, (const char*)(ws + WS_Y2), 2048, 2048, 1024, S, E);
            } LSEAM(pb + 3); STAMP(8);
        }
        if (PHON(9) && IN(pb + 4)) { refresh(F); unsigned char* ws = opq(F.ws); (void)ws; const float* xin = (layer == 0) ? inp(F, 0) : (const float*)(ws + WS_X); if (layer == 0) ln1_router_phase<false>(F, layer, xin); else ln1_router_phase<true>(F, layer, xin); } SEAM(pb + 4); STAMP(9);
        if (PHON(10) && IN(pb + 5)) { refresh(F); unsigned char* ws = opq(F.ws); (void)ws;
            moe_build_table(F, layer);
            const LAS int* ts = (const LAS int*)(F.lc + LC_TS);
            const int ntile = ts[65];
            MoeSched<true> S{ts, (const LAS int*)(F.lc + LC_CNT), 2, ntile * 2, F.G, cid, F.lane, (const int*)(ws + WS_TOKL), (const float*)(ws + WS_WL),
                       (const char*)(ws + WS_WEGU) + (size_t)layer * 64 * MiB, (size_t)1 * MiB, (const char*)(ws + WS_WSHGU) + (size_t)layer * MiB, 2048};
            pg8::EpiGU E{(bf16*)(ws + WS_ACT)};
            pg8::gemm_phase<pg8::EpiGU, MoeSched<true>>(F.tid, F.lds, (const char*)(ws + WS_H), 2048, 2048, 1024, S, E);
        } LSEAM(pb + 5); STAMP(10);
        if (PHON(11) && IN(pb + 6)) { refresh(F); unsigned char* ws = opq(F.ws); (void)ws;
            moe_build_table(F, layer);
            const LAS int* ts = (const LAS int*)(F.lc + LC_TS);
            const int ntile = ts[65];
            MoeSched<false> S{ts, (const LAS int*)(F.lc + LC_CNT), 4, ntile * 4, F.G, cid, F.lane, nullptr, nullptr,
                       (const char*)(ws + WS_WEDN) + (size_t)layer * 32 * MiB, (size_t)512 * 1024, (const char*)(ws + WS_WSHDN) + (size_t)layer * 512 * 1024, 512};
            pg8::EpiStoreF8 E{(unsigned char*)(ws + WS_YS), D, F.lds + LDS_TB_OFF + F.wave * 2048, 0};
            pg8::gemm_phase<pg8::EpiStoreF8, MoeSched<false>>(F.tid, F.lds, (const char*)(ws + WS_ACT), 512, 512, 256, S, E);
        } SEAM(pb + 6); STAMP(11);
        if (PHON(12) && IN(pb + 7)) { refresh(F); unsigned char* ws = opq(F.ws); (void)ws; moe_build_table(F, layer); combine_ln2_phase(F, layer); }
        if (layer < DEPTH - 1) LSEAM(pb + 7);
        STAMP(12);
    }
#ifdef PROBE_TYPE
    if (blockIdx.x == 0 && F.tid == 0) { const unsigned long long t0_ = __builtin_amdgcn_s_memrealtime(); const unsigned long long want_ = 4ull * ((LAS unsigned long long*)(F.lc + LC_STAMP))[1 + PROBE_TYPE];
        while (__builtin_amdgcn_s_memrealtime() - t0_ < want_) __builtin_amdgcn_s_sleep(8); }
#endif
#undef IN
#undef SEAM
}

extern "C" void kernel_launch(void* const* d_in, const int* in_sizes, int n_in, void* d_out, int out_size, void* d_ws, size_t ws_size, hipStream_t stream) {
    static int grid = 0;
    if (grid == 0) {
        if (n_in != 20 || in_sizes[0] != T * D || out_size != T * D || ws_size < WS_END) { fprintf(stderr, "kernel_launch: unexpected shapes / workspace (n_in %d, ws %zu); nothing launched\n", n_in, ws_size); grid = -1; return; }
        int dev = 0, cus = 0, per_cu = 0;
        if (hipGetDevice(&dev) != hipSuccess || hipDeviceGetAttribute(&cus, hipDeviceAttributeMultiprocessorCount, dev) != hipSuccess) { grid = -1; return; }
        if (hipFuncSetAttribute((const void*)mk_fwd, hipFuncAttributeMaxDynamicSharedMemorySize, LDS_BYTES) != hipSuccess) { fprintf(stderr, "kernel_launch: hipFuncSetAttribute failed\n"); grid = -1; return; }
        if (hipOccupancyMaxActiveBlocksPerMultiprocessor(&per_cu, (const void*)mk_fwd, NWAVES * 64, LDS_BYTES) != hipSuccess || per_cu < 1) { fprintf(stderr, "kernel_launch: occupancy query says %d\n", per_cu); }
        (void)hipGetLastError();
        grid = cus;
    }
    if (grid < 0) return;
    if (hipMemsetAsync((char*)d_ws + WS_CTL, 0, CTL_ZERO_BYTES, stream) != hipSuccess) return;
    Args a{};
    for (int i = 0; i < 20; ++i) a.in[i] = (const float*)d_in[i];
    a.out = (float*)d_out; a.ws = (unsigned char*)d_ws;
#if MK_PER_PHASE
    for (int p = 0; p < NPHASE; ++p) { a.ph_lo = p; a.ph_hi = p + 1; hipLaunchKernelGGL(mk_fwd, dim3(grid), dim3(NWAVES * 64), LDS_BYTES, stream, a); }
#else
    a.ph_lo = 0; a.ph_hi = NPHASE;
    hipLaunchKernelGGL(mk_fwd, dim3(grid), dim3(NWAVES * 64), LDS_BYTES, stream, a);
#endif
    const hipError_t le = hipPeekAtLastError();
    if (le != hipSuccess) fprintf(stderr, "kernel_launch: launch failed: %s\n", hipGetErrorName(le));
}
```

```cpp
#include <hip/hip_runtime.h>
#include <cstdio>
#include <cstdint>

#ifndef MK_PER_PHASE
#define MK_PER_PHASE 0
#endif
#define ORACLE_SEL 1
#define ATTN_GMASK 7
#define ORACLE_W 1
#define ORACLE_LAYER 1
#ifndef MK_XLOCAL
#define MK_XLOCAL 1
#endif
#ifndef PHSEL
#define PHSEL 0xFFFF
#endif
#define PHON(n) (((PHSEL) >> (n)) & 1)

#define GAS __attribute__((address_space(1)))
#define LAS __attribute__((address_space(3)))
typedef unsigned short bf16;
typedef short bf16x8 __attribute__((ext_vector_type(8)));
typedef short s16x4 __attribute__((ext_vector_type(4)));
typedef float f32x2 __attribute__((ext_vector_type(2)));
typedef float f32x4 __attribute__((ext_vector_type(4)));
typedef float f32x16 __attribute__((ext_vector_type(16)));
typedef unsigned u32x2 __attribute__((ext_vector_type(2)));
typedef unsigned u32x4 __attribute__((ext_vector_type(4)));

constexpr int BATCH = 8, SEQ = 2048, D = 1024, T = BATCH * SEQ, DEPTH = 4;
constexpr int NQKV = 9216, NE = 64, TOPK = 8, DEXP = 256;
constexpr int CAP = 16384;
constexpr int PSLOT = 147456 + T;
constexpr float ALPHA = 1.6817928305074290f;
constexpr float LN_EPS = 1e-5f;
constexpr float LOG2E = 1.4426950408889634f;
constexpr float QSCALE = 0.125f * LOG2E;
constexpr float ROUTED_SCALE = 2.5f;

constexpr size_t MiB = 1u << 20;
constexpr size_t WS_CTL = 0, CTL_ZERO_BYTES = 1 * MiB;
constexpr size_t WS_MOD = 1 * MiB;
constexpr size_t WS_WRHI = 2 * MiB;
constexpr size_t WS_WRLO = WS_WRHI + 512 * 1024;
constexpr size_t WS_WPIN = 3 * MiB;
constexpr size_t WS_WPGRP = 7 * MiB;
constexpr size_t WS_WPOUT = 8 * MiB;
constexpr size_t WS_WAIN = 12 * MiB;
constexpr size_t WS_WAOUT = 48 * MiB;
constexpr size_t WS_WSHGU = 52 * MiB;
constexpr size_t WS_WSHDN = 56 * MiB;
constexpr size_t WS_WEGU = 58 * MiB;
constexpr size_t WS_WEDN = 314 * MiB;
constexpr size_t WS_X = 442 * MiB;
constexpr size_t WS_H = 506 * MiB;
constexpr size_t WS_Y = 538 * MiB;
constexpr size_t WS_U = 570 * MiB;
constexpr size_t WS_Z = 602 * MiB;
constexpr size_t WS_Y2 = 634 * MiB;
constexpr size_t WS_YS = 666 * MiB;
constexpr size_t WS_ACT = 986 * MiB;
constexpr size_t WS_TOKL = 1066 * MiB;
constexpr size_t WS_WL = 1070 * MiB;
constexpr size_t WS_TSLOT = 1074 * MiB;
constexpr size_t WS_QKV = 1076 * MiB;
constexpr size_t WS_END = 1364 * MiB;
static_assert(WS_YS + (size_t)PSLOT * 2048 <= WS_ACT && WS_ACT + (size_t)PSLOT * 512 <= WS_TOKL, "ws map");
constexpr int CW_BAR = 4096;
constexpr int CW_CNT = 12288;

constexpr int RING_BYTES = 135168;
constexpr int LDSCTL_OFF = RING_BYTES;
constexpr int LDS_TB_OFF = 147456;
constexpr int LDS_BYTES = 163840;
constexpr int LC_MISC = 0;
constexpr int LC_TS = 128;
constexpr int LC_CNT = 128 + 272;
constexpr int LC_LCNT = 128 + 272 + 256;
constexpr int LC_GB = 128 + 272 + 512;

#define RLX_AGENT __ATOMIC_RELAXED, __HIP_MEMORY_SCOPE_AGENT
#define LDS_WAIT() asm volatile("s_waitcnt lgkmcnt(0)" ::: "memory")
#define VM_WAIT() asm volatile("s_waitcnt vmcnt(0)" ::: "memory")

typedef __bf16 b16x2 __attribute__((ext_vector_type(2)));
__device__ __forceinline__ unsigned f2bf(float f) { unsigned u = __builtin_bit_cast(unsigned, f); return (u + 0x7fffu + ((u >> 16) & 1u)) >> 16; }
__device__ __forceinline__ unsigned pk2(float lo, float hi) { const f32x2 v = {lo, hi}; return __builtin_bit_cast(unsigned, __builtin_convertvector(v, b16x2)); }
__device__ __forceinline__ float bf2f(unsigned h) { return __builtin_bit_cast(float, h << 16); }
__device__ __forceinline__ unsigned cvt_pk_bf16(float lo, float hi) { return pk2(lo, hi); }
typedef _Float16 h16x2 __attribute__((ext_vector_type(2)));
__device__ __forceinline__ unsigned pkh2(float lo, float hi) { const f32x2 v = {lo, hi}; return __builtin_bit_cast(unsigned, __builtin_convertvector(v, h16x2)); }
__device__ __forceinline__ float h2f(unsigned h) { return (float)__builtin_bit_cast(_Float16, (unsigned short)h); }
#define MFMA16(a, b, c) __builtin_amdgcn_mfma_f32_16x16x32_bf16(a, b, c, 0, 0, 0)
#define MFMA32(a, b, c) __builtin_amdgcn_mfma_f32_32x32x16_bf16(a, b, c, 0, 0, 0)
__device__ __forceinline__ float wave_sum(float v) {
#pragma unroll
    for (int o = 1; o < 64; o <<= 1) v += __shfl_xor(v, o);
    return v;
}

namespace pg8 {
constexpr int BM = 256, BK = 64, HALF = 128, HTB = HALF * BK * 2, STAGE_BYTES = 8 * HTB, NXCD = 8;
__host__ __device__ __forceinline__ int lds_byte(int r, int c) { const int st = (r >> 4) * 2 + (c >> 5), rr = r & 15, cc = c & 31, ob = rr * 64 + cc * 2; return st * 1024 + (ob ^ (((ob >> 9) & 1) << 5)); }
__host__ __device__ __forceinline__ void stage_rc(int b, int& R, int& C) { const int st = b / 1024, sb = b % 1024, swz = sb ^ (((sb >> 9) & 1) << 5); R = (st >> 1) * 16 + swz / 64; C = (st & 1) * 32 + (swz % 64) / 2; }
__host__ __device__ __forceinline__ int perm32(int rho) { const int n = rho >> 4, i = rho & 15; return 8 * (i >> 2) + 4 * n + (i & 3); }

struct Unit {
    int pm, pn;
    const char* bptr;
    int roff;
    int nvalid;
};

__device__ __forceinline__ int xcd_chunk(int L, int nwg) { const int q = nwg / NXCD, r = nwg % NXCD, xcd = L % NXCD, off = L / NXCD; return (xcd < r ? xcd * (q + 1) : r * (q + 1) + (xcd - r) * q) + off; }

template <class Epi, class Sched>
__device__ __forceinline__ void gemm_phase(const int tid, LAS unsigned char* lds, const char* Abase, const int lda, const int ldb, const int K, const Sched& S, const Epi& E) {
    constexpr bool GATHER = Sched::GATHER;
    const int wid = __builtin_amdgcn_readfirstlane(tid >> 6), lane = tid & 63, wr = wid >> 2, wc = wid & 3, fr = lane & 15, fq = lane >> 4;
    const int nt = K / BK;
    int Rr[2]; unsigned C2[2], voffB[2], voffA[2];
#pragma unroll
    for (int i = 0; i < 2; ++i) { int R, C; stage_rc(tid * 16 + i * 8192, R, C); const int Rb = Epi::WIDE ? ((R >> 5) * 64 + perm32(R & 31)) : ((R & ~31) + perm32(R & 31)); Rr[i] = R; C2[i] = (unsigned)C * 2u; voffB[i] = (unsigned)(Rb * ldb) + (unsigned)C * 2u;
        voffA[i] = Sched::ABLK ? (unsigned)((C >> 5) * 16384 + R * 64 + (C & 31) * 2) : ((unsigned)(R * lda) + (unsigned)C * 2u); }
    const size_t kstep = (size_t)(BK * 2);
    const size_t hstepB = (size_t)(Epi::WIDE ? 32 : HALF) * ldb;
    const size_t hstepA = GATHER ? (size_t)0 : (Sched::ABLK ? (size_t)8192 : (size_t)HALF * lda);
    const size_t kstepA = Sched::ABLK ? (size_t)32768 : kstep;
    const unsigned ldsw = (unsigned)wid * 1024u;
    const int aoff = lds_byte(wr * 64 + fr, fq * 8), boff = lds_byte(wc * 32 + fr, fq * 8);
#define PG8_SA(b, h) (((b) * 2 + (h)) * HTB)
#define PG8_SB(b, h) ((4 + (b) * 2 + (h)) * HTB)
#define PG8_STAGE(bufoff, gbase, voff) do { _Pragma("unroll") for (int _i = 0; _i < 2; ++_i) \
        __builtin_amdgcn_global_load_lds((const unsigned*)((const char*)(gbase) + (voff)[_i]), (LAS unsigned*)(lds + (bufoff) + ldsw + _i * 8192), 16, 0, 0); } while (0)
#define PG8_STAGEA(bufoff, gbase, h) do { if constexpr (GATHER) { PG8_STAGE(bufoff, gbase, vA[h]); } else { PG8_STAGE(bufoff, (gbase) + (h) * hstepA, voffA); } } while (0)
#define PG8_LDA(dst, b, h) do { _Pragma("unroll") for (int m = 0; m < 4; ++m) _Pragma("unroll") for (int k = 0; k < 2; ++k) dst[m][k] = *(const LAS bf16x8*)(lds + PG8_SA(b, h) + aoff + m * 2048 + k * 1024); } while (0)
#define PG8_LDB(dst, b, h) do { _Pragma("unroll") for (int n = 0; n < 2; ++n) _Pragma("unroll") for (int k = 0; k < 2; ++k) dst[n][k] = *(const LAS bf16x8*)(lds + PG8_SB(b, h) + boff + n * 2048 + k * 1024); } while (0)
#define PG8_MMA(ai, bj, At, Bt) do { __builtin_amdgcn_s_setprio(1); _Pragma("unroll") for (int m = 0; m < 4; ++m) _Pragma("unroll") for (int n = 0; n < 2; ++n) _Pragma("unroll") for (int k = 0; k < 2; ++k) \
        acc[ai][bj][m][n] = MFMA16(Bt[n][k], At[m][k], acc[ai][bj][m][n]); __builtin_amdgcn_s_setprio(0); } while (0)
#define PG8_WAIT_V(n) asm volatile("s_waitcnt vmcnt(" #n ")" ::: "memory")
#define PG8_WAIT_L(n) asm volatile("s_waitcnt lgkmcnt(" #n ")" ::: "memory")
#define PG8_BAR __builtin_amdgcn_s_barrier()
#define PG8_SCHED __builtin_amdgcn_sched_barrier(0)
#define PG8_CALCA(u, vo) do { _Pragma("unroll") for (int _h = 0; _h < 2; ++_h) _Pragma("unroll") for (int _i = 0; _i < 2; ++_i) \
        vo[_h][_i] = (unsigned)S.arow(u, _h * HALF + Rr[_i]) * (unsigned)lda + C2[_i]; } while (0)
    Unit cur, nxt; int ui = 0;
    if (!S.next(0, cur)) return;
    f32x4 acc[2][2][4][2];
#pragma unroll
    for (int a = 0; a < 2; ++a)
#pragma unroll
        for (int b = 0; b < 2; ++b)
#pragma unroll
            for (int m = 0; m < 4; ++m)
#pragma unroll
                for (int n = 0; n < 2; ++n) acc[a][b][m][n] = (f32x4){0.f, 0.f, 0.f, 0.f};
    bf16x8 At[4][2], B0[2][2], B1[2][2];
    unsigned vA[2][2], vAn[2][2];
    const char* cA = Abase;
    if constexpr (GATHER) { PG8_CALCA(cur, vA); } else { cA = Abase + (size_t)S.arow(cur, 0) * lda + S.acolb(cur); }
    const char* cB = cur.bptr;
    PG8_STAGE(PG8_SB(0, 0), cB, voffB); PG8_STAGE(PG8_SB(0, 1), cB + hstepB, voffB); PG8_STAGEA(PG8_SA(0, 0), cA, 0); PG8_STAGEA(PG8_SA(0, 1), cA, 1);
    if (wr == 1) PG8_BAR;
    PG8_WAIT_V(2); PG8_BAR;
    PG8_STAGE(PG8_SB(1, 0), cB + kstep, voffB); PG8_STAGEA(PG8_SA(1, 0), cA + kstepA, 0); PG8_STAGE(PG8_SB(1, 1), cB + hstepB + kstep, voffB);
    PG8_WAIT_V(6); PG8_BAR;
    for (;;) {
        const bool has_next = S.next(ui + 1, nxt);
        float rs[2][4];
        if constexpr (Epi::ROWSCALE) {
#pragma unroll
            for (int ai = 0; ai < 2; ++ai)
#pragma unroll
                for (int m = 0; m < 4; ++m) rs[ai][m] = S.rowscale(cur, ai * HALF + wr * 64 + m * 16 + fr);
        }
        const char* nA = cA;
        if constexpr (GATHER) {
            if (has_next) { PG8_CALCA(nxt, vAn); }
            else {
#pragma unroll
                for (int h = 0; h < 2; ++h)
#pragma unroll
                    for (int i = 0; i < 2; ++i) vAn[h][i] = vA[h][i];
            }
            asm volatile("s_waitcnt vmcnt(0)" : "+v"(vAn[0][0]), "+v"(vAn[0][1]), "+v"(vAn[1][0]), "+v"(vAn[1][1]) :: "memory");
            if constexpr (Epi::ROWSCALE) { asm volatile("" : "+v"(rs[0][0]), "+v"(rs[0][1]), "+v"(rs[0][2]), "+v"(rs[0][3]), "+v"(rs[1][0]), "+v"(rs[1][1]), "+v"(rs[1][2]), "+v"(rs[1][3])); }
        } else { if (has_next) nA = Abase + (size_t)S.arow(nxt, 0) * lda + S.acolb(nxt); }
        const char* nB = has_next ? nxt.bptr : cB;
#pragma unroll 1
        for (int t = 0; t < nt; t += 2) {
            const bool last = (t == nt - 2);
            const char* a1 = cA + (size_t)(t + 1) * kstepA;
            const char* a2 = last ? nA : cA + (size_t)(t + 2) * kstepA; const char* b2 = last ? nB : cB + (size_t)(t + 2) * kstep;
            const char* a3 = a2 + kstepA; const char* b3 = b2 + kstep;
            PG8_LDB(B0, 0, 0); PG8_LDB(B1, 0, 1); PG8_SCHED; PG8_LDA(At, 0, 0); PG8_STAGEA(PG8_SA(1, 1), a1, 1);
            if constexpr (GATHER) { if (last) {
#pragma unroll
                for (int h = 0; h < 2; ++h)
#pragma unroll
                    for (int i = 0; i < 2; ++i) vA[h][i] = vAn[h][i]; } }
            PG8_WAIT_V(8); PG8_WAIT_L(0); PG8_BAR; PG8_MMA(0, 0, At, B0); PG8_MMA(0, 1, At, B1); PG8_BAR; PG8_SCHED;
            PG8_LDA(At, 0, 1); PG8_STAGE(PG8_SB(0, 0), b2, voffB); PG8_STAGE(PG8_SB(0, 1), b2 + hstepB, voffB); PG8_STAGEA(PG8_SA(0, 0), a2, 0);
            PG8_WAIT_V(8); PG8_WAIT_L(0); PG8_BAR; PG8_MMA(1, 0, At, B0); PG8_MMA(1, 1, At, B1); PG8_BAR; PG8_SCHED;
            PG8_LDB(B0, 1, 0); PG8_LDB(B1, 1, 1); PG8_SCHED; PG8_LDA(At, 1, 0); PG8_STAGEA(PG8_SA(0, 1), a2, 1);
            PG8_WAIT_V(8); PG8_WAIT_L(0); PG8_BAR; PG8_MMA(0, 0, At, B0); PG8_MMA(0, 1, At, B1); PG8_BAR; PG8_SCHED;
            PG8_LDA(At, 1, 1); PG8_STAGE(PG8_SB(1, 0), b3, voffB); PG8_STAGE(PG8_SB(1, 1), b3 + hstepB, voffB); PG8_STAGEA(PG8_SA(1, 0), a3, 0);
            PG8_WAIT_V(8); PG8_WAIT_L(0); PG8_BAR; PG8_MMA(1, 0, At, B0); PG8_MMA(1, 1, At, B1); PG8_BAR; PG8_SCHED;
        }
        if (wr == 0) PG8_BAR;
        E(acc, cur, rs, wr, wc, fr, fq);
        if (!has_next) break;
#pragma unroll
        for (int a = 0; a < 2; ++a)
#pragma unroll
            for (int b = 0; b < 2; ++b)
#pragma unroll
                for (int m = 0; m < 4; ++m)
#pragma unroll
                    for (int n = 0; n < 2; ++n) acc[a][b][m][n] = (f32x4){0.f, 0.f, 0.f, 0.f};
        cur = nxt; cB = nB; cA = nA; ++ui;
        if (wr == 1) PG8_BAR;
    }
    PG8_WAIT_V(0);
    PG8_BAR;
#undef PG8_SA
#undef PG8_SB
#undef PG8_STAGE
#undef PG8_STAGEA
#undef PG8_LDA
#undef PG8_LDB
#undef PG8_MMA
#undef PG8_WAIT_V
#undef PG8_WAIT_L
#undef PG8_BAR
#undef PG8_SCHED
#undef PG8_CALCA
}

struct EpiStore {
    static constexpr bool ROWSCALE = false, WIDE = true;
    bf16* O; int ldc; const float* cscale; int qmode; int ntst; int f16; LAS unsigned char* tb;
    __device__ __forceinline__ void operator()(const f32x4 (&acc)[2][2][4][2], const Unit& u, const float (&rs)[2][4], int wr, int wc, int fr, int fq) const {
        const int colw = u.pn * BM + wc * 64;
        float sc = 1.f; if (qmode) { if ((((u.pn * BM) >> 10) % 3) == 0) sc = QSCALE; }
        f32x4 cs[2][2];
#pragma unroll
        for (int bj = 0; bj < 2; ++bj)
#pragma unroll
            for (int n = 0; n < 2; ++n) { cs[bj][n] = cscale ? *(const f32x4*)(cscale + colw + 32 * bj + 8 * fq + 4 * n) : (f32x4){1.f, 1.f, 1.f, 1.f}; cs[bj][n] = cs[bj][n] * sc; }
        const int L = fr + 16 * fq, rr = L >> 3, sg = L & 7;
        LAS u32x4* tbv = (LAS u32x4*)tb;
        const int wi0 = fr * 8 + (fq ^ (fr & 7)), wi1 = fr * 8 + ((4 + fq) ^ (fr & 7)), ri = rr * 8 + (sg ^ rr);
        bf16* gp = O + (size_t)(u.pm * BM + wr * 64 + rr) * ldc + colw + sg * 8;
#pragma unroll
        for (int ai = 0; ai < 2; ++ai)
#pragma unroll
            for (int m = 0; m < 4; ++m) {
                u32x4 w[2];
#pragma unroll
                for (int bj = 0; bj < 2; ++bj) { const f32x4 v0 = acc[ai][bj][m][0] * cs[bj][0], v1 = acc[ai][bj][m][1] * cs[bj][1];
                    if (f16) { w[bj].x = pkh2(v0[0], v0[1]); w[bj].y = pkh2(v0[2], v0[3]); w[bj].z = pkh2(v1[0], v1[1]); w[bj].w = pkh2(v1[2], v1[3]); }
                    else { w[bj].x = cvt_pk_bf16(v0[0], v0[1]); w[bj].y = cvt_pk_bf16(v0[2], v0[3]); w[bj].z = cvt_pk_bf16(v1[0], v1[1]); w[bj].w = cvt_pk_bf16(v1[2], v1[3]); } }
                tbv[wi0] = w[0]; tbv[wi1] = w[1];
                asm volatile("" ::: "memory");
                const u32x4 r0 = tbv[ri], r1 = tbv[ri + 64];
                asm volatile("" ::: "memory");
                bf16* rowp = gp + (size_t)(ai * HALF + m * 16) * ldc;
                if (ntst) { __builtin_nontemporal_store(r0, (u32x4*)rowp); __builtin_nontemporal_store(r1, (u32x4*)(rowp + (size_t)8 * ldc)); }
                else { *(u32x4*)rowp = r0; *(u32x4*)(rowp + (size_t)8 * ldc) = r1; } }
    }
};
typedef unsigned u32x2_t __attribute__((ext_vector_type(2)));
struct EpiStoreF8 {
    static constexpr bool ROWSCALE = false, WIDE = true;
    unsigned char* O; int ldc; LAS unsigned char* tb; int qmode;
    __device__ __forceinline__ void operator()(const f32x4 (&acc)[2][2][4][2], const Unit& u, const float (&rs)[2][4], int wr, int wc, int fr, int fq) const {
        const int colw = u.pn * BM + wc * 64;
        const float osc = qmode ? (((((u.pn * BM) >> 10) % 3) == 0) ? QSCALE * 64.0f : 16.0f) : 32.0f;
        const int L = fr + 16 * fq, rr = L >> 2, sg = L & 3;
        LAS unsigned char* wp0 = tb + fr * 64 + ((fq) ^ (fr & 7)) * 8; LAS unsigned char* wp1 = tb + fr * 64 + ((4 + fq) ^ (fr & 7)) * 8;
        const LAS unsigned char* rp0 = tb + rr * 64 + ((2 * sg) ^ (rr & 7)) * 8; const LAS unsigned char* rp1 = tb + rr * 64 + ((2 * sg + 1) ^ (rr & 7)) * 8;
        unsigned char* gp = O + (size_t)(u.pm * BM + wr * 64 + rr) * ldc + colw + sg * 16;
#pragma unroll
        for (int ai = 0; ai < 2; ++ai)
#pragma unroll
            for (int m = 0; m < 4; ++m) {
                u32x2_t w[2];
#pragma unroll
                for (int bj = 0; bj < 2; ++bj) { f32x4 v0 = acc[ai][bj][m][0] * osc, v1 = acc[ai][bj][m][1] * osc;
#pragma unroll
                    for (int e = 0; e < 4; ++e) { v0[e] = __builtin_amdgcn_fmed3f(v0[e], -448.0f, 448.0f); v1[e] = __builtin_amdgcn_fmed3f(v1[e], -448.0f, 448.0f); }
                    int p0 = __builtin_amdgcn_cvt_pk_fp8_f32(v0[0], v0[1], 0, false); p0 = __builtin_amdgcn_cvt_pk_fp8_f32(v0[2], v0[3], p0, true);
                    int p1 = __builtin_amdgcn_cvt_pk_fp8_f32(v1[0], v1[1], 0, false); p1 = __builtin_amdgcn_cvt_pk_fp8_f32(v1[2], v1[3], p1, true);
                    w[bj].x = (unsigned)p0; w[bj].y = (unsigned)p1; }
                *(LAS u32x2_t*)wp0 = w[0]; *(LAS u32x2_t*)wp1 = w[1];
                asm volatile("" ::: "memory");
                const u32x2_t a = *(const LAS u32x2_t*)rp0, b = *(const LAS u32x2_t*)rp1;
                asm volatile("" ::: "memory");
                u32x4 o; o.x = a.x; o.y = a.y; o.z = b.x; o.w = b.y;
                __builtin_nontemporal_store(o, (GAS u32x4*)(gp + (size_t)(ai * HALF + m * 16) * ldc)); }
    }
};
struct EpiGU {
    static constexpr bool ROWSCALE = false, WIDE = false;
    bf16* O;
    __device__ __forceinline__ void operator()(const f32x4 (&acc)[2][2][4][2], const Unit& u, const float (&rs)[2][4], int wr, int wc, int fr, int fq) const {
        bf16* tp = O + (size_t)u.pm * (BM * DEXP) + (size_t)(u.pn * 4 + wc) * (BM * 32) + (wr * 64 + fr) * 32 + 8 * fq;
#pragma unroll
        for (int ai = 0; ai < 2; ++ai)
#pragma unroll
            for (int m = 0; m < 4; ++m) { bf16* rowp = tp + (ai * HALF + m * 16) * 32;
                float o[8];
#pragma unroll
                for (int n = 0; n < 2; ++n)
#pragma unroll
                    for (int j = 0; j < 4; ++j) { const float g = acc[ai][0][m][n][j], uu = acc[ai][1][m][n][j];
                        const float sg = g * __builtin_amdgcn_rcpf(1.0f + __builtin_amdgcn_exp2f(-g * LOG2E)); o[n * 4 + j] = sg * uu; }
                u32x4 wv; wv.x = cvt_pk_bf16(o[0], o[1]); wv.y = cvt_pk_bf16(o[2], o[3]); wv.z = cvt_pk_bf16(o[4], o[5]); wv.w = cvt_pk_bf16(o[6], o[7]);
                *(u32x4*)rowp = wv; }
    }
};
}

#define XB_TMO      128
#define XB_XCNT(j)  (256  + 64 * (j))
#define XB_XSUB(j)  (1280 + 64 * (j))
#define XB_XGEN(j)  (2304 + 64 * (j))
#define XB_TOP      3328
#define XB_TOPGEN   3392
#define XB_LSUB(j)  (3456 + 64 * (j))
#define XB_LGEN(j)  (4480 + 64 * (j))
#define XCD_BAR_WORDS 5504
#define XB_SPIN_CAP (1u << 18)
__device__ __forceinline__ unsigned xb_ld(unsigned* p)              { return __hip_atomic_load(p, __ATOMIC_RELAXED, __HIP_MEMORY_SCOPE_AGENT); }
__device__ __forceinline__ unsigned xb_add(unsigned* p, unsigned v) { return __hip_atomic_fetch_add(p, v, __ATOMIC_RELAXED, __HIP_MEMORY_SCOPE_AGENT); }
__device__ __forceinline__ unsigned xb_xcc_id() { return (unsigned)__builtin_amdgcn_s_getreg((3 << 11) | 20) & 0xFu; }
#define XB_SPIN(cond, bar) do { unsigned _sp = 0; while (cond) { __builtin_amdgcn_s_sleep(1); \
    if ((++_sp & 255u) == 0u) { if (xb_ld(&(bar)[XB_TMO])) break; if (_sp > XB_SPIN_CAP) { atomicAdd(&(bar)[XB_TMO], 1u); break; } } } } while (0)
struct XcdBarrier { unsigned* bar; unsigned x; volatile LAS unsigned* st; };
__device__ __forceinline__ XcdBarrier xcd_barrier_post(unsigned* bar, volatile LAS unsigned* st) {
    XcdBarrier b; b.bar = bar; b.x = xb_xcc_id(); b.st = st;
    if (threadIdx.x == 0) st[2] = xb_add(&bar[XB_XCNT(b.x)], 1u);
    return b;
}
__device__ __forceinline__ void xcd_local_barrier(const XcdBarrier& b, const bool wave0) {
    asm volatile("s_waitcnt vmcnt(0)" ::: "memory");
    __syncthreads();
    if (wave0 && __builtin_amdgcn_mbcnt_hi(~0u, __builtin_amdgcn_mbcnt_lo(~0u, 0u)) == 0u) {
        unsigned* bar = b.bar;
        __builtin_amdgcn_s_waitcnt(0);
        const unsigned nloc = b.st[0];
        const unsigned old = xb_add(&bar[XB_LSUB(b.x)], 1u);
        const unsigned gen = old / nloc;
        if (old + 1u == (gen + 1u) * nloc) xb_add(&bar[XB_LGEN(b.x)], 1u);
        else XB_SPIN(xb_ld(&bar[XB_LGEN(b.x)]) == gen, bar);
        __builtin_amdgcn_fence(__ATOMIC_ACQUIRE, "agent");
        asm volatile("s_waitcnt vmcnt(0)" ::: "memory");
    }
    __syncthreads();
}
__device__ __forceinline__ void xcd_barrier_complete(unsigned* bar, unsigned x, unsigned& nloc, unsigned& nx) {
    const unsigned G = gridDim.x * gridDim.y * gridDim.z;
    unsigned sum, cnt, mine, sp = 0u;
    for (;;) {
        sum = 0u; cnt = 0u; mine = 0u;
#pragma unroll
        for (unsigned j = 0; j < 16; ++j) { const unsigned c = xb_ld(&bar[XB_XCNT(j)]); sum += c; cnt += (c > 0u) ? 1u : 0u; mine = (j == x) ? c : mine; }
        if (sum == G) break;
        __builtin_amdgcn_s_sleep(1);
        if ((++sp & 255u) == 0u) { if (xb_ld(&bar[XB_TMO])) break; if (sp > XB_SPIN_CAP) { atomicAdd(&bar[XB_TMO], 1u); break; } }
    }
    nloc = mine > 0u ? mine : 1u; nx = cnt > 0u ? cnt : 1u;
}
__device__ __forceinline__ void xcd_barrier(const XcdBarrier& b) {
    asm volatile("s_waitcnt vmcnt(0)" ::: "memory");
    __syncthreads();
    if (threadIdx.x == 0) {
        unsigned* bar = b.bar;
        __builtin_amdgcn_s_waitcnt(0);
        unsigned nloc = b.st[0], nx = b.st[1];
        if (nloc == 0u) { xcd_barrier_complete(bar, b.x, nloc, nx); b.st[0] = nloc; b.st[1] = nx; }
        const unsigned old = xb_add(&bar[XB_XSUB(b.x)], 1u);
        const unsigned gen = old / nloc;
        if (old + 1u == (gen + 1u) * nloc) {
            __builtin_amdgcn_fence(__ATOMIC_RELEASE, "agent");
            asm volatile("s_waitcnt vmcnt(0)" ::: "memory");
            const unsigned og = xb_add(&bar[XB_TOP], 1u);
            const unsigned tg = og / nx;
            if (og + 1u == (tg + 1u) * nx) xb_add(&bar[XB_TOPGEN], 1u);
            else XB_SPIN(xb_ld(&bar[XB_TOPGEN]) == tg, bar);
            __builtin_amdgcn_fence(__ATOMIC_ACQUIRE, "agent");
            xb_add(&bar[XB_XGEN(b.x)], 1u);
            asm volatile("s_waitcnt vmcnt(0)" ::: "memory");
        } else {
            XB_SPIN(xb_ld(&bar[XB_XGEN(b.x)]) == gen, bar);
            __builtin_amdgcn_fence(__ATOMIC_ACQUIRE, "agent");
            asm volatile("s_waitcnt vmcnt(0)" ::: "memory");
        }
    }
    __syncthreads();
}

constexpr int NWAVES = 8;
struct Frame {
    LAS unsigned char* lds;
    LAS unsigned char* lc;
    unsigned* ctl;
    unsigned char* ws;
    int tid, lane, wave, vcu, G;
};
constexpr int LC_PTR = 2048;
__device__ __forceinline__ const float* inp(const Frame& F, int i) {
    const unsigned long long v = *(const LAS unsigned long long*)(F.lc + LC_PTR + 8 * i);
    const unsigned lo = __builtin_amdgcn_readfirstlane((unsigned)v), hi = __builtin_amdgcn_readfirstlane((unsigned)(v >> 32));
    return (const float*)(const GAS float*)(((unsigned long long)hi << 32) | lo);
}
__device__ __forceinline__ unsigned char* opq(unsigned char* p) { GAS unsigned char* g = (GAS unsigned char*)p; asm volatile("" : "+s"(g)); return (unsigned char*)g; }
__device__ __forceinline__ void refresh(Frame& F) { asm volatile("" : "+v"(F.tid)); F.lane = F.tid & 63; F.wave = __builtin_amdgcn_readfirstlane(F.tid >> 6); }

struct PlainSched {   static constexpr bool GATHER = false, ABLK = false;
    int nM, nN, nwg, G, c; const char* B; int ldb;
    __device__ __forceinline__ bool next(int i, pg8::Unit& u) const {
        const int L = i * G + c; if (L >= nwg) return false;
        const int wgid = pg8::xcd_chunk(L, nwg);
        const int nig = 8 * nN, gid = wgid / nig, fm = gid * 8, gsz = (nM - fm) < 8 ? (nM - fm) : 8;
        u.pm = fm + ((wgid % nig) % gsz); u.pn = (wgid % nig) / gsz;
        u.bptr = B + (size_t)u.pn * 256 * ldb; u.roff = -(u.pm * 256) - 1; u.nvalid = 256; return true;
    }
    __device__ __forceinline__ int arow(const pg8::Unit& u, int r) const { return -u.roff - 1 + r; }
    __device__ __forceinline__ int acolb(const pg8::Unit&) const { return 0; }
    __device__ __forceinline__ float rowscale(const pg8::Unit&, int) const { return 1.0f; }
};
struct GrpSched {     static constexpr bool GATHER = false, ABLK = false;
    int G, c; const char* B;
    __device__ __forceinline__ bool next(int i, pg8::Unit& u) const {
        const int L = i * G + c; if (L >= 256) return false;
        const int wgid = pg8::xcd_chunk(L, 256);
        u.pm = wgid >> 2; u.pn = wgid & 3; u.bptr = B + (size_t)u.pn * 256 * 512; u.roff = -(u.pm * 256) - 1; u.nvalid = 256; return true;
    }
    __device__ __forceinline__ int arow(const pg8::Unit& u, int r) const { return -u.roff - 1 + r; }
    __device__ __forceinline__ int acolb(const pg8::Unit& u) const { return u.pn * 512; }
    __device__ __forceinline__ float rowscale(const pg8::Unit&, int) const { return 1.0f; }
};
template <bool GATHER_> struct MoeSched {     static constexpr bool GATHER = GATHER_, ABLK = !GATHER_;
    const LAS int* ts; const LAS int* cn; int npn, nunits, G, c, lane_;
    const int* tokl; const float* wl; const char* Bexp; size_t bstride; const char* Bsh; int ldb;
    __device__ __forceinline__ bool next(int i, pg8::Unit& u) const {
        const int L = i * G + c; const int xg = L % pg8::NXCD, off = L / pg8::NXCD;
        const int ntile = nunits / npn, tq = ntile / pg8::NXCD, tr = ntile % pg8::NXCD;
        const int tcnt = tq + (xg < tr ? 1 : 0), tstart = xg * tq + (xg < tr ? xg : tr);
        if (off >= tcnt * npn) return false;
        const int tile = tstart + off / npn, pn = off % npn;
        const int lane = lane_;
        const bool hit = (tile >= ts[lane]) && (tile < ts[lane + 1]);
        const unsigned long long mk = __ballot(hit);
        const int e = mk ? (int)__builtin_ctzll(mk) : 64;
        const int tse = __builtin_amdgcn_readfirstlane(ts[e]);
        const int r0 = (tile - tse) * 256;
        u.pm = tile; u.pn = pn;
        u.bptr = (e < 64 ? Bexp + (size_t)e * bstride : Bsh) + (size_t)pn * 256 * ldb;
        if (GATHER) {
            if (e < 64) { const int ce = __builtin_amdgcn_readfirstlane(cn[e]); u.roff = e * CAP + r0; u.nvalid = (ce - r0) < 256 ? (ce - r0) : 256; }
            else { u.roff = -r0 - 1; u.nvalid = 256; }
        } else { u.roff = -(tile * 256) - 1; u.nvalid = 256; }
        return true;
    }
    __device__ __forceinline__ int arow(const pg8::Unit& u, int r) const { if (GATHER && u.roff >= 0) { const int rr = r < u.nvalid ? r : u.nvalid - 1; return tokl[u.roff + rr]; } return -u.roff - 1 + r; }
    __device__ __forceinline__ int acolb(const pg8::Unit&) const { return 0; }
    __device__ __forceinline__ float rowscale(const pg8::Unit& u, int r) const { if (GATHER && u.roff >= 0) { const int rr = r < u.nvalid ? r : u.nvalid - 1; return wl[u.roff + rr]; } return 1.0f; }
};

__device__ __forceinline__ void p0_transpose_item64(const float* W, int K, int N, bf16* WT, int dst_n0, LAS float* scr, int kb, int nb, int lane) {
    const int k0 = 64 * kb, n0 = 64 * nb; const int r = lane >> 4, c4 = lane & 15;
    f32x4 v[16];
#pragma unroll
    for (int i = 0; i < 16; ++i) v[i] = __builtin_nontemporal_load((const GAS f32x4*)(W + (size_t)(k0 + 4 * i + r) * N + n0 + 4 * c4));
#pragma unroll
    for (int i = 0; i < 16; ++i) { const int k = 4 * i + r; *(LAS f32x4*)(scr + k * 64 + 4 * (c4 ^ (k >> 3))) = v[i]; }
    LDS_WAIT(); asm volatile("" ::: "memory");
    const int c = lane & 7;
#pragma unroll
    for (int j = 0; j < 8; ++j) { const int n = (lane >> 3) + 8 * j; const LAS float* sp = scr + (8 * c) * 64 + 4 * ((n >> 2) ^ c) + (n & 3);
        u32x4 o; o.x = pk2(sp[0 * 64], sp[1 * 64]); o.y = pk2(sp[2 * 64], sp[3 * 64]); o.z = pk2(sp[4 * 64], sp[5 * 64]); o.w = pk2(sp[6 * 64], sp[7 * 64]);
        *(GAS u32x4*)(WT + (size_t)(dst_n0 + n) * K + k0 + 8 * c) = o; }
    LDS_WAIT(); asm volatile("" ::: "memory");
}
__device__ __forceinline__ void p0_router_item(const float* W, bf16* WH, bf16* WLo, LAS float* scr, int kb, int nb, int lane) {
    const int K = 1024, N = 64; const int k0 = 64 * kb, n0 = 32 * nb;
#pragma unroll 8
    for (int i = 0; i < 32; ++i) { const int kk = 2 * i + (lane >> 5); scr[kk * 33 + (lane & 31)] = W[(size_t)(k0 + kk) * N + n0 + (lane & 31)]; }
    LDS_WAIT(); asm volatile("" ::: "memory");
    const int c = lane & 7;
#pragma unroll
    for (int j = 0; j < 4; ++j) { const int n = (lane >> 3) + 8 * j; const LAS float* s = scr + (8 * c) * 33 + n;
        unsigned h[8], l[8];
#pragma unroll
        for (int q = 0; q < 8; ++q) { const float v = s[q * 33]; h[q] = f2bf(v); l[q] = f2bf(v - bf2f(h[q])); }
        u32x4 oh, ol; oh.x = h[0] | (h[1] << 16); oh.y = h[2] | (h[3] << 16); oh.z = h[4] | (h[5] << 16); oh.w = h[6] | (h[7] << 16);
        ol.x = l[0] | (l[1] << 16); ol.y = l[2] | (l[3] << 16); ol.z = l[4] | (l[5] << 16); ol.w = l[6] | (l[7] << 16);
        *(GAS u32x4*)(WH + (size_t)(n0 + n) * K + k0 + 8 * c) = oh; *(GAS u32x4*)(WLo + (size_t)(n0 + n) * K + k0 + 8 * c) = ol; }
    LDS_WAIT(); asm volatile("" ::: "memory");
}

__device__ __forceinline__ void p0_prologue(Frame& F) {
    LAS float* cs = (LAS float*)(F.lds);
    LAS float* part = (LAS float*)(F.lds + 32768);
    const float* c = inp(F, 1);
    for (int i = F.tid; i < 8 * 1024; i += 512) { const float v = c[i]; cs[i] = v / (1.0f + __expf(-v)); }
    __syncthreads();
    float* mod = (float*)(F.ws + WS_MOD);
    for (int it = F.vcu; it < 4 * 96; it += F.G) {
        const int layer = it / 96, slab = it % 96; const int col = slab * 64 + F.lane;
        const float* W = inp(F, 2) + (size_t)layer * 1024 * 6144 + col;
        float a[8];
#pragma unroll
        for (int b = 0; b < 8; ++b) a[b] = 0.f;
        const int k0 = F.wave * 128;
#pragma unroll 4
        for (int k = 0; k < 128; k += 4) {
            float w[4];
#pragma unroll
            for (int j = 0; j < 4; ++j) w[j] = W[(size_t)(k0 + k + j) * 6144];
#pragma unroll
            for (int b = 0; b < 8; ++b) { const f32x4 cv = *(const LAS f32x4*)(cs + b * 1024 + k0 + k); a[b] += cv[0] * w[0] + cv[1] * w[1] + cv[2] * w[2] + cv[3] * w[3]; }
        }
#pragma unroll
        for (int b = 0; b < 8; ++b) part[(F.wave * 8 + b) * 64 + F.lane] = a[b];
        __syncthreads();
        { const int b = F.wave; float s = 0.f;
#pragma unroll
          for (int w = 0; w < 8; ++w) s += part[(w * 8 + b) * 64 + F.lane];
          mod[((size_t)layer * 8 + b) * 6144 + col] = s + inp(F, 3)[layer * 6144 + col]; }
        __syncthreads();
    }
    __syncthreads();
    LAS float* scr = (LAS float*)(F.lds + F.wave * 16384);
    const int gw = F.vcu * NWAVES + F.wave, NGW = F.G * NWAVES;
    constexpr int I_PIN = 2 * 16 * 16, I_GRP = 8 * 4 * 4, I_POUT = I_PIN, I_AIN = 2 * 16 * 144, I_AOUT = I_PIN, I_SHGU = 4 * 16 * 8, I_SHDN = 4 * 4 * 16, I_R = 4 * 16 * 2;
    constexpr int I_EGU = 256 * 16 * 8, I_EDN = 256 * 4 * 16;
    constexpr int NITEMS = I_PIN + I_GRP + I_POUT + I_AIN + I_AOUT + I_SHGU + I_SHDN + I_R + I_EGU + I_EDN;
    for (int it = gw; it < NITEMS; it += NGW) {
        int r = it;
#define P0_GROUP(CNT, SRC, KK, NN, DST, GU) if (r < (CNT)) { const int per = ((KK) / 64) * ((NN) / 64), mat = r / per, q = r % per, nblk = (NN) / 64, kblk = (KK) / 64, nb = q / kblk, kb = q % kblk; (void)nblk; \
            int dn0 = 64 * nb; if (GU) { const int n0 = 64 * nb; dn0 = (n0 < 256) ? ((n0 >> 7) * 256 + (n0 & 127)) : (((n0 - 256) >> 7) * 256 + 128 + ((n0 - 256) & 127)); } \
            p0_transpose_item64((SRC) + (size_t)mat * (KK) * (NN), (KK), (NN), (bf16*)(F.ws + (DST)) + (size_t)mat * (KK) * (NN), dn0, scr, kb, nb, F.lane); continue; } r -= (CNT);
        P0_GROUP(I_PIN, inp(F, 4), 1024, 1024, WS_WPIN, 0)
        P0_GROUP(I_GRP, inp(F, 5), 256, 256, WS_WPGRP, 0)
        P0_GROUP(I_POUT, inp(F, 7), 1024, 1024, WS_WPOUT, 0)
        P0_GROUP(I_AIN, inp(F, 8), 1024, 9216, WS_WAIN, 0)
        P0_GROUP(I_AOUT, inp(F, 9), 1024, 1024, WS_WAOUT, 0)
        P0_GROUP(I_SHGU, inp(F, 16), 1024, 512, WS_WSHGU, 1)
        P0_GROUP(I_SHDN, inp(F, 17), 256, 1024, WS_WSHDN, 0)
        if (r < I_R) { const int mat = r / 32, q = r % 32, kb = q / 2, nb = q % 2;
            p0_router_item(inp(F, 12) + (size_t)mat * 65536, (bf16*)(F.ws + WS_WRHI) + (size_t)mat * 65536, (bf16*)(F.ws + WS_WRLO) + (size_t)mat * 65536, scr, kb, nb, F.lane); continue; } r -= I_R;
        P0_GROUP(I_EGU, inp(F, 14), 1024, 512, WS_WEGU, 1)
        P0_GROUP(I_EDN, inp(F, 15), 256, 1024, WS_WEDN, 0)
#undef P0_GROUP
    }
}

__device__ __forceinline__ void p1_modulate(Frame& F, const float* x, const float* modl  , int sh_off, int sc_off) {
    bf16* H = (bf16*)(F.ws + WS_H);
    const int gw = F.vcu * NWAVES + F.wave, NGW = F.G * NWAVES;
    for (int m = gw; m < T; m += NGW) {
        const int b = m / SEQ; const float* mb = modl + (size_t)b * 6144;
        const GAS f32x4* xr = (const GAS f32x4*)(x + (size_t)m * D) + F.lane;
        GAS u32x2* o8 = (GAS u32x2*)(H + (size_t)m * D) + F.lane;
#pragma unroll
        for (int j = 0; j < 4; ++j) { const f32x4 v = xr[64 * j]; const f32x4 sc = *(const f32x4*)(mb + sc_off + 4 * F.lane + 256 * j), sh = *(const f32x4*)(mb + sh_off + 4 * F.lane + 256 * j);
            const f32x4 h = v * (sc + 1.0f) + sh; u32x2 w; w.x = pk2(h[0], h[1]); w.y = pk2(h[2], h[3]); o8[64 * j] = w; }
    }
}

template <int W>
__device__ __forceinline__ void pool_item(const bf16* U, bf16* Z, int b, int t0, int g, int lane) {
    const size_t base = (size_t)b * SEQ * D + 256 * g + 4 * lane;
    float s[4] = {0.f, 0.f, 0.f, 0.f};
#pragma unroll
    for (int j = 1; j <= W; ++j) { const int t = t0 - j; if (t >= 0) { const u32x2 v = *(const GAS u32x2*)(U + base + (size_t)t * D);
            s[0] += bf2f(v.x & 0xffffu); s[1] += bf2f(v.x >> 16); s[2] += bf2f(v.y & 0xffffu); s[3] += bf2f(v.y >> 16); } }
#pragma unroll 8
    for (int i = 0; i < 32; ++i) { const int t = t0 + i;
        const u32x2 v = *(const GAS u32x2*)(U + base + (size_t)t * D);
        const float c0 = bf2f(v.x & 0xffffu), c1 = bf2f(v.x >> 16), c2 = bf2f(v.y & 0xffffu), c3 = bf2f(v.y >> 16);
        s[0] += c0; s[1] += c1; s[2] += c2; s[3] += c3;
        if (t - W >= 0) { const u32x2 o = *(const GAS u32x2*)(U + base + (size_t)(t - W) * D);
            s[0] -= bf2f(o.x & 0xffffu); s[1] -= bf2f(o.x >> 16); s[2] -= bf2f(o.y & 0xffffu); s[3] -= bf2f(o.y >> 16); }
        const float inv = 1.0f / (float)((t + 1) < W ? (t + 1) : W);
        u32x2 w; w.x = pk2(s[0] * inv - c0, s[1] * inv - c1); w.y = pk2(s[2] * inv - c2, s[3] * inv - c3);
        *(GAS u32x2*)(Z + base + (size_t)t * D) = w; }
}

__device__ __forceinline__ void moe_build_table(Frame& F, int layer) {
    LAS int* ts = (LAS int*)(F.lc + LC_TS); LAS int* cn = (LAS int*)(F.lc + LC_CNT);
    __syncthreads();
    if (F.wave == 0) {
        const int c = (int)__hip_atomic_load(F.ctl + CW_CNT + layer * 64 + F.lane, RLX_AGENT);
        int t = (c + 255) >> 8;
#pragma unroll
        for (int o = 1; o < 64; o <<= 1) { const int v = __shfl_up(t, o); if (F.lane >= o) t += v; }
        cn[F.lane] = c; ts[F.lane + 1] = t;
        if (F.lane == 0) ts[0] = 0;
        if (F.lane == 63) ts[65] = t + 64;
    }
    __syncthreads();
}

#ifdef PROBE_TYPE
#define LSTAMP(ty) do { if (blockIdx.x == 0 && F.tid == 0) { const unsigned long long now_ = __builtin_amdgcn_s_memrealtime(); LAS unsigned long long* st_ = (LAS unsigned long long*)(F.lc + 3072); \
        st_[1 + (ty)] += now_ - st_[20]; st_[20] = now_; } } while (0)
#define LSTAMP0() do { if (blockIdx.x == 0 && F.tid == 0) { ((LAS unsigned long long*)(F.lc + 3072))[20] = __builtin_amdgcn_s_memrealtime(); } } while (0)
#else
#define LSTAMP(ty) do { } while (0)
#define LSTAMP0() do { } while (0)
#endif
constexpr int APITCH = 1032;
#define LDS_ONLY_BARRIER() do { asm volatile("s_waitcnt lgkmcnt(0)" ::: "memory"); __builtin_amdgcn_s_barrier(); asm volatile("" ::: "memory"); } while (0)
template <bool X16>
__device__ __forceinline__ void ln1_router_phase(Frame& F, int layer, const float* xin) {
    bf16* X = (bf16*)(F.ws + WS_X);
    bf16* H = (bf16*)(F.ws + WS_H); const bf16* Y = (const bf16*)(F.ws + WS_Y);
    const float* modl = (const float*)(F.ws + WS_MOD) + (size_t)layer * 8 * 6144;
    const float* lg = inp(F, 10) + layer * D; const float* lb = inp(F, 11) + layer * D;
    const float* rb = inp(F, 13) + layer * NE;
    const bf16* WH = (const bf16*)(F.ws + WS_WRHI) + (size_t)layer * 65536; const bf16* WLo = (const bf16*)(F.ws + WS_WRLO) + (size_t)layer * 65536;
    int* tokl = (int*)(F.ws + WS_TOKL); float* wl = (float*)(F.ws + WS_WL); int* tslot = (int*)(F.ws + WS_TSLOT);
    unsigned* gcnt = F.ctl + CW_CNT + layer * 64;
    LAS bf16* Ahi = (LAS bf16*)F.lds; LAS bf16* Alo = Ahi + 32 * APITCH;
    LAS float* PART = (LAS float*)F.lds;
    LAS float* PV = (LAS float*)(F.lds + LDS_TB_OFF);
    LAS int* lcnt = (LAS int*)(F.lc + LC_LCNT); LAS int* gb = (LAS int*)(F.lc + LC_GB);
    const int lane = F.lane, wave = F.wave;
    const int nblk = (T / 32) / F.G;
#define LN1_BLK(bi_) ((F.G == 256) ? ((F.vcu >> 5) * 64 + (F.vcu & 31) * 2 + (bi_)) : (F.vcu + (bi_) * F.G))
    constexpr int NX = X16 ? 2 : 4;
    u32x4 xr[4][NX], yv[4][2];
#define LN1_LOAD(bi_) do { const int t0_ = LN1_BLK(bi_) * 32 + wave * 4; \
        _Pragma("unroll") for (int q = 0; q < 4; ++q) _Pragma("unroll") for (int j = 0; j < 2; ++j) { const size_t o_ = (size_t)(t0_ + q) * D + 8 * lane + 512 * j; \
            if constexpr (X16) xr[q][j] = __builtin_nontemporal_load((const GAS u32x4*)((const bf16*)xin + o_)); \
            else { xr[q][2 * j] = *(const GAS u32x4*)(xin + o_); xr[q][2 * j + 1] = *(const GAS u32x4*)(xin + o_ + 4); } \
            yv[q][j] = __builtin_nontemporal_load((const GAS u32x4*)(Y + o_)); } } while (0)
    LN1_LOAD(0);
    const float rbe = rb[lane];
    { const int b = (LN1_BLK(0) * 32) / SEQ; const float* mb = modl + (size_t)b * 6144;
      for (int i = F.tid; i < 1024; i += NWAVES * 64) { const int v = i >> 8, c4 = (i & 255) * 4;
          const float* src = (v == 0) ? lg : (v == 1) ? lb : (v == 2) ? (mb + 4096) : (mb + 3072);
          f32x4 t = *(const GAS f32x4*)(src + c4); if (v == 2) t = t + 1.0f; *(LAS f32x4*)(PV + v * 1024 + c4) = t; } }
    __syncthreads();
    for (int bi = 0; bi < nblk; ++bi) {
        const int blk = LN1_BLK(bi);
        const int tok0 = blk * 32;
        LSTAMP0();
        bf16x8 bh[8][2], bl[8][2];
        {
            const int b = tok0 / SEQ; const float* mb = modl + (size_t)b * 6144;
            f32x4 xv[4][4];
            f32x4 pg1[4];
#pragma unroll
            for (int jj = 0; jj < 4; ++jj) pg1[jj] = *(const GAS f32x4*)(mb + 2048 + 8 * lane + 512 * (jj >> 1) + 4 * (jj & 1)) + 1.0f;
            float sm[4];
#pragma unroll
            for (int q = 0; q < 4; ++q) { float s = 0.f;
#pragma unroll
                for (int jj = 0; jj < 4; ++jj) { const unsigned w0 = (jj & 1) ? yv[q][jj >> 1].z : yv[q][jj >> 1].x, w1 = (jj & 1) ? yv[q][jj >> 1].w : yv[q][jj >> 1].y;
                    f32x4 y4; y4[0] = h2f(w0 & 0xffffu); y4[1] = h2f(w0 >> 16); y4[2] = h2f(w1 & 0xffffu); y4[3] = h2f(w1 >> 16);
                    f32x4 x4;
                    if constexpr (X16) { const unsigned v0 = (jj & 1) ? xr[q][jj >> 1].z : xr[q][jj >> 1].x, v1 = (jj & 1) ? xr[q][jj >> 1].w : xr[q][jj >> 1].y;
                        x4 = (f32x4){h2f(v0 & 0xffffu), h2f(v0 >> 16), h2f(v1 & 0xffffu), h2f(v1 >> 16)}; }
                    else { const u32x4 v = xr[q][jj]; x4 = (f32x4){__uint_as_float(v.x), __uint_as_float(v.y), __uint_as_float(v.z), __uint_as_float(v.w)}; }
                    xv[q][jj] = x4 * ALPHA + pg1[jj] * y4; s += (xv[q][jj][0] + xv[q][jj][1]) + (xv[q][jj][2] + xv[q][jj][3]); }
                sm[q] = s; }
#pragma unroll
            for (int o = 1; o < 64; o <<= 1) {
#pragma unroll
                for (int q = 0; q < 4; ++q) sm[q] += __shfl_xor(sm[q], o); }
            float s2[4];
#pragma unroll
            for (int q = 0; q < 4; ++q) { const float mean = sm[q] * (1.f / D); float t = 0.f;
#pragma unroll
                for (int jj = 0; jj < 4; ++jj) { xv[q][jj] = xv[q][jj] - mean; t += (xv[q][jj][0] * xv[q][jj][0] + xv[q][jj][1] * xv[q][jj][1]) + (xv[q][jj][2] * xv[q][jj][2] + xv[q][jj][3] * xv[q][jj][3]); }
                s2[q] = t; }
#pragma unroll
            for (int o = 1; o < 64; o <<= 1) {
#pragma unroll
                for (int q = 0; q < 4; ++q) s2[q] += __shfl_xor(s2[q], o); }
            LAS float* pvb = PV + 8 * lane; asm volatile("" : "+v"(pvb));
#pragma unroll
            for (int jj = 0; jj < 4; ++jj) { const int col = 8 * lane + 512 * (jj >> 1) + 4 * (jj & 1); const int co = 512 * (jj >> 1) + 4 * (jj & 1);
                const f32x4 gg = *(const LAS f32x4*)(pvb + co), bb = *(const LAS f32x4*)(pvb + 1024 + co), sc2 = *(const LAS f32x4*)(pvb + 2048 + co), sh2 = *(const LAS f32x4*)(pvb + 3072 + co);
#pragma unroll
                for (int q = 0; q < 4; ++q) { const int rl = wave * 4 + q, tok = tok0 + rl; const float rstd = 1.0f / sqrtf(s2[q] * (1.f / D) + LN_EPS);
                    const f32x4 xn = xv[q][jj] * rstd * gg + bb; { u32x2 xw; xw.x = pkh2(xn[0], xn[1]); xw.y = pkh2(xn[2], xn[3]); *(GAS u32x2*)(X + (size_t)tok * D + col) = xw; }
                    const f32x4 hf = xn * sc2 + sh2;
                    unsigned hh[4], ll[4];
#pragma unroll
                    for (int e = 0; e < 4; ++e) { hh[e] = f2bf(hf[e]); ll[e] = f2bf(hf[e] - bf2f(hh[e])); }
                    u32x2 wh, wlo; wh.x = hh[0] | (hh[1] << 16); wh.y = hh[2] | (hh[3] << 16); wlo.x = ll[0] | (ll[1] << 16); wlo.y = ll[2] | (ll[3] << 16);
                    *(GAS u32x2*)(H + (size_t)tok * D + col) = wh;
                    *(LAS u32x2*)(Ahi + rl * APITCH + col) = wh; *(LAS u32x2*)(Alo + rl * APITCH + col) = wlo; } }
        }
        __builtin_amdgcn_sched_barrier(0);
        {
            const int r32 = lane & 31, hi = lane >> 5;
#pragma unroll
            for (int nb = 0; nb < 2; ++nb) {
                const GAS bf16* ph = (const GAS bf16*)WH + (size_t)(r32 + 32 * nb) * 1024 + wave * 128 + hi * 8; const GAS bf16* pl = (const GAS bf16*)WLo + (size_t)(r32 + 32 * nb) * 1024 + wave * 128 + hi * 8;
                asm volatile("" : "+v"(ph), "+v"(pl));
#pragma unroll
                for (int ks = 0; ks < 8; ++ks) { bh[ks][nb] = *(const GAS bf16x8*)(ph + ks * 16); bl[ks][nb] = *(const GAS bf16x8*)(pl + ks * 16); } }
        }
        __syncthreads();
        LSTAMP(13);
        f32x16 acc[2]; acc[0] = (f32x16){}; acc[1] = (f32x16){};
        {
            const int r32 = lane & 31, hi = lane >> 5;
#pragma unroll
            for (int ks = 0; ks < 8; ++ks) {
                const int k = wave * 128 + ks * 16 + hi * 8;
                const bf16x8 ah = *(const LAS bf16x8*)(Ahi + r32 * APITCH + k), al = *(const LAS bf16x8*)(Alo + r32 * APITCH + k);
#pragma unroll
                for (int nb = 0; nb < 2; ++nb) {
                    acc[nb] = MFMA32(ah, bh[ks][nb], acc[nb]);
                    acc[nb] = MFMA32(al, bh[ks][nb], acc[nb]);
                    acc[nb] = MFMA32(ah, bl[ks][nb], acc[nb]);
                }
            }
        }
        LDS_ONLY_BARRIER();
        {
            const int r32 = lane & 31, hi = lane >> 5;
#pragma unroll
            for (int nb = 0; nb < 2; ++nb)
#pragma unroll
                for (int r = 0; r < 16; ++r) { const int trow = (r & 3) + 8 * (r >> 2) + 4 * hi; PART[(wave * 32 + trow) * 64 + 32 * nb + r32] = acc[nb][r]; }
        }
        if (F.tid < 64) lcnt[F.tid] = 0;
        LDS_ONLY_BARRIER();
        LSTAMP(14);
        if (bi + 1 < nblk) LN1_LOAD(bi + 1);
        else {
#pragma unroll
            for (int q = 0; q < 4; ++q) {
#pragma unroll
                for (int j = 0; j < NX; ++j) xr[q][j] = (u32x4){0u, 0u, 0u, 0u};
#pragma unroll
                for (int j = 0; j < 2; ++j) yv[q][j] = (u32x4){0u, 0u, 0u, 0u}; } }
        int chosen_m = 0; int posl[4]; float wv[4]; int rk[4];
        unsigned key[4]; float sgv[4];
#pragma unroll
        for (int q = 0; q < 4; ++q) {
            const int rl = wave * 4 + q;
            float logit = 0.f;
#pragma unroll
            for (int w = 0; w < 8; ++w) logit += PART[(w * 32 + rl) * 64 + lane];
            const float sg = 1.0f / (1.0f + __expf(-logit));
            const float sel = sg + rbe;
            float m1 = sel; m1 = fmaxf(m1, __shfl_xor(m1, 1)); m1 = fmaxf(m1, __shfl_xor(m1, 2)); m1 = fmaxf(m1, __shfl_xor(m1, 4));
            const unsigned long long bal = __ballot(sel == m1);
            const unsigned long long gm = bal & (0xFFull << (8 * (lane >> 3)));
            const int first = (int)__builtin_ctzll(gm);
            float m2 = (lane == first) ? -INFINITY : sel; m2 = fmaxf(m2, __shfl_xor(m2, 1)); m2 = fmaxf(m2, __shfl_xor(m2, 2)); m2 = fmaxf(m2, __shfl_xor(m2, 4));
            const float gs = m1 + m2;
            int rg = 0;
#pragma unroll
            for (int g2 = 0; g2 < 8; ++g2) { const float v = __builtin_bit_cast(float, __builtin_amdgcn_readlane(__builtin_bit_cast(int, gs), 8 * g2)); rg += ((v > gs) || (v == gs && g2 < (lane >> 3))) ? 1 : 0; }
            const bool gsel = rg < 4;
            const float msel = gsel ? sel : -INFINITY;
            const unsigned mb_ = __float_as_uint(msel); key[q] = (mb_ & 0x80000000u) ? ~mb_ : (mb_ | 0x80000000u); sgv[q] = sg;
        }
        unsigned tau[4] = {0u, 0u, 0u, 0u};
#pragma unroll 1
        for (int bit = 31; bit >= 0; --bit) {
#pragma unroll
            for (int q = 0; q < 4; ++q) { const unsigned cand = tau[q] | (1u << bit); const int cnt = (int)__popcll(__ballot(key[q] >= cand)); tau[q] = (cnt >= TOPK) ? cand : tau[q]; } }
#pragma unroll
        for (int q = 0; q < 4; ++q) {
            const unsigned long long gtm = __ballot(key[q] > tau[q]), eqm = __ballot(key[q] == tau[q]);
            const int need = TOPK - (int)__popcll(gtm);
            const unsigned long long below = (1ull << lane) - 1ull;
            const bool ch = (key[q] > tau[q]) || ((key[q] == tau[q]) && ((int)__popcll(eqm & below) < need));
            const unsigned long long chm = __ballot(ch);
            const int rank = (int)__popcll(chm & below);
            const float wsum = wave_sum(ch ? sgv[q] : 0.f);
            wv[q] = sgv[q] / wsum * ROUTED_SCALE; rk[q] = rank; posl[q] = 0;
            if (ch) { chosen_m |= (1 << q); posl[q] = __hip_atomic_fetch_add(lcnt + lane, 1, __ATOMIC_RELAXED, __HIP_MEMORY_SCOPE_WORKGROUP); }
        }
        LDS_ONLY_BARRIER();
        LSTAMP(15);
        if (wave == 0) { const int n = lcnt[lane]; int base = 0; if (n > 0) base = (int)__hip_atomic_fetch_add(gcnt + lane, (unsigned)n, RLX_AGENT); gb[lane] = base; }
        LDS_ONLY_BARRIER();
        {
            const int base = gb[lane];
#pragma unroll
            for (int q = 0; q < 4; ++q) if (chosen_m & (1 << q)) { const int tok = tok0 + wave * 4 + q; const int pos = base + posl[q];
                tokl[(size_t)lane * CAP + pos] = tok; wl[(size_t)tok * 8 + rk[q]] = wv[q]; tslot[(size_t)tok * 8 + rk[q]] = lane * CAP + pos; }
        }
        LDS_ONLY_BARRIER();
        LSTAMP(16);
    }
#undef LN1_LOAD
#undef LN1_BLK
}

__device__ __forceinline__ void combine_ln2_phase(Frame& F, int layer) {
    bf16* X = (bf16*)(F.ws + WS_X); bf16* H = (bf16*)(F.ws + WS_H); const unsigned char* YS = (const unsigned char*)(F.ws + WS_YS);
    const float* modl = (const float*)(F.ws + WS_MOD) + (size_t)layer * 8 * 6144;
    const float* modn = (const float*)(F.ws + WS_MOD) + (size_t)(layer + 1) * 8 * 6144;
    const float* lg = inp(F, 18) + layer * D; const float* lb = inp(F, 19) + layer * D;
    const int* tslot = (const int*)(F.ws + WS_TSLOT);
    const LAS int* ts = (const LAS int*)(F.lc + LC_TS);
    const bool lastl = (layer == DEPTH - 1);
    float* xout = (float*)inp(F, 20);
    const int lane = F.lane, wave = F.wave;
    LAS float* PV = (LAS float*)F.lds;
    const int shbase = ts[64] * 256;
    for (int blk = F.vcu; blk < T / 64; blk += F.G) {
        const int tokb = blk * 64, b = tokb / SEQ;
        __syncthreads();
        for (int i = F.tid; i < 1024; i += 512) { PV[i] = modl[(size_t)b * 6144 + 5120 + i] + 1.0f; PV[1024 + i] = lg[i]; PV[2048 + i] = lb[i];
            if (!lastl) { PV[3072 + i] = modn[(size_t)b * 6144 + 1024 + i] + 1.0f; PV[4096 + i] = modn[(size_t)b * 6144 + i]; } }
        __syncthreads();
        const int tw = tokb + wave * 8;
        int sv; { const int v = tslot[(size_t)tw * 8 + lane]; sv = ts[v >> 14] * 256 + (v & (CAP - 1)); }
        const float wvv = ((const float*)(F.ws + WS_WL))[(size_t)tw * 8 + lane] * (1.0f / 32.0f);
        pg8::u32x2_t ys[18]; u32x4 xs[2];
#define CB_LOAD(k) do { const int tok_ = tw + (k); _Pragma("unroll") for (int kk_ = 0; kk_ < 9; ++kk_) { const int slot_ = (kk_ < 8) ? __builtin_amdgcn_readlane(sv, 8 * (k) + kk_) : (shbase + tok_); \
            const unsigned char* yr_ = YS + (size_t)slot_ * D + 8 * lane; ys[2 * kk_] = __builtin_nontemporal_load((const GAS pg8::u32x2_t*)(yr_)); ys[2 * kk_ + 1] = __builtin_nontemporal_load((const GAS pg8::u32x2_t*)(yr_ + 512)); } \
            _Pragma("unroll") for (int j_ = 0; j_ < 2; ++j_) xs[j_] = __builtin_nontemporal_load((const GAS u32x4*)(X + (size_t)tok_ * D + 8 * lane + 512 * j_)); } while (0)
        CB_LOAD(0);
#pragma unroll 1
        for (int k = 0; k < 8; ++k) {
            const int tok_ = tw + k; f32x4 y_[4];
#pragma unroll
            for (int jj_ = 0; jj_ < 4; ++jj_) y_[jj_] = (f32x4){0.f, 0.f, 0.f, 0.f};
#pragma unroll
            for (int kk_ = 0; kk_ < 9; ++kk_) { const float wk_ = (kk_ < 8) ? __builtin_bit_cast(float, __builtin_amdgcn_readlane(__builtin_bit_cast(int, wvv), 8 * k + kk_)) : (1.0f / 32.0f);
#pragma unroll
                for (int j_ = 0; j_ < 2; ++j_) { const pg8::u32x2_t w_ = ys[2 * kk_ + j_];
                    const f32x2 a0_ = __builtin_amdgcn_cvt_pk_f32_fp8((int)w_.x, false), a1_ = __builtin_amdgcn_cvt_pk_f32_fp8((int)w_.x, true), b0_ = __builtin_amdgcn_cvt_pk_f32_fp8((int)w_.y, false), b1_ = __builtin_amdgcn_cvt_pk_f32_fp8((int)w_.y, true);
                    y_[2 * j_][0] += wk_ * a0_[0]; y_[2 * j_][1] += wk_ * a0_[1]; y_[2 * j_][2] += wk_ * a1_[0]; y_[2 * j_][3] += wk_ * a1_[1];
                    y_[2 * j_ + 1][0] += wk_ * b0_[0]; y_[2 * j_ + 1][1] += wk_ * b0_[1]; y_[2 * j_ + 1][2] += wk_ * b1_[0]; y_[2 * j_ + 1][3] += wk_ * b1_[1]; } }
            f32x4 v_[4]; float s_ = 0.f;
#pragma unroll
            for (int jj_ = 0; jj_ < 4; ++jj_) { const int col_ = 8 * lane + 512 * (jj_ >> 1) + 4 * (jj_ & 1); const f32x4 g2_ = *(const LAS f32x4*)(PV + col_);
                const unsigned w0_ = (jj_ & 1) ? xs[jj_ >> 1].z : xs[jj_ >> 1].x, w1_ = (jj_ & 1) ? xs[jj_ >> 1].w : xs[jj_ >> 1].y;
                const f32x4 x4_ = (f32x4){h2f(w0_ & 0xffffu), h2f(w0_ >> 16), h2f(w1_ & 0xffffu), h2f(w1_ >> 16)};
                v_[jj_] = x4_ * ALPHA + g2_ * y_[jj_]; s_ += (v_[jj_][0] + v_[jj_][1]) + (v_[jj_][2] + v_[jj_][3]); }
            asm volatile("" : "+v"(v_[0]), "+v"(v_[1]), "+v"(v_[2]), "+v"(v_[3]));
            __builtin_amdgcn_sched_barrier(0);
            { const int kn = (k + 1 < 8) ? k + 1 : k; CB_LOAD(kn); }
            __builtin_amdgcn_sched_barrier(0);
            const float mean_ = wave_sum(s_) * (1.f / D); float q_ = 0.f;
#pragma unroll
            for (int jj_ = 0; jj_ < 4; ++jj_) { v_[jj_] = v_[jj_] - mean_; q_ += (v_[jj_][0] * v_[jj_][0] + v_[jj_][1] * v_[jj_][1]) + (v_[jj_][2] * v_[jj_][2] + v_[jj_][3] * v_[jj_][3]); }
            const float rstd_ = 1.0f / sqrtf(wave_sum(q_) * (1.f / D) + LN_EPS);
#pragma unroll
            for (int jj_ = 0; jj_ < 4; ++jj_) { const int col_ = 8 * lane + 512 * (jj_ >> 1) + 4 * (jj_ & 1);
                const f32x4 gg_ = *(const LAS f32x4*)(PV + 1024 + col_), bb_ = *(const LAS f32x4*)(PV + 2048 + col_);
                const f32x4 xn_ = v_[jj_] * rstd_ * gg_ + bb_;
                if (lastl) *(GAS f32x4*)(xout + (size_t)tok_ * D + col_) = xn_;
                else { u32x2 xw_; xw_.x = pkh2(xn_[0], xn_[1]); xw_.y = pkh2(xn_[2], xn_[3]); *(GAS u32x2*)(X + (size_t)tok_ * D + col_) = xw_; }
                if (!lastl) { const f32x4 sc_ = *(const LAS f32x4*)(PV + 3072 + col_), sh_ = *(const LAS f32x4*)(PV + 4096 + col_); const f32x4 hm_ = xn_ * sc_ + sh_;
                    u32x2 w2_; w2_.x = pk2(hm_[0], hm_[1]); w2_.y = pk2(hm_[2], hm_[3]); *(GAS u32x2*)(H + (size_t)tok_ * D + col_) = w2_; } }
        }
#undef CB_LOAD
    }
}

constexpr int ACCP = 68;
__device__ __forceinline__ int crow(int r, int hi) { return (r & 3) + 8 * (r >> 2) + 4 * hi; }
constexpr int KPITCH = 144;
__device__ __forceinline__ u32x4 f8x8_to_bf16(unsigned a, unsigned b, float inv) {
    typedef __bf16 bfx2 __attribute__((ext_vector_type(2)));
    u32x4 r; r.x = __builtin_bit_cast(unsigned, (bfx2)__builtin_amdgcn_cvt_scalef32_pk_bf16_fp8(a, inv, false)); r.y = __builtin_bit_cast(unsigned, (bfx2)__builtin_amdgcn_cvt_scalef32_pk_bf16_fp8(a, inv, true));
    r.z = __builtin_bit_cast(unsigned, (bfx2)__builtin_amdgcn_cvt_scalef32_pk_bf16_fp8(b, inv, false)); r.w = __builtin_bit_cast(unsigned, (bfx2)__builtin_amdgcn_cvt_scalef32_pk_bf16_fp8(b, inv, true)); return r;
}
template <bool FIRST, int NB>
__device__ __forceinline__ void attn_task(const unsigned char* QKVb  , int g, int h, int dil, int cls, int q0, int QS, int kb0, int L, float slope2d,
                                          LAS unsigned char* stg  , LAS float* wsf  , LAS float* ACC, LAS float* ML, int trow_mul, int trow_add, int lane) {
    asm volatile("" : "+v"(lane));
    const int r32 = lane & 31, hi = lane >> 5, lr = lane >> 2, lc = lane & 3;
    const int qcol = ((g * 3 + 0) * 16 + h) * 64, kcol = ((g * 3 + 1) * 16 + h) * 64, vcol = ((g * 3 + 2) * 16 + h) * 64;
    const size_t rstride = (size_t)dil * NQKV;
    const unsigned char* base = QKVb + (size_t)cls * NQKV + lc * 16;
    const int jlo = (kb0 >= -31) ? 0 : ((-kb0) >> 5);
    const int qpos = q0 + QS * r32;
    const int dmax = qpos < 128 ? qpos : 128;
    const float half = 0.5f * (float)dmax;
#define AT_LOADROWS(dst, l0, ls, col) do { _Pragma("unroll") for (int i_ = 0; i_ < 2; ++i_) { int l_ = (l0) + (ls) * (16 * i_ + lr); l_ = l_ < 0 ? 0 : (l_ > L - 1 ? L - 1 : l_); \
        dst[i_] = *(const GAS u32x4*)(base + (size_t)l_ * rstride + (col)); } } while (0)
#define AT_PUTROWS(src, inv) do { _Pragma("unroll") for (int i_ = 0; i_ < 2; ++i_) { LAS unsigned char* p_ = stg + (16 * i_ + lr) * KPITCH + lc * 32; \
        *(LAS u32x4*)(p_) = f8x8_to_bf16(src[i_].x, src[i_].y, inv); *(LAS u32x4*)(p_ + 16) = f8x8_to_bf16(src[i_].z, src[i_].w, inv); } } while (0)
#define AT_GETFRAG(dst) do { _Pragma("unroll") for (int s_ = 0; s_ < 4; ++s_) dst[s_] = *(const LAS bf16x8*)(stg + r32 * KPITCH + 32 * s_ + 16 * hi); } while (0)
#define AT_LDSWAIT() asm volatile("s_waitcnt lgkmcnt(0)" ::: "memory")
    u32x4 kr[2][2];
    bf16x8 qf[4];
    { u32x4 qr[2]; AT_LOADROWS(qr, q0, QS, qcol);
#pragma unroll
      for (int j = 0; j < NB; ++j) if (j == jlo) AT_LOADROWS(kr[j & 1], kb0 + 32 * j, 1, kcol);
      AT_PUTROWS(qr, 1.0f / 64.0f); AT_LDSWAIT(); AT_GETFRAG(qf); AT_LDSWAIT(); }
    f32x16 S[NB];
    float mx = -INFINITY;
#pragma unroll
    for (int j = 0; j < NB; ++j) {
        if (j >= jlo) {
            asm volatile("" ::: "memory");
            if (j < NB - 1) AT_LOADROWS(kr[(j + 1) & 1], kb0 + 32 * (j + 1), 1, kcol);
            AT_PUTROWS(kr[j & 1], 1.0f / 16.0f);
            const float xd0 = (float)(qpos - kb0 - 32 * j - 4 * hi) - half;
            const bool inner = (q0 - kb0 - 32 * j - 31 >= 0) && (q0 + QS * 31 - kb0 - 32 * j <= 128) && (kb0 + 32 * j >= 0);
            f32x16 a;
            if (inner) {
                const float cb = -slope2d * xd0;
#pragma unroll
                for (int r = 0; r < 16; ++r) a[r] = __builtin_fmaf(slope2d, (float)((r & 3) + 8 * (r >> 2)), cb);
            } else {
#pragma unroll
                for (int r = 0; r < 16; ++r) { const float x = xd0 - (float)((r & 3) + 8 * (r >> 2)); a[r] = (__builtin_fabsf(x) <= half) ? (-slope2d * x) : -INFINITY; }
            }
            bf16x8 kf[4];
            AT_LDSWAIT(); AT_GETFRAG(kf); AT_LDSWAIT();
#pragma unroll
            for (int s = 0; s < 4; ++s) a = MFMA32(kf[s], qf[s], a);
#pragma unroll
            for (int r = 0; r < 16; ++r) mx = fmaxf(mx, a[r]);
            S[j] = a;
        } else {
#pragma unroll
            for (int r = 0; r < 16; ++r) S[j][r] = -INFINITY;
        }
        __builtin_amdgcn_sched_barrier(0);
    }
    u32x4 vr[2][2];
#pragma unroll
    for (int j = 0; j < NB; ++j) if (j == jlo) AT_LOADROWS(vr[j & 1], kb0 + 32 * j, 1, vcol);
    { auto rr = __builtin_amdgcn_permlane32_swap(__float_as_uint(mx), __float_as_uint(mx), false, false);
      const unsigned r0 = rr[0], r1 = rr[1]; mx = fmaxf(__uint_as_float(r0), __uint_as_float(r1)); }
    const float mx_true = mx - slope2d * half;
    float lsum = 0.f;
    u32x4 P[NB][2];
#pragma unroll
    for (int j = 0; j < NB; ++j) {
        float p[16];
#pragma unroll
        for (int r = 0; r < 16; ++r) { p[r] = __builtin_amdgcn_exp2f(S[j][r] - mx); lsum += p[r]; }
#pragma unroll
        for (int ks = 0; ks < 2; ++ks) { P[j][ks].x = cvt_pk_bf16(p[8 * ks + 0], p[8 * ks + 1]); P[j][ks].y = cvt_pk_bf16(p[8 * ks + 2], p[8 * ks + 3]); P[j][ks].z = cvt_pk_bf16(p[8 * ks + 4], p[8 * ks + 5]); P[j][ks].w = cvt_pk_bf16(p[8 * ks + 6], p[8 * ks + 7]); }
        __builtin_amdgcn_sched_barrier(0);
    }
    { auto rr = __builtin_amdgcn_permlane32_swap(__float_as_uint(lsum), __float_as_uint(lsum), false, false);
      const unsigned r0 = rr[0], r1 = rr[1]; lsum = __uint_as_float(r0) + __uint_as_float(r1); }
    f32x16 o[2]; o[0] = (f32x16){}; o[1] = (f32x16){};
    const unsigned vrd = (unsigned)(((lane >> 4) & 1) * 32 + (lane & 3) * 8 + (4 * hi + ((lane & 15) >> 2)) * 64);
#pragma unroll
    for (int j = 0; j < NB; ++j) {
        if (j >= jlo) {
            asm volatile("" ::: "memory");
            if (j < NB - 1) AT_LOADROWS(vr[(j + 1) & 1], kb0 + 32 * (j + 1), 1, vcol);
#pragma unroll
            for (int i = 0; i < 2; ++i) { const int key = 16 * i + lr;
#pragma unroll
                for (int hf = 0; hf < 2; ++hf) { const int c8 = 2 * lc + hf; const u32x4 src = vr[j & 1][i];
                    *(LAS u32x4*)(stg + ((c8 >> 2) * 2 + (key >> 4)) * 1024 + (key & 15) * 64 + (c8 & 3) * 16) = f8x8_to_bf16(hf ? src.z : src.x, hf ? src.w : src.y, 1.0f / 16.0f); } }
            AT_LDSWAIT();
#pragma unroll
            for (int d0 = 0; d0 < 2; ++d0)
#pragma unroll
                for (int ks = 0; ks < 2; ++ks) {
                    LAS unsigned char* vp = stg + (d0 * 2 + ks) * 1024 + vrd;
                    const s16x4 lo = __builtin_bit_cast(s16x4, __builtin_amdgcn_ds_read_tr16_b64_v4i16((LAS s16x4*)(vp)));
                    const s16x4 hh = __builtin_bit_cast(s16x4, __builtin_amdgcn_ds_read_tr16_b64_v4i16((LAS s16x4*)(vp + 512)));
                    const bf16x8 vf = (bf16x8){lo[0], lo[1], lo[2], lo[3], hh[0], hh[1], hh[2], hh[3]};
                    o[d0] = MFMA32(__builtin_bit_cast(bf16x8, P[j][ks]), vf, o[d0]);
                }
            AT_LDSWAIT();
        }
        __builtin_amdgcn_sched_barrier(0);
    }
#undef AT_LOADROWS
#undef AT_PUTROWS
#undef AT_GETFRAG
#undef AT_LDSWAIT
    if (hi == 0) { wsf[r32] = mx_true; wsf[32 + r32] = lsum; }
    asm volatile("s_waitcnt lgkmcnt(0)" ::: "memory");
    f32x4 mt4[4], lt4[4];
#pragma unroll
    for (int k = 0; k < 4; ++k) { mt4[k] = *(const LAS f32x4*)(wsf + 8 * k + 4 * hi); lt4[k] = *(const LAS f32x4*)(wsf + 32 + 8 * k + 4 * hi); }
    if (FIRST) {
#pragma unroll
        for (int r = 0; r < 16; ++r) { const int q = crow(r, hi); const int trow = q * trow_mul + trow_add;
            ACC[trow * ACCP + r32] = o[0][r]; ACC[trow * ACCP + 32 + r32] = o[1][r];
            if (r32 == 0) { ML[trow * 2] = mt4[r >> 2][r & 3]; ML[trow * 2 + 1] = lt4[r >> 2][r & 3]; } }
    } else {
        f32x2 ml[16]; float a0[16], a1[16];
#pragma unroll
        for (int r = 0; r < 16; ++r) { const int q = crow(r, hi); const int trow = q * trow_mul + trow_add;
            ml[r] = *(const LAS f32x2*)(ML + trow * 2); a0[r] = ACC[trow * ACCP + r32]; a1[r] = ACC[trow * ACCP + 32 + r32]; }
        asm volatile("s_waitcnt lgkmcnt(0)" ::: "memory");
#pragma unroll
        for (int r = 0; r < 16; ++r) { const int q = crow(r, hi); const int trow = q * trow_mul + trow_add;
            const float mt = mt4[r >> 2][r & 3], lt = lt4[r >> 2][r & 3], mo = ml[r][0], lo_ = ml[r][1];
            const float mn = fmaxf(mo, mt); const float fa = __builtin_amdgcn_exp2f(mo - mn), fb = __builtin_amdgcn_exp2f(mt - mn);
            ACC[trow * ACCP + r32] = a0[r] * fa + o[0][r] * fb; ACC[trow * ACCP + 32 + r32] = a1[r] * fa + o[1][r] * fb;
            if (r32 == 0) { ML[trow * 2] = mn; ML[trow * 2 + 1] = lo_ * fa + lt * fb; } }
    }
    asm volatile("s_waitcnt lgkmcnt(0)" ::: "memory");
}

__device__ __forceinline__ void attn_phase(Frame& F, bf16* MIX) {
    const unsigned char* QKV = (const unsigned char*)(F.ws + WS_QKV);
    LAS float* ACC = (LAS float*)F.lds;
    LAS float* ML = (LAS float*)(F.lds + 69632);
    LAS unsigned char* vst = F.lds + 73728 + F.wave * 4608;
    LAS float* wsf = (LAS float*)(F.lds + 73728 + 8 * 4608 + F.wave * 256);
    const int lane = F.lane, w = F.wave;
    for (int i = 0;; ++i) {
        if (i >= (BATCH * 16 * 8) / F.G) break;
        const int L0 = (F.G == 256) ? ((F.vcu >> 5) * 128 + i * 32 + (F.vcu & 31)) : (i * F.G + F.vcu);
        const int bh = L0 >> 3, ti = L0 & 7; int w4 = ti >> 1; const int c = ti & 1; if (i & 1) w4 = 3 - w4;
        const int b = bh >> 4, h = bh & 15, win0 = w4 * 512;
        const unsigned char* Qb = QKV + (size_t)b * SEQ * NQKV;
        const float sl0 = exp2f(-8.0f * (float)(0 * 16 + h + 1) / 48.0f) * LOG2E, sl1 = exp2f(-8.0f * (float)(1 * 16 + h + 1) / 48.0f) * LOG2E * 4.0f, sl2 = exp2f(-8.0f * (float)(2 * 16 + h + 1) / 48.0f) * LOG2E * 16.0f;
        LSTAMP0();
        attn_task<true, 6>(Qb, 0, h, 1, 0, win0 + 64 * w + c, 2, win0 + 64 * w - 128, SEQ, sl0, vst, wsf, ACC, ML, 1, 32 * w, lane);
        __syncthreads();
        LSTAMP(24);
        if (ATTN_GMASK & 2) { const int cls = c + 2 * (w & 1), lb = w >> 1, lq0 = 128 * w4 + 32 * lb; attn_task<false, 5>(Qb, 1, h, 4, cls, lq0, 1, lq0 - 128, SEQ / 4, sl1, vst, wsf, ACC, ML, 2, 64 * lb + (w & 1), lane); }
        __syncthreads();
        LSTAMP(25);
        if (ATTN_GMASK & 4) { const int cls = c + 2 * w, lq0 = 32 * w4; attn_task<false, 5>(Qb, 2, h, 16, cls, lq0, 1, lq0 - 128, SEQ / 16, sl2, vst, wsf, ACC, ML, 8, w, lane); }
        __syncthreads();
        LSTAMP(26);
        {
#pragma unroll
          for (int it = 0; it < 4; ++it) { const int trow = 32 * w + 8 * it + (lane >> 3), sg = lane & 7; const float inv = 1.0f / ML[trow * 2 + 1];
              const LAS f32x4* ap = (const LAS f32x4*)(ACC + trow * ACCP + sg * 8);
              bf16* op = MIX + (size_t)(b * SEQ + win0 + 2 * trow + c) * D + h * 64 + sg * 8;
              const f32x4 a = ap[0] * inv, bq = ap[1] * inv; u32x4 wv; wv.x = pk2(a[0], a[1]); wv.y = pk2(a[2], a[3]); wv.z = pk2(bq[0], bq[1]); wv.w = pk2(bq[2], bq[3]);
              *(GAS u32x4*)op = wv; } }
        __syncthreads();
    }
}

__device__ __forceinline__ void attn_phase_naive(Frame& F, bf16* MIX, const int gmask) {
    const bf16* QKV = (const bf16*)(F.ws + WS_YS);
    const int lane = F.lane;
    const int gw = F.vcu * NWAVES + F.wave, NGW = F.G * NWAVES;
    for (int item = gw; item < T * 16; item += NGW) {
        const int tok = item >> 4, h = item & 15, b = tok / SEQ, t = tok % SEQ;
        const bf16* Qb = QKV + (size_t)b * SEQ * NQKV;
        float sc[3][3]; int kt[3][3];
        float mx = -INFINITY;
#pragma unroll
        for (int g = 0; g < 3; ++g) {
            const int dil = (g == 0) ? 1 : (g == 1 ? 4 : 16);
            const float slope = exp2f(-8.0f * (float)(g * 16 + h + 1) / 48.0f);
            const bf16* qp = Qb + (size_t)t * NQKV + ((g * 3 + 0) * 16 + h) * 64;
#pragma unroll
            for (int c = 0; c < 3; ++c) {
                const int j = lane + 64 * c; const int tk = t - j * dil;
                float s = -INFINITY;
                if (j <= 128 && tk >= 0 && ((gmask >> g) & 1)) {
                    const bf16* kp = Qb + (size_t)tk * NQKV + ((g * 3 + 1) * 16 + h) * 64;
                    float d = 0.f;
                    for (int e = 0; e < 64; ++e) d += bf2f(qp[e]) * bf2f(kp[e]);
                    s = d - slope * LOG2E * (float)(j * dil);
                }
                sc[g][c] = s; kt[g][c] = tk; mx = fmaxf(mx, s);
            }
        }
#pragma unroll
        for (int o = 1; o < 64; o <<= 1) mx = fmaxf(mx, __shfl_xor(mx, o));
        float den = 0.f; float acc[64];
#pragma unroll
        for (int e = 0; e < 64; ++e) acc[e] = 0.f;
#pragma unroll
        for (int g = 0; g < 3; ++g)
#pragma unroll
            for (int c = 0; c < 3; ++c) {
                const float p = (sc[g][c] == -INFINITY) ? 0.f : exp2f(sc[g][c] - mx);
                den += p;
                if (p != 0.f) { const bf16* vp = Qb + (size_t)kt[g][c] * NQKV + ((g * 3 + 2) * 16 + h) * 64;
#pragma unroll
                    for (int e = 0; e < 64; ++e) acc[e] += p * bf2f(vp[e]); }
            }
        den = wave_sum(den);
        float mine = 0.f;
#pragma unroll
        for (int e = 0; e < 64; ++e) { const float v = wave_sum(acc[e]); if (lane == e) mine = v; }
        MIX[(size_t)tok * D + h * 64 + lane] = (bf16)f2bf(mine / den);
    }
}

struct Args { const float* in[20]; float* out; unsigned char* ws; int ph_lo, ph_hi; };
constexpr int NPHASE = 2 + DEPTH * 8;

__global__ void __launch_bounds__(NWAVES * 64, 2) mk_fwd(Args args) {
    extern __shared__ __attribute__((aligned(16))) unsigned char lds_raw[];
    Frame F;
    F.lds = (LAS unsigned char*)lds_raw; F.lc = F.lds + LDSCTL_OFF;
    F.tid = threadIdx.x; F.lane = F.tid & 63; F.wave = __builtin_amdgcn_readfirstlane(F.tid >> 6);
    F.G = gridDim.x; { const int bx = blockIdx.x; F.vcu = (F.G % 8 == 0) ? (bx % 8) * (F.G / 8) + bx / 8 : bx; }
    F.ws = args.ws; F.ctl = (unsigned*)(args.ws + WS_CTL);
    for (int u = F.tid; u < (LDS_BYTES - LDSCTL_OFF) / 4; u += NWAVES * 64) ((LAS unsigned*)F.lc)[u] = 0u;
    __syncthreads();
    if (F.tid == 0) {
#pragma unroll
        for (int i = 0; i < 20; ++i) *(LAS unsigned long long*)(F.lc + LC_PTR + 8 * i) = (unsigned long long)args.in[i];
        *(LAS unsigned long long*)(F.lc + LC_PTR + 8 * 20) = (unsigned long long)args.out;
    }
    __syncthreads();
#if MK_PER_PHASE
#define GRID_BAR() do { } while (0)
    XcdBarrier bar; bar.bar = nullptr; bar.x = 0; bar.st = nullptr;
#else
    XcdBarrier bar = xcd_barrier_post(F.ctl + CW_BAR, (volatile LAS unsigned*)(F.lc + LC_MISC) + 8);
#define GRID_BAR() xcd_barrier(bar)
#endif
    const int lo = args.ph_lo, hi = args.ph_hi;
#ifdef PROBE_TYPE
#define LC_STAMP 3072
#define STAMP(ty) do { if (blockIdx.x == 0 && F.tid == 0) { const unsigned long long now_ = __builtin_amdgcn_s_memrealtime(); LAS unsigned long long* st_ = (LAS unsigned long long*)(F.lc + LC_STAMP); \
        st_[1 + (ty)] += now_ - st_[0]; st_[0] = now_; } } while (0)
    if (blockIdx.x == 0 && F.tid == 0) { ((LAS unsigned long long*)(F.lc + LC_STAMP))[0] = __builtin_amdgcn_s_memrealtime(); }
#else
#define STAMP(ty) do { } while (0)
#endif
#define IN(k) (lo <= (k) && (k) < hi)
#define SEAM(k) do { if (IN(k) && IN((k) + 1)) GRID_BAR(); } while (0)
    const float* mod = (const float*)(F.ws + WS_MOD);

    if (PHON(0) && IN(0)) { p0_prologue(F); } SEAM(0); STAMP(0);
    bool xlocal = false; int cid = (int)blockIdx.x;
#if !MK_PER_PHASE
    { volatile LAS unsigned* st = (volatile LAS unsigned*)(F.lc + LC_MISC) + 8;
      if (F.tid == 0) { unsigned ok = (F.G == 256) ? 1u : 0u;
#pragma unroll
          for (unsigned jx = 0; jx < 16; ++jx) { const unsigned cj = xb_ld(&bar.bar[XB_XCNT(jx)]); ok &= (jx < 8u) ? (cj == 32u ? 1u : 0u) : (cj == 0u ? 1u : 0u); }
          st[3] = ok; }
      __syncthreads();
      xlocal = (st[3] != 0u) && (MK_XLOCAL != 0);
      if (xlocal) cid = (int)(st[2] * 8u + bar.x); }
#endif
    cid = __builtin_amdgcn_readfirstlane(cid);
    F.vcu = (F.G % 8 == 0) ? (cid % 8) * (F.G / 8) + cid / 8 : cid;
#define LSEAM(k) do { if (IN(k) && IN((k) + 1)) { if (xlocal) xcd_local_barrier(bar, F.wave == 0); else GRID_BAR(); } } while (0)
    if (PHON(1) && IN(1)) { p1_modulate(F, inp(F, 0), mod, 0, 1024); } SEAM(1); STAMP(1);

    for (int layer = 0; layer < DEPTH; ++layer) {
        const int pb = 2 + layer * 8; const int j = layer >> 1;
        if ((layer & 1) == 0) {
            if (PHON(2) && IN(pb + 0)) { refresh(F); unsigned char* ws = opq(F.ws); (void)ws;
                PlainSched S{T / 256, 4, 256, F.G, cid, (const char*)(ws + WS_WPIN) + (size_t)j * 2 * MiB, 2048};
                pg8::EpiStore E{(bf16*)(ws + WS_U), D, nullptr, 0, 0, 0, F.lds + LDS_TB_OFF + F.wave * 2048};
                pg8::gemm_phase<pg8::EpiStore, PlainSched>(F.tid, F.lds, (const char*)(ws + WS_H), 2048, 2048, 1024, S, E);
            } LSEAM(pb + 0); STAMP(2);
            if (PHON(4) && IN(pb + 2)) { refresh(F); unsigned char* ws = opq(F.ws); (void)ws;
                GrpSched S{F.G, cid, (const char*)(ws + WS_WPGRP) + (size_t)j * 512 * 1024};
                { const bf16* U = (const bf16*)(ws + WS_U); bf16* Z = (bf16*)(ws + WS_Z); pg8::Unit pu;
                  for (int i = 0; S.next(i, pu); ++i) {
                      const int b = pu.pm >> 3, t0 = (pu.pm & 7) * 256 + 32 * F.wave, g = pu.pn;
                      if (g == 0) pool_item<2>(U, Z, b, t0, 0, F.lane); else if (g == 1) pool_item<4>(U, Z, b, t0, 1, F.lane);
                      else if (g == 2) pool_item<8>(U, Z, b, t0, 2, F.lane); else pool_item<16>(U, Z, b, t0, 3, F.lane); }
                  asm volatile("s_waitcnt vmcnt(0)" ::: "memory"); __syncthreads(); }
                pg8::EpiStore E{(bf16*)(ws + WS_Y2), D, inp(F, 6) + j * D, 0, 0, 0, F.lds + LDS_TB_OFF + F.wave * 2048};
                pg8::gemm_phase<pg8::EpiStore, GrpSched>(F.tid, F.lds, (const char*)(ws + WS_Z), 2048, 512, 256, S, E);
            } LSEAM(pb + 2); STAMP(4);
            if (PHON(5) && IN(pb + 3)) { refresh(F); unsigned char* ws = opq(F.ws); (void)ws;
                PlainSched S{T / 256, 4, 256, F.G, cid, (const char*)(ws + WS_WPOUT) + (size_t)j * 2 * MiB, 2048};
                pg8::EpiStore E{(bf16*)(ws + WS_Y), D, nullptr, 0, 0, 1, F.lds + LDS_TB_OFF + F.wave * 2048};
                pg8::gemm_phase<pg8::EpiStore, PlainSched>(F.tid, F.lds, (const char*)(ws + WS_Y2), 2048, 2048, 1024, S, E);
            } LSEAM(pb + 3); STAMP(5);
        } else {
            if (PHON(6) && IN(pb + 0)) { refresh(F); unsigned char* ws = opq(F.ws); (void)ws;
                PlainSched S{T / 256, NQKV / 256, (T / 256) * (NQKV / 256), F.G, cid, (const char*)(ws + WS_WAIN) + (size_t)j * 18 * MiB, 2048};
                pg8::EpiStoreF8 E{(unsigned char*)(ws + WS_QKV), NQKV, F.lds + LDS_TB_OFF + F.wave * 2048, 1};
                pg8::gemm_phase<pg8::EpiStoreF8, PlainSched>(F.tid, F.lds, (const char*)(ws + WS_H), 2048, 2048, 1024, S, E);
            } LSEAM(pb + 0); STAMP(6);
            if (PHON(7) && IN(pb + 1)) { refresh(F); unsigned char* ws = opq(F.ws); (void)ws;
#ifdef NAIVE_ATTN
                attn_phase_naive(F, (bf16*)(F.ws + WS_Y2), 7);
#ifdef ORACLE
                if (layer == ORACLE_LAYER) { attn_phase_naive(F, (bf16*)(F.ws + WS_Z), ATTN_GMASK); attn_phase(F, (bf16*)(F.ws + WS_U)); }
#endif
#else
                attn_phase(F, (bf16*)(F.ws + WS_Y2));
#endif
            } if (IN(pb + 1) && IN(pb + 3)) { if (xlocal) xcd_local_barrier(bar, F.wave == 0); else GRID_BAR(); } STAMP(7);
            if (IN(pb + 2)) { refresh(F); unsigned char* ws = opq(F.ws); (void)ws;
#ifdef ORACLE
                if (layer == ORACLE_LAYER) { if (blockIdx.x == 0 && F.tid == 0) atomicAdd(F.ctl + 20000, 3276u * 16u);
                    const bf16* A = (const bf16*)(ws + WS_U); const bf16* B = (const bf16*)(ws + WS_Z);
                    const int gw = F.vcu * NWAVES + F.wave, NGW = F.G * NWAVES;
                    for (int tok = gw; tok < T; tok += NGW) { int bad = 0;
                        for (int h = 0; h < 16; ++h) { if (ORACLE_SEL) { const float a = bf2f(A[(size_t)tok * D + h * 64 + F.lane]), b = bf2f(B[(size_t)tok * D + h * 64 + F.lane]);
                            const float e2 = wave_sum((a - b) * (a - b)), n2 = wave_sum(b * b); if (!(e2 <= 0.0025f * n2)) bad += ORACLE_W; } }
                        if (bad && F.lane == 0) atomicAdd(F.ctl + 20000, (unsigned)bad); } }
#endif
            }
            if (PHON(8) && IN(pb + 3)) { refresh(F); unsigned char* ws = opq(F.ws); (void)ws;
                PlainSched S{T / 256, 4, 256, F.G, cid, (const char*)(ws + WS_WAOUT) + (size_t)j * 2 * MiB, 2048};
                pg8::EpiStore E{(bf16*)(ws + WS_Y), D, nullptr, 0, 0, 1, F.lds + LDS_TB_OFF + F.wave * 2048};
                pg8::gemm_phase<pg8::EpiStore, PlainSched>(F.tid, F.lds, (const char*)(ws + WS_Y2), 2048, 2048, 1024, S, E);
            } LSEAM(pb + 3); STAMP(8);
        }
        if (PHON(9) && IN(pb + 4)) { refresh(F); unsigned char* ws = opq(F.ws); (void)ws; const float* xin = (layer == 0) ? inp(F, 0) : (const float*)(ws + WS_X); if (layer == 0) ln1_router_phase<false>(F, layer, xin); else ln1_router_phase<true>(F, layer, xin); } SEAM(pb + 4); STAMP(9);
        if (PHON(10) && IN(pb + 5)) { refresh(F); unsigned char* ws = opq(F.ws); (void)ws;
            moe_build_table(F, layer);
            const LAS int* ts = (const LAS int*)(F.lc + LC_TS);
            const int ntile = ts[65];
            MoeSched<true> S{ts, (const LAS int*)(F.lc + LC_CNT), 2, ntile * 2, F.G, cid, F.lane, (const int*)(ws + WS_TOKL), (const float*)(ws + WS_WL),
                       (const char*)(ws + WS_WEGU) + (size_t)layer * 64 * MiB, (size_t)1 * MiB, (const char*)(ws + WS_WSHGU) + (size_t)layer * MiB, 2048};
            pg8::EpiGU E{(bf16*)(ws + WS_ACT)};
            pg8::gemm_phase<pg8::EpiGU, MoeSched<true>>(F.tid, F.lds, (const char*)(ws + WS_H), 2048, 2048, 1024, S, E);
        } LSEAM(pb + 5); STAMP(10);
        if (PHON(11) && IN(pb + 6)) { refresh(F); unsigned char* ws = opq(F.ws); (void)ws;
            moe_build_table(F, layer);
            const LAS int* ts = (const LAS int*)(F.lc + LC_TS);
            const int ntile = ts[65];
            MoeSched<false> S{ts, (const LAS int*)(F.lc + LC_CNT), 4, ntile * 4, F.G, cid, F.lane, nullptr, nullptr,
                       (const char*)(ws + WS_WEDN) + (size_t)layer * 32 * MiB, (size_t)512 * 1024, (const char*)(ws + WS_WSHDN) + (size_t)layer * 512 * 1024, 512};
            pg8::EpiStoreF8 E{(unsigned char*)(ws + WS_YS), D, F.lds + LDS_TB_OFF + F.wave * 2048, 0};
            pg8::gemm_phase<pg8::EpiStoreF8, MoeSched<false>>(F.tid, F.lds, (const char*)(ws + WS_ACT), 512, 512, 256, S, E);
        } SEAM(pb + 6); STAMP(11);
        if (PHON(12) && IN(pb + 7)) { refresh(F); unsigned char* ws = opq(F.ws); (void)ws; moe_build_table(F, layer); combine_ln2_phase(F, layer); }
        if (layer < DEPTH - 1) LSEAM(pb + 7);
        STAMP(12);
    }
#ifdef PROBE_TYPE
    if (blockIdx.x == 0 && F.tid == 0) { const unsigned long long t0_ = __builtin_amdgcn_s_memrealtime(); const unsigned long long want_ = 4ull * ((LAS unsigned long long*)(F.lc + LC_STAMP))[1 + PROBE_TYPE];
        while (__builtin_amdgcn_s_memrealtime() - t0_ < want_) __builtin_amdgcn_s_sleep(8); }
#endif
#undef IN
#undef SEAM
}

extern "C" void kernel_launch(void* const* d_in, const int* in_sizes, int n_in, void* d_out, int out_size, void* d_ws, size_t ws_size, hipStream_t stream) {
    static int grid = 0;
    if (grid == 0) {
        if (n_in != 20 || in_sizes[0] != T * D || out_size != T * D || ws_size < WS_END) { fprintf(stderr, "kernel_launch: unexpected shapes / workspace (n_in %d, ws %zu); nothing launched\n", n_in, ws_size); grid = -1; return; }
        int dev = 0, cus = 0, per_cu = 0;
        if (hipGetDevice(&dev) != hipSuccess || hipDeviceGetAttribute(&cus, hipDeviceAttributeMultiprocessorCount, dev) != hipSuccess) { grid = -1; return; }
        if (hipFuncSetAttribute((const void*)mk_fwd, hipFuncAttributeMaxDynamicSharedMemorySize, LDS_BYTES) != hipSuccess) { fprintf(stderr, "kernel_launch: hipFuncSetAttribute failed\n"); grid = -1; return; }
        if (hipOccupancyMaxActiveBlocksPerMultiprocessor(&per_cu, (const void*)mk_fwd, NWAVES * 64, LDS_BYTES) != hipSuccess || per_cu < 1) { fprintf(stderr, "kernel_launch: occupancy query says %d\n", per_cu); }
        (void)hipGetLastError();
        grid = cus;
    }
    if (grid < 0) return;
    if (hipMemsetAsync((char*)d_ws + WS_CTL, 0, CTL_ZERO_BYTES, stream) != hipSuccess) return;
    Args a{};
    for (int i = 0; i < 20; ++i) a.in[i] = (const float*)d_in[i];
    a.out = (float*)d_out; a.ws = (unsigned char*)d_ws;
#if MK_PER_PHASE
    for (int p = 0; p < NPHASE; ++p) { a.ph_lo = p; a.ph_hi = p + 1; hipLaunchKernelGGL(mk_fwd, dim3(grid), dim3(NWAVES * 64), LDS_BYTES, stream, a); }
#else
    a.ph_lo = 0; a.ph_hi = NPHASE;
    hipLaunchKernelGGL(mk_fwd, dim3(grid), dim3(NWAVES * 64), LDS_BYTES, stream, a);
#endif
    const hipError_t le = hipPeekAtLastError();
    if (le != hipSuccess) fprintf(stderr, "kernel_launch: launch failed: %s\n", hipGetErrorName(le));
}
```

```cpp
#include <hip/hip_runtime.h>
#include <cstdio>
#include <cstdint>

#ifndef MK_PER_PHASE
#define MK_PER_PHASE 0
#endif
#define ORACLE_SEL 1
#define ATTN_GMASK 7
#define ORACLE_W 1
#define ORACLE_LAYER 1
#ifndef MK_XLOCAL
#define MK_XLOCAL 1
#endif
#ifndef PHSEL
#define PHSEL 0xFFFF
#endif
#define PHON(n) (((PHSEL) >> (n)) & 1)

#define GAS __attribute__((address_space(1)))
#define LAS __attribute__((address_space(3)))
typedef unsigned short bf16;
typedef short bf16x8 __attribute__((ext_vector_type(8)));
typedef short s16x4 __attribute__((ext_vector_type(4)));
typedef float f32x2 __attribute__((ext_vector_type(2)));
typedef float f32x4 __attribute__((ext_vector_type(4)));
typedef float f32x16 __attribute__((ext_vector_type(16)));
typedef unsigned u32x2 __attribute__((ext_vector_type(2)));
typedef unsigned u32x4 __attribute__((ext_vector_type(4)));

constexpr int BATCH = 8, SEQ = 2048, D = 1024, T = BATCH * SEQ, DEPTH = 4;
constexpr int NQKV = 9216, NE = 64, TOPK = 8, DEXP = 256;
constexpr int CAP = 16384;
constexpr int PSLOT = 147456 + T;
constexpr float ALPHA = 1.6817928305074290f;
constexpr float LN_EPS = 1e-5f;
constexpr float LOG2E = 1.4426950408889634f;
constexpr float QSCALE = 0.125f * LOG2E;
constexpr float ROUTED_SCALE = 2.5f;

constexpr size_t MiB = 1u << 20;
constexpr size_t WS_CTL = 0, CTL_ZERO_BYTES = 1 * MiB;
constexpr size_t WS_MOD = 1 * MiB;
constexpr size_t WS_WRHI = 2 * MiB;
constexpr size_t WS_WRLO = WS_WRHI + 512 * 1024;
constexpr size_t WS_WPIN = 3 * MiB;
constexpr size_t WS_WPGRP = 7 * MiB;
constexpr size_t WS_WPOUT = 8 * MiB;
constexpr size_t WS_WAIN = 12 * MiB;
constexpr size_t WS_WAOUT = 48 * MiB;
constexpr size_t WS_WSHGU = 52 * MiB;
constexpr size_t WS_WSHDN = 56 * MiB;
constexpr size_t WS_WEGU = 58 * MiB;
constexpr size_t WS_WEDN = 314 * MiB;
constexpr size_t WS_X = 442 * MiB;
constexpr size_t WS_H = 506 * MiB;
constexpr size_t WS_Y = 538 * MiB;
constexpr size_t WS_U = 570 * MiB;
constexpr size_t WS_Z = 602 * MiB;
constexpr size_t WS_Y2 = 634 * MiB;
constexpr size_t WS_YS = 666 * MiB;
constexpr size_t WS_ACT = 986 * MiB;
constexpr size_t WS_TOKL = 1066 * MiB;
constexpr size_t WS_WL = 1070 * MiB;
constexpr size_t WS_TSLOT = 1074 * MiB;
constexpr size_t WS_QKV = 1076 * MiB;
constexpr size_t WS_END = 1364 * MiB;
static_assert(WS_YS + (size_t)PSLOT * 2048 <= WS_ACT && WS_ACT + (size_t)PSLOT * 512 <= WS_TOKL, "ws map");
constexpr int CW_BAR = 4096;
constexpr int CW_CNT = 12288;

constexpr int RING_BYTES = 135168;
constexpr int LDSCTL_OFF = RING_BYTES;
constexpr int LDS_TB_OFF = 147456;
constexpr int LDS_BYTES = 163840;
constexpr int LC_MISC = 0;
constexpr int LC_TS = 128;
constexpr int LC_CNT = 128 + 272;
constexpr int LC_LCNT = 128 + 272 + 256;
constexpr int LC_GB = 128 + 272 + 512;

#define RLX_AGENT __ATOMIC_RELAXED, __HIP_MEMORY_SCOPE_AGENT
#define LDS_WAIT() asm volatile("s_waitcnt lgkmcnt(0)" ::: "memory")
#define VM_WAIT() asm volatile("s_waitcnt vmcnt(0)" ::: "memory")

typedef __bf16 b16x2 __attribute__((ext_vector_type(2)));
__device__ __forceinline__ unsigned f2bf(float f) { unsigned u = __builtin_bit_cast(unsigned, f); return (u + 0x7fffu + ((u >> 16) & 1u)) >> 16; }
__device__ __forceinline__ unsigned pk2(float lo, float hi) { const f32x2 v = {lo, hi}; return __builtin_bit_cast(unsigned, __builtin_convertvector(v, b16x2)); }
__device__ __forceinline__ float bf2f(unsigned h) { return __builtin_bit_cast(float, h << 16); }
__device__ __forceinline__ unsigned cvt_pk_bf16(float lo, float hi) { return pk2(lo, hi); }
typedef _Float16 h16x2 __attribute__((ext_vector_type(2)));
__device__ __forceinline__ unsigned pkh2(float lo, float hi) { const f32x2 v = {lo, hi}; return __builtin_bit_cast(unsigned, __builtin_convertvector(v, h16x2)); }
__device__ __forceinline__ float h2f(unsigned h) { return (float)__builtin_bit_cast(_Float16, (unsigned short)h); }
#define MFMA16(a, b, c) __builtin_amdgcn_mfma_f32_16x16x32_bf16(a, b, c, 0, 0, 0)
#define MFMA32(a, b, c) __builtin_amdgcn_mfma_f32_32x32x16_bf16(a, b, c, 0, 0, 0)
__device__ __forceinline__ float wave_sum(float v) {
#pragma unroll
    for (int o = 1; o < 64; o <<= 1) v += __shfl_xor(v, o);
    return v;
}

namespace pg8 {
constexpr int BM = 256, BK = 64, HALF = 128, HTB = HALF * BK * 2, STAGE_BYTES = 8 * HTB, NXCD = 8;
__host__ __device__ __forceinline__ int lds_byte(int r, int c) { const int st = (r >> 4) * 2 + (c >> 5), rr = r & 15, cc = c & 31, ob = rr * 64 + cc * 2; return st * 1024 + (ob ^ (((ob >> 9) & 1) << 5)); }
__host__ __device__ __forceinline__ void stage_rc(int b, int& R, int& C) { const int st = b / 1024, sb = b % 1024, swz = sb ^ (((sb >> 9) & 1) << 5); R = (st >> 1) * 16 + swz / 64; C = (st & 1) * 32 + (swz % 64) / 2; }
__host__ __device__ __forceinline__ int perm32(int rho) { const int n = rho >> 4, i = rho & 15; return 8 * (i >> 2) + 4 * n + (i & 3); }

struct Unit {
    int pm, pn;
    const char* bptr;
    int roff;
    int nvalid;
};

__device__ __forceinline__ int xcd_chunk(int L, int nwg) { const int q = nwg / NXCD, r = nwg % NXCD, xcd = L % NXCD, off = L / NXCD; return (xcd < r ? xcd * (q + 1) : r * (q + 1) + (xcd - r) * q) + off; }

template <class Epi, class Sched>
__device__ __forceinline__ void gemm_phase(const int tid, LAS unsigned char* lds, const char* Abase, const int lda, const int ldb, const int K, const Sched& S, const Epi& E) {
    constexpr bool GATHER = Sched::GATHER;
    const int wid = __builtin_amdgcn_readfirstlane(tid >> 6), lane = tid & 63, wr = wid >> 2, wc = wid & 3, fr = lane & 15, fq = lane >> 4;
    const int nt = K / BK;
    int Rr[2]; unsigned C2[2], voffB[2], voffA[2];
#pragma unroll
    for (int i = 0; i < 2; ++i) { int R, C; stage_rc(tid * 16 + i * 8192, R, C); const int Rb = Epi::WIDE ? ((R >> 5) * 64 + perm32(R & 31)) : ((R & ~31) + perm32(R & 31)); Rr[i] = R; C2[i] = (unsigned)C * 2u; voffB[i] = (unsigned)(Rb * ldb) + (unsigned)C * 2u;
        voffA[i] = Sched::ABLK ? (unsigned)((C >> 5) * 16384 + R * 64 + (C & 31) * 2) : ((unsigned)(R * lda) + (unsigned)C * 2u); }
    const size_t kstep = (size_t)(BK * 2);
    const size_t hstepB = (size_t)(Epi::WIDE ? 32 : HALF) * ldb;
    const size_t hstepA = GATHER ? (size_t)0 : (Sched::ABLK ? (size_t)8192 : (size_t)HALF * lda);
    const size_t kstepA = Sched::ABLK ? (size_t)32768 : kstep;
    const unsigned ldsw = (unsigned)wid * 1024u;
    const int aoff = lds_byte(wr * 64 + fr, fq * 8), boff = lds_byte(wc * 32 + fr, fq * 8);
#define PG8_SA(b, h) (((b) * 2 + (h)) * HTB)
#define PG8_SB(b, h) ((4 + (b) * 2 + (h)) * HTB)
#define PG8_STAGE(bufoff, gbase, voff) do { _Pragma("unroll") for (int _i = 0; _i < 2; ++_i) \
        __builtin_amdgcn_global_load_lds((const unsigned*)((const char*)(gbase) + (voff)[_i]), (LAS unsigned*)(lds + (bufoff) + ldsw + _i * 8192), 16, 0, 0); } while (0)
#define PG8_STAGEA(bufoff, gbase, h) do { if constexpr (GATHER) { PG8_STAGE(bufoff, gbase, vA[h]); } else { PG8_STAGE(bufoff, (gbase) + (h) * hstepA, voffA); } } while (0)
#define PG8_LDA(dst, b, h) do { _Pragma("unroll") for (int m = 0; m < 4; ++m) _Pragma("unroll") for (int k = 0; k < 2; ++k) dst[m][k] = *(const LAS bf16x8*)(lds + PG8_SA(b, h) + aoff + m * 2048 + k * 1024); } while (0)
#define PG8_LDB(dst, b, h) do { _Pragma("unroll") for (int n = 0; n < 2; ++n) _Pragma("unroll") for (int k = 0; k < 2; ++k) dst[n][k] = *(const LAS bf16x8*)(lds + PG8_SB(b, h) + boff + n * 2048 + k * 1024); } while (0)
#define PG8_MMA(ai, bj, At, Bt) do { __builtin_amdgcn_s_setprio(1); _Pragma("unroll") for (int m = 0; m < 4; ++m) _Pragma("unroll") for (int n = 0; n < 2; ++n) _Pragma("unroll") for (int k = 0; k < 2; ++k) \
        acc[ai][bj][m][n] = MFMA16(Bt[n][k], At[m][k], acc[ai][bj][m][n]); __builtin_amdgcn_s_setprio(0); } while (0)
#define PG8_WAIT_V(n) asm volatile("s_waitcnt vmcnt(" #n ")" ::: "memory")
#define PG8_WAIT_L(n) asm volatile("s_waitcnt lgkmcnt(" #n ")" ::: "memory")
#define PG8_BAR __builtin_amdgcn_s_barrier()
#define PG8_SCHED __builtin_amdgcn_sched_barrier(0)
#define PG8_CALCA(u, vo) do { _Pragma("unroll") for (int _h = 0; _h < 2; ++_h) _Pragma("unroll") for (int _i = 0; _i < 2; ++_i) \
        vo[_h][_i] = (unsigned)S.arow(u, _h * HALF + Rr[_i]) * (unsigned)lda + C2[_i]; } while (0)
    Unit cur, nxt; int ui = 0;
    if (!S.next(0, cur)) return;
    f32x4 acc[2][2][4][2];
#pragma unroll
    for (int a = 0; a < 2; ++a)
#pragma unroll
        for (int b = 0; b < 2; ++b)
#pragma unroll
            for (int m = 0; m < 4; ++m)
#pragma unroll
                for (int n = 0; n < 2; ++n) acc[a][b][m][n] = (f32x4){0.f, 0.f, 0.f, 0.f};
    bf16x8 At[4][2], B0[2][2], B1[2][2];
    unsigned vA[2][2], vAn[2][2];
    const char* cA = Abase;
    if constexpr (GATHER) { PG8_CALCA(cur, vA); } else { cA = Abase + (size_t)S.arow(cur, 0) * lda + S.acolb(cur); }
    const char* cB = cur.bptr;
    PG8_STAGE(PG8_SB(0, 0), cB, voffB); PG8_STAGE(PG8_SB(0, 1), cB + hstepB, voffB); PG8_STAGEA(PG8_SA(0, 0), cA, 0); PG8_STAGEA(PG8_SA(0, 1), cA, 1);
    if (wr == 1) PG8_BAR;
    PG8_WAIT_V(2); PG8_BAR;
    PG8_STAGE(PG8_SB(1, 0), cB + kstep, voffB); PG8_STAGEA(PG8_SA(1, 0), cA + kstepA, 0); PG8_STAGE(PG8_SB(1, 1), cB + hstepB + kstep, voffB);
    PG8_WAIT_V(6); PG8_BAR;
    for (;;) {
        const bool has_next = S.next(ui + 1, nxt);
        float rs[2][4];
        if constexpr (Epi::ROWSCALE) {
#pragma unroll
            for (int ai = 0; ai < 2; ++ai)
#pragma unroll
                for (int m = 0; m < 4; ++m) rs[ai][m] = S.rowscale(cur, ai * HALF + wr * 64 + m * 16 + fr);
        }
        const char* nA = cA;
        if constexpr (GATHER) {
            if (has_next) { PG8_CALCA(nxt, vAn); }
            else {
#pragma unroll
                for (int h = 0; h < 2; ++h)
#pragma unroll
                    for (int i = 0; i < 2; ++i) vAn[h][i] = vA[h][i];
            }
            asm volatile("s_waitcnt vmcnt(0)" : "+v"(vAn[0][0]), "+v"(vAn[0][1]), "+v"(vAn[1][0]), "+v"(vAn[1][1]) :: "memory");
            if constexpr (Epi::ROWSCALE) { asm volatile("" : "+v"(rs[0][0]), "+v"(rs[0][1]), "+v"(rs[0][2]), "+v"(rs[0][3]), "+v"(rs[1][0]), "+v"(rs[1][1]), "+v"(rs[1][2]), "+v"(rs[1][3])); }
        } else { if (has_next) nA = Abase + (size_t)S.arow(nxt, 0) * lda + S.acolb(nxt); }
        const char* nB = has_next ? nxt.bptr : cB;
#pragma unroll 1
        for (int t = 0; t < nt; t += 2) {
            const bool last = (t == nt - 2);
            const char* a1 = cA + (size_t)(t + 1) * kstepA;
            const char* a2 = last ? nA : cA + (size_t)(t + 2) * kstepA; const char* b2 = last ? nB : cB + (size_t)(t + 2) * kstep;
            const char* a3 = a2 + kstepA; const char* b3 = b2 + kstep;
            PG8_LDB(B0, 0, 0); PG8_LDB(B1, 0, 1); PG8_SCHED; PG8_LDA(At, 0, 0); PG8_STAGEA(PG8_SA(1, 1), a1, 1);
            if constexpr (GATHER) { if (last) {
#pragma unroll
                for (int h = 0; h < 2; ++h)
#pragma unroll
                    for (int i = 0; i < 2; ++i) vA[h][i] = vAn[h][i]; } }
            PG8_WAIT_V(8); PG8_WAIT_L(0); PG8_BAR; PG8_MMA(0, 0, At, B0); PG8_MMA(0, 1, At, B1); PG8_BAR; PG8_SCHED;
            PG8_LDA(At, 0, 1); PG8_STAGE(PG8_SB(0, 0), b2, voffB); PG8_STAGE(PG8_SB(0, 1), b2 + hstepB, voffB); PG8_STAGEA(PG8_SA(0, 0), a2, 0);
            PG8_WAIT_V(8); PG8_WAIT_L(0); PG8_BAR; PG8_MMA(1, 0, At, B0); PG8_MMA(1, 1, At, B1); PG8_BAR; PG8_SCHED;
            PG8_LDB(B0, 1, 0); PG8_LDB(B1, 1, 1); PG8_SCHED; PG8_LDA(At, 1, 0); PG8_STAGEA(PG8_SA(0, 1), a2, 1);
            PG8_WAIT_V(8); PG8_WAIT_L(0); PG8_BAR; PG8_MMA(0, 0, At, B0); PG8_MMA(0, 1, At, B1); PG8_BAR; PG8_SCHED;
            PG8_LDA(At, 1, 1); PG8_STAGE(PG8_SB(1, 0), b3, voffB); PG8_STAGE(PG8_SB(1, 1), b3 + hstepB, voffB); PG8_STAGEA(PG8_SA(1, 0), a3, 0);
            PG8_WAIT_V(8); PG8_WAIT_L(0); PG8_BAR; PG8_MMA(1, 0, At, B0); PG8_MMA(1, 1, At, B1); PG8_BAR; PG8_SCHED;
        }
        if (wr == 0) PG8_BAR;
        E(acc, cur, rs, wr, wc, fr, fq);
        if (!has_next) break;
#pragma unroll
        for (int a = 0; a < 2; ++a)
#pragma unroll
            for (int b = 0; b < 2; ++b)
#pragma unroll
                for (int m = 0; m < 4; ++m)
#pragma unroll
                    for (int n = 0; n < 2; ++n) acc[a][b][m][n] = (f32x4){0.f, 0.f, 0.f, 0.f};
        cur = nxt; cB = nB; cA = nA; ++ui;
        if (wr == 1) PG8_BAR;
    }
    PG8_WAIT_V(0);
    PG8_BAR;
#undef PG8_SA
#undef PG8_SB
#undef PG8_STAGE
#undef PG8_STAGEA
#undef PG8_LDA
#undef PG8_LDB
#undef PG8_MMA
#undef PG8_WAIT_V
#undef PG8_WAIT_L
#undef PG8_BAR
#undef PG8_SCHED
#undef PG8_CALCA
}

struct EpiStore {
    static constexpr bool ROWSCALE = false, WIDE = true;
    bf16* O; int ldc; const float* cscale; int qmode; int ntst; int f16; LAS unsigned char* tb;
    __device__ __forceinline__ void operator()(const f32x4 (&acc)[2][2][4][2], const Unit& u, const float (&rs)[2][4], int wr, int wc, int fr, int fq) const {
        const int colw = u.pn * BM + wc * 64;
        float sc = 1.f; if (qmode) { if ((((u.pn * BM) >> 10) % 3) == 0) sc = QSCALE; }
        f32x4 cs[2][2];
#pragma unroll
        for (int bj = 0; bj < 2; ++bj)
#pragma unroll
            for (int n = 0; n < 2; ++n) { cs[bj][n] = cscale ? *(const f32x4*)(cscale + colw + 32 * bj + 8 * fq + 4 * n) : (f32x4){1.f, 1.f, 1.f, 1.f}; cs[bj][n] = cs[bj][n] * sc; }
        const int L = fr + 16 * fq, rr = L >> 3, sg = L & 7;
        LAS u32x4* tbv = (LAS u32x4*)tb;
        const int wi0 = fr * 8 + (fq ^ (fr & 7)), wi1 = fr * 8 + ((4 + fq) ^ (fr & 7)), ri = rr * 8 + (sg ^ rr);
        bf16* gp = O + (size_t)(u.pm * BM + wr * 64 + rr) * ldc + colw + sg * 8;
#pragma unroll
        for (int ai = 0; ai < 2; ++ai)
#pragma unroll
            for (int m = 0; m < 4; ++m) {
                u32x4 w[2];
#pragma unroll
                for (int bj = 0; bj < 2; ++bj) { const f32x4 v0 = acc[ai][bj][m][0] * cs[bj][0], v1 = acc[ai][bj][m][1] * cs[bj][1];
                    if (f16) { w[bj].x = pkh2(v0[0], v0[1]); w[bj].y = pkh2(v0[2], v0[3]); w[bj].z = pkh2(v1[0], v1[1]); w[bj].w = pkh2(v1[2], v1[3]); }
                    else { w[bj].x = cvt_pk_bf16(v0[0], v0[1]); w[bj].y = cvt_pk_bf16(v0[2], v0[3]); w[bj].z = cvt_pk_bf16(v1[0], v1[1]); w[bj].w = cvt_pk_bf16(v1[2], v1[3]); } }
                tbv[wi0] = w[0]; tbv[wi1] = w[1];
                asm volatile("" ::: "memory");
                const u32x4 r0 = tbv[ri], r1 = tbv[ri + 64];
                asm volatile("" ::: "memory");
                bf16* rowp = gp + (size_t)(ai * HALF + m * 16) * ldc;
                if (ntst) { __builtin_nontemporal_store(r0, (u32x4*)rowp); __builtin_nontemporal_store(r1, (u32x4*)(rowp + (size_t)8 * ldc)); }
                else { *(u32x4*)rowp = r0; *(u32x4*)(rowp + (size_t)8 * ldc) = r1; } }
    }
};
typedef unsigned u32x2_t __attribute__((ext_vector_type(2)));
struct EpiStoreF8 {
    static constexpr bool ROWSCALE = false, WIDE = true;
    unsigned char* O; int ldc; LAS unsigned char* tb; int qmode;
    __device__ __forceinline__ void operator()(const f32x4 (&acc)[2][2][4][2], const Unit& u, const float (&rs)[2][4], int wr, int wc, int fr, int fq) const {
        const int colw = u.pn * BM + wc * 64;
        const float osc = qmode ? (((((u.pn * BM) >> 10) % 3) == 0) ? QSCALE * 64.0f : 16.0f) : 32.0f;
        const int L = fr + 16 * fq, rr = L >> 2, sg = L & 3;
        LAS unsigned char* wp0 = tb + fr * 64 + ((fq) ^ (fr & 7)) * 8; LAS unsigned char* wp1 = tb + fr * 64 + ((4 + fq) ^ (fr & 7)) * 8;
        const LAS unsigned char* rp0 = tb + rr * 64 + ((2 * sg) ^ (rr & 7)) * 8; const LAS unsigned char* rp1 = tb + rr * 64 + ((2 * sg + 1) ^ (rr & 7)) * 8;
        unsigned char* gp = O + (size_t)(u.pm * BM + wr * 64 + rr) * ldc + colw + sg * 16;
#pragma unroll
        for (int ai = 0; ai < 2; ++ai)
#pragma unroll
            for (int m = 0; m < 4; ++m) {
                u32x2_t w[2];
#pragma unroll
                for (int bj = 0; bj < 2; ++bj) { f32x4 v0 = acc[ai][bj][m][0] * osc, v1 = acc[ai][bj][m][1] * osc;
#pragma unroll
                    for (int e = 0; e < 4; ++e) { v0[e] = __builtin_amdgcn_fmed3f(v0[e], -448.0f, 448.0f); v1[e] = __builtin_amdgcn_fmed3f(v1[e], -448.0f, 448.0f); }
                    int p0 = __builtin_amdgcn_cvt_pk_fp8_f32(v0[0], v0[1], 0, false); p0 = __builtin_amdgcn_cvt_pk_fp8_f32(v0[2], v0[3], p0, true);
                    int p1 = __builtin_amdgcn_cvt_pk_fp8_f32(v1[0], v1[1], 0, false); p1 = __builtin_amdgcn_cvt_pk_fp8_f32(v1[2], v1[3], p1, true);
                    w[bj].x = (unsigned)p0; w[bj].y = (unsigned)p1; }
                *(LAS u32x2_t*)wp0 = w[0]; *(LAS u32x2_t*)wp1 = w[1];
                asm volatile("" ::: "memory");
                const u32x2_t a = *(const LAS u32x2_t*)rp0, b = *(const LAS u32x2_t*)rp1;
                asm volatile("" ::: "memory");
                u32x4 o; o.x = a.x; o.y = a.y; o.z = b.x; o.w = b.y;
                *(GAS u32x4*)(gp + (size_t)(ai * HALF + m * 16) * ldc) = o; }
    }
};
struct EpiGU {
    static constexpr bool ROWSCALE = false, WIDE = false;
    bf16* O;
    __device__ __forceinline__ void operator()(const f32x4 (&acc)[2][2][4][2], const Unit& u, const float (&rs)[2][4], int wr, int wc, int fr, int fq) const {
        bf16* tp = O + (size_t)u.pm * (BM * DEXP) + (size_t)(u.pn * 4 + wc) * (BM * 32) + (wr * 64 + fr) * 32 + 8 * fq;
#pragma unroll
        for (int ai = 0; ai < 2; ++ai)
#pragma unroll
            for (int m = 0; m < 4; ++m) { bf16* rowp = tp + (ai * HALF + m * 16) * 32;
                float o[8];
#pragma unroll
                for (int n = 0; n < 2; ++n)
#pragma unroll
                    for (int j = 0; j < 4; ++j) { const float g = acc[ai][0][m][n][j], uu = acc[ai][1][m][n][j];
                        const float sg = g * __builtin_amdgcn_rcpf(1.0f + __builtin_amdgcn_exp2f(-g * LOG2E)); o[n * 4 + j] = sg * uu; }
                u32x4 wv; wv.x = cvt_pk_bf16(o[0], o[1]); wv.y = cvt_pk_bf16(o[2], o[3]); wv.z = cvt_pk_bf16(o[4], o[5]); wv.w = cvt_pk_bf16(o[6], o[7]);
                *(u32x4*)rowp = wv; }
    }
};
}

#define XB_TMO      128
#define XB_XCNT(j)  (256  + 64 * (j))
#define XB_XSUB(j)  (1280 + 64 * (j))
#define XB_XGEN(j)  (2304 + 64 * (j))
#define XB_TOP      3328
#define XB_TOPGEN   3392
#define XB_LSUB(j)  (3456 + 64 * (j))
#define XB_LGEN(j)  (4480 + 64 * (j))
#define XCD_BAR_WORDS 5504
#define XB_SPIN_CAP (1u << 18)
__device__ __forceinline__ unsigned xb_ld(unsigned* p)              { return __hip_atomic_load(p, __ATOMIC_RELAXED, __HIP_MEMORY_SCOPE_AGENT); }
__device__ __forceinline__ unsigned xb_add(unsigned* p, unsigned v) { return __hip_atomic_fetch_add(p, v, __ATOMIC_RELAXED, __HIP_MEMORY_SCOPE_AGENT); }
__device__ __forceinline__ unsigned xb_xcc_id() { return (unsigned)__builtin_amdgcn_s_getreg((3 << 11) | 20) & 0xFu; }
#define XB_SPIN(cond, bar) do { unsigned _sp = 0; while (cond) { __builtin_amdgcn_s_sleep(1); \
    if ((++_sp & 255u) == 0u) { if (xb_ld(&(bar)[XB_TMO])) break; if (_sp > XB_SPIN_CAP) { atomicAdd(&(bar)[XB_TMO], 1u); break; } } } } while (0)
struct XcdBarrier { unsigned* bar; unsigned x; volatile LAS unsigned* st; };
__device__ __forceinline__ XcdBarrier xcd_barrier_post(unsigned* bar, volatile LAS unsigned* st) {
    XcdBarrier b; b.bar = bar; b.x = xb_xcc_id(); b.st = st;
    if (threadIdx.x == 0) st[2] = xb_add(&bar[XB_XCNT(b.x)], 1u);
    return b;
}
__device__ __forceinline__ void xcd_local_barrier(const XcdBarrier& b, const bool wave0) {
    asm volatile("s_waitcnt vmcnt(0)" ::: "memory");
    __syncthreads();
    if (wave0 && __builtin_amdgcn_mbcnt_hi(~0u, __builtin_amdgcn_mbcnt_lo(~0u, 0u)) == 0u) {
        unsigned* bar = b.bar;
        __builtin_amdgcn_s_waitcnt(0);
        const unsigned nloc = b.st[0];
        const unsigned old = xb_add(&bar[XB_LSUB(b.x)], 1u);
        const unsigned gen = old / nloc;
        if (old + 1u == (gen + 1u) * nloc) xb_add(&bar[XB_LGEN(b.x)], 1u);
        else XB_SPIN(xb_ld(&bar[XB_LGEN(b.x)]) == gen, bar);
        __builtin_amdgcn_fence(__ATOMIC_ACQUIRE, "agent");
        asm volatile("s_waitcnt vmcnt(0)" ::: "memory");
    }
    __syncthreads();
}
__device__ __forceinline__ void xcd_barrier_complete(unsigned* bar, unsigned x, unsigned& nloc, unsigned& nx) {
    const unsigned G = gridDim.x * gridDim.y * gridDim.z;
    unsigned sum, cnt, mine, sp = 0u;
    for (;;) {
        sum = 0u; cnt = 0u; mine = 0u;
#pragma unroll
        for (unsigned j = 0; j < 16; ++j) { const unsigned c = xb_ld(&bar[XB_XCNT(j)]); sum += c; cnt += (c > 0u) ? 1u : 0u; mine = (j == x) ? c : mine; }
        if (sum == G) break;
        __builtin_amdgcn_s_sleep(1);
        if ((++sp & 255u) == 0u) { if (xb_ld(&bar[XB_TMO])) break; if (sp > XB_SPIN_CAP) { atomicAdd(&bar[XB_TMO], 1u); break; } }
    }
    nloc = mine > 0u ? mine : 1u; nx = cnt > 0u ? cnt : 1u;
}
__device__ __forceinline__ void xcd_barrier(const XcdBarrier& b) {
    asm volatile("s_waitcnt vmcnt(0)" ::: "memory");
    __syncthreads();
    if (threadIdx.x == 0) {
        unsigned* bar = b.bar;
        __builtin_amdgcn_s_waitcnt(0);
        unsigned nloc = b.st[0], nx = b.st[1];
        if (nloc == 0u) { xcd_barrier_complete(bar, b.x, nloc, nx); b.st[0] = nloc; b.st[1] = nx; }
        const unsigned old = xb_add(&bar[XB_XSUB(b.x)], 1u);
        const unsigned gen = old / nloc;
        if (old + 1u == (gen + 1u) * nloc) {
            __builtin_amdgcn_fence(__ATOMIC_RELEASE, "agent");
            asm volatile("s_waitcnt vmcnt(0)" ::: "memory");
            const unsigned og = xb_add(&bar[XB_TOP], 1u);
            const unsigned tg = og / nx;
            if (og + 1u == (tg + 1u) * nx) xb_add(&bar[XB_TOPGEN], 1u);
            else XB_SPIN(xb_ld(&bar[XB_TOPGEN]) == tg, bar);
            __builtin_amdgcn_fence(__ATOMIC_ACQUIRE, "agent");
            xb_add(&bar[XB_XGEN(b.x)], 1u);
            asm volatile("s_waitcnt vmcnt(0)" ::: "memory");
        } else {
            XB_SPIN(xb_ld(&bar[XB_XGEN(b.x)]) == gen, bar);
            __builtin_amdgcn_fence(__ATOMIC_ACQUIRE, "agent");
            asm volatile("s_waitcnt vmcnt(0)" ::: "memory");
        }
    }
    __syncthreads();
}

constexpr int NWAVES = 8;
struct Frame {
    LAS unsigned char* lds;
    LAS unsigned char* lc;
    unsigned* ctl;
    unsigned char* ws;
    int tid, lane, wave, vcu, G;
};
constexpr int LC_PTR = 2048;
__device__ __forceinline__ const float* inp(const Frame& F, int i) {
    const unsigned long long v = *(const LAS unsigned long long*)(F.lc + LC_PTR + 8 * i);
    const unsigned lo = __builtin_amdgcn_readfirstlane((unsigned)v), hi = __builtin_amdgcn_readfirstlane((unsigned)(v >> 32));
    return (const float*)(const GAS float*)(((unsigned long long)hi << 32) | lo);
}
__device__ __forceinline__ unsigned char* opq(unsigned char* p) { GAS unsigned char* g = (GAS unsigned char*)p; asm volatile("" : "+s"(g)); return (unsigned char*)g; }
__device__ __forceinline__ void refresh(Frame& F) { asm volatile("" : "+v"(F.tid)); F.lane = F.tid & 63; F.wave = __builtin_amdgcn_readfirstlane(F.tid >> 6); }

struct PlainSched {   static constexpr bool GATHER = false, ABLK = false;
    int nM, nN, nwg, G, c; const char* B; int ldb;
    __device__ __forceinline__ bool next(int i, pg8::Unit& u) const {
        const int L = i * G + c; if (L >= nwg) return false;
        const int wgid = pg8::xcd_chunk(L, nwg);
        const int nig = 8 * nN, gid = wgid / nig, fm = gid * 8, gsz = (nM - fm) < 8 ? (nM - fm) : 8;
        u.pm = fm + ((wgid % nig) % gsz); u.pn = (wgid % nig) / gsz;
        u.bptr = B + (size_t)u.pn * 256 * ldb; u.roff = -(u.pm * 256) - 1; u.nvalid = 256; return true;
    }
    __device__ __forceinline__ int arow(const pg8::Unit& u, int r) const { return -u.roff - 1 + r; }
    __device__ __forceinline__ int acolb(const pg8::Unit&) const { return 0; }
    __device__ __forceinline__ float rowscale(const pg8::Unit&, int) const { return 1.0f; }
};
struct GrpSched {     static constexpr bool GATHER = false, ABLK = false;
    int G, c; const char* B;
    __device__ __forceinline__ bool next(int i, pg8::Unit& u) const {
        const int L = i * G + c; if (L >= 256) return false;
        const int wgid = pg8::xcd_chunk(L, 256);
        u.pm = wgid >> 2; u.pn = wgid & 3; u.bptr = B + (size_t)u.pn * 256 * 512; u.roff = -(u.pm * 256) - 1; u.nvalid = 256; return true;
    }
    __device__ __forceinline__ int arow(const pg8::Unit& u, int r) const { return -u.roff - 1 + r; }
    __device__ __forceinline__ int acolb(const pg8::Unit& u) const { return u.pn * 512; }
    __device__ __forceinline__ float rowscale(const pg8::Unit&, int) const { return 1.0f; }
};
template <bool GATHER_> struct MoeSched {     static constexpr bool GATHER = GATHER_, ABLK = !GATHER_;
    const LAS int* ts; const LAS int* cn; int npn, nunits, G, c, lane_;
    const int* tokl; const float* wl; const char* Bexp; size_t bstride; const char* Bsh; int ldb;
    __device__ __forceinline__ bool next(int i, pg8::Unit& u) const {
        const int L = i * G + c; const int xg = L % pg8::NXCD, off = L / pg8::NXCD;
        const int ntile = nunits / npn, tq = ntile / pg8::NXCD, tr = ntile % pg8::NXCD;
        const int tcnt = tq + (xg < tr ? 1 : 0), tstart = xg * tq + (xg < tr ? xg : tr);
        if (off >= tcnt * npn) return false;
        const int tile = tstart + off / npn, pn = off % npn;
        const int lane = lane_;
        const bool hit = (tile >= ts[lane]) && (tile < ts[lane + 1]);
        const unsigned long long mk = __ballot(hit);
        const int e = mk ? (int)__builtin_ctzll(mk) : 64;
        const int tse = __builtin_amdgcn_readfirstlane(ts[e]);
        const int r0 = (tile - tse) * 256;
        u.pm = tile; u.pn = pn;
        u.bptr = (e < 64 ? Bexp + (size_t)e * bstride : Bsh) + (size_t)pn * 256 * ldb;
        if (GATHER) {
            if (e < 64) { const int ce = __builtin_amdgcn_readfirstlane(cn[e]); u.roff = e * CAP + r0; u.nvalid = (ce - r0) < 256 ? (ce - r0) : 256; }
            else { u.roff = -r0 - 1; u.nvalid = 256; }
        } else { u.roff = -(tile * 256) - 1; u.nvalid = 256; }
        return true;
    }
    __device__ __forceinline__ int arow(const pg8::Unit& u, int r) const { if (GATHER && u.roff >= 0) { const int rr = r < u.nvalid ? r : u.nvalid - 1; return tokl[u.roff + rr]; } return -u.roff - 1 + r; }
    __device__ __forceinline__ int acolb(const pg8::Unit&) const { return 0; }
    __device__ __forceinline__ float rowscale(const pg8::Unit& u, int r) const { if (GATHER && u.roff >= 0) { const int rr = r < u.nvalid ? r : u.nvalid - 1; return wl[u.roff + rr]; } return 1.0f; }
};

__device__ __forceinline__ void p0_transpose_item64(const float* W, int K, int N, bf16* WT, int dst_n0, LAS float* scr, int kb, int nb, int lane) {
    const int k0 = 64 * kb, n0 = 64 * nb; const int r = lane >> 4, c4 = lane & 15;
    f32x4 v[16];
#pragma unroll
    for (int i = 0; i < 16; ++i) v[i] = __builtin_nontemporal_load((const GAS f32x4*)(W + (size_t)(k0 + 4 * i + r) * N + n0 + 4 * c4));
#pragma unroll
    for (int i = 0; i < 16; ++i) { const int k = 4 * i + r; *(LAS f32x4*)(scr + k * 64 + 4 * (c4 ^ (k >> 3))) = v[i]; }
    LDS_WAIT(); asm volatile("" ::: "memory");
    const int c = lane & 7;
#pragma unroll
    for (int j = 0; j < 8; ++j) { const int n = (lane >> 3) + 8 * j; const LAS float* sp = scr + (8 * c) * 64 + 4 * ((n >> 2) ^ c) + (n & 3);
        u32x4 o; o.x = pk2(sp[0 * 64], sp[1 * 64]); o.y = pk2(sp[2 * 64], sp[3 * 64]); o.z = pk2(sp[4 * 64], sp[5 * 64]); o.w = pk2(sp[6 * 64], sp[7 * 64]);
        *(GAS u32x4*)(WT + (size_t)(dst_n0 + n) * K + k0 + 8 * c) = o; }
    LDS_WAIT(); asm volatile("" ::: "memory");
}
__device__ __forceinline__ void p0_router_item(const float* W, bf16* WH, bf16* WLo, LAS float* scr, int kb, int nb, int lane) {
    const int K = 1024, N = 64; const int k0 = 64 * kb, n0 = 32 * nb;
#pragma unroll 8
    for (int i = 0; i < 32; ++i) { const int kk = 2 * i + (lane >> 5); scr[kk * 33 + (lane & 31)] = W[(size_t)(k0 + kk) * N + n0 + (lane & 31)]; }
    LDS_WAIT(); asm volatile("" ::: "memory");
    const int c = lane & 7;
#pragma unroll
    for (int j = 0; j < 4; ++j) { const int n = (lane >> 3) + 8 * j; const LAS float* s = scr + (8 * c) * 33 + n;
        unsigned h[8], l[8];
#pragma unroll
        for (int q = 0; q < 8; ++q) { const float v = s[q * 33]; h[q] = f2bf(v); l[q] = f2bf(v - bf2f(h[q])); }
        u32x4 oh, ol; oh.x = h[0] | (h[1] << 16); oh.y = h[2] | (h[3] << 16); oh.z = h[4] | (h[5] << 16); oh.w = h[6] | (h[7] << 16);
        ol.x = l[0] | (l[1] << 16); ol.y = l[2] | (l[3] << 16); ol.z = l[4] | (l[5] << 16); ol.w = l[6] | (l[7] << 16);
        *(GAS u32x4*)(WH + (size_t)(n0 + n) * K + k0 + 8 * c) = oh; *(GAS u32x4*)(WLo + (size_t)(n0 + n) * K + k0 + 8 * c) = ol; }
    LDS_WAIT(); asm volatile("" ::: "memory");
}

__device__ __forceinline__ void p0_prologue(Frame& F) {
    LAS float* cs = (LAS float*)(F.lds);
    LAS float* part = (LAS float*)(F.lds + 32768);
    const float* c = inp(F, 1);
    for (int i = F.tid; i < 8 * 1024; i += 512) { const float v = c[i]; cs[i] = v / (1.0f + __expf(-v)); }
    __syncthreads();
    float* mod = (float*)(F.ws + WS_MOD);
    for (int it = F.vcu; it < 4 * 96; it += F.G) {
        const int layer = it / 96, slab = it % 96; const int col = slab * 64 + F.lane;
        const float* W = inp(F, 2) + (size_t)layer * 1024 * 6144 + col;
        float a[8];
#pragma unroll
        for (int b = 0; b < 8; ++b) a[b] = 0.f;
        const int k0 = F.wave * 128;
#pragma unroll 4
        for (int k = 0; k < 128; k += 4) {
            float w[4];
#pragma unroll
            for (int j = 0; j < 4; ++j) w[j] = W[(size_t)(k0 + k + j) * 6144];
#pragma unroll
            for (int b = 0; b < 8; ++b) { const f32x4 cv = *(const LAS f32x4*)(cs + b * 1024 + k0 + k); a[b] += cv[0] * w[0] + cv[1] * w[1] + cv[2] * w[2] + cv[3] * w[3]; }
        }
#pragma unroll
        for (int b = 0; b < 8; ++b) part[(F.wave * 8 + b) * 64 + F.lane] = a[b];
        __syncthreads();
        { const int b = F.wave; float s = 0.f;
#pragma unroll
          for (int w = 0; w < 8; ++w) s += part[(w * 8 + b) * 64 + F.lane];
          mod[((size_t)layer * 8 + b) * 6144 + col] = s + inp(F, 3)[layer * 6144 + col]; }
        __syncthreads();
    }
    __syncthreads();
    LAS float* scr = (LAS float*)(F.lds + F.wave * 16384);
    const int gw = F.vcu * NWAVES + F.wave, NGW = F.G * NWAVES;
    constexpr int I_PIN = 2 * 16 * 16, I_GRP = 8 * 4 * 4, I_POUT = I_PIN, I_AIN = 2 * 16 * 144, I_AOUT = I_PIN, I_SHGU = 4 * 16 * 8, I_SHDN = 4 * 4 * 16, I_R = 4 * 16 * 2;
    constexpr int I_EGU = 256 * 16 * 8, I_EDN = 256 * 4 * 16;
    constexpr int NITEMS = I_PIN + I_GRP + I_POUT + I_AIN + I_AOUT + I_SHGU + I_SHDN + I_R + I_EGU + I_EDN;
    for (int it = gw; it < NITEMS; it += NGW) {
        int r = it;
#define P0_GROUP(CNT, SRC, KK, NN, DST, GU) if (r < (CNT)) { const int per = ((KK) / 64) * ((NN) / 64), mat = r / per, q = r % per, nblk = (NN) / 64, kblk = (KK) / 64, nb = q / kblk, kb = q % kblk; (void)nblk; \
            int dn0 = 64 * nb; if (GU) { const int n0 = 64 * nb; dn0 = (n0 < 256) ? ((n0 >> 7) * 256 + (n0 & 127)) : (((n0 - 256) >> 7) * 256 + 128 + ((n0 - 256) & 127)); } \
            p0_transpose_item64((SRC) + (size_t)mat * (KK) * (NN), (KK), (NN), (bf16*)(F.ws + (DST)) + (size_t)mat * (KK) * (NN), dn0, scr, kb, nb, F.lane); continue; } r -= (CNT);
        P0_GROUP(I_PIN, inp(F, 4), 1024, 1024, WS_WPIN, 0)
        P0_GROUP(I_GRP, inp(F, 5), 256, 256, WS_WPGRP, 0)
        P0_GROUP(I_POUT, inp(F, 7), 1024, 1024, WS_WPOUT, 0)
        P0_GROUP(I_AIN, inp(F, 8), 1024, 9216, WS_WAIN, 0)
        P0_GROUP(I_AOUT, inp(F, 9), 1024, 1024, WS_WAOUT, 0)
        P0_GROUP(I_SHGU, inp(F, 16), 1024, 512, WS_WSHGU, 1)
        P0_GROUP(I_SHDN, inp(F, 17), 256, 1024, WS_WSHDN, 0)
        if (r < I_R) { const int mat = r / 32, q = r % 32, kb = q / 2, nb = q % 2;
            p0_router_item(inp(F, 12) + (size_t)mat * 65536, (bf16*)(F.ws + WS_WRHI) + (size_t)mat * 65536, (bf16*)(F.ws + WS_WRLO) + (size_t)mat * 65536, scr, kb, nb, F.lane); continue; } r -= I_R;
        P0_GROUP(I_EGU, inp(F, 14), 1024, 512, WS_WEGU, 1)
        P0_GROUP(I_EDN, inp(F, 15), 256, 1024, WS_WEDN, 0)
#undef P0_GROUP
    }
}

__device__ __forceinline__ void p1_modulate(Frame& F, const float* x, const float* modl  , int sh_off, int sc_off) {
    bf16* H = (bf16*)(F.ws + WS_H);
    const int gw = F.vcu * NWAVES + F.wave, NGW = F.G * NWAVES;
    for (int m = gw; m < T; m += NGW) {
        const int b = m / SEQ; const float* mb = modl + (size_t)b * 6144;
        const GAS f32x4* xr = (const GAS f32x4*)(x + (size_t)m * D) + F.lane;
        GAS u32x2* o8 = (GAS u32x2*)(H + (size_t)m * D) + F.lane;
#pragma unroll
        for (int j = 0; j < 4; ++j) { const f32x4 v = xr[64 * j]; const f32x4 sc = *(const f32x4*)(mb + sc_off + 4 * F.lane + 256 * j), sh = *(const f32x4*)(mb + sh_off + 4 * F.lane + 256 * j);
            const f32x4 h = v * (sc + 1.0f) + sh; u32x2 w; w.x = pk2(h[0], h[1]); w.y = pk2(h[2], h[3]); o8[64 * j] = w; }
    }
}

template <int W>
__device__ __forceinline__ void pool_item(const bf16* U, bf16* Z, int b, int t0, int g, int lane) {
    const size_t base = (size_t)b * SEQ * D + 256 * g + 4 * lane;
    float s[4] = {0.f, 0.f, 0.f, 0.f};
#pragma unroll
    for (int j = 1; j <= W; ++j) { const int t = t0 - j; if (t >= 0) { const u32x2 v = *(const GAS u32x2*)(U + base + (size_t)t * D);
            s[0] += bf2f(v.x & 0xffffu); s[1] += bf2f(v.x >> 16); s[2] += bf2f(v.y & 0xffffu); s[3] += bf2f(v.y >> 16); } }
#pragma unroll 8
    for (int i = 0; i < 32; ++i) { const int t = t0 + i;
        const u32x2 v = *(const GAS u32x2*)(U + base + (size_t)t * D);
        const float c0 = bf2f(v.x & 0xffffu), c1 = bf2f(v.x >> 16), c2 = bf2f(v.y & 0xffffu), c3 = bf2f(v.y >> 16);
        s[0] += c0; s[1] += c1; s[2] += c2; s[3] += c3;
        if (t - W >= 0) { const u32x2 o = *(const GAS u32x2*)(U + base + (size_t)(t - W) * D);
            s[0] -= bf2f(o.x & 0xffffu); s[1] -= bf2f(o.x >> 16); s[2] -= bf2f(o.y & 0xffffu); s[3] -= bf2f(o.y >> 16); }
        const float inv = 1.0f / (float)((t + 1) < W ? (t + 1) : W);
        u32x2 w; w.x = pk2(s[0] * inv - c0, s[1] * inv - c1); w.y = pk2(s[2] * inv - c2, s[3] * inv - c3);
        *(GAS u32x2*)(Z + base + (size_t)t * D) = w; }
}

__device__ __forceinline__ void moe_build_table(Frame& F, int layer) {
    LAS int* ts = (LAS int*)(F.lc + LC_TS); LAS int* cn = (LAS int*)(F.lc + LC_CNT);
    __syncthreads();
    if (F.wave == 0) {
        const int c = (int)__hip_atomic_load(F.ctl + CW_CNT + layer * 64 + F.lane, RLX_AGENT);
        int t = (c + 255) >> 8;
#pragma unroll
        for (int o = 1; o < 64; o <<= 1) { const int v = __shfl_up(t, o); if (F.lane >= o) t += v; }
        cn[F.lane] = c; ts[F.lane + 1] = t;
        if (F.lane == 0) ts[0] = 0;
        if (F.lane == 63) ts[65] = t + 64;
    }
    __syncthreads();
}

#ifdef PROBE_TYPE
#define LSTAMP(ty) do { if (blockIdx.x == 0 && F.tid == 0) { const unsigned long long now_ = __builtin_amdgcn_s_memrealtime(); LAS unsigned long long* st_ = (LAS unsigned long long*)(F.lc + 3072); \
        st_[1 + (ty)] += now_ - st_[20]; st_[20] = now_; } } while (0)
#define LSTAMP0() do { if (blockIdx.x == 0 && F.tid == 0) { ((LAS unsigned long long*)(F.lc + 3072))[20] = __builtin_amdgcn_s_memrealtime(); } } while (0)
#else
#define LSTAMP(ty) do { } while (0)
#define LSTAMP0() do { } while (0)
#endif
constexpr int APITCH = 1032;
#define LDS_ONLY_BARRIER() do { asm volatile("s_waitcnt lgkmcnt(0)" ::: "memory"); __builtin_amdgcn_s_barrier(); asm volatile("" ::: "memory"); } while (0)
template <bool X16>
__device__ __forceinline__ void ln1_router_phase(Frame& F, int layer, const float* xin) {
    bf16* X = (bf16*)(F.ws + WS_X);
    bf16* H = (bf16*)(F.ws + WS_H); const bf16* Y = (const bf16*)(F.ws + WS_Y);
    const float* modl = (const float*)(F.ws + WS_MOD) + (size_t)layer * 8 * 6144;
    const float* lg = inp(F, 10) + layer * D; const float* lb = inp(F, 11) + layer * D;
    const float* rb = inp(F, 13) + layer * NE;
    const bf16* WH = (const bf16*)(F.ws + WS_WRHI) + (size_t)layer * 65536; const bf16* WLo = (const bf16*)(F.ws + WS_WRLO) + (size_t)layer * 65536;
    int* tokl = (int*)(F.ws + WS_TOKL); float* wl = (float*)(F.ws + WS_WL); int* tslot = (int*)(F.ws + WS_TSLOT);
    unsigned* gcnt = F.ctl + CW_CNT + layer * 64;
    LAS bf16* Ahi = (LAS bf16*)F.lds; LAS bf16* Alo = Ahi + 32 * APITCH;
    LAS float* PART = (LAS float*)F.lds;
    LAS float* PV = (LAS float*)(F.lds + LDS_TB_OFF);
    LAS int* lcnt = (LAS int*)(F.lc + LC_LCNT); LAS int* gb = (LAS int*)(F.lc + LC_GB);
    const int lane = F.lane, wave = F.wave;
    const int nblk = (T / 32) / F.G;
#define LN1_BLK(bi_) ((F.G == 256) ? ((F.vcu >> 5) * 64 + (F.vcu & 31) * 2 + (bi_)) : (F.vcu + (bi_) * F.G))
    constexpr int NX = X16 ? 2 : 4;
    u32x4 xr[4][NX], yv[4][2];
#define LN1_LOAD(bi_) do { const int t0_ = LN1_BLK(bi_) * 32 + wave * 4; \
        _Pragma("unroll") for (int q = 0; q < 4; ++q) _Pragma("unroll") for (int j = 0; j < 2; ++j) { const size_t o_ = (size_t)(t0_ + q) * D + 8 * lane + 512 * j; \
            if constexpr (X16) xr[q][j] = __builtin_nontemporal_load((const GAS u32x4*)((const bf16*)xin + o_)); \
            else { xr[q][2 * j] = *(const GAS u32x4*)(xin + o_); xr[q][2 * j + 1] = *(const GAS u32x4*)(xin + o_ + 4); } \
            yv[q][j] = __builtin_nontemporal_load((const GAS u32x4*)(Y + o_)); } } while (0)
    LN1_LOAD(0);
    const float rbe = rb[lane];
    { const int b = (LN1_BLK(0) * 32) / SEQ; const float* mb = modl + (size_t)b * 6144;
      for (int i = F.tid; i < 1024; i += NWAVES * 64) { const int v = i >> 8, c4 = (i & 255) * 4;
          const float* src = (v == 0) ? lg : (v == 1) ? lb : (v == 2) ? (mb + 4096) : (mb + 3072);
          f32x4 t = *(const GAS f32x4*)(src + c4); if (v == 2) t = t + 1.0f; *(LAS f32x4*)(PV + v * 1024 + c4) = t; } }
    __syncthreads();
    for (int bi = 0; bi < nblk; ++bi) {
        const int blk = LN1_BLK(bi);
        const int tok0 = blk * 32;
        LSTAMP0();
        bf16x8 bh[8][2], bl[8][2];
        {
            const int b = tok0 / SEQ; const float* mb = modl + (size_t)b * 6144;
            f32x4 xv[4][4];
            f32x4 pg1[4];
#pragma unroll
            for (int jj = 0; jj < 4; ++jj) pg1[jj] = *(const GAS f32x4*)(mb + 2048 + 8 * lane + 512 * (jj >> 1) + 4 * (jj & 1)) + 1.0f;
            float sm[4];
#pragma unroll
            for (int q = 0; q < 4; ++q) { float s = 0.f;
#pragma unroll
                for (int jj = 0; jj < 4; ++jj) { const unsigned w0 = (jj & 1) ? yv[q][jj >> 1].z : yv[q][jj >> 1].x, w1 = (jj & 1) ? yv[q][jj >> 1].w : yv[q][jj >> 1].y;
                    f32x4 y4; y4[0] = h2f(w0 & 0xffffu); y4[1] = h2f(w0 >> 16); y4[2] = h2f(w1 & 0xffffu); y4[3] = h2f(w1 >> 16);
                    f32x4 x4;
                    if constexpr (X16) { const unsigned v0 = (jj & 1) ? xr[q][jj >> 1].z : xr[q][jj >> 1].x, v1 = (jj & 1) ? xr[q][jj >> 1].w : xr[q][jj >> 1].y;
                        x4 = (f32x4){h2f(v0 & 0xffffu), h2f(v0 >> 16), h2f(v1 & 0xffffu), h2f(v1 >> 16)}; }
                    else { const u32x4 v = xr[q][jj]; x4 = (f32x4){__uint_as_float(v.x), __uint_as_float(v.y), __uint_as_float(v.z), __uint_as_float(v.w)}; }
                    xv[q][jj] = x4 * ALPHA + pg1[jj] * y4; s += (xv[q][jj][0] + xv[q][jj][1]) + (xv[q][jj][2] + xv[q][jj][3]); }
                sm[q] = s; }
#pragma unroll
            for (int o = 1; o < 64; o <<= 1) {
#pragma unroll
                for (int q = 0; q < 4; ++q) sm[q] += __shfl_xor(sm[q], o); }
            float s2[4];
#pragma unroll
            for (int q = 0; q < 4; ++q) { const float mean = sm[q] * (1.f / D); float t = 0.f;
#pragma unroll
                for (int jj = 0; jj < 4; ++jj) { xv[q][jj] = xv[q][jj] - mean; t += (xv[q][jj][0] * xv[q][jj][0] + xv[q][jj][1] * xv[q][jj][1]) + (xv[q][jj][2] * xv[q][jj][2] + xv[q][jj][3] * xv[q][jj][3]); }
                s2[q] = t; }
#pragma unroll
            for (int o = 1; o < 64; o <<= 1) {
#pragma unroll
                for (int q = 0; q < 4; ++q) s2[q] += __shfl_xor(s2[q], o); }
            LAS float* pvb = PV + 8 * lane; asm volatile("" : "+v"(pvb));
#pragma unroll
            for (int jj = 0; jj < 4; ++jj) { const int col = 8 * lane + 512 * (jj >> 1) + 4 * (jj & 1); const int co = 512 * (jj >> 1) + 4 * (jj & 1);
                const f32x4 gg = *(const LAS f32x4*)(pvb + co), bb = *(const LAS f32x4*)(pvb + 1024 + co), sc2 = *(const LAS f32x4*)(pvb + 2048 + co), sh2 = *(const LAS f32x4*)(pvb + 3072 + co);
#pragma unroll
                for (int q = 0; q < 4; ++q) { const int rl = wave * 4 + q, tok = tok0 + rl; const float rstd = 1.0f / sqrtf(s2[q] * (1.f / D) + LN_EPS);
                    const f32x4 xn = xv[q][jj] * rstd * gg + bb; { u32x2 xw; xw.x = pkh2(xn[0], xn[1]); xw.y = pkh2(xn[2], xn[3]); *(GAS u32x2*)(X + (size_t)tok * D + col) = xw; }
                    const f32x4 hf = xn * sc2 + sh2;
                    unsigned hh[4], ll[4];
#pragma unroll
                    for (int e = 0; e < 4; ++e) { hh[e] = f2bf(hf[e]); ll[e] = f2bf(hf[e] - bf2f(hh[e])); }
                    u32x2 wh, wlo; wh.x = hh[0] | (hh[1] << 16); wh.y = hh[2] | (hh[3] << 16); wlo.x = ll[0] | (ll[1] << 16); wlo.y = ll[2] | (ll[3] << 16);
                    *(GAS u32x2*)(H + (size_t)tok * D + col) = wh;
                    *(LAS u32x2*)(Ahi + rl * APITCH + col) = wh; *(LAS u32x2*)(Alo + rl * APITCH + col) = wlo; } }
        }
        __builtin_amdgcn_sched_barrier(0);
        {
            const int r32 = lane & 31, hi = lane >> 5;
#pragma unroll
            for (int nb = 0; nb < 2; ++nb) {
                const GAS bf16* ph = (const GAS bf16*)WH + (size_t)(r32 + 32 * nb) * 1024 + wave * 128 + hi * 8; const GAS bf16* pl = (const GAS bf16*)WLo + (size_t)(r32 + 32 * nb) * 1024 + wave * 128 + hi * 8;
                asm volatile("" : "+v"(ph), "+v"(pl));
#pragma unroll
                for (int ks = 0; ks < 8; ++ks) { bh[ks][nb] = *(const GAS bf16x8*)(ph + ks * 16); bl[ks][nb] = *(const GAS bf16x8*)(pl + ks * 16); } }
        }
        __syncthreads();
        LSTAMP(13);
        f32x16 acc[2]; acc[0] = (f32x16){}; acc[1] = (f32x16){};
        {
            const int r32 = lane & 31, hi = lane >> 5;
#pragma unroll
            for (int ks = 0; ks < 8; ++ks) {
                const int k = wave * 128 + ks * 16 + hi * 8;
                const bf16x8 ah = *(const LAS bf16x8*)(Ahi + r32 * APITCH + k), al = *(const LAS bf16x8*)(Alo + r32 * APITCH + k);
#pragma unroll
                for (int nb = 0; nb < 2; ++nb) {
                    acc[nb] = MFMA32(ah, bh[ks][nb], acc[nb]);
                    acc[nb] = MFMA32(al, bh[ks][nb], acc[nb]);
                    acc[nb] = MFMA32(ah, bl[ks][nb], acc[nb]);
                }
            }
        }
        LDS_ONLY_BARRIER();
        {
            const int r32 = lane & 31, hi = lane >> 5;
#pragma unroll
            for (int nb = 0; nb < 2; ++nb)
#pragma unroll
                for (int r = 0; r < 16; ++r) { const int trow = (r & 3) + 8 * (r >> 2) + 4 * hi; PART[(wave * 32 + trow) * 64 + 32 * nb + r32] = acc[nb][r]; }
        }
        if (F.tid < 64) lcnt[F.tid] = 0;
        LDS_ONLY_BARRIER();
        LSTAMP(14);
        if (bi + 1 < nblk) LN1_LOAD(bi + 1);
        else {
#pragma unroll
            for (int q = 0; q < 4; ++q) {
#pragma unroll
                for (int j = 0; j < NX; ++j) xr[q][j] = (u32x4){0u, 0u, 0u, 0u};
#pragma unroll
                for (int j = 0; j < 2; ++j) yv[q][j] = (u32x4){0u, 0u, 0u, 0u}; } }
        int chosen_m = 0; int posl[4]; float wv[4]; int rk[4];
        unsigned key[4]; float sgv[4];
#pragma unroll
        for (int q = 0; q < 4; ++q) {
            const int rl = wave * 4 + q;
            float logit = 0.f;
#pragma unroll
            for (int w = 0; w < 8; ++w) logit += PART[(w * 32 + rl) * 64 + lane];
            const float sg = 1.0f / (1.0f + __expf(-logit));
            const float sel = sg + rbe;
            float m1 = sel; m1 = fmaxf(m1, __shfl_xor(m1, 1)); m1 = fmaxf(m1, __shfl_xor(m1, 2)); m1 = fmaxf(m1, __shfl_xor(m1, 4));
            const unsigned long long bal = __ballot(sel == m1);
            const unsigned long long gm = bal & (0xFFull << (8 * (lane >> 3)));
            const int first = (int)__builtin_ctzll(gm);
            float m2 = (lane == first) ? -INFINITY : sel; m2 = fmaxf(m2, __shfl_xor(m2, 1)); m2 = fmaxf(m2, __shfl_xor(m2, 2)); m2 = fmaxf(m2, __shfl_xor(m2, 4));
            const float gs = m1 + m2;
            int rg = 0;
#pragma unroll
            for (int g2 = 0; g2 < 8; ++g2) { const float v = __builtin_bit_cast(float, __builtin_amdgcn_readlane(__builtin_bit_cast(int, gs), 8 * g2)); rg += ((v > gs) || (v == gs && g2 < (lane >> 3))) ? 1 : 0; }
            const bool gsel = rg < 4;
            const float msel = gsel ? sel : -INFINITY;
            const unsigned mb_ = __float_as_uint(msel); key[q] = (mb_ & 0x80000000u) ? ~mb_ : (mb_ | 0x80000000u); sgv[q] = sg;
        }
        unsigned tau[4] = {0u, 0u, 0u, 0u};
#pragma unroll 1
        for (int bit = 31; bit >= 0; --bit) {
#pragma unroll
            for (int q = 0; q < 4; ++q) { const unsigned cand = tau[q] | (1u << bit); const int cnt = (int)__popcll(__ballot(key[q] >= cand)); tau[q] = (cnt >= TOPK) ? cand : tau[q]; } }
#pragma unroll
        for (int q = 0; q < 4; ++q) {
            const unsigned long long gtm = __ballot(key[q] > tau[q]), eqm = __ballot(key[q] == tau[q]);
            const int need = TOPK - (int)__popcll(gtm);
            const unsigned long long below = (1ull << lane) - 1ull;
            const bool ch = (key[q] > tau[q]) || ((key[q] == tau[q]) && ((int)__popcll(eqm & below) < need));
            const unsigned long long chm = __ballot(ch);
            const int rank = (int)__popcll(chm & below);
            const float wsum = wave_sum(ch ? sgv[q] : 0.f);
            wv[q] = sgv[q] / wsum * ROUTED_SCALE; rk[q] = rank; posl[q] = 0;
            if (ch) { chosen_m |= (1 << q); posl[q] = __hip_atomic_fetch_add(lcnt + lane, 1, __ATOMIC_RELAXED, __HIP_MEMORY_SCOPE_WORKGROUP); }
        }
        LDS_ONLY_BARRIER();
        LSTAMP(15);
        if (wave == 0) { const int n = lcnt[lane]; int base = 0; if (n > 0) base = (int)__hip_atomic_fetch_add(gcnt + lane, (unsigned)n, RLX_AGENT); gb[lane] = base; }
        LDS_ONLY_BARRIER();
        {
            const int base = gb[lane];
#pragma unroll
            for (int q = 0; q < 4; ++q) if (chosen_m & (1 << q)) { const int tok = tok0 + wave * 4 + q; const int pos = base + posl[q];
                tokl[(size_t)lane * CAP + pos] = tok; wl[(size_t)tok * 8 + rk[q]] = wv[q]; tslot[(size_t)tok * 8 + rk[q]] = lane * CAP + pos; }
        }
        LDS_ONLY_BARRIER();
        LSTAMP(16);
    }
#undef LN1_LOAD
#undef LN1_BLK
}

__device__ __forceinline__ void combine_ln2_phase(Frame& F, int layer) {
    bf16* X = (bf16*)(F.ws + WS_X); bf16* H = (bf16*)(F.ws + WS_H); const unsigned char* YS = (const unsigned char*)(F.ws + WS_YS);
    const float* modl = (const float*)(F.ws + WS_MOD) + (size_t)layer * 8 * 6144;
    const float* modn = (const float*)(F.ws + WS_MOD) + (size_t)(layer + 1) * 8 * 6144;
    const float* lg = inp(F, 18) + layer * D; const float* lb = inp(F, 19) + layer * D;
    const int* tslot = (const int*)(F.ws + WS_TSLOT);
    const LAS int* ts = (const LAS int*)(F.lc + LC_TS);
    const bool lastl = (layer == DEPTH - 1);
    float* xout = (float*)inp(F, 20);
    const int lane = F.lane, wave = F.wave;
    LAS float* PV = (LAS float*)F.lds;
    const int shbase = ts[64] * 256;
    for (int blk = F.vcu; blk < T / 64; blk += F.G) {
        const int tokb = blk * 64, b = tokb / SEQ;
        __syncthreads();
        for (int i = F.tid; i < 1024; i += 512) { PV[i] = modl[(size_t)b * 6144 + 5120 + i] + 1.0f; PV[1024 + i] = lg[i]; PV[2048 + i] = lb[i];
            if (!lastl) { PV[3072 + i] = modn[(size_t)b * 6144 + 1024 + i] + 1.0f; PV[4096 + i] = modn[(size_t)b * 6144 + i]; } }
        __syncthreads();
        const int tw = tokb + wave * 8;
        int sv; { const int v = tslot[(size_t)tw * 8 + lane]; sv = ts[v >> 14] * 256 + (v & (CAP - 1)); }
        const float wvv = ((const float*)(F.ws + WS_WL))[(size_t)tw * 8 + lane] * (1.0f / 32.0f);
        pg8::u32x2_t ys[18]; u32x4 xs[2];
#define CB_LOAD(k) do { const int tok_ = tw + (k); _Pragma("unroll") for (int kk_ = 0; kk_ < 9; ++kk_) { const int slot_ = (kk_ < 8) ? __builtin_amdgcn_readlane(sv, 8 * (k) + kk_) : (shbase + tok_); \
            const unsigned char* yr_ = YS + (size_t)slot_ * D + 8 * lane; ys[2 * kk_] = __builtin_nontemporal_load((const GAS pg8::u32x2_t*)(yr_)); ys[2 * kk_ + 1] = __builtin_nontemporal_load((const GAS pg8::u32x2_t*)(yr_ + 512)); } \
            _Pragma("unroll") for (int j_ = 0; j_ < 2; ++j_) xs[j_] = __builtin_nontemporal_load((const GAS u32x4*)(X + (size_t)tok_ * D + 8 * lane + 512 * j_)); } while (0)
        CB_LOAD(0);
#pragma unroll 1
        for (int k = 0; k < 8; ++k) {
            const int tok_ = tw + k; f32x4 y_[4];
#pragma unroll
            for (int jj_ = 0; jj_ < 4; ++jj_) y_[jj_] = (f32x4){0.f, 0.f, 0.f, 0.f};
#pragma unroll
            for (int kk_ = 0; kk_ < 9; ++kk_) { const float wk_ = (kk_ < 8) ? __builtin_bit_cast(float, __builtin_amdgcn_readlane(__builtin_bit_cast(int, wvv), 8 * k + kk_)) : (1.0f / 32.0f);
#pragma unroll
                for (int j_ = 0; j_ < 2; ++j_) { const pg8::u32x2_t w_ = ys[2 * kk_ + j_];
                    const f32x2 a0_ = __builtin_amdgcn_cvt_pk_f32_fp8((int)w_.x, false), a1_ = __builtin_amdgcn_cvt_pk_f32_fp8((int)w_.x, true), b0_ = __builtin_amdgcn_cvt_pk_f32_fp8((int)w_.y, false), b1_ = __builtin_amdgcn_cvt_pk_f32_fp8((int)w_.y, true);
                    y_[2 * j_][0] += wk_ * a0_[0]; y_[2 * j_][1] += wk_ * a0_[1]; y_[2 * j_][2] += wk_ * a1_[0]; y_[2 * j_][3] += wk_ * a1_[1];
                    y_[2 * j_ + 1][0] += wk_ * b0_[0]; y_[2 * j_ + 1][1] += wk_ * b0_[1]; y_[2 * j_ + 1][2] += wk_ * b1_[0]; y_[2 * j_ + 1][3] += wk_ * b1_[1]; } }
            f32x4 v_[4]; float s_ = 0.f;
#pragma unroll
            for (int jj_ = 0; jj_ < 4; ++jj_) { const int col_ = 8 * lane + 512 * (jj_ >> 1) + 4 * (jj_ & 1); const f32x4 g2_ = *(const LAS f32x4*)(PV + col_);
                const unsigned w0_ = (jj_ & 1) ? xs[jj_ >> 1].z : xs[jj_ >> 1].x, w1_ = (jj_ & 1) ? xs[jj_ >> 1].w : xs[jj_ >> 1].y;
                const f32x4 x4_ = (f32x4){h2f(w0_ & 0xffffu), h2f(w0_ >> 16), h2f(w1_ & 0xffffu), h2f(w1_ >> 16)};
                v_[jj_] = x4_ * ALPHA + g2_ * y_[jj_]; s_ += (v_[jj_][0] + v_[jj_][1]) + (v_[jj_][2] + v_[jj_][3]); }
            asm volatile("" : "+v"(v_[0]), "+v"(v_[1]), "+v"(v_[2]), "+v"(v_[3]));
            __builtin_amdgcn_sched_barrier(0);
            { const int kn = (k + 1 < 8) ? k + 1 : k; CB_LOAD(kn); }
            __builtin_amdgcn_sched_barrier(0);
            const float mean_ = wave_sum(s_) * (1.f / D); float q_ = 0.f;
#pragma unroll
            for (int jj_ = 0; jj_ < 4; ++jj_) { v_[jj_] = v_[jj_] - mean_; q_ += (v_[jj_][0] * v_[jj_][0] + v_[jj_][1] * v_[jj_][1]) + (v_[jj_][2] * v_[jj_][2] + v_[jj_][3] * v_[jj_][3]); }
            const float rstd_ = 1.0f / sqrtf(wave_sum(q_) * (1.f / D) + LN_EPS);
#pragma unroll
            for (int jj_ = 0; jj_ < 4; ++jj_) { const int col_ = 8 * lane + 512 * (jj_ >> 1) + 4 * (jj_ & 1);
                const f32x4 gg_ = *(const LAS f32x4*)(PV + 1024 + col_), bb_ = *(const LAS f32x4*)(PV + 2048 + col_);
                const f32x4 xn_ = v_[jj_] * rstd_ * gg_ + bb_;
                if (lastl) *(GAS f32x4*)(xout + (size_t)tok_ * D + col_) = xn_;
                else { u32x2 xw_; xw_.x = pkh2(xn_[0], xn_[1]); xw_.y = pkh2(xn_[2], xn_[3]); *(GAS u32x2*)(X + (size_t)tok_ * D + col_) = xw_; }
                if (!lastl) { const f32x4 sc_ = *(const LAS f32x4*)(PV + 3072 + col_), sh_ = *(const LAS f32x4*)(PV + 4096 + col_); const f32x4 hm_ = xn_ * sc_ + sh_;
                    u32x2 w2_; w2_.x = pk2(hm_[0], hm_[1]); w2_.y = pk2(hm_[2], hm_[3]); *(GAS u32x2*)(H + (size_t)tok_ * D + col_) = w2_; } }
        }
#undef CB_LOAD
    }
}

constexpr int ACCP = 68;
__device__ __forceinline__ int crow(int r, int hi) { return (r & 3) + 8 * (r >> 2) + 4 * hi; }
constexpr int KPITCH = 144;
__device__ __forceinline__ u32x4 f8x8_to_bf16(unsigned a, unsigned b, float inv) {
    typedef __bf16 bfx2 __attribute__((ext_vector_type(2)));
    u32x4 r; r.x = __builtin_bit_cast(unsigned, (bfx2)__builtin_amdgcn_cvt_scalef32_pk_bf16_fp8(a, inv, false)); r.y = __builtin_bit_cast(unsigned, (bfx2)__builtin_amdgcn_cvt_scalef32_pk_bf16_fp8(a, inv, true));
    r.z = __builtin_bit_cast(unsigned, (bfx2)__builtin_amdgcn_cvt_scalef32_pk_bf16_fp8(b, inv, false)); r.w = __builtin_bit_cast(unsigned, (bfx2)__builtin_amdgcn_cvt_scalef32_pk_bf16_fp8(b, inv, true)); return r;
}
template <bool FIRST, int NB>
__device__ __forceinline__ void attn_task(const unsigned char* QKVb  , int g, int h, int dil, int cls, int q0, int QS, int kb0, int L, float slope2d,
                                          LAS unsigned char* stg  , LAS float* wsf  , LAS float* ACC, LAS float* ML, int trow_mul, int trow_add, int lane) {
    asm volatile("" : "+v"(lane));
    const int r32 = lane & 31, hi = lane >> 5, lr = lane >> 2, lc = lane & 3;
    const int qcol = ((g * 3 + 0) * 16 + h) * 64, kcol = ((g * 3 + 1) * 16 + h) * 64, vcol = ((g * 3 + 2) * 16 + h) * 64;
    const size_t rstride = (size_t)dil * NQKV;
    const unsigned char* base = QKVb + (size_t)cls * NQKV + lc * 16;
    const int jlo = (kb0 >= -31) ? 0 : ((-kb0) >> 5);
    const int qpos = q0 + QS * r32;
    const int dmax = qpos < 128 ? qpos : 128;
    const float half = 0.5f * (float)dmax;
#define AT_LOADROWS(dst, l0, ls, col) do { _Pragma("unroll") for (int i_ = 0; i_ < 2; ++i_) { int l_ = (l0) + (ls) * (16 * i_ + lr); l_ = l_ < 0 ? 0 : (l_ > L - 1 ? L - 1 : l_); \
        dst[i_] = *(const GAS u32x4*)(base + (size_t)l_ * rstride + (col)); } } while (0)
#define AT_PUTROWS(src, inv) do { _Pragma("unroll") for (int i_ = 0; i_ < 2; ++i_) { LAS unsigned char* p_ = stg + (16 * i_ + lr) * KPITCH + lc * 32; \
        *(LAS u32x4*)(p_) = f8x8_to_bf16(src[i_].x, src[i_].y, inv); *(LAS u32x4*)(p_ + 16) = f8x8_to_bf16(src[i_].z, src[i_].w, inv); } } while (0)
#define AT_GETFRAG(dst) do { _Pragma("unroll") for (int s_ = 0; s_ < 4; ++s_) dst[s_] = *(const LAS bf16x8*)(stg + r32 * KPITCH + 32 * s_ + 16 * hi); } while (0)
#define AT_LDSWAIT() asm volatile("s_waitcnt lgkmcnt(0)" ::: "memory")
    u32x4 kr[2][2];
    bf16x8 qf[4];
    { u32x4 qr[2]; AT_LOADROWS(qr, q0, QS, qcol);
#pragma unroll
      for (int j = 0; j < NB; ++j) if (j == jlo) AT_LOADROWS(kr[j & 1], kb0 + 32 * j, 1, kcol);
      AT_PUTROWS(qr, 1.0f / 64.0f); AT_LDSWAIT(); AT_GETFRAG(qf); AT_LDSWAIT(); }
    f32x16 S[NB];
    float mx = -INFINITY;
#pragma unroll
    for (int j = 0; j < NB; ++j) {
        if (j >= jlo) {
            asm volatile("" ::: "memory");
            if (j < NB - 1) AT_LOADROWS(kr[(j + 1) & 1], kb0 + 32 * (j + 1), 1, kcol);
            AT_PUTROWS(kr[j & 1], 1.0f / 16.0f);
            const float xd0 = (float)(qpos - kb0 - 32 * j - 4 * hi) - half;
            const bool inner = (q0 - kb0 - 32 * j - 31 >= 0) && (q0 + QS * 31 - kb0 - 32 * j <= 128) && (kb0 + 32 * j >= 0);
            f32x16 a;
            if (inner) {
                const float cb = -slope2d * xd0;
#pragma unroll
                for (int r = 0; r < 16; ++r) a[r] = __builtin_fmaf(slope2d, (float)((r & 3) + 8 * (r >> 2)), cb);
            } else {
#pragma unroll
                for (int r = 0; r < 16; ++r) { const float x = xd0 - (float)((r & 3) + 8 * (r >> 2)); a[r] = (__builtin_fabsf(x) <= half) ? (-slope2d * x) : -INFINITY; }
            }
            bf16x8 kf[4];
            AT_LDSWAIT(); AT_GETFRAG(kf); AT_LDSWAIT();
#pragma unroll
            for (int s = 0; s < 4; ++s) a = MFMA32(kf[s], qf[s], a);
#pragma unroll
            for (int r = 0; r < 16; ++r) mx = fmaxf(mx, a[r]);
            S[j] = a;
        } else {
#pragma unroll
            for (int r = 0; r < 16; ++r) S[j][r] = -INFINITY;
        }
        __builtin_amdgcn_sched_barrier(0);
    }
    u32x4 vr[2][2];
#pragma unroll
    for (int j = 0; j < NB; ++j) if (j == jlo) AT_LOADROWS(vr[j & 1], kb0 + 32 * j, 1, vcol);
    { auto rr = __builtin_amdgcn_permlane32_swap(__float_as_uint(mx), __float_as_uint(mx), false, false);
      const unsigned r0 = rr[0], r1 = rr[1]; mx = fmaxf(__uint_as_float(r0), __uint_as_float(r1)); }
    const float mx_true = mx - slope2d * half;
    float lsum = 0.f;
    u32x4 P[NB][2];
#pragma unroll
    for (int j = 0; j < NB; ++j) {
        float p[16];
#pragma unroll
        for (int r = 0; r < 16; ++r) { p[r] = __builtin_amdgcn_exp2f(S[j][r] - mx); lsum += p[r]; }
#pragma unroll
        for (int ks = 0; ks < 2; ++ks) { P[j][ks].x = cvt_pk_bf16(p[8 * ks + 0], p[8 * ks + 1]); P[j][ks].y = cvt_pk_bf16(p[8 * ks + 2], p[8 * ks + 3]); P[j][ks].z = cvt_pk_bf16(p[8 * ks + 4], p[8 * ks + 5]); P[j][ks].w = cvt_pk_bf16(p[8 * ks + 6], p[8 * ks + 7]); }
        __builtin_amdgcn_sched_barrier(0);
    }
    { auto rr = __builtin_amdgcn_permlane32_swap(__float_as_uint(lsum), __float_as_uint(lsum), false, false);
      const unsigned r0 = rr[0], r1 = rr[1]; lsum = __uint_as_float(r0) + __uint_as_float(r1); }
    f32x16 o[2]; o[0] = (f32x16){}; o[1] = (f32x16){};
    const unsigned vrd = (unsigned)(((lane >> 4) & 1) * 32 + (lane & 3) * 8 + (4 * hi + ((lane & 15) >> 2)) * 64);
#pragma unroll
    for (int j = 0; j < NB; ++j) {
        if (j >= jlo) {
            asm volatile("" ::: "memory");
            if (j < NB - 1) AT_LOADROWS(vr[(j + 1) & 1], kb0 + 32 * (j + 1), 1, vcol);
#pragma unroll
            for (int i = 0; i < 2; ++i) { const int key = 16 * i + lr;
#pragma unroll
                for (int hf = 0; hf < 2; ++hf) { const int c8 = 2 * lc + hf; const u32x4 src = vr[j & 1][i];
                    *(LAS u32x4*)(stg + ((c8 >> 2) * 2 + (key >> 4)) * 1024 + (key & 15) * 64 + (c8 & 3) * 16) = f8x8_to_bf16(hf ? src.z : src.x, hf ? src.w : src.y, 1.0f / 16.0f); } }
            AT_LDSWAIT();
#pragma unroll
            for (int d0 = 0; d0 < 2; ++d0)
#pragma unroll
                for (int ks = 0; ks < 2; ++ks) {
                    LAS unsigned char* vp = stg + (d0 * 2 + ks) * 1024 + vrd;
                    const s16x4 lo = __builtin_bit_cast(s16x4, __builtin_amdgcn_ds_read_tr16_b64_v4i16((LAS s16x4*)(vp)));
                    const s16x4 hh = __builtin_bit_cast(s16x4, __builtin_amdgcn_ds_read_tr16_b64_v4i16((LAS s16x4*)(vp + 512)));
                    const bf16x8 vf = (bf16x8){lo[0], lo[1], lo[2], lo[3], hh[0], hh[1], hh[2], hh[3]};
                    o[d0] = MFMA32(__builtin_bit_cast(bf16x8, P[j][ks]), vf, o[d0]);
                }
            AT_LDSWAIT();
        }
        __builtin_amdgcn_sched_barrier(0);
    }
#undef AT_LOADROWS
#undef AT_PUTROWS
#undef AT_GETFRAG
#undef AT_LDSWAIT
    if (hi == 0) { wsf[r32] = mx_true; wsf[32 + r32] = lsum; }
    asm volatile("s_waitcnt lgkmcnt(0)" ::: "memory");
    f32x4 mt4[4], lt4[4];
#pragma unroll
    for (int k = 0; k < 4; ++k) { mt4[k] = *(const LAS f32x4*)(wsf + 8 * k + 4 * hi); lt4[k] = *(const LAS f32x4*)(wsf + 32 + 8 * k + 4 * hi); }
    if (FIRST) {
#pragma unroll
        for (int r = 0; r < 16; ++r) { const int q = crow(r, hi); const int trow = q * trow_mul + trow_add;
            ACC[trow * ACCP + r32] = o[0][r]; ACC[trow * ACCP + 32 + r32] = o[1][r];
            if (r32 == 0) { ML[trow * 2] = mt4[r >> 2][r & 3]; ML[trow * 2 + 1] = lt4[r >> 2][r & 3]; } }
    } else {
        f32x2 ml[16]; float a0[16], a1[16];
#pragma unroll
        for (int r = 0; r < 16; ++r) { const int q = crow(r, hi); const int trow = q * trow_mul + trow_add;
            ml[r] = *(const LAS f32x2*)(ML + trow * 2); a0[r] = ACC[trow * ACCP + r32]; a1[r] = ACC[trow * ACCP + 32 + r32]; }
        asm volatile("s_waitcnt lgkmcnt(0)" ::: "memory");
#pragma unroll
        for (int r = 0; r < 16; ++r) { const int q = crow(r, hi); const int trow = q * trow_mul + trow_add;
            const float mt = mt4[r >> 2][r & 3], lt = lt4[r >> 2][r & 3], mo = ml[r][0], lo_ = ml[r][1];
            const float mn = fmaxf(mo, mt); const float fa = __builtin_amdgcn_exp2f(mo - mn), fb = __builtin_amdgcn_exp2f(mt - mn);
            ACC[trow * ACCP + r32] = a0[r] * fa + o[0][r] * fb; ACC[trow * ACCP + 32 + r32] = a1[r] * fa + o[1][r] * fb;
            if (r32 == 0) { ML[trow * 2] = mn; ML[trow * 2 + 1] = lo_ * fa + lt * fb; } }
    }
    asm volatile("s_waitcnt lgkmcnt(0)" ::: "memory");
}

__device__ __forceinline__ void attn_phase(Frame& F, bf16* MIX) {
    const unsigned char* QKV = (const unsigned char*)(F.ws + WS_QKV);
    LAS float* ACC = (LAS float*)F.lds;
    LAS float* ML = (LAS float*)(F.lds + 69632);
    LAS unsigned char* vst = F.lds + 73728 + F.wave * 4608;
    LAS float* wsf = (LAS float*)(F.lds + 73728 + 8 * 4608 + F.wave * 256);
    const int lane = F.lane, w = F.wave;
    for (int i = 0;; ++i) {
        if (i >= (BATCH * 16 * 8) / F.G) break;
        const int L0 = (F.G == 256) ? ((F.vcu >> 5) * 128 + i * 32 + (F.vcu & 31)) : (i * F.G + F.vcu);
        const int bh = L0 >> 3, ti = L0 & 7; int w4 = ti >> 1; const int c = ti & 1; if (i & 1) w4 = 3 - w4;
        const int b = bh >> 4, h = bh & 15, win0 = w4 * 512;
        const unsigned char* Qb = QKV + (size_t)b * SEQ * NQKV;
        const float sl0 = exp2f(-8.0f * (float)(0 * 16 + h + 1) / 48.0f) * LOG2E, sl1 = exp2f(-8.0f * (float)(1 * 16 + h + 1) / 48.0f) * LOG2E * 4.0f, sl2 = exp2f(-8.0f * (float)(2 * 16 + h + 1) / 48.0f) * LOG2E * 16.0f;
        LSTAMP0();
        attn_task<true, 6>(Qb, 0, h, 1, 0, win0 + 64 * w + c, 2, win0 + 64 * w - 128, SEQ, sl0, vst, wsf, ACC, ML, 1, 32 * w, lane);
        __syncthreads();
        LSTAMP(24);
        if (ATTN_GMASK & 2) { const int cls = c + 2 * (w & 1), lb = w >> 1, lq0 = 128 * w4 + 32 * lb; attn_task<false, 5>(Qb, 1, h, 4, cls, lq0, 1, lq0 - 128, SEQ / 4, sl1, vst, wsf, ACC, ML, 2, 64 * lb + (w & 1), lane); }
        __syncthreads();
        LSTAMP(25);
        if (ATTN_GMASK & 4) { const int cls = c + 2 * w, lq0 = 32 * w4; attn_task<false, 5>(Qb, 2, h, 16, cls, lq0, 1, lq0 - 128, SEQ / 16, sl2, vst, wsf, ACC, ML, 8, w, lane); }
        __syncthreads();
        LSTAMP(26);
        {
#pragma unroll
          for (int it = 0; it < 4; ++it) { const int trow = 32 * w + 8 * it + (lane >> 3), sg = lane & 7; const float inv = 1.0f / ML[trow * 2 + 1];
              const LAS f32x4* ap = (const LAS f32x4*)(ACC + trow * ACCP + sg * 8);
              bf16* op = MIX + (size_t)(b * SEQ + win0 + 2 * trow + c) * D + h * 64 + sg * 8;
              const f32x4 a = ap[0] * inv, bq = ap[1] * inv; u32x4 wv; wv.x = pk2(a[0], a[1]); wv.y = pk2(a[2], a[3]); wv.z = pk2(bq[0], bq[1]); wv.w = pk2(bq[2], bq[3]);
              *(GAS u32x4*)op = wv; } }
        __syncthreads();
    }
}

__device__ __forceinline__ void attn_phase_naive(Frame& F, bf16* MIX, const int gmask) {
    const bf16* QKV = (const bf16*)(F.ws + WS_YS);
    const int lane = F.lane;
    const int gw = F.vcu * NWAVES + F.wave, NGW = F.G * NWAVES;
    for (int item = gw; item < T * 16; item += NGW) {
        const int tok = item >> 4, h = item & 15, b = tok / SEQ, t = tok % SEQ;
        const bf16* Qb = QKV + (size_t)b * SEQ * NQKV;
        float sc[3][3]; int kt[3][3];
        float mx = -INFINITY;
#pragma unroll
        for (int g = 0; g < 3; ++g) {
            const int dil = (g == 0) ? 1 : (g == 1 ? 4 : 16);
            const float slope = exp2f(-8.0f * (float)(g * 16 + h + 1) / 48.0f);
            const bf16* qp = Qb + (size_t)t * NQKV + ((g * 3 + 0) * 16 + h) * 64;
#pragma unroll
            for (int c = 0; c < 3; ++c) {
                const int j = lane + 64 * c; const int tk = t - j * dil;
                float s = -INFINITY;
                if (j <= 128 && tk >= 0 && ((gmask >> g) & 1)) {
                    const bf16* kp = Qb + (size_t)tk * NQKV + ((g * 3 + 1) * 16 + h) * 64;
                    float d = 0.f;
                    for (int e = 0; e < 64; ++e) d += bf2f(qp[e]) * bf2f(kp[e]);
                    s = d - slope * LOG2E * (float)(j * dil);
                }
                sc[g][c] = s; kt[g][c] = tk; mx = fmaxf(mx, s);
            }
        }
#pragma unroll
        for (int o = 1; o < 64; o <<= 1) mx = fmaxf(mx, __shfl_xor(mx, o));
        float den = 0.f; float acc[64];
#pragma unroll
        for (int e = 0; e < 64; ++e) acc[e] = 0.f;
#pragma unroll
        for (int g = 0; g < 3; ++g)
#pragma unroll
            for (int c = 0; c < 3; ++c) {
                const float p = (sc[g][c] == -INFINITY) ? 0.f : exp2f(sc[g][c] - mx);
                den += p;
                if (p != 0.f) { const bf16* vp = Qb + (size_t)kt[g][c] * NQKV + ((g * 3 + 2) * 16 + h) * 64;
#pragma unroll
                    for (int e = 0; e < 64; ++e) acc[e] += p * bf2f(vp[e]); }
            }
        den = wave_sum(den);
        float mine = 0.f;
#pragma unroll
        for (int e = 0; e < 64; ++e) { const float v = wave_sum(acc[e]); if (lane == e) mine = v; }
        MIX[(size_t)tok * D + h * 64 + lane] = (bf16)f2bf(mine / den);
    }
}

struct Args { const float* in[20]; float* out; unsigned char* ws; int ph_lo, ph_hi; };
constexpr int NPHASE = 2 + DEPTH * 8;

__global__ void __launch_bounds__(NWAVES * 64, 2) mk_fwd(Args args) {
    extern __shared__ __attribute__((aligned(16))) unsigned char lds_raw[];
    Frame F;
    F.lds = (LAS unsigned char*)lds_raw; F.lc = F.lds + LDSCTL_OFF;
    F.tid = threadIdx.x; F.lane = F.tid & 63; F.wave = __builtin_amdgcn_readfirstlane(F.tid >> 6);
    F.G = gridDim.x; { const int bx = blockIdx.x; F.vcu = (F.G % 8 == 0) ? (bx % 8) * (F.G / 8) + bx / 8 : bx; }
    F.ws = args.ws; F.ctl = (unsigned*)(args.ws + WS_CTL);
    for (int u = F.tid; u < (LDS_BYTES - LDSCTL_OFF) / 4; u += NWAVES * 64) ((LAS unsigned*)F.lc)[u] = 0u;
    __syncthreads();
    if (F.tid == 0) {
#pragma unroll
        for (int i = 0; i < 20; ++i) *(LAS unsigned long long*)(F.lc + LC_PTR + 8 * i) = (unsigned long long)args.in[i];
        *(LAS unsigned long long*)(F.lc + LC_PTR + 8 * 20) = (unsigned long long)args.out;
    }
    __syncthreads();
#if MK_PER_PHASE
#define GRID_BAR() do { } while (0)
    XcdBarrier bar; bar.bar = nullptr; bar.x = 0; bar.st = nullptr;
#else
    XcdBarrier bar = xcd_barrier_post(F.ctl + CW_BAR, (volatile LAS unsigned*)(F.lc + LC_MISC) + 8);
#define GRID_BAR() xcd_barrier(bar)
#endif
    const int lo = args.ph_lo, hi = args.ph_hi;
#ifdef PROBE_TYPE
#define LC_STAMP 3072
#define STAMP(ty) do { if (blockIdx.x == 0 && F.tid == 0) { const unsigned long long now_ = __builtin_amdgcn_s_memrealtime(); LAS unsigned long long* st_ = (LAS unsigned long long*)(F.lc + LC_STAMP); \
        st_[1 + (ty)] += now_ - st_[0]; st_[0] = now_; } } while (0)
    if (blockIdx.x == 0 && F.tid == 0) { ((LAS unsigned long long*)(F.lc + LC_STAMP))[0] = __builtin_amdgcn_s_memrealtime(); }
#else
#define STAMP(ty) do { } while (0)
#endif
#define IN(k) (lo <= (k) && (k) < hi)
#define SEAM(k) do { if (IN(k) && IN((k) + 1)) GRID_BAR(); } while (0)
    const float* mod = (const float*)(F.ws + WS_MOD);

    if (PHON(0) && IN(0)) { p0_prologue(F); } SEAM(0); STAMP(0);
    bool xlocal = false; int cid = (int)blockIdx.x;
#if !MK_PER_PHASE
    { volatile LAS unsigned* st = (volatile LAS unsigned*)(F.lc + LC_MISC) + 8;
      if (F.tid == 0) { unsigned ok = (F.G == 256) ? 1u : 0u;
#pragma unroll
          for (unsigned jx = 0; jx < 16; ++jx) { const unsigned cj = xb_ld(&bar.bar[XB_XCNT(jx)]); ok &= (jx < 8u) ? (cj == 32u ? 1u : 0u) : (cj == 0u ? 1u : 0u); }
          st[3] = ok; }
      __syncthreads();
      xlocal = (st[3] != 0u) && (MK_XLOCAL != 0);
      if (xlocal) cid = (int)(st[2] * 8u + bar.x); }
#endif
    cid = __builtin_amdgcn_readfirstlane(cid);
    F.vcu = (F.G % 8 == 0) ? (cid % 8) * (F.G / 8) + cid / 8 : cid;
#define LSEAM(k) do { if (IN(k) && IN((k) + 1)) { if (xlocal) xcd_local_barrier(bar, F.wave == 0); else GRID_BAR(); } } while (0)
    if (PHON(1) && IN(1)) { p1_modulate(F, inp(F, 0), mod, 0, 1024); } SEAM(1); STAMP(1);

    for (int layer = 0; layer < DEPTH; ++layer) {
        const int pb = 2 + layer * 8; const int j = layer >> 1;
        if ((layer & 1) == 0) {
            if (PHON(2) && IN(pb + 0)) { refresh(F); unsigned char* ws = opq(F.ws); (void)ws;
                PlainSched S{T / 256, 4, 256, F.G, cid, (const char*)(ws + WS_WPIN) + (size_t)j * 2 * MiB, 2048};
                pg8::EpiStore E{(bf16*)(ws + WS_U), D, nullptr, 0, 0, 0, F.lds + LDS_TB_OFF + F.wave * 2048};
                pg8::gemm_phase<pg8::EpiStore, PlainSched>(F.tid, F.lds, (const char*)(ws + WS_H), 2048, 2048, 1024, S, E);
            } LSEAM(pb + 0); STAMP(2);
            if (PHON(4) && IN(pb + 2)) { refresh(F); unsigned char* ws = opq(F.ws); (void)ws;
                GrpSched S{F.G, cid, (const char*)(ws + WS_WPGRP) + (size_t)j * 512 * 1024};
                { const bf16* U = (const bf16*)(ws + WS_U); bf16* Z = (bf16*)(ws + WS_Z); pg8::Unit pu;
                  for (int i = 0; S.next(i, pu); ++i) {
                      const int b = pu.pm >> 3, t0 = (pu.pm & 7) * 256 + 32 * F.wave, g = pu.pn;
                      if (g == 0) pool_item<2>(U, Z, b, t0, 0, F.lane); else if (g == 1) pool_item<4>(U, Z, b, t0, 1, F.lane);
                      else if (g == 2) pool_item<8>(U, Z, b, t0, 2, F.lane); else pool_item<16>(U, Z, b, t0, 3, F.lane); }
                  asm volatile("s_waitcnt vmcnt(0)" ::: "memory"); __syncthreads(); }
                pg8::EpiStore E{(bf16*)(ws + WS_Y2), D, inp(F, 6) + j * D, 0, 0, 0, F.lds + LDS_TB_OFF + F.wave * 2048};
                pg8::gemm_phase<pg8::EpiStore, GrpSched>(F.tid, F.lds, (const char*)(ws + WS_Z), 2048, 512, 256, S, E);
            } LSEAM(pb + 2); STAMP(4);
            if (PHON(5) && IN(pb + 3)) { refresh(F); unsigned char* ws = opq(F.ws); (void)ws;
                PlainSched S{T / 256, 4, 256, F.G, cid, (const char*)(ws + WS_WPOUT) + (size_t)j * 2 * MiB, 2048};
                pg8::EpiStore E{(bf16*)(ws + WS_Y), D, nullptr, 0, 0, 1, F.lds + LDS_TB_OFF + F.wave * 2048};
                pg8::gemm_phase<pg8::EpiStore, PlainSched>(F.tid, F.lds, (const char*)(ws + WS_Y2), 2048, 2048, 1024, S, E);
            } LSEAM(pb + 3); STAMP(5);
        } else {
            if (PHON(6) && IN(pb + 0)) { refresh(F); unsigned char* ws = opq(F.ws); (void)ws;
                PlainSched S{T / 256, NQKV / 256, (T / 256) * (NQKV / 256), F.G, cid, (const char*)(ws + WS_WAIN) + (size_t)j * 18 * MiB, 2048};
                pg8::EpiStoreF8 E{(unsigned char*)(ws + WS_QKV), NQKV, F.lds + LDS_TB_OFF + F.wave * 2048, 1};
                pg8::gemm_phase<pg8::EpiStoreF8, PlainSched>(F.tid, F.lds, (const char*)(ws + WS_H), 2048, 2048, 1024, S, E);
            } LSEAM(pb + 0); STAMP(6);
            if (PHON(7) && IN(pb + 1)) { refresh(F); unsigned char* ws = opq(F.ws); (void)ws;
#ifdef NAIVE_ATTN
                attn_phase_naive(F, (bf16*)(F.ws + WS_Y2), 7);
#ifdef ORACLE
                if (layer == ORACLE_LAYER) { attn_phase_naive(F, (bf16*)(F.ws + WS_Z), ATTN_GMASK); attn_phase(F, (bf16*)(F.ws + WS_U)); }
#endif
#else
                attn_phase(F, (bf16*)(F.ws + WS_Y2));
#endif
            } if (IN(pb + 1) && IN(pb + 3)) { if (xlocal) xcd_local_barrier(bar, F.wave == 0); else GRID_BAR(); } STAMP(7);
            if (IN(pb + 2)) { refresh(F); unsigned char* ws = opq(F.ws); (void)ws;
#ifdef ORACLE
                if (layer == ORACLE_LAYER) { if (blockIdx.x == 0 && F.tid == 0) atomicAdd(F.ctl + 20000, 3276u * 16u);
                    const bf16* A = (const bf16*)(ws + WS_U); const bf16* B = (const bf16*)(ws + WS_Z);
                    const int gw = F.vcu * NWAVES + F.wave, NGW = F.G * NWAVES;
                    for (int tok = gw; tok < T; tok += NGW) { int bad = 0;
                        for (int h = 0; h < 16; ++h) { if (ORACLE_SEL) { const float a = bf2f(A[(size_t)tok * D + h * 64 + F.lane]), b = bf2f(B[(size_t)tok * D + h * 64 + F.lane]);
                            const float e2 = wave_sum((a - b) * (a - b)), n2 = wave_sum(b * b); if (!(e2 <= 0.0025f * n2)) bad += ORACLE_W; } }
                        if (bad && F.lane == 0) atomicAdd(F.ctl + 20000, (unsigned)bad); } }
#endif
            }
            if (PHON(8) && IN(pb + 3)) { refresh(F); unsigned char* ws = opq(F.ws); (void)ws;
                PlainSched S{T / 256, 4, 256, F.G, cid, (const char*)(ws + WS_WAOUT) + (size_t)j * 2 * MiB, 2048};
                pg8::EpiStore E{(bf16*)(ws + WS_Y), D, nullptr, 0, 0, 1, F.lds + LDS_TB_OFF + F.wave * 2048};
                pg8::gemm_phase<pg8::EpiStore, PlainSched>(F.tid, F.lds, (const char*)(ws + WS_Y2), 2048, 2048, 1024, S, E);
            } LSEAM(pb + 3); STAMP(8);
        }
        if (PHON(9) && IN(pb + 4)) { refresh(F); unsigned char* ws = opq(F.ws); (void)ws; const float* xin = (layer == 0) ? inp(F, 0) : (const float*)(ws + WS_X); if (layer == 0) ln1_router_phase<false>(F, layer, xin); else ln1_router_phase<true>(F, layer, xin); } SEAM(pb + 4); STAMP(9);
        if (PHON(10) && IN(pb + 5)) { refresh(F); unsigned char* ws = opq(F.ws); (void)ws;
            moe_build_table(F, layer);
            const LAS int* ts = (const LAS int*)(F.lc + LC_TS);
            const int ntile = ts[65];
            MoeSched<true> S{ts, (const LAS int*)(F.lc + LC_CNT), 2, ntile * 2, F.G, cid, F.lane, (const int*)(ws + WS_TOKL), (const float*)(ws + WS_WL),
                       (const char*)(ws + WS_WEGU) + (size_t)layer * 64 * MiB, (size_t)1 * MiB, (const char*)(ws + WS_WSHGU) + (size_t)layer * MiB, 2048};
            pg8::EpiGU E{(bf16*)(ws + WS_ACT)};
            pg8::gemm_phase<pg8::EpiGU, MoeSched<true>>(F.tid, F.lds, (const char*)(ws + WS_H), 2048, 2048, 1024, S, E);
        } LSEAM(pb + 5); STAMP(10);
        if (PHON(11) && IN(pb + 6)) { refresh(F); unsigned char* ws = opq(F.ws); (void)ws;
            moe_build_table(F, layer);
            const LAS int* ts = (const LAS int*)(F.lc + LC_TS);
            const int ntile = ts[65];
            MoeSched<false> S{ts, (const LAS int*)(F.lc + LC_CNT), 4, ntile * 4, F.G, cid, F.lane, nullptr, nullptr,
                       (const char*)(ws + WS_WEDN) + (size_t)layer * 32 * MiB, (size_t)512 * 1024, (const char*)(ws + WS_WSHDN) + (size_t)layer * 512 * 1024, 512};
            pg8::EpiStoreF8 E{(unsigned char*)(ws + WS_YS), D, F.lds + LDS_TB_OFF + F.wave * 2048, 0};
            pg8::gemm_phase<pg8::EpiStoreF8, MoeSched<false>>(F.tid, F.lds, (const char*)(ws + WS_ACT), 512, 512, 256, S, E);
        } SEAM(pb + 6); STAMP(11);
        if (PHON(12) && IN(pb + 7)) { refresh(F); unsigned char* ws = opq(F.ws); (void)ws; moe_build_table(F, layer); combine_ln2_phase(F, layer); }
        if (layer < DEPTH - 1) LSEAM(pb + 7);
        STAMP(12);
    }
#ifdef PROBE_TYPE
    if (blockIdx.x == 0 && F.tid == 0) { const unsigned long long t0_ = __builtin_amdgcn_s_memrealtime(); const unsigned long long want_ = 4ull * ((LAS unsigned long long*)(F.lc + LC_STAMP))[1 + PROBE_TYPE];
        while (__builtin_amdgcn_s_memrealtime() - t0_ < want_) __builtin_amdgcn_s_sleep(8); }
#endif
#undef IN
#undef SEAM
}

extern "C" void kernel_launch(void* const* d_in, const int* in_sizes, int n_in, void* d_out, int out_size, void* d_ws, size_t ws_size, hipStream_t stream) {
    static int grid = 0;
    if (grid == 0) {
        if (n_in != 20 || in_sizes[0] != T * D || out_size != T * D || ws_size < WS_END) { fprintf(stderr, "kernel_launch: unexpected shapes / workspace (n_in %d, ws %zu); nothing launched\n", n_in, ws_size); grid = -1; return; }
        int dev = 0, cus = 0, per_cu = 0;
        if (hipGetDevice(&dev) != hipSuccess || hipDeviceGetAttribute(&cus, hipDeviceAttributeMultiprocessorCount, dev) != hipSuccess) { grid = -1; return; }
        if (hipFuncSetAttribute((const void*)mk_fwd, hipFuncAttributeMaxDynamicSharedMemorySize, LDS_BYTES) != hipSuccess) { fprintf(stderr, "kernel_launch: hipFuncSetAttribute failed\n"); grid = -1; return; }
        if (hipOccupancyMaxActiveBlocksPerMultiprocessor(&per_cu, (const void*)mk_fwd, NWAVES * 64, LDS_BYTES) != hipSuccess || per_cu < 1) { fprintf(stderr, "kernel_launch: occupancy query says %d\n", per_cu); }
        (void)hipGetLastError();
        grid = cus;
    }
    if (grid < 0) return;
    if (hipMemsetAsync((char*)d_ws + WS_CTL, 0, CTL_ZERO_BYTES, stream) != hipSuccess) return;
    Args a{};
    for (int i = 0; i < 20; ++i) a.in[i] = (const float*)d_in[i];
    a.out = (float*)d_out; a.ws = (unsigned char*)d_ws;
#if MK_PER_PHASE
    for (int p = 0; p < NPHASE; ++p) { a.ph_lo = p; a.ph_hi = p + 1; hipLaunchKernelGGL(mk_fwd, dim3(grid), dim3(NWAVES * 64), LDS_BYTES, stream, a); }
#else
    a.ph_lo = 0; a.ph_hi = NPHASE;
    hipLaunchKernelGGL(mk_fwd, dim3(grid), dim3(NWAVES * 64), LDS_BYTES, stream, a);
#endif
    const hipError_t le = hipPeekAtLastError();
    if (le != hipSuccess) fprintf(stderr, "kernel_launch: launch failed: %s\n", hipGetErrorName(le));
}
```

```cpp
#include <hip/hip_runtime.h>
#include <cstdio>
#include <cstdint>

#ifndef MK_PER_PHASE
#define MK_PER_PHASE 0
#endif
#define ORACLE_SEL 1
#define ATTN_GMASK 7
#define ORACLE_W 1
#define ORACLE_LAYER 1
#ifndef MK_XLOCAL
#define MK_XLOCAL 1
#endif
#ifndef PHSEL
#define PHSEL 0xFFFF
#endif
#define PHON(n) (((PHSEL) >> (n)) & 1)

#define GAS __attribute__((address_space(1)))
#define LAS __attribute__((address_space(3)))
typedef unsigned short bf16;
typedef short bf16x8 __attribute__((ext_vector_type(8)));
typedef short s16x4 __attribute__((ext_vector_type(4)));
typedef float f32x2 __attribute__((ext_vector_type(2)));
typedef float f32x4 __attribute__((ext_vector_type(4)));
typedef float f32x16 __attribute__((ext_vector_type(16)));
typedef unsigned u32x2 __attribute__((ext_vector_type(2)));
typedef unsigned u32x4 __attribute__((ext_vector_type(4)));

constexpr int BATCH = 8, SEQ = 2048, D = 1024, T = BATCH * SEQ, DEPTH = 4;
constexpr int NQKV = 9216, NE = 64, TOPK = 8, DEXP = 256;
constexpr int CAP = 16384;
constexpr int PSLOT = 147456 + T;
constexpr float ALPHA = 1.6817928305074290f;
constexpr float LN_EPS = 1e-5f;
constexpr float LOG2E = 1.4426950408889634f;
constexpr float QSCALE = 0.125f * LOG2E;
constexpr float ROUTED_SCALE = 2.5f;

constexpr size_t MiB = 1u << 20;
constexpr size_t WS_CTL = 0, CTL_ZERO_BYTES = 1 * MiB;
constexpr size_t WS_MOD = 1 * MiB;
constexpr size_t WS_WRHI = 2 * MiB;
constexpr size_t WS_WRLO = WS_WRHI + 512 * 1024;
constexpr size_t WS_WPIN = 3 * MiB;
constexpr size_t WS_WPGRP = 7 * MiB;
constexpr size_t WS_WPOUT = 8 * MiB;
constexpr size_t WS_WAIN = 12 * MiB;
constexpr size_t WS_WAOUT = 48 * MiB;
constexpr size_t WS_WSHGU = 52 * MiB;
constexpr size_t WS_WSHDN = 56 * MiB;
constexpr size_t WS_WEGU = 58 * MiB;
constexpr size_t WS_WEDN = 314 * MiB;
constexpr size_t WS_X = 442 * MiB;
constexpr size_t WS_H = 506 * MiB;
constexpr size_t WS_Y = 538 * MiB;
constexpr size_t WS_U = 570 * MiB;
constexpr size_t WS_Z = 602 * MiB;
constexpr size_t WS_Y2 = 634 * MiB;
constexpr size_t WS_YS = 666 * MiB;
constexpr size_t WS_ACT = 986 * MiB;
constexpr size_t WS_TOKL = 1066 * MiB;
constexpr size_t WS_WL = 1070 * MiB;
constexpr size_t WS_TSLOT = 1074 * MiB;
constexpr size_t WS_QKV = 1076 * MiB;
constexpr size_t WS_END = 1364 * MiB;
static_assert(WS_YS + (size_t)PSLOT * 2048 <= WS_ACT && WS_ACT + (size_t)PSLOT * 512 <= WS_TOKL, "ws map");
constexpr int CW_BAR = 4096;
constexpr int CW_CNT = 12288;

constexpr int RING_BYTES = 135168;
constexpr int LDSCTL_OFF = RING_BYTES;
constexpr int LDS_TB_OFF = 147456;
constexpr int LDS_BYTES = 163840;
constexpr int LC_MISC = 0;
constexpr int LC_TS = 128;
constexpr int LC_CNT = 128 + 272;
constexpr int LC_LCNT = 128 + 272 + 256;
constexpr int LC_GB = 128 + 272 + 512;

#define RLX_AGENT __ATOMIC_RELAXED, __HIP_MEMORY_SCOPE_AGENT
#define LDS_WAIT() asm volatile("s_waitcnt lgkmcnt(0)" ::: "memory")
#define VM_WAIT() asm volatile("s_waitcnt vmcnt(0)" ::: "memory")

typedef __bf16 b16x2 __attribute__((ext_vector_type(2)));
__device__ __forceinline__ unsigned f2bf(float f) { unsigned u = __builtin_bit_cast(unsigned, f); return (u + 0x7fffu + ((u >> 16) & 1u)) >> 16; }
__device__ __forceinline__ unsigned pk2(float lo, float hi) { const f32x2 v = {lo, hi}; return __builtin_bit_cast(unsigned, __builtin_convertvector(v, b16x2)); }
__device__ __forceinline__ float bf2f(unsigned h) { return __builtin_bit_cast(float, h << 16); }
__device__ __forceinline__ unsigned cvt_pk_bf16(float lo, float hi) { return pk2(lo, hi); }
typedef _Float16 h16x2 __attribute__((ext_vector_type(2)));
__device__ __forceinline__ unsigned pkh2(float lo, float hi) { const f32x2 v = {lo, hi}; return __builtin_bit_cast(unsigned, __builtin_convertvector(v, h16x2)); }
__device__ __forceinline__ float h2f(unsigned h) { return (float)__builtin_bit_cast(_Float16, (unsigned short)h); }
#define MFMA16(a, b, c) __builtin_amdgcn_mfma_f32_16x16x32_bf16(a, b, c, 0, 0, 0)
#define MFMA32(a, b, c) __builtin_amdgcn_mfma_f32_32x32x16_bf16(a, b, c, 0, 0, 0)
__device__ __forceinline__ float wave_sum(float v) {
#pragma unroll
    for (int o = 1; o < 64; o <<= 1) v += __shfl_xor(v, o);
    return v;
}

namespace pg8 {
constexpr int BM = 256, BK = 64, HALF = 128, HTB = HALF * BK * 2, STAGE_BYTES = 8 * HTB, NXCD = 8;
__host__ __device__ __forceinline__ int lds_byte(int r, int c) { const int st = (r >> 4) * 2 + (c >> 5), rr = r & 15, cc = c & 31, ob = rr * 64 + cc * 2; return st * 1024 + (ob ^ (((ob >> 9) & 1) << 5)); }
__host__ __device__ __forceinline__ void stage_rc(int b, int& R, int& C) { const int st = b / 1024, sb = b % 1024, swz = sb ^ (((sb >> 9) & 1) << 5); R = (st >> 1) * 16 + swz / 64; C = (st & 1) * 32 + (swz % 64) / 2; }
__host__ __device__ __forceinline__ int perm32(int rho) { const int n = rho >> 4, i = rho & 15; return 8 * (i >> 2) + 4 * n + (i & 3); }

struct Unit {
    int pm, pn;
    const char* bptr;
    int roff;
    int nvalid;
};

__device__ __forceinline__ int xcd_chunk(int L, int nwg) { const int q = nwg / NXCD, r = nwg % NXCD, xcd = L % NXCD, off = L / NXCD; return (xcd < r ? xcd * (q + 1) : r * (q + 1) + (xcd - r) * q) + off; }

template <class Epi, class Sched>
__device__ __forceinline__ void gemm_phase(const int tid, LAS unsigned char* lds, const char* Abase, const int lda, const int ldb, const int K, const Sched& S, const Epi& E) {
    constexpr bool GATHER = Sched::GATHER;
    const int wid = __builtin_amdgcn_readfirstlane(tid >> 6), lane = tid & 63, wr = wid >> 2, wc = wid & 3, fr = lane & 15, fq = lane >> 4;
    const int nt = K / BK;
    int Rr[2]; unsigned C2[2], voffB[2], voffA[2];
#pragma unroll
    for (int i = 0; i < 2; ++i) { int R, C; stage_rc(tid * 16 + i * 8192, R, C); const int Rb = Epi::WIDE ? ((R >> 5) * 64 + perm32(R & 31)) : ((R & ~31) + perm32(R & 31)); Rr[i] = R; C2[i] = (unsigned)C * 2u; voffB[i] = (unsigned)(Rb * ldb) + (unsigned)C * 2u;
        voffA[i] = Sched::ABLK ? (unsigned)((C >> 5) * 16384 + R * 64 + (C & 31) * 2) : ((unsigned)(R * lda) + (unsigned)C * 2u); }
    const size_t kstep = (size_t)(BK * 2);
    const size_t hstepB = (size_t)(Epi::WIDE ? 32 : HALF) * ldb;
    const size_t hstepA = GATHER ? (size_t)0 : (Sched::ABLK ? (size_t)8192 : (size_t)HALF * lda);
    const size_t kstepA = Sched::ABLK ? (size_t)32768 : kstep;
    const unsigned ldsw = (unsigned)wid * 1024u;
    const int aoff = lds_byte(wr * 64 + fr, fq * 8), boff = lds_byte(wc * 32 + fr, fq * 8);
#define PG8_SA(b, h) (((b) * 2 + (h)) * HTB)
#define PG8_SB(b, h) ((4 + (b) * 2 + (h)) * HTB)
#define PG8_STAGE(bufoff, gbase, voff) do { _Pragma("unroll") for (int _i = 0; _i < 2; ++_i) \
        __builtin_amdgcn_global_load_lds((const unsigned*)((const char*)(gbase) + (voff)[_i]), (LAS unsigned*)(lds + (bufoff) + ldsw + _i * 8192), 16, 0, 0); } while (0)
#define PG8_STAGEA(bufoff, gbase, h) do { if constexpr (GATHER) { PG8_STAGE(bufoff, gbase, vA[h]); } else { PG8_STAGE(bufoff, (gbase) + (h) * hstepA, voffA); } } while (0)
#define PG8_LDA(dst, b, h) do { _Pragma("unroll") for (int m = 0; m < 4; ++m) _Pragma("unroll") for (int k = 0; k < 2; ++k) dst[m][k] = *(const LAS bf16x8*)(lds + PG8_SA(b, h) + aoff + m * 2048 + k * 1024); } while (0)
#define PG8_LDB(dst, b, h) do { _Pragma("unroll") for (int n = 0; n < 2; ++n) _Pragma("unroll") for (int k = 0; k < 2; ++k) dst[n][k] = *(const LAS bf16x8*)(lds + PG8_SB(b, h) + boff + n * 2048 + k * 1024); } while (0)
#define PG8_MMA(ai, bj, At, Bt) do { __builtin_amdgcn_s_setprio(1); _Pragma("unroll") for (int m = 0; m < 4; ++m) _Pragma("unroll") for (int n = 0; n < 2; ++n) _Pragma("unroll") for (int k = 0; k < 2; ++k) \
        acc[ai][bj][m][n] = MFMA16(Bt[n][k], At[m][k], acc[ai][bj][m][n]); __builtin_amdgcn_s_setprio(0); } while (0)
#define PG8_WAIT_V(n) asm volatile("s_waitcnt vmcnt(" #n ")" ::: "memory")
#define PG8_WAIT_L(n) asm volatile("s_waitcnt lgkmcnt(" #n ")" ::: "memory")
#define PG8_BAR __builtin_amdgcn_s_barrier()
#define PG8_SCHED __builtin_amdgcn_sched_barrier(0)
#define PG8_CALCA(u, vo) do { _Pragma("unroll") for (int _h = 0; _h < 2; ++_h) _Pragma("unroll") for (int _i = 0; _i < 2; ++_i) \
        vo[_h][_i] = (unsigned)S.arow(u, _h * HALF + Rr[_i]) * (unsigned)lda + C2[_i]; } while (0)
    Unit cur, nxt; int ui = 0;
    if (!S.next(0, cur)) return;
    f32x4 acc[2][2][4][2];
#pragma unroll
    for (int a = 0; a < 2; ++a)
#pragma unroll
        for (int b = 0; b < 2; ++b)
#pragma unroll
            for (int m = 0; m < 4; ++m)
#pragma unroll
                for (int n = 0; n < 2; ++n) acc[a][b][m][n] = (f32x4){0.f, 0.f, 0.f, 0.f};
    bf16x8 At[4][2], B0[2][2], B1[2][2];
    unsigned vA[2][2], vAn[2][2];
    const char* cA = Abase;
    if constexpr (GATHER) { PG8_CALCA(cur, vA); } else { cA = Abase + (size_t)S.arow(cur, 0) * lda + S.acolb(cur); }
    const char* cB = cur.bptr;
    PG8_STAGE(PG8_SB(0, 0), cB, voffB); PG8_STAGE(PG8_SB(0, 1), cB + hstepB, voffB); PG8_STAGEA(PG8_SA(0, 0), cA, 0); PG8_STAGEA(PG8_SA(0, 1), cA, 1);
    if (wr == 1) PG8_BAR;
    PG8_WAIT_V(2); PG8_BAR;
    PG8_STAGE(PG8_SB(1, 0), cB + kstep, voffB); PG8_STAGEA(PG8_SA(1, 0), cA + kstepA, 0); PG8_STAGE(PG8_SB(1, 1), cB + hstepB + kstep, voffB);
    PG8_WAIT_V(6); PG8_BAR;
    for (;;) {
        const bool has_next = S.next(ui + 1, nxt);
        float rs[2][4];
        if constexpr (Epi::ROWSCALE) {
#pragma unroll
            for (int ai = 0; ai < 2; ++ai)
#pragma unroll
                for (int m = 0; m < 4; ++m) rs[ai][m] = S.rowscale(cur, ai * HALF + wr * 64 + m * 16 + fr);
        }
        const char* nA = cA;
        if constexpr (GATHER) {
            if (has_next) { PG8_CALCA(nxt, vAn); }
            else {
#pragma unroll
                for (int h = 0; h < 2; ++h)
#pragma unroll
                    for (int i = 0; i < 2; ++i) vAn[h][i] = vA[h][i];
            }
            asm volatile("s_waitcnt vmcnt(0)" : "+v"(vAn[0][0]), "+v"(vAn[0][1]), "+v"(vAn[1][0]), "+v"(vAn[1][1]) :: "memory");
            if constexpr (Epi::ROWSCALE) { asm volatile("" : "+v"(rs[0][0]), "+v"(rs[0][1]), "+v"(rs[0][2]), "+v"(rs[0][3]), "+v"(rs[1][0]), "+v"(rs[1][1]), "+v"(rs[1][2]), "+v"(rs[1][3])); }
        } else { if (has_next) nA = Abase + (size_t)S.arow(nxt, 0) * lda + S.acolb(nxt); }
        const char* nB = has_next ? nxt.bptr : cB;
#pragma unroll 1
        for (int t = 0; t < nt; t += 2) {
            const bool last = (t == nt - 2);
            const char* a1 = cA + (size_t)(t + 1) * kstepA;
            const char* a2 = last ? nA : cA + (size_t)(t + 2) * kstepA; const char* b2 = last ? nB : cB + (size_t)(t + 2) * kstep;
            const char* a3 = a2 + kstepA; const char* b3 = b2 + kstep;
            PG8_LDB(B0, 0, 0); PG8_LDB(B1, 0, 1); PG8_SCHED; PG8_LDA(At, 0, 0); PG8_STAGEA(PG8_SA(1, 1), a1, 1);
            if constexpr (GATHER) { if (last) {
#pragma unroll
                for (int h = 0; h < 2; ++h)
#pragma unroll
                    for (int i = 0; i < 2; ++i) vA[h][i] = vAn[h][i]; } }
            PG8_WAIT_V(8); PG8_WAIT_L(0); PG8_BAR; PG8_MMA(0, 0, At, B0); PG8_MMA(0, 1, At, B1); PG8_BAR; PG8_SCHED;
            PG8_LDA(At, 0, 1); PG8_STAGE(PG8_SB(0, 0), b2, voffB); PG8_STAGE(PG8_SB(0, 1), b2 + hstepB, voffB); PG8_STAGEA(PG8_SA(0, 0), a2, 0);
            PG8_WAIT_V(8); PG8_WAIT_L(0); PG8_BAR; PG8_MMA(1, 0, At, B0); PG8_MMA(1, 1, At, B1); PG8_BAR; PG8_SCHED;
            PG8_LDB(B0, 1, 0); PG8_LDB(B1, 1, 1); PG8_SCHED; PG8_LDA(At, 1, 0); PG8_STAGEA(PG8_SA(0, 1), a2, 1);
            PG8_WAIT_V(8); PG8_WAIT_L(0); PG8_BAR; PG8_MMA(0, 0, At, B0); PG8_MMA(0, 1, At, B1); PG8_BAR; PG8_SCHED;
            PG8_LDA(At, 1, 1); PG8_STAGE(PG8_SB(1, 0), b3, voffB); PG8_STAGE(PG8_SB(1, 1), b3 + hstepB, voffB); PG8_STAGEA(PG8_SA(1, 0), a3, 0);
            PG8_WAIT_V(8); PG8_WAIT_L(0); PG8_BAR; PG8_MMA(1, 0, At, B0); PG8_MMA(1, 1, At, B1); PG8_BAR; PG8_SCHED;
        }
        if (wr == 0) PG8_BAR;
        E(acc, cur, rs, wr, wc, fr, fq);
        if (!has_next) break;
#pragma unroll
        for (int a = 0; a < 2; ++a)
#pragma unroll
            for (int b = 0; b < 2; ++b)
#pragma unroll
                for (int m = 0; m < 4; ++m)
#pragma unroll
                    for (int n = 0; n < 2; ++n) acc[a][b][m][n] = (f32x4){0.f, 0.f, 0.f, 0.f};
        cur = nxt; cB = nB; cA = nA; ++ui;
        if (wr == 1) PG8_BAR;
    }
    PG8_WAIT_V(0);
    PG8_BAR;
#undef PG8_SA
#undef PG8_SB
#undef PG8_STAGE
#undef PG8_STAGEA
#undef PG8_LDA
#undef PG8_LDB
#undef PG8_MMA
#undef PG8_WAIT_V
#undef PG8_WAIT_L
#undef PG8_BAR
#undef PG8_SCHED
#undef PG8_CALCA
}

struct EpiStore {
    static constexpr bool ROWSCALE = false, WIDE = true;
    bf16* O; int ldc; const float* cscale; int qmode; int ntst; int f16; LAS unsigned char* tb;
    __device__ __forceinline__ void operator()(const f32x4 (&acc)[2][2][4][2], const Unit& u, const float (&rs)[2][4], int wr, int wc, int fr, int fq) const {
        const int colw = u.pn * BM + wc * 64;
        float sc = 1.f; if (qmode) { if ((((u.pn * BM) >> 10) % 3) == 0) sc = QSCALE; }
        f32x4 cs[2][2];
#pragma unroll
        for (int bj = 0; bj < 2; ++bj)
#pragma unroll
            for (int n = 0; n < 2; ++n) { cs[bj][n] = cscale ? *(const f32x4*)(cscale + colw + 32 * bj + 8 * fq + 4 * n) : (f32x4){1.f, 1.f, 1.f, 1.f}; cs[bj][n] = cs[bj][n] * sc; }
        const int L = fr + 16 * fq, rr = L >> 3, sg = L & 7;
        LAS u32x4* tbv = (LAS u32x4*)tb;
        const int wi0 = fr * 8 + (fq ^ (fr & 7)), wi1 = fr * 8 + ((4 + fq) ^ (fr & 7)), ri = rr * 8 + (sg ^ rr);
        bf16* gp = O + (size_t)(u.pm * BM + wr * 64 + rr) * ldc + colw + sg * 8;
#pragma unroll
        for (int ai = 0; ai < 2; ++ai)
#pragma unroll
            for (int m = 0; m < 4; ++m) {
                u32x4 w[2];
#pragma unroll
                for (int bj = 0; bj < 2; ++bj) { const f32x4 v0 = acc[ai][bj][m][0] * cs[bj][0], v1 = acc[ai][bj][m][1] * cs[bj][1];
                    if (f16) { w[bj].x = pkh2(v0[0], v0[1]); w[bj].y = pkh2(v0[2], v0[3]); w[bj].z = pkh2(v1[0], v1[1]); w[bj].w = pkh2(v1[2], v1[3]); }
                    else { w[bj].x = cvt_pk_bf16(v0[0], v0[1]); w[bj].y = cvt_pk_bf16(v0[2], v0[3]); w[bj].z = cvt_pk_bf16(v1[0], v1[1]); w[bj].w = cvt_pk_bf16(v1[2], v1[3]); } }
                tbv[wi0] = w[0]; tbv[wi1] = w[1];
                asm volatile("" ::: "memory");
                const u32x4 r0 = tbv[ri], r1 = tbv[ri + 64];
                asm volatile("" ::: "memory");
                bf16* rowp = gp + (size_t)(ai * HALF + m * 16) * ldc;
                if (ntst) { __builtin_nontemporal_store(r0, (u32x4*)rowp); __builtin_nontemporal_store(r1, (u32x4*)(rowp + (size_t)8 * ldc)); }
                else { *(u32x4*)rowp = r0; *(u32x4*)(rowp + (size_t)8 * ldc) = r1; } }
    }
};
typedef unsigned u32x2_t __attribute__((ext_vector_type(2)));
struct EpiStoreF8 {
    static constexpr bool ROWSCALE = false, WIDE = true;
    unsigned char* O; int ldc; LAS unsigned char* tb; int qmode;
    __device__ __forceinline__ void operator()(const f32x4 (&acc)[2][2][4][2], const Unit& u, const float (&rs)[2][4], int wr, int wc, int fr, int fq) const {
        const int colw = u.pn * BM + wc * 64;

        const int L = fr + 16 * fq, rr = L >> 2, sg = L & 3;
        LAS unsigned char* wp0 = tb + fr * 64 + ((fq) ^ (fr & 7)) * 8; LAS unsigned char* wp1 = tb + fr * 64 + ((4 + fq) ^ (fr & 7)) * 8;
        const LAS unsigned char* rp0 = tb + rr * 64 + ((2 * sg) ^ (rr & 7)) * 8; const LAS unsigned char* rp1 = tb + rr * 64 + ((2 * sg + 1) ^ (rr & 7)) * 8;
        unsigned char* gp = O + (size_t)(u.pm * BM + wr * 64 + rr) * ldc + colw + sg * 16;
#pragma unroll
        for (int ai = 0; ai < 2; ++ai)
#pragma unroll
            for (int m = 0; m < 4; ++m) {
                u32x2_t w[2];
#pragma unroll
                for (int bj = 0; bj < 2; ++bj) { const f32x4 v0 = acc[ai][bj][m][0], v1 = acc[ai][bj][m][1];
                    int p0 = __builtin_amdgcn_cvt_pk_fp8_f32(v0[0], v0[1], 0, false); p0 = __builtin_amdgcn_cvt_pk_fp8_f32(v0[2], v0[3], p0, true);
                    int p1 = __builtin_amdgcn_cvt_pk_fp8_f32(v1[0], v1[1], 0, false); p1 = __builtin_amdgcn_cvt_pk_fp8_f32(v1[2], v1[3], p1, true);
                    w[bj].x = (unsigned)p0; w[bj].y = (unsigned)p1; }
                *(LAS u32x2_t*)wp0 = w[0]; *(LAS u32x2_t*)wp1 = w[1];
                asm volatile("" ::: "memory");
                const u32x2_t a = *(const LAS u32x2_t*)rp0, b = *(const LAS u32x2_t*)rp1;
                asm volatile("" ::: "memory");
                u32x4 o; o.x = a.x; o.y = a.y; o.z = b.x; o.w = b.y;
                *(GAS u32x4*)(gp + (size_t)(ai * HALF + m * 16) * ldc) = o; }
    }
};
struct EpiGU {
    static constexpr bool ROWSCALE = false, WIDE = false;
    bf16* O;
    __device__ __forceinline__ void operator()(const f32x4 (&acc)[2][2][4][2], const Unit& u, const float (&rs)[2][4], int wr, int wc, int fr, int fq) const {
        bf16* tp = O + (size_t)u.pm * (BM * DEXP) + (size_t)(u.pn * 4 + wc) * (BM * 32) + (wr * 64 + fr) * 32 + 8 * fq;
#pragma unroll
        for (int ai = 0; ai < 2; ++ai)
#pragma unroll
            for (int m = 0; m < 4; ++m) { bf16* rowp = tp + (ai * HALF + m * 16) * 32;
                float o[8];
#pragma unroll
                for (int n = 0; n < 2; ++n)
#pragma unroll
                    for (int j = 0; j < 4; ++j) { const float g = acc[ai][0][m][n][j], uu = acc[ai][1][m][n][j];
                        const float sg = g * __builtin_amdgcn_rcpf(1.0f + __builtin_amdgcn_exp2f(-g * LOG2E)); o[n * 4 + j] = sg * uu; }
                u32x4 wv; wv.x = cvt_pk_bf16(o[0], o[1]); wv.y = cvt_pk_bf16(o[2], o[3]); wv.z = cvt_pk_bf16(o[4], o[5]); wv.w = cvt_pk_bf16(o[6], o[7]);
                *(u32x4*)rowp = wv; }
    }
};
}

#define XB_TMO      128
#define XB_XCNT(j)  (256  + 64 * (j))
#define XB_XSUB(j)  (1280 + 64 * (j))
#define XB_XGEN(j)  (2304 + 64 * (j))
#define XB_TOP      3328
#define XB_TOPGEN   3392
#define XB_LSUB(j)  (3456 + 64 * (j))
#define XB_LGEN(j)  (4480 + 64 * (j))
#define XCD_BAR_WORDS 5504
#define XB_SPIN_CAP (1u << 18)
__device__ __forceinline__ unsigned xb_ld(unsigned* p)              { return __hip_atomic_load(p, __ATOMIC_RELAXED, __HIP_MEMORY_SCOPE_AGENT); }
__device__ __forceinline__ unsigned xb_add(unsigned* p, unsigned v) { return __hip_atomic_fetch_add(p, v, __ATOMIC_RELAXED, __HIP_MEMORY_SCOPE_AGENT); }
__device__ __forceinline__ unsigned xb_xcc_id() { return (unsigned)__builtin_amdgcn_s_getreg((3 << 11) | 20) & 0xFu; }
#define XB_SPIN(cond, bar) do { unsigned _sp = 0; while (cond) { __builtin_amdgcn_s_sleep(1); \
    if ((++_sp & 255u) == 0u) { if (xb_ld(&(bar)[XB_TMO])) break; if (_sp > XB_SPIN_CAP) { atomicAdd(&(bar)[XB_TMO], 1u); break; } } } } while (0)
struct XcdBarrier { unsigned* bar; unsigned x; volatile LAS unsigned* st; };
__device__ __forceinline__ XcdBarrier xcd_barrier_post(unsigned* bar, volatile LAS unsigned* st) {
    XcdBarrier b; b.bar = bar; b.x = xb_xcc_id(); b.st = st;
    if (threadIdx.x == 0) st[2] = xb_add(&bar[XB_XCNT(b.x)], 1u);
    return b;
}
__device__ __forceinline__ void xcd_local_barrier(const XcdBarrier& b, const bool wave0) {
    asm volatile("s_waitcnt vmcnt(0)" ::: "memory");
    __syncthreads();
    if (wave0 && __builtin_amdgcn_mbcnt_hi(~0u, __builtin_amdgcn_mbcnt_lo(~0u, 0u)) == 0u) {
        unsigned* bar = b.bar;
        __builtin_amdgcn_s_waitcnt(0);
        const unsigned nloc = b.st[0];
        const unsigned old = xb_add(&bar[XB_LSUB(b.x)], 1u);
        const unsigned gen = old / nloc;
        if (old + 1u == (gen + 1u) * nloc) xb_add(&bar[XB_LGEN(b.x)], 1u);
        else XB_SPIN(xb_ld(&bar[XB_LGEN(b.x)]) == gen, bar);
        __builtin_amdgcn_fence(__ATOMIC_ACQUIRE, "agent");
        asm volatile("s_waitcnt vmcnt(0)" ::: "memory");
    }
    __syncthreads();
}
__device__ __forceinline__ void xcd_barrier_complete(unsigned* bar, unsigned x, unsigned& nloc, unsigned& nx) {
    const unsigned G = gridDim.x * gridDim.y * gridDim.z;
    unsigned sum, cnt, mine, sp = 0u;
    for (;;) {
        sum = 0u; cnt = 0u; mine = 0u;
#pragma unroll
        for (unsigned j = 0; j < 16; ++j) { const unsigned c = xb_ld(&bar[XB_XCNT(j)]); sum += c; cnt += (c > 0u) ? 1u : 0u; mine = (j == x) ? c : mine; }
        if (sum == G) break;
        __builtin_amdgcn_s_sleep(1);
        if ((++sp & 255u) == 0u) { if (xb_ld(&bar[XB_TMO])) break; if (sp > XB_SPIN_CAP) { atomicAdd(&bar[XB_TMO], 1u); break; } }
    }
    nloc = mine > 0u ? mine : 1u; nx = cnt > 0u ? cnt : 1u;
}
__device__ __forceinline__ void xcd_barrier(const XcdBarrier& b) {
    asm volatile("s_waitcnt vmcnt(0)" ::: "memory");
    __syncthreads();
    if (threadIdx.x == 0) {
        unsigned* bar = b.bar;
        __builtin_amdgcn_s_waitcnt(0);
        unsigned nloc = b.st[0], nx = b.st[1];
        if (nloc == 0u) { xcd_barrier_complete(bar, b.x, nloc, nx); b.st[0] = nloc; b.st[1] = nx; }
        const unsigned old = xb_add(&bar[XB_XSUB(b.x)], 1u);
        const unsigned gen = old / nloc;
        if (old + 1u == (gen + 1u) * nloc) {
            __builtin_amdgcn_fence(__ATOMIC_RELEASE, "agent");
            asm volatile("s_waitcnt vmcnt(0)" ::: "memory");
            const unsigned og = xb_add(&bar[XB_TOP], 1u);
            const unsigned tg = og / nx;
            if (og + 1u == (tg + 1u) * nx) xb_add(&bar[XB_TOPGEN], 1u);
            else XB_SPIN(xb_ld(&bar[XB_TOPGEN]) == tg, bar);
            __builtin_amdgcn_fence(__ATOMIC_ACQUIRE, "agent");
            xb_add(&bar[XB_XGEN(b.x)], 1u);
            asm volatile("s_waitcnt vmcnt(0)" ::: "memory");
        } else {
            XB_SPIN(xb_ld(&bar[XB_XGEN(b.x)]) == gen, bar);
            __builtin_amdgcn_fence(__ATOMIC_ACQUIRE, "agent");
            asm volatile("s_waitcnt vmcnt(0)" ::: "memory");
        }
    }
    __syncthreads();
}

constexpr int NWAVES = 8;
struct Frame {
    LAS unsigned char* lds;
    LAS unsigned char* lc;
    unsigned* ctl;
    unsigned char* ws;
    int tid, lane, wave, vcu, G;
};
constexpr int LC_PTR = 2048;
__device__ __forceinline__ const float* inp(const Frame& F, int i) {
    const unsigned long long v = *(const LAS unsigned long long*)(F.lc + LC_PTR + 8 * i);
    const unsigned lo = __builtin_amdgcn_readfirstlane((unsigned)v), hi = __builtin_amdgcn_readfirstlane((unsigned)(v >> 32));
    return (const float*)(const GAS float*)(((unsigned long long)hi << 32) | lo);
}
__device__ __forceinline__ unsigned char* opq(unsigned char* p) { GAS unsigned char* g = (GAS unsigned char*)p; asm volatile("" : "+s"(g)); return (unsigned char*)g; }
__device__ __forceinline__ void refresh(Frame& F) { asm volatile("" : "+v"(F.tid)); F.lane = F.tid & 63; F.wave = __builtin_amdgcn_readfirstlane(F.tid >> 6); }

struct PlainSched {   static constexpr bool GATHER = false, ABLK = false;
    int nM, nN, nwg, G, c; const char* B; int ldb;
    __device__ __forceinline__ bool next(int i, pg8::Unit& u) const {
        const int L = i * G + c; if (L >= nwg) return false;
        const int wgid = pg8::xcd_chunk(L, nwg);
        const int nig = 8 * nN, gid = wgid / nig, fm = gid * 8, gsz = (nM - fm) < 8 ? (nM - fm) : 8;
        u.pm = fm + ((wgid % nig) % gsz); u.pn = (wgid % nig) / gsz;
        u.bptr = B + (size_t)u.pn * 256 * ldb; u.roff = -(u.pm * 256) - 1; u.nvalid = 256; return true;
    }
    __device__ __forceinline__ int arow(const pg8::Unit& u, int r) const { return -u.roff - 1 + r; }
    __device__ __forceinline__ int acolb(const pg8::Unit&) const { return 0; }
    __device__ __forceinline__ float rowscale(const pg8::Unit&, int) const { return 1.0f; }
};
struct GrpSched {     static constexpr bool GATHER = false, ABLK = false;
    int G, c; const char* B;
    __device__ __forceinline__ bool next(int i, pg8::Unit& u) const {
        const int L = i * G + c; if (L >= 256) return false;
        const int wgid = pg8::xcd_chunk(L, 256);
        u.pm = wgid >> 2; u.pn = wgid & 3; u.bptr = B + (size_t)u.pn * 256 * 512; u.roff = -(u.pm * 256) - 1; u.nvalid = 256; return true;
    }
    __device__ __forceinline__ int arow(const pg8::Unit& u, int r) const { return -u.roff - 1 + r; }
    __device__ __forceinline__ int acolb(const pg8::Unit& u) const { return u.pn * 512; }
    __device__ __forceinline__ float rowscale(const pg8::Unit&, int) const { return 1.0f; }
};
template <bool GATHER_> struct MoeSched {     static constexpr bool GATHER = GATHER_, ABLK = !GATHER_;
    const LAS int* ts; const LAS int* cn; int npn, nunits, G, c, lane_;
    const int* tokl; const float* wl; const char* Bexp; size_t bstride; const char* Bsh; int ldb;
    __device__ __forceinline__ bool next(int i, pg8::Unit& u) const {
        const int L = i * G + c; const int xg = L % pg8::NXCD, off = L / pg8::NXCD;
        const int ntile = nunits / npn, tq = ntile / pg8::NXCD, tr = ntile % pg8::NXCD;
        const int tcnt = tq + (xg < tr ? 1 : 0), tstart = xg * tq + (xg < tr ? xg : tr);
        if (off >= tcnt * npn) return false;
        const int tile = tstart + off / npn, pn = off % npn;
        const int lane = lane_;
        const bool hit = (tile >= ts[lane]) && (tile < ts[lane + 1]);
        const unsigned long long mk = __ballot(hit);
        const int e = mk ? (int)__builtin_ctzll(mk) : 64;
        const int tse = __builtin_amdgcn_readfirstlane(ts[e]);
        const int r0 = (tile - tse) * 256;
        u.pm = tile; u.pn = pn;
        u.bptr = (e < 64 ? Bexp + (size_t)e * bstride : Bsh) + (size_t)pn * 256 * ldb;
        if (GATHER) {
            if (e < 64) { const int ce = __builtin_amdgcn_readfirstlane(cn[e]); u.roff = e * CAP + r0; u.nvalid = (ce - r0) < 256 ? (ce - r0) : 256; }
            else { u.roff = -r0 - 1; u.nvalid = 256; }
        } else { u.roff = -(tile * 256) - 1; u.nvalid = 256; }
        return true;
    }
    __device__ __forceinline__ int arow(const pg8::Unit& u, int r) const { if (GATHER && u.roff >= 0) { const int rr = r < u.nvalid ? r : u.nvalid - 1; return tokl[u.roff + rr]; } return -u.roff - 1 + r; }
    __device__ __forceinline__ int acolb(const pg8::Unit&) const { return 0; }
    __device__ __forceinline__ float rowscale(const pg8::Unit& u, int r) const { if (GATHER && u.roff >= 0) { const int rr = r < u.nvalid ? r : u.nvalid - 1; return wl[u.roff + rr]; } return 1.0f; }
};

__device__ __forceinline__ void p0_transpose_item64(const float* W, int K, int N, bf16* WT, int dst_n0, LAS float* scr, int kb, int nb, int lane, const float wsc) {
    const int k0 = 64 * kb, n0 = 64 * nb; const int r = lane >> 4, c4 = lane & 15;
    f32x4 v[16];
#pragma unroll
    for (int i = 0; i < 16; ++i) v[i] = __builtin_nontemporal_load((const GAS f32x4*)(W + (size_t)(k0 + 4 * i + r) * N + n0 + 4 * c4));
#pragma unroll
    for (int i = 0; i < 16; ++i) { const int k = 4 * i + r; *(LAS f32x4*)(scr + k * 64 + 4 * (c4 ^ (k >> 3))) = v[i]; }
    LDS_WAIT(); asm volatile("" ::: "memory");
    const int c = lane & 7;
#pragma unroll
    for (int j = 0; j < 8; ++j) { const int n = (lane >> 3) + 8 * j; const LAS float* sp = scr + (8 * c) * 64 + 4 * ((n >> 2) ^ c) + (n & 3);
        u32x4 o; o.x = pk2(sp[0 * 64] * wsc, sp[1 * 64] * wsc); o.y = pk2(sp[2 * 64] * wsc, sp[3 * 64] * wsc); o.z = pk2(sp[4 * 64] * wsc, sp[5 * 64] * wsc); o.w = pk2(sp[6 * 64] * wsc, sp[7 * 64] * wsc);
        *(GAS u32x4*)(WT + (size_t)(dst_n0 + n) * K + k0 + 8 * c) = o; }
    LDS_WAIT(); asm volatile("" ::: "memory");
}
__device__ __forceinline__ void p0_router_item(const float* W, bf16* WH, bf16* WLo, LAS float* scr, int kb, int nb, int lane) {
    const int K = 1024, N = 64; const int k0 = 64 * kb, n0 = 32 * nb;
#pragma unroll 8
    for (int i = 0; i < 32; ++i) { const int kk = 2 * i + (lane >> 5); scr[kk * 33 + (lane & 31)] = W[(size_t)(k0 + kk) * N + n0 + (lane & 31)]; }
    LDS_WAIT(); asm volatile("" ::: "memory");
    const int c = lane & 7;
#pragma unroll
    for (int j = 0; j < 4; ++j) { const int n = (lane >> 3) + 8 * j; const LAS float* s = scr + (8 * c) * 33 + n;
        unsigned h[8], l[8];
#pragma unroll
        for (int q = 0; q < 8; ++q) { const float v = s[q * 33]; h[q] = f2bf(v); l[q] = f2bf(v - bf2f(h[q])); }
        u32x4 oh, ol; oh.x = h[0] | (h[1] << 16); oh.y = h[2] | (h[3] << 16); oh.z = h[4] | (h[5] << 16); oh.w = h[6] | (h[7] << 16);
        ol.x = l[0] | (l[1] << 16); ol.y = l[2] | (l[3] << 16); ol.z = l[4] | (l[5] << 16); ol.w = l[6] | (l[7] << 16);
        *(GAS u32x4*)(WH + (size_t)(n0 + n) * K + k0 + 8 * c) = oh; *(GAS u32x4*)(WLo + (size_t)(n0 + n) * K + k0 + 8 * c) = ol; }
    LDS_WAIT(); asm volatile("" ::: "memory");
}

__device__ __forceinline__ void p0_prologue(Frame& F) {
    LAS float* cs = (LAS float*)(F.lds);
    LAS float* part = (LAS float*)(F.lds + 32768);
    const float* c = inp(F, 1);
    for (int i = F.tid; i < 8 * 1024; i += 512) { const float v = c[i]; cs[i] = v / (1.0f + __expf(-v)); }
    __syncthreads();
    float* mod = (float*)(F.ws + WS_MOD);
    for (int it = F.vcu; it < 4 * 96; it += F.G) {
        const int layer = it / 96, slab = it % 96; const int col = slab * 64 + F.lane;
        const float* W = inp(F, 2) + (size_t)layer * 1024 * 6144 + col;
        float a[8];
#pragma unroll
        for (int b = 0; b < 8; ++b) a[b] = 0.f;
        const int k0 = F.wave * 128;
#pragma unroll 4
        for (int k = 0; k < 128; k += 4) {
            float w[4];
#pragma unroll
            for (int j = 0; j < 4; ++j) w[j] = W[(size_t)(k0 + k + j) * 6144];
#pragma unroll
            for (int b = 0; b < 8; ++b) { const f32x4 cv = *(const LAS f32x4*)(cs + b * 1024 + k0 + k); a[b] += cv[0] * w[0] + cv[1] * w[1] + cv[2] * w[2] + cv[3] * w[3]; }
        }
#pragma unroll
        for (int b = 0; b < 8; ++b) part[(F.wave * 8 + b) * 64 + F.lane] = a[b];
        __syncthreads();
        { const int b = F.wave; float s = 0.f;
#pragma unroll
          for (int w = 0; w < 8; ++w) s += part[(w * 8 + b) * 64 + F.lane];
          mod[((size_t)layer * 8 + b) * 6144 + col] = s + inp(F, 3)[layer * 6144 + col]; }
        __syncthreads();
    }
    __syncthreads();
    LAS float* scr = (LAS float*)(F.lds + F.wave * 16384);
    const int gw = F.vcu * NWAVES + F.wave, NGW = F.G * NWAVES;
    constexpr int I_PIN = 2 * 16 * 16, I_GRP = 8 * 4 * 4, I_POUT = I_PIN, I_AIN = 2 * 16 * 144, I_AOUT = I_PIN, I_SHGU = 4 * 16 * 8, I_SHDN = 4 * 4 * 16, I_R = 4 * 16 * 2;
    constexpr int I_EGU = 256 * 16 * 8, I_EDN = 256 * 4 * 16;
    constexpr int NITEMS = I_PIN + I_GRP + I_POUT + I_AIN + I_AOUT + I_SHGU + I_SHDN + I_R + I_EGU + I_EDN;
    for (int it = gw; it < NITEMS; it += NGW) {
        int r = it;
#define P0_GROUP(CNT, SRC, KK, NN, DST, GU) if (r < (CNT)) { const int per = ((KK) / 64) * ((NN) / 64), mat = r / per, q = r % per, nblk = (NN) / 64, kblk = (KK) / 64, nb = q / kblk, kb = q % kblk; (void)nblk; \
            int dn0 = 64 * nb; if ((GU) == 1) { const int n0 = 64 * nb; dn0 = (n0 < 256) ? ((n0 >> 7) * 256 + (n0 & 127)) : (((n0 - 256) >> 7) * 256 + 128 + ((n0 - 256) & 127)); } \
            p0_transpose_item64((SRC) + (size_t)mat * (KK) * (NN), (KK), (NN), (bf16*)(F.ws + (DST)) + (size_t)mat * (KK) * (NN), dn0, scr, kb, nb, F.lane, ((GU) == 2) ? (((((64 * nb) >> 10) % 3) == 0) ? QSCALE * 64.0f : 16.0f) : (((GU) == 3) ? 32.0f : 1.0f)); continue; } r -= (CNT);
        P0_GROUP(I_PIN, inp(F, 4), 1024, 1024, WS_WPIN, 0)
        P0_GROUP(I_GRP, inp(F, 5), 256, 256, WS_WPGRP, 0)
        P0_GROUP(I_POUT, inp(F, 7), 1024, 1024, WS_WPOUT, 0)
        P0_GROUP(I_AIN, inp(F, 8), 1024, 9216, WS_WAIN, 2)
        P0_GROUP(I_AOUT, inp(F, 9), 1024, 1024, WS_WAOUT, 0)
        P0_GROUP(I_SHGU, inp(F, 16), 1024, 512, WS_WSHGU, 1)
        P0_GROUP(I_SHDN, inp(F, 17), 256, 1024, WS_WSHDN, 3)
        if (r < I_R) { const int mat = r / 32, q = r % 32, kb = q / 2, nb = q % 2;
            p0_router_item(inp(F, 12) + (size_t)mat * 65536, (bf16*)(F.ws + WS_WRHI) + (size_t)mat * 65536, (bf16*)(F.ws + WS_WRLO) + (size_t)mat * 65536, scr, kb, nb, F.lane); continue; } r -= I_R;
        P0_GROUP(I_EGU, inp(F, 14), 1024, 512, WS_WEGU, 1)
        P0_GROUP(I_EDN, inp(F, 15), 256, 1024, WS_WEDN, 3)
#undef P0_GROUP
    }
}

__device__ __forceinline__ void p1_modulate(Frame& F, const float* x, const float* modl  , int sh_off, int sc_off) {
    bf16* H = (bf16*)(F.ws + WS_H);
    const int gw = F.vcu * NWAVES + F.wave, NGW = F.G * NWAVES;
    for (int m = gw; m < T; m += NGW) {
        const int b = m / SEQ; const float* mb = modl + (size_t)b * 6144;
        const GAS f32x4* xr = (const GAS f32x4*)(x + (size_t)m * D) + F.lane;
        GAS u32x2* o8 = (GAS u32x2*)(H + (size_t)m * D) + F.lane;
#pragma unroll
        for (int j = 0; j < 4; ++j) { const f32x4 v = xr[64 * j]; const f32x4 sc = *(const f32x4*)(mb + sc_off + 4 * F.lane + 256 * j), sh = *(const f32x4*)(mb + sh_off + 4 * F.lane + 256 * j);
            const f32x4 h = v * (sc + 1.0f) + sh; u32x2 w; w.x = pk2(h[0], h[1]); w.y = pk2(h[2], h[3]); o8[64 * j] = w; }
    }
}

template <int W>
__device__ __forceinline__ void pool_item(const bf16* U, bf16* Z, int b, int t0, int g, int lane) {
    const size_t base = (size_t)b * SEQ * D + 256 * g + 4 * lane;
    float s[4] = {0.f, 0.f, 0.f, 0.f};
#pragma unroll
    for (int j = 1; j <= W; ++j) { const int t = t0 - j; if (t >= 0) { const u32x2 v = *(const GAS u32x2*)(U + base + (size_t)t * D);
            s[0] += bf2f(v.x & 0xffffu); s[1] += bf2f(v.x >> 16); s[2] += bf2f(v.y & 0xffffu); s[3] += bf2f(v.y >> 16); } }
#pragma unroll 8
    for (int i = 0; i < 32; ++i) { const int t = t0 + i;
        const u32x2 v = *(const GAS u32x2*)(U + base + (size_t)t * D);
        const float c0 = bf2f(v.x & 0xffffu), c1 = bf2f(v.x >> 16), c2 = bf2f(v.y & 0xffffu), c3 = bf2f(v.y >> 16);
        s[0] += c0; s[1] += c1; s[2] += c2; s[3] += c3;
        if (t - W >= 0) { const u32x2 o = *(const GAS u32x2*)(U + base + (size_t)(t - W) * D);
            s[0] -= bf2f(o.x & 0xffffu); s[1] -= bf2f(o.x >> 16); s[2] -= bf2f(o.y & 0xffffu); s[3] -= bf2f(o.y >> 16); }
        const float inv = 1.0f / (float)((t + 1) < W ? (t + 1) : W);
        u32x2 w; w.x = pk2(s[0] * inv - c0, s[1] * inv - c1); w.y = pk2(s[2] * inv - c2, s[3] * inv - c3);
        *(GAS u32x2*)(Z + base + (size_t)t * D) = w; }
}

__device__ __forceinline__ void moe_build_table(Frame& F, int layer) {
    LAS int* ts = (LAS int*)(F.lc + LC_TS); LAS int* cn = (LAS int*)(F.lc + LC_CNT);
    __syncthreads();
    if (F.wave == 0) {
        const int c = (int)__hip_atomic_load(F.ctl + CW_CNT + layer * 64 + F.lane, RLX_AGENT);
        int t = (c + 255) >> 8;
#pragma unroll
        for (int o = 1; o < 64; o <<= 1) { const int v = __shfl_up(t, o); if (F.lane >= o) t += v; }
        cn[F.lane] = c; ts[F.lane + 1] = t;
        if (F.lane == 0) ts[0] = 0;
        if (F.lane == 63) ts[65] = t + 64;
    }
    __syncthreads();
}

#ifdef PROBE_TYPE
#define LSTAMP(ty) do { if (blockIdx.x == 0 && F.tid == 0) { const unsigned long long now_ = __builtin_amdgcn_s_memrealtime(); LAS unsigned long long* st_ = (LAS unsigned long long*)(F.lc + 3072); \
        st_[1 + (ty)] += now_ - st_[20]; st_[20] = now_; } } while (0)
#define LSTAMP0() do { if (blockIdx.x == 0 && F.tid == 0) { ((LAS unsigned long long*)(F.lc + 3072))[20] = __builtin_amdgcn_s_memrealtime(); } } while (0)
#else
#define LSTAMP(ty) do { } while (0)
#define LSTAMP0() do { } while (0)
#endif
constexpr int APITCH = 1032;
#define LDS_ONLY_BARRIER() do { asm volatile("s_waitcnt lgkmcnt(0)" ::: "memory"); __builtin_amdgcn_s_barrier(); asm volatile("" ::: "memory"); } while (0)
template <bool X16>
__device__ __forceinline__ void ln1_router_phase(Frame& F, int layer, const float* xin) {
    bf16* X = (bf16*)(F.ws + WS_X);
    bf16* H = (bf16*)(F.ws + WS_H); const bf16* Y = (const bf16*)(F.ws + WS_Y);
    const float* modl = (const float*)(F.ws + WS_MOD) + (size_t)layer * 8 * 6144;
    const float* lg = inp(F, 10) + layer * D; const float* lb = inp(F, 11) + layer * D;
    const float* rb = inp(F, 13) + layer * NE;
    const bf16* WH = (const bf16*)(F.ws + WS_WRHI) + (size_t)layer * 65536; const bf16* WLo = (const bf16*)(F.ws + WS_WRLO) + (size_t)layer * 65536;
    int* tokl = (int*)(F.ws + WS_TOKL); float* wl = (float*)(F.ws + WS_WL); int* tslot = (int*)(F.ws + WS_TSLOT);
    unsigned* gcnt = F.ctl + CW_CNT + layer * 64;
    LAS bf16* Ahi = (LAS bf16*)F.lds; LAS bf16* Alo = Ahi + 32 * APITCH;
    LAS float* PART = (LAS float*)F.lds;
    LAS float* PV = (LAS float*)(F.lds + LDS_TB_OFF);
    LAS int* lcnt = (LAS int*)(F.lc + LC_LCNT); LAS int* gb = (LAS int*)(F.lc + LC_GB);
    const int lane = F.lane, wave = F.wave;
    const int nblk = (T / 32) / F.G;
#define LN1_BLK(bi_) ((F.G == 256) ? ((F.vcu >> 5) * 64 + (F.vcu & 31) * 2 + (bi_)) : (F.vcu + (bi_) * F.G))
    constexpr int NX = X16 ? 2 : 4;
    u32x4 xr[4][NX], yv[4][2];
#define LN1_LOAD(bi_) do { const int t0_ = LN1_BLK(bi_) * 32 + wave * 4; \
        _Pragma("unroll") for (int q = 0; q < 4; ++q) _Pragma("unroll") for (int j = 0; j < 2; ++j) { const size_t o_ = (size_t)(t0_ + q) * D + 8 * lane + 512 * j; \
            if constexpr (X16) xr[q][j] = __builtin_nontemporal_load((const GAS u32x4*)((const bf16*)xin + o_)); \
            else { xr[q][2 * j] = *(const GAS u32x4*)(xin + o_); xr[q][2 * j + 1] = *(const GAS u32x4*)(xin + o_ + 4); } \
            yv[q][j] = __builtin_nontemporal_load((const GAS u32x4*)(Y + o_)); } } while (0)
    LN1_LOAD(0);
    const float rbe = rb[lane];
    { const int b = (LN1_BLK(0) * 32) / SEQ; const float* mb = modl + (size_t)b * 6144;
      for (int i = F.tid; i < 1024; i += NWAVES * 64) { const int v = i >> 8, c4 = (i & 255) * 4;
          const float* src = (v == 0) ? lg : (v == 1) ? lb : (v == 2) ? (mb + 4096) : (mb + 3072);
          f32x4 t = *(const GAS f32x4*)(src + c4); if (v == 2) t = t + 1.0f; *(LAS f32x4*)(PV + v * 1024 + c4) = t; } }
    __syncthreads();
    for (int bi = 0; bi < nblk; ++bi) {
        const int blk = LN1_BLK(bi);
        const int tok0 = blk * 32;
        LSTAMP0();
        bf16x8 bh[8][2], bl[8][2];
        {
            const int b = tok0 / SEQ; const float* mb = modl + (size_t)b * 6144;
            f32x4 xv[4][4];
            f32x4 pg1[4];
#pragma unroll
            for (int jj = 0; jj < 4; ++jj) pg1[jj] = *(const GAS f32x4*)(mb + 2048 + 8 * lane + 512 * (jj >> 1) + 4 * (jj & 1)) + 1.0f;
            float sm[4];
#pragma unroll
            for (int q = 0; q < 4; ++q) { float s = 0.f;
#pragma unroll
                for (int jj = 0; jj < 4; ++jj) { const unsigned w0 = (jj & 1) ? yv[q][jj >> 1].z : yv[q][jj >> 1].x, w1 = (jj & 1) ? yv[q][jj >> 1].w : yv[q][jj >> 1].y;
                    f32x4 y4; y4[0] = h2f(w0 & 0xffffu); y4[1] = h2f(w0 >> 16); y4[2] = h2f(w1 & 0xffffu); y4[3] = h2f(w1 >> 16);
                    f32x4 x4;
                    if constexpr (X16) { const unsigned v0 = (jj & 1) ? xr[q][jj >> 1].z : xr[q][jj >> 1].x, v1 = (jj & 1) ? xr[q][jj >> 1].w : xr[q][jj >> 1].y;
                        x4 = (f32x4){h2f(v0 & 0xffffu), h2f(v0 >> 16), h2f(v1 & 0xffffu), h2f(v1 >> 16)}; }
                    else { const u32x4 v = xr[q][jj]; x4 = (f32x4){__uint_as_float(v.x), __uint_as_float(v.y), __uint_as_float(v.z), __uint_as_float(v.w)}; }
                    xv[q][jj] = x4 * ALPHA + pg1[jj] * y4; s += (xv[q][jj][0] + xv[q][jj][1]) + (xv[q][jj][2] + xv[q][jj][3]); }
                sm[q] = s; }
#pragma unroll
            for (int o = 1; o < 64; o <<= 1) {
#pragma unroll
                for (int q = 0; q < 4; ++q) sm[q] += __shfl_xor(sm[q], o); }
            float s2[4];
#pragma unroll
            for (int q = 0; q < 4; ++q) { const float mean = sm[q] * (1.f / D); float t = 0.f;
#pragma unroll
                for (int jj = 0; jj < 4; ++jj) { xv[q][jj] = xv[q][jj] - mean; t += (xv[q][jj][0] * xv[q][jj][0] + xv[q][jj][1] * xv[q][jj][1]) + (xv[q][jj][2] * xv[q][jj][2] + xv[q][jj][3] * xv[q][jj][3]); }
                s2[q] = t; }
#pragma unroll
            for (int o = 1; o < 64; o <<= 1) {
#pragma unroll
                for (int q = 0; q < 4; ++q) s2[q] += __shfl_xor(s2[q], o); }
            LAS float* pvb = PV + 8 * lane; asm volatile("" : "+v"(pvb));
#pragma unroll
            for (int jj = 0; jj < 4; ++jj) { const int col = 8 * lane + 512 * (jj >> 1) + 4 * (jj & 1); const int co = 512 * (jj >> 1) + 4 * (jj & 1);
                const f32x4 gg = *(const LAS f32x4*)(pvb + co), bb = *(const LAS f32x4*)(pvb + 1024 + co), sc2 = *(const LAS f32x4*)(pvb + 2048 + co), sh2 = *(const LAS f32x4*)(pvb + 3072 + co);
#pragma unroll
                for (int q = 0; q < 4; ++q) { const int rl = wave * 4 + q, tok = tok0 + rl; const float rstd = 1.0f / sqrtf(s2[q] * (1.f / D) + LN_EPS);
                    const f32x4 xn = xv[q][jj] * rstd * gg + bb; { u32x2 xw; xw.x = pkh2(xn[0], xn[1]); xw.y = pkh2(xn[2], xn[3]); *(GAS u32x2*)(X + (size_t)tok * D + col) = xw; }
                    const f32x4 hf = xn * sc2 + sh2;
                    unsigned hh[4], ll[4];
#pragma unroll
                    for (int e = 0; e < 4; ++e) { hh[e] = f2bf(hf[e]); ll[e] = f2bf(hf[e] - bf2f(hh[e])); }
                    u32x2 wh, wlo; wh.x = hh[0] | (hh[1] << 16); wh.y = hh[2] | (hh[3] << 16); wlo.x = ll[0] | (ll[1] << 16); wlo.y = ll[2] | (ll[3] << 16);
                    *(GAS u32x2*)(H + (size_t)tok * D + col) = wh;
                    *(LAS u32x2*)(Ahi + rl * APITCH + col) = wh; *(LAS u32x2*)(Alo + rl * APITCH + col) = wlo; } }
        }
        __builtin_amdgcn_sched_barrier(0);
        {
            const int r32 = lane & 31, hi = lane >> 5;
#pragma unroll
            for (int nb = 0; nb < 2; ++nb) {
                const GAS bf16* ph = (const GAS bf16*)WH + (size_t)(r32 + 32 * nb) * 1024 + wave * 128 + hi * 8; const GAS bf16* pl = (const GAS bf16*)WLo + (size_t)(r32 + 32 * nb) * 1024 + wave * 128 + hi * 8;
                asm volatile("" : "+v"(ph), "+v"(pl));
#pragma unroll
                for (int ks = 0; ks < 8; ++ks) { bh[ks][nb] = *(const GAS bf16x8*)(ph + ks * 16); bl[ks][nb] = *(const GAS bf16x8*)(pl + ks * 16); } }
        }
        __syncthreads();
        LSTAMP(13);
        f32x16 acc[2]; acc[0] = (f32x16){}; acc[1] = (f32x16){};
        {
            const int r32 = lane & 31, hi = lane >> 5;
#pragma unroll
            for (int ks = 0; ks < 8; ++ks) {
                const int k = wave * 128 + ks * 16 + hi * 8;
                const bf16x8 ah = *(const LAS bf16x8*)(Ahi + r32 * APITCH + k), al = *(const LAS bf16x8*)(Alo + r32 * APITCH + k);
#pragma unroll
                for (int nb = 0; nb < 2; ++nb) {
                    acc[nb] = MFMA32(ah, bh[ks][nb], acc[nb]);
                    acc[nb] = MFMA32(al, bh[ks][nb], acc[nb]);
                    acc[nb] = MFMA32(ah, bl[ks][nb], acc[nb]);
                }
            }
        }
        LDS_ONLY_BARRIER();
        {
            const int r32 = lane & 31, hi = lane >> 5;
#pragma unroll
            for (int nb = 0; nb < 2; ++nb)
#pragma unroll
                for (int r = 0; r < 16; ++r) { const int trow = (r & 3) + 8 * (r >> 2) + 4 * hi; PART[(wave * 32 + trow) * 64 + 32 * nb + r32] = acc[nb][r]; }
        }
        if (F.tid < 64) lcnt[F.tid] = 0;
        LDS_ONLY_BARRIER();
        LSTAMP(14);
        if (bi + 1 < nblk) LN1_LOAD(bi + 1);
        else {
#pragma unroll
            for (int q = 0; q < 4; ++q) {
#pragma unroll
                for (int j = 0; j < NX; ++j) xr[q][j] = (u32x4){0u, 0u, 0u, 0u};
#pragma unroll
                for (int j = 0; j < 2; ++j) yv[q][j] = (u32x4){0u, 0u, 0u, 0u}; } }
        int chosen_m = 0; int posl[4]; float wv[4]; int rk[4];
        unsigned key[4]; float sgv[4];
#pragma unroll
        for (int q = 0; q < 4; ++q) {
            const int rl = wave * 4 + q;
            float logit = 0.f;
#pragma unroll
            for (int w = 0; w < 8; ++w) logit += PART[(w * 32 + rl) * 64 + lane];
            const float sg = 1.0f / (1.0f + __expf(-logit));
            const float sel = sg + rbe;
            float m1 = sel; m1 = fmaxf(m1, __shfl_xor(m1, 1)); m1 = fmaxf(m1, __shfl_xor(m1, 2)); m1 = fmaxf(m1, __shfl_xor(m1, 4));
            const unsigned long long bal = __ballot(sel == m1);
            const unsigned long long gm = bal & (0xFFull << (8 * (lane >> 3)));
            const int first = (int)__builtin_ctzll(gm);
            float m2 = (lane == first) ? -INFINITY : sel; m2 = fmaxf(m2, __shfl_xor(m2, 1)); m2 = fmaxf(m2, __shfl_xor(m2, 2)); m2 = fmaxf(m2, __shfl_xor(m2, 4));
            const float gs = m1 + m2;
            int rg = 0;
#pragma unroll
            for (int g2 = 0; g2 < 8; ++g2) { const float v = __builtin_bit_cast(float, __builtin_amdgcn_readlane(__builtin_bit_cast(int, gs), 8 * g2)); rg += ((v > gs) || (v == gs && g2 < (lane >> 3))) ? 1 : 0; }
            const bool gsel = rg < 4;
            const float msel = gsel ? sel : -INFINITY;
            const unsigned mb_ = __float_as_uint(msel); key[q] = (mb_ & 0x80000000u) ? ~mb_ : (mb_ | 0x80000000u); sgv[q] = sg;
        }
        unsigned tau[4] = {0u, 0u, 0u, 0u};
#pragma unroll 1
        for (int bit = 31; bit >= 0; --bit) {
#pragma unroll
            for (int q = 0; q < 4; ++q) { const unsigned cand = tau[q] | (1u << bit); const int cnt = (int)__popcll(__ballot(key[q] >= cand)); tau[q] = (cnt >= TOPK) ? cand : tau[q]; } }
#pragma unroll
        for (int q = 0; q < 4; ++q) {
            const unsigned long long gtm = __ballot(key[q] > tau[q]), eqm = __ballot(key[q] == tau[q]);
            const int need = TOPK - (int)__popcll(gtm);
            const unsigned long long below = (1ull << lane) - 1ull;
            const bool ch = (key[q] > tau[q]) || ((key[q] == tau[q]) && ((int)__popcll(eqm & below) < need));
            const unsigned long long chm = __ballot(ch);
            const int rank = (int)__popcll(chm & below);
            const float wsum = wave_sum(ch ? sgv[q] : 0.f);
            wv[q] = sgv[q] / wsum * ROUTED_SCALE; rk[q] = rank; posl[q] = 0;
            if (ch) { chosen_m |= (1 << q); posl[q] = __hip_atomic_fetch_add(lcnt + lane, 1, __ATOMIC_RELAXED, __HIP_MEMORY_SCOPE_WORKGROUP); }
        }
        LDS_ONLY_BARRIER();
        LSTAMP(15);
        if (wave == 0) { const int n = lcnt[lane]; int base = 0; if (n > 0) base = (int)__hip_atomic_fetch_add(gcnt + lane, (unsigned)n, RLX_AGENT); gb[lane] = base; }
        LDS_ONLY_BARRIER();
        {
            const int base = gb[lane];
#pragma unroll
            for (int q = 0; q < 4; ++q) if (chosen_m & (1 << q)) { const int tok = tok0 + wave * 4 + q; const int pos = base + posl[q];
                tokl[(size_t)lane * CAP + pos] = tok; wl[(size_t)tok * 8 + rk[q]] = wv[q]; tslot[(size_t)tok * 8 + rk[q]] = lane * CAP + pos; }
        }
        LDS_ONLY_BARRIER();
        LSTAMP(16);
    }
#undef LN1_LOAD
#undef LN1_BLK
}

__device__ __forceinline__ void combine_ln2_phase(Frame& F, int layer) {
    bf16* X = (bf16*)(F.ws + WS_X); bf16* H = (bf16*)(F.ws + WS_H); const unsigned char* YS = (const unsigned char*)(F.ws + WS_YS);
    const float* modl = (const float*)(F.ws + WS_MOD) + (size_t)layer * 8 * 6144;
    const float* modn = (const float*)(F.ws + WS_MOD) + (size_t)(layer + 1) * 8 * 6144;
    const float* lg = inp(F, 18) + layer * D; const float* lb = inp(F, 19) + layer * D;
    const int* tslot = (const int*)(F.ws + WS_TSLOT);
    const LAS int* ts = (const LAS int*)(F.lc + LC_TS);
    const bool lastl = (layer == DEPTH - 1);
    float* xout = (float*)inp(F, 20);
    const int lane = F.lane, wave = F.wave;
    LAS float* PV = (LAS float*)F.lds;
    const int shbase = ts[64] * 256;
    for (int blk = F.vcu; blk < T / 64; blk += F.G) {
        const int tokb = blk * 64, b = tokb / SEQ;
        __syncthreads();
        for (int i = F.tid; i < 1024; i += 512) { PV[i] = modl[(size_t)b * 6144 + 5120 + i] + 1.0f; PV[1024 + i] = lg[i]; PV[2048 + i] = lb[i];
            if (!lastl) { PV[3072 + i] = modn[(size_t)b * 6144 + 1024 + i] + 1.0f; PV[4096 + i] = modn[(size_t)b * 6144 + i]; } }
        __syncthreads();
        const int tw = tokb + wave * 8;
        int sv; { const int v = tslot[(size_t)tw * 8 + lane]; sv = ts[v >> 14] * 256 + (v & (CAP - 1)); }
        const float wvv = ((const float*)(F.ws + WS_WL))[(size_t)tw * 8 + lane] * (1.0f / 32.0f);
        pg8::u32x2_t ys[18]; u32x4 xs[2];
#define CB_LOAD(k) do { const int tok_ = tw + (k); _Pragma("unroll") for (int kk_ = 0; kk_ < 9; ++kk_) { const int slot_ = (kk_ < 8) ? __builtin_amdgcn_readlane(sv, 8 * (k) + kk_) : (shbase + tok_); \
            const unsigned char* yr_ = YS + (size_t)slot_ * D + 8 * lane; ys[2 * kk_] = __builtin_nontemporal_load((const GAS pg8::u32x2_t*)(yr_)); ys[2 * kk_ + 1] = __builtin_nontemporal_load((const GAS pg8::u32x2_t*)(yr_ + 512)); } \
            _Pragma("unroll") for (int j_ = 0; j_ < 2; ++j_) xs[j_] = __builtin_nontemporal_load((const GAS u32x4*)(X + (size_t)tok_ * D + 8 * lane + 512 * j_)); } while (0)
        CB_LOAD(0);
#pragma unroll 1
        for (int k = 0; k < 8; ++k) {
            const int tok_ = tw + k; f32x4 y_[4];
#pragma unroll
            for (int jj_ = 0; jj_ < 4; ++jj_) y_[jj_] = (f32x4){0.f, 0.f, 0.f, 0.f};
#pragma unroll
            for (int kk_ = 0; kk_ < 9; ++kk_) { const float wk_ = (kk_ < 8) ? __builtin_bit_cast(float, __builtin_amdgcn_readlane(__builtin_bit_cast(int, wvv), 8 * k + kk_)) : (1.0f / 32.0f);
#pragma unroll
                for (int j_ = 0; j_ < 2; ++j_) { const pg8::u32x2_t w_ = ys[2 * kk_ + j_];
                    const f32x2 a0_ = __builtin_amdgcn_cvt_pk_f32_fp8((int)w_.x, false), a1_ = __builtin_amdgcn_cvt_pk_f32_fp8((int)w_.x, true), b0_ = __builtin_amdgcn_cvt_pk_f32_fp8((int)w_.y, false), b1_ = __builtin_amdgcn_cvt_pk_f32_fp8((int)w_.y, true);
                    y_[2 * j_][0] += wk_ * a0_[0]; y_[2 * j_][1] += wk_ * a0_[1]; y_[2 * j_][2] += wk_ * a1_[0]; y_[2 * j_][3] += wk_ * a1_[1];
                    y_[2 * j_ + 1][0] += wk_ * b0_[0]; y_[2 * j_ + 1][1] += wk_ * b0_[1]; y_[2 * j_ + 1][2] += wk_ * b1_[0]; y_[2 * j_ + 1][3] += wk_ * b1_[1]; } }
            f32x4 v_[4]; float s_ = 0.f;
#pragma unroll
            for (int jj_ = 0; jj_ < 4; ++jj_) { const int col_ = 8 * lane + 512 * (jj_ >> 1) + 4 * (jj_ & 1); const f32x4 g2_ = *(const LAS f32x4*)(PV + col_);
                const unsigned w0_ = (jj_ & 1) ? xs[jj_ >> 1].z : xs[jj_ >> 1].x, w1_ = (jj_ & 1) ? xs[jj_ >> 1].w : xs[jj_ >> 1].y;
                const f32x4 x4_ = (f32x4){h2f(w0_ & 0xffffu), h2f(w0_ >> 16), h2f(w1_ & 0xffffu), h2f(w1_ >> 16)};
                v_[jj_] = x4_ * ALPHA + g2_ * y_[jj_]; s_ += (v_[jj_][0] + v_[jj_][1]) + (v_[jj_][2] + v_[jj_][3]); }
            asm volatile("" : "+v"(v_[0]), "+v"(v_[1]), "+v"(v_[2]), "+v"(v_[3]));
            __builtin_amdgcn_sched_barrier(0);
            { const int kn = (k + 1 < 8) ? k + 1 : k; CB_LOAD(kn); }
            __builtin_amdgcn_sched_barrier(0);
            const float mean_ = wave_sum(s_) * (1.f / D); float q_ = 0.f;
#pragma unroll
            for (int jj_ = 0; jj_ < 4; ++jj_) { v_[jj_] = v_[jj_] - mean_; q_ += (v_[jj_][0] * v_[jj_][0] + v_[jj_][1] * v_[jj_][1]) + (v_[jj_][2] * v_[jj_][2] + v_[jj_][3] * v_[jj_][3]); }
            const float rstd_ = 1.0f / sqrtf(wave_sum(q_) * (1.f / D) + LN_EPS);
#pragma unroll
            for (int jj_ = 0; jj_ < 4; ++jj_) { const int col_ = 8 * lane + 512 * (jj_ >> 1) + 4 * (jj_ & 1);
                const f32x4 gg_ = *(const LAS f32x4*)(PV + 1024 + col_), bb_ = *(const LAS f32x4*)(PV + 2048 + col_);
                const f32x4 xn_ = v_[jj_] * rstd_ * gg_ + bb_;
                if (lastl) *(GAS f32x4*)(xout + (size_t)tok_ * D + col_) = xn_;
                else { u32x2 xw_; xw_.x = pkh2(xn_[0], xn_[1]); xw_.y = pkh2(xn_[2], xn_[3]); *(GAS u32x2*)(X + (size_t)tok_ * D + col_) = xw_; }
                if (!lastl) { const f32x4 sc_ = *(const LAS f32x4*)(PV + 3072 + col_), sh_ = *(const LAS f32x4*)(PV + 4096 + col_); const f32x4 hm_ = xn_ * sc_ + sh_;
                    u32x2 w2_; w2_.x = pk2(hm_[0], hm_[1]); w2_.y = pk2(hm_[2], hm_[3]); *(GAS u32x2*)(H + (size_t)tok_ * D + col_) = w2_; } }
        }
#undef CB_LOAD
    }
}

constexpr int ACCP = 68;
__device__ __forceinline__ int crow(int r, int hi) { return (r & 3) + 8 * (r >> 2) + 4 * hi; }
constexpr int KPITCH = 144;
__device__ __forceinline__ u32x4 f8x8_to_bf16(unsigned a, unsigned b, float inv) {
    typedef __bf16 bfx2 __attribute__((ext_vector_type(2)));
    u32x4 r; r.x = __builtin_bit_cast(unsigned, (bfx2)__builtin_amdgcn_cvt_scalef32_pk_bf16_fp8(a, inv, false)); r.y = __builtin_bit_cast(unsigned, (bfx2)__builtin_amdgcn_cvt_scalef32_pk_bf16_fp8(a, inv, true));
    r.z = __builtin_bit_cast(unsigned, (bfx2)__builtin_amdgcn_cvt_scalef32_pk_bf16_fp8(b, inv, false)); r.w = __builtin_bit_cast(unsigned, (bfx2)__builtin_amdgcn_cvt_scalef32_pk_bf16_fp8(b, inv, true)); return r;
}
template <bool FIRST, int NB>
__device__ __forceinline__ void attn_task(const unsigned char* QKVb  , int g, int h, int dil, int cls, int q0, int QS, int kb0, int L, float slope2d,
                                          LAS unsigned char* stg  , LAS float* wsf  , LAS float* ACC, LAS float* ML, int trow_mul, int trow_add, int lane) {
    asm volatile("" : "+v"(lane));
    const int r32 = lane & 31, hi = lane >> 5, lr = lane >> 2, lc = lane & 3;
    const int qcol = ((g * 3 + 0) * 16 + h) * 64, kcol = ((g * 3 + 1) * 16 + h) * 64, vcol = ((g * 3 + 2) * 16 + h) * 64;
    const size_t rstride = (size_t)dil * NQKV;
    const unsigned char* base = QKVb + (size_t)cls * NQKV + lc * 16;
    const int jlo = (kb0 >= -31) ? 0 : ((-kb0) >> 5);
    const int qpos = q0 + QS * r32;
    const int dmax = qpos < 128 ? qpos : 128;
    const float half = 0.5f * (float)dmax;
#define AT_LOADROWS(dst, l0, ls, col) do { _Pragma("unroll") for (int i_ = 0; i_ < 2; ++i_) { int l_ = (l0) + (ls) * (16 * i_ + lr); l_ = l_ < 0 ? 0 : (l_ > L - 1 ? L - 1 : l_); \
        dst[i_] = *(const GAS u32x4*)(base + (size_t)l_ * rstride + (col)); } } while (0)
#define AT_PUTROWS(src, inv) do { _Pragma("unroll") for (int i_ = 0; i_ < 2; ++i_) { LAS unsigned char* p_ = stg + (16 * i_ + lr) * KPITCH + lc * 32; \
        *(LAS u32x4*)(p_) = f8x8_to_bf16(src[i_].x, src[i_].y, inv); *(LAS u32x4*)(p_ + 16) = f8x8_to_bf16(src[i_].z, src[i_].w, inv); } } while (0)
#define AT_GETFRAG(dst) do { _Pragma("unroll") for (int s_ = 0; s_ < 4; ++s_) dst[s_] = *(const LAS bf16x8*)(stg + r32 * KPITCH + 32 * s_ + 16 * hi); } while (0)
#define AT_LDSWAIT() asm volatile("s_waitcnt lgkmcnt(0)" ::: "memory")
    u32x4 kr[2][2];
    bf16x8 qf[4];
    { u32x4 qr[2]; AT_LOADROWS(qr, q0, QS, qcol);
#pragma unroll
      for (int j = 0; j < NB; ++j) if (j == jlo) AT_LOADROWS(kr[j & 1], kb0 + 32 * j, 1, kcol);
      AT_PUTROWS(qr, 1.0f / 64.0f); AT_LDSWAIT(); AT_GETFRAG(qf); AT_LDSWAIT(); }
    f32x16 S[NB];
    float mx = -INFINITY;
#pragma unroll
    for (int j = 0; j < NB; ++j) {
        if (j >= jlo) {
            asm volatile("" ::: "memory");
            if (j < NB - 1) AT_LOADROWS(kr[(j + 1) & 1], kb0 + 32 * (j + 1), 1, kcol);
            AT_PUTROWS(kr[j & 1], 1.0f / 16.0f);
            const float xd0 = (float)(qpos - kb0 - 32 * j - 4 * hi) - half;
            const bool inner = (q0 - kb0 - 32 * j - 31 >= 0) && (q0 + QS * 31 - kb0 - 32 * j <= 128) && (kb0 + 32 * j >= 0);
            f32x16 a;
            if (inner) {
                const float cb = -slope2d * xd0;
#pragma unroll
                for (int r = 0; r < 16; ++r) a[r] = __builtin_fmaf(slope2d, (float)((r & 3) + 8 * (r >> 2)), cb);
            } else {
#pragma unroll
                for (int r = 0; r < 16; ++r) { const float x = xd0 - (float)((r & 3) + 8 * (r >> 2)); a[r] = (__builtin_fabsf(x) <= half) ? (-slope2d * x) : -INFINITY; }
            }
            bf16x8 kf[4];
            AT_LDSWAIT(); AT_GETFRAG(kf); AT_LDSWAIT();
#pragma unroll
            for (int s = 0; s < 4; ++s) a = MFMA32(kf[s], qf[s], a);
#pragma unroll
            for (int r = 0; r < 16; ++r) mx = fmaxf(mx, a[r]);
            S[j] = a;
        } else {
#pragma unroll
            for (int r = 0; r < 16; ++r) S[j][r] = -INFINITY;
        }
        __builtin_amdgcn_sched_barrier(0);
    }
    u32x4 vr[2][2];
#pragma unroll
    for (int j = 0; j < NB; ++j) if (j == jlo) AT_LOADROWS(vr[j & 1], kb0 + 32 * j, 1, vcol);
    { auto rr = __builtin_amdgcn_permlane32_swap(__float_as_uint(mx), __float_as_uint(mx), false, false);
      const unsigned r0 = rr[0], r1 = rr[1]; mx = fmaxf(__uint_as_float(r0), __uint_as_float(r1)); }
    const float mx_true = mx - slope2d * half;
    float lsum = 0.f;
    u32x4 P[NB][2];
#pragma unroll
    for (int j = 0; j < NB; ++j) {
        float p[16];
#pragma unroll
        for (int r = 0; r < 16; ++r) { p[r] = __builtin_amdgcn_exp2f(S[j][r] - mx); lsum += p[r]; }
#pragma unroll
        for (int ks = 0; ks < 2; ++ks) { P[j][ks].x = cvt_pk_bf16(p[8 * ks + 0], p[8 * ks + 1]); P[j][ks].y = cvt_pk_bf16(p[8 * ks + 2], p[8 * ks + 3]); P[j][ks].z = cvt_pk_bf16(p[8 * ks + 4], p[8 * ks + 5]); P[j][ks].w = cvt_pk_bf16(p[8 * ks + 6], p[8 * ks + 7]); }
        __builtin_amdgcn_sched_barrier(0);
    }
    { auto rr = __builtin_amdgcn_permlane32_swap(__float_as_uint(lsum), __float_as_uint(lsum), false, false);
      const unsigned r0 = rr[0], r1 = rr[1]; lsum = __uint_as_float(r0) + __uint_as_float(r1); }
    f32x16 o[2]; o[0] = (f32x16){}; o[1] = (f32x16){};
    const unsigned vrd = (unsigned)(((lane >> 4) & 1) * 32 + (lane & 3) * 8 + (4 * hi + ((lane & 15) >> 2)) * 64);
#pragma unroll
    for (int j = 0; j < NB; ++j) {
        if (j >= jlo) {
            asm volatile("" ::: "memory");
            if (j < NB - 1) AT_LOADROWS(vr[(j + 1) & 1], kb0 + 32 * (j + 1), 1, vcol);
#pragma unroll
            for (int i = 0; i < 2; ++i) { const int key = 16 * i + lr;
#pragma unroll
                for (int hf = 0; hf < 2; ++hf) { const int c8 = 2 * lc + hf; const u32x4 src = vr[j & 1][i];
                    *(LAS u32x4*)(stg + ((c8 >> 2) * 2 + (key >> 4)) * 1024 + (key & 15) * 64 + (c8 & 3) * 16) = f8x8_to_bf16(hf ? src.z : src.x, hf ? src.w : src.y, 1.0f / 16.0f); } }
            AT_LDSWAIT();
#pragma unroll
            for (int d0 = 0; d0 < 2; ++d0)
#pragma unroll
                for (int ks = 0; ks < 2; ++ks) {
                    LAS unsigned char* vp = stg + (d0 * 2 + ks) * 1024 + vrd;
                    const s16x4 lo = __builtin_bit_cast(s16x4, __builtin_amdgcn_ds_read_tr16_b64_v4i16((LAS s16x4*)(vp)));
                    const s16x4 hh = __builtin_bit_cast(s16x4, __builtin_amdgcn_ds_read_tr16_b64_v4i16((LAS s16x4*)(vp + 512)));
                    const bf16x8 vf = (bf16x8){lo[0], lo[1], lo[2], lo[3], hh[0], hh[1], hh[2], hh[3]};
                    o[d0] = MFMA32(__builtin_bit_cast(bf16x8, P[j][ks]), vf, o[d0]);
                }
            AT_LDSWAIT();
        }
        __builtin_amdgcn_sched_barrier(0);
    }
#undef AT_LOADROWS
#undef AT_PUTROWS
#undef AT_GETFRAG
#undef AT_LDSWAIT
    if (hi == 0) { wsf[r32] = mx_true; wsf[32 + r32] = lsum; }
    asm volatile("s_waitcnt lgkmcnt(0)" ::: "memory");
    f32x4 mt4[4], lt4[4];
#pragma unroll
    for (int k = 0; k < 4; ++k) { mt4[k] = *(const LAS f32x4*)(wsf + 8 * k + 4 * hi); lt4[k] = *(const LAS f32x4*)(wsf + 32 + 8 * k + 4 * hi); }
    if (FIRST) {
#pragma unroll
        for (int r = 0; r < 16; ++r) { const int q = crow(r, hi); const int trow = q * trow_mul + trow_add;
            ACC[trow * ACCP + r32] = o[0][r]; ACC[trow * ACCP + 32 + r32] = o[1][r];
            if (r32 == 0) { ML[trow * 2] = mt4[r >> 2][r & 3]; ML[trow * 2 + 1] = lt4[r >> 2][r & 3]; } }
    } else {
        f32x2 ml[16]; float a0[16], a1[16];
#pragma unroll
        for (int r = 0; r < 16; ++r) { const int q = crow(r, hi); const int trow = q * trow_mul + trow_add;
            ml[r] = *(const LAS f32x2*)(ML + trow * 2); a0[r] = ACC[trow * ACCP + r32]; a1[r] = ACC[trow * ACCP + 32 + r32]; }
        asm volatile("s_waitcnt lgkmcnt(0)" ::: "memory");
#pragma unroll
        for (int r = 0; r < 16; ++r) { const int q = crow(r, hi); const int trow = q * trow_mul + trow_add;
            const float mt = mt4[r >> 2][r & 3], lt = lt4[r >> 2][r & 3], mo = ml[r][0], lo_ = ml[r][1];
            const float mn = fmaxf(mo, mt); const float fa = __builtin_amdgcn_exp2f(mo - mn), fb = __builtin_amdgcn_exp2f(mt - mn);
            ACC[trow * ACCP + r32] = a0[r] * fa + o[0][r] * fb; ACC[trow * ACCP + 32 + r32] = a1[r] * fa + o[1][r] * fb;
            if (r32 == 0) { ML[trow * 2] = mn; ML[trow * 2 + 1] = lo_ * fa + lt * fb; } }
    }
    asm volatile("s_waitcnt lgkmcnt(0)" ::: "memory");
}

__device__ __forceinline__ void attn_phase(Frame& F, bf16* MIX) {
    const unsigned char* QKV = (const unsigned char*)(F.ws + WS_QKV);
    LAS float* ACC = (LAS float*)F.lds;
    LAS float* ML = (LAS float*)(F.lds + 69632);
    LAS unsigned char* vst = F.lds + 73728 + F.wave * 4608;
    LAS float* wsf = (LAS float*)(F.lds + 73728 + 8 * 4608 + F.wave * 256);
    const int lane = F.lane, w = F.wave;
    for (int i = 0;; ++i) {
        if (i >= (BATCH * 16 * 8) / F.G) break;
        const int L0 = (F.G == 256) ? ((F.vcu >> 5) * 128 + i * 32 + (F.vcu & 31)) : (i * F.G + F.vcu);
        const int bh = L0 >> 3, ti = L0 & 7; int w4 = ti >> 1; const int c = ti & 1; if (i & 1) w4 = 3 - w4;
        const int b = bh >> 4, h = bh & 15, win0 = w4 * 512;
        const unsigned char* Qb = QKV + (size_t)b * SEQ * NQKV;
        const float sl0 = exp2f(-8.0f * (float)(0 * 16 + h + 1) / 48.0f) * LOG2E, sl1 = exp2f(-8.0f * (float)(1 * 16 + h + 1) / 48.0f) * LOG2E * 4.0f, sl2 = exp2f(-8.0f * (float)(2 * 16 + h + 1) / 48.0f) * LOG2E * 16.0f;
        LSTAMP0();
        attn_task<true, 6>(Qb, 0, h, 1, 0, win0 + 64 * w + c, 2, win0 + 64 * w - 128, SEQ, sl0, vst, wsf, ACC, ML, 1, 32 * w, lane);
        __syncthreads();
        LSTAMP(24);
        if (ATTN_GMASK & 2) { const int cls = c + 2 * (w & 1), lb = w >> 1, lq0 = 128 * w4 + 32 * lb; attn_task<false, 5>(Qb, 1, h, 4, cls, lq0, 1, lq0 - 128, SEQ / 4, sl1, vst, wsf, ACC, ML, 2, 64 * lb + (w & 1), lane); }
        __syncthreads();
        LSTAMP(25);
        if (ATTN_GMASK & 4) { const int cls = c + 2 * w, lq0 = 32 * w4; attn_task<false, 5>(Qb, 2, h, 16, cls, lq0, 1, lq0 - 128, SEQ / 16, sl2, vst, wsf, ACC, ML, 8, w, lane); }
        __syncthreads();
        LSTAMP(26);
        {
#pragma unroll
          for (int it = 0; it < 4; ++it) { const int trow = 32 * w + 8 * it + (lane >> 3), sg = lane & 7; const float inv = 1.0f / ML[trow * 2 + 1];
              const LAS f32x4* ap = (const LAS f32x4*)(ACC + trow * ACCP + sg * 8);
              bf16* op = MIX + (size_t)(b * SEQ + win0 + 2 * trow + c) * D + h * 64 + sg * 8;
              const f32x4 a = ap[0] * inv, bq = ap[1] * inv; u32x4 wv; wv.x = pk2(a[0], a[1]); wv.y = pk2(a[2], a[3]); wv.z = pk2(bq[0], bq[1]); wv.w = pk2(bq[2], bq[3]);
              *(GAS u32x4*)op = wv; } }
        __syncthreads();
    }
}

__device__ __forceinline__ void attn_phase_naive(Frame& F, bf16* MIX, const int gmask) {
    const bf16* QKV = (const bf16*)(F.ws + WS_YS);
    const int lane = F.lane;
    const int gw = F.vcu * NWAVES + F.wave, NGW = F.G * NWAVES;
    for (int item = gw; item < T * 16; item += NGW) {
        const int tok = item >> 4, h = item & 15, b = tok / SEQ, t = tok % SEQ;
        const bf16* Qb = QKV + (size_t)b * SEQ * NQKV;
        float sc[3][3]; int kt[3][3];
        float mx = -INFINITY;
#pragma unroll
        for (int g = 0; g < 3; ++g) {
            const int dil = (g == 0) ? 1 : (g == 1 ? 4 : 16);
            const float slope = exp2f(-8.0f * (float)(g * 16 + h + 1) / 48.0f);
            const bf16* qp = Qb + (size_t)t * NQKV + ((g * 3 + 0) * 16 + h) * 64;
#pragma unroll
            for (int c = 0; c < 3; ++c) {
                const int j = lane + 64 * c; const int tk = t - j * dil;
                float s = -INFINITY;
                if (j <= 128 && tk >= 0 && ((gmask >> g) & 1)) {
                    const bf16* kp = Qb + (size_t)tk * NQKV + ((g * 3 + 1) * 16 + h) * 64;
                    float d = 0.f;
                    for (int e = 0; e < 64; ++e) d += bf2f(qp[e]) * bf2f(kp[e]);
                    s = d - slope * LOG2E * (float)(j * dil);
                }
                sc[g][c] = s; kt[g][c] = tk; mx = fmaxf(mx, s);
            }
        }
#pragma unroll
        for (int o = 1; o < 64; o <<= 1) mx = fmaxf(mx, __shfl_xor(mx, o));
        float den = 0.f; float acc[64];
#pragma unroll
        for (int e = 0; e < 64; ++e) acc[e] = 0.f;
#pragma unroll
        for (int g = 0; g < 3; ++g)
#pragma unroll
            for (int c = 0; c < 3; ++c) {
                const float p = (sc[g][c] == -INFINITY) ? 0.f : exp2f(sc[g][c] - mx);
                den += p;
                if (p != 0.f) { const bf16* vp = Qb + (size_t)kt[g][c] * NQKV + ((g * 3 + 2) * 16 + h) * 64;
#pragma unroll
                    for (int e = 0; e < 64; ++e) acc[e] += p * bf2f(vp[e]); }
            }
        den = wave_sum(den);
        float mine = 0.f;
#pragma unroll
        for (int e = 0; e < 64; ++e) { const float v = wave_sum(acc[e]); if (lane == e) mine = v; }
        MIX[(size_t)tok * D + h * 64 + lane] = (bf16)f2bf(mine / den);
    }
}

struct Args { const float* in[20]; float* out; unsigned char* ws; int ph_lo, ph_hi; };
constexpr int NPHASE = 2 + DEPTH * 8;

__global__ void __launch_bounds__(NWAVES * 64, 2) mk_fwd(Args args) {
    extern __shared__ __attribute__((aligned(16))) unsigned char lds_raw[];
    Frame F;
    F.lds = (LAS unsigned char*)lds_raw; F.lc = F.lds + LDSCTL_OFF;
    F.tid = threadIdx.x; F.lane = F.tid & 63; F.wave = __builtin_amdgcn_readfirstlane(F.tid >> 6);
    F.G = gridDim.x; { const int bx = blockIdx.x; F.vcu = (F.G % 8 == 0) ? (bx % 8) * (F.G / 8) + bx / 8 : bx; }
    F.ws = args.ws; F.ctl = (unsigned*)(args.ws + WS_CTL);
    for (int u = F.tid; u < (LDS_BYTES - LDSCTL_OFF) / 4; u += NWAVES * 64) ((LAS unsigned*)F.lc)[u] = 0u;
    __syncthreads();
    if (F.tid == 0) {
#pragma unroll
        for (int i = 0; i < 20; ++i) *(LAS unsigned long long*)(F.lc + LC_PTR + 8 * i) = (unsigned long long)args.in[i];
        *(LAS unsigned long long*)(F.lc + LC_PTR + 8 * 20) = (unsigned long long)args.out;
    }
    __syncthreads();
#if MK_PER_PHASE
#define GRID_BAR() do { } while (0)
    XcdBarrier bar; bar.bar = nullptr; bar.x = 0; bar.st = nullptr;
#else
    XcdBarrier bar = xcd_barrier_post(F.ctl + CW_BAR, (volatile LAS unsigned*)(F.lc + LC_MISC) + 8);
#define GRID_BAR() xcd_barrier(bar)
#endif
    const int lo = args.ph_lo, hi = args.ph_hi;
#ifdef PROBE_TYPE
#define LC_STAMP 3072
#define STAMP(ty) do { if (blockIdx.x == 0 && F.tid == 0) { const unsigned long long now_ = __builtin_amdgcn_s_memrealtime(); LAS unsigned long long* st_ = (LAS unsigned long long*)(F.lc + LC_STAMP); \
        st_[1 + (ty)] += now_ - st_[0]; st_[0] = now_; } } while (0)
    if (blockIdx.x == 0 && F.tid == 0) { ((LAS unsigned long long*)(F.lc + LC_STAMP))[0] = __builtin_amdgcn_s_memrealtime(); }
#else
#define STAMP(ty) do { } while (0)
#endif
#define IN(k) (lo <= (k) && (k) < hi)
#define SEAM(k) do { if (IN(k) && IN((k) + 1)) GRID_BAR(); } while (0)
    const float* mod = (const float*)(F.ws + WS_MOD);

    if (PHON(0) && IN(0)) { p0_prologue(F); } SEAM(0); STAMP(0);
    bool xlocal = false; int cid = (int)blockIdx.x;
#if !MK_PER_PHASE
    { volatile LAS unsigned* st = (volatile LAS unsigned*)(F.lc + LC_MISC) + 8;
      if (F.tid == 0) { unsigned ok = (F.G == 256) ? 1u : 0u;
#pragma unroll
          for (unsigned jx = 0; jx < 16; ++jx) { const unsigned cj = xb_ld(&bar.bar[XB_XCNT(jx)]); ok &= (jx < 8u) ? (cj == 32u ? 1u : 0u) : (cj == 0u ? 1u : 0u); }
          st[3] = ok; }
      __syncthreads();
      xlocal = (st[3] != 0u) && (MK_XLOCAL != 0);
      if (xlocal) cid = (int)(st[2] * 8u + bar.x); }
#endif
    cid = __builtin_amdgcn_readfirstlane(cid);
    F.vcu = (F.G % 8 == 0) ? (cid % 8) * (F.G / 8) + cid / 8 : cid;
#define LSEAM(k) do { if (IN(k) && IN((k) + 1)) { if (xlocal) xcd_local_barrier(bar, F.wave == 0); else GRID_BAR(); } } while (0)
    if (PHON(1) && IN(1)) { p1_modulate(F, inp(F, 0), mod, 0, 1024); } SEAM(1); STAMP(1);

    for (int layer = 0; layer < DEPTH; ++layer) {
        const int pb = 2 + layer * 8; const int j = layer >> 1;
        if ((layer & 1) == 0) {
            if (PHON(2) && IN(pb + 0)) { refresh(F); unsigned char* ws = opq(F.ws); (void)ws;
                PlainSched S{T / 256, 4, 256, F.G, cid, (const char*)(ws + WS_WPIN) + (size_t)j * 2 * MiB, 2048};
                pg8::EpiStore E{(bf16*)(ws + WS_U), D, nullptr, 0, 0, 0, F.lds + LDS_TB_OFF + F.wave * 2048};
                pg8::gemm_phase<pg8::EpiStore, PlainSched>(F.tid, F.lds, (const char*)(ws + WS_H), 2048, 2048, 1024, S, E);
            } LSEAM(pb + 0); STAMP(2);
            if (PHON(4) && IN(pb + 2)) { refresh(F); unsigned char* ws = opq(F.ws); (void)ws;
                GrpSched S{F.G, cid, (const char*)(ws + WS_WPGRP) + (size_t)j * 512 * 1024};
                { const bf16* U = (const bf16*)(ws + WS_U); bf16* Z = (bf16*)(ws + WS_Z); pg8::Unit pu;
                  for (int i = 0; S.next(i, pu); ++i) {
                      const int b = pu.pm >> 3, t0 = (pu.pm & 7) * 256 + 32 * F.wave, g = pu.pn;
                      if (g == 0) pool_item<2>(U, Z, b, t0, 0, F.lane); else if (g == 1) pool_item<4>(U, Z, b, t0, 1, F.lane);
                      else if (g == 2) pool_item<8>(U, Z, b, t0, 2, F.lane); else pool_item<16>(U, Z, b, t0, 3, F.lane); }
                  asm volatile("s_waitcnt vmcnt(0)" ::: "memory"); __syncthreads(); }
                pg8::EpiStore E{(bf16*)(ws + WS_Y2), D, inp(F, 6) + j * D, 0, 0, 0, F.lds + LDS_TB_OFF + F.wave * 2048};
                pg8::gemm_phase<pg8::EpiStore, GrpSched>(F.tid, F.lds, (const char*)(ws + WS_Z), 2048, 512, 256, S, E);
            } LSEAM(pb + 2); STAMP(4);
            if (PHON(5) && IN(pb + 3)) { refresh(F); unsigned char* ws = opq(F.ws); (void)ws;
                PlainSched S{T / 256, 4, 256, F.G, cid, (const char*)(ws + WS_WPOUT) + (size_t)j * 2 * MiB, 2048};
                pg8::EpiStore E{(bf16*)(ws + WS_Y), D, nullptr, 0, 0, 1, F.lds + LDS_TB_OFF + F.wave * 2048};
                pg8::gemm_phase<pg8::EpiStore, PlainSched>(F.tid, F.lds, (const char*)(ws + WS_Y2), 2048, 2048, 1024, S, E);
            } LSEAM(pb + 3); STAMP(5);
        } else {
            if (PHON(6) && IN(pb + 0)) { refresh(F); unsigned char* ws = opq(F.ws); (void)ws;
                PlainSched S{T / 256, NQKV / 256, (T / 256) * (NQKV / 256), F.G, cid, (const char*)(ws + WS_WAIN) + (size_t)j * 18 * MiB, 2048};
                pg8::EpiStoreF8 E{(unsigned char*)(ws + WS_QKV), NQKV, F.lds + LDS_TB_OFF + F.wave * 2048, 1};
                pg8::gemm_phase<pg8::EpiStoreF8, PlainSched>(F.tid, F.lds, (const char*)(ws + WS_H), 2048, 2048, 1024, S, E);
            } LSEAM(pb + 0); STAMP(6);
            if (PHON(7) && IN(pb + 1)) { refresh(F); unsigned char* ws = opq(F.ws); (void)ws;
#ifdef NAIVE_ATTN
                attn_phase_naive(F, (bf16*)(F.ws + WS_Y2), 7);
#ifdef ORACLE
                if (layer == ORACLE_LAYER) { attn_phase_naive(F, (bf16*)(F.ws + WS_Z), ATTN_GMASK); attn_phase(F, (bf16*)(F.ws + WS_U)); }
#endif
#else
                attn_phase(F, (bf16*)(F.ws + WS_Y2));
#endif
            } if (IN(pb + 1) && IN(pb + 3)) { if (xlocal) xcd_local_barrier(bar, F.wave == 0); else GRID_BAR(); } STAMP(7);
            if (IN(pb + 2)) { refresh(F); unsigned char* ws = opq(F.ws); (void)ws;
#ifdef ORACLE
                if (layer == ORACLE_LAYER) { if (blockIdx.x == 0 && F.tid == 0) atomicAdd(F.ctl + 20000, 3276u * 16u);
                    const bf16* A = (const bf16*)(ws + WS_U); const bf16* B = (const bf16*)(ws + WS_Z);
                    const int gw = F.vcu * NWAVES + F.wave, NGW = F.G * NWAVES;
                    for (int tok = gw; tok < T; tok += NGW) { int bad = 0;
                        for (int h = 0; h < 16; ++h) { if (ORACLE_SEL) { const float a = bf2f(A[(size_t)tok * D + h * 64 + F.lane]), b = bf2f(B[(size_t)tok * D + h * 64 + F.lane]);
                            const float e2 = wave_sum((a - b) * (a - b)), n2 = wave_sum(b * b); if (!(e2 <= 0.0025f * n2)) bad += ORACLE_W; } }
                        if (bad && F.lane == 0) atomicAdd(F.ctl + 20000, (unsigned)bad); } }
#endif
            }
            if (PHON(8) && IN(pb + 3)) { refresh(F); unsigned char* ws = opq(F.ws); (void)ws;
                PlainSched S{T / 256, 4, 256, F.G, cid, (const char*)(ws + WS_WAOUT) + (size_t)j * 2 * MiB, 2048};
                pg8::EpiStore E{(bf16*)(ws + WS_Y), D, nullptr, 0, 0, 1, F.lds + LDS_TB_OFF + F.wave * 2048};
                pg8::gemm_phase<pg8::EpiStore, PlainSched>(F.tid, F.lds, (const char*)(ws + WS_Y2), 2048, 2048, 1024, S, E);
            } LSEAM(pb + 3); STAMP(8);
        }
        if (PHON(9) && IN(pb + 4)) { refresh(F); unsigned char* ws = opq(F.ws); (void)ws; const float* xin = (layer == 0) ? inp(F, 0) : (const float*)(ws + WS_X); if (layer == 0) ln1_router_phase<false>(F, layer, xin); else ln1_router_phase<true>(F, layer, xin); } SEAM(pb + 4); STAMP(9);
        if (PHON(10) && IN(pb + 5)) { refresh(F); unsigned char* ws = opq(F.ws); (void)ws;
            moe_build_table(F, layer);
            const LAS int* ts = (const LAS int*)(F.lc + LC_TS);
            const int ntile = ts[65];
            MoeSched<true> S{ts, (const LAS int*)(F.lc + LC_CNT), 2, ntile * 2, F.G, cid, F.lane, (const int*)(ws + WS_TOKL), (const float*)(ws + WS_WL),
                       (const char*)(ws + WS_WEGU) + (size_t)layer * 64 * MiB, (size_t)1 * MiB, (const char*)(ws + WS_WSHGU) + (size_t)layer * MiB, 2048};
            pg8::EpiGU E{(bf16*)(ws + WS_ACT)};
            pg8::gemm_phase<pg8::EpiGU, MoeSched<true>>(F.tid, F.lds, (const char*)(ws + WS_H), 2048, 2048, 1024, S, E);
        } LSEAM(pb + 5); STAMP(10);
        if (PHON(11) && IN(pb + 6)) { refresh(F); unsigned char* ws = opq(F.ws); (void)ws;
            moe_build_table(F, layer);
            const LAS int* ts = (const LAS int*)(F.lc + LC_TS);
            const int ntile = ts[65];
            MoeSched<false> S{ts, (const LAS int*)(F.lc + LC_CNT), 4, ntile * 4, F.G, cid, F.lane, nullptr, nullptr,
                       (const char*)(ws + WS_WEDN) + (size_t)layer * 32 * MiB, (size_t)512 * 1024, (const char*)(ws + WS_WSHDN) + (size_t)layer * 512 * 1024, 512};
            pg8::EpiStoreF8 E{(unsigned char*)(ws + WS_YS), D, F.lds + LDS_TB_OFF + F.wave * 2048, 0};
            pg8::gemm_phase<pg8::EpiStoreF8, MoeSched<false>>(F.tid, F.lds, (const char*)(ws + WS_ACT), 512, 512, 256, S, E);
        } SEAM(pb + 6); STAMP(11);
        if (PHON(12) && IN(pb + 7)) { refresh(F); unsigned char* ws = opq(F.ws); (void)ws; moe_build_table(F, layer); combine_ln2_phase(F, layer); }
        if (layer < DEPTH - 1) LSEAM(pb + 7);
        STAMP(12);
    }
#ifdef PROBE_TYPE
    if (blockIdx.x == 0 && F.tid == 0) { const unsigned long long t0_ = __builtin_amdgcn_s_memrealtime(); const unsigned long long want_ = 4ull * ((LAS unsigned long long*)(F.lc + LC_STAMP))[1 + PROBE_TYPE];
        while (__builtin_amdgcn_s_memrealtime() - t0_ < want_) __builtin_amdgcn_s_sleep(8); }
#endif
#undef IN
#undef SEAM
}

extern "C" void kernel_launch(void* const* d_in, const int* in_sizes, int n_in, void* d_out, int out_size, void* d_ws, size_t ws_size, hipStream_t stream) {
    static int grid = 0;
    if (grid == 0) {
        if (n_in != 20 || in_sizes[0] != T * D || out_size != T * D || ws_size < WS_END) { fprintf(stderr, "kernel_launch: unexpected shapes / workspace (n_in %d, ws %zu); nothing launched\n", n_in, ws_size); grid = -1; return; }
        int dev = 0, cus = 0, per_cu = 0;
        if (hipGetDevice(&dev) != hipSuccess || hipDeviceGetAttribute(&cus, hipDeviceAttributeMultiprocessorCount, dev) != hipSuccess) { grid = -1; return; }
        if (hipFuncSetAttribute((const void*)mk_fwd, hipFuncAttributeMaxDynamicSharedMemorySize, LDS_BYTES) != hipSuccess) { fprintf(stderr, "kernel_launch: hipFuncSetAttribute failed\n"); grid = -1; return; }
        if (hipOccupancyMaxActiveBlocksPerMultiprocessor(&per_cu, (const void*)mk_fwd, NWAVES * 64, LDS_BYTES) != hipSuccess || per_cu < 1) { fprintf(stderr, "kernel_launch: occupancy query says %d\n", per_cu); }
        (void)hipGetLastError();
        grid = cus;
    }
    if (grid < 0) return;
    if (hipMemsetAsync((char*)d_ws + WS_CTL, 0, CTL_ZERO_BYTES, stream) != hipSuccess) return;
    Args a{};
    for (int i = 0; i < 20; ++i) a.in[i] = (const float*)d_in[i];
    a.out = (float*)d_out; a.ws = (unsigned char*)d_ws;
#if MK_PER_PHASE
    for (int p = 0; p < NPHASE; ++p) { a.ph_lo = p; a.ph_hi = p + 1; hipLaunchKernelGGL(mk_fwd, dim3(grid), dim3(NWAVES * 64), LDS_BYTES, stream, a); }
#else
    a.ph_lo = 0; a.ph_hi = NPHASE;
    hipLaunchKernelGGL(mk_fwd, dim3(grid), dim3(NWAVES * 64), LDS_BYTES, stream, a);
#endif
    const hipError_t le = hipPeekAtLastError();
    if (le != hipSuccess) fprintf(stderr, "kernel_launch: launch failed: %s\n", hipGetErrorName(le));
}
```

```cpp
#include <hip/hip_runtime.h>
#include <cstdio>
#include <cstdint>

#ifndef MK_PER_PHASE
#define MK_PER_PHASE 0
#endif
#define ORACLE_SEL 1
#define ATTN_GMASK 7
#define WGU_SCALE 256.0f
#define ACT8_SCALE 16.0f
#define MIX8_SCALE 32.0f
#define H8_SCALE 16.0f
#define ORACLE_W 1
#define ORACLE_LAYER 1
#ifndef MK_XLOCAL
#define MK_XLOCAL 1
#endif
#ifndef PHSEL
#define PHSEL 0xFFFF
#endif
#define PHON(n) (((PHSEL) >> (n)) & 1)

#define GAS __attribute__((address_space(1)))
#define LAS __attribute__((address_space(3)))
typedef unsigned short bf16;
typedef short bf16x8 __attribute__((ext_vector_type(8)));
typedef short s16x4 __attribute__((ext_vector_type(4)));
typedef float f32x2 __attribute__((ext_vector_type(2)));
typedef int i32x4 __attribute__((ext_vector_type(4)));
typedef int i32x8 __attribute__((ext_vector_type(8)));
typedef float f32x4 __attribute__((ext_vector_type(4)));
typedef float f32x16 __attribute__((ext_vector_type(16)));
typedef unsigned u32x2 __attribute__((ext_vector_type(2)));
typedef unsigned u32x4 __attribute__((ext_vector_type(4)));

constexpr int BATCH = 8, SEQ = 2048, D = 1024, T = BATCH * SEQ, DEPTH = 4;
constexpr int NQKV = 9216, NE = 64, TOPK = 8, DEXP = 256;
constexpr int CAP = 16384;
constexpr int PSLOT = 147456 + T;
constexpr float ALPHA = 1.6817928305074290f;
constexpr float LN_EPS = 1e-5f;
constexpr float LOG2E = 1.4426950408889634f;
constexpr float QSCALE = 0.125f * LOG2E;
constexpr float ROUTED_SCALE = 2.5f;

constexpr size_t MiB = 1u << 20;
constexpr size_t WS_CTL = 0, CTL_ZERO_BYTES = 64 * 1024;
constexpr size_t WS_MOD = 1 * MiB;
constexpr size_t WS_WRHI = 2 * MiB;
constexpr size_t WS_WRLO = WS_WRHI + 512 * 1024;
constexpr size_t WS_WPIN = 3 * MiB;
constexpr size_t WS_WPGRP = 7 * MiB;
constexpr size_t WS_WPOUT = 8 * MiB;
constexpr size_t WS_WAIN = 12 * MiB;
constexpr size_t WS_WAOUT = 48 * MiB;
constexpr size_t WS_WSHGU = 52 * MiB;
constexpr size_t WS_WSHDN = 56 * MiB;
constexpr size_t WS_WEGU = 58 * MiB;
constexpr size_t WS_WEDN = 314 * MiB;
constexpr size_t WS_X = 442 * MiB;
constexpr size_t WS_H = 506 * MiB;
constexpr size_t WS_Y = 538 * MiB;
constexpr size_t WS_U = 570 * MiB;
constexpr size_t WS_Z = 602 * MiB;
constexpr size_t WS_Y2 = 634 * MiB;
constexpr size_t WS_YS = 666 * MiB;
constexpr size_t WS_ACT = 986 * MiB;
constexpr size_t WS_TOKL = 1066 * MiB;
constexpr size_t WS_WL = 1070 * MiB;
constexpr size_t WS_TSLOT = 1074 * MiB;
constexpr size_t WS_QKV = 1076 * MiB;
constexpr size_t WS_END = 1364 * MiB;
static_assert(WS_YS + (size_t)PSLOT * 2048 <= WS_ACT && WS_ACT + (size_t)PSLOT * 512 <= WS_TOKL, "ws map");
constexpr int CW_BAR = 4096;
constexpr int CW_CNT = 12288;

constexpr int RING_BYTES = 135168;
constexpr int LDSCTL_OFF = RING_BYTES;
constexpr int LDS_TB_OFF = 147456;
constexpr int LDS_BYTES = 163840;
constexpr int LC_MISC = 0;
constexpr int LC_TS = 128;
constexpr int LC_CNT = 128 + 272;
constexpr int LC_LCNT = 128 + 272 + 256;
constexpr int LC_GB = 128 + 272 + 512;

#define RLX_AGENT __ATOMIC_RELAXED, __HIP_MEMORY_SCOPE_AGENT
#define LDS_WAIT() asm volatile("s_waitcnt lgkmcnt(0)" ::: "memory")
#define VM_WAIT() asm volatile("s_waitcnt vmcnt(0)" ::: "memory")

typedef __bf16 b16x2 __attribute__((ext_vector_type(2)));
__device__ __forceinline__ unsigned f2bf(float f) { unsigned u = __builtin_bit_cast(unsigned, f); return (u + 0x7fffu + ((u >> 16) & 1u)) >> 16; }
__device__ __forceinline__ unsigned pk2(float lo, float hi) { const f32x2 v = {lo, hi}; return __builtin_bit_cast(unsigned, __builtin_convertvector(v, b16x2)); }
__device__ __forceinline__ float bf2f(unsigned h) { return __builtin_bit_cast(float, h << 16); }
__device__ __forceinline__ unsigned cvt_pk_bf16(float lo, float hi) { return pk2(lo, hi); }
typedef _Float16 h16x2 __attribute__((ext_vector_type(2)));
__device__ __forceinline__ unsigned pkh2(float lo, float hi) { const f32x2 v = {lo, hi}; return __builtin_bit_cast(unsigned, __builtin_convertvector(v, h16x2)); }
__device__ __forceinline__ float h2f(unsigned h) { return (float)__builtin_bit_cast(_Float16, (unsigned short)h); }
#define MFMA16(a, b, c) __builtin_amdgcn_mfma_f32_16x16x32_bf16(a, b, c, 0, 0, 0)
#define MFMA32(a, b, c) __builtin_amdgcn_mfma_f32_32x32x16_bf16(a, b, c, 0, 0, 0)
__device__ __forceinline__ float wave_sum(float v) {
#pragma unroll
    for (int o = 1; o < 64; o <<= 1) v += __shfl_xor(v, o);
    return v;
}

namespace pg8 {
constexpr int BM = 256, BK = 64, HALF = 128, HTB = HALF * BK * 2, STAGE_BYTES = 8 * HTB, NXCD = 8;
__host__ __device__ __forceinline__ int lds_byte(int r, int c) { const int st = (r >> 4) * 2 + (c >> 5), rr = r & 15, cc = c & 31, ob = rr * 64 + cc * 2; return st * 1024 + (ob ^ (((ob >> 9) & 1) << 5)); }
__host__ __device__ __forceinline__ void stage_rc(int b, int& R, int& C) { const int st = b / 1024, sb = b % 1024, swz = sb ^ (((sb >> 9) & 1) << 5); R = (st >> 1) * 16 + swz / 64; C = (st & 1) * 32 + (swz % 64) / 2; }
__host__ __device__ __forceinline__ int perm32(int rho) { const int n = rho >> 4, i = rho & 15; return 8 * (i >> 2) + 4 * n + (i & 3); }

struct Unit {
    int pm, pn;
    const char* bptr;
    int roff;
    int nvalid;
};

__device__ __forceinline__ int xcd_chunk(int L, int nwg) { const int q = nwg / NXCD, r = nwg % NXCD, xcd = L % NXCD, off = L / NXCD; return (xcd < r ? xcd * (q + 1) : r * (q + 1) + (xcd - r) * q) + off; }

template <class Epi, class Sched>
__device__ __forceinline__ void gemm_phase(const int tid, LAS unsigned char* lds, const char* Abase, const int lda, const int ldb, const int K, const Sched& S, const Epi& E) {
    constexpr bool GATHER = Sched::GATHER;
    const int wid = __builtin_amdgcn_readfirstlane(tid >> 6), lane = tid & 63, wr = wid >> 2, wc = wid & 3, fr = lane & 15, fq = lane >> 4;
    int nt = K / BK; asm volatile("" : "+s"(nt));
    int Rr[2]; unsigned C2[2], voffB[2], voffA[2];
#pragma unroll
    for (int i = 0; i < 2; ++i) { int R, C; stage_rc(tid * 16 + i * 8192, R, C); const int Rb = Epi::WIDE ? ((R >> 5) * 64 + perm32(R & 31)) : ((R & ~31) + perm32(R & 31)); Rr[i] = R; C2[i] = (unsigned)C * 2u; voffB[i] = (unsigned)(Rb * ldb) + (unsigned)C * 2u;
        voffA[i] = Sched::ABLK ? (unsigned)((C >> 5) * 16384 + R * 64 + (C & 31) * 2) : ((unsigned)(R * lda) + (unsigned)C * 2u); }
    const size_t kstep = (size_t)(BK * 2);
    const size_t hstepB = (size_t)(Epi::WIDE ? 32 : HALF) * ldb;
    const size_t hstepA = GATHER ? (size_t)0 : (Sched::ABLK ? (size_t)8192 : (size_t)HALF * lda);
    const size_t kstepA = Sched::ABLK ? (size_t)32768 : kstep;
    const unsigned ldsw = (unsigned)wid * 1024u;
    const int aoff = lds_byte(wr * 64 + fr, fq * 8), boff = lds_byte(wc * 32 + fr, fq * 8);
#define PG8_SA(b, h) (((b) * 2 + (h)) * HTB)
#define PG8_SB(b, h) ((4 + (b) * 2 + (h)) * HTB)
#define PG8_STAGE(bufoff, gbase, voff) do { const unsigned long long gb64_ = (unsigned long long)(gbase); \
        const char* gbu_ = (const char*)(((unsigned long long)(unsigned)__builtin_amdgcn_readfirstlane((unsigned)(gb64_ >> 32)) << 32) | (unsigned)__builtin_amdgcn_readfirstlane((unsigned)gb64_));     \
        _Pragma("unroll") for (int _i = 0; _i < 2; ++_i) \
        __builtin_amdgcn_global_load_lds((const unsigned*)(gbu_ + (voff)[_i]), (LAS unsigned*)(lds + (bufoff) + ldsw + _i * 8192), 16, 0, 0); } while (0)
#define PG8_STAGEA(bufoff, gbase, h) do { if constexpr (GATHER) { PG8_STAGE(bufoff, gbase, vA[h]); } else { PG8_STAGE(bufoff, (gbase) + (h) * hstepA, voffA); } } while (0)
#define PG8_LDA(dst, b, h) do { _Pragma("unroll") for (int m = 0; m < 4; ++m) _Pragma("unroll") for (int k = 0; k < 2; ++k) dst[m][k] = *(const LAS bf16x8*)(lds + PG8_SA(b, h) + aoff + m * 2048 + k * 1024); } while (0)
#define PG8_LDB(dst, b, h) do { if constexpr (Epi::F8MMA) { _Pragma("unroll") for (int n = 0; n < 2; ++n) { const i32x4 lo_ = *(const LAS i32x4*)(lds + PG8_SB(b, h) + boff + n * 2048), hi_ = *(const LAS i32x4*)(lds + PG8_SB(b, h) + boff + n * 2048 + 1024); \
            dst##8[n] = __builtin_shufflevector(lo_, hi_, 0, 1, 2, 3, 4, 5, 6, 7); } }     \
        else { _Pragma("unroll") for (int n = 0; n < 2; ++n) _Pragma("unroll") for (int k = 0; k < 2; ++k) dst[n][k] = *(const LAS bf16x8*)(lds + PG8_SB(b, h) + boff + n * 2048 + k * 1024); } } while (0)
#define PG8_MMA(ai, bj, At, Bt) do { __builtin_amdgcn_s_setprio(1); _Pragma("unroll") for (int m = 0; m < 4; ++m) _Pragma("unroll") for (int n = 0; n < 2; ++n) _Pragma("unroll") for (int k = 0; k < 2; ++k) \
        acc[ai][bj][m][n] = MFMA16(Bt[n][k], At[m][k], acc[ai][bj][m][n]); __builtin_amdgcn_s_setprio(0); } while (0)
#define PG8_MMA8(ai, bj, At, Bt8) do { __builtin_amdgcn_s_setprio(1); \
        _Pragma("unroll") for (int m = 0; m < 4; ++m) { const i32x8 a8_ = __builtin_shufflevector(__builtin_bit_cast(i32x4, At[m][0]), __builtin_bit_cast(i32x4, At[m][1]), 0, 1, 2, 3, 4, 5, 6, 7); \
            acc[ai][bj][m][0] = __builtin_amdgcn_mfma_scale_f32_16x16x128_f8f6f4(Bt8[0], a8_, acc[ai][bj][m][0], 0, 0, 0, swb[bj], 0, 0x7b7b7b7b); \
            acc[ai][bj][m][1] = __builtin_amdgcn_mfma_scale_f32_16x16x128_f8f6f4(Bt8[1], a8_, acc[ai][bj][m][1], 0, 0, 0, swb[bj], 0, 0x7b7b7b7b); } __builtin_amdgcn_s_setprio(0); } while (0)
#define PG8_MM(ai, bj, At, Bt) do { if constexpr (Epi::F8MMA) PG8_MMA8(ai, bj, At, Bt##8); else PG8_MMA(ai, bj, At, Bt); } while (0)
#define PG8_WAIT_V(n) asm volatile("s_waitcnt vmcnt(" #n ")" ::: "memory")
#define PG8_WAIT_L(n) asm volatile("s_waitcnt lgkmcnt(" #n ")" ::: "memory")
#define PG8_BAR __builtin_amdgcn_s_barrier()
#define PG8_SCHED __builtin_amdgcn_sched_barrier(0)
#define PG8_CALCA(u, vo) do { _Pragma("unroll") for (int _h = 0; _h < 2; ++_h) _Pragma("unroll") for (int _i = 0; _i < 2; ++_i) \
        vo[_h][_i] = Sched::ABLK ? ((unsigned)S.arow(u, 0) * (unsigned)lda + voffA[_i] + (unsigned)_h * 8192u) : ((unsigned)S.arow(u, _h * HALF + Rr[_i]) * (unsigned)lda + C2[_i]); } while (0)
    Unit cur, nxt; int ui = 0;
    if (!S.next(0, cur)) return;
    f32x4 acc[2][2][4][2];
#pragma unroll
    for (int a = 0; a < 2; ++a)
#pragma unroll
        for (int b = 0; b < 2; ++b)
#pragma unroll
            for (int m = 0; m < 4; ++m)
#pragma unroll
                for (int n = 0; n < 2; ++n) acc[a][b][m][n] = (f32x4){0.f, 0.f, 0.f, 0.f};
    bf16x8 At[4][2], B0[2][2], B1[2][2];
    i32x8 B08[2], B18[2];
    unsigned vA[2][2], vAn[2][2];
    const char* cA = Abase;
    if constexpr (GATHER) { PG8_CALCA(cur, vA); } else { cA = Abase + (size_t)S.arow(cur, 0) * lda + S.acolb(cur); }
    const char* cB = cur.bptr;
    PG8_STAGE(PG8_SB(0, 0), cB, voffB); PG8_STAGE(PG8_SB(0, 1), cB + hstepB, voffB); PG8_STAGEA(PG8_SA(0, 0), cA, 0); PG8_STAGEA(PG8_SA(0, 1), cA, 1);
    if (wr == 1) PG8_BAR;
    PG8_WAIT_V(2); PG8_BAR;
    PG8_STAGE(PG8_SB(1, 0), cB + kstep, voffB); PG8_STAGEA(PG8_SA(1, 0), cA + kstepA, 0); PG8_STAGE(PG8_SB(1, 1), cB + hstepB + kstep, voffB);
    PG8_WAIT_V(6); PG8_BAR;
    for (;;) {
        const bool has_next = S.next(ui + 1, nxt);
        float rs[2][4];
        if constexpr (Epi::ROWSCALE) {
#pragma unroll
            for (int ai = 0; ai < 2; ++ai)
#pragma unroll
                for (int m = 0; m < 4; ++m) rs[ai][m] = S.rowscale(cur, ai * HALF + wr * 64 + m * 16 + fr);
        }
        const char* nA = cA;
        if constexpr (GATHER) {
            if (has_next) { PG8_CALCA(nxt, vAn); }
            else {
#pragma unroll
                for (int h = 0; h < 2; ++h)
#pragma unroll
                    for (int i = 0; i < 2; ++i) vAn[h][i] = vA[h][i];
            }
            asm volatile("s_waitcnt vmcnt(0)" : "+v"(vAn[0][0]), "+v"(vAn[0][1]), "+v"(vAn[1][0]), "+v"(vAn[1][1]) :: "memory");
            if constexpr (Epi::ROWSCALE) { asm volatile("" : "+v"(rs[0][0]), "+v"(rs[0][1]), "+v"(rs[0][2]), "+v"(rs[0][3]), "+v"(rs[1][0]), "+v"(rs[1][1]), "+v"(rs[1][2]), "+v"(rs[1][3])); }
        } else { if (has_next) nA = Abase + (size_t)S.arow(nxt, 0) * lda + S.acolb(nxt); }
        const char* nB = has_next ? nxt.bptr : cB;
        int swb[2] = {0x7f7f7f7f, 0x7f7f7f7f}; if constexpr (Epi::F8MMA) { swb[0] = E.wscale(cur, 0); swb[1] = E.wscale(cur, 1); }
#pragma unroll 1
        for (int t = 0; t < nt; t += 2) {
            const bool last = (t == nt - 2);
            const char* a1 = cA + (size_t)(t + 1) * kstepA;
            const char* a2 = last ? nA : cA + (size_t)(t + 2) * kstepA; const char* b2 = last ? nB : cB + (size_t)(t + 2) * kstep;
            const char* a3 = a2 + kstepA; const char* b3 = b2 + kstep;
            PG8_LDB(B0, 0, 0); PG8_LDB(B1, 0, 1); PG8_SCHED; PG8_LDA(At, 0, 0); PG8_STAGEA(PG8_SA(1, 1), a1, 1);
            if constexpr (GATHER) { if (last) {
#pragma unroll
                for (int h = 0; h < 2; ++h)
#pragma unroll
                    for (int i = 0; i < 2; ++i) vA[h][i] = vAn[h][i]; } }
            PG8_WAIT_V(8); PG8_WAIT_L(0); PG8_BAR; PG8_MM(0, 0, At, B0); PG8_MM(0, 1, At, B1); PG8_BAR; PG8_SCHED;
            PG8_LDA(At, 0, 1); PG8_STAGE(PG8_SB(0, 0), b2, voffB); PG8_STAGE(PG8_SB(0, 1), b2 + hstepB, voffB); PG8_STAGEA(PG8_SA(0, 0), a2, 0);
            PG8_WAIT_V(8); PG8_WAIT_L(0); PG8_BAR; PG8_MM(1, 0, At, B0); PG8_MM(1, 1, At, B1); PG8_BAR; PG8_SCHED;
            PG8_LDB(B0, 1, 0); PG8_LDB(B1, 1, 1); PG8_SCHED; PG8_LDA(At, 1, 0); PG8_STAGEA(PG8_SA(0, 1), a2, 1);
            PG8_WAIT_V(8); PG8_WAIT_L(0); PG8_BAR; PG8_MM(0, 0, At, B0); PG8_MM(0, 1, At, B1); PG8_BAR; PG8_SCHED;
            PG8_LDA(At, 1, 1); PG8_STAGE(PG8_SB(1, 0), b3, voffB); PG8_STAGE(PG8_SB(1, 1), b3 + hstepB, voffB); PG8_STAGEA(PG8_SA(1, 0), a3, 0);
            PG8_WAIT_V(8); PG8_WAIT_L(0); PG8_BAR; PG8_MM(1, 0, At, B0); PG8_MM(1, 1, At, B1); PG8_BAR; PG8_SCHED;
        }
        if (wr == 0) PG8_BAR;
        E(acc, cur, rs, wr, wc, fr, fq);
        if (!has_next) break;
#pragma unroll
        for (int a = 0; a < 2; ++a)
#pragma unroll
            for (int b = 0; b < 2; ++b)
#pragma unroll
                for (int m = 0; m < 4; ++m)
#pragma unroll
                    for (int n = 0; n < 2; ++n) acc[a][b][m][n] = (f32x4){0.f, 0.f, 0.f, 0.f};
        cur = nxt; cB = nB; cA = nA; ++ui;
        if (wr == 1) PG8_BAR;
    }
    PG8_WAIT_V(0);
    PG8_BAR;
#undef PG8_SA
#undef PG8_SB
#undef PG8_STAGE
#undef PG8_STAGEA
#undef PG8_LDA
#undef PG8_LDB
#undef PG8_MMA
#undef PG8_MMA8
#undef PG8_MM
#undef PG8_WAIT_V
#undef PG8_WAIT_L
#undef PG8_BAR
#undef PG8_SCHED
#undef PG8_CALCA
}

template <bool F8IN> struct EpiStoreB {
    static constexpr bool ROWSCALE = false, WIDE = true, F8MMA = F8IN;
    __device__ __forceinline__ int wscale(const Unit&, int) const { return wsc; }
    bf16* O; int ldc; const float* cscale; int qmode; int ntst; int f16; LAS unsigned char* tb; int wsc = 0x7f7f7f7f;
    __device__ __forceinline__ void operator()(const f32x4 (&acc)[2][2][4][2], const Unit& u, const float (&rs)[2][4], int wr, int wc, int fr, int fq) const {
        const int colw = u.pn * BM + wc * 64;
        float sc = 1.f; if (qmode) { if ((((u.pn * BM) >> 10) % 3) == 0) sc = QSCALE; }
        f32x4 cs[2][2];
#pragma unroll
        for (int bj = 0; bj < 2; ++bj)
#pragma unroll
            for (int n = 0; n < 2; ++n) { cs[bj][n] = cscale ? *(const f32x4*)(cscale + colw + 32 * bj + 8 * fq + 4 * n) : (f32x4){1.f, 1.f, 1.f, 1.f}; cs[bj][n] = cs[bj][n] * sc; }
        const int L = fr + 16 * fq, rr = L >> 3, sg = L & 7;
        LAS u32x4* tbv = (LAS u32x4*)tb;
        const int wi0 = fr * 8 + (fq ^ (fr & 7)), wi1 = fr * 8 + ((4 + fq) ^ (fr & 7)), ri = rr * 8 + (sg ^ rr);
        bf16* gp = O + (size_t)(u.pm * BM + wr * 64 + rr) * ldc + colw + sg * 8;
#pragma unroll
        for (int ai = 0; ai < 2; ++ai)
#pragma unroll
            for (int m = 0; m < 4; ++m) {
                u32x4 w[2];
#pragma unroll
                for (int bj = 0; bj < 2; ++bj) { const f32x4 v0 = acc[ai][bj][m][0] * cs[bj][0], v1 = acc[ai][bj][m][1] * cs[bj][1];
                    if (f16) { w[bj].x = pkh2(v0[0], v0[1]); w[bj].y = pkh2(v0[2], v0[3]); w[bj].z = pkh2(v1[0], v1[1]); w[bj].w = pkh2(v1[2], v1[3]); }
                    else { w[bj].x = cvt_pk_bf16(v0[0], v0[1]); w[bj].y = cvt_pk_bf16(v0[2], v0[3]); w[bj].z = cvt_pk_bf16(v1[0], v1[1]); w[bj].w = cvt_pk_bf16(v1[2], v1[3]); } }
                tbv[wi0] = w[0]; tbv[wi1] = w[1];
                asm volatile("" ::: "memory");
                const u32x4 r0 = tbv[ri], r1 = tbv[ri + 64];
                asm volatile("" ::: "memory");
                bf16* rowp = gp + (size_t)(ai * HALF + m * 16) * ldc;
                if (ntst) { __builtin_nontemporal_store(r0, (u32x4*)rowp); __builtin_nontemporal_store(r1, (u32x4*)(rowp + (size_t)8 * ldc)); }
                else { *(u32x4*)rowp = r0; *(u32x4*)(rowp + (size_t)8 * ldc) = r1; } }
    }
};
typedef EpiStoreB<false> EpiStore;
typedef EpiStoreB<true> EpiStore8;
typedef unsigned u32x2_t __attribute__((ext_vector_type(2)));
template <bool F8IN> struct EpiStoreF8T {
    static constexpr bool ROWSCALE = false, WIDE = true, F8MMA = F8IN;
    __device__ __forceinline__ int wscale(const Unit& u, int) const { return wsc_ov ? wsc_ov : (qmode ? (((((u.pn * BM) >> 10) % 3) == 0) ? 0x7a7a7a7a : 0x7b7b7b7b) : 0x7c7c7c7c); }
    unsigned char* O; int ldc; LAS unsigned char* tb; int qmode; const float* cscale = nullptr; float oscale = 1.0f; int wsc_ov = 0;
    __device__ __forceinline__ void operator()(const f32x4 (&acc)[2][2][4][2], const Unit& u, const float (&rs)[2][4], int wr, int wc, int fr, int fq) const {
        const int colw = u.pn * BM + wc * 64;
        const int L = fr + 16 * fq, rr = L >> 2, sg = L & 3;
        LAS unsigned char* wp0 = tb + fr * 64 + ((fq) ^ (fr & 7)) * 8; LAS unsigned char* wp1 = tb + fr * 64 + ((4 + fq) ^ (fr & 7)) * 8;
        const LAS unsigned char* rp0 = tb + rr * 64 + ((2 * sg) ^ (rr & 7)) * 8; const LAS unsigned char* rp1 = tb + rr * 64 + ((2 * sg + 1) ^ (rr & 7)) * 8;
        unsigned char* gp = O + (size_t)(u.pm * BM + wr * 64 + rr) * ldc + colw + sg * 16;
#define F8_PACKW(s_) do { const int ai_ = (s_) >> 2, m_ = (s_) & 3; u32x2_t w_[2]; \
            _Pragma("unroll") for (int bj = 0; bj < 2; ++bj) { f32x4 v0 = acc[ai_][bj][m_][0], v1 = acc[ai_][bj][m_][1]; \
                if (cscale) { v0 = v0 * (*(const f32x4*)(cscale + colw + 32 * bj + 8 * fq) * oscale); v1 = v1 * (*(const f32x4*)(cscale + colw + 32 * bj + 8 * fq + 4) * oscale); } \
                int p0 = __builtin_amdgcn_cvt_pk_fp8_f32(v0[0], v0[1], 0, false); p0 = __builtin_amdgcn_cvt_pk_fp8_f32(v0[2], v0[3], p0, true); \
                int p1 = __builtin_amdgcn_cvt_pk_fp8_f32(v1[0], v1[1], 0, false); p1 = __builtin_amdgcn_cvt_pk_fp8_f32(v1[2], v1[3], p1, true); \
                w_[bj].x = (unsigned)p0; w_[bj].y = (unsigned)p1; } \
            *(LAS u32x2_t*)(wp0 + ((s_) & 1) * 1024) = w_[0]; *(LAS u32x2_t*)(wp1 + ((s_) & 1) * 1024) = w_[1]; } while (0)
        F8_PACKW(0);
#pragma unroll
        for (int st = 0; st < 8; ++st) {
            asm volatile("" ::: "memory");
            const u32x2_t a = *(const LAS u32x2_t*)(rp0 + (st & 1) * 1024), b = *(const LAS u32x2_t*)(rp1 + (st & 1) * 1024);
            asm volatile("" ::: "memory");
            if (st + 1 < 8) F8_PACKW(st + 1);
            u32x4 o; o.x = a.x; o.y = a.y; o.z = b.x; o.w = b.y;
            *(GAS u32x4*)(gp + (size_t)((st >> 2) * HALF + (st & 3) * 16) * ldc) = o; }
#undef F8_PACKW
    }
};
typedef EpiStoreF8T<false> EpiStoreF8;
typedef EpiStoreF8T<true> EpiStoreF8Q;
struct EpiGU {
    static constexpr bool ROWSCALE = false, WIDE = false, F8MMA = true;
    __device__ __forceinline__ int wscale(const Unit&, int bj) const { return bj == 0 ? 0x77777777 : 0x7b7b7b7b; }
    unsigned char* O;
    __device__ __forceinline__ void operator()(const f32x4 (&acc)[2][2][4][2], const Unit& u, const float (&rs)[2][4], int wr, int wc, int fr, int fq) const {
        unsigned char* tp = O + (size_t)u.pm * (BM * DEXP) + (size_t)(u.pn * 2 + (wc >> 1)) * (BM * 64) + (wr * 64 + fr) * 64 + (wc & 1) * 32 + 8 * fq;
#pragma unroll
        for (int ai = 0; ai < 2; ++ai)
#pragma unroll
            for (int m = 0; m < 4; ++m) { unsigned char* rowp = tp + (ai * HALF + m * 16) * 64;
                float o[8];
#pragma unroll
                for (int n = 0; n < 2; ++n)
#pragma unroll
                    for (int j = 0; j < 4; ++j) { const float g = acc[ai][0][m][n][j], uu = acc[ai][1][m][n][j];
                        const float sg = g * __builtin_amdgcn_rcpf(1.0f + __builtin_amdgcn_exp2f(-g * LOG2E)); o[n * 4 + j] = __builtin_amdgcn_fmed3f(sg * uu, -448.0f, 448.0f); }
                int p0 = __builtin_amdgcn_cvt_pk_fp8_f32(o[0], o[1], 0, false); p0 = __builtin_amdgcn_cvt_pk_fp8_f32(o[2], o[3], p0, true);
                int p1 = __builtin_amdgcn_cvt_pk_fp8_f32(o[4], o[5], 0, false); p1 = __builtin_amdgcn_cvt_pk_fp8_f32(o[6], o[7], p1, true);
                u32x2_t wv; wv.x = (unsigned)p0; wv.y = (unsigned)p1;
                *(GAS u32x2_t*)rowp = wv; }
    }
};
}

#define XB_TMO      128
#define XB_XCNT(j)  (256  + 64 * (j))
#define XB_XSUB(j)  (1280 + 64 * (j))
#define XB_XGEN(j)  (2304 + 64 * (j))
#define XB_TOP      3328
#define XB_TOPGEN   3392
#define XB_LSUB(j)  (3456 + 64 * (j))
#define XB_LGEN(j)  (4480 + 64 * (j))
#define XCD_BAR_WORDS 5504
#define XB_SPIN_CAP (1u << 18)
__device__ __forceinline__ unsigned xb_ld(unsigned* p)              { return __hip_atomic_load(p, __ATOMIC_RELAXED, __HIP_MEMORY_SCOPE_AGENT); }
__device__ __forceinline__ unsigned xb_add(unsigned* p, unsigned v) { return __hip_atomic_fetch_add(p, v, __ATOMIC_RELAXED, __HIP_MEMORY_SCOPE_AGENT); }
__device__ __forceinline__ unsigned xb_xcc_id() { return (unsigned)__builtin_amdgcn_s_getreg((3 << 11) | 20) & 0xFu; }
#define XB_SPIN(cond, bar) do { unsigned _sp = 0; while (cond) { __builtin_amdgcn_s_sleep(1); \
    if ((++_sp & 255u) == 0u) { if (xb_ld(&(bar)[XB_TMO])) break; if (_sp > XB_SPIN_CAP) { atomicAdd(&(bar)[XB_TMO], 1u); break; } } } } while (0)
struct XcdBarrier { unsigned* bar; unsigned x; volatile LAS unsigned* st; };
__device__ __forceinline__ XcdBarrier xcd_barrier_post(unsigned* bar, volatile LAS unsigned* st) {
    XcdBarrier b; b.bar = bar; b.x = xb_xcc_id(); b.st = st;
    if (threadIdx.x == 0) st[2] = xb_add(&bar[XB_XCNT(b.x)], 1u);
    return b;
}
__device__ __forceinline__ void xcd_local_barrier(const XcdBarrier& b, const bool wave0) {
    asm volatile("s_waitcnt vmcnt(0)" ::: "memory");
    __syncthreads();
    if (wave0 && __builtin_amdgcn_mbcnt_hi(~0u, __builtin_amdgcn_mbcnt_lo(~0u, 0u)) == 0u) {
        unsigned* bar = b.bar;
        __builtin_amdgcn_s_waitcnt(0);
        const unsigned nloc = b.st[0];
        const unsigned old = xb_add(&bar[XB_LSUB(b.x)], 1u);
        const unsigned gen = old / nloc;
        if (old + 1u == (gen + 1u) * nloc) xb_add(&bar[XB_LGEN(b.x)], 1u);
        else XB_SPIN(xb_ld(&bar[XB_LGEN(b.x)]) == gen, bar);
        __builtin_amdgcn_fence(__ATOMIC_ACQUIRE, "agent");
        asm volatile("s_waitcnt vmcnt(0)" ::: "memory");
    }
    __syncthreads();
}
__device__ __forceinline__ void xcd_barrier_complete(unsigned* bar, unsigned x, unsigned& nloc, unsigned& nx) {
    const unsigned G = gridDim.x * gridDim.y * gridDim.z;
    unsigned sum, cnt, mine, sp = 0u;
    for (;;) {
        sum = 0u; cnt = 0u; mine = 0u;
#pragma unroll
        for (unsigned j = 0; j < 16; ++j) { const unsigned c = xb_ld(&bar[XB_XCNT(j)]); sum += c; cnt += (c > 0u) ? 1u : 0u; mine = (j == x) ? c : mine; }
        if (sum == G) break;
        __builtin_amdgcn_s_sleep(1);
        if ((++sp & 255u) == 0u) { if (xb_ld(&bar[XB_TMO])) break; if (sp > XB_SPIN_CAP) { atomicAdd(&bar[XB_TMO], 1u); break; } }
    }
    nloc = mine > 0u ? mine : 1u; nx = cnt > 0u ? cnt : 1u;
}
__device__ __forceinline__ void xcd_barrier(const XcdBarrier& b) {
    asm volatile("s_waitcnt vmcnt(0)" ::: "memory");
    __syncthreads();
    if (threadIdx.x == 0) {
        unsigned* bar = b.bar;
        __builtin_amdgcn_s_waitcnt(0);
        unsigned nloc = b.st[0], nx = b.st[1];
        if (nloc == 0u) { xcd_barrier_complete(bar, b.x, nloc, nx); b.st[0] = nloc; b.st[1] = nx; }
        const unsigned old = xb_add(&bar[XB_XSUB(b.x)], 1u);
        const unsigned gen = old / nloc;
        if (old + 1u == (gen + 1u) * nloc) {
            __builtin_amdgcn_fence(__ATOMIC_RELEASE, "agent");
            asm volatile("s_waitcnt vmcnt(0)" ::: "memory");
            const unsigned og = xb_add(&bar[XB_TOP], 1u);
            const unsigned tg = og / nx;
            if (og + 1u == (tg + 1u) * nx) xb_add(&bar[XB_TOPGEN], 1u);
            else XB_SPIN(xb_ld(&bar[XB_TOPGEN]) == tg, bar);
            __builtin_amdgcn_fence(__ATOMIC_ACQUIRE, "agent");
            xb_add(&bar[XB_XGEN(b.x)], 1u);
            asm volatile("s_waitcnt vmcnt(0)" ::: "memory");
        } else {
            XB_SPIN(xb_ld(&bar[XB_XGEN(b.x)]) == gen, bar);
            __builtin_amdgcn_fence(__ATOMIC_ACQUIRE, "agent");
            asm volatile("s_waitcnt vmcnt(0)" ::: "memory");
        }
    }
    __syncthreads();
}

constexpr int NWAVES = 8;
struct Frame {
    LAS unsigned char* lds;
    LAS unsigned char* lc;
    unsigned* ctl;
    unsigned char* ws;
    int tid, lane, wave, vcu, G;
};
constexpr int LC_PTR = 2048;
__device__ __forceinline__ const float* inp(const Frame& F, int i) {
    const unsigned long long v = *(const LAS unsigned long long*)(F.lc + LC_PTR + 8 * i);
    const unsigned lo = __builtin_amdgcn_readfirstlane((unsigned)v), hi = __builtin_amdgcn_readfirstlane((unsigned)(v >> 32));
    return (const float*)(const GAS float*)(((unsigned long long)hi << 32) | lo);
}
__device__ __forceinline__ unsigned char* opq(unsigned char* p) { GAS unsigned char* g = (GAS unsigned char*)p; asm volatile("" : "+s"(g)); return (unsigned char*)g; }
__device__ __forceinline__ void refresh(Frame& F) { asm volatile("" : "+v"(F.tid)); F.lane = F.tid & 63; F.wave = __builtin_amdgcn_readfirstlane(F.tid >> 6); }

struct PlainSched {   static constexpr bool GATHER = false, ABLK = false;
    int nM, nN, nwg, G, c; const char* B; int ldb;
    __device__ __forceinline__ bool next(int i, pg8::Unit& u) const {
        const int L = i * G + c; if (L >= nwg) return false;
        const int wgid = pg8::xcd_chunk(L, nwg);
        const int nig = 8 * nN, gid = wgid / nig, fm = gid * 8, gsz = (nM - fm) < 8 ? (nM - fm) : 8;
        u.pm = fm + ((wgid % nig) % gsz); u.pn = (wgid % nig) / gsz;
        u.bptr = B + (size_t)u.pn * 256 * ldb; u.roff = -(u.pm * 256) - 1; u.nvalid = 256; return true;
    }
    __device__ __forceinline__ int arow(const pg8::Unit& u, int r) const { return -u.roff - 1 + r; }
    __device__ __forceinline__ int acolb(const pg8::Unit&) const { return 0; }
    __device__ __forceinline__ float rowscale(const pg8::Unit&, int) const { return 1.0f; }
};
struct PlainSchedG {  static constexpr bool GATHER = true, ABLK = false;
    int nM, nN, nwg, G, c; const char* B; int ldb;
    __device__ __forceinline__ bool next(int i, pg8::Unit& u) const {
        const int L = i * G + c; if (L >= nwg) return false;
        const int wgid = pg8::xcd_chunk(L, nwg);
        const int nig = 8 * nN, gid = wgid / nig, fm = gid * 8, gsz = (nM - fm) < 8 ? (nM - fm) : 8;
        u.pm = fm + ((wgid % nig) % gsz); u.pn = (wgid % nig) / gsz;
        u.bptr = B + (size_t)u.pn * 256 * ldb; u.roff = -(u.pm * 256) - 1; u.nvalid = 256; return true;
    }
    __device__ __forceinline__ int arow(const pg8::Unit& u, int r) const { return -u.roff - 1 + r; }
    __device__ __forceinline__ int acolb(const pg8::Unit&) const { return 0; }
    __device__ __forceinline__ float rowscale(const pg8::Unit&, int) const { return 1.0f; }
};
struct GrpSched {     static constexpr bool GATHER = false, ABLK = false;
    int G, c; const char* B;
    __device__ __forceinline__ bool next(int i, pg8::Unit& u) const {
        const int L = i * G + c; if (L >= 256) return false;
        const int wgid = pg8::xcd_chunk(L, 256);
        u.pm = wgid >> 2; u.pn = wgid & 3; u.bptr = B + (size_t)u.pn * 256 * 512; u.roff = -(u.pm * 256) - 1; u.nvalid = 256; return true;
    }
    __device__ __forceinline__ int arow(const pg8::Unit& u, int r) const { return -u.roff - 1 + r; }
    __device__ __forceinline__ int acolb(const pg8::Unit& u) const { return u.pn * 512; }
    __device__ __forceinline__ float rowscale(const pg8::Unit&, int) const { return 1.0f; }
};
template <bool GATHER_> struct MoeSched {     static constexpr bool GATHER = GATHER_, ABLK = !GATHER_;
    const LAS int* ts; const LAS int* cn; int npn, nunits, G, c, lane_;
    const int* tokl; const float* wl; const char* Bexp; size_t bstride; const char* Bsh; int ldb;
    __device__ __forceinline__ bool next(int i, pg8::Unit& u) const {
        const int L = i * G + c; const int xg = L % pg8::NXCD, off = L / pg8::NXCD;
        const int ntile = nunits / npn, tq = ntile / pg8::NXCD, tr = ntile % pg8::NXCD;
        const int tcnt = tq + (xg < tr ? 1 : 0), tstart = xg * tq + (xg < tr ? xg : tr);
        if (off >= tcnt * npn) return false;
        const int tile = tstart + off / npn, pn = off % npn;
        const int lane = lane_;
        const bool hit = (tile >= ts[lane]) && (tile < ts[lane + 1]);
        const unsigned long long mk = __ballot(hit);
        const int e = mk ? (int)__builtin_ctzll(mk) : 64;
        const int tse = __builtin_amdgcn_readfirstlane(ts[e]);
        const int r0 = (tile - tse) * 256;
        u.pm = tile; u.pn = pn;
        u.bptr = (e < 64 ? Bexp + (size_t)e * bstride : Bsh) + (size_t)pn * 256 * ldb;
        if (GATHER) {
            if (e < 64) { const int ce = __builtin_amdgcn_readfirstlane(cn[e]); u.roff = e * CAP + r0; u.nvalid = (ce - r0) < 256 ? (ce - r0) : 256; }
            else { u.roff = -r0 - 1; u.nvalid = 256; }
        } else { u.roff = -(tile * 256) - 1; u.nvalid = 256; }
        return true;
    }
    __device__ __forceinline__ int arow(const pg8::Unit& u, int r) const { if (GATHER && u.roff >= 0) { const int rr = r < u.nvalid ? r : u.nvalid - 1; return tokl[u.roff + rr]; } return -u.roff - 1 + r; }
    __device__ __forceinline__ int acolb(const pg8::Unit&) const { return 0; }
    __device__ __forceinline__ float rowscale(const pg8::Unit& u, int r) const { if (GATHER && u.roff >= 0) { const int rr = r < u.nvalid ? r : u.nvalid - 1; return wl[u.roff + rr]; } return 1.0f; }
};

struct MoeSchedDG {   static constexpr bool GATHER = true, ABLK = true;
    static constexpr int npn = 4, ldb = 256; static constexpr size_t bstride = (size_t)256 * 1024;
    const LAS int* ts; int ntile, G, c, lane_;
    const char* Bexp; const char* Bsh;
    __device__ __forceinline__ bool next(int i, pg8::Unit& u) const {
        const int L = i * G + c; const int xg = L % pg8::NXCD, off = L / pg8::NXCD;
        const int tq = ntile / pg8::NXCD, tr = ntile % pg8::NXCD;
        const int tcnt = tq + (xg < tr ? 1 : 0), tstart = xg * tq + (xg < tr ? xg : tr);
        if (off >= tcnt * npn) return false;
        const int tile = tstart + off / npn, pn = off % npn;
        const int lane = lane_;
        const bool hit = (tile >= ts[lane]) && (tile < ts[lane + 1]);
        const unsigned long long mk = __ballot(hit);
        const int e = mk ? (int)__builtin_ctzll(mk) : 64;
        u.pm = tile; u.pn = pn;
        u.bptr = (e < 64 ? Bexp + (size_t)e * bstride : Bsh) + (size_t)pn * 256 * ldb;
        u.roff = -(tile * 256) - 1; u.nvalid = 256;
        return true;
    }
    __device__ __forceinline__ int arow(const pg8::Unit& u, int r) const { return -u.roff - 1 + r; }
    __device__ __forceinline__ int acolb(const pg8::Unit&) const { return 0; }
    __device__ __forceinline__ float rowscale(const pg8::Unit&, int) const { return 1.0f; }
};

__device__ __forceinline__ void p0_transpose_item64(const float* W, int K, int N, bf16* WT, int dst_n0, LAS float* scr, int kb, int nb, int lane, const float wsc) {
    const int k0 = 64 * kb, n0 = 64 * nb; const int r = lane >> 4, c4 = lane & 15;
    f32x4 v[16];
#pragma unroll
    for (int i = 0; i < 16; ++i) v[i] = __builtin_nontemporal_load((const GAS f32x4*)(W + (size_t)(k0 + 4 * i + r) * N + n0 + 4 * c4));
#pragma unroll
    for (int i = 0; i < 16; ++i) { const int k = 4 * i + r; *(LAS f32x4*)(scr + k * 64 + 4 * (c4 ^ (k >> 3))) = v[i]; }
    LDS_WAIT(); asm volatile("" ::: "memory");
    const int c = lane & 7;
#pragma unroll
    for (int j = 0; j < 8; ++j) { const int n = (lane >> 3) + 8 * j; const LAS float* sp = scr + (8 * c) * 64 + 4 * ((n >> 2) ^ c) + (n & 3);
        u32x4 o; o.x = pk2(sp[0 * 64] * wsc, sp[1 * 64] * wsc); o.y = pk2(sp[2 * 64] * wsc, sp[3 * 64] * wsc); o.z = pk2(sp[4 * 64] * wsc, sp[5 * 64] * wsc); o.w = pk2(sp[6 * 64] * wsc, sp[7 * 64] * wsc);
        *(GAS u32x4*)(WT + (size_t)(dst_n0 + n) * K + k0 + 8 * c) = o; }
    LDS_WAIT(); asm volatile("" ::: "memory");
}
__device__ __forceinline__ void p0_transpose_item64_f8(const float* W, int K, int N, unsigned char* WT, int dst_n0, LAS float* scr, int kb, int nb, int lane, const float wsc) {
    const int k0 = 64 * kb, n0 = 64 * nb; const int r = lane >> 4, c4 = lane & 15;
    f32x4 v[16];
#pragma unroll
    for (int i = 0; i < 16; ++i) v[i] = __builtin_nontemporal_load((const GAS f32x4*)(W + (size_t)(k0 + 4 * i + r) * N + n0 + 4 * c4));
#pragma unroll
    for (int i = 0; i < 16; ++i) { const int k = 4 * i + r; *(LAS f32x4*)(scr + k * 64 + 4 * (c4 ^ (k >> 3))) = v[i]; }
    LDS_WAIT(); asm volatile("" ::: "memory");
    const int c = lane & 3;
#pragma unroll
    for (int j = 0; j < 4; ++j) { const int n = (lane >> 2) + 16 * j;
        unsigned o[4];
#pragma unroll
        for (int d = 0; d < 4; ++d) { float f[4];
#pragma unroll
            for (int e = 0; e < 4; ++e) { const int k = 16 * c + 4 * d + e; f[e] = scr[k * 64 + 4 * ((n >> 2) ^ (k >> 3)) + (n & 3)] * wsc; }
            int p = __builtin_amdgcn_cvt_pk_fp8_f32(f[0], f[1], 0, false); p = __builtin_amdgcn_cvt_pk_fp8_f32(f[2], f[3], p, true); o[d] = (unsigned)p; }
        u32x4 ov; ov.x = o[0]; ov.y = o[1]; ov.z = o[2]; ov.w = o[3];
        *(GAS u32x4*)(WT + (size_t)(dst_n0 + n) * K + k0 + 16 * c) = ov; }
    LDS_WAIT(); asm volatile("" ::: "memory");
}
__device__ __forceinline__ void p0_router_item(const float* W, bf16* WH, bf16* WLo, LAS float* scr, int kb, int nb, int lane) {
    const int K = 1024, N = 64; const int k0 = 64 * kb, n0 = 32 * nb;
#pragma unroll 8
    for (int i = 0; i < 32; ++i) { const int kk = 2 * i + (lane >> 5); scr[kk * 33 + (lane & 31)] = W[(size_t)(k0 + kk) * N + n0 + (lane & 31)]; }
    LDS_WAIT(); asm volatile("" ::: "memory");
    const int c = lane & 7;
#pragma unroll
    for (int j = 0; j < 4; ++j) { const int n = (lane >> 3) + 8 * j; const LAS float* s = scr + (8 * c) * 33 + n;
        unsigned h[8], l[8];
#pragma unroll
        for (int q = 0; q < 8; ++q) { const float v = s[q * 33]; h[q] = f2bf(v); l[q] = f2bf(v - bf2f(h[q])); }
        u32x4 oh, ol; oh.x = h[0] | (h[1] << 16); oh.y = h[2] | (h[3] << 16); oh.z = h[4] | (h[5] << 16); oh.w = h[6] | (h[7] << 16);
        ol.x = l[0] | (l[1] << 16); ol.y = l[2] | (l[3] << 16); ol.z = l[4] | (l[5] << 16); ol.w = l[6] | (l[7] << 16);
        *(GAS u32x4*)(WH + (size_t)(n0 + n) * K + k0 + 8 * c) = oh; *(GAS u32x4*)(WLo + (size_t)(n0 + n) * K + k0 + 8 * c) = ol; }
    LDS_WAIT(); asm volatile("" ::: "memory");
}

__device__ __forceinline__ void p0_prologue(Frame& F) {
    LAS float* cs = (LAS float*)(F.lds);
    LAS float* part = (LAS float*)(F.lds + 32768);
    const float* c = inp(F, 1);
    for (int i = F.tid; i < 8 * 1024; i += 512) { const float v = c[i]; cs[i] = v / (1.0f + __expf(-v)); }
    __syncthreads();
    float* mod = (float*)(F.ws + WS_MOD);
    for (int it = F.vcu; it < 4 * 96; it += F.G) {
        const int layer = it / 96, slab = it % 96; const int col = slab * 64 + F.lane;
        const float* W = inp(F, 2) + (size_t)layer * 1024 * 6144 + col;
        float a[8];
#pragma unroll
        for (int b = 0; b < 8; ++b) a[b] = 0.f;
        const int k0 = F.wave * 128;
#pragma unroll 4
        for (int k = 0; k < 128; k += 4) {
            float w[4];
#pragma unroll
            for (int j = 0; j < 4; ++j) w[j] = W[(size_t)(k0 + k + j) * 6144];
#pragma unroll
            for (int b = 0; b < 8; ++b) { const f32x4 cv = *(const LAS f32x4*)(cs + b * 1024 + k0 + k); a[b] += cv[0] * w[0] + cv[1] * w[1] + cv[2] * w[2] + cv[3] * w[3]; }
        }
#pragma unroll
        for (int b = 0; b < 8; ++b) part[(F.wave * 8 + b) * 64 + F.lane] = a[b];
        __syncthreads();
        { const int b = F.wave; float s = 0.f;
#pragma unroll
          for (int w = 0; w < 8; ++w) s += part[(w * 8 + b) * 64 + F.lane];
          mod[((size_t)layer * 8 + b) * 6144 + col] = s + inp(F, 3)[layer * 6144 + col]; }
        __syncthreads();
    }
    __syncthreads();
    LAS float* scr = (LAS float*)(F.lds + F.wave * 16384);
    const int gw = F.vcu * NWAVES + F.wave, NGW = F.G * NWAVES;
    constexpr int I_PIN = 2 * 16 * 16, I_GRP = 8 * 4 * 4, I_POUT = I_PIN, I_AIN = 2 * 16 * 144, I_AOUT = I_PIN, I_SHGU = 4 * 16 * 8, I_SHDN = 4 * 4 * 16, I_R = 4 * 16 * 2;
    constexpr int I_EGU = 256 * 16 * 8, I_EDN = 256 * 4 * 16;
    constexpr int NITEMS = I_PIN + I_GRP + I_POUT + I_AIN + I_AOUT + I_SHGU + I_SHDN + I_R + I_EGU + I_EDN;
    for (int it = gw; it < NITEMS; it += NGW) {
        int r = it;
#define P0_GROUP(CNT, SRC, KK, NN, DST, GU) if (r < (CNT)) { const int per = ((KK) / 64) * ((NN) / 64), mat = r / per, q = r % per, nblk = (NN) / 64, kblk = (KK) / 64, nb = q / kblk, kb = q % kblk; (void)nblk; \
            int dn0 = 64 * nb; if ((GU) == 1 || (GU) == 4) { const int n0 = 64 * nb; dn0 = (n0 < 256) ? ((n0 >> 7) * 256 + (n0 & 127)) : (((n0 - 256) >> 7) * 256 + 128 + ((n0 - 256) & 127)); } \
            if ((GU) >= 4) { p0_transpose_item64_f8((SRC) + (size_t)mat * (KK) * (NN), (KK), (NN), (unsigned char*)(F.ws + (DST)) + (size_t)mat * (KK) * (NN), dn0, scr, kb, nb, F.lane, \
                ((GU) == 5 && ((((64 * nb) >> 10) % 3) == 0)) ? WGU_SCALE * LOG2E : (((GU) == 7) ? 512.0f : WGU_SCALE)); continue; } \
            p0_transpose_item64((SRC) + (size_t)mat * (KK) * (NN), (KK), (NN), (bf16*)(F.ws + (DST)) + (size_t)mat * (KK) * (NN), dn0, scr, kb, nb, F.lane, ((GU) == 2) ? (((((64 * nb) >> 10) % 3) == 0) ? QSCALE * 64.0f : 16.0f) : (((GU) == 3) ? 32.0f : 1.0f)); continue; } r -= (CNT);
        P0_GROUP(I_PIN, inp(F, 4), 1024, 1024, WS_WPIN, 8)
        P0_GROUP(I_GRP, inp(F, 5), 256, 256, WS_WPGRP, 0)
        P0_GROUP(I_POUT, inp(F, 7), 1024, 1024, WS_WPOUT, 7)
        P0_GROUP(I_AIN, inp(F, 8), 1024, 9216, WS_WAIN, 5)
        P0_GROUP(I_AOUT, inp(F, 9), 1024, 1024, WS_WAOUT, 7)
        P0_GROUP(I_SHGU, inp(F, 16), 1024, 512, WS_WSHGU, 4)
        P0_GROUP(I_SHDN, inp(F, 17), 256, 1024, WS_WSHDN, 6)
        if (r < I_R) { const int mat = r / 32, q = r % 32, kb = q / 2, nb = q % 2;
            p0_router_item(inp(F, 12) + (size_t)mat * 65536, (bf16*)(F.ws + WS_WRHI) + (size_t)mat * 65536, (bf16*)(F.ws + WS_WRLO) + (size_t)mat * 65536, scr, kb, nb, F.lane); continue; } r -= I_R;
        P0_GROUP(I_EGU, inp(F, 14), 1024, 512, WS_WEGU, 4)
        P0_GROUP(I_EDN, inp(F, 15), 256, 1024, WS_WEDN, 6)
#undef P0_GROUP
    }
}

__device__ __forceinline__ void p1_modulate(Frame& F, const float* x, const float* modl  , int sh_off, int sc_off) {
    unsigned char* H8 = (unsigned char*)(F.ws + WS_H);
    const int gw = F.vcu * NWAVES + F.wave, NGW = F.G * NWAVES;
    for (int m = gw; m < T; m += NGW) {
        const int b = m / SEQ; const float* mb = modl + (size_t)b * 6144;
        const GAS f32x4* xr = (const GAS f32x4*)(x + (size_t)m * D) + F.lane;
        GAS unsigned* o8 = (GAS unsigned*)(H8 + (size_t)m * D) + F.lane;
#pragma unroll
        for (int j = 0; j < 4; ++j) { const f32x4 v = xr[64 * j]; const f32x4 sc = *(const f32x4*)(mb + sc_off + 4 * F.lane + 256 * j), sh = *(const f32x4*)(mb + sh_off + 4 * F.lane + 256 * j);
            f32x4 h = (v * (sc + 1.0f) + sh) * H8_SCALE;
#pragma unroll
            for (int e = 0; e < 4; ++e) h[e] = __builtin_amdgcn_fmed3f(h[e], -448.0f, 448.0f);
            int p = __builtin_amdgcn_cvt_pk_fp8_f32(h[0], h[1], 0, false); p = __builtin_amdgcn_cvt_pk_fp8_f32(h[2], h[3], p, true); o8[64 * j] = (unsigned)p; }
    }
}

template <int W>
__device__ __forceinline__ void pool_item(const bf16* U, bf16* Z, int b, int t0, int g, int lane) {
    const size_t base = (size_t)b * SEQ * D + 256 * g + 4 * lane;
    float s[4] = {0.f, 0.f, 0.f, 0.f};
#pragma unroll
    for (int j = 1; j <= W; ++j) { const int t = t0 - j; if (t >= 0) { const u32x2 v = *(const GAS u32x2*)(U + base + (size_t)t * D);
            s[0] += bf2f(v.x & 0xffffu); s[1] += bf2f(v.x >> 16); s[2] += bf2f(v.y & 0xffffu); s[3] += bf2f(v.y >> 16); } }
#pragma unroll 8
    for (int i = 0; i < 32; ++i) { const int t = t0 + i;
        const u32x2 v = *(const GAS u32x2*)(U + base + (size_t)t * D);
        const float c0 = bf2f(v.x & 0xffffu), c1 = bf2f(v.x >> 16), c2 = bf2f(v.y & 0xffffu), c3 = bf2f(v.y >> 16);
        s[0] += c0; s[1] += c1; s[2] += c2; s[3] += c3;
        if (t - W >= 0) { const u32x2 o = *(const GAS u32x2*)(U + base + (size_t)(t - W) * D);
            s[0] -= bf2f(o.x & 0xffffu); s[1] -= bf2f(o.x >> 16); s[2] -= bf2f(o.y & 0xffffu); s[3] -= bf2f(o.y >> 16); }
        const float inv = 1.0f / (float)((t + 1) < W ? (t + 1) : W);
        u32x2 w; w.x = pk2(s[0] * inv - c0, s[1] * inv - c1); w.y = pk2(s[2] * inv - c2, s[3] * inv - c3);
        *(GAS u32x2*)(Z + base + (size_t)t * D) = w; }
}

__device__ __forceinline__ void moe_build_table(Frame& F, int layer) {
    LAS int* ts = (LAS int*)(F.lc + LC_TS); LAS int* cn = (LAS int*)(F.lc + LC_CNT);
    __syncthreads();
    if (F.wave == 0) {
        const int c = (int)__hip_atomic_load(F.ctl + CW_CNT + layer * 64 + F.lane, RLX_AGENT);
        int t = (c + 255) >> 8;
#pragma unroll
        for (int o = 1; o < 64; o <<= 1) { const int v = __shfl_up(t, o); if (F.lane >= o) t += v; }
        cn[F.lane] = c; ts[F.lane + 1] = t;
        if (F.lane == 0) ts[0] = 0;
        if (F.lane == 63) ts[65] = t + 64;
    }
    __syncthreads();
}

#ifdef PROBE_TYPE
#define LSTAMP(ty) do { if (blockIdx.x == 0 && F.tid == 0) { const unsigned long long now_ = __builtin_amdgcn_s_memrealtime(); LAS unsigned long long* st_ = (LAS unsigned long long*)(F.lc + 3072); \
        st_[1 + (ty)] += now_ - st_[20]; st_[20] = now_; } } while (0)
#define LSTAMP0() do { if (blockIdx.x == 0 && F.tid == 0) { ((LAS unsigned long long*)(F.lc + 3072))[20] = __builtin_amdgcn_s_memrealtime(); } } while (0)
#else
#define LSTAMP(ty) do { } while (0)
#define LSTAMP0() do { } while (0)
#endif
constexpr int APITCH = 1032;
#define LDS_ONLY_BARRIER() do { asm volatile("s_waitcnt lgkmcnt(0)" ::: "memory"); __builtin_amdgcn_s_barrier(); asm volatile("" ::: "memory"); } while (0)
template <bool X16>
__device__ __forceinline__ void ln1_router_phase(Frame& F, int layer, const float* xin) {
    const bool Y8 = X16 && ((layer & 1) != 0);
    bf16* X = (bf16*)(F.ws + WS_X);
    unsigned char* H8 = (unsigned char*)(F.ws + WS_U); const bf16* Y = (const bf16*)(F.ws + WS_Y);
    const float* modl = (const float*)(F.ws + WS_MOD) + (size_t)layer * 8 * 6144;
    const float* lg = inp(F, 10) + layer * D; const float* lb = inp(F, 11) + layer * D;
    const float* rb = inp(F, 13) + layer * NE;
    const bf16* WH = (const bf16*)(F.ws + WS_WRHI) + (size_t)layer * 65536; const bf16* WLo = (const bf16*)(F.ws + WS_WRLO) + (size_t)layer * 65536;
    int* tokl = (int*)(F.ws + WS_TOKL); float* wl = (float*)(F.ws + WS_WL); int* tslot = (int*)(F.ws + WS_TSLOT);
    unsigned* gcnt = F.ctl + CW_CNT + layer * 64;
    LAS bf16* Ahi = (LAS bf16*)F.lds; LAS bf16* Alo = Ahi + 32 * APITCH;
    LAS float* PART = (LAS float*)F.lds;
    LAS float* PV = (LAS float*)(F.lds + LDS_TB_OFF);
    LAS int* lcnt = (LAS int*)(F.lc + LC_LCNT); LAS int* gb = (LAS int*)(F.lc + LC_GB);
    const int lane = F.lane, wave = F.wave;
    const int nblk = (T / 32) / F.G;
#define LN1_BLK(bi_) ((F.G == 256) ? ((F.vcu >> 5) * 64 + (F.vcu & 31) * 2 + (bi_)) : (F.vcu + (bi_) * F.G))
    constexpr int NX = X16 ? 2 : 4;
    u32x4 xr[4][NX], yv[4][2];
#define LN1_LOAD(bi_) do { const int t0_ = LN1_BLK(bi_) * 32 + wave * 4; \
        _Pragma("unroll") for (int q = 0; q < 4; ++q) _Pragma("unroll") for (int j = 0; j < 2; ++j) { const size_t o_ = (size_t)(t0_ + q) * D + 8 * lane + 512 * j; \
            if constexpr (X16) xr[q][j] = __builtin_nontemporal_load((const GAS u32x4*)((const bf16*)xin + o_)); \
            else { xr[q][2 * j] = *(const GAS u32x4*)(xin + o_); xr[q][2 * j + 1] = *(const GAS u32x4*)(xin + o_ + 4); } \
            if (Y8) { const pg8::u32x2_t y8_ = __builtin_nontemporal_load((const GAS pg8::u32x2_t*)((const unsigned char*)Y + o_)); yv[q][j] = (u32x4){y8_.x, y8_.y, 0u, 0u}; } \
            else yv[q][j] = __builtin_nontemporal_load((const GAS u32x4*)(Y + o_)); } } while (0)
    LN1_LOAD(0);
    const float rbe = rb[lane];
    { const int b = (LN1_BLK(0) * 32) / SEQ; const float* mb = modl + (size_t)b * 6144;
      for (int i = F.tid; i < 1024; i += NWAVES * 64) { const int v = i >> 8, c4 = (i & 255) * 4;
          const float* src = (v == 0) ? lg : (v == 1) ? lb : (v == 2) ? (mb + 4096) : (mb + 3072);
          f32x4 t = *(const GAS f32x4*)(src + c4); if (v == 2) t = t + 1.0f; *(LAS f32x4*)(PV + v * 1024 + c4) = t; } }
    __syncthreads();
    for (int bi = 0; bi < nblk; ++bi) {
        const int blk = LN1_BLK(bi);
        const int tok0 = blk * 32;
        LSTAMP0();
        bf16x8 bh[8][2], bl[8][2];
        {
            const int b = tok0 / SEQ; const float* mb = modl + (size_t)b * 6144;
            f32x4 xv[4][4];
            f32x4 pg1[4];
#pragma unroll
            for (int jj = 0; jj < 4; ++jj) pg1[jj] = (*(const GAS f32x4*)(mb + 2048 + 8 * lane + 512 * (jj >> 1) + 4 * (jj & 1)) + 1.0f) * (Y8 ? (1.0f / 32.0f) : 1.0f);
            float sm[4];
#pragma unroll
            for (int q = 0; q < 4; ++q) { float s = 0.f;
#pragma unroll
                for (int jj = 0; jj < 4; ++jj) { const unsigned w0 = (jj & 1) ? yv[q][jj >> 1].z : yv[q][jj >> 1].x, w1 = (jj & 1) ? yv[q][jj >> 1].w : yv[q][jj >> 1].y;
                    f32x4 y4;
                    if (Y8) { const unsigned wq = (jj & 1) ? yv[q][jj >> 1].y : yv[q][jj >> 1].x; const f32x2 ya = __builtin_amdgcn_cvt_pk_f32_fp8((int)wq, false), yb = __builtin_amdgcn_cvt_pk_f32_fp8((int)wq, true); y4 = (f32x4){ya[0], ya[1], yb[0], yb[1]}; }
                    else { y4[0] = h2f(w0 & 0xffffu); y4[1] = h2f(w0 >> 16); y4[2] = h2f(w1 & 0xffffu); y4[3] = h2f(w1 >> 16); }
                    f32x4 x4;
                    if constexpr (X16) { const unsigned v0 = (jj & 1) ? xr[q][jj >> 1].z : xr[q][jj >> 1].x, v1 = (jj & 1) ? xr[q][jj >> 1].w : xr[q][jj >> 1].y;
                        x4 = (f32x4){h2f(v0 & 0xffffu), h2f(v0 >> 16), h2f(v1 & 0xffffu), h2f(v1 >> 16)}; }
                    else { const u32x4 v = xr[q][jj]; x4 = (f32x4){__uint_as_float(v.x), __uint_as_float(v.y), __uint_as_float(v.z), __uint_as_float(v.w)}; }
                    xv[q][jj] = x4 * ALPHA + pg1[jj] * y4; s += (xv[q][jj][0] + xv[q][jj][1]) + (xv[q][jj][2] + xv[q][jj][3]); }
                sm[q] = s; }
#pragma unroll
            for (int o = 1; o < 64; o <<= 1) {
#pragma unroll
                for (int q = 0; q < 4; ++q) sm[q] += __shfl_xor(sm[q], o); }
            float s2[4];
#pragma unroll
            for (int q = 0; q < 4; ++q) { const float mean = sm[q] * (1.f / D); float t = 0.f;
#pragma unroll
                for (int jj = 0; jj < 4; ++jj) { xv[q][jj] = xv[q][jj] - mean; t += (xv[q][jj][0] * xv[q][jj][0] + xv[q][jj][1] * xv[q][jj][1]) + (xv[q][jj][2] * xv[q][jj][2] + xv[q][jj][3] * xv[q][jj][3]); }
                s2[q] = t; }
#pragma unroll
            for (int o = 1; o < 64; o <<= 1) {
#pragma unroll
                for (int q = 0; q < 4; ++q) s2[q] += __shfl_xor(s2[q], o); }
            LAS float* pvb = PV + 8 * lane; asm volatile("" : "+v"(pvb));
            unsigned h8lo[4];
#pragma unroll
            for (int jj = 0; jj < 4; ++jj) { const int col = 8 * lane + 512 * (jj >> 1) + 4 * (jj & 1); const int co = 512 * (jj >> 1) + 4 * (jj & 1);
                const f32x4 gg = *(const LAS f32x4*)(pvb + co), bb = *(const LAS f32x4*)(pvb + 1024 + co), sc2 = *(const LAS f32x4*)(pvb + 2048 + co), sh2 = *(const LAS f32x4*)(pvb + 3072 + co);
#pragma unroll
                for (int q = 0; q < 4; ++q) { const int rl = wave * 4 + q, tok = tok0 + rl; const float rstd = 1.0f / sqrtf(s2[q] * (1.f / D) + LN_EPS);
                    const f32x4 xn = xv[q][jj] * rstd * gg + bb; { u32x2 xw; xw.x = pkh2(xn[0], xn[1]); xw.y = pkh2(xn[2], xn[3]); *(GAS u32x2*)(X + (size_t)tok * D + col) = xw; }
                    const f32x4 hf = xn * sc2 + sh2;
                    unsigned hh[4], ll[4];
#pragma unroll
                    for (int e = 0; e < 4; ++e) { hh[e] = f2bf(hf[e]); ll[e] = f2bf(hf[e] - bf2f(hh[e])); }
                    u32x2 wh, wlo; wh.x = hh[0] | (hh[1] << 16); wh.y = hh[2] | (hh[3] << 16); wlo.x = ll[0] | (ll[1] << 16); wlo.y = ll[2] | (ll[3] << 16);
                    { f32x4 h8_ = hf * H8_SCALE;
#pragma unroll
                      for (int e = 0; e < 4; ++e) h8_[e] = __builtin_amdgcn_fmed3f(h8_[e], -448.0f, 448.0f);
                      int p8 = __builtin_amdgcn_cvt_pk_fp8_f32(h8_[0], h8_[1], 0, false); p8 = __builtin_amdgcn_cvt_pk_fp8_f32(h8_[2], h8_[3], p8, true);
                      if ((jj & 1) == 0) h8lo[q] = (unsigned)p8; else { u32x2 w8; w8.x = h8lo[q]; w8.y = (unsigned)p8; *(GAS u32x2*)(H8 + (size_t)tok * D + 8 * lane + 512 * (jj >> 1)) = w8; } }
                    *(LAS u32x2*)(Ahi + rl * APITCH + col) = wh; *(LAS u32x2*)(Alo + rl * APITCH + col) = wlo; } }
        }
        __builtin_amdgcn_sched_barrier(0);
        {
            const int r32 = lane & 31, hi = lane >> 5;
#pragma unroll
            for (int nb = 0; nb < 2; ++nb) {
                const GAS bf16* ph = (const GAS bf16*)WH + (size_t)(r32 + 32 * nb) * 1024 + wave * 128 + hi * 8; const GAS bf16* pl = (const GAS bf16*)WLo + (size_t)(r32 + 32 * nb) * 1024 + wave * 128 + hi * 8;
                asm volatile("" : "+v"(ph), "+v"(pl));
#pragma unroll
                for (int ks = 0; ks < 8; ++ks) { bh[ks][nb] = *(const GAS bf16x8*)(ph + ks * 16); bl[ks][nb] = *(const GAS bf16x8*)(pl + ks * 16); } }
        }
        __syncthreads();
        LSTAMP(13);
        f32x16 acc[2]; acc[0] = (f32x16){}; acc[1] = (f32x16){};
        {
            const int r32 = lane & 31, hi = lane >> 5;
#pragma unroll
            for (int ks = 0; ks < 8; ++ks) {
                const int k = wave * 128 + ks * 16 + hi * 8;
                const bf16x8 ah = *(const LAS bf16x8*)(Ahi + r32 * APITCH + k), al = *(const LAS bf16x8*)(Alo + r32 * APITCH + k);
#pragma unroll
                for (int nb = 0; nb < 2; ++nb) {
                    acc[nb] = MFMA32(ah, bh[ks][nb], acc[nb]);
                    acc[nb] = MFMA32(al, bh[ks][nb], acc[nb]);
                    acc[nb] = MFMA32(ah, bl[ks][nb], acc[nb]);
                }
            }
        }
        LDS_ONLY_BARRIER();
        {
            const int r32 = lane & 31, hi = lane >> 5;
#pragma unroll
            for (int nb = 0; nb < 2; ++nb)
#pragma unroll
                for (int r = 0; r < 16; ++r) { const int trow = (r & 3) + 8 * (r >> 2) + 4 * hi; PART[(wave * 32 + trow) * 64 + 32 * nb + r32] = acc[nb][r]; }
        }
        if (F.tid < 64) lcnt[F.tid] = 0;
        LDS_ONLY_BARRIER();
        LSTAMP(14);
        if (bi + 1 < nblk) LN1_LOAD(bi + 1);
        else {
#pragma unroll
            for (int q = 0; q < 4; ++q) {
#pragma unroll
                for (int j = 0; j < NX; ++j) xr[q][j] = (u32x4){0u, 0u, 0u, 0u};
#pragma unroll
                for (int j = 0; j < 2; ++j) yv[q][j] = (u32x4){0u, 0u, 0u, 0u}; } }
        int chosen_m = 0; int posl[4]; float wv[4]; int rk[4];
        unsigned key[4]; float sgv[4];
#pragma unroll
        for (int q = 0; q < 4; ++q) {
            const int rl = wave * 4 + q;
            float logit = 0.f;
#pragma unroll
            for (int w = 0; w < 8; ++w) logit += PART[(w * 32 + rl) * 64 + lane];
            const float sg = 1.0f / (1.0f + __expf(-logit));
            const float sel = sg + rbe;
            float m1 = sel; m1 = fmaxf(m1, __shfl_xor(m1, 1)); m1 = fmaxf(m1, __shfl_xor(m1, 2)); m1 = fmaxf(m1, __shfl_xor(m1, 4));
            const unsigned long long bal = __ballot(sel == m1);
            const unsigned long long gm = bal & (0xFFull << (8 * (lane >> 3)));
            const int first = (int)__builtin_ctzll(gm);
            float m2 = (lane == first) ? -INFINITY : sel; m2 = fmaxf(m2, __shfl_xor(m2, 1)); m2 = fmaxf(m2, __shfl_xor(m2, 2)); m2 = fmaxf(m2, __shfl_xor(m2, 4));
            const float gs = m1 + m2;
            int rg = 0;
#pragma unroll
            for (int g2 = 0; g2 < 8; ++g2) { const float v = __builtin_bit_cast(float, __builtin_amdgcn_readlane(__builtin_bit_cast(int, gs), 8 * g2)); rg += ((v > gs) || (v == gs && g2 < (lane >> 3))) ? 1 : 0; }
            const bool gsel = rg < 4;
            const float msel = gsel ? sel : -INFINITY;
            const unsigned mb_ = __float_as_uint(msel); key[q] = (mb_ & 0x80000000u) ? ~mb_ : (mb_ | 0x80000000u); sgv[q] = sg;
        }
        unsigned tau[4] = {0u, 0u, 0u, 0u};
#pragma unroll 1
        for (int bit = 31; bit >= 0; --bit) {
#pragma unroll
            for (int q = 0; q < 4; ++q) { const unsigned cand = tau[q] | (1u << bit); const int cnt = (int)__popcll(__ballot(key[q] >= cand)); tau[q] = (cnt >= TOPK) ? cand : tau[q]; } }
#pragma unroll
        for (int q = 0; q < 4; ++q) {
            const unsigned long long gtm = __ballot(key[q] > tau[q]), eqm = __ballot(key[q] == tau[q]);
            const int need = TOPK - (int)__popcll(gtm);
            const unsigned long long below = (1ull << lane) - 1ull;
            const bool ch = (key[q] > tau[q]) || ((key[q] == tau[q]) && ((int)__popcll(eqm & below) < need));
            const unsigned long long chm = __ballot(ch);
            const int rank = (int)__popcll(chm & below);
            const float wsum = wave_sum(ch ? sgv[q] : 0.f);
            wv[q] = sgv[q] / wsum * ROUTED_SCALE; rk[q] = rank; posl[q] = 0;
            if (ch) { chosen_m |= (1 << q); posl[q] = __hip_atomic_fetch_add(lcnt + lane, 1, __ATOMIC_RELAXED, __HIP_MEMORY_SCOPE_WORKGROUP); }
        }
        LDS_ONLY_BARRIER();
        LSTAMP(15);
        if (wave == 0) { const int n = lcnt[lane]; int base = 0; if (n > 0) base = (int)__hip_atomic_fetch_add(gcnt + lane, (unsigned)n, RLX_AGENT); gb[lane] = base; }
        LDS_ONLY_BARRIER();
        {
            const int base = gb[lane];
#pragma unroll
            for (int q = 0; q < 4; ++q) if (chosen_m & (1 << q)) { const int tok = tok0 + wave * 4 + q; const int pos = base + posl[q];
                tokl[(size_t)lane * CAP + pos] = tok; wl[(size_t)tok * 8 + rk[q]] = wv[q]; tslot[(size_t)tok * 8 + rk[q]] = lane * CAP + pos; }
        }
        LDS_ONLY_BARRIER();
        LSTAMP(16);
    }
#undef LN1_LOAD
#undef LN1_BLK
}

__device__ __forceinline__ void combine_ln2_phase(Frame& F, int layer) {
    bf16* X = (bf16*)(F.ws + WS_X); bf16* H = (bf16*)(F.ws + WS_H); const unsigned char* YS = (const unsigned char*)(F.ws + WS_YS);
    const float* modl = (const float*)(F.ws + WS_MOD) + (size_t)layer * 8 * 6144;
    const float* modn = (const float*)(F.ws + WS_MOD) + (size_t)(layer + 1) * 8 * 6144;
    const float* lg = inp(F, 18) + layer * D; const float* lb = inp(F, 19) + layer * D;
    const int* tslot = (const int*)(F.ws + WS_TSLOT);
    const LAS int* ts = (const LAS int*)(F.lc + LC_TS);
    const bool lastl = (layer == DEPTH - 1);
    unsigned char* H8 = (unsigned char*)(F.ws + WS_H);
    float* xout = (float*)inp(F, 20);
    const int lane = F.lane, wave = F.wave;
    LAS float* PV = (LAS float*)F.lds;
    const int shbase = ts[64] * 256;
    for (int blk = F.vcu; blk < T / 64; blk += F.G) {
        const int tokb = blk * 64, b = tokb / SEQ;
        __syncthreads();
        for (int i = F.tid; i < 1024; i += 512) { PV[i] = modl[(size_t)b * 6144 + 5120 + i] + 1.0f; PV[1024 + i] = lg[i]; PV[2048 + i] = lb[i];
            if (!lastl) { PV[3072 + i] = modn[(size_t)b * 6144 + 1024 + i] + 1.0f; PV[4096 + i] = modn[(size_t)b * 6144 + i]; } }
        __syncthreads();
        const int tw = tokb + wave * 8;
        int sv; { const int v = tslot[(size_t)tw * 8 + lane]; sv = ts[v >> 14] * 256 + (v & (CAP - 1)); }
        const float wvv = ((const float*)(F.ws + WS_WL))[(size_t)tw * 8 + lane] * (1.0f / 32.0f);
        pg8::u32x2_t ys[18]; u32x4 xs[2];
#define CB_LOAD(k) do { const int tok_ = tw + (k); _Pragma("unroll") for (int kk_ = 0; kk_ < 9; ++kk_) { const int slot_ = (kk_ < 8) ? __builtin_amdgcn_readlane(sv, 8 * (k) + kk_) : (shbase + tok_); \
            const unsigned char* yr_ = YS + (size_t)slot_ * D + 8 * lane; ys[2 * kk_] = __builtin_nontemporal_load((const GAS pg8::u32x2_t*)(yr_)); ys[2 * kk_ + 1] = __builtin_nontemporal_load((const GAS pg8::u32x2_t*)(yr_ + 512)); } \
            _Pragma("unroll") for (int j_ = 0; j_ < 2; ++j_) xs[j_] = __builtin_nontemporal_load((const GAS u32x4*)(X + (size_t)tok_ * D + 8 * lane + 512 * j_)); } while (0)
        CB_LOAD(0);
#pragma unroll 1
        for (int k = 0; k < 8; ++k) {
            const int tok_ = tw + k; f32x4 y_[4];
#pragma unroll
            for (int jj_ = 0; jj_ < 4; ++jj_) y_[jj_] = (f32x4){0.f, 0.f, 0.f, 0.f};
#pragma unroll
            for (int kk_ = 0; kk_ < 9; ++kk_) { const float wk_ = (kk_ < 8) ? __builtin_bit_cast(float, __builtin_amdgcn_readlane(__builtin_bit_cast(int, wvv), 8 * k + kk_)) : (1.0f / 32.0f);
#pragma unroll
                for (int j_ = 0; j_ < 2; ++j_) { const pg8::u32x2_t w_ = ys[2 * kk_ + j_];
                    const f32x2 a0_ = __builtin_amdgcn_cvt_pk_f32_fp8((int)w_.x, false), a1_ = __builtin_amdgcn_cvt_pk_f32_fp8((int)w_.x, true), b0_ = __builtin_amdgcn_cvt_pk_f32_fp8((int)w_.y, false), b1_ = __builtin_amdgcn_cvt_pk_f32_fp8((int)w_.y, true);
                    y_[2 * j_][0] += wk_ * a0_[0]; y_[2 * j_][1] += wk_ * a0_[1]; y_[2 * j_][2] += wk_ * a1_[0]; y_[2 * j_][3] += wk_ * a1_[1];
                    y_[2 * j_ + 1][0] += wk_ * b0_[0]; y_[2 * j_ + 1][1] += wk_ * b0_[1]; y_[2 * j_ + 1][2] += wk_ * b1_[0]; y_[2 * j_ + 1][3] += wk_ * b1_[1]; } }
            f32x4 v_[4]; float s_ = 0.f;
#pragma unroll
            for (int jj_ = 0; jj_ < 4; ++jj_) { const int col_ = 8 * lane + 512 * (jj_ >> 1) + 4 * (jj_ & 1); const f32x4 g2_ = *(const LAS f32x4*)(PV + col_);
                const unsigned w0_ = (jj_ & 1) ? xs[jj_ >> 1].z : xs[jj_ >> 1].x, w1_ = (jj_ & 1) ? xs[jj_ >> 1].w : xs[jj_ >> 1].y;
                const f32x4 x4_ = (f32x4){h2f(w0_ & 0xffffu), h2f(w0_ >> 16), h2f(w1_ & 0xffffu), h2f(w1_ >> 16)};
                v_[jj_] = x4_ * ALPHA + g2_ * y_[jj_]; s_ += (v_[jj_][0] + v_[jj_][1]) + (v_[jj_][2] + v_[jj_][3]); }
            asm volatile("" : "+v"(v_[0]), "+v"(v_[1]), "+v"(v_[2]), "+v"(v_[3]));
            __builtin_amdgcn_sched_barrier(0);
            { const int kn = (k + 1 < 8) ? k + 1 : k; CB_LOAD(kn); }
            __builtin_amdgcn_sched_barrier(0);
            const float mean_ = wave_sum(s_) * (1.f / D); float q_ = 0.f;
#pragma unroll
            for (int jj_ = 0; jj_ < 4; ++jj_) { v_[jj_] = v_[jj_] - mean_; q_ += (v_[jj_][0] * v_[jj_][0] + v_[jj_][1] * v_[jj_][1]) + (v_[jj_][2] * v_[jj_][2] + v_[jj_][3] * v_[jj_][3]); }
            const float rstd_ = 1.0f / sqrtf(wave_sum(q_) * (1.f / D) + LN_EPS);
            unsigned h8lo_ = 0u;
#pragma unroll
            for (int jj_ = 0; jj_ < 4; ++jj_) { const int col_ = 8 * lane + 512 * (jj_ >> 1) + 4 * (jj_ & 1);
                const f32x4 gg_ = *(const LAS f32x4*)(PV + 1024 + col_), bb_ = *(const LAS f32x4*)(PV + 2048 + col_);
                const f32x4 xn_ = v_[jj_] * rstd_ * gg_ + bb_;
                if (lastl) *(GAS f32x4*)(xout + (size_t)tok_ * D + col_) = xn_;
                else { u32x2 xw_; xw_.x = pkh2(xn_[0], xn_[1]); xw_.y = pkh2(xn_[2], xn_[3]); *(GAS u32x2*)(X + (size_t)tok_ * D + col_) = xw_; }
                if (!lastl) { const f32x4 sc_ = *(const LAS f32x4*)(PV + 3072 + col_), sh_ = *(const LAS f32x4*)(PV + 4096 + col_); const f32x4 hm_ = xn_ * sc_ + sh_;
                    {
                        f32x4 h8_ = hm_ * H8_SCALE;
#pragma unroll
                        for (int e_ = 0; e_ < 4; ++e_) h8_[e_] = __builtin_amdgcn_fmed3f(h8_[e_], -448.0f, 448.0f);
                        int p8_ = __builtin_amdgcn_cvt_pk_fp8_f32(h8_[0], h8_[1], 0, false); p8_ = __builtin_amdgcn_cvt_pk_fp8_f32(h8_[2], h8_[3], p8_, true);
                        if ((jj_ & 1) == 0) h8lo_ = (unsigned)p8_; else { u32x2 w8_; w8_.x = h8lo_; w8_.y = (unsigned)p8_; *(GAS u32x2*)(H8 + (size_t)tok_ * D + 8 * lane + 512 * (jj_ >> 1)) = w8_; } } } }
        }
#undef CB_LOAD
    }
}

constexpr int ACCP = 68;
__device__ __forceinline__ int crow(int r, int hi) { return (r & 3) + 8 * (r >> 2) + 4 * hi; }
constexpr int KPITCH = 144;
__device__ __forceinline__ u32x4 f8x8_to_bf16(unsigned a, unsigned b, float inv) {
    typedef __bf16 bfx2 __attribute__((ext_vector_type(2)));
    u32x4 r; r.x = __builtin_bit_cast(unsigned, (bfx2)__builtin_amdgcn_cvt_scalef32_pk_bf16_fp8(a, inv, false)); r.y = __builtin_bit_cast(unsigned, (bfx2)__builtin_amdgcn_cvt_scalef32_pk_bf16_fp8(a, inv, true));
    r.z = __builtin_bit_cast(unsigned, (bfx2)__builtin_amdgcn_cvt_scalef32_pk_bf16_fp8(b, inv, false)); r.w = __builtin_bit_cast(unsigned, (bfx2)__builtin_amdgcn_cvt_scalef32_pk_bf16_fp8(b, inv, true)); return r;
}
template <bool FIRST, int NB>
__device__ __forceinline__ void attn_task(const unsigned char* QKVb  , int g, int h, int dil, int cls, int q0, int QS, int kb0, int L, float slope2d,
                                          LAS unsigned char* stg  , LAS float* wsf  , LAS float* ACC, LAS float* ML, int trow_mul, int trow_add, int lane) {
    asm volatile("" : "+v"(lane));
    const int r32 = lane & 31, hi = lane >> 5, lr = lane >> 2, lc = lane & 3;
    const int qcol = ((g * 3 + 0) * 16 + h) * 64, kcol = ((g * 3 + 1) * 16 + h) * 64, vcol = ((g * 3 + 2) * 16 + h) * 64;
    const size_t rstride = (size_t)dil * NQKV;
    const unsigned char* base = QKVb + (size_t)cls * NQKV + lc * 16;
    const int jlo = (kb0 >= -31) ? 0 : ((-kb0) >> 5);
    const int qpos = q0 + QS * r32;
    const int dmax = qpos < 128 ? qpos : 128;
    const float half = 0.5f * (float)dmax;
#define AT_LOADROWS(dst, l0, ls, col) do { _Pragma("unroll") for (int i_ = 0; i_ < 2; ++i_) { int l_ = (l0) + (ls) * (16 * i_ + lr); l_ = l_ < 0 ? 0 : (l_ > L - 1 ? L - 1 : l_); \
        dst[i_] = *(const GAS u32x4*)(base + (size_t)l_ * rstride + (col)); } } while (0)
#define AT_PUTROWS(src, inv) do { _Pragma("unroll") for (int i_ = 0; i_ < 2; ++i_) { LAS unsigned char* p_ = stg + (16 * i_ + lr) * KPITCH + lc * 32; \
        *(LAS u32x4*)(p_) = f8x8_to_bf16(src[i_].x, src[i_].y, inv); *(LAS u32x4*)(p_ + 16) = f8x8_to_bf16(src[i_].z, src[i_].w, inv); } } while (0)
#define AT_GETFRAG(dst) do { _Pragma("unroll") for (int s_ = 0; s_ < 4; ++s_) dst[s_] = *(const LAS bf16x8*)(stg + r32 * KPITCH + 32 * s_ + 16 * hi); } while (0)
#define AT_LDSWAIT() asm volatile("s_waitcnt lgkmcnt(0)" ::: "memory")
#define AT_PUTRAW(src) do { _Pragma("unroll") for (int i_ = 0; i_ < 2; ++i_) *(LAS u32x4*)(stg + (16 * i_ + lr) * 80 + lc * 16) = src[i_]; } while (0)
#define AT_GETRAW(dst) do { const i32x4 lo_ = *(const LAS i32x4*)(stg + r32 * 80 + 32 * hi), hi_ = *(const LAS i32x4*)(stg + r32 * 80 + 32 * hi + 16); dst = __builtin_shufflevector(lo_, hi_, 0, 1, 2, 3, 4, 5, 6, 7); } while (0)
    u32x4 kr[2][2];
    i32x8 qf8;
    { u32x4 qr[2]; AT_LOADROWS(qr, q0, QS, qcol);
#pragma unroll
      for (int j = 0; j < NB; ++j) if (j == jlo) AT_LOADROWS(kr[j & 1], kb0 + 32 * j, 1, kcol);
      AT_PUTRAW(qr); AT_LDSWAIT(); AT_GETRAW(qf8); AT_LDSWAIT(); }
    f32x16 S[NB];
    float mx = -INFINITY;
#pragma unroll
    for (int j = 0; j < NB; ++j) {
        if (j >= jlo) {
            asm volatile("" ::: "memory");
            if (j < NB - 1) AT_LOADROWS(kr[(j + 1) & 1], kb0 + 32 * (j + 1), 1, kcol);
            AT_PUTRAW(kr[j & 1]);
            const float xd0 = (float)(qpos - kb0 - 32 * j - 4 * hi) - half;
            const bool inner = (q0 - kb0 - 32 * j - 31 >= 0) && (q0 + QS * 31 - kb0 - 32 * j <= 128) && (kb0 + 32 * j >= 0);
            f32x16 a;
            if (inner) {
                const float cb = -slope2d * xd0;
#pragma unroll
                for (int r = 0; r < 16; ++r) a[r] = __builtin_fmaf(slope2d, (float)((r & 3) + 8 * (r >> 2)), cb);
            } else {
                const f32x2 xd2 = {xd0, xd0}, ns2 = {-slope2d, -slope2d};
#pragma unroll
                for (int r = 0; r < 16; r += 2) { const f32x2 c2 = {(float)((r & 3) + 8 * (r >> 2)), (float)(((r + 1) & 3) + 8 * ((r + 1) >> 2))};
                    const f32x2 x2 = xd2 - c2, b2 = x2 * ns2;
                    a[r] = (__builtin_fabsf(x2[0]) <= half) ? b2[0] : -INFINITY; a[r + 1] = (__builtin_fabsf(x2[1]) <= half) ? b2[1] : -INFINITY; }
            }
            i32x8 kf8;
            AT_LDSWAIT(); AT_GETRAW(kf8); AT_LDSWAIT();
            a = __builtin_amdgcn_mfma_scale_f32_32x32x64_f8f6f4(kf8, qf8, a, 0, 0, 0, 0x797b, 1, 0x797b);
#pragma unroll
            for (int r = 0; r < 16; ++r) mx = fmaxf(mx, a[r]);
            S[j] = a;
        } else {
#pragma unroll
            for (int r = 0; r < 16; ++r) S[j][r] = -INFINITY;
        }
        __builtin_amdgcn_sched_barrier(0);
    }
    u32x4 vr[2][2];
#pragma unroll
    for (int j = 0; j < NB; ++j) if (j == jlo) AT_LOADROWS(vr[j & 1], kb0 + 32 * j, 1, vcol);
    { auto rr = __builtin_amdgcn_permlane32_swap(__float_as_uint(mx), __float_as_uint(mx), false, false);
      const unsigned r0 = rr[0], r1 = rr[1]; mx = fmaxf(__uint_as_float(r0), __uint_as_float(r1)); }
    const float mx_true = mx - slope2d * half;
    float lsum = 0.f;
    u32x4 P[NB][2];
#pragma unroll
    for (int j = 0; j < NB; ++j) {
        float p[16];
#pragma unroll
        for (int r = 0; r < 16; ++r) { p[r] = __builtin_amdgcn_exp2f(S[j][r] - mx); lsum += p[r]; }
#pragma unroll
        for (int ks = 0; ks < 2; ++ks) { P[j][ks].x = cvt_pk_bf16(p[8 * ks + 0], p[8 * ks + 1]); P[j][ks].y = cvt_pk_bf16(p[8 * ks + 2], p[8 * ks + 3]); P[j][ks].z = cvt_pk_bf16(p[8 * ks + 4], p[8 * ks + 5]); P[j][ks].w = cvt_pk_bf16(p[8 * ks + 6], p[8 * ks + 7]); }
        __builtin_amdgcn_sched_barrier(0);
    }
    { auto rr = __builtin_amdgcn_permlane32_swap(__float_as_uint(lsum), __float_as_uint(lsum), false, false);
      const unsigned r0 = rr[0], r1 = rr[1]; lsum = __uint_as_float(r0) + __uint_as_float(r1); }
    f32x16 o[2]; o[0] = (f32x16){}; o[1] = (f32x16){};
    const unsigned vrd = (unsigned)(((lane >> 4) & 1) * 32 + (lane & 3) * 8 + (4 * hi + ((lane & 15) >> 2)) * 64);
#pragma unroll
    for (int j = 0; j < NB; ++j) {
        if (j >= jlo) {
            asm volatile("" ::: "memory");
            if (j < NB - 1) AT_LOADROWS(vr[(j + 1) & 1], kb0 + 32 * (j + 1), 1, vcol);
#pragma unroll
            for (int i = 0; i < 2; ++i) { const int key = 16 * i + lr;
#pragma unroll
                for (int hf = 0; hf < 2; ++hf) { const int c8 = 2 * lc + hf; const u32x4 src = vr[j & 1][i];
                    *(LAS u32x4*)(stg + ((c8 >> 2) * 2 + (key >> 4)) * 1024 + (key & 15) * 64 + (c8 & 3) * 16) = f8x8_to_bf16(hf ? src.z : src.x, hf ? src.w : src.y, 1.0f / 16.0f); } }
            AT_LDSWAIT();
#pragma unroll
            for (int d0 = 0; d0 < 2; ++d0)
#pragma unroll
                for (int ks = 0; ks < 2; ++ks) {
                    LAS unsigned char* vp = stg + (d0 * 2 + ks) * 1024 + vrd;
                    const s16x4 lo = __builtin_bit_cast(s16x4, __builtin_amdgcn_ds_read_tr16_b64_v4i16((LAS s16x4*)(vp)));
                    const s16x4 hh = __builtin_bit_cast(s16x4, __builtin_amdgcn_ds_read_tr16_b64_v4i16((LAS s16x4*)(vp + 512)));
                    const bf16x8 vf = (bf16x8){lo[0], lo[1], lo[2], lo[3], hh[0], hh[1], hh[2], hh[3]};
                    o[d0] = MFMA32(__builtin_bit_cast(bf16x8, P[j][ks]), vf, o[d0]);
                }
            AT_LDSWAIT();
        }
        __builtin_amdgcn_sched_barrier(0);
    }
#undef AT_LOADROWS
#undef AT_PUTROWS
#undef AT_GETFRAG
#undef AT_PUTRAW
#undef AT_GETRAW
#undef AT_LDSWAIT
    if (hi == 0) { wsf[r32] = mx_true; wsf[32 + r32] = lsum; }
    asm volatile("s_waitcnt lgkmcnt(0)" ::: "memory");
    f32x4 mt4[4], lt4[4];
#pragma unroll
    for (int k = 0; k < 4; ++k) { mt4[k] = *(const LAS f32x4*)(wsf + 8 * k + 4 * hi); lt4[k] = *(const LAS f32x4*)(wsf + 32 + 8 * k + 4 * hi); }
    if (FIRST) {
#pragma unroll
        for (int r = 0; r < 16; ++r) { const int q = crow(r, hi); const int trow = q * trow_mul + trow_add;
            ACC[trow * ACCP + r32] = o[0][r]; ACC[trow * ACCP + 32 + r32] = o[1][r];
            if (r32 == 0) { ML[trow * 2] = mt4[r >> 2][r & 3]; ML[trow * 2 + 1] = lt4[r >> 2][r & 3]; } }
    } else {
        f32x2 ml[16]; float a0[16], a1[16];
#pragma unroll
        for (int r = 0; r < 16; ++r) { const int q = crow(r, hi); const int trow = q * trow_mul + trow_add;
            ml[r] = *(const LAS f32x2*)(ML + trow * 2); a0[r] = ACC[trow * ACCP + r32]; a1[r] = ACC[trow * ACCP + 32 + r32]; }
        asm volatile("s_waitcnt lgkmcnt(0)" ::: "memory");
#pragma unroll
        for (int r = 0; r < 16; ++r) { const int q = crow(r, hi); const int trow = q * trow_mul + trow_add;
            const float mt = mt4[r >> 2][r & 3], lt = lt4[r >> 2][r & 3], mo = ml[r][0], lo_ = ml[r][1];
            const float mn = fmaxf(mo, mt); const float fa = __builtin_amdgcn_exp2f(mo - mn), fb = __builtin_amdgcn_exp2f(mt - mn);
            ACC[trow * ACCP + r32] = a0[r] * fa + o[0][r] * fb; ACC[trow * ACCP + 32 + r32] = a1[r] * fa + o[1][r] * fb;
            if (r32 == 0) { ML[trow * 2] = mn; ML[trow * 2 + 1] = lo_ * fa + lt * fb; } }
    }
    asm volatile("s_waitcnt lgkmcnt(0)" ::: "memory");
}

__device__ __forceinline__ void attn_phase(Frame& F, bf16* MIX) {
    const unsigned char* QKV = (const unsigned char*)(F.ws + WS_QKV);
    LAS float* ACC = (LAS float*)F.lds;
    LAS float* ML = (LAS float*)(F.lds + 69632);
    LAS unsigned char* vst = F.lds + 73728 + F.wave * 4608;
    LAS float* wsf = (LAS float*)(F.lds + 73728 + 8 * 4608 + F.wave * 256);
    const int lane = F.lane, w = F.wave;
    for (int i = 0;; ++i) {
        if (i >= (BATCH * 16 * 8) / F.G) break;
        const int L0 = (F.G == 256) ? ((F.vcu >> 5) * 128 + i * 32 + (F.vcu & 31)) : (i * F.G + F.vcu);
        const int bh = L0 >> 3, ti = L0 & 7; int w4 = ti >> 1; const int c = ti & 1; if (i & 1) w4 = 3 - w4;
        const int b = bh >> 4, h = bh & 15, win0 = w4 * 512;
        const unsigned char* Qb = QKV + (size_t)b * SEQ * NQKV;
        const float sl0 = exp2f(-8.0f * (float)(0 * 16 + h + 1) / 48.0f) * LOG2E, sl1 = exp2f(-8.0f * (float)(1 * 16 + h + 1) / 48.0f) * LOG2E * 4.0f, sl2 = exp2f(-8.0f * (float)(2 * 16 + h + 1) / 48.0f) * LOG2E * 16.0f;
        LSTAMP0();
        attn_task<true, 6>(Qb, 0, h, 1, 0, win0 + 64 * w + c, 2, win0 + 64 * w - 128, SEQ, sl0, vst, wsf, ACC, ML, 1, 32 * w, lane);
        __syncthreads();
        LSTAMP(24);
        if (ATTN_GMASK & 2) { const int cls = c + 2 * (w & 1), lb = w >> 1, lq0 = 128 * w4 + 32 * lb; attn_task<false, 5>(Qb, 1, h, 4, cls, lq0, 1, lq0 - 128, SEQ / 4, sl1, vst, wsf, ACC, ML, 2, 64 * lb + (w & 1), lane); }
        __syncthreads();
        LSTAMP(25);
        if (ATTN_GMASK & 4) { const int cls = c + 2 * w, lq0 = 32 * w4; attn_task<false, 5>(Qb, 2, h, 16, cls, lq0, 1, lq0 - 128, SEQ / 16, sl2, vst, wsf, ACC, ML, 8, w, lane); }
        __syncthreads();
        LSTAMP(26);
        {
#pragma unroll
          for (int it = 0; it < 4; ++it) { const int trow = 32 * w + 8 * it + (lane >> 3), sg = lane & 7; const float inv = 1.0f / ML[trow * 2 + 1];
              const LAS f32x4* ap = (const LAS f32x4*)(ACC + trow * ACCP + sg * 8);
              unsigned char* op = (unsigned char*)MIX + (size_t)(b * SEQ + win0 + 2 * trow + c) * D + h * 64 + sg * 8;
              const float inv2 = inv * MIX8_SCALE; f32x4 a = ap[0] * inv2, bq = ap[1] * inv2;
#pragma unroll
              for (int e = 0; e < 4; ++e) { a[e] = __builtin_amdgcn_fmed3f(a[e], -448.0f, 448.0f); bq[e] = __builtin_amdgcn_fmed3f(bq[e], -448.0f, 448.0f); }
              int p0 = __builtin_amdgcn_cvt_pk_fp8_f32(a[0], a[1], 0, false); p0 = __builtin_amdgcn_cvt_pk_fp8_f32(a[2], a[3], p0, true);
              int p1 = __builtin_amdgcn_cvt_pk_fp8_f32(bq[0], bq[1], 0, false); p1 = __builtin_amdgcn_cvt_pk_fp8_f32(bq[2], bq[3], p1, true);
              pg8::u32x2_t wv; wv.x = (unsigned)p0; wv.y = (unsigned)p1;
              *(GAS pg8::u32x2_t*)op = wv; } }
        __syncthreads();
    }
}

__device__ __forceinline__ void attn_phase_naive(Frame& F, bf16* MIX, const int gmask) {
    const bf16* QKV = (const bf16*)(F.ws + WS_YS);
    const int lane = F.lane;
    const int gw = F.vcu * NWAVES + F.wave, NGW = F.G * NWAVES;
    for (int item = gw; item < T * 16; item += NGW) {
        const int tok = item >> 4, h = item & 15, b = tok / SEQ, t = tok % SEQ;
        const bf16* Qb = QKV + (size_t)b * SEQ * NQKV;
        float sc[3][3]; int kt[3][3];
        float mx = -INFINITY;
#pragma unroll
        for (int g = 0; g < 3; ++g) {
            const int dil = (g == 0) ? 1 : (g == 1 ? 4 : 16);
            const float slope = exp2f(-8.0f * (float)(g * 16 + h + 1) / 48.0f);
            const bf16* qp = Qb + (size_t)t * NQKV + ((g * 3 + 0) * 16 + h) * 64;
#pragma unroll
            for (int c = 0; c < 3; ++c) {
                const int j = lane + 64 * c; const int tk = t - j * dil;
                float s = -INFINITY;
                if (j <= 128 && tk >= 0 && ((gmask >> g) & 1)) {
                    const bf16* kp = Qb + (size_t)tk * NQKV + ((g * 3 + 1) * 16 + h) * 64;
                    float d = 0.f;
                    for (int e = 0; e < 64; ++e) d += bf2f(qp[e]) * bf2f(kp[e]);
                    s = d - slope * LOG2E * (float)(j * dil);
                }
                sc[g][c] = s; kt[g][c] = tk; mx = fmaxf(mx, s);
            }
        }
#pragma unroll
        for (int o = 1; o < 64; o <<= 1) mx = fmaxf(mx, __shfl_xor(mx, o));
        float den = 0.f; float acc[64];
#pragma unroll
        for (int e = 0; e < 64; ++e) acc[e] = 0.f;
#pragma unroll
        for (int g = 0; g < 3; ++g)
#pragma unroll
            for (int c = 0; c < 3; ++c) {
                const float p = (sc[g][c] == -INFINITY) ? 0.f : exp2f(sc[g][c] - mx);
                den += p;
                if (p != 0.f) { const bf16* vp = Qb + (size_t)kt[g][c] * NQKV + ((g * 3 + 2) * 16 + h) * 64;
#pragma unroll
                    for (int e = 0; e < 64; ++e) acc[e] += p * bf2f(vp[e]); }
            }
        den = wave_sum(den);
        float mine = 0.f;
#pragma unroll
        for (int e = 0; e < 64; ++e) { const float v = wave_sum(acc[e]); if (lane == e) mine = v; }
        MIX[(size_t)tok * D + h * 64 + lane] = (bf16)f2bf(mine / den);
    }
}

struct Args { const float* in[20]; float* out; unsigned char* ws; int ph_lo, ph_hi; };
constexpr int NPHASE = 2 + DEPTH * 8;

__global__ void __launch_bounds__(NWAVES * 64, 2) mk_fwd(Args args) {
    extern __shared__ __attribute__((aligned(16))) unsigned char lds_raw[];
    Frame F;
    F.lds = (LAS unsigned char*)lds_raw; F.lc = F.lds + LDSCTL_OFF;
    F.tid = threadIdx.x; F.lane = F.tid & 63; F.wave = __builtin_amdgcn_readfirstlane(F.tid >> 6);
    F.G = gridDim.x; { const int bx = blockIdx.x; F.vcu = (F.G % 8 == 0) ? (bx % 8) * (F.G / 8) + bx / 8 : bx; }
    F.ws = args.ws; F.ctl = (unsigned*)(args.ws + WS_CTL);
    for (int u = F.tid; u < (LDS_BYTES - LDSCTL_OFF) / 4; u += NWAVES * 64) ((LAS unsigned*)F.lc)[u] = 0u;
    __syncthreads();
    if (F.tid == 0) {
#pragma unroll
        for (int i = 0; i < 20; ++i) *(LAS unsigned long long*)(F.lc + LC_PTR + 8 * i) = (unsigned long long)args.in[i];
        *(LAS unsigned long long*)(F.lc + LC_PTR + 8 * 20) = (unsigned long long)args.out;
    }
    __syncthreads();
#if MK_PER_PHASE
#define GRID_BAR() do { } while (0)
    XcdBarrier bar; bar.bar = nullptr; bar.x = 0; bar.st = nullptr;
#else
    XcdBarrier bar = xcd_barrier_post(F.ctl + CW_BAR, (volatile LAS unsigned*)(F.lc + LC_MISC) + 8);
#define GRID_BAR() xcd_barrier(bar)
#endif
    const int lo = args.ph_lo, hi = args.ph_hi;
#ifdef PROBE_TYPE
#define LC_STAMP 3072
#define STAMP(ty) do { if (blockIdx.x == 0 && F.tid == 0) { const unsigned long long now_ = __builtin_amdgcn_s_memrealtime(); LAS unsigned long long* st_ = (LAS unsigned long long*)(F.lc + LC_STAMP); \
        st_[1 + (ty)] += now_ - st_[0]; st_[0] = now_; } } while (0)
    if (blockIdx.x == 0 && F.tid == 0) { ((LAS unsigned long long*)(F.lc + LC_STAMP))[0] = __builtin_amdgcn_s_memrealtime(); }
#else
#define STAMP(ty) do { } while (0)
#endif
#define IN(k) (lo <= (k) && (k) < hi)
#define SEAM(k) do { if (IN(k) && IN((k) + 1)) GRID_BAR(); } while (0)
    const float* mod = (const float*)(F.ws + WS_MOD);

    if (PHON(0) && IN(0)) { p0_prologue(F); } SEAM(0); STAMP(0);
    bool xlocal = false; int cid = (int)blockIdx.x;
#if !MK_PER_PHASE
    { volatile LAS unsigned* st = (volatile LAS unsigned*)(F.lc + LC_MISC) + 8;
      if (F.tid == 0) { unsigned ok = (F.G == 256) ? 1u : 0u;
#pragma unroll
          for (unsigned jx = 0; jx < 16; ++jx) { const unsigned cj = xb_ld(&bar.bar[XB_XCNT(jx)]); ok &= (jx < 8u) ? (cj == 32u ? 1u : 0u) : (cj == 0u ? 1u : 0u); }
          st[3] = ok; }
      __syncthreads();
      xlocal = (st[3] != 0u) && (MK_XLOCAL != 0);
      if (xlocal) cid = (int)(st[2] * 8u + bar.x); }
#endif
    cid = __builtin_amdgcn_readfirstlane(cid);
    F.vcu = (F.G % 8 == 0) ? (cid % 8) * (F.G / 8) + cid / 8 : cid;
#define LSEAM(k) do { if (IN(k) && IN((k) + 1)) { if (xlocal) xcd_local_barrier(bar, F.wave == 0); else GRID_BAR(); } } while (0)
    if (PHON(1) && IN(1)) { p1_modulate(F, inp(F, 0), mod, 0, 1024); } SEAM(1); STAMP(1);

    for (int layer = 0; layer < DEPTH; ++layer) {
        const int pb = 2 + layer * 8; const int j = layer >> 1;
        if ((layer & 1) == 0) {
            if (PHON(2) && IN(pb + 0)) { refresh(F); unsigned char* ws = opq(F.ws); (void)ws;
                PlainSchedG S{T / 256, 4, 256, F.G, cid, (const char*)(ws + WS_WPIN) + (size_t)j * MiB, 1024};
                pg8::EpiStore8 E{(bf16*)(ws + WS_U), D, nullptr, 0, 0, 0, F.lds + LDS_TB_OFF + F.wave * 2048, 0x77777777};
                pg8::gemm_phase<pg8::EpiStore8, PlainSchedG>(F.tid, F.lds, (const char*)(ws + WS_H), 1024, 1024, 512, S, E);
            } LSEAM(pb + 0); STAMP(2);
            if (PHON(4) && IN(pb + 2)) { refresh(F); unsigned char* ws = opq(F.ws); (void)ws;
                GrpSched S{F.G, cid, (const char*)(ws + WS_WPGRP) + (size_t)j * 512 * 1024};
                { const bf16* U = (const bf16*)(ws + WS_U); bf16* Z = (bf16*)(ws + WS_Z); pg8::Unit pu;
                  for (int i = 0; S.next(i, pu); ++i) {
                      const int b = pu.pm >> 3, t0 = (pu.pm & 7) * 256 + 32 * F.wave, g = pu.pn;
                      if (g == 0) pool_item<2>(U, Z, b, t0, 0, F.lane); else if (g == 1) pool_item<4>(U, Z, b, t0, 1, F.lane);
                      else if (g == 2) pool_item<8>(U, Z, b, t0, 2, F.lane); else pool_item<16>(U, Z, b, t0, 3, F.lane); }
                  asm volatile("s_waitcnt vmcnt(0)" ::: "memory"); __syncthreads(); }
                pg8::EpiStoreF8 E{(unsigned char*)(ws + WS_Y2), D, F.lds + LDS_TB_OFF + F.wave * 2048, 0, inp(F, 6) + j * D, 16.0f};
                pg8::gemm_phase<pg8::EpiStoreF8, GrpSched>(F.tid, F.lds, (const char*)(ws + WS_Z), 2048, 512, 256, S, E);
            } LSEAM(pb + 2); STAMP(4);
            if (PHON(5) && IN(pb + 3)) { refresh(F); unsigned char* ws = opq(F.ws); (void)ws;
                PlainSchedG S{T / 256, 4, 256, F.G, cid, (const char*)(ws + WS_WPOUT) + (size_t)j * MiB, 1024};
                pg8::EpiStore8 E{(bf16*)(ws + WS_Y), D, nullptr, 0, 0, 1, F.lds + LDS_TB_OFF + F.wave * 2048, 0x76767676};
                pg8::gemm_phase<pg8::EpiStore8, PlainSchedG>(F.tid, F.lds, (const char*)(ws + WS_Y2), 1024, 1024, 512, S, E);
            } LSEAM(pb + 3); STAMP(5);
        } else {
            if (PHON(6) && IN(pb + 0)) { refresh(F); unsigned char* ws = opq(F.ws); (void)ws;
                PlainSchedG S{T / 256, NQKV / 256, (T / 256) * (NQKV / 256), F.G, cid, (const char*)(ws + WS_WAIN) + (size_t)j * 9 * MiB, 1024};
                pg8::EpiStoreF8Q E{(unsigned char*)(ws + WS_QKV), NQKV, F.lds + LDS_TB_OFF + F.wave * 2048, 1};
                pg8::gemm_phase<pg8::EpiStoreF8Q, PlainSchedG>(F.tid, F.lds, (const char*)(ws + WS_H), 1024, 1024, 512, S, E);
            } LSEAM(pb + 0); STAMP(6);
            if (PHON(7) && IN(pb + 1)) { refresh(F); unsigned char* ws = opq(F.ws); (void)ws;
#ifdef NAIVE_ATTN
                attn_phase_naive(F, (bf16*)(F.ws + WS_Y2), 7);
#ifdef ORACLE
                if (layer == ORACLE_LAYER) { attn_phase_naive(F, (bf16*)(F.ws + WS_Z), ATTN_GMASK); attn_phase(F, (bf16*)(F.ws + WS_U)); }
#endif
#else
                attn_phase(F, (bf16*)(F.ws + WS_Y2));
#endif
            } if (IN(pb + 1) && IN(pb + 3)) { if (xlocal) xcd_local_barrier(bar, F.wave == 0); else GRID_BAR(); } STAMP(7);
            if (IN(pb + 2)) { refresh(F); unsigned char* ws = opq(F.ws); (void)ws;
#ifdef ORACLE
                if (layer == ORACLE_LAYER) { if (blockIdx.x == 0 && F.tid == 0) atomicAdd(F.ctl + 20000, 3276u * 16u);
                    const bf16* A = (const bf16*)(ws + WS_U); const bf16* B = (const bf16*)(ws + WS_Z);
                    const int gw = F.vcu * NWAVES + F.wave, NGW = F.G * NWAVES;
                    for (int tok = gw; tok < T; tok += NGW) { int bad = 0;
                        for (int h = 0; h < 16; ++h) { if (ORACLE_SEL) { const float a = bf2f(A[(size_t)tok * D + h * 64 + F.lane]), b = bf2f(B[(size_t)tok * D + h * 64 + F.lane]);
                            const float e2 = wave_sum((a - b) * (a - b)), n2 = wave_sum(b * b); if (!(e2 <= 0.0025f * n2)) bad += ORACLE_W; } }
                        if (bad && F.lane == 0) atomicAdd(F.ctl + 20000, (unsigned)bad); } }
#endif
            }
            if (PHON(8) && IN(pb + 3)) { refresh(F); unsigned char* ws = opq(F.ws); (void)ws;
                PlainSchedG S{T / 256, 4, 256, F.G, cid, (const char*)(ws + WS_WAOUT) + (size_t)j * MiB, 1024};
                pg8::EpiStoreF8Q E{(unsigned char*)(ws + WS_Y), D, F.lds + LDS_TB_OFF + F.wave * 2048, 0, nullptr, 1.0f, 0x7a7a7a7a};
                pg8::gemm_phase<pg8::EpiStoreF8Q, PlainSchedG>(F.tid, F.lds, (const char*)(ws + WS_Y2), 1024, 1024, 512, S, E);
            } LSEAM(pb + 3); STAMP(8);
        }
        if (PHON(9) && IN(pb + 4)) { refresh(F); unsigned char* ws = opq(F.ws); (void)ws; const float* xin = (layer == 0) ? inp(F, 0) : (const float*)(ws + WS_X); if (layer == 0) ln1_router_phase<false>(F, layer, xin); else ln1_router_phase<true>(F, layer, xin); } SEAM(pb + 4); STAMP(9);
        if (PHON(10) && IN(pb + 5)) { refresh(F); unsigned char* ws = opq(F.ws); (void)ws;
            moe_build_table(F, layer);
            const LAS int* ts = (const LAS int*)(F.lc + LC_TS);
            const int ntile = ts[65];
            MoeSched<true> S{ts, (const LAS int*)(F.lc + LC_CNT), 2, ntile * 2, F.G, cid, F.lane, (const int*)(ws + WS_TOKL), (const float*)(ws + WS_WL),
                       (const char*)(ws + WS_WEGU) + (size_t)layer * 32 * MiB, (size_t)512 * 1024, (const char*)(ws + WS_WSHGU) + (size_t)layer * 512 * 1024, 1024};
            pg8::EpiGU E{(unsigned char*)(ws + WS_ACT)};
            pg8::gemm_phase<pg8::EpiGU, MoeSched<true>>(F.tid, F.lds, (const char*)(ws + WS_U), 1024, 1024, 512, S, E);
        } LSEAM(pb + 5); STAMP(10);
        if (PHON(11) && IN(pb + 6)) { refresh(F); unsigned char* ws = opq(F.ws); (void)ws;
            moe_build_table(F, layer);
            const LAS int* ts = (const LAS int*)(F.lc + LC_TS);
            const int ntile = ts[65];
            MoeSchedDG S{ts, ntile, F.G, cid, F.lane, (const char*)(ws + WS_WEDN) + (size_t)layer * 16 * MiB, (const char*)(ws + WS_WSHDN) + (size_t)layer * 256 * 1024};
            pg8::EpiStoreF8Q E{(unsigned char*)(ws + WS_YS), D, F.lds + LDS_TB_OFF + F.wave * 2048, 0};
            pg8::gemm_phase<pg8::EpiStoreF8Q, MoeSchedDG>(F.tid, F.lds, (const char*)(ws + WS_ACT), 256, 256, 128, S, E);
        } SEAM(pb + 6); STAMP(11);
        if (PHON(12) && IN(pb + 7)) { refresh(F); unsigned char* ws = opq(F.ws); (void)ws; moe_build_table(F, layer); combine_ln2_phase(F, layer); }
        if (layer < DEPTH - 1) LSEAM(pb + 7);
        STAMP(12);
    }
#ifdef PROBE_TYPE
    if (blockIdx.x == 0 && F.tid == 0) { const unsigned long long t0_ = __builtin_amdgcn_s_memrealtime(); const unsigned long long want_ = 4ull * ((LAS unsigned long long*)(F.lc + LC_STAMP))[1 + PROBE_TYPE];
        while (__builtin_amdgcn_s_memrealtime() - t0_ < want_) __builtin_amdgcn_s_sleep(8); }
#endif
#undef IN
#undef SEAM
}

extern "C" void kernel_launch(void* const* d_in, const int* in_sizes, int n_in, void* d_out, int out_size, void* d_ws, size_t ws_size, hipStream_t stream) {
    static int grid = 0;
    if (grid == 0) {
        if (n_in != 20 || in_sizes[0] != T * D || out_size != T * D || ws_size < WS_END) { fprintf(stderr, "kernel_launch: unexpected shapes / workspace (n_in %d, ws %zu); nothing launched\n", n_in, ws_size); grid = -1; return; }
        int dev = 0, cus = 0, per_cu = 0;
        if (hipGetDevice(&dev) != hipSuccess || hipDeviceGetAttribute(&cus, hipDeviceAttributeMultiprocessorCount, dev) != hipSuccess) { grid = -1; return; }
        if (hipFuncSetAttribute((const void*)mk_fwd, hipFuncAttributeMaxDynamicSharedMemorySize, LDS_BYTES) != hipSuccess) { fprintf(stderr, "kernel_launch: hipFuncSetAttribute failed\n"); grid = -1; return; }
        if (hipOccupancyMaxActiveBlocksPerMultiprocessor(&per_cu, (const void*)mk_fwd, NWAVES * 64, LDS_BYTES) != hipSuccess || per_cu < 1) { fprintf(stderr, "kernel_launch: occupancy query says %d\n", per_cu); }
        (void)hipGetLastError();
        grid = cus;
    }
    if (grid < 0) return;
    if (hipMemsetAsync((char*)d_ws + WS_CTL, 0, CTL_ZERO_BYTES, stream) != hipSuccess) return;
    Args a{};
    for (int i = 0; i < 20; ++i) a.in[i] = (const float*)d_in[i];
    a.out = (float*)d_out; a.ws = (unsigned char*)d_ws;
#if MK_PER_PHASE
    for (int p = 0; p < NPHASE; ++p) { a.ph_lo = p; a.ph_hi = p + 1; hipLaunchKernelGGL(mk_fwd, dim3(grid), dim3(NWAVES * 64), LDS_BYTES, stream, a); }
#else
    a.ph_lo = 0; a.ph_hi = NPHASE;
    hipLaunchKernelGGL(mk_fwd, dim3(grid), dim3(NWAVES * 64), LDS_BYTES, stream, a);
#endif
    const hipError_t le = hipPeekAtLastError();
    if (le != hipSuccess) fprintf(stderr, "kernel_launch: launch failed: %s\n", hipGetErrorName(le));
}
```
